# Optimizing an MI355X kernel written in HIP

```python
import numpy as np
import jax, jax.numpy as jnp
from jax import lax

D_MODEL = 2048
BATCH = 4
SEQ = 2048
DEPTH = 1

MEM_LEN = 256
NSA_HEADS = 16
NSA_GROUPS = 4
NSA_REP = NSA_HEADS // NSA_GROUPS
NSA_DK = 128
NSA_DV = 128
CMP_LEN = 32
CMP_STRIDE = 16
CMP_HIDDEN = 1024
SEL_LEN = 64
SEL_TOPK = 16
WIN = 512
WIN_QB = 128
SEL_QB = 32
RET_HEADS = 8
RET_DK = 128
RET_DV = 256
RET_CHUNK = 128
ROPE_BASE = 10000.0
X_HEADS = 4
X_DH = 128
D_FF = 4 * D_MODEL
EPS = 1e-6
NEG = -1e30
NSA_Q = NSA_HEADS * NSA_DK
NSA_KW = NSA_GROUPS * NSA_DK
NSA_VW = NSA_GROUPS * NSA_DV
NSA_GATE = NSA_HEADS * 3
RET_QK = RET_HEADS * RET_DK
RET_V = RET_HEADS * RET_DV
IN_SIZES = (NSA_Q, NSA_KW, NSA_VW, NSA_KW, NSA_VW, NSA_KW, NSA_VW, NSA_GATE,
            RET_QK, RET_QK, RET_V, RET_V, D_MODEL, D_MODEL)
IN_WIDTH = sum(IN_SIZES)

kernel_name = "hybrid_nsa_retention_gated_block"


def rmsnorm(x, w):
    xf = x.astype(jnp.float32)
    y = xf * lax.rsqrt(jnp.mean(xf * xf, axis=-1, keepdims=True) + EPS)
    return (y * w.astype(jnp.float32)).astype(x.dtype)


def masked_softmax(s, mask):
    p = jax.nn.softmax(jnp.where(mask, s, NEG), axis=-1)
    return p * mask


def split_in(z):
    offs = np.cumsum(np.array(IN_SIZES))[:-1]
    return jnp.split(z, offs, axis=-1)


def nsa_compress(k, pe, w1, w2):
    B, T, G, d = k.shape
    n_cmp = (T - CMP_LEN) // CMP_STRIDE + 1
    idx = np.arange(n_cmp)[:, None] * CMP_STRIDE + np.arange(CMP_LEN)[None, :]
    blk = k[:, idx] + pe[None, None, :, None, :]
    blk = blk.transpose(0, 1, 3, 2, 4).reshape(B, n_cmp, G, CMP_LEN * d)
    return jax.nn.silu(blk @ w1) @ w2


def cmp_attention(q, kc, vc):
    T, n_cmp = q.shape[1], kc.shape[1]
    s = jnp.einsum('btgrd,bcgd->bgrtc', q, kc).astype(jnp.float32) * (NSA_DK ** -0.5)
    t = jnp.arange(T)
    end = jnp.arange(n_cmp) * CMP_STRIDE + CMP_LEN - 1
    mask = end[None, :] <= t[:, None]
    p = masked_softmax(s, mask)
    o = jnp.einsum('bgrtc,bcgd->btgrd', p.astype(vc.dtype), vc)
    return o, p


def select_blocks(p_cmp, T):
    n_cmp = p_cmp.shape[-1]
    n_sel = T // SEL_LEN
    cs = np.arange(n_cmp) * CMP_STRIDE
    js = np.arange(n_sel) * SEL_LEN
    ov = ((cs[:, None] < js[None, :] + SEL_LEN) & (cs[:, None] + CMP_LEN > js[None, :])).astype(np.float32)
    imp = jnp.einsum('bgrtc,cj->bgtj', p_cmp, jnp.asarray(ov))
    t = jnp.arange(T)
    cur = t // SEL_LEN
    j = jnp.arange(n_sel)
    forced = (j[None, :] == 0) | (j[None, :] == cur[:, None]) | (j[None, :] == cur[:, None] - 1)
    future = j[None, :] > cur[:, None]
    imp = jnp.where(forced, jnp.inf, jnp.where(future, -jnp.inf, imp))
    _, idx = lax.top_k(imp, min(SEL_TOPK, n_sel))
    return idx


def sel_attention(q, ks, vs, idx):
    B, T, G, R, d = q.shape
    dv = vs.shape[-1]
    n_sel = T // SEL_LEN
    n = idx.shape[-1]
    kb = ks.reshape(B, n_sel, SEL_LEN, G, d).transpose(0, 3, 1, 2, 4).reshape(B * G, n_sel, SEL_LEN, d)
    vb = vs.reshape(B, n_sel, SEL_LEN, G, dv).transpose(0, 3, 1, 2, 4).reshape(B * G, n_sel, SEL_LEN, dv)
    nq = T // SEL_QB
    qx = q.reshape(B, nq, SEL_QB, G, R, d).transpose(1, 0, 2, 3, 4, 5)
    ix = idx.reshape(B * G, nq, SEL_QB, n).transpose(1, 0, 2, 3)
    gather = jax.vmap(lambda tab, ii: tab[ii])

    def one(args):
        qb, ib, start = args
        kg = gather(kb, ib).reshape(B, G, SEL_QB, n * SEL_LEN, d)
        vg = gather(vb, ib).reshape(B, G, SEL_QB, n * SEL_LEN, dv)
        s = jnp.einsum('bqgrd,bgqkd->bgrqk', qb, kg).astype(jnp.float32) * (NSA_DK ** -0.5)
        tq = start + jnp.arange(SEL_QB)
        tk = (ib.reshape(B, G, SEL_QB, n)[..., None] * SEL_LEN + jnp.arange(SEL_LEN)).reshape(B, G, SEL_QB, n * SEL_LEN)
        mask = (tk <= tq[None, None, :, None])[:, :, None]
        p = masked_softmax(s, mask)
        return jnp.einsum('bgrqk,bgqkd->bqgrd', p.astype(vg.dtype), vg)

    o = lax.map(one, (qx, ix, jnp.arange(nq) * SEL_QB))
    return o.transpose(1, 0, 2, 3, 4, 5).reshape(B, T, G, R, dv)


def win_attention(q, kw, vw):
    B, T, G, R, d = q.shape
    nb = T // WIN_QB
    P = WIN // WIN_QB

    def band(x):
        xp = jnp.pad(x, ((0, 0), (WIN, 0), (0, 0), (0, 0))).reshape(B, nb + P, WIN_QB, G, x.shape[-1])
        return jnp.concatenate([xp[:, j:j + nb] for j in range(P + 1)], axis=2)

    kb, vb = band(kw), band(vw)
    qb = q.reshape(B, nb, WIN_QB, G, R, d)
    s = jnp.einsum('bnqgrd,bnkgd->bgrnqk', qb, kb).astype(jnp.float32) * (NSA_DK ** -0.5)
    blk = jnp.arange(nb)[:, None] * WIN_QB
    tq = blk + jnp.arange(WIN_QB)[None, :]
    tk = blk - WIN + jnp.arange((P + 1) * WIN_QB)[None, :]
    diff = tq[:, :, None] - tk[:, None, :]
    mask = (diff >= 0) & (diff < WIN) & (tk[:, None, :] >= 0)
    p = masked_softmax(s, mask)
    o = jnp.einsum('bgrnqk,bnkgd->bnqgrd', p.astype(vb.dtype), vb)
    return o.reshape(B, T, G, R, vw.shape[-1])


def rotary(x):
    T, d = x.shape[1], x.shape[-1]
    inv = ROPE_BASE ** (-jnp.arange(0, d, 2, dtype=jnp.float32) / d)
    ang = jnp.arange(T, dtype=jnp.float32)[:, None] * inv[None, :]
    cos, sin = jnp.cos(ang)[None, :, None, :], jnp.sin(ang)[None, :, None, :]
    xf = x.astype(jnp.float32)
    x1, x2 = xf[..., 0::2], xf[..., 1::2]
    return jnp.stack([x1 * cos - x2 * sin, x1 * sin + x2 * cos], axis=-1).reshape(xf.shape)


def retention(q, k, v, gn_w):
    B, T, H, dk = q.shape
    dv = v.shape[-1]
    C = RET_CHUNK
    nc = T // C
    qf = rotary(q)
    kf = rotary(k) * (dk ** -0.5)
    log_g = jnp.log1p(-jnp.exp2(-5.0 - jnp.arange(H, dtype=jnp.float32)))
    i = jnp.arange(C, dtype=jnp.float32)
    rel = i[:, None] - i[None, :]
    decay = jnp.where(rel >= 0, jnp.exp(log_g[:, None, None] * jnp.maximum(rel, 0.0)), 0.0)
    qc = qf.reshape(B, nc, C, H, dk)
    kc = kf.reshape(B, nc, C, H, dk)
    vc = v.astype(jnp.float32).reshape(B, nc, C, H, dv)
    s = jnp.einsum('bnchd,bnmhd->bhncm', qc, kc) * decay[:, None]
    o_intra = jnp.einsum('bhncm,bnmhe->bnche', s, vc)
    w_k = jnp.exp(log_g[:, None] * (C - 1 - i)[None, :])
    kv = jnp.einsum('bnmhd,bnmhe,hm->nbhde', kc, vc, w_k)
    g_chunk = jnp.exp(log_g * C)

    def step(state, kv_n):
        return state * g_chunk[None, :, None, None] + kv_n, state

    _, prev = lax.scan(step, jnp.zeros((B, H, dk, dv), jnp.float32), kv)
    w_q = jnp.exp(log_g[:, None] * (i + 1.0)[None, :])
    o_inter = jnp.einsum('bnchd,nbhde->bnche', qc, prev) * w_q.T[None, None, :, :, None]
    o = (o_intra + o_inter).reshape(B, T, H, dv)
    mu = jnp.mean(o, axis=-1, keepdims=True)
    var = jnp.mean(jnp.square(o - mu), axis=-1, keepdims=True)
    o = ((o - mu) * lax.rsqrt(var + EPS)).reshape(B, T, H * dv) * gn_w.astype(jnp.float32)
    return o.astype(v.dtype)


def hybrid_layer(h, mem, attn_norm_w, w_in, cmp_pe_k, cmp_w1_k, cmp_w2_k, cmp_pe_v, cmp_w1_v, cmp_w2_v,
                 w_a, ret_gn_w, w_b, w_out, x_norm_w, mem_norm_w, wq_x, wk_x, wv_x, wo_x,
                 mlp_norm_w, w_up, w_down):
    B, T, _ = h.shape
    G, R = NSA_GROUPS, NSA_REP
    n = rmsnorm(h, attn_norm_w)
    (q_n, k_c, v_c, k_s, v_s, k_w, v_w, g_nsa,
     q_r, k_r, v_r, g_r, gate_a, gate_b) = split_in(n @ w_in)
    q_n = q_n.reshape(B, T, G, R, NSA_DK)
    kv = lambda a, d: a.reshape(B, T, G, d)
    kc = nsa_compress(kv(k_c, NSA_DK), cmp_pe_k, cmp_w1_k, cmp_w2_k)
    vc = nsa_compress(kv(v_c, NSA_DV), cmp_pe_v, cmp_w1_v, cmp_w2_v)
    o_cmp, p_cmp = cmp_attention(q_n, kc, vc)
    idx = select_blocks(p_cmp, T)
    o_sel = sel_attention(q_n, kv(k_s, NSA_DK), kv(v_s, NSA_DV), idx)
    o_win = win_attention(q_n, kv(k_w, NSA_DK), kv(v_w, NSA_DV))
    g3 = jax.nn.sigmoid(g_nsa).reshape(B, T, G, R, 3)
    o_nsa = (g3[..., 0:1] * o_cmp + g3[..., 1:2] * o_sel + g3[..., 2:3] * o_win).reshape(B, T, NSA_HEADS * NSA_DV)
    o_ret = retention(q_r.reshape(B, T, RET_HEADS, RET_DK), k_r.reshape(B, T, RET_HEADS, RET_DK),
                      v_r.reshape(B, T, RET_HEADS, RET_DV), ret_gn_w)
    o_ret = jax.nn.silu(g_r) * o_ret
    merged = jax.nn.sigmoid(gate_a) * (o_nsa @ w_a) + jax.nn.sigmoid(gate_b) * (o_ret @ w_b)
    h = h + merged @ w_out
    nx = rmsnorm(h, x_norm_w)
    m = rmsnorm(mem, mem_norm_w)
    qx = (nx @ wq_x).reshape(B, T, X_HEADS, X_DH)
    kx = (m @ wk_x).reshape(B, m.shape[1], X_HEADS, X_DH)
    vx = (m @ wv_x).reshape(B, m.shape[1], X_HEADS, X_DH)
    sx = jnp.einsum('bthd,bmhd->bhtm', qx, kx).astype(jnp.float32) * (X_DH ** -0.5)
    px = jax.nn.softmax(sx, axis=-1).astype(vx.dtype)
    ox = jnp.einsum('bhtm,bmhd->bthd', px, vx).reshape(B, T, X_HEADS * X_DH)
    h = h + ox @ wo_x
    nm = rmsnorm(h, mlp_norm_w)
    h = h + jnp.square(jax.nn.relu(nm @ w_up)) @ w_down
    return h


def setup_inputs(seed: int = 0) -> dict:
    key = jax.random.key(seed)
    ks = iter(jax.random.split(key, 32))
    L = DEPTH
    f32 = jnp.float32

    def w(shape, fan_in):
        return jax.random.normal(next(ks), shape, f32) * (fan_in ** -0.5)

    def gain(shape):
        return 1.0 + 0.1 * jax.random.normal(next(ks), shape, f32)

    return {
        "x": jax.random.normal(next(ks), (BATCH, SEQ, D_MODEL), f32),
        "mem": jax.random.normal(next(ks), (BATCH, MEM_LEN, D_MODEL), f32),
        "attn_norm_w": gain((L, D_MODEL)),
        "w_in": w((L, D_MODEL, IN_WIDTH), D_MODEL),
        "cmp_pe_k": 0.02 * jax.random.normal(next(ks), (L, CMP_LEN, NSA_DK), f32),
        "cmp_w1_k": w((L, CMP_LEN * NSA_DK, CMP_HIDDEN), CMP_LEN * NSA_DK),
        "cmp_w2_k": w((L, CMP_HIDDEN, NSA_DK), CMP_HIDDEN),
        "cmp_pe_v": 0.02 * jax.random.normal(next(ks), (L, CMP_LEN, NSA_DV), f32),
        "cmp_w1_v": w((L, CMP_LEN * NSA_DV, CMP_HIDDEN), CMP_LEN * NSA_DV),
        "cmp_w2_v": w((L, CMP_HIDDEN, NSA_DV), CMP_HIDDEN),
        "w_a": w((L, NSA_HEADS * NSA_DV, D_MODEL), NSA_HEADS * NSA_DV),
        "ret_gn_w": gain((L, RET_V)),
        "w_b": w((L, RET_V, D_MODEL), RET_V),
        "w_out": w((L, D_MODEL, D_MODEL), D_MODEL),
        "x_norm_w": gain((L, D_MODEL)),
        "mem_norm_w": gain((L, D_MODEL)),
        "wq_x": w((L, D_MODEL, X_HEADS * X_DH), D_MODEL),
        "wk_x": w((L, D_MODEL, X_HEADS * X_DH), D_MODEL),
        "wv_x": w((L, D_MODEL, X_HEADS * X_DH), D_MODEL),
        "wo_x": w((L, X_HEADS * X_DH, D_MODEL), X_HEADS * X_DH),
        "mlp_norm_w": gain((L, D_MODEL)),
        "w_up": w((L, D_MODEL, D_FF), D_MODEL),
        "w_down": w((L, D_FF, D_MODEL), D_FF),
        "final_norm_w": gain((D_MODEL,)),
    }


def reference(x, mem, attn_norm_w, w_in, cmp_pe_k, cmp_w1_k, cmp_w2_k, cmp_pe_v, cmp_w1_v, cmp_w2_v,
              w_a, ret_gn_w, w_b, w_out, x_norm_w, mem_norm_w, wq_x, wk_x, wv_x, wo_x,
              mlp_norm_w, w_up, w_down, final_norm_w):
    h = x
    for l in range(DEPTH):
        h = hybrid_layer(h, mem, attn_norm_w[l], w_in[l], cmp_pe_k[l], cmp_w1_k[l], cmp_w2_k[l],
                         cmp_pe_v[l], cmp_w1_v[l], cmp_w2_v[l], w_a[l], ret_gn_w[l], w_b[l], w_out[l],
                         x_norm_w[l], mem_norm_w[l], wq_x[l], wk_x[l], wv_x[l], wo_x[l],
                         mlp_norm_w[l], w_up[l], w_down[l])
    return rmsnorm(h, final_norm_w)
```

```cpp
#include <hip/hip_runtime.h>
#include <hip/hip_cooperative_groups.h>
#include <cstdio>
namespace cg = cooperative_groups;

#ifndef ONE_LAUNCH
#define ONE_LAUNCH 1
#endif

#define DI __device__ __forceinline__
typedef unsigned short bfr;
using bf16x8 = __attribute__((ext_vector_type(8))) short;
using s16x4 = __attribute__((ext_vector_type(4))) short;
using f32x16 = __attribute__((ext_vector_type(16))) float;
using u32x4 = __attribute__((ext_vector_type(4))) unsigned;
#define MFMA(a, b, c) __builtin_amdgcn_mfma_f32_32x32x16_bf16((a), (b), (c), 0, 0, 0)

constexpr int DM = 2048, SEQ = 2048, NTOK = 8192;
constexpr int ZS = 15488;
constexpr int ZC_Q = 0, ZC_KC = 2048, ZC_VC = 2560, ZC_KS = 3072, ZC_VS = 3584, ZC_KW = 4096, ZC_VW = 4608,
              ZC_QR = 5120, ZC_KR = 6144, ZC_VR = 7168, ZC_GR = 9216, ZC_GA = 11264, ZC_GB = 13312, ZC_GN = 15360;
constexpr int NPHASE = 16;

constexpr size_t SZ_WINT = (size_t)ZS * 2048 * 2;
constexpr size_t SZ_ACT = (size_t)NTOK * 2048 * 2;
constexpr size_t OFF_WINT = 0;
constexpr size_t OFF_N = OFF_WINT + SZ_WINT;
constexpr size_t OFF_MERGED = OFF_WINT;
constexpr size_t OFF_ORET = OFF_N;
constexpr size_t OFF_WUPT = 0;
constexpr size_t OFF_WDOWNT = SZ_ACT;
constexpr size_t OFF_Z = OFF_N + SZ_ACT;
constexpr size_t SZ_Z = (size_t)NTOK * ZS * 2;
constexpr size_t OFF_HID = OFF_Z;
constexpr size_t OFF_H = OFF_Z + (size_t)NTOK * 8192 * 2;
constexpr size_t OFF_NX = OFF_H + (size_t)NTOK * 2048 * 4;
constexpr size_t OFF_QX = OFF_NX + SZ_ACT;
constexpr size_t OFF_OX = OFF_QX + (size_t)NTOK * 512 * 2;
static_assert(OFF_OX + (size_t)NTOK * 512 * 2 <= OFF_Z + SZ_Z, "alias overflow");
constexpr size_t OFF_ZCHI = OFF_Z + SZ_Z;
constexpr size_t OFF_MN = OFF_ZCHI + (size_t)NTOK * 1024 * 2;
constexpr size_t OFF_W1T = OFF_MN + (size_t)1024 * 2048 * 2;
constexpr size_t OFF_W2T = OFF_W1T + (size_t)2 * 1024 * 4096 * 2;
constexpr size_t OFF_WAT = OFF_W2T + (size_t)2 * 128 * 1024 * 2;
constexpr size_t OFF_WBT = OFF_WAT + (size_t)2048 * 2048 * 2;
constexpr size_t OFF_WOUTT = OFF_WBT + (size_t)2048 * 2048 * 2;
constexpr size_t OFF_WQT = OFF_WOUTT + (size_t)2048 * 2048 * 2;
constexpr size_t OFF_WKT = OFF_WQT + (size_t)512 * 2048 * 2;
constexpr size_t OFF_WVT = OFF_WKT + (size_t)512 * 2048 * 2;
constexpr size_t OFF_WOT = OFF_WVT + (size_t)512 * 2048 * 2;
constexpr size_t OFF_ROPE = OFF_WOT + (size_t)512 * 2048 * 2;
constexpr size_t OFF_HIDC = OFF_ROPE + (size_t)2048 * 64 * 8;
constexpr size_t OFF_KCVC = OFF_HIDC + (size_t)2 * 2048 * 1024 * 2;
constexpr size_t OFF_SELM = OFF_KCVC + (size_t)2 * 2048 * 128 * 2;
constexpr size_t OFF_ONSA = OFF_SELM + (size_t)16 * 2048 * 4;
constexpr size_t OFF_KX = OFF_ONSA + SZ_ACT;
constexpr size_t OFF_VX = OFF_KX + (size_t)1024 * 512 * 2;
constexpr size_t WS_END = OFF_VX + (size_t)1024 * 512 * 2;

struct Params {
  const float *x, *mem, *attn_norm_w, *w_in, *pe_k, *w1k, *w2k, *pe_v, *w1v, *w2v, *w_a, *gn_w, *w_b, *w_out, *x_norm_w,
      *mem_norm_w, *wq, *wk, *wv, *wo, *mlp_norm_w, *w_up, *w_down, *final_norm_w;
  float* out;
  char* ws;
  int ph_lo, ph_hi;
};

constexpr int SMEM_BYTES = 52224;

DI unsigned pack2(float a, float b) {
  typedef float f2 __attribute__((ext_vector_type(2)));
  typedef __bf16 b2 __attribute__((ext_vector_type(2)));
  f2 v = {a, b};
  b2 r = __builtin_convertvector(v, b2);
  return __builtin_bit_cast(unsigned, r);
}
DI float bflo(unsigned u) { return __uint_as_float(u << 16); }
DI float bfhi(unsigned u) { return __uint_as_float(u & 0xffff0000u); }
DI void st_bf4(bfr* p, float a, float b, float c, float d) {
  uint2 v; v.x = pack2(a, b); v.y = pack2(c, d);
  *(uint2*)p = v;
}
DI float wave_sum(float v) {
#pragma unroll
  for (int o = 32; o > 0; o >>= 1) v += __shfl_xor(v, o);
  return v;
}
DI float sigmoidf_(float x) { return 1.f / (1.f + __expf(-x)); }
DI int crow(int i, int h) { return (i & 3) + 8 * (i >> 2) + 4 * h; }
DI bf16x8 pack8(const f32x16& x, int s) {
  unsigned a = pack2(x[8 * s], x[8 * s + 1]), b = pack2(x[8 * s + 2], x[8 * s + 3]), c = pack2(x[8 * s + 4], x[8 * s + 5]),
           d = pack2(x[8 * s + 6], x[8 * s + 7]);
  typedef unsigned u4 __attribute__((ext_vector_type(4)));
  u4 v = {a, b, c, d};
  return __builtin_bit_cast(bf16x8, v);
}
DI s16x4 tr_read(const bfr* p) {
  return __builtin_amdgcn_ds_read_tr16_b64_v4i16((__attribute__((address_space(3))) s16x4*)(p));
}

struct TJob { const float* src; bfr* dst; int K, N, ntn, perm; };
DI TJob get_tjob(const Params& p, int j) {
  TJob t;
  char* ws = p.ws;
  switch (j) {
    case 0: t = {p.w_in, (bfr*)(ws + OFF_WINT), 2048, 15408, 242, 1}; break;
    case 1: t = {p.w1k, (bfr*)(ws + OFF_W1T), 4096, 1024, 16, 0}; break;
    case 2: t = {p.w1v, (bfr*)(ws + OFF_W1T) + (size_t)1024 * 4096, 4096, 1024, 16, 0}; break;
    case 3: t = {p.w2k, (bfr*)(ws + OFF_W2T), 1024, 128, 2, 0}; break;
    case 4: t = {p.w2v, (bfr*)(ws + OFF_W2T) + (size_t)128 * 1024, 1024, 128, 2, 0}; break;
    case 5: t = {p.w_a, (bfr*)(ws + OFF_WAT), 2048, 2048, 32, 0}; break;
    case 6: t = {p.w_b, (bfr*)(ws + OFF_WBT), 2048, 2048, 32, 0}; break;
    case 7: t = {p.w_out, (bfr*)(ws + OFF_WOUTT), 2048, 2048, 32, 0}; break;
    case 8: t = {p.wq, (bfr*)(ws + OFF_WQT), 2048, 512, 8, 0}; break;
    case 9: t = {p.wk, (bfr*)(ws + OFF_WKT), 2048, 512, 8, 0}; break;
    case 10: t = {p.wv, (bfr*)(ws + OFF_WVT), 2048, 512, 8, 0}; break;
    case 11: t = {p.wo, (bfr*)(ws + OFF_WOT), 512, 2048, 32, 0}; break;
    case 12: t = {p.w_up, (bfr*)(ws + OFF_WUPT), 2048, 8192, 128, 0}; break;
    default: t = {p.w_down, (bfr*)(ws + OFF_WDOWNT), 8192, 2048, 32, 0}; break;
  }
  return t;
}
DI int tjob_tiles(int j) {
  switch (j) {
    case 0: return 242 * 32;
    case 1: case 2: return 16 * 64;
    case 3: case 4: return 2 * 16;
    case 5: case 6: case 7: return 32 * 32;
    case 8: case 9: case 10: return 8 * 32;
    case 11: return 32 * 8;
    case 12: return 128 * 32;
    default: return 32 * 128;
  }
}
DI void transpose_tile(const TJob& t, int tile, float* sm, const int tid) {
  const int nkt = t.K >> 6;
  const int kt = tile % nkt, nt = tile / nkt;
  const int k0 = kt * 64, d0 = nt * 64;
  int scol0 = d0, nvalid = 64;
  if (t.perm) {
    if (d0 < 5120) scol0 = d0;
    else if (d0 < 15360) scol0 = d0 + 48;
    else { scol0 = d0 - 15360 + 5120; nvalid = (d0 == 15360) ? 48 : 0; }
  }
#pragma unroll
  for (int i = 0; i < 4; ++i) {
    const int row = i * 16 + (tid >> 4), col = (tid & 15) * 4;
    float4 v = make_float4(0.f, 0.f, 0.f, 0.f);
    if (col < nvalid) v = *(const float4*)(t.src + (size_t)(k0 + row) * t.N + scol0 + col);
    float* d = sm + row * 65 + col;
    d[0] = v.x; d[1] = v.y; d[2] = v.z; d[3] = v.w;
  }
  __syncthreads();
  const int n = tid >> 2, ks = (tid & 3) * 16;
  unsigned o[8];
#pragma unroll
  for (int j = 0; j < 8; ++j) o[j] = pack2(sm[(ks + 2 * j) * 65 + n], sm[(ks + 2 * j + 1) * 65 + n]);
  uint4* d = (uint4*)(t.dst + (size_t)(d0 + n) * t.K + k0 + ks);
  d[0] = make_uint4(o[0], o[1], o[2], o[3]);
  d[1] = make_uint4(o[4], o[5], o[6], o[7]);
  __syncthreads();
}

DI void rmsnorm_row(const float* xrow, const float* w, bfr* obf, float* of32, const int tid) {
  const int lane = tid & 63;
  float4 v[8];
  float ss = 0.f;
#pragma unroll
  for (int i = 0; i < 8; ++i) {
    v[i] = ((const float4*)xrow)[lane + 64 * i];
    ss += v[i].x * v[i].x + v[i].y * v[i].y + v[i].z * v[i].z + v[i].w * v[i].w;
  }
  ss = wave_sum(ss);
  const float rs = rsqrtf(ss * (1.f / 2048.f) + 1e-6f);
#pragma unroll
  for (int i = 0; i < 8; ++i) {
    const float4 ww = ((const float4*)w)[lane + 64 * i];
    const float a = v[i].x * rs * ww.x, b = v[i].y * rs * ww.y, c = v[i].z * rs * ww.z, d = v[i].w * rs * ww.w;
    if (obf) st_bf4(obf + (lane + 64 * i) * 4, a, b, c, d);
    else ((float4*)of32)[lane + 64 * i] = make_float4(a, b, c, d);
  }
}

constexpr int GP = 72;
struct PlainPtr {
  const bfr* base; int ld;
  DI const bfr* operator()(int row, int k0) const { return base + (size_t)row * ld + k0; }
};
template <class AF, class BF>
DI void gemm_main(f32x16 (&acc)[2][2], const AF& af, const BF& bf, int nk, char* smem, const int tid) {
  bfr* sa = (bfr*)smem;
  bfr* sb = sa + 128 * GP;
  const int lane = tid & 63, w = tid >> 6, r = lane & 31, h = lane >> 5;
  const int wm = w & 1, wn = w >> 1;
  const int chunk = tid & 7, r0 = tid >> 3;
  u32x4 ra[4], rb[4];
#pragma unroll
  for (int i = 0; i < 4; ++i) {
    ra[i] = *(const u32x4*)(af(r0 + 32 * i, 0) + chunk * 8);
    rb[i] = *(const u32x4*)(bf(r0 + 32 * i, 0) + chunk * 8);
  }
  __syncthreads();
  for (int kt = 0; kt < nk; ++kt) {
#pragma unroll
    for (int i = 0; i < 4; ++i) {
      *(u32x4*)(sa + (r0 + 32 * i) * GP + chunk * 8) = ra[i];
      *(u32x4*)(sb + (r0 + 32 * i) * GP + chunk * 8) = rb[i];
    }
    __syncthreads();
    if (kt + 1 < nk) {
#pragma unroll
      for (int i = 0; i < 4; ++i) {
        ra[i] = *(const u32x4*)(af(r0 + 32 * i, (kt + 1) * 64) + chunk * 8);
        rb[i] = *(const u32x4*)(bf(r0 + 32 * i, (kt + 1) * 64) + chunk * 8);
      }
    }
#pragma unroll
    for (int ks = 0; ks < 4; ++ks) {
      bf16x8 wf[2], xf[2];
#pragma unroll
      for (int i = 0; i < 2; ++i) {
        wf[i] = *(const bf16x8*)(sb + (wn * 64 + i * 32 + r) * GP + ks * 16 + h * 8);
        xf[i] = *(const bf16x8*)(sa + (wm * 64 + i * 32 + r) * GP + ks * 16 + h * 8);
      }
#pragma unroll
      for (int ni = 0; ni < 2; ++ni)
#pragma unroll
        for (int mi = 0; mi < 2; ++mi) acc[ni][mi] = MFMA(wf[ni], xf[mi], acc[ni][mi]);
    }
    __syncthreads();
  }
}
DI void acc_zero(f32x16 (&acc)[2][2]) {
#pragma unroll
  for (int a = 0; a < 2; ++a)
#pragma unroll
    for (int b = 0; b < 2; ++b)
#pragma unroll
      for (int i = 0; i < 16; ++i) acc[a][b][i] = 0.f;
}
template <class EPI>
DI void gemm_epi(const f32x16 (&acc)[2][2], int m0, int n0, const int tid, const EPI& epi) {
  const int lane = tid & 63, w = tid >> 6, r = lane & 31, h = lane >> 5;
  const int wm = w & 1, wn = w >> 1;
#pragma unroll
  for (int ni = 0; ni < 2; ++ni)
#pragma unroll
    for (int mi = 0; mi < 2; ++mi)
#pragma unroll
      for (int g = 0; g < 4; ++g) {
        const int n = n0 + wn * 64 + ni * 32 + 8 * g + 4 * h;
        const int m = m0 + wm * 64 + mi * 32 + r;
        epi(m, n, acc[ni][mi][4 * g], acc[ni][mi][4 * g + 1], acc[ni][mi][4 * g + 2], acc[ni][mi][4 * g + 3]);
      }
}
DI void map_tile64(int v, int& mt, int& nt) {
  const int xcd = v & 7, j = v >> 3;
  nt = j >> 3;
  mt = xcd * 8 + (j & 7);
}

enum { MODE_WIN = 0, MODE_SEL = 1, MODE_X = 2, MODE_RET = 3 };
constexpr int KP = 136;

template <int MODE>
DI void attn_item(const Params& p, int item, char* smem, const int tid) {
  constexpr int DVT = (MODE == MODE_RET) ? 256 : 128;
  constexpr int VP = DVT + 8;
  constexpr int VCH = DVT / 8;
  constexpr int NVR = 64 * VCH / 256;
  bfr* Ks = (bfr*)smem;
  bfr* Vs = Ks + 64 * KP;
  float* stat = (float*)(smem + 64 * KP * 2 + 64 * 264 * 2);
  const int w = tid >> 6, lane = tid & 63, r = lane & 31, h = lane >> 5;
  char* ws = p.ws;
  const bfr* z = (const bfr*)(ws + OFF_Z);

  int b, t0, tq0, jlo, jhi, head = 0, grp = 0, dcol0 = 0;
  const bfr *qrow, *kbase, *vbase;
  int ldk;
  unsigned selm = 0, umask = 0xffffffffu;
  if (MODE == MODE_WIN) {
    const int tb = item >> 4, bg = item & 15;
    b = bg >> 2; grp = bg & 3; t0 = tb * 32; tq0 = t0; head = grp * 4 + w;
    qrow = z + (size_t)(b * SEQ + tq0 + r) * ZS + ZC_Q + head * 128;
    kbase = z + (size_t)(b * SEQ) * ZS + ZC_KW + grp * 128;
    vbase = z + (size_t)(b * SEQ) * ZS + ZC_VW + grp * 128;
    ldk = ZS;
    jlo = (t0 - 511 > 0 ? t0 - 511 : 0) >> 6;
    jhi = (t0 + 31) >> 6;
  } else if (MODE == MODE_SEL) {
    const int tb = 63 - (item >> 4), bg = item & 15;
    b = bg >> 2; grp = bg & 3; t0 = tb * 32; tq0 = t0; head = grp * 4 + w;
    qrow = z + (size_t)(b * SEQ + tq0 + r) * ZS + ZC_Q + head * 128;
    kbase = z + (size_t)(b * SEQ) * ZS + ZC_KS + grp * 128;
    vbase = z + (size_t)(b * SEQ) * ZS + ZC_VS + grp * 128;
    ldk = ZS;
    jlo = 0;
    jhi = (t0 + 31) >> 6;
    selm = ((const unsigned*)(ws + OFF_SELM))[(b * 4 + grp) * SEQ + tq0 + r];
    unsigned u = selm;
#pragma unroll
    for (int o = 16; o > 0; o >>= 1) u |= (unsigned)__shfl_xor((int)u, o);
    umask = (unsigned)__builtin_amdgcn_readfirstlane((int)u);
    umask &= (jhi >= 31) ? 0xffffffffu : ((1u << (jhi + 1)) - 1u);
  } else if (MODE == MODE_X) {
    const int tb = item >> 4, bh = item & 15;
    b = bh >> 2; head = bh & 3; t0 = tb * 128; tq0 = t0 + 32 * w;
    qrow = (const bfr*)(ws + OFF_QX) + (size_t)(b * SEQ + tq0 + r) * 512 + head * 128;
    kbase = (const bfr*)(ws + OFF_KX) + (size_t)(b * 256) * 512 + head * 128;
    vbase = (const bfr*)(ws + OFF_VX) + (size_t)(b * 256) * 512 + head * 128;
    ldk = 512;
    jlo = 0; jhi = 3;
  } else {
    const int tb = 31 - (item >> 5), bh = item & 31;
    b = bh >> 3; head = bh & 7; t0 = tb * 64; tq0 = t0 + 32 * (w & 1); dcol0 = 128 * (w >> 1);
    qrow = z + (size_t)(b * SEQ + tq0 + r) * ZS + ZC_QR + head * 128;
    kbase = z + (size_t)(b * SEQ) * ZS + ZC_KR + head * 128;
    vbase = z + (size_t)(b * SEQ) * ZS + ZC_VR + head * 256;
    ldk = ZS;
    jlo = 0; jhi = tb;
  }
  const int tq = tq0 + r;

  bf16x8 qf[8];
#pragma unroll
  for (int s = 0; s < 8; ++s) qf[s] = *(const bf16x8*)(qrow + 16 * s + 8 * h);

  f32x16 o[4];
#pragma unroll
  for (int dt = 0; dt < 4; ++dt)
#pragma unroll
    for (int i = 0; i < 16; ++i) o[dt][i] = 0.f;
  float m_run = -INFINITY, l_run = 0.f;
  float lg = 0.f;
  if (MODE == MODE_RET) lg = log1pf(-exp2f(-5.f - (float)head)) * 1.4426950408889634f;

  u32x4 kreg[4], vreg[NVR];
  auto gload = [&](int j) {
    const int k0 = j * 64;
#pragma unroll
    for (int i = 0; i < 4; ++i) {
      const int c = tid + 256 * i, row = c >> 4, cc = c & 15;
      kreg[i] = *(const u32x4*)(kbase + (size_t)(k0 + row) * ldk + cc * 8);
    }
#pragma unroll
    for (int i = 0; i < NVR; ++i) {
      const int c = tid + 256 * i, row = c / VCH, cc = c % VCH;
      vreg[i] = *(const u32x4*)(vbase + (size_t)(k0 + row) * ldk + cc * 8);
    }
  };
  auto swrite = [&]() {
#pragma unroll
    for (int i = 0; i < 4; ++i) {
      const int c = tid + 256 * i, row = c >> 4, cc = c & 15;
      *(u32x4*)(Ks + row * KP + cc * 8) = kreg[i];
    }
#pragma unroll
    for (int i = 0; i < NVR; ++i) {
      const int c = tid + 256 * i, row = c / VCH, cc = c % VCH;
      *(u32x4*)(Vs + row * VP + cc * 8) = vreg[i];
    }
  };
  auto next_j = [&](int j) -> int {
    if (MODE == MODE_SEL) {
      const unsigned rem = (j >= 31) ? 0u : (umask & ~((2u << j) - 1u));
      return rem ? (__builtin_ctz(rem)) : 64;
    }
    return j + 1;
  };
  int j = jlo;
  if (MODE == MODE_SEL) j = __builtin_ctz(umask);
  gload(j);
  const float csc = 0.08838834764831845f * 1.4426950408889634f;
  const int q4 = (lane & 15) >> 2, p4 = lane & 3, blk = (lane >> 4) & 1;
#pragma unroll 1
  while (j <= jhi) {
    __syncthreads();
    swrite();
    __syncthreads();
    const int jn = next_j(j);
    if (jn <= jhi) gload(jn);
    const int k0 = j * 64;
    f32x16 s0, s1;
#pragma unroll
    for (int i = 0; i < 16; ++i) { s0[i] = 0.f; s1[i] = 0.f; }
#pragma unroll
    for (int s = 0; s < 8; ++s) {
      const bf16x8 k0f = *(const bf16x8*)(Ks + r * KP + 16 * s + 8 * h);
      const bf16x8 k1f = *(const bf16x8*)(Ks + (32 + r) * KP + 16 * s + 8 * h);
      s0 = MFMA(k0f, qf[s], s0);
      s1 = MFMA(k1f, qf[s], s1);
    }
    if (MODE == MODE_RET) {
#pragma unroll
      for (int i = 0; i < 16; ++i) {
        const int tk0 = k0 + crow(i, h), tk1 = tk0 + 32;
        s0[i] = (tk0 <= tq) ? s0[i] * __builtin_amdgcn_exp2f(lg * (float)(tq - tk0)) : 0.f;
        s1[i] = (tk1 <= tq) ? s1[i] * __builtin_amdgcn_exp2f(lg * (float)(tq - tk1)) : 0.f;
      }
    } else {
      const bool lanesel = (MODE == MODE_SEL) ? ((selm >> j) & 1u) : true;
      float mx = -INFINITY;
#pragma unroll
      for (int i = 0; i < 16; ++i) {
        const int tk0 = k0 + crow(i, h), tk1 = tk0 + 32;
        bool ok0 = true, ok1 = true;
        if (MODE == MODE_WIN) { ok0 = (tk0 <= tq) && (tq - tk0 < 512); ok1 = (tk1 <= tq) && (tq - tk1 < 512); }
        if (MODE == MODE_SEL) { ok0 = lanesel && (tk0 <= tq); ok1 = lanesel && (tk1 <= tq); }
        s0[i] = ok0 ? s0[i] * csc : -INFINITY;
        s1[i] = ok1 ? s1[i] * csc : -INFINITY;
        mx = fmaxf(mx, fmaxf(s0[i], s1[i]));
      }
      mx = fmaxf(mx, __shfl_xor(mx, 32));
      const float mnew = fmaxf(m_run, mx);
      const float muse = (mnew == -INFINITY) ? 0.f : mnew;
      const float alpha = __builtin_amdgcn_exp2f(m_run - muse);
      float ls = 0.f;
#pragma unroll
      for (int i = 0; i < 16; ++i) {
        s0[i] = __builtin_amdgcn_exp2f(s0[i] - muse);
        s1[i] = __builtin_amdgcn_exp2f(s1[i] - muse);
        ls += s0[i] + s1[i];
      }
      ls += __shfl_xor(ls, 32);
      l_run = l_run * alpha + ls;
      m_run = mnew;
#pragma unroll
      for (int dt = 0; dt < 4; ++dt)
#pragma unroll
        for (int i = 0; i < 16; ++i) o[dt][i] *= alpha;
    }
    bf16x8 pf[2][2];
    pf[0][0] = pack8(s0, 0); pf[0][1] = pack8(s0, 1);
    pf[1][0] = pack8(s1, 0); pf[1][1] = pack8(s1, 1);
#pragma unroll
    for (int dt = 0; dt < 4; ++dt)
#pragma unroll
      for (int sub = 0; sub < 2; ++sub)
#pragma unroll
        for (int st = 0; st < 2; ++st) {
          const int key0 = 32 * sub + 16 * st + 4 * h;
          const bfr* vp = Vs + (key0 + q4) * VP + dcol0 + 32 * dt + 16 * blk + 4 * p4;
          const s16x4 lo = tr_read(vp);
          const s16x4 hi = tr_read(vp + 8 * VP);
          const bf16x8 vf = __builtin_shufflevector(lo, hi, 0, 1, 2, 3, 4, 5, 6, 7);
          o[dt] = MFMA(vf, pf[sub][st], o[dt]);
        }
    j = jn;
  }

  const size_t mrow = (size_t)(b * SEQ + tq);
  if (MODE == MODE_WIN || MODE == MODE_SEL) {
    const float inv = (l_run > 0.f) ? 1.f / l_run : 0.f;
    const float gate = bflo(z[mrow * ZS + ZC_GN + head * 3 + (MODE == MODE_WIN ? 2 : 1)]);
    bfr* orow = (bfr*)(ws + OFF_ONSA) + mrow * 2048 + head * 128;
    const float sc = inv * gate;
#pragma unroll
    for (int dt = 0; dt < 4; ++dt)
#pragma unroll
      for (int g = 0; g < 4; ++g) {
        bfr* dst = orow + 32 * dt + 8 * g + 4 * h;
        float a = o[dt][4 * g] * sc, bb = o[dt][4 * g + 1] * sc, c = o[dt][4 * g + 2] * sc, d = o[dt][4 * g + 3] * sc;
        if (MODE == MODE_SEL) {
          const uint2 old = *(const uint2*)dst;
          a += bflo(old.x); bb += bfhi(old.x); c += bflo(old.y); d += bfhi(old.y);
        }
        st_bf4(dst, a, bb, c, d);
      }
  } else if (MODE == MODE_X) {
    const float inv = 1.f / l_run;
    bfr* orow = (bfr*)(ws + OFF_OX) + mrow * 512 + head * 128;
#pragma unroll
    for (int dt = 0; dt < 4; ++dt)
#pragma unroll
      for (int g = 0; g < 4; ++g)
        st_bf4(orow + 32 * dt + 8 * g + 4 * h, o[dt][4 * g] * inv, o[dt][4 * g + 1] * inv, o[dt][4 * g + 2] * inv,
               o[dt][4 * g + 3] * inv);
  } else {
    float sm = 0.f, sq = 0.f;
#pragma unroll
    for (int dt = 0; dt < 4; ++dt)
#pragma unroll
      for (int i = 0; i < 16; ++i) { sm += o[dt][i]; sq += o[dt][i] * o[dt][i]; }
    sm += __shfl_xor(sm, 32);
    sq += __shfl_xor(sq, 32);
    __syncthreads();
    if (h == 0) { stat[(w * 32 + r) * 2] = sm; stat[(w * 32 + r) * 2 + 1] = sq; }
    __syncthreads();
    const int wp = w ^ 2;
    sm += stat[(wp * 32 + r) * 2];
    sq += stat[(wp * 32 + r) * 2 + 1];
    const float mu = sm * (1.f / 256.f);
    const float var = fmaxf(sq * (1.f / 256.f) - mu * mu, 0.f);
    const float rstd = rsqrtf(var + 1e-6f);
    const int col0 = head * 256 + dcol0;
    const bfr* grow = z + mrow * ZS + ZC_GR + col0;
    const float* gw = p.gn_w + col0;
    bfr* orow = (bfr*)(ws + OFF_ORET) + mrow * 2048 + col0;
#pragma unroll
    for (int dt = 0; dt < 4; ++dt)
#pragma unroll
      for (int g = 0; g < 4; ++g) {
        const int d = 32 * dt + 8 * g + 4 * h;
        const uint2 gg = *(const uint2*)(grow + d);
        const float4 ww = *(const float4*)(gw + d);
        st_bf4(orow + d, (o[dt][4 * g] - mu) * rstd * ww.x * bflo(gg.x), (o[dt][4 * g + 1] - mu) * rstd * ww.y * bfhi(gg.x),
               (o[dt][4 * g + 2] - mu) * rstd * ww.z * bflo(gg.y), (o[dt][4 * g + 3] - mu) * rstd * ww.w * bfhi(gg.y));
      }
  }
}

DI void cmp_item(const Params& p, int item, char* smem, const int tid) {
  bfr* Ks = (bfr*)smem;
  bfr* Vs = Ks + 64 * KP;
  float* impw = (float*)(smem + 2 * 64 * KP * 2);
  const int w = tid >> 6, lane = tid & 63, r = lane & 31, h = lane >> 5;
  char* ws = p.ws;
  const bfr* z = (const bfr*)(ws + OFF_Z);
  const int tb = item >> 4, bg = item & 15, b = bg >> 2, grp = bg & 3;
  const int t0 = tb * 32, tq = t0 + r, head = grp * 4 + w;
  const bfr* qrow = z + (size_t)(b * SEQ + tq) * ZS + ZC_Q + head * 128;
  const bfr* kc = (const bfr*)(ws + OFF_KCVC) + (size_t)((b * 4 + grp) * 128) * 128;
  const bfr* vc = kc + (size_t)2048 * 128;
  bf16x8 qf[8];
#pragma unroll
  for (int s = 0; s < 8; ++s) qf[s] = *(const bf16x8*)(qrow + 16 * s + 8 * h);
  u32x4 reg[8];
#pragma unroll
  for (int i = 0; i < 8; ++i) {
    const int c = tid + 256 * i, row = c >> 4, cc = c & 15;
    reg[i] = *(const u32x4*)(kc + row * 128 + cc * 8);
  }
  __syncthreads();
#pragma unroll
  for (int i = 0; i < 8; ++i) {
    const int c = tid + 256 * i, row = c >> 4, cc = c & 15;
    *(u32x4*)(Ks + row * KP + cc * 8) = reg[i];
  }
  __syncthreads();
#pragma unroll
  for (int i = 0; i < 8; ++i) {
    const int c = tid + 256 * i, row = c >> 4, cc = c & 15;
    reg[i] = *(const u32x4*)(vc + row * 128 + cc * 8);
  }
  f32x16 s[4];
#pragma unroll
  for (int kt = 0; kt < 4; ++kt) {
#pragma unroll
    for (int i = 0; i < 16; ++i) s[kt][i] = 0.f;
#pragma unroll
    for (int ss = 0; ss < 8; ++ss) {
      const bf16x8 kf = *(const bf16x8*)(Ks + (32 * kt + r) * KP + 16 * ss + 8 * h);
      s[kt] = MFMA(kf, qf[ss], s[kt]);
    }
  }
  const float csc = 0.08838834764831845f * 1.4426950408889634f;
  float mx = -INFINITY;
#pragma unroll
  for (int kt = 0; kt < 4; ++kt)
#pragma unroll
    for (int i = 0; i < 16; ++i) {
      const int c = 32 * kt + crow(i, h);
      const bool ok = (c * 16 + 31 <= tq) && (c < 127);
      s[kt][i] = ok ? s[kt][i] * csc : -INFINITY;
      mx = fmaxf(mx, s[kt][i]);
    }
  mx = fmaxf(mx, __shfl_xor(mx, 32));
  const float muse = (mx == -INFINITY) ? 0.f : mx;
  float ls = 0.f;
#pragma unroll
  for (int kt = 0; kt < 4; ++kt)
#pragma unroll
    for (int i = 0; i < 16; ++i) {
      s[kt][i] = __builtin_amdgcn_exp2f(s[kt][i] - muse);
      ls += s[kt][i];
    }
  ls += __shfl_xor(ls, 32);
  const float inv = (ls > 0.f) ? 1.f / ls : 0.f;
#pragma unroll
  for (int kt = 0; kt < 4; ++kt)
#pragma unroll
    for (int i = 0; i < 16; ++i) s[kt][i] *= inv;
  float plast[16];
#pragma unroll
  for (int kt = 0; kt < 4; ++kt)
#pragma unroll
    for (int g = 0; g < 4; ++g) plast[kt * 4 + g] = __shfl_xor(s[kt][4 * g + 3], 32);
#pragma unroll
  for (int kt = 0; kt < 4; ++kt)
#pragma unroll
    for (int g = 0; g < 4; ++g) {
      const int slot = kt * 4 + g;
      const float sum4 = s[kt][4 * g] + s[kt][4 * g + 1] + s[kt][4 * g + 2] + s[kt][4 * g + 3];
      const float prevl = (slot > 0) ? plast[slot > 0 ? slot - 1 : 0] : 0.f;
      const float add = h ? plast[slot] : prevl;
      impw[(w * 32 + r) * 32 + 8 * kt + 2 * g + h] = sum4 + add;
    }
  bf16x8 pf[4][2];
#pragma unroll
  for (int kt = 0; kt < 4; ++kt) { pf[kt][0] = pack8(s[kt], 0); pf[kt][1] = pack8(s[kt], 1); }
  __syncthreads();
#pragma unroll
  for (int i = 0; i < 8; ++i) {
    const int c = tid + 256 * i, row = c >> 4, cc = c & 15;
    *(u32x4*)(Ks + row * KP + cc * 8) = reg[i];
  }
  __syncthreads();
  f32x16 o[4];
#pragma unroll
  for (int dt = 0; dt < 4; ++dt)
#pragma unroll
    for (int i = 0; i < 16; ++i) o[dt][i] = 0.f;
  const int q4 = (lane & 15) >> 2, p4 = lane & 3, blk = (lane >> 4) & 1;
#pragma unroll
  for (int dt = 0; dt < 4; ++dt)
#pragma unroll
    for (int kt = 0; kt < 4; ++kt)
#pragma unroll
      for (int st = 0; st < 2; ++st) {
        const int key0 = 32 * kt + 16 * st + 4 * h;
        const bfr* vp = Ks + (key0 + q4) * KP + 32 * dt + 16 * blk + 4 * p4;
        const s16x4 lo = tr_read(vp);
        const s16x4 hi = tr_read(vp + 8 * KP);
        const bf16x8 vf = __builtin_shufflevector(lo, hi, 0, 1, 2, 3, 4, 5, 6, 7);
        o[dt] = MFMA(vf, pf[kt][st], o[dt]);
      }
  {
    const size_t mrow = (size_t)(b * SEQ + tq);
    const float gate = bflo(z[mrow * ZS + ZC_GN + head * 3 + 0]);
    bfr* orow = (bfr*)(ws + OFF_ONSA) + mrow * 2048 + head * 128;
#pragma unroll
    for (int dt = 0; dt < 4; ++dt)
#pragma unroll
      for (int g = 0; g < 4; ++g) {
        bfr* dst = orow + 32 * dt + 8 * g + 4 * h;
        const uint2 old = *(const uint2*)dst;
        st_bf4(dst, o[dt][4 * g] * gate + bflo(old.x), o[dt][4 * g + 1] * gate + bfhi(old.x),
               o[dt][4 * g + 2] * gate + bflo(old.y), o[dt][4 * g + 3] * gate + bfhi(old.y));
      }
  }
  {
    const int i = tid >> 3, jg = tid & 7;
    const int cur = (t0 + i) >> 6;
    float v[32];
#pragma unroll
    for (int jj = 0; jj < 32; ++jj) {
      float a = impw[(0 * 32 + i) * 32 + jj] + impw[(1 * 32 + i) * 32 + jj] + impw[(2 * 32 + i) * 32 + jj] + impw[(3 * 32 + i) * 32 + jj];
      const bool forced = (jj == 0) || (jj == cur) || (jj == cur - 1);
      v[jj] = forced ? INFINITY : ((jj > cur) ? -INFINITY : a);
    }
    unsigned bits = 0;
#pragma unroll
    for (int e = 0; e < 4; ++e) {
      const int jme = 4 * jg + e;
      float a = impw[(0 * 32 + i) * 32 + jme] + impw[(1 * 32 + i) * 32 + jme] + impw[(2 * 32 + i) * 32 + jme] + impw[(3 * 32 + i) * 32 + jme];
      const bool forced = (jme == 0) || (jme == cur) || (jme == cur - 1);
      const float vm = forced ? INFINITY : ((jme > cur) ? -INFINITY : a);
      int rank = 0;
#pragma unroll
      for (int k = 0; k < 32; ++k) rank += (v[k] > vm || (v[k] == vm && k < jme)) ? 1 : 0;
      if (rank < 16 && jme <= cur) bits |= 1u << jme;
    }
    bits |= (unsigned)__shfl_xor((int)bits, 1);
    bits |= (unsigned)__shfl_xor((int)bits, 2);
    bits |= (unsigned)__shfl_xor((int)bits, 4);
    if (jg == 0) ((unsigned*)(ws + OFF_SELM))[(b * 4 + grp) * SEQ + t0 + i] = bits;
  }
  __syncthreads();
}

DI void run_phase(const Params& p, int ph, char* smem) {
  char* ws = p.ws;
  const int G = gridDim.x;
  int bid = blockIdx.x, tid = threadIdx.x;
  asm volatile("" : "+s"(bid));
  asm volatile("" : "+v"(tid));
  bfr* z = (bfr*)(ws + OFF_Z);
  switch (ph) {
    case 0: {
      int tot = 0;
      for (int j = 0; j < 12; ++j) tot += tjob_tiles(j);
      const int n_norm = 2048 + 256, n_rope = 512;
      for (int it = bid; it < tot + n_norm + n_rope; it += G) {
        if (it < tot) {
          int j = 0, rem = it;
          while (rem >= tjob_tiles(j)) { rem -= tjob_tiles(j); ++j; }
          const TJob t = get_tjob(p, j);
          transpose_tile(t, rem, (float*)smem, tid);
        } else if (it < tot + n_norm) {
          const int row = (it - tot) * 4 + (tid >> 6);
          if (row < NTOK) rmsnorm_row(p.x + (size_t)row * 2048, p.attn_norm_w, (bfr*)(ws + OFF_N) + (size_t)row * 2048, nullptr, tid);
          else rmsnorm_row(p.mem + (size_t)(row - NTOK) * 2048, p.mem_norm_w, (bfr*)(ws + OFF_MN) + (size_t)(row - NTOK) * 2048, nullptr, tid);
        } else {
          const int e = (it - tot - n_norm) * 256 + tid;
          const int t = e >> 6, i = e & 63;
          const double invd = exp2(-((double)(2 * i) / 128.0) * 13.287712379549449);
          const float inv = (float)invd;
          const float ang = (float)t * inv;
          double rev = (double)ang * 0.15915494309189535;
          rev -= rint(rev);
          const float fr = (float)rev;
          ((float2*)(ws + OFF_ROPE))[e] = make_float2(__builtin_amdgcn_cosf(fr), __builtin_amdgcn_sinf(fr));
        }
      }
    } break;
    case 1: {
      const int nt_main = 64 * 121;
      for (int v = bid; v < nt_main + 64; v += G) {
        f32x16 acc[2][2];
        acc_zero(acc);
        if (v < nt_main) {
          int mt, nt;
          map_tile64(v, mt, nt);
          const int m0 = mt * 128, n0 = nt * 128;
          PlainPtr af{(const bfr*)(ws + OFF_N) + (size_t)m0 * 2048, 2048};
          PlainPtr bf{(const bfr*)(ws + OFF_WINT) + (size_t)n0 * 2048, 2048};
          gemm_main(acc, af, bf, 32, smem, tid);
          bfr* zchi = (bfr*)(ws + OFF_ZCHI);
          const float2* rope = (const float2*)(ws + OFF_ROPE);
          gemm_epi(acc, m0, n0, tid, [&](int m, int n, float a, float b, float c, float d) {
            bfr* dst = z + (size_t)m * ZS + n;
            const int t = m & 2047;
            if (n >= ZC_KC && n < ZC_KS) {
              const float* pe = (n < ZC_VC) ? p.pe_k : p.pe_v;
              const int dd = n & 127;
              const float4 plo = *(const float4*)(pe + (t & 15) * 128 + dd);
              const float4 phi = *(const float4*)(pe + (16 + (t & 15)) * 128 + dd);
              st_bf4(dst, a + plo.x, b + plo.y, c + plo.z, d + plo.w);
              st_bf4(zchi + (size_t)m * 1024 + (n - ZC_KC), a + phi.x, b + phi.y, c + phi.z, d + phi.w);
            } else if (n >= ZC_QR && n < ZC_VR) {
              const int i0 = (n & 127) >> 1;
              const float2 c0 = rope[t * 64 + i0], c1 = rope[t * 64 + i0 + 1];
              float o0 = a * c0.x - b * c0.y, o1 = a * c0.y + b * c0.x;
              float o2 = c * c1.x - d * c1.y, o3 = c * c1.y + d * c1.x;
              if (n >= ZC_KR) { const float sc = 0.08838834764831845f; o0 *= sc; o1 *= sc; o2 *= sc; o3 *= sc; }
              st_bf4(dst, o0, o1, o2, o3);
            } else if (n >= ZC_GR && n < ZC_GA) {
              st_bf4(dst, a * sigmoidf_(a), b * sigmoidf_(b), c * sigmoidf_(c), d * sigmoidf_(d));
            } else if (n >= ZC_GA) {
              st_bf4(dst, sigmoidf_(a), sigmoidf_(b), sigmoidf_(c), sigmoidf_(d));
            } else {
              st_bf4(dst, a, b, c, d);
            }
          });
        } else {
          const int u = v - nt_main, which = u >> 5, mt = (u & 31) >> 2, nt = u & 3;
          const int m0 = mt * 128, n0 = nt * 128;
          PlainPtr af{(const bfr*)(ws + OFF_MN) + (size_t)m0 * 2048, 2048};
          PlainPtr bf{(const bfr*)(ws + (which ? OFF_WVT : OFF_WKT)) + (size_t)n0 * 2048, 2048};
          gemm_main(acc, af, bf, 32, smem, tid);
          bfr* dstb = (bfr*)(ws + (which ? OFF_VX : OFF_KX));
          gemm_epi(acc, m0, n0, tid, [&](int m, int n, float a, float b, float c, float d) { st_bf4(dstb + (size_t)m * 512 + n, a, b, c, d); });
        }
      }
    } break;
    case 2: {
      for (int it = bid; it < 256 + 1024 + 1024; it += G) {
        if (it < 256) {
          const int which = it >> 7, mt = (it & 127) >> 3, nt = it & 7;
          const int m0 = mt * 128, n0 = nt * 128;
          f32x16 acc[2][2];
          acc_zero(acc);
          const bfr* zc = z + ZC_KC + which * 512;
          const bfr* zh = (const bfr*)(ws + OFF_ZCHI) + which * 512;
          auto af = [&](int row, int kk) -> const bfr* {
            const int R = m0 + row;
            const int b = R >> 9, g = (R >> 7) & 3;
            int c = R & 127; c = c > 126 ? 126 : c;
            const int l = kk >> 7, dd = kk & 127;
            const size_t tok = (size_t)(b * SEQ + c * 16 + l);
            return (l < 16) ? (zc + tok * ZS + g * 128 + dd) : (zh + tok * 1024 + g * 128 + dd);
          };
          PlainPtr bf{(const bfr*)(ws + OFF_W1T) + (size_t)which * 1024 * 4096 + (size_t)n0 * 4096, 4096};
          gemm_main(acc, af, bf, 64, smem, tid);
          bfr* hid = (bfr*)(ws + OFF_HIDC) + (size_t)which * 2048 * 1024;
          gemm_epi(acc, m0, n0, tid, [&](int m, int n, float a, float b, float c, float d) {
            st_bf4(hid + (size_t)m * 1024 + n, a * sigmoidf_(a), b * sigmoidf_(b), c * sigmoidf_(c), d * sigmoidf_(d));
          });
        } else if (it < 256 + 1024) {
          attn_item<MODE_RET>(p, it - 256, smem, tid);
        } else {
          attn_item<MODE_WIN>(p, it - 1280, smem, tid);
        }
      }
    } break;
    case 3: {
      for (int it = bid; it < 32; it += G) {
        const int which = it >> 4, mt = it & 15;
        const int m0 = mt * 128;
        f32x16 acc[2][2];
        acc_zero(acc);
        PlainPtr af{(const bfr*)(ws + OFF_HIDC) + (size_t)which * 2048 * 1024 + (size_t)m0 * 1024, 1024};
        PlainPtr bf{(const bfr*)(ws + OFF_W2T) + (size_t)which * 128 * 1024, 1024};
        gemm_main(acc, af, bf, 16, smem, tid);
        bfr* dstb = (bfr*)(ws + OFF_KCVC) + (size_t)which * 2048 * 128;
        gemm_epi(acc, m0, 0, tid, [&](int m, int n, float a, float b, float c, float d) { st_bf4(dstb + (size_t)m * 128 + n, a, b, c, d); });
      }
    } break;
    case 4: {
      for (int it = bid; it < 1024; it += G) cmp_item(p, it, smem, tid);
    } break;
    case 5: {
      int k = 0;
      for (int base = 0; base < 1024; base += G, ++k) {
        const int it = (k & 1) ? base + (G - 1 - bid) : base + bid;
        if (it < 1024) attn_item<MODE_SEL>(p, it, smem, tid);
      }
    } break;
    case 6: {
      for (int v = bid; v < 64 * 16; v += G) {
        int mt, nt;
        map_tile64(v, mt, nt);
        const int m0 = mt * 128, n0 = nt * 128;
        f32x16 acc[2][2], acc2[2][2];
        acc_zero(acc);
        acc_zero(acc2);
        {
          PlainPtr af{(const bfr*)(ws + OFF_ONSA) + (size_t)m0 * 2048, 2048};
          PlainPtr bf{(const bfr*)(ws + OFF_WAT) + (size_t)n0 * 2048, 2048};
          gemm_main(acc, af, bf, 32, smem, tid);
        }
        {
          PlainPtr af{(const bfr*)(ws + OFF_ORET) + (size_t)m0 * 2048, 2048};
          PlainPtr bf{(const bfr*)(ws + OFF_WBT) + (size_t)n0 * 2048, 2048};
          gemm_main(acc2, af, bf, 32, smem, tid);
        }
        const int lane = tid & 63, w = tid >> 6, r = lane & 31, h = lane >> 5, wm = w & 1, wn = w >> 1;
        bfr* mg = (bfr*)(ws + OFF_MERGED);
#pragma unroll
        for (int ni = 0; ni < 2; ++ni)
#pragma unroll
          for (int mi = 0; mi < 2; ++mi)
#pragma unroll
            for (int g = 0; g < 4; ++g) {
              const int n = n0 + wn * 64 + ni * 32 + 8 * g + 4 * h;
              const int m = m0 + wm * 64 + mi * 32 + r;
              const uint2 ga = *(const uint2*)(z + (size_t)m * ZS + ZC_GA + n);
              const uint2 gb = *(const uint2*)(z + (size_t)m * ZS + ZC_GB + n);
              st_bf4(mg + (size_t)m * 2048 + n, bflo(ga.x) * acc[ni][mi][4 * g] + bflo(gb.x) * acc2[ni][mi][4 * g],
                     bfhi(ga.x) * acc[ni][mi][4 * g + 1] + bfhi(gb.x) * acc2[ni][mi][4 * g + 1],
                     bflo(ga.y) * acc[ni][mi][4 * g + 2] + bflo(gb.y) * acc2[ni][mi][4 * g + 2],
                     bfhi(ga.y) * acc[ni][mi][4 * g + 3] + bfhi(gb.y) * acc2[ni][mi][4 * g + 3]);
            }
      }
    } break;
    case 7: {
      for (int v = bid; v < 64 * 16; v += G) {
        int mt, nt;
        map_tile64(v, mt, nt);
        const int m0 = mt * 128, n0 = nt * 128;
        f32x16 acc[2][2];
        acc_zero(acc);
        PlainPtr af{(const bfr*)(ws + OFF_MERGED) + (size_t)m0 * 2048, 2048};
        PlainPtr bf{(const bfr*)(ws + OFF_WOUTT) + (size_t)n0 * 2048, 2048};
        gemm_main(acc, af, bf, 32, smem, tid);
        float* hbuf = (float*)(ws + OFF_H);
        gemm_epi(acc, m0, n0, tid, [&](int m, int n, float a, float b, float c, float d) {
          const float4 xv = *(const float4*)(p.x + (size_t)m * 2048 + n);
          *(float4*)(hbuf + (size_t)m * 2048 + n) = make_float4(xv.x + a, xv.y + b, xv.z + c, xv.w + d);
        });
      }
    } break;
    case 8: case 12: {
      const float* w = (ph == 8) ? p.x_norm_w : p.mlp_norm_w;
      const int n_tr = (ph == 8) ? (tjob_tiles(12) + tjob_tiles(13)) : 0;
      for (int it = bid; it < 2048 + n_tr; it += G) {
        if (it < 2048) {
          const int row = it * 4 + (tid >> 6);
          rmsnorm_row((const float*)(ws + OFF_H) + (size_t)row * 2048, w, (bfr*)(ws + OFF_NX) + (size_t)row * 2048, nullptr, tid);
        } else {
          int rem = it - 2048, j = 12;
          if (rem >= tjob_tiles(12)) { rem -= tjob_tiles(12); j = 13; }
          const TJob t = get_tjob(p, j);
          transpose_tile(t, rem, (float*)smem, tid);
        }
      }
    } break;
    case 9: {
      for (int v = bid; v < 64 * 4; v += G) {
        int mt, nt;
        map_tile64(v, mt, nt);
        const int m0 = mt * 128, n0 = nt * 128;
        f32x16 acc[2][2];
        acc_zero(acc);
        PlainPtr af{(const bfr*)(ws + OFF_NX) + (size_t)m0 * 2048, 2048};
        PlainPtr bf{(const bfr*)(ws + OFF_WQT) + (size_t)n0 * 2048, 2048};
        gemm_main(acc, af, bf, 32, smem, tid);
        bfr* qx = (bfr*)(ws + OFF_QX);
        gemm_epi(acc, m0, n0, tid, [&](int m, int n, float a, float b, float c, float d) { st_bf4(qx + (size_t)m * 512 + n, a, b, c, d); });
      }
    } break;
    case 10: {
      for (int it = bid; it < 256; it += G) attn_item<MODE_X>(p, it, smem, tid);
    } break;
    case 11: {
      for (int v = bid; v < 64 * 16; v += G) {
        int mt, nt;
        map_tile64(v, mt, nt);
        const int m0 = mt * 128, n0 = nt * 128;
        f32x16 acc[2][2];
        acc_zero(acc);
        PlainPtr af{(const bfr*)(ws + OFF_OX) + (size_t)m0 * 512, 512};
        PlainPtr bf{(const bfr*)(ws + OFF_WOT) + (size_t)n0 * 512, 512};
        gemm_main(acc, af, bf, 8, smem, tid);
        float* hbuf = (float*)(ws + OFF_H);
        gemm_epi(acc, m0, n0, tid, [&](int m, int n, float a, float b, float c, float d) {
          float4* hp = (float4*)(hbuf + (size_t)m * 2048 + n);
          const float4 xv = *hp;
          *hp = make_float4(xv.x + a, xv.y + b, xv.z + c, xv.w + d);
        });
      }
    } break;
    case 13: {
      for (int v = bid; v < 64 * 64; v += G) {
        int mt, nt;
        map_tile64(v, mt, nt);
        const int m0 = mt * 128, n0 = nt * 128;
        f32x16 acc[2][2];
        acc_zero(acc);
        PlainPtr af{(const bfr*)(ws + OFF_NX) + (size_t)m0 * 2048, 2048};
        PlainPtr bf{(const bfr*)(ws + OFF_WUPT) + (size_t)n0 * 2048, 2048};
        gemm_main(acc, af, bf, 32, smem, tid);
        bfr* hid = (bfr*)(ws + OFF_HID);
        gemm_epi(acc, m0, n0, tid, [&](int m, int n, float a, float b, float c, float d) {
          a = fmaxf(a, 0.f); b = fmaxf(b, 0.f); c = fmaxf(c, 0.f); d = fmaxf(d, 0.f);
          st_bf4(hid + (size_t)m * 8192 + n, a * a, b * b, c * c, d * d);
        });
      }
    } break;
    case 14: {
      for (int v = bid; v < 64 * 16; v += G) {
        int mt, nt;
        map_tile64(v, mt, nt);
        const int m0 = mt * 128, n0 = nt * 128;
        f32x16 acc[2][2];
        acc_zero(acc);
        PlainPtr af{(const bfr*)(ws + OFF_HID) + (size_t)m0 * 8192, 8192};
        PlainPtr bf{(const bfr*)(ws + OFF_WDOWNT) + (size_t)n0 * 8192, 8192};
        gemm_main(acc, af, bf, 128, smem, tid);
        const float* hbuf = (const float*)(ws + OFF_H);
        gemm_epi(acc, m0, n0, tid, [&](int m, int n, float a, float b, float c, float d) {
          const float4 xv = *(const float4*)(hbuf + (size_t)m * 2048 + n);
          *(float4*)(p.out + (size_t)m * 2048 + n) = make_float4(xv.x + a, xv.y + b, xv.z + c, xv.w + d);
        });
      }
    } break;
    case 15: {
      for (int it = bid; it < 2048; it += G) {
        const int row = it * 4 + (tid >> 6);
        rmsnorm_row(p.out + (size_t)row * 2048, p.final_norm_w, nullptr, p.out + (size_t)row * 2048, tid);
      }
    } break;
    default: break;
  }
}

__global__ void __launch_bounds__(256) mega(Params p) {
  __shared__ __attribute__((aligned(16))) char smem[SMEM_BYTES];
  cg::grid_group grid = cg::this_grid();
  for (int ph = p.ph_lo; ph < p.ph_hi; ++ph) {
    run_phase(p, ph, smem);
    if (ph + 1 < p.ph_hi) grid.sync();
  }
}

extern "C" void kernel_launch(void* const* d_in, const int* in_sizes, int n_in, void* d_out, int out_size, void* d_ws,
                              size_t ws_size, hipStream_t stream) {
  static int grid_blocks = 0;
  if (!grid_blocks) {
    int dev = 0, cus = 0, per_cu = 0;
    hipGetDevice(&dev);
    hipDeviceGetAttribute(&cus, hipDeviceAttributeMultiprocessorCount, dev);
    hipOccupancyMaxActiveBlocksPerMultiprocessor(&per_cu, mega, 256, 0);
    if (per_cu < 1) per_cu = 1;
    if (per_cu > 2) per_cu = 2;
    grid_blocks = cus * per_cu;
    grid_blocks &= ~7;
    if (ws_size < WS_END || n_in != 24) { fprintf(stderr, "kernel_launch: ws %zu < %zu or n_in %d\n", ws_size, (size_t)WS_END, n_in); grid_blocks = -1; }
  }
  if (grid_blocks < 0) return;
  Params p{};
  const float** pp = (const float**)&p;
  for (int i = 0; i < 24; ++i) pp[i] = (const float*)d_in[i];
  p.out = (float*)d_out;
  p.ws = (char*)d_ws;
#if ONE_LAUNCH
  p.ph_lo = 0; p.ph_hi = NPHASE;
  void* args[] = {&p};
  hipError_t e = hipLaunchCooperativeKernel((void*)mega, dim3(grid_blocks), dim3(256), args, 0, stream);
  if (e != hipSuccess) fprintf(stderr, "cooperative launch failed: %s (grid %d)\n", hipGetErrorString(e), grid_blocks);
#else
  for (int ph = 0; ph < NPHASE; ++ph) {
    p.ph_lo = ph; p.ph_hi = ph + 1;
    hipLaunchKernelGGL(mega, dim3(grid_blocks), dim3(256), 0, stream, p);
  }
#endif
}
```

```cpp
#include <hip/hip_runtime.h>
#include <hip/hip_cooperative_groups.h>
#include <cstdio>
namespace cg = cooperative_groups;

#ifndef ONE_LAUNCH
#define ONE_LAUNCH 1
#endif

#define DI __device__ __forceinline__
typedef unsigned short bfr;
using bf16x8 = __attribute__((ext_vector_type(8))) short;
using s16x4 = __attribute__((ext_vector_type(4))) short;
using f32x16 = __attribute__((ext_vector_type(16))) float;
using u32x4 = __attribute__((ext_vector_type(4))) unsigned;
#define MFMA(a, b, c) __builtin_amdgcn_mfma_f32_32x32x16_bf16((a), (b), (c), 0, 0, 0)

constexpr int DM = 2048, SEQ = 2048, NTOK = 8192;
constexpr int ZS = 15488;
constexpr int ZC_Q = 0, ZC_KC = 2048, ZC_VC = 2560, ZC_KS = 3072, ZC_VS = 3584, ZC_KW = 4096, ZC_VW = 4608,
              ZC_QR = 5120, ZC_KR = 6144, ZC_VR = 7168, ZC_GR = 9216, ZC_GA = 11264, ZC_GB = 13312, ZC_GN = 15360;
constexpr int NPHASE = 16;

constexpr size_t SZ_WINT = (size_t)ZS * 2048 * 2;
constexpr size_t SZ_ACT = (size_t)NTOK * 2048 * 2;
constexpr size_t OFF_WINT = 0;
constexpr size_t OFF_N = OFF_WINT + SZ_WINT;
constexpr size_t OFF_MERGED = OFF_WINT;
constexpr size_t OFF_ORET = OFF_N;
constexpr size_t OFF_WUPT = 0;
constexpr size_t OFF_WDOWNT = SZ_ACT;
constexpr size_t OFF_Z = OFF_N + SZ_ACT;
constexpr size_t SZ_Z = (size_t)NTOK * ZS * 2;
constexpr size_t OFF_HID = OFF_Z;
constexpr size_t OFF_H = OFF_Z + (size_t)NTOK * 8192 * 2;
constexpr size_t OFF_NX = OFF_H + (size_t)NTOK * 2048 * 4;
constexpr size_t OFF_QX = OFF_NX + SZ_ACT;
constexpr size_t OFF_OX = OFF_QX + (size_t)NTOK * 512 * 2;
static_assert(OFF_OX + (size_t)NTOK * 512 * 2 <= OFF_Z + SZ_Z, "alias overflow");
constexpr size_t OFF_ZC = OFF_Z + SZ_Z;
constexpr size_t OFF_MN = OFF_ZC + (size_t)NTOK * 2048 * 2;
constexpr size_t OFF_W1T = OFF_MN + (size_t)1024 * 2048 * 2;
constexpr size_t OFF_W2T = OFF_W1T + (size_t)2 * 1024 * 4096 * 2;
constexpr size_t OFF_WAT = OFF_W2T + (size_t)2 * 128 * 1024 * 2;
constexpr size_t OFF_WBT = OFF_WAT + (size_t)2048 * 2048 * 2;
constexpr size_t OFF_WOUTT = OFF_WBT + (size_t)2048 * 2048 * 2;
constexpr size_t OFF_WQT = OFF_WOUTT + (size_t)2048 * 2048 * 2;
constexpr size_t OFF_WKT = OFF_WQT + (size_t)512 * 2048 * 2;
constexpr size_t OFF_WVT = OFF_WKT + (size_t)512 * 2048 * 2;
constexpr size_t OFF_WOT = OFF_WVT + (size_t)512 * 2048 * 2;
constexpr size_t OFF_ROPE = OFF_WOT + (size_t)512 * 2048 * 2;
constexpr size_t OFF_HIDC = OFF_ROPE + (size_t)2048 * 64 * 8;
constexpr size_t OFF_KCVC = OFF_HIDC + (size_t)2 * 2048 * 1024 * 2;
constexpr size_t OFF_SELM = OFF_KCVC + (size_t)2 * 2048 * 128 * 2;
constexpr size_t OFF_ONSA = OFF_SELM + (size_t)16 * 2048 * 4;
constexpr size_t OFF_KX = OFF_ONSA + SZ_ACT;
constexpr size_t OFF_VX = OFF_KX + (size_t)1024 * 512 * 2;
constexpr size_t OFF_RSTAT = OFF_VX + (size_t)1024 * 512 * 2;
constexpr size_t OFF_CTR = OFF_RSTAT + (size_t)NTOK * 8 * 2 * 2 * 4;
constexpr size_t WS_END = OFF_CTR + 256;

struct Params {
  const float *x, *mem, *attn_norm_w, *w_in, *pe_k, *w1k, *w2k, *pe_v, *w1v, *w2v, *w_a, *gn_w, *w_b, *w_out, *x_norm_w,
      *mem_norm_w, *wq, *wk, *wv, *wo, *mlp_norm_w, *w_up, *w_down, *final_norm_w;
  float* out;
  char* ws;
  int ph_lo, ph_hi;
};

constexpr int SMEM_BYTES = 61440;
__device__ const float ROPE_INV[64] = {1.0f, 0.865964353f, 0.749894261f, 0.649381638f, 0.562341332f, 0.486967534f, 0.421696514f, 0.365174115f, 0.316227764f, 0.273841977f, 0.237137377f, 0.2053525f, 0.177827939f, 0.153992653f, 0.133352131f, 0.115478203f, 0.100000001f, 0.0865964293f, 0.0749894157f, 0.0649381652f, 0.0562341325f, 0.0486967526f, 0.0421696529f, 0.0365174115f, 0.0316227749f, 0.0273841973f, 0.0237137377f, 0.0205352511f, 0.0177827943f, 0.0153992651f, 0.0133352149f, 0.0115478206f, 0.00999999978f, 0.00865964312f, 0.00749894185f, 0.00649381615f, 0.00562341325f, 0.00486967526f, 0.00421696482f, 0.00365174119f, 0.00316227763f, 0.00273841969f, 0.00237137359f, 0.00205352483f, 0.00177827943f, 0.00153992651f, 0.00133352145f, 0.0011547819f, 0.00100000005f, 0.000865964335f, 0.000749894243f, 0.000649381662f, 0.000562341302f, 0.000486967532f, 0.000421696517f, 0.000365174143f, 0.000316227757f, 0.000273841957f, 0.00023713737f, 0.00020535251f, 0.00017782794f, 0.000153992645f, 0.00013335215f, 0.0001154782f};

DI unsigned pack2(float a, float b) {
  typedef float f2 __attribute__((ext_vector_type(2)));
  typedef __bf16 b2 __attribute__((ext_vector_type(2)));
  f2 v = {a, b};
  b2 r = __builtin_convertvector(v, b2);
  return __builtin_bit_cast(unsigned, r);
}
DI float bflo(unsigned u) { return __uint_as_float(u << 16); }
DI float bfhi(unsigned u) { return __uint_as_float(u & 0xffff0000u); }
DI void st_bf4(bfr* p, float a, float b, float c, float d) {
  uint2 v; v.x = pack2(a, b); v.y = pack2(c, d);
  *(uint2*)p = v;
}
DI float wave_sum(float v) {
#pragma unroll
  for (int o = 32; o > 0; o >>= 1) v += __shfl_xor(v, o);
  return v;
}
DI float sigmoidf_(float x) { return 1.f / (1.f + __expf(-x)); }
DI int crow(int i, int h) { return (i & 3) + 8 * (i >> 2) + 4 * h; }
DI bf16x8 pack8(const f32x16& x, int s) {
  unsigned a = pack2(x[8 * s], x[8 * s + 1]), b = pack2(x[8 * s + 2], x[8 * s + 3]), c = pack2(x[8 * s + 4], x[8 * s + 5]),
           d = pack2(x[8 * s + 6], x[8 * s + 7]);
  typedef unsigned u4 __attribute__((ext_vector_type(4)));
  u4 v = {a, b, c, d};
  return __builtin_bit_cast(bf16x8, v);
}
DI s16x4 tr_read(const bfr* p) {
  return __builtin_amdgcn_ds_read_tr16_b64_v4i16((__attribute__((address_space(3))) s16x4*)(p));
}

struct TJob { const float* src; bfr* dst; int K, N, ntn, perm; };
DI TJob get_tjob(const Params& p, int j) {
  TJob t;
  char* ws = p.ws;
  switch (j) {
    case 0: t = {p.w_in, (bfr*)(ws + OFF_WINT), 2048, 15408, 242, 1}; break;
    case 1: t = {p.w1k, (bfr*)(ws + OFF_W1T), 4096, 1024, 16, 0}; break;
    case 2: t = {p.w1v, (bfr*)(ws + OFF_W1T) + (size_t)1024 * 4096, 4096, 1024, 16, 0}; break;
    case 3: t = {p.w2k, (bfr*)(ws + OFF_W2T), 1024, 128, 2, 0}; break;
    case 4: t = {p.w2v, (bfr*)(ws + OFF_W2T) + (size_t)128 * 1024, 1024, 128, 2, 0}; break;
    case 5: t = {p.w_a, (bfr*)(ws + OFF_WAT), 2048, 2048, 32, 0}; break;
    case 6: t = {p.w_b, (bfr*)(ws + OFF_WBT), 2048, 2048, 32, 0}; break;
    case 7: t = {p.w_out, (bfr*)(ws + OFF_WOUTT), 2048, 2048, 32, 0}; break;
    case 8: t = {p.wq, (bfr*)(ws + OFF_WQT), 2048, 512, 8, 0}; break;
    case 9: t = {p.wk, (bfr*)(ws + OFF_WKT), 2048, 512, 8, 0}; break;
    case 10: t = {p.wv, (bfr*)(ws + OFF_WVT), 2048, 512, 8, 0}; break;
    case 11: t = {p.wo, (bfr*)(ws + OFF_WOT), 512, 2048, 32, 0}; break;
    case 12: t = {p.w_up, (bfr*)(ws + OFF_WUPT), 2048, 8192, 128, 0}; break;
    default: t = {p.w_down, (bfr*)(ws + OFF_WDOWNT), 8192, 2048, 32, 0}; break;
  }
  return t;
}
DI int tjob_tiles(int j) {
  switch (j) {
    case 0: return 242 * 32;
    case 1: case 2: return 16 * 64;
    case 3: case 4: return 2 * 16;
    case 5: case 6: case 7: return 32 * 32;
    case 8: case 9: case 10: return 8 * 32;
    case 11: return 32 * 8;
    case 12: return 128 * 32;
    default: return 32 * 128;
  }
}
DI void transpose_tile(const TJob& t, int tile, float* sm, const int tid) {
  const int nkt = t.K >> 6;
  const int kt = tile % nkt, nt = tile / nkt;
  const int k0 = kt * 64, d0 = nt * 64;
  int scol0 = d0, nvalid = 64;
  if (t.perm) {
    if (d0 < 5120) scol0 = d0;
    else if (d0 < 15360) scol0 = d0 + 48;
    else { scol0 = d0 - 15360 + 5120; nvalid = (d0 == 15360) ? 48 : 0; }
  }
#pragma unroll
  for (int i = 0; i < 4; ++i) {
    const int row = i * 16 + (tid >> 4), col = (tid & 15) * 4;
    float4 v = make_float4(0.f, 0.f, 0.f, 0.f);
    if (col < nvalid) v = *(const float4*)(t.src + (size_t)(k0 + row) * t.N + scol0 + col);
    float* d = sm + row * 65 + col;
    d[0] = v.x; d[1] = v.y; d[2] = v.z; d[3] = v.w;
  }
  __syncthreads();
  const int n = tid >> 2, ks = (tid & 3) * 16;
  unsigned o[8];
#pragma unroll
  for (int j = 0; j < 8; ++j) o[j] = pack2(sm[(ks + 2 * j) * 65 + n], sm[(ks + 2 * j + 1) * 65 + n]);
  uint4* d = (uint4*)(t.dst + (size_t)(d0 + n) * t.K + k0 + ks);
  d[0] = make_uint4(o[0], o[1], o[2], o[3]);
  d[1] = make_uint4(o[4], o[5], o[6], o[7]);
  __syncthreads();
}

DI void rmsnorm_row(const float* xrow, const float* w, bfr* obf, float* of32, const int tid) {
  const int lane = tid & 63;
  float4 v[8];
  float ss = 0.f;
#pragma unroll
  for (int i = 0; i < 8; ++i) {
    v[i] = ((const float4*)xrow)[lane + 64 * i];
    ss += v[i].x * v[i].x + v[i].y * v[i].y + v[i].z * v[i].z + v[i].w * v[i].w;
  }
  ss = wave_sum(ss);
  const float rs = rsqrtf(ss * (1.f / 2048.f) + 1e-6f);
#pragma unroll
  for (int i = 0; i < 8; ++i) {
    const float4 ww = ((const float4*)w)[lane + 64 * i];
    const float a = v[i].x * rs * ww.x, b = v[i].y * rs * ww.y, c = v[i].z * rs * ww.z, d = v[i].w * rs * ww.w;
    if (obf) st_bf4(obf + (lane + 64 * i) * 4, a, b, c, d);
    else ((float4*)of32)[lane + 64 * i] = make_float4(a, b, c, d);
  }
}

constexpr int GP = 40;
struct PlainPtr {
  const bfr* base; int ld;
  DI int rowoff(int row) const { return row * ld; }
  DI int koff(int k0) const { return k0; }
};
template <class AF, class BF>
DI void gemm_main(f32x16 (&acc)[2][4], const AF& af, const BF& bf, int nk, char* smem, const int tid) {
  bfr* sa = (bfr*)smem;
  bfr* sb = sa + 2 * 256 * GP;
  const int lane = tid & 63, w = tid >> 6, r = lane & 31, h = lane >> 5;
  const int wm = w & 1, wn = w >> 1;
  const int chunk = tid & 3, r0 = tid >> 2;
  u32x4 ra[4], rb[2];
  int ao[4], bo[2];
#pragma unroll
  for (int i = 0; i < 4; ++i) ao[i] = af.rowoff(r0 + 64 * i) + chunk * 8;
#pragma unroll
  for (int i = 0; i < 2; ++i) bo[i] = bf.rowoff(r0 + 64 * i) + chunk * 8;
  auto gload = [&](int kt) {
    const int ka = af.koff(kt * 32), kb = bf.koff(kt * 32);
#pragma unroll
    for (int i = 0; i < 4; ++i) ra[i] = *(const u32x4*)(af.base + (ao[i] + ka));
#pragma unroll
    for (int i = 0; i < 2; ++i) rb[i] = *(const u32x4*)(bf.base + (bo[i] + kb));
  };
  auto swrite = [&](int buf) {
#pragma unroll
    for (int i = 0; i < 4; ++i) *(u32x4*)(sa + buf * 256 * GP + (r0 + 64 * i) * GP + chunk * 8) = ra[i];
#pragma unroll
    for (int i = 0; i < 2; ++i) *(u32x4*)(sb + buf * 128 * GP + (r0 + 64 * i) * GP + chunk * 8) = rb[i];
  };
  gload(0);
  __syncthreads();
  swrite(0);
  if (nk > 1) gload(1);
  __syncthreads();
#pragma unroll 1
  for (int kt = 0; kt < nk; ++kt) {
    const int cur = kt & 1;
    if (kt + 1 < nk) swrite(cur ^ 1);
    if (kt + 2 < nk) gload(kt + 2);
    const bfr* ca = sa + cur * 256 * GP + (wm * 128 + r) * GP + h * 8;
    const bfr* cb = sb + cur * 128 * GP + (wn * 64 + r) * GP + h * 8;
#pragma unroll
    for (int ks = 0; ks < 2; ++ks) {
      bf16x8 wf[2], xf[4];
#pragma unroll
      for (int i = 0; i < 2; ++i) wf[i] = *(const bf16x8*)(cb + i * 32 * GP + ks * 16);
#pragma unroll
      for (int i = 0; i < 4; ++i) xf[i] = *(const bf16x8*)(ca + i * 32 * GP + ks * 16);
#pragma unroll
      for (int mi = 0; mi < 4; ++mi)
#pragma unroll
        for (int ni = 0; ni < 2; ++ni) acc[ni][mi] = MFMA(wf[ni], xf[mi], acc[ni][mi]);
    }
    __syncthreads();
  }
}
DI void acc_zero(f32x16 (&acc)[2][4]) {
#pragma unroll
  for (int a = 0; a < 2; ++a)
#pragma unroll
    for (int b = 0; b < 4; ++b)
#pragma unroll
      for (int i = 0; i < 16; ++i) acc[a][b][i] = 0.f;
}
template <class EPI>
DI void gemm_epi(const f32x16 (&acc)[2][4], int m0, int n0, const int tid_in, const EPI& epi) {
  int tid = tid_in;
  asm volatile("" : "+v"(tid));
  const int lane = tid & 63, w = tid >> 6, r = lane & 31, h = lane >> 5;
  const int wm = w & 1, wn = w >> 1;
#pragma unroll
  for (int mi = 0; mi < 4; ++mi)
#pragma unroll
    for (int ni = 0; ni < 2; ++ni)
#pragma unroll
      for (int g = 0; g < 4; ++g) {
        const int n = n0 + wn * 64 + ni * 32 + 8 * g + 4 * h;
        const int m = m0 + wm * 128 + mi * 32 + r;
        epi(m, n, acc[ni][mi][4 * g], acc[ni][mi][4 * g + 1], acc[ni][mi][4 * g + 2], acc[ni][mi][4 * g + 3]);
      }
}
DI void map_tile32(int v, int& mt, int& nt) {
  const int xcd = v & 7, j = v >> 3;
  nt = j >> 2;
  mt = xcd * 4 + (j & 3);
}

enum { MODE_WIN = 0, MODE_SEL = 1, MODE_X = 2, MODE_RET = 3 };
constexpr int KP = 136;

template <int MODE>
DI void attn_item(const Params& p, int item, char* smem, const int tid) {
  constexpr int VP = 136;
  constexpr int VCH = 16;
  constexpr int NVR = 4;
  bfr* Ks = (bfr*)smem;
  bfr* Vs = Ks + 64 * KP;
  const int w = tid >> 6, lane = tid & 63, r = lane & 31, h = lane >> 5;
  char* ws = p.ws;
  const bfr* z = (const bfr*)(ws + OFF_Z);

  int b, t0, tq0, jlo, jhi, head = 0, grp = 0, vh = 0;
  const bfr *qrow, *kbase, *vbase;
  int ldk;
  unsigned selm = 0, umask = 0xffffffffu;
  if (MODE == MODE_WIN) {
    const int tb = item >> 4, bg = item & 15;
    b = bg >> 2; grp = bg & 3; t0 = tb * 32; tq0 = t0; head = grp * 4 + w;
    qrow = z + (size_t)(b * SEQ + tq0 + r) * ZS + ZC_Q + head * 128;
    kbase = z + (size_t)(b * SEQ) * ZS + ZC_KW + grp * 128;
    vbase = z + (size_t)(b * SEQ) * ZS + ZC_VW + grp * 128;
    ldk = ZS;
    jlo = (t0 - 511 > 0 ? t0 - 511 : 0) >> 6;
    jhi = (t0 + 31) >> 6;
  } else if (MODE == MODE_SEL) {
    const int tb = 63 - (item >> 4), bg = item & 15;
    b = bg >> 2; grp = bg & 3; t0 = tb * 32; tq0 = t0; head = grp * 4 + w;
    qrow = z + (size_t)(b * SEQ + tq0 + r) * ZS + ZC_Q + head * 128;
    kbase = z + (size_t)(b * SEQ) * ZS + ZC_KS + grp * 128;
    vbase = z + (size_t)(b * SEQ) * ZS + ZC_VS + grp * 128;
    ldk = ZS;
    jlo = 0;
    jhi = (t0 + 31) >> 6;
    selm = ((const unsigned*)(ws + OFF_SELM))[(b * 4 + grp) * SEQ + tq0 + r];
    unsigned u = selm;
#pragma unroll
    for (int o = 16; o > 0; o >>= 1) u |= (unsigned)__shfl_xor((int)u, o);
    umask = (unsigned)__builtin_amdgcn_readfirstlane((int)u);
    umask &= (jhi >= 31) ? 0xffffffffu : ((1u << (jhi + 1)) - 1u);
  } else if (MODE == MODE_X) {
    const int tb = item >> 4, bh = item & 15;
    b = bh >> 2; head = bh & 3; t0 = tb * 128; tq0 = t0 + 32 * w;
    qrow = (const bfr*)(ws + OFF_QX) + (size_t)(b * SEQ + tq0 + r) * 512 + head * 128;
    kbase = (const bfr*)(ws + OFF_KX) + (size_t)(b * 256) * 512 + head * 128;
    vbase = (const bfr*)(ws + OFF_VX) + (size_t)(b * 256) * 512 + head * 128;
    ldk = 512;
    jlo = 0; jhi = 3;
  } else {
    const int tb = 15 - (item >> 6), rest = item & 63;
    b = rest >> 4; head = (rest >> 1) & 7; vh = rest & 1; t0 = tb * 128; tq0 = t0 + 32 * w;
    qrow = z + (size_t)(b * SEQ + tq0 + r) * ZS + ZC_QR + head * 128;
    kbase = z + (size_t)(b * SEQ) * ZS + ZC_KR + head * 128;
    vbase = z + (size_t)(b * SEQ) * ZS + ZC_VR + head * 256 + vh * 128;
    ldk = ZS;
    jlo = 0; jhi = 2 * tb + 1;
  }
  const int tq = tq0 + r;


  f32x16 o[4];
#pragma unroll
  for (int dt = 0; dt < 4; ++dt)
#pragma unroll
    for (int i = 0; i < 16; ++i) o[dt][i] = 0.f;
  float m_run = -INFINITY, l_run = 0.f;
  float lg = 0.f;
  if (MODE == MODE_RET) lg = log1pf(-exp2f(-5.f - (float)head)) * 1.4426950408889634f;

  u32x4 kreg[4], vreg[NVR];
  auto gload = [&](int j) {
    const int k0 = j * 64;
#pragma unroll
    for (int i = 0; i < 4; ++i) {
      const int c = tid + 256 * i, row = c >> 4, cc = c & 15;
      kreg[i] = *(const u32x4*)(kbase + (size_t)(k0 + row) * ldk + cc * 8);
    }
#pragma unroll
    for (int i = 0; i < NVR; ++i) {
      const int c = tid + 256 * i, row = c / VCH, cc = c % VCH;
      vreg[i] = *(const u32x4*)(vbase + (size_t)(k0 + row) * ldk + cc * 8);
    }
  };
  auto swrite = [&]() {
#pragma unroll
    for (int i = 0; i < 4; ++i) {
      const int c = tid + 256 * i, row = c >> 4, cc = c & 15;
      *(u32x4*)(Ks + row * KP + cc * 8) = kreg[i];
    }
#pragma unroll
    for (int i = 0; i < NVR; ++i) {
      const int c = tid + 256 * i, row = c / VCH, cc = c % VCH;
      *(u32x4*)(Vs + row * VP + cc * 8) = vreg[i];
    }
  };
  auto next_j = [&](int j) -> int {
    if (MODE == MODE_SEL) {
      const unsigned rem = (j >= 31) ? 0u : (umask & ~((2u << j) - 1u));
      return rem ? (__builtin_ctz(rem)) : 64;
    }
    return j + 1;
  };
  int j = jlo;
  if (MODE == MODE_SEL) j = __builtin_ctz(umask);
  gload(j);
  const float csc = 0.08838834764831845f * 1.4426950408889634f;
  const int q4 = (lane & 15) >> 2, p4 = lane & 3, blk = (lane >> 4) & 1;
#pragma unroll 1
  while (j <= jhi) {
    __syncthreads();
    swrite();
    __syncthreads();
    const int jn = next_j(j);
    if (jn <= jhi) gload(jn);
    const int k0 = j * 64;
    if (MODE == MODE_RET && k0 > tq0 + 31) { j = jn; continue; }
    bf16x8 qf[8];
    {
      const bfr* qp = qrow + 8 * h;
      asm volatile("" : "+v"(qp));
#pragma unroll
      for (int s = 0; s < 8; ++s) qf[s] = *(const bf16x8*)(qp + 16 * s);
    }
    bf16x8 pf[2][2];
    if (MODE == MODE_RET) {
#pragma unroll
      for (int sub = 0; sub < 2; ++sub) {
        f32x16 sx;
#pragma unroll
        for (int i = 0; i < 16; ++i) sx[i] = 0.f;
#pragma unroll
        for (int s = 0; s < 8; ++s) {
          const bf16x8 kf = *(const bf16x8*)(Ks + (32 * sub + r) * KP + 16 * s + 8 * h);
          sx = MFMA(kf, qf[s], sx);
        }
#pragma unroll
        for (int i = 0; i < 16; ++i) {
          const int tk = k0 + 32 * sub + crow(i, h);
          sx[i] = (tk <= tq) ? sx[i] * __builtin_amdgcn_exp2f(lg * (float)(tq - tk)) : 0.f;
        }
        pf[sub][0] = pack8(sx, 0);
        pf[sub][1] = pack8(sx, 1);
      }
    } else {
      f32x16 s0, s1;
  #pragma unroll
      for (int i = 0; i < 16; ++i) { s0[i] = 0.f; s1[i] = 0.f; }
  #pragma unroll
      for (int s = 0; s < 8; ++s) {
        const bf16x8 k0f = *(const bf16x8*)(Ks + r * KP + 16 * s + 8 * h);
        const bf16x8 k1f = *(const bf16x8*)(Ks + (32 + r) * KP + 16 * s + 8 * h);
        s0 = MFMA(k0f, qf[s], s0);
        s1 = MFMA(k1f, qf[s], s1);
      }
      const bool lanesel = (MODE == MODE_SEL) ? ((selm >> j) & 1u) : true;
      float mx = -INFINITY;
#pragma unroll
      for (int i = 0; i < 16; ++i) {
        const int tk0 = k0 + crow(i, h), tk1 = tk0 + 32;
        bool ok0 = true, ok1 = true;
        if (MODE == MODE_WIN) { ok0 = (tk0 <= tq) && (tq - tk0 < 512); ok1 = (tk1 <= tq) && (tq - tk1 < 512); }
        if (MODE == MODE_SEL) { ok0 = lanesel && (tk0 <= tq); ok1 = lanesel && (tk1 <= tq); }
        s0[i] = ok0 ? s0[i] * csc : -INFINITY;
        s1[i] = ok1 ? s1[i] * csc : -INFINITY;
        mx = fmaxf(mx, fmaxf(s0[i], s1[i]));
      }
      mx = fmaxf(mx, __shfl_xor(mx, 32));
      const float mnew = fmaxf(m_run, mx);
      const float muse = (mnew == -INFINITY) ? 0.f : mnew;
      const float alpha = __builtin_amdgcn_exp2f(m_run - muse);
      float ls = 0.f;
#pragma unroll
      for (int i = 0; i < 16; ++i) {
        s0[i] = __builtin_amdgcn_exp2f(s0[i] - muse);
        s1[i] = __builtin_amdgcn_exp2f(s1[i] - muse);
        ls += s0[i] + s1[i];
      }
      ls += __shfl_xor(ls, 32);
      l_run = l_run * alpha + ls;
      m_run = mnew;
#pragma unroll
      for (int dt = 0; dt < 4; ++dt)
#pragma unroll
        for (int i = 0; i < 16; ++i) o[dt][i] *= alpha;
      pf[0][0] = pack8(s0, 0); pf[0][1] = pack8(s0, 1);
      pf[1][0] = pack8(s1, 0); pf[1][1] = pack8(s1, 1);
    }
    __builtin_amdgcn_sched_barrier(0);
#pragma unroll
    for (int dt = 0; dt < 4; ++dt)
#pragma unroll
      for (int sub = 0; sub < 2; ++sub)
#pragma unroll
        for (int st = 0; st < 2; ++st) {
          const int key0 = 32 * sub + 16 * st + 4 * h;
          const bfr* vp = Vs + (key0 + q4) * VP + 32 * dt + 16 * blk + 4 * p4;
          const s16x4 lo = tr_read(vp);
          const s16x4 hi = tr_read(vp + 8 * VP);
          const bf16x8 vf = __builtin_shufflevector(lo, hi, 0, 1, 2, 3, 4, 5, 6, 7);
          o[dt] = MFMA(vf, pf[sub][st], o[dt]);
          if (sub == 1 && st == 1) __builtin_amdgcn_sched_barrier(0);
        }
    j = jn;
  }

  const size_t mrow = (size_t)(b * SEQ + tq);
  if (MODE == MODE_WIN || MODE == MODE_SEL) {
    const float inv = (l_run > 0.f) ? 1.f / l_run : 0.f;
    const float gate = bflo(z[mrow * ZS + ZC_GN + head * 3 + (MODE == MODE_WIN ? 2 : 1)]);
    bfr* orow = (bfr*)(ws + OFF_ONSA) + mrow * 2048 + head * 128;
    const float sc = inv * gate;
#pragma unroll
    for (int dt = 0; dt < 4; ++dt)
#pragma unroll
      for (int g = 0; g < 4; ++g) {
        bfr* dst = orow + 32 * dt + 8 * g + 4 * h;
        float a = o[dt][4 * g] * sc, bb = o[dt][4 * g + 1] * sc, c = o[dt][4 * g + 2] * sc, d = o[dt][4 * g + 3] * sc;
        if (MODE == MODE_SEL) {
          const uint2 old = *(const uint2*)dst;
          a += bflo(old.x); bb += bfhi(old.x); c += bflo(old.y); d += bfhi(old.y);
        }
        st_bf4(dst, a, bb, c, d);
      }
  } else if (MODE == MODE_X) {
    const float inv = 1.f / l_run;
    bfr* orow = (bfr*)(ws + OFF_OX) + mrow * 512 + head * 128;
#pragma unroll
    for (int dt = 0; dt < 4; ++dt)
#pragma unroll
      for (int g = 0; g < 4; ++g)
        st_bf4(orow + 32 * dt + 8 * g + 4 * h, o[dt][4 * g] * inv, o[dt][4 * g + 1] * inv, o[dt][4 * g + 2] * inv,
               o[dt][4 * g + 3] * inv);
  } else {
    float sm = 0.f, sq = 0.f;
#pragma unroll
    for (int dt = 0; dt < 4; ++dt)
#pragma unroll
      for (int i = 0; i < 16; ++i) { sm += o[dt][i]; sq += o[dt][i] * o[dt][i]; }
    sm += __shfl_xor(sm, 32);
    sq += __shfl_xor(sq, 32);
    if (h == 0) *(float2*)((float*)(ws + OFF_RSTAT) + ((mrow * 8 + head) * 2 + vh) * 2) = make_float2(sm, sq);
    bfr* orow = (bfr*)(ws + OFF_ORET) + mrow * 2048 + head * 256 + vh * 128;
#pragma unroll
    for (int dt = 0; dt < 4; ++dt)
#pragma unroll
      for (int g = 0; g < 4; ++g)
        st_bf4(orow + 32 * dt + 8 * g + 4 * h, o[dt][4 * g], o[dt][4 * g + 1], o[dt][4 * g + 2], o[dt][4 * g + 3]);
  }
}

DI void ret_finish_row(const Params& p, int row, const int tid) {
  char* ws = p.ws;
  const bfr* z = (const bfr*)(ws + OFF_Z);
  const int col = tid * 8, head = tid >> 5;
  const float4 st = *(const float4*)((const float*)(ws + OFF_RSTAT) + ((size_t)row * 8 + head) * 4);
  const float mu = (st.x + st.z) * (1.f / 256.f);
  const float var = fmaxf((st.y + st.w) * (1.f / 256.f) - mu * mu, 0.f);
  const float rstd = rsqrtf(var + 1e-6f);
  bfr* op = (bfr*)(ws + OFF_ORET) + (size_t)row * 2048 + col;
  const u32x4 ov = *(const u32x4*)op;
  const u32x4 gv = *(const u32x4*)(z + (size_t)row * ZS + ZC_GR + col);
  const float4 w0 = *(const float4*)(p.gn_w + col), w1 = *(const float4*)(p.gn_w + col + 4);
  u32x4 res;
  res[0] = pack2((bflo(ov[0]) - mu) * rstd * w0.x * bflo(gv[0]), (bfhi(ov[0]) - mu) * rstd * w0.y * bfhi(gv[0]));
  res[1] = pack2((bflo(ov[1]) - mu) * rstd * w0.z * bflo(gv[1]), (bfhi(ov[1]) - mu) * rstd * w0.w * bfhi(gv[1]));
  res[2] = pack2((bflo(ov[2]) - mu) * rstd * w1.x * bflo(gv[2]), (bfhi(ov[2]) - mu) * rstd * w1.y * bfhi(gv[2]));
  res[3] = pack2((bflo(ov[3]) - mu) * rstd * w1.z * bflo(gv[3]), (bfhi(ov[3]) - mu) * rstd * w1.w * bfhi(gv[3]));
  *(u32x4*)op = res;
}

DI void cmp_item(const Params& p, int item, char* smem, const int tid) {
  bfr* Ks = (bfr*)smem;
  bfr* Vs = Ks + 64 * KP;
  float* impw = (float*)(smem + 2 * 64 * KP * 2);
  const int w = tid >> 6, lane = tid & 63, r = lane & 31, h = lane >> 5;
  char* ws = p.ws;
  const bfr* z = (const bfr*)(ws + OFF_Z);
  const int tb = item >> 4, bg = item & 15, b = bg >> 2, grp = bg & 3;
  const int t0 = tb * 32, tq = t0 + r, head = grp * 4 + w;
  const bfr* qrow = z + (size_t)(b * SEQ + tq) * ZS + ZC_Q + head * 128;
  const bfr* kc = (const bfr*)(ws + OFF_KCVC) + (size_t)((b * 4 + grp) * 128) * 128;
  const bfr* vc = kc + (size_t)2048 * 128;
  bf16x8 qf[8];
#pragma unroll
  for (int s = 0; s < 8; ++s) qf[s] = *(const bf16x8*)(qrow + 16 * s + 8 * h);
  u32x4 reg[8];
#pragma unroll
  for (int i = 0; i < 8; ++i) {
    const int c = tid + 256 * i, row = c >> 4, cc = c & 15;
    reg[i] = *(const u32x4*)(kc + row * 128 + cc * 8);
  }
  __syncthreads();
#pragma unroll
  for (int i = 0; i < 8; ++i) {
    const int c = tid + 256 * i, row = c >> 4, cc = c & 15;
    *(u32x4*)(Ks + row * KP + cc * 8) = reg[i];
  }
  __syncthreads();
  f32x16 s[4];
#pragma unroll
  for (int kt = 0; kt < 4; ++kt) {
#pragma unroll
    for (int i = 0; i < 16; ++i) s[kt][i] = 0.f;
#pragma unroll
    for (int ss = 0; ss < 8; ++ss) {
      const bf16x8 kf = *(const bf16x8*)(Ks + (32 * kt + r) * KP + 16 * ss + 8 * h);
      s[kt] = MFMA(kf, qf[ss], s[kt]);
    }
  }
  const float csc = 0.08838834764831845f * 1.4426950408889634f;
  float mx = -INFINITY;
#pragma unroll
  for (int kt = 0; kt < 4; ++kt)
#pragma unroll
    for (int i = 0; i < 16; ++i) {
      const int c = 32 * kt + crow(i, h);
      const bool ok = (c * 16 + 31 <= tq) && (c < 127);
      s[kt][i] = ok ? s[kt][i] * csc : -INFINITY;
      mx = fmaxf(mx, s[kt][i]);
    }
  mx = fmaxf(mx, __shfl_xor(mx, 32));
  const float muse = (mx == -INFINITY) ? 0.f : mx;
  float ls = 0.f;
#pragma unroll
  for (int kt = 0; kt < 4; ++kt)
#pragma unroll
    for (int i = 0; i < 16; ++i) {
      s[kt][i] = __builtin_amdgcn_exp2f(s[kt][i] - muse);
      ls += s[kt][i];
    }
  ls += __shfl_xor(ls, 32);
  const float inv = (ls > 0.f) ? 1.f / ls : 0.f;
#pragma unroll
  for (int kt = 0; kt < 4; ++kt)
#pragma unroll
    for (int i = 0; i < 16; ++i) s[kt][i] *= inv;
  float plast[16];
#pragma unroll
  for (int kt = 0; kt < 4; ++kt)
#pragma unroll
    for (int g = 0; g < 4; ++g) plast[kt * 4 + g] = __shfl_xor(s[kt][4 * g + 3], 32);
#pragma unroll
  for (int kt = 0; kt < 4; ++kt)
#pragma unroll
    for (int g = 0; g < 4; ++g) {
      const int slot = kt * 4 + g;
      const float sum4 = s[kt][4 * g] + s[kt][4 * g + 1] + s[kt][4 * g + 2] + s[kt][4 * g + 3];
      const float prevl = (slot > 0) ? plast[slot > 0 ? slot - 1 : 0] : 0.f;
      const float add = h ? plast[slot] : prevl;
      impw[(w * 32 + r) * 32 + 8 * kt + 2 * g + h] = sum4 + add;
    }
  bf16x8 pf[4][2];
#pragma unroll
  for (int kt = 0; kt < 4; ++kt) { pf[kt][0] = pack8(s[kt], 0); pf[kt][1] = pack8(s[kt], 1); }
#pragma unroll
  for (int i = 0; i < 8; ++i) {
    const int c = tid + 256 * i, row = c >> 4, cc = c & 15;
    reg[i] = *(const u32x4*)(vc + row * 128 + cc * 8);
  }
  __syncthreads();
#pragma unroll
  for (int i = 0; i < 8; ++i) {
    const int c = tid + 256 * i, row = c >> 4, cc = c & 15;
    *(u32x4*)(Ks + row * KP + cc * 8) = reg[i];
  }
  __syncthreads();
  f32x16 o[4];
#pragma unroll
  for (int dt = 0; dt < 4; ++dt)
#pragma unroll
    for (int i = 0; i < 16; ++i) o[dt][i] = 0.f;
  const int q4 = (lane & 15) >> 2, p4 = lane & 3, blk = (lane >> 4) & 1;
#pragma unroll
  for (int dt = 0; dt < 4; ++dt)
#pragma unroll
    for (int kt = 0; kt < 4; ++kt)
#pragma unroll
      for (int st = 0; st < 2; ++st) {
        const int key0 = 32 * kt + 16 * st + 4 * h;
        const bfr* vp = Ks + (key0 + q4) * KP + 32 * dt + 16 * blk + 4 * p4;
        const s16x4 lo = tr_read(vp);
        const s16x4 hi = tr_read(vp + 8 * KP);
        const bf16x8 vf = __builtin_shufflevector(lo, hi, 0, 1, 2, 3, 4, 5, 6, 7);
        o[dt] = MFMA(vf, pf[kt][st], o[dt]);
      }
  {
    const size_t mrow = (size_t)(b * SEQ + tq);
    const float gate = bflo(z[mrow * ZS + ZC_GN + head * 3 + 0]);
    bfr* orow = (bfr*)(ws + OFF_ONSA) + mrow * 2048 + head * 128;
#pragma unroll
    for (int dt = 0; dt < 4; ++dt)
#pragma unroll
      for (int g = 0; g < 4; ++g) {
        bfr* dst = orow + 32 * dt + 8 * g + 4 * h;
        const uint2 old = *(const uint2*)dst;
        st_bf4(dst, o[dt][4 * g] * gate + bflo(old.x), o[dt][4 * g + 1] * gate + bfhi(old.x),
               o[dt][4 * g + 2] * gate + bflo(old.y), o[dt][4 * g + 3] * gate + bfhi(old.y));
      }
  }
  {
    const int i = tid >> 3, jg = tid & 7;
    const int cur = (t0 + i) >> 6;
    float vm[4];
#pragma unroll
    for (int e = 0; e < 4; ++e) {
      const int jme = 4 * jg + e;
      const float a = impw[(0 * 32 + i) * 32 + jme] + impw[(1 * 32 + i) * 32 + jme] + impw[(2 * 32 + i) * 32 + jme] + impw[(3 * 32 + i) * 32 + jme];
      const bool forced = (jme == 0) || (jme == cur) || (jme == cur - 1);
      vm[e] = forced ? INFINITY : ((jme > cur) ? -INFINITY : a);
    }
#pragma unroll
    for (int e = 0; e < 4; ++e) impw[i * 32 + 4 * jg + e] = vm[e];
    __syncthreads();
    int rank[4] = {0, 0, 0, 0};
#pragma unroll 4
    for (int k = 0; k < 32; ++k) {
      const float vk = impw[i * 32 + k];
#pragma unroll
      for (int e = 0; e < 4; ++e) rank[e] += (vk > vm[e] || (vk == vm[e] && k < 4 * jg + e)) ? 1 : 0;
    }
    unsigned bits = 0;
#pragma unroll
    for (int e = 0; e < 4; ++e)
      if (rank[e] < 16 && 4 * jg + e <= cur) bits |= 1u << (4 * jg + e);
    bits |= (unsigned)__shfl_xor((int)bits, 1);
    bits |= (unsigned)__shfl_xor((int)bits, 2);
    bits |= (unsigned)__shfl_xor((int)bits, 4);
    if (jg == 0) ((unsigned*)(ws + OFF_SELM))[(b * 4 + grp) * SEQ + t0 + i] = bits;
  }
  __syncthreads();
}

DI int grab(unsigned* ctr, int* slot, const int tid) {
  __syncthreads();
  if (tid == 0) *slot = (int)atomicAdd(ctr, 1u);
  __syncthreads();
  return *slot;
}

DI void run_phase(const Params& p0, int ph, char* smem, int* slot, const int wave_s) {
  char* ws = p0.ws;
  asm volatile("" : "+s"(ws));
  Params p = p0;
  p.ws = ws;
  const int G = gridDim.x;
  int bid = blockIdx.x;
  int tid = wave_s * 64 + (int)__builtin_amdgcn_mbcnt_hi(~0u, __builtin_amdgcn_mbcnt_lo(~0u, 0u));
  asm volatile("" : "+s"(bid));
  asm volatile("" : "+v"(tid));
  bfr* z = (bfr*)(ws + OFF_Z);
  unsigned* ctr = (unsigned*)(ws + OFF_CTR);
  switch (ph) {
    case 0: {
      if (bid == 0 && tid < 64) ctr[tid] = 0u;
      int tot = 0;
      for (int j = 0; j < 12; ++j) tot += tjob_tiles(j);
      const int n_norm = 2048 + 256, n_rope = 512;
      for (int it = bid; it < tot + n_norm + n_rope; it += G) {
        if (it < tot) {
          int j = 0, rem = it;
          while (rem >= tjob_tiles(j)) { rem -= tjob_tiles(j); ++j; }
          const TJob t = get_tjob(p, j);
          transpose_tile(t, rem, (float*)smem, tid);
        } else if (it < tot + n_norm) {
          const int row = (it - tot) * 4 + (tid >> 6);
          if (row < NTOK) rmsnorm_row(p.x + (size_t)row * 2048, p.attn_norm_w, (bfr*)(ws + OFF_N) + (size_t)row * 2048, nullptr, tid);
          else rmsnorm_row(p.mem + (size_t)(row - NTOK) * 2048, p.mem_norm_w, (bfr*)(ws + OFF_MN) + (size_t)(row - NTOK) * 2048, nullptr, tid);
        } else {
          const int e = (it - tot - n_norm) * 256 + tid;
          const int t = e >> 6, i = e & 63;
          const float ang = (float)t * ROPE_INV[i];
          const float kk = rintf(ang * 0.15915494309189535f);
          float rr = fmaf(-kk, 6.2831854820251465f, ang);
          rr = fmaf(-kk, -1.7484555e-7f, rr);
          const float fr = rr * 0.15915494309189535f;
          ((float2*)(ws + OFF_ROPE))[e] = make_float2(__builtin_amdgcn_cosf(fr), __builtin_amdgcn_sinf(fr));
        }
      }
    } break;
    case 1: {
      const int nt_main = 32 * 121;
      for (int v = bid; v < nt_main + 32; v += G) {
        f32x16 acc[2][4];
        acc_zero(acc);
        if (v < nt_main) {
          int mt, nt;
          map_tile32(v, mt, nt);
          const int m0 = mt * 256, n0 = nt * 128;
          PlainPtr af{(const bfr*)(ws + OFF_N) + (size_t)m0 * 2048, 2048};
          PlainPtr bf{(const bfr*)(ws + OFF_WINT) + (size_t)n0 * 2048, 2048};
          gemm_main(acc, af, bf, 64, smem, tid);
          bfr* zcb = (bfr*)(ws + OFF_ZC);
          const float2* rope = (const float2*)(ws + OFF_ROPE);
          gemm_epi(acc, m0, n0, tid, [&](int m, int n, float a, float b, float c, float d) {
            bfr* dst = z + (size_t)m * ZS + n;
            const int t = m & 2047;
            if (n >= ZC_KC && n < ZC_KS) {
              const float* pe = (n < ZC_VC) ? p.pe_k : p.pe_v;
              const int dd = n & 127;
              const float4 plo = *(const float4*)(pe + (t & 15) * 128 + dd);
              const float4 phi = *(const float4*)(pe + (16 + (t & 15)) * 128 + dd);
              st_bf4(zcb + (size_t)m * 2048 + (n - ZC_KC), a + plo.x, b + plo.y, c + plo.z, d + plo.w);
              st_bf4(zcb + (size_t)m * 2048 + 1024 + (n - ZC_KC), a + phi.x, b + phi.y, c + phi.z, d + phi.w);
            } else if (n >= ZC_QR && n < ZC_VR) {
              const int i0 = (n & 127) >> 1;
              const float2 c0 = rope[t * 64 + i0], c1 = rope[t * 64 + i0 + 1];
              float o0 = a * c0.x - b * c0.y, o1 = a * c0.y + b * c0.x;
              float o2 = c * c1.x - d * c1.y, o3 = c * c1.y + d * c1.x;
              if (n >= ZC_KR) { const float sc = 0.08838834764831845f; o0 *= sc; o1 *= sc; o2 *= sc; o3 *= sc; }
              st_bf4(dst, o0, o1, o2, o3);
            } else if (n >= ZC_GR && n < ZC_GA) {
              st_bf4(dst, a * sigmoidf_(a), b * sigmoidf_(b), c * sigmoidf_(c), d * sigmoidf_(d));
            } else if (n >= ZC_GA) {
              st_bf4(dst, sigmoidf_(a), sigmoidf_(b), sigmoidf_(c), sigmoidf_(d));
            } else {
              st_bf4(dst, a, b, c, d);
            }
          });
        } else {
          const int u = v - nt_main, which = u >> 4, mt = (u & 15) >> 2, nt = u & 3;
          const int m0 = mt * 256, n0 = nt * 128;
          PlainPtr af{(const bfr*)(ws + OFF_MN) + (size_t)m0 * 2048, 2048};
          PlainPtr bf{(const bfr*)(ws + (which ? OFF_WVT : OFF_WKT)) + (size_t)n0 * 2048, 2048};
          gemm_main(acc, af, bf, 64, smem, tid);
          bfr* dstb = (bfr*)(ws + (which ? OFF_VX : OFF_KX));
          gemm_epi(acc, m0, n0, tid, [&](int m, int n, float a, float b, float c, float d) { st_bf4(dstb + (size_t)m * 512 + n, a, b, c, d); });
        }
      }
    } break;
    case 2: {
      for (int it = grab(ctr + 0, slot, tid); it < 128; it = grab(ctr + 0, slot, tid)) {
          const int which = it >> 6, mt = (it & 63) >> 3, nt = it & 7;
          const int m0 = mt * 256, n0 = nt * 128;
          f32x16 acc[2][4];
          acc_zero(acc);
          struct GatherA {
            const bfr* base; int m0;
            DI int rowoff(int row) const {
              const int R = m0 + row;
              const int bb = R >> 9, g = (R >> 7) & 3;
              int c = R & 127; c = c > 126 ? 126 : c;
              return (bb * SEQ + c * 16) * 2048 + g * 128;
            }
            DI int koff(int kk) const { const int l = kk >> 7; return l * 2048 + ((l >> 4) << 10) + (kk & 127); }
          };
          GatherA af{(const bfr*)(ws + OFF_ZC) + which * 512, m0};
          PlainPtr bf{(const bfr*)(ws + OFF_W1T) + (size_t)which * 1024 * 4096 + (size_t)n0 * 4096, 4096};
          gemm_main(acc, af, bf, 128, smem, tid);
          bfr* hid = (bfr*)(ws + OFF_HIDC) + (size_t)which * 2048 * 1024;
          gemm_epi(acc, m0, n0, tid, [&](int m, int n, float a, float b, float c, float d) {
            st_bf4(hid + (size_t)m * 1024 + n, a * sigmoidf_(a), b * sigmoidf_(b), c * sigmoidf_(c), d * sigmoidf_(d));
          });
      }
      for (int it = grab(ctr + 1, slot, tid); it < 2048; it = grab(ctr + 1, slot, tid)) {
        if (it < 1024) attn_item<MODE_RET>(p, it, smem, tid);
        else attn_item<MODE_WIN>(p, it - 1024, smem, tid);
      }
    } break;
    case 3: {
      for (int it = bid; it < 16 + NTOK; it += G) {
        if (it >= 16) { ret_finish_row(p, it - 16, tid); continue; }
        const int which = it >> 3, mt = it & 7;
        const int m0 = mt * 256;
        f32x16 acc[2][4];
        acc_zero(acc);
        PlainPtr af{(const bfr*)(ws + OFF_HIDC) + (size_t)which * 2048 * 1024 + (size_t)m0 * 1024, 1024};
        PlainPtr bf{(const bfr*)(ws + OFF_W2T) + (size_t)which * 128 * 1024, 1024};
        gemm_main(acc, af, bf, 32, smem, tid);
        bfr* dstb = (bfr*)(ws + OFF_KCVC) + (size_t)which * 2048 * 128;
        gemm_epi(acc, m0, 0, tid, [&](int m, int n, float a, float b, float c, float d) { st_bf4(dstb + (size_t)m * 128 + n, a, b, c, d); });
      }
    } break;
    case 4: {
      for (int it = bid; it < 1024; it += G) cmp_item(p, it, smem, tid);
    } break;
    case 5: {
      for (int it = grab(ctr + 2, slot, tid); it < 1024; it = grab(ctr + 2, slot, tid)) attn_item<MODE_SEL>(p, it, smem, tid);
    } break;
    case 6: {
      for (int v = bid; v < 32 * 16; v += G) {
        int mt, nt;
        map_tile32(v, mt, nt);
        const int m0 = mt * 256, n0 = nt * 128;
        f32x16 acc[2][4];
        acc_zero(acc);
        bfr* mg = (bfr*)(ws + OFF_MERGED);
        {
          PlainPtr af{(const bfr*)(ws + OFF_ONSA) + (size_t)m0 * 2048, 2048};
          PlainPtr bf{(const bfr*)(ws + OFF_WAT) + (size_t)n0 * 2048, 2048};
          gemm_main(acc, af, bf, 64, smem, tid);
          gemm_epi(acc, m0, n0, tid, [&](int m, int n, float a, float b, float c, float d) {
            const uint2 ga = *(const uint2*)(z + (size_t)m * ZS + ZC_GA + n);
            st_bf4(mg + (size_t)m * 2048 + n, bflo(ga.x) * a, bfhi(ga.x) * b, bflo(ga.y) * c, bfhi(ga.y) * d);
          });
        }
        acc_zero(acc);
        {
          PlainPtr af{(const bfr*)(ws + OFF_ORET) + (size_t)m0 * 2048, 2048};
          PlainPtr bf{(const bfr*)(ws + OFF_WBT) + (size_t)n0 * 2048, 2048};
          gemm_main(acc, af, bf, 64, smem, tid);
          gemm_epi(acc, m0, n0, tid, [&](int m, int n, float a, float b, float c, float d) {
            const uint2 gb = *(const uint2*)(z + (size_t)m * ZS + ZC_GB + n);
            bfr* dst = mg + (size_t)m * 2048 + n;
            const uint2 old = *(const uint2*)dst;
            st_bf4(dst, bflo(old.x) + bflo(gb.x) * a, bfhi(old.x) + bfhi(gb.x) * b, bflo(old.y) + bflo(gb.y) * c, bfhi(old.y) + bfhi(gb.y) * d);
          });
        }
      }
    } break;
    case 7: {
      for (int v = bid; v < 32 * 16; v += G) {
        int mt, nt;
        map_tile32(v, mt, nt);
        const int m0 = mt * 256, n0 = nt * 128;
        f32x16 acc[2][4];
        acc_zero(acc);
        PlainPtr af{(const bfr*)(ws + OFF_MERGED) + (size_t)m0 * 2048, 2048};
        PlainPtr bf{(const bfr*)(ws + OFF_WOUTT) + (size_t)n0 * 2048, 2048};
        gemm_main(acc, af, bf, 64, smem, tid);
        float* hbuf = (float*)(ws + OFF_H);
        gemm_epi(acc, m0, n0, tid, [&](int m, int n, float a, float b, float c, float d) {
          const float4 xv = *(const float4*)(p.x + (size_t)m * 2048 + n);
          *(float4*)(hbuf + (size_t)m * 2048 + n) = make_float4(xv.x + a, xv.y + b, xv.z + c, xv.w + d);
        });
      }
    } break;
    case 8: case 12: {
      const float* w = (ph == 8) ? p.x_norm_w : p.mlp_norm_w;
      const int n_tr = (ph == 8) ? (tjob_tiles(12) + tjob_tiles(13)) : 0;
      for (int it = bid; it < 2048 + n_tr; it += G) {
        if (it < 2048) {
          const int row = it * 4 + (tid >> 6);
          rmsnorm_row((const float*)(ws + OFF_H) + (size_t)row * 2048, w, (bfr*)(ws + OFF_NX) + (size_t)row * 2048, nullptr, tid);
        } else {
          int rem = it - 2048, j = 12;
          if (rem >= tjob_tiles(12)) { rem -= tjob_tiles(12); j = 13; }
          const TJob t = get_tjob(p, j);
          transpose_tile(t, rem, (float*)smem, tid);
        }
      }
    } break;
    case 9: {
      for (int v = bid; v < 32 * 4; v += G) {
        int mt, nt;
        map_tile32(v, mt, nt);
        const int m0 = mt * 256, n0 = nt * 128;
        f32x16 acc[2][4];
        acc_zero(acc);
        PlainPtr af{(const bfr*)(ws + OFF_NX) + (size_t)m0 * 2048, 2048};
        PlainPtr bf{(const bfr*)(ws + OFF_WQT) + (size_t)n0 * 2048, 2048};
        gemm_main(acc, af, bf, 64, smem, tid);
        bfr* qx = (bfr*)(ws + OFF_QX);
        gemm_epi(acc, m0, n0, tid, [&](int m, int n, float a, float b, float c, float d) { st_bf4(qx + (size_t)m * 512 + n, a, b, c, d); });
      }
    } break;
    case 10: {
      for (int it = bid; it < 256; it += G) attn_item<MODE_X>(p, it, smem, tid);
    } break;
    case 11: {
      for (int v = bid; v < 32 * 16; v += G) {
        int mt, nt;
        map_tile32(v, mt, nt);
        const int m0 = mt * 256, n0 = nt * 128;
        f32x16 acc[2][4];
        acc_zero(acc);
        PlainPtr af{(const bfr*)(ws + OFF_OX) + (size_t)m0 * 512, 512};
        PlainPtr bf{(const bfr*)(ws + OFF_WOT) + (size_t)n0 * 512, 512};
        gemm_main(acc, af, bf, 16, smem, tid);
        float* hbuf = (float*)(ws + OFF_H);
        gemm_epi(acc, m0, n0, tid, [&](int m, int n, float a, float b, float c, float d) {
          float4* hp = (float4*)(hbuf + (size_t)m * 2048 + n);
          const float4 xv = *hp;
          *hp = make_float4(xv.x + a, xv.y + b, xv.z + c, xv.w + d);
        });
      }
    } break;
    case 13: {
      for (int v = bid; v < 32 * 64; v += G) {
        int mt, nt;
        map_tile32(v, mt, nt);
        const int m0 = mt * 256, n0 = nt * 128;
        f32x16 acc[2][4];
        acc_zero(acc);
        PlainPtr af{(const bfr*)(ws + OFF_NX) + (size_t)m0 * 2048, 2048};
        PlainPtr bf{(const bfr*)(ws + OFF_WUPT) + (size_t)n0 * 2048, 2048};
        gemm_main(acc, af, bf, 64, smem, tid);
        bfr* hid = (bfr*)(ws + OFF_HID);
        gemm_epi(acc, m0, n0, tid, [&](int m, int n, float a, float b, float c, float d) {
          a = fmaxf(a, 0.f); b = fmaxf(b, 0.f); c = fmaxf(c, 0.f); d = fmaxf(d, 0.f);
          st_bf4(hid + (size_t)m * 8192 + n, a * a, b * b, c * c, d * d);
        });
      }
    } break;
    case 14: {
      for (int v = bid; v < 32 * 16; v += G) {
        int mt, nt;
        map_tile32(v, mt, nt);
        const int m0 = mt * 256, n0 = nt * 128;
        f32x16 acc[2][4];
        acc_zero(acc);
        PlainPtr af{(const bfr*)(ws + OFF_HID) + (size_t)m0 * 8192, 8192};
        PlainPtr bf{(const bfr*)(ws + OFF_WDOWNT) + (size_t)n0 * 8192, 8192};
        gemm_main(acc, af, bf, 256, smem, tid);
        const float* hbuf = (const float*)(ws + OFF_H);
        gemm_epi(acc, m0, n0, tid, [&](int m, int n, float a, float b, float c, float d) {
          const float4 xv = *(const float4*)(hbuf + (size_t)m * 2048 + n);
          *(float4*)(p.out + (size_t)m * 2048 + n) = make_float4(xv.x + a, xv.y + b, xv.z + c, xv.w + d);
        });
      }
    } break;
    case 15: {
      for (int it = bid; it < 2048; it += G) {
        const int row = it * 4 + (tid >> 6);
        rmsnorm_row(p.out + (size_t)row * 2048, p.final_norm_w, nullptr, p.out + (size_t)row * 2048, tid);
      }
    } break;
    default: break;
  }
}

__global__ void __launch_bounds__(256, 2) mega(Params p) {
  __shared__ __attribute__((aligned(16))) char smem[SMEM_BYTES];
  __shared__ int slot;
  cg::grid_group grid = cg::this_grid();
  const int wave_s = __builtin_amdgcn_readfirstlane((int)(threadIdx.x >> 6));
  for (int ph = p.ph_lo; ph < p.ph_hi; ++ph) {
    run_phase(p, ph, smem, &slot, wave_s);
    if (ph + 1 < p.ph_hi) grid.sync();
  }
}

extern "C" void kernel_launch(void* const* d_in, const int* in_sizes, int n_in, void* d_out, int out_size, void* d_ws,
                              size_t ws_size, hipStream_t stream) {
  static int grid_blocks = 0;
  if (!grid_blocks) {
    int dev = 0, cus = 0, per_cu = 0;
    hipGetDevice(&dev);
    hipDeviceGetAttribute(&cus, hipDeviceAttributeMultiprocessorCount, dev);
    hipOccupancyMaxActiveBlocksPerMultiprocessor(&per_cu, mega, 256, 0);
    if (per_cu < 1) per_cu = 1;
    if (per_cu > 2) per_cu = 2;
    grid_blocks = cus * per_cu;
    grid_blocks &= ~7;
    if (ws_size < WS_END || n_in != 24) { fprintf(stderr, "kernel_launch: ws %zu < %zu or n_in %d\n", ws_size, (size_t)WS_END, n_in); grid_blocks = -1; }
  }
  if (grid_blocks < 0) return;
  Params p{};
  const float** pp = (const float**)&p;
  for (int i = 0; i < 24; ++i) pp[i] = (const float*)d_in[i];
  p.out = (float*)d_out;
  p.ws = (char*)d_ws;
#if ONE_LAUNCH
  p.ph_lo = 0; p.ph_hi = NPHASE;
  void* args[] = {&p};
  hipError_t e = hipLaunchCooperativeKernel((void*)mega, dim3(grid_blocks), dim3(256), args, 0, stream);
  if (e != hipSuccess) fprintf(stderr, "cooperative launch failed: %s (grid %d)\n", hipGetErrorString(e), grid_blocks);
#else
  for (int ph = 0; ph < NPHASE; ++ph) {
    p.ph_lo = ph; p.ph_hi = ph + 1;
    hipLaunchKernelGGL(mega, dim3(grid_blocks), dim3(256), 0, stream, p);
  }
#endif
}
```

```cpp
#include <hip/hip_runtime.h>
#include <hip/hip_cooperative_groups.h>
#include <cstdio>
namespace cg = cooperative_groups;

#ifndef ONE_LAUNCH
#define ONE_LAUNCH 1
#endif

#define DI __device__ __forceinline__
typedef unsigned short bfr;
using bf16x8 = __attribute__((ext_vector_type(8))) short;
using s16x4 = __attribute__((ext_vector_type(4))) short;
using f32x16 = __attribute__((ext_vector_type(16))) float;
using u32x4 = __attribute__((ext_vector_type(4))) unsigned;
#define MFMA(a, b, c) __builtin_amdgcn_mfma_f32_32x32x16_bf16((a), (b), (c), 0, 0, 0)

constexpr int DM = 2048, SEQ = 2048, NTOK = 8192;
constexpr int ZS = 15488;
constexpr int ZC_Q = 0, ZC_KC = 2048, ZC_VC = 2560, ZC_KS = 3072, ZC_VS = 3584, ZC_KW = 4096, ZC_VW = 4608,
              ZC_QR = 5120, ZC_KR = 6144, ZC_VR = 7168, ZC_GR = 9216, ZC_GA = 11264, ZC_GB = 13312, ZC_GN = 15360;
constexpr int NPHASE = 16;

constexpr int ZSP = 15616;
constexpr size_t SZ_WINT = (size_t)ZSP * 2048 * 2;
constexpr size_t SZ_ACT = (size_t)NTOK * 2048 * 2;
constexpr size_t OFF_WINT = 0;
constexpr size_t OFF_N = OFF_WINT + SZ_WINT;
constexpr size_t OFF_MERGED = OFF_WINT;
constexpr size_t OFF_ORET = OFF_N;
constexpr size_t OFF_WUPT = 0;
constexpr size_t OFF_WDOWNT = SZ_ACT;
constexpr size_t OFF_Z = OFF_N + SZ_ACT;
constexpr size_t SZ_Z = (size_t)NTOK * ZS * 2;
constexpr size_t OFF_HID = OFF_Z;
constexpr size_t OFF_H = OFF_Z + (size_t)NTOK * 8192 * 2;
constexpr size_t OFF_NX = OFF_H + (size_t)NTOK * 2048 * 4;
constexpr size_t OFF_QX = OFF_NX + SZ_ACT;
constexpr size_t OFF_OX = OFF_QX + (size_t)NTOK * 512 * 2;
static_assert(OFF_OX + (size_t)NTOK * 512 * 2 <= OFF_Z + SZ_Z, "alias overflow");
constexpr size_t OFF_ZC = OFF_Z + SZ_Z;
constexpr size_t OFF_MN = OFF_ZC + (size_t)NTOK * 2048 * 2;
constexpr size_t OFF_W1T = OFF_MN + (size_t)1024 * 2048 * 2;
constexpr size_t OFF_W2T = OFF_W1T + (size_t)2 * 1024 * 4096 * 2;
constexpr size_t OFF_WAT = OFF_W2T + (size_t)2 * 128 * 1024 * 2;
constexpr size_t OFF_WBT = OFF_WAT + (size_t)2048 * 2048 * 2;
constexpr size_t OFF_WOUTT = OFF_WBT + (size_t)2048 * 2048 * 2;
constexpr size_t OFF_WQT = OFF_WOUTT + (size_t)2048 * 2048 * 2;
constexpr size_t OFF_WKT = OFF_WQT + (size_t)512 * 2048 * 2;
constexpr size_t OFF_WVT = OFF_WKT + (size_t)512 * 2048 * 2;
constexpr size_t OFF_WOT = OFF_WVT + (size_t)512 * 2048 * 2;
constexpr size_t OFF_ROPE = OFF_WOT + (size_t)512 * 2048 * 2;
constexpr size_t OFF_HIDC = OFF_ROPE + (size_t)2048 * 64 * 8;
constexpr size_t OFF_KCVC = OFF_HIDC + (size_t)2 * 2048 * 1024 * 2;
constexpr size_t OFF_SELM = OFF_KCVC + (size_t)2 * 2048 * 128 * 2;
constexpr size_t OFF_ONSA = OFF_SELM + (size_t)16 * 2048 * 4;
constexpr size_t OFF_KX = OFF_ONSA + SZ_ACT;
constexpr size_t OFF_VX = OFF_KX + (size_t)1024 * 512 * 2;
constexpr size_t OFF_RSTAT = OFF_VX + (size_t)1024 * 512 * 2;
constexpr size_t OFF_CTR = OFF_RSTAT + (size_t)NTOK * 8 * 2 * 2 * 4;
constexpr size_t WS_END = OFF_CTR + 256;

struct Params {
  const float *x, *mem, *attn_norm_w, *w_in, *pe_k, *w1k, *w2k, *pe_v, *w1v, *w2v, *w_a, *gn_w, *w_b, *w_out, *x_norm_w,
      *mem_norm_w, *wq, *wk, *wv, *wo, *mlp_norm_w, *w_up, *w_down, *final_norm_w;
  float* out;
  char* ws;
  int ph_lo, ph_hi;
};

constexpr int NTHR = 512;
constexpr int SMEM_BYTES = 131072;
__device__ const float ROPE_INV[64] = {1.0f, 0.865964353f, 0.749894261f, 0.649381638f, 0.562341332f, 0.486967534f, 0.421696514f, 0.365174115f, 0.316227764f, 0.273841977f, 0.237137377f, 0.2053525f, 0.177827939f, 0.153992653f, 0.133352131f, 0.115478203f, 0.100000001f, 0.0865964293f, 0.0749894157f, 0.0649381652f, 0.0562341325f, 0.0486967526f, 0.0421696529f, 0.0365174115f, 0.0316227749f, 0.0273841973f, 0.0237137377f, 0.0205352511f, 0.0177827943f, 0.0153992651f, 0.0133352149f, 0.0115478206f, 0.00999999978f, 0.00865964312f, 0.00749894185f, 0.00649381615f, 0.00562341325f, 0.00486967526f, 0.00421696482f, 0.00365174119f, 0.00316227763f, 0.00273841969f, 0.00237137359f, 0.00205352483f, 0.00177827943f, 0.00153992651f, 0.00133352145f, 0.0011547819f, 0.00100000005f, 0.000865964335f, 0.000749894243f, 0.000649381662f, 0.000562341302f, 0.000486967532f, 0.000421696517f, 0.000365174143f, 0.000316227757f, 0.000273841957f, 0.00023713737f, 0.00020535251f, 0.00017782794f, 0.000153992645f, 0.00013335215f, 0.0001154782f};

DI unsigned pack2(float a, float b) {
  typedef float f2 __attribute__((ext_vector_type(2)));
  typedef __bf16 b2 __attribute__((ext_vector_type(2)));
  f2 v = {a, b};
  b2 r = __builtin_convertvector(v, b2);
  return __builtin_bit_cast(unsigned, r);
}
DI float bflo(unsigned u) { return __uint_as_float(u << 16); }
DI float bfhi(unsigned u) { return __uint_as_float(u & 0xffff0000u); }
DI void st_bf4(bfr* p, float a, float b, float c, float d) {
  uint2 v; v.x = pack2(a, b); v.y = pack2(c, d);
  *(uint2*)p = v;
}
DI float wave_sum(float v) {
#pragma unroll
  for (int o = 32; o > 0; o >>= 1) v += __shfl_xor(v, o);
  return v;
}
DI float sigmoidf_(float x) { return 1.f / (1.f + __expf(-x)); }
DI int crow(int i, int h) { return (i & 3) + 8 * (i >> 2) + 4 * h; }
DI bf16x8 pack8(const f32x16& x, int s) {
  unsigned a = pack2(x[8 * s], x[8 * s + 1]), b = pack2(x[8 * s + 2], x[8 * s + 3]), c = pack2(x[8 * s + 4], x[8 * s + 5]),
           d = pack2(x[8 * s + 6], x[8 * s + 7]);
  typedef unsigned u4 __attribute__((ext_vector_type(4)));
  u4 v = {a, b, c, d};
  return __builtin_bit_cast(bf16x8, v);
}
DI s16x4 tr_read(const bfr* p) {
  return __builtin_amdgcn_ds_read_tr16_b64_v4i16((__attribute__((address_space(3))) s16x4*)(p));
}

struct TJob { const float* src; bfr* dst; int K, N, ntn, perm; };
DI TJob get_tjob(const Params& p, int j) {
  TJob t;
  char* ws = p.ws;
  switch (j) {
    case 0: t = {p.w_in, (bfr*)(ws + OFF_WINT), 2048, 15408, 244, 1}; break;
    case 1: t = {p.w1k, (bfr*)(ws + OFF_W1T), 4096, 1024, 16, 0}; break;
    case 2: t = {p.w1v, (bfr*)(ws + OFF_W1T) + (size_t)1024 * 4096, 4096, 1024, 16, 0}; break;
    case 3: t = {p.w2k, (bfr*)(ws + OFF_W2T), 1024, 128, 2, 0}; break;
    case 4: t = {p.w2v, (bfr*)(ws + OFF_W2T) + (size_t)128 * 1024, 1024, 128, 2, 0}; break;
    case 5: t = {p.w_a, (bfr*)(ws + OFF_WAT), 2048, 2048, 32, 0}; break;
    case 6: t = {p.w_b, (bfr*)(ws + OFF_WBT), 2048, 2048, 32, 0}; break;
    case 7: t = {p.w_out, (bfr*)(ws + OFF_WOUTT), 2048, 2048, 32, 0}; break;
    case 8: t = {p.wq, (bfr*)(ws + OFF_WQT), 2048, 512, 8, 0}; break;
    case 9: t = {p.wk, (bfr*)(ws + OFF_WKT), 2048, 512, 8, 0}; break;
    case 10: t = {p.wv, (bfr*)(ws + OFF_WVT), 2048, 512, 8, 0}; break;
    case 11: t = {p.wo, (bfr*)(ws + OFF_WOT), 512, 2048, 32, 0}; break;
    case 12: t = {p.w_up, (bfr*)(ws + OFF_WUPT), 2048, 8192, 128, 0}; break;
    default: t = {p.w_down, (bfr*)(ws + OFF_WDOWNT), 8192, 2048, 32, 0}; break;
  }
  return t;
}
DI int tjob_tiles(int j) {
  switch (j) {
    case 0: return 244 * 16;
    case 1: case 2: return 16 * 32;
    case 3: case 4: return 2 * 8;
    case 5: case 6: case 7: return 32 * 16;
    case 8: case 9: case 10: return 8 * 16;
    case 11: return 32 * 4;
    case 12: return 128 * 16;
    default: return 32 * 64;
  }
}
DI void transpose_tile(const TJob& t, int tile, float* sm, const int tid) {
  const int nkt = t.K >> 7;
  const int kt = tile % nkt, nt = tile / nkt;
  const int k0 = kt * 128, d0 = nt * 64;
  int scol0 = d0, nvalid = 64;
  if (t.perm) {
    if (d0 < 5120) scol0 = d0;
    else if (d0 < 15360) scol0 = d0 + 48;
    else { scol0 = d0 - 15360 + 5120; nvalid = (d0 == 15360) ? 48 : 0; }
  }
#pragma unroll
  for (int i = 0; i < 4; ++i) {
    const int row = i * 32 + (tid >> 4), col = (tid & 15) * 4;
    float4 v = make_float4(0.f, 0.f, 0.f, 0.f);
    if (col < nvalid) v = *(const float4*)(t.src + (size_t)(k0 + row) * t.N + scol0 + col);
    float* d = sm + row * 65 + col;
    d[0] = v.x; d[1] = v.y; d[2] = v.z; d[3] = v.w;
  }
  __syncthreads();
  const int n = tid >> 3, ks = (tid & 7) * 16;
  unsigned o[8];
#pragma unroll
  for (int j = 0; j < 8; ++j) o[j] = pack2(sm[(ks + 2 * j) * 65 + n], sm[(ks + 2 * j + 1) * 65 + n]);
  uint4* d = (uint4*)(t.dst + (size_t)(d0 + n) * t.K + k0 + ks);
  d[0] = make_uint4(o[0], o[1], o[2], o[3]);
  d[1] = make_uint4(o[4], o[5], o[6], o[7]);
  __syncthreads();
}

DI void rmsnorm_row(const float* xrow, const float* w, bfr* obf, float* of32, const int tid) {
  const int lane = tid & 63;
  float4 v[8];
  float ss = 0.f;
#pragma unroll
  for (int i = 0; i < 8; ++i) {
    v[i] = ((const float4*)xrow)[lane + 64 * i];
    ss += v[i].x * v[i].x + v[i].y * v[i].y + v[i].z * v[i].z + v[i].w * v[i].w;
  }
  ss = wave_sum(ss);
  const float rs = rsqrtf(ss * (1.f / 2048.f) + 1e-6f);
#pragma unroll
  for (int i = 0; i < 8; ++i) {
    const float4 ww = ((const float4*)w)[lane + 64 * i];
    const float a = v[i].x * rs * ww.x, b = v[i].y * rs * ww.y, c = v[i].z * rs * ww.z, d = v[i].w * rs * ww.w;
    if (obf) st_bf4(obf + (lane + 64 * i) * 4, a, b, c, d);
    else ((float4*)of32)[lane + 64 * i] = make_float4(a, b, c, d);
  }
}

struct PlainPtr {
  const bfr* base; int ld;
  DI int rowoff(int row) const { return row * ld; }
  DI int koff(int k0) const { return k0; }
};
#define WAIT_V(n) asm volatile("s_waitcnt vmcnt(%0)" ::"n"(n) : "memory")
#define WAIT_L(n) asm volatile("s_waitcnt lgkmcnt(%0)" ::"n"(n) : "memory")
#define RAW_BARRIER() do { WAIT_L(0); __builtin_amdgcn_s_barrier(); } while (0)
typedef __attribute__((address_space(3))) unsigned lds_u32;
constexpr int STAGE_B = 32768;
template <int NI, class AF, class BF>
DI void gemm_main(f32x16 (&acc)[NI][4], const AF& af, const BF& bf, int nk, char* smem, const int tid) {
  const int lane = tid & 63, r = lane & 31, h = lane >> 5;
  const int w = __builtin_amdgcn_readfirstlane(tid >> 6);
  const int wm = w & 1, wn = w >> 1;
  int ao[2], bo[NI];
  {
    const int rl = lane >> 2, kc = (lane & 3) ^ ((lane >> 4) & 3);
#pragma unroll
    for (int i = 0; i < 2; ++i) ao[i] = af.rowoff((w + 8 * i) * 16 + rl) + 8 * kc;
#pragma unroll
    for (int i = 0; i < NI; ++i) bo[i] = bf.rowoff((w + 8 * i) * 16 + rl) + 8 * kc;
  }
  auto stage = [&](int buf, int kt) {
    const int ka = af.koff(kt * 32), kb = bf.koff(kt * 32);
    char* sbase = smem + buf * STAGE_B + w * 1024;
#pragma unroll
    for (int i = 0; i < 2; ++i)
      __builtin_amdgcn_global_load_lds((const unsigned*)(af.base + (ao[i] + ka)), (lds_u32*)(sbase + i * 8192), 16, 0, 0);
#pragma unroll
    for (int i = 0; i < NI; ++i)
      __builtin_amdgcn_global_load_lds((const unsigned*)(bf.base + (bo[i] + kb)), (lds_u32*)(sbase + 16384 + i * 8192), 16, 0, 0);
  };
  constexpr int LPS = 2 + NI;
  const int xr = (r >> 2) & 3;
  const int off0 = (h ^ xr) * 16, off1 = off0 ^ 32;
  const int arow = (wm * 128 + r) * 64, brow = 16384 + (wn * 32 * NI + r) * 64;
  WAIT_V(0);
  __syncthreads();
  stage(0, 0);
  if (nk > 1) stage(1, 1);
  if (nk > 2) stage(2, 2);
  if (nk > 2) { WAIT_V(2 * LPS); } else { WAIT_V(0); }
  RAW_BARRIER();
#pragma unroll 1
  for (int kt = 0; kt < nk; ++kt) {
    const int cur = kt & 3;
    if (kt + 3 < nk) stage((kt + 3) & 3, kt + 3);
    const char* sb = smem + cur * STAGE_B;
#pragma unroll
    for (int ks = 0; ks < 2; ++ks) {
      const int off = ks ? off1 : off0;
      bf16x8 wf[NI], xf[4];
#pragma unroll
      for (int i = 0; i < NI; ++i) wf[i] = *(const bf16x8*)(sb + brow + i * 2048 + off);
#pragma unroll
      for (int i = 0; i < 4; ++i) xf[i] = *(const bf16x8*)(sb + arow + i * 2048 + off);
#pragma unroll
      for (int mi = 0; mi < 4; ++mi)
#pragma unroll
        for (int ni = 0; ni < NI; ++ni) acc[ni][mi] = MFMA(wf[ni], xf[mi], acc[ni][mi]);
    }
    if (kt + 3 < nk) { WAIT_V(2 * LPS); } else { WAIT_V(0); }
    RAW_BARRIER();
  }
}
template <int NI>
DI void acc_zero(f32x16 (&acc)[NI][4]) {
#pragma unroll
  for (int a = 0; a < NI; ++a)
#pragma unroll
    for (int b = 0; b < 4; ++b)
#pragma unroll
      for (int i = 0; i < 16; ++i) acc[a][b][i] = 0.f;
}
template <int NI, class EPI>
DI void gemm_epi(const f32x16 (&acc)[NI][4], int m0, int n0, const int tid_in, const EPI& epi) {
  int tid = tid_in;
  asm volatile("" : "+v"(tid));
  const int lane = tid & 63, w = tid >> 6, r = lane & 31, h = lane >> 5;
  const int wm = w & 1, wn = w >> 1;
#pragma unroll
  for (int mi = 0; mi < 4; ++mi)
#pragma unroll
    for (int ni = 0; ni < NI; ++ni)
#pragma unroll
      for (int g = 0; g < 4; ++g) {
        const int n = n0 + wn * 32 * NI + ni * 32 + 8 * g + 4 * h;
        const int m = m0 + wm * 128 + mi * 32 + r;
        epi(m, n, acc[ni][mi][4 * g], acc[ni][mi][4 * g + 1], acc[ni][mi][4 * g + 2], acc[ni][mi][4 * g + 3]);
      }
}
DI void map_tile32(int v, int& mt, int& nt) {
  const int xcd = v & 7, j = v >> 3;
  nt = j >> 2;
  mt = xcd * 4 + (j & 3);
}

enum { MODE_WIN = 0, MODE_SEL = 1, MODE_X = 2, MODE_RET = 3 };
constexpr int KP = 136;

template <int MODE>
DI void attn_item(const Params& p, int item, char* smem, const int tid) {
  constexpr int VP = 136;
  bfr* Ks = (bfr*)smem;
  bfr* Vs = Ks + 64 * KP;
  const int w = tid >> 6, lane = tid & 63, r = lane & 31, h = lane >> 5;
  bfr* Qw = Vs + 64 * VP + w * 32 * KP;
  char* ws = p.ws;
  const bfr* z = (const bfr*)(ws + OFF_Z);

  int b, t0, tq0, jlo, jhi, head = 0, grp = 0, vh = 0;
  const bfr *qbase, *kbase, *vbase;
  int ldq, ldk;
  unsigned selm = 0, umask = 0xffffffffu;
  if (MODE == MODE_WIN) {
    const int tb = item >> 4, bg = item & 15;
    b = bg >> 2; grp = bg & 3; t0 = tb * 64; tq0 = t0 + 32 * (w >> 2); head = grp * 4 + (w & 3);
    qbase = z + (size_t)(b * SEQ + tq0) * ZS + ZC_Q + head * 128; ldq = ZS;
    kbase = z + (size_t)(b * SEQ) * ZS + ZC_KW + grp * 128;
    vbase = z + (size_t)(b * SEQ) * ZS + ZC_VW + grp * 128;
    ldk = ZS;
    jlo = (t0 - 511 > 0 ? t0 - 511 : 0) >> 6;
    jhi = tb;
  } else if (MODE == MODE_SEL) {
    const int tb = 31 - (item >> 4), bg = item & 15;
    b = bg >> 2; grp = bg & 3; t0 = tb * 64; tq0 = t0 + 32 * (w >> 2); head = grp * 4 + (w & 3);
    qbase = z + (size_t)(b * SEQ + tq0) * ZS + ZC_Q + head * 128; ldq = ZS;
    kbase = z + (size_t)(b * SEQ) * ZS + ZC_KS + grp * 128;
    vbase = z + (size_t)(b * SEQ) * ZS + ZC_VS + grp * 128;
    ldk = ZS;
    jlo = 0;
    jhi = tb;
    const unsigned* sm = (const unsigned*)(ws + OFF_SELM) + (b * 4 + grp) * SEQ;
    selm = sm[tq0 + r];
    unsigned u = sm[t0 + lane];
#pragma unroll
    for (int o = 32; o > 0; o >>= 1) u |= (unsigned)__shfl_xor((int)u, o);
    umask = (unsigned)__builtin_amdgcn_readfirstlane((int)u);
    umask &= (jhi >= 31) ? 0xffffffffu : ((1u << (jhi + 1)) - 1u);
  } else if (MODE == MODE_X) {
    const int tb = item >> 4, bh = item & 15;
    b = bh >> 2; head = bh & 3; t0 = tb * 256; tq0 = t0 + 32 * w;
    qbase = (const bfr*)(ws + OFF_QX) + (size_t)(b * SEQ + tq0) * 512 + head * 128; ldq = 512;
    kbase = (const bfr*)(ws + OFF_KX) + (size_t)(b * 256) * 512 + head * 128;
    vbase = (const bfr*)(ws + OFF_VX) + (size_t)(b * 256) * 512 + head * 128;
    ldk = 512;
    jlo = 0; jhi = 3;
  } else {
    const int tb = 7 - (item >> 6), rest = item & 63;
    b = rest >> 4; head = (rest >> 1) & 7; vh = rest & 1; t0 = tb * 256; tq0 = t0 + 32 * w;
    qbase = z + (size_t)(b * SEQ + tq0) * ZS + ZC_QR + head * 128; ldq = ZS;
    kbase = z + (size_t)(b * SEQ) * ZS + ZC_KR + head * 128;
    vbase = z + (size_t)(b * SEQ) * ZS + ZC_VR + head * 256 + vh * 128;
    ldk = ZS;
    jlo = 0; jhi = 4 * tb + 3;
  }
  const int tq = tq0 + r;

  f32x16 o[4];
#pragma unroll
  for (int dt = 0; dt < 4; ++dt)
#pragma unroll
    for (int i = 0; i < 16; ++i) o[dt][i] = 0.f;
  float m_run = -INFINITY, l_run = 0.f;
  float lg = 0.f;
  float rf[16];
  if (MODE == MODE_RET) {
    lg = log1pf(-exp2f(-5.f - (float)head)) * 1.4426950408889634f;
#pragma unroll
    for (int i = 0; i < 16; ++i) rf[i] = __builtin_amdgcn_exp2f(-lg * (float)crow(i, h));
  }

  u32x4 kreg[2], vreg[2];
  auto gload = [&](int j) {
    const int k0 = j * 64;
#pragma unroll
    for (int i = 0; i < 2; ++i) {
      const int c = tid + 512 * i, row = c >> 4, cc = c & 15;
      kreg[i] = *(const u32x4*)(kbase + (size_t)(k0 + row) * ldk + cc * 8);
      vreg[i] = *(const u32x4*)(vbase + (size_t)(k0 + row) * ldk + cc * 8);
    }
  };
  auto swrite = [&]() {
#pragma unroll
    for (int i = 0; i < 2; ++i) {
      const int c = tid + 512 * i, row = c >> 4, cc = c & 15;
      *(u32x4*)(Ks + row * KP + cc * 8) = kreg[i];
      *(u32x4*)(Vs + row * VP + cc * 8) = vreg[i];
    }
  };
  auto next_j = [&](int j) -> int {
    if (MODE == MODE_SEL) {
      const unsigned rem = (j >= 31) ? 0u : (umask & ~((2u << j) - 1u));
      return rem ? (__builtin_ctz(rem)) : 64;
    }
    return j + 1;
  };
  int j = jlo;
  if (MODE == MODE_SEL) j = __builtin_ctz(umask);
  gload(j);
  __syncthreads();
  {
    u32x4 qreg[8];
#pragma unroll
    for (int i = 0; i < 8; ++i) {
      const int c = lane + 64 * i, row = c >> 4, cc = c & 15;
      qreg[i] = *(const u32x4*)(qbase + (size_t)row * ldq + cc * 8);
    }
#pragma unroll
    for (int i = 0; i < 8; ++i) {
      const int c = lane + 64 * i, row = c >> 4, cc = c & 15;
      *(u32x4*)(Qw + row * KP + cc * 8) = qreg[i];
    }
  }
  const float csc = 0.08838834764831845f * 1.4426950408889634f;
  const int q4 = (lane & 15) >> 2, p4 = lane & 3, blk = (lane >> 4) & 1;
  bool first = true;
#pragma unroll 1
  while (j <= jhi) {
    if (!first) __syncthreads();
    first = false;
    swrite();
    __syncthreads();
    const int jn = next_j(j);
    if (jn <= jhi) gload(jn);
    const int k0 = j * 64;
    if (MODE == MODE_RET && k0 > tq0 + 31) { j = jn; continue; }
    bf16x8 pf[2][2];
    if (MODE == MODE_RET) {
#pragma unroll
      for (int sub = 0; sub < 2; ++sub) {
        f32x16 sx;
#pragma unroll
        for (int i = 0; i < 16; ++i) sx[i] = 0.f;
#pragma unroll
        for (int s = 0; s < 8; ++s) {
          const bf16x8 kf = *(const bf16x8*)(Ks + (32 * sub + r) * KP + 16 * s + 8 * h);
          const bf16x8 qf = *(const bf16x8*)(Qw + r * KP + 16 * s + 8 * h);
          sx = MFMA(kf, qf, sx);
        }
        {
          const int dq = tq - (k0 + 32 * sub);
          const float cf = __builtin_amdgcn_exp2f(lg * (float)dq);
#pragma unroll
          for (int i = 0; i < 16; ++i) sx[i] = (crow(i, h) <= dq) ? sx[i] * (cf * rf[i]) : 0.f;
        }
        pf[sub][0] = pack8(sx, 0);
        pf[sub][1] = pack8(sx, 1);
      }
    } else {
      f32x16 s0, s1;
#pragma unroll
      for (int i = 0; i < 16; ++i) { s0[i] = 0.f; s1[i] = 0.f; }
#pragma unroll
      for (int s = 0; s < 8; ++s) {
        const bf16x8 k0f = *(const bf16x8*)(Ks + r * KP + 16 * s + 8 * h);
        const bf16x8 k1f = *(const bf16x8*)(Ks + (32 + r) * KP + 16 * s + 8 * h);
        const bf16x8 qf = *(const bf16x8*)(Qw + r * KP + 16 * s + 8 * h);
        s0 = MFMA(k0f, qf, s0);
        s1 = MFMA(k1f, qf, s1);
      }
      bool need_mask = false;
      if (MODE == MODE_WIN) need_mask = (k0 + 63 > tq0) || (k0 < tq0 + 31 - 511);
      if (MODE == MODE_SEL) need_mask = (k0 + 63 > tq0);
      const bool lanesel = (MODE == MODE_SEL) ? ((selm >> j) & 1u) : true;
      float mx = -INFINITY;
      if (need_mask) {
#pragma unroll
        for (int i = 0; i < 16; ++i) {
          const int tk0 = k0 + crow(i, h), tk1 = tk0 + 32;
          bool ok0 = true, ok1 = true;
          if (MODE == MODE_WIN) { ok0 = (tk0 <= tq) && (tq - tk0 < 512); ok1 = (tk1 <= tq) && (tq - tk1 < 512); }
          if (MODE == MODE_SEL) { ok0 = lanesel && (tk0 <= tq); ok1 = lanesel && (tk1 <= tq); }
          s0[i] = ok0 ? s0[i] * csc : -INFINITY;
          s1[i] = ok1 ? s1[i] * csc : -INFINITY;
          mx = fmaxf(mx, fmaxf(s0[i], s1[i]));
        }
      } else {
#pragma unroll
        for (int i = 0; i < 16; ++i) {
          s0[i] = lanesel ? s0[i] * csc : -INFINITY;
          s1[i] = lanesel ? s1[i] * csc : -INFINITY;
          mx = fmaxf(mx, fmaxf(s0[i], s1[i]));
        }
      }
      mx = fmaxf(mx, __shfl_xor(mx, 32));
      const float mnew = fmaxf(m_run, mx);
      const float muse = (mnew == -INFINITY) ? 0.f : mnew;
      const float alpha = __builtin_amdgcn_exp2f(m_run - muse);
      float ls = 0.f;
#pragma unroll
      for (int i = 0; i < 16; ++i) {
        s0[i] = __builtin_amdgcn_exp2f(s0[i] - muse);
        s1[i] = __builtin_amdgcn_exp2f(s1[i] - muse);
        ls += s0[i] + s1[i];
      }
      ls += __shfl_xor(ls, 32);
      l_run = l_run * alpha + ls;
      m_run = mnew;
      if (__builtin_amdgcn_ballot_w64(alpha != 1.f) != 0) {
#pragma unroll
        for (int dt = 0; dt < 4; ++dt)
#pragma unroll
          for (int i = 0; i < 16; ++i) o[dt][i] *= alpha;
      }
      pf[0][0] = pack8(s0, 0); pf[0][1] = pack8(s0, 1);
      pf[1][0] = pack8(s1, 0); pf[1][1] = pack8(s1, 1);
    }
#pragma unroll
    for (int dt = 0; dt < 4; ++dt)
#pragma unroll
      for (int sub = 0; sub < 2; ++sub)
#pragma unroll
        for (int st = 0; st < 2; ++st) {
          const int key0 = 32 * sub + 16 * st + 4 * h;
          const bfr* vp = Vs + (key0 + q4) * VP + 32 * dt + 16 * blk + 4 * p4;
          const s16x4 lo = tr_read(vp);
          const s16x4 hi = tr_read(vp + 8 * VP);
          const bf16x8 vf = __builtin_shufflevector(lo, hi, 0, 1, 2, 3, 4, 5, 6, 7);
          o[dt] = MFMA(vf, pf[sub][st], o[dt]);
        }
    j = jn;
  }

  const size_t mrow = (size_t)(b * SEQ + tq);
  if (MODE == MODE_WIN || MODE == MODE_SEL) {
    const float inv = (l_run > 0.f) ? 1.f / l_run : 0.f;
    const float gate = bflo(z[mrow * ZS + ZC_GN + head * 3 + (MODE == MODE_WIN ? 2 : 1)]);
    bfr* orow = (bfr*)(ws + OFF_ONSA) + mrow * 2048 + head * 128;
    const float sc = inv * gate;
#pragma unroll
    for (int dt = 0; dt < 4; ++dt)
#pragma unroll
      for (int g = 0; g < 4; ++g) {
        bfr* dst = orow + 32 * dt + 8 * g + 4 * h;
        float a = o[dt][4 * g] * sc, bb = o[dt][4 * g + 1] * sc, c = o[dt][4 * g + 2] * sc, d = o[dt][4 * g + 3] * sc;
        if (MODE == MODE_SEL) {
          const uint2 old = *(const uint2*)dst;
          a += bflo(old.x); bb += bfhi(old.x); c += bflo(old.y); d += bfhi(old.y);
        }
        st_bf4(dst, a, bb, c, d);
      }
  } else if (MODE == MODE_X) {
    const float inv = 1.f / l_run;
    bfr* orow = (bfr*)(ws + OFF_OX) + mrow * 512 + head * 128;
#pragma unroll
    for (int dt = 0; dt < 4; ++dt)
#pragma unroll
      for (int g = 0; g < 4; ++g)
        st_bf4(orow + 32 * dt + 8 * g + 4 * h, o[dt][4 * g] * inv, o[dt][4 * g + 1] * inv, o[dt][4 * g + 2] * inv,
               o[dt][4 * g + 3] * inv);
  } else {
    float sm = 0.f, sq = 0.f;
#pragma unroll
    for (int dt = 0; dt < 4; ++dt)
#pragma unroll
      for (int i = 0; i < 16; ++i) { sm += o[dt][i]; sq += o[dt][i] * o[dt][i]; }
    sm += __shfl_xor(sm, 32);
    sq += __shfl_xor(sq, 32);
    if (h == 0) *(float2*)((float*)(ws + OFF_RSTAT) + ((mrow * 8 + head) * 2 + vh) * 2) = make_float2(sm, sq);
    bfr* orow = (bfr*)(ws + OFF_ORET) + mrow * 2048 + head * 256 + vh * 128;
#pragma unroll
    for (int dt = 0; dt < 4; ++dt)
#pragma unroll
      for (int g = 0; g < 4; ++g)
        st_bf4(orow + 32 * dt + 8 * g + 4 * h, o[dt][4 * g], o[dt][4 * g + 1], o[dt][4 * g + 2], o[dt][4 * g + 3]);
  }
}

DI void ret_finish_row(const Params& p, int row, const int t) {
  char* ws = p.ws;
  const bfr* z = (const bfr*)(ws + OFF_Z);
  const int col = t * 8, head = t >> 5;
  const float4 st = *(const float4*)((const float*)(ws + OFF_RSTAT) + ((size_t)row * 8 + head) * 4);
  const float mu = (st.x + st.z) * (1.f / 256.f);
  const float var = fmaxf((st.y + st.w) * (1.f / 256.f) - mu * mu, 0.f);
  const float rstd = rsqrtf(var + 1e-6f);
  bfr* op = (bfr*)(ws + OFF_ORET) + (size_t)row * 2048 + col;
  const u32x4 ov = *(const u32x4*)op;
  const u32x4 gv = *(const u32x4*)(z + (size_t)row * ZS + ZC_GR + col);
  const float4 w0 = *(const float4*)(p.gn_w + col), w1 = *(const float4*)(p.gn_w + col + 4);
  u32x4 res;
  res[0] = pack2((bflo(ov[0]) - mu) * rstd * w0.x * bflo(gv[0]), (bfhi(ov[0]) - mu) * rstd * w0.y * bfhi(gv[0]));
  res[1] = pack2((bflo(ov[1]) - mu) * rstd * w0.z * bflo(gv[1]), (bfhi(ov[1]) - mu) * rstd * w0.w * bfhi(gv[1]));
  res[2] = pack2((bflo(ov[2]) - mu) * rstd * w1.x * bflo(gv[2]), (bfhi(ov[2]) - mu) * rstd * w1.y * bfhi(gv[2]));
  res[3] = pack2((bflo(ov[3]) - mu) * rstd * w1.z * bflo(gv[3]), (bfhi(ov[3]) - mu) * rstd * w1.w * bfhi(gv[3]));
  *(u32x4*)op = res;
}

DI void cmp_item(const Params& p, int item, char* smem, const int tid) {
  bfr* Ks = (bfr*)smem;
  float* impw = (float*)(smem + 128 * KP * 2);
  const int w = tid >> 6, lane = tid & 63, r = lane & 31, h = lane >> 5;
  char* ws = p.ws;
  const bfr* z = (const bfr*)(ws + OFF_Z);
  const int tb = item >> 4, bg = item & 15, b = bg >> 2, grp = bg & 3;
  const int t0 = tb * 64, ti = 32 * (w >> 2) + r, tq = t0 + ti, hw = w & 3, head = grp * 4 + hw;
  const bfr* qrow = z + (size_t)(b * SEQ + tq) * ZS + ZC_Q + head * 128;
  const bfr* kc = (const bfr*)(ws + OFF_KCVC) + (size_t)((b * 4 + grp) * 128) * 128;
  const bfr* vc = kc + (size_t)2048 * 128;
  bf16x8 qf[8];
#pragma unroll
  for (int s = 0; s < 8; ++s) qf[s] = *(const bf16x8*)(qrow + 16 * s + 8 * h);
  u32x4 reg[4];
#pragma unroll
  for (int i = 0; i < 4; ++i) {
    const int c = tid + 512 * i, row = c >> 4, cc = c & 15;
    reg[i] = *(const u32x4*)(kc + row * 128 + cc * 8);
  }
  __syncthreads();
#pragma unroll
  for (int i = 0; i < 4; ++i) {
    const int c = tid + 512 * i, row = c >> 4, cc = c & 15;
    *(u32x4*)(Ks + row * KP + cc * 8) = reg[i];
  }
  __syncthreads();
  f32x16 s[4];
#pragma unroll
  for (int kt = 0; kt < 4; ++kt) {
#pragma unroll
    for (int i = 0; i < 16; ++i) s[kt][i] = 0.f;
#pragma unroll
    for (int ss = 0; ss < 8; ++ss) {
      const bf16x8 kf = *(const bf16x8*)(Ks + (32 * kt + r) * KP + 16 * ss + 8 * h);
      s[kt] = MFMA(kf, qf[ss], s[kt]);
    }
  }
  const float csc = 0.08838834764831845f * 1.4426950408889634f;
  float mx = -INFINITY;
#pragma unroll
  for (int kt = 0; kt < 4; ++kt)
#pragma unroll
    for (int i = 0; i < 16; ++i) {
      const int c = 32 * kt + crow(i, h);
      const bool ok = (c * 16 + 31 <= tq) && (c < 127);
      s[kt][i] = ok ? s[kt][i] * csc : -INFINITY;
      mx = fmaxf(mx, s[kt][i]);
    }
  mx = fmaxf(mx, __shfl_xor(mx, 32));
  const float muse = (mx == -INFINITY) ? 0.f : mx;
  float ls = 0.f;
#pragma unroll
  for (int kt = 0; kt < 4; ++kt)
#pragma unroll
    for (int i = 0; i < 16; ++i) {
      s[kt][i] = __builtin_amdgcn_exp2f(s[kt][i] - muse);
      ls += s[kt][i];
    }
  ls += __shfl_xor(ls, 32);
  const float inv = (ls > 0.f) ? 1.f / ls : 0.f;
#pragma unroll
  for (int kt = 0; kt < 4; ++kt)
#pragma unroll
    for (int i = 0; i < 16; ++i) s[kt][i] *= inv;
  float plast[16];
#pragma unroll
  for (int kt = 0; kt < 4; ++kt)
#pragma unroll
    for (int g = 0; g < 4; ++g) plast[kt * 4 + g] = __shfl_xor(s[kt][4 * g + 3], 32);
#pragma unroll
  for (int kt = 0; kt < 4; ++kt)
#pragma unroll
    for (int g = 0; g < 4; ++g) {
      const int slot = kt * 4 + g;
      const float sum4 = s[kt][4 * g] + s[kt][4 * g + 1] + s[kt][4 * g + 2] + s[kt][4 * g + 3];
      const float prevl = (slot > 0) ? plast[slot > 0 ? slot - 1 : 0] : 0.f;
      const float add = h ? plast[slot] : prevl;
      impw[(hw * 64 + ti) * 32 + 8 * kt + 2 * g + h] = sum4 + add;
    }
  bf16x8 pf[4][2];
#pragma unroll
  for (int kt = 0; kt < 4; ++kt) { pf[kt][0] = pack8(s[kt], 0); pf[kt][1] = pack8(s[kt], 1); }
#pragma unroll
  for (int i = 0; i < 4; ++i) {
    const int c = tid + 512 * i, row = c >> 4, cc = c & 15;
    reg[i] = *(const u32x4*)(vc + row * 128 + cc * 8);
  }
  __syncthreads();
#pragma unroll
  for (int i = 0; i < 4; ++i) {
    const int c = tid + 512 * i, row = c >> 4, cc = c & 15;
    *(u32x4*)(Ks + row * KP + cc * 8) = reg[i];
  }
  __syncthreads();
  f32x16 o[4];
#pragma unroll
  for (int dt = 0; dt < 4; ++dt)
#pragma unroll
    for (int i = 0; i < 16; ++i) o[dt][i] = 0.f;
  const int q4 = (lane & 15) >> 2, p4 = lane & 3, blk = (lane >> 4) & 1;
#pragma unroll
  for (int dt = 0; dt < 4; ++dt)
#pragma unroll
    for (int kt = 0; kt < 4; ++kt)
#pragma unroll
      for (int st = 0; st < 2; ++st) {
        const int key0 = 32 * kt + 16 * st + 4 * h;
        const bfr* vp = Ks + (key0 + q4) * KP + 32 * dt + 16 * blk + 4 * p4;
        const s16x4 lo = tr_read(vp);
        const s16x4 hi = tr_read(vp + 8 * KP);
        const bf16x8 vf = __builtin_shufflevector(lo, hi, 0, 1, 2, 3, 4, 5, 6, 7);
        o[dt] = MFMA(vf, pf[kt][st], o[dt]);
      }
  {
    const size_t mrow = (size_t)(b * SEQ + tq);
    const float gate = bflo(z[mrow * ZS + ZC_GN + head * 3 + 0]);
    bfr* orow = (bfr*)(ws + OFF_ONSA) + mrow * 2048 + head * 128;
#pragma unroll
    for (int dt = 0; dt < 4; ++dt)
#pragma unroll
      for (int g = 0; g < 4; ++g) {
        bfr* dst = orow + 32 * dt + 8 * g + 4 * h;
        const uint2 old = *(const uint2*)dst;
        st_bf4(dst, o[dt][4 * g] * gate + bflo(old.x), o[dt][4 * g + 1] * gate + bfhi(old.x),
               o[dt][4 * g + 2] * gate + bflo(old.y), o[dt][4 * g + 3] * gate + bfhi(old.y));
      }
  }
  {
    const int i = tid >> 3, jg = tid & 7;
    const int cur = (t0 + i) >> 6;
    float vm[4];
#pragma unroll
    for (int e = 0; e < 4; ++e) {
      const int jme = 4 * jg + e;
      const float a = impw[(0 * 64 + i) * 32 + jme] + impw[(1 * 64 + i) * 32 + jme] + impw[(2 * 64 + i) * 32 + jme] + impw[(3 * 64 + i) * 32 + jme];
      const bool forced = (jme == 0) || (jme == cur) || (jme == cur - 1);
      vm[e] = forced ? INFINITY : ((jme > cur) ? -INFINITY : a);
    }
#pragma unroll
    for (int e = 0; e < 4; ++e) impw[i * 32 + 4 * jg + e] = vm[e];
    __syncthreads();
    int rank[4] = {0, 0, 0, 0};
#pragma unroll 4
    for (int k = 0; k < 32; ++k) {
      const float vk = impw[i * 32 + k];
#pragma unroll
      for (int e = 0; e < 4; ++e) rank[e] += (vk > vm[e] || (vk == vm[e] && k < 4 * jg + e)) ? 1 : 0;
    }
    unsigned bits = 0;
#pragma unroll
    for (int e = 0; e < 4; ++e)
      if (rank[e] < 16 && 4 * jg + e <= cur) bits |= 1u << (4 * jg + e);
    bits |= (unsigned)__shfl_xor((int)bits, 1);
    bits |= (unsigned)__shfl_xor((int)bits, 2);
    bits |= (unsigned)__shfl_xor((int)bits, 4);
    if (jg == 0) ((unsigned*)(ws + OFF_SELM))[(b * 4 + grp) * SEQ + t0 + i] = bits;
  }
  __syncthreads();
}

DI int grab(unsigned* ctr, int* slot, const int tid) {
  __syncthreads();
  if (tid == 0) *slot = (int)atomicAdd(ctr, 1u);
  __syncthreads();
  return *slot;
}

DI void run_phase(const Params& p0, int ph, char* smem, int* slot, const int wave_s, const int rep) {
  char* ws = p0.ws;
  asm volatile("" : "+s"(ws));
  Params p = p0;
  p.ws = ws;
  const int G = gridDim.x;
  int bid = blockIdx.x;
  int tid = wave_s * 64 + (int)__builtin_amdgcn_mbcnt_hi(~0u, __builtin_amdgcn_mbcnt_lo(~0u, 0u));
  asm volatile("" : "+s"(bid));
  asm volatile("" : "+v"(tid));
  bfr* z = (bfr*)(ws + OFF_Z);
  unsigned* ctr = (unsigned*)(ws + OFF_CTR) + rep * 8;
  switch (ph) {
    case 0: {
      if (bid == 0 && tid < 64) ((unsigned*)(ws + OFF_CTR))[tid] = 0u;
      int tot = 0;
      for (int j = 0; j < 12; ++j) tot += tjob_tiles(j);
      const int n_norm = 1024 + 128, n_rope = 256;
      for (int it = bid; it < tot + n_norm + n_rope; it += G) {
        if (it < tot) {
          int j = 0, rem = it;
          while (rem >= tjob_tiles(j)) { rem -= tjob_tiles(j); ++j; }
          const TJob t = get_tjob(p, j);
          transpose_tile(t, rem, (float*)smem, tid);
        } else if (it < tot + n_norm) {
          const int row = (it - tot) * 8 + (tid >> 6);
          if (row < NTOK) rmsnorm_row(p.x + (size_t)row * 2048, p.attn_norm_w, (bfr*)(ws + OFF_N) + (size_t)row * 2048, nullptr, tid);
          else rmsnorm_row(p.mem + (size_t)(row - NTOK) * 2048, p.mem_norm_w, (bfr*)(ws + OFF_MN) + (size_t)(row - NTOK) * 2048, nullptr, tid);
        } else {
          const int e = (it - tot - n_norm) * 512 + tid;
          const int t = e >> 6, i = e & 63;
          const float ang = (float)t * ROPE_INV[i];
          const float kk = rintf(ang * 0.15915494309189535f);
          float rr = fmaf(-kk, 6.2831854820251465f, ang);
          rr = fmaf(-kk, -1.7484555e-7f, rr);
          const float fr = rr * 0.15915494309189535f;
          ((float2*)(ws + OFF_ROPE))[e] = make_float2(__builtin_amdgcn_cosf(fr), __builtin_amdgcn_sinf(fr));
        }
      }
    } break;
    case 1: {
      const int nt_main = 32 * 61;
      for (int v = bid; v < nt_main + 32; v += G) {
        if (v < nt_main) {
          f32x16 acc[2][4];
          acc_zero<2>(acc);
          int mt, nt;
          map_tile32(v, mt, nt);
          const int m0 = mt * 256, n0 = nt * 256;
          PlainPtr af{(const bfr*)(ws + OFF_N) + (size_t)m0 * 2048, 2048};
          PlainPtr bf{(const bfr*)(ws + OFF_WINT) + (size_t)n0 * 2048, 2048};
          gemm_main<2>(acc, af, bf, 64, smem, tid);
          bfr* zcb = (bfr*)(ws + OFF_ZC);
          const float2* rope = (const float2*)(ws + OFF_ROPE);
          gemm_epi<2>(acc, m0, n0, tid, [&](int m, int n, float a, float b, float c, float d) {
            if (n >= ZS) return;
            bfr* dst = z + (size_t)m * ZS + n;
            const int t = m & 2047;
            if (n >= ZC_KC && n < ZC_KS) {
              const float* pe = (n < ZC_VC) ? p.pe_k : p.pe_v;
              const int dd = n & 127;
              const float4 plo = *(const float4*)(pe + (t & 15) * 128 + dd);
              const float4 phi = *(const float4*)(pe + (16 + (t & 15)) * 128 + dd);
              st_bf4(zcb + (size_t)m * 2048 + (n - ZC_KC), a + plo.x, b + plo.y, c + plo.z, d + plo.w);
              st_bf4(zcb + (size_t)m * 2048 + 1024 + (n - ZC_KC), a + phi.x, b + phi.y, c + phi.z, d + phi.w);
            } else if (n >= ZC_QR && n < ZC_VR) {
              const int i0 = (n & 127) >> 1;
              const float2 c0 = rope[t * 64 + i0], c1 = rope[t * 64 + i0 + 1];
              float o0 = a * c0.x - b * c0.y, o1 = a * c0.y + b * c0.x;
              float o2 = c * c1.x - d * c1.y, o3 = c * c1.y + d * c1.x;
              if (n >= ZC_KR) { const float sc = 0.08838834764831845f; o0 *= sc; o1 *= sc; o2 *= sc; o3 *= sc; }
              st_bf4(dst, o0, o1, o2, o3);
            } else if (n >= ZC_GR && n < ZC_GA) {
              st_bf4(dst, a * sigmoidf_(a), b * sigmoidf_(b), c * sigmoidf_(c), d * sigmoidf_(d));
            } else if (n >= ZC_GA) {
              st_bf4(dst, sigmoidf_(a), sigmoidf_(b), sigmoidf_(c), sigmoidf_(d));
            } else {
              st_bf4(dst, a, b, c, d);
            }
          });
        } else {
          f32x16 acc[1][4];
          acc_zero<1>(acc);
          const int u = v - nt_main, which = u >> 4, mt = (u & 15) >> 2, nt = u & 3;
          const int m0 = mt * 256, n0 = nt * 128;
          PlainPtr af{(const bfr*)(ws + OFF_MN) + (size_t)m0 * 2048, 2048};
          PlainPtr bf{(const bfr*)(ws + (which ? OFF_WVT : OFF_WKT)) + (size_t)n0 * 2048, 2048};
          gemm_main<1>(acc, af, bf, 64, smem, tid);
          bfr* dstb = (bfr*)(ws + (which ? OFF_VX : OFF_KX));
          gemm_epi<1>(acc, m0, n0, tid, [&](int m, int n, float a, float b, float c, float d) { st_bf4(dstb + (size_t)m * 512 + n, a, b, c, d); });
        }
      }
    } break;
    case 2: {
      for (int it = grab(ctr + 0, slot, tid); it < 128; it = grab(ctr + 0, slot, tid)) {
        const int which = it >> 6, mt = (it & 63) >> 3, nt = it & 7;
        const int m0 = mt * 256, n0 = nt * 128;
        f32x16 acc[1][4];
        acc_zero<1>(acc);
        struct GatherA {
          const bfr* base; int m0;
          DI int rowoff(int row) const {
            const int R = m0 + row;
            const int bb = R >> 9, g = (R >> 7) & 3;
            int c = R & 127; c = c > 126 ? 126 : c;
            return (bb * SEQ + c * 16) * 2048 + g * 128;
          }
          DI int koff(int kk) const { const int l = kk >> 7; return l * 2048 + ((l >> 4) << 10) + (kk & 127); }
        };
        GatherA af{(const bfr*)(ws + OFF_ZC) + which * 512, m0};
        PlainPtr bf{(const bfr*)(ws + OFF_W1T) + (size_t)which * 1024 * 4096 + (size_t)n0 * 4096, 4096};
        gemm_main<1>(acc, af, bf, 128, smem, tid);
        bfr* hid = (bfr*)(ws + OFF_HIDC) + (size_t)which * 2048 * 1024;
        gemm_epi<1>(acc, m0, n0, tid, [&](int m, int n, float a, float b, float c, float d) {
          st_bf4(hid + (size_t)m * 1024 + n, a * sigmoidf_(a), b * sigmoidf_(b), c * sigmoidf_(c), d * sigmoidf_(d));
        });
      }
      for (int it = grab(ctr + 1, slot, tid); it < 1024; it = grab(ctr + 1, slot, tid)) {
        if (it < 512) attn_item<MODE_RET>(p, it, smem, tid);
        else attn_item<MODE_WIN>(p, it - 512, smem, tid);
      }
    } break;
    case 3: {
      for (int it = bid; it < 16 + NTOK / 2; it += G) {
        if (it >= 16) { ret_finish_row(p, (it - 16) * 2 + (tid >> 8), tid & 255); continue; }
        const int which = it >> 3, mt = it & 7;
        const int m0 = mt * 256;
        f32x16 acc[1][4];
        acc_zero<1>(acc);
        PlainPtr af{(const bfr*)(ws + OFF_HIDC) + (size_t)which * 2048 * 1024 + (size_t)m0 * 1024, 1024};
        PlainPtr bf{(const bfr*)(ws + OFF_W2T) + (size_t)which * 128 * 1024, 1024};
        gemm_main<1>(acc, af, bf, 32, smem, tid);
        bfr* dstb = (bfr*)(ws + OFF_KCVC) + (size_t)which * 2048 * 128;
        gemm_epi<1>(acc, m0, 0, tid, [&](int m, int n, float a, float b, float c, float d) { st_bf4(dstb + (size_t)m * 128 + n, a, b, c, d); });
      }
    } break;
    case 4: {
      for (int it = bid; it < 512; it += G) cmp_item(p, it, smem, tid);
    } break;
    case 5: {
      for (int it = grab(ctr + 2, slot, tid); it < 512; it = grab(ctr + 2, slot, tid)) attn_item<MODE_SEL>(p, it, smem, tid);
    } break;
    case 6: {
      for (int v = bid; v < 32 * 8; v += G) {
        int mt, nt;
        map_tile32(v, mt, nt);
        const int m0 = mt * 256, n0 = nt * 256;
        f32x16 acc[2][4];
        acc_zero<2>(acc);
        bfr* mg = (bfr*)(ws + OFF_MERGED);
        {
          PlainPtr af{(const bfr*)(ws + OFF_ONSA) + (size_t)m0 * 2048, 2048};
          PlainPtr bf{(const bfr*)(ws + OFF_WAT) + (size_t)n0 * 2048, 2048};
          gemm_main<2>(acc, af, bf, 64, smem, tid);
          gemm_epi<2>(acc, m0, n0, tid, [&](int m, int n, float a, float b, float c, float d) {
            const uint2 ga = *(const uint2*)(z + (size_t)m * ZS + ZC_GA + n);
            st_bf4(mg + (size_t)m * 2048 + n, bflo(ga.x) * a, bfhi(ga.x) * b, bflo(ga.y) * c, bfhi(ga.y) * d);
          });
        }
        acc_zero<2>(acc);
        {
          PlainPtr af{(const bfr*)(ws + OFF_ORET) + (size_t)m0 * 2048, 2048};
          PlainPtr bf{(const bfr*)(ws + OFF_WBT) + (size_t)n0 * 2048, 2048};
          gemm_main<2>(acc, af, bf, 64, smem, tid);
          gemm_epi<2>(acc, m0, n0, tid, [&](int m, int n, float a, float b, float c, float d) {
            const uint2 gb = *(const uint2*)(z + (size_t)m * ZS + ZC_GB + n);
            bfr* dst = mg + (size_t)m * 2048 + n;
            const uint2 old = *(const uint2*)dst;
            st_bf4(dst, bflo(old.x) + bflo(gb.x) * a, bfhi(old.x) + bfhi(gb.x) * b, bflo(old.y) + bflo(gb.y) * c, bfhi(old.y) + bfhi(gb.y) * d);
          });
        }
      }
    } break;
    case 7: {
      for (int v = bid; v < 32 * 8; v += G) {
        int mt, nt;
        map_tile32(v, mt, nt);
        const int m0 = mt * 256, n0 = nt * 256;
        f32x16 acc[2][4];
        acc_zero<2>(acc);
        PlainPtr af{(const bfr*)(ws + OFF_MERGED) + (size_t)m0 * 2048, 2048};
        PlainPtr bf{(const bfr*)(ws + OFF_WOUTT) + (size_t)n0 * 2048, 2048};
        gemm_main<2>(acc, af, bf, 64, smem, tid);
        float* hbuf = (float*)(ws + OFF_H);
        gemm_epi<2>(acc, m0, n0, tid, [&](int m, int n, float a, float b, float c, float d) {
          const float4 xv = *(const float4*)(p.x + (size_t)m * 2048 + n);
          *(float4*)(hbuf + (size_t)m * 2048 + n) = make_float4(xv.x + a, xv.y + b, xv.z + c, xv.w + d);
        });
      }
    } break;
    case 8: case 12: {
      const float* w = (ph == 8) ? p.x_norm_w : p.mlp_norm_w;
      const int n_tr = (ph == 8) ? (tjob_tiles(12) + tjob_tiles(13)) : 0;
      for (int it = bid; it < 1024 + n_tr; it += G) {
        if (it < 1024) {
          const int row = it * 8 + (tid >> 6);
          rmsnorm_row((const float*)(ws + OFF_H) + (size_t)row * 2048, w, (bfr*)(ws + OFF_NX) + (size_t)row * 2048, nullptr, tid);
        } else {
          int rem = it - 1024, j = 12;
          if (rem >= tjob_tiles(12)) { rem -= tjob_tiles(12); j = 13; }
          const TJob t = get_tjob(p, j);
          transpose_tile(t, rem, (float*)smem, tid);
        }
      }
    } break;
    case 9: {
      for (int v = bid; v < 32 * 4; v += G) {
        int mt, nt;
        map_tile32(v, mt, nt);
        const int m0 = mt * 256, n0 = nt * 128;
        f32x16 acc[1][4];
        acc_zero<1>(acc);
        PlainPtr af{(const bfr*)(ws + OFF_NX) + (size_t)m0 * 2048, 2048};
        PlainPtr bf{(const bfr*)(ws + OFF_WQT) + (size_t)n0 * 2048, 2048};
        gemm_main<1>(acc, af, bf, 64, smem, tid);
        bfr* qx = (bfr*)(ws + OFF_QX);
        gemm_epi<1>(acc, m0, n0, tid, [&](int m, int n, float a, float b, float c, float d) { st_bf4(qx + (size_t)m * 512 + n, a, b, c, d); });
      }
    } break;
    case 10: {
      for (int it = bid; it < 128; it += G) attn_item<MODE_X>(p, it, smem, tid);
    } break;
    case 11: {
      for (int v = bid; v < 32 * 8; v += G) {
        int mt, nt;
        map_tile32(v, mt, nt);
        const int m0 = mt * 256, n0 = nt * 256;
        f32x16 acc[2][4];
        acc_zero<2>(acc);
        PlainPtr af{(const bfr*)(ws + OFF_OX) + (size_t)m0 * 512, 512};
        PlainPtr bf{(const bfr*)(ws + OFF_WOT) + (size_t)n0 * 512, 512};
        gemm_main<2>(acc, af, bf, 16, smem, tid);
        float* hbuf = (float*)(ws + OFF_H);
        gemm_epi<2>(acc, m0, n0, tid, [&](int m, int n, float a, float b, float c, float d) {
          float4* hp = (float4*)(hbuf + (size_t)m * 2048 + n);
          const float4 xv = *hp;
          *hp = make_float4(xv.x + a, xv.y + b, xv.z + c, xv.w + d);
        });
      }
    } break;
    case 13: {
      for (int v = bid; v < 32 * 32; v += G) {
        int mt, nt;
        map_tile32(v, mt, nt);
        const int m0 = mt * 256, n0 = nt * 256;
        f32x16 acc[2][4];
        acc_zero<2>(acc);
        PlainPtr af{(const bfr*)(ws + OFF_NX) + (size_t)m0 * 2048, 2048};
        PlainPtr bf{(const bfr*)(ws + OFF_WUPT) + (size_t)n0 * 2048, 2048};
        gemm_main<2>(acc, af, bf, 64, smem, tid);
        bfr* hid = (bfr*)(ws + OFF_HID);
        gemm_epi<2>(acc, m0, n0, tid, [&](int m, int n, float a, float b, float c, float d) {
          a = fmaxf(a, 0.f); b = fmaxf(b, 0.f); c = fmaxf(c, 0.f); d = fmaxf(d, 0.f);
          st_bf4(hid + (size_t)m * 8192 + n, a * a, b * b, c * c, d * d);
        });
      }
    } break;
    case 14: {
      for (int v = bid; v < 32 * 8; v += G) {
        int mt, nt;
        map_tile32(v, mt, nt);
        const int m0 = mt * 256, n0 = nt * 256;
        f32x16 acc[2][4];
        acc_zero<2>(acc);
        PlainPtr af{(const bfr*)(ws + OFF_HID) + (size_t)m0 * 8192, 8192};
        PlainPtr bf{(const bfr*)(ws + OFF_WDOWNT) + (size_t)n0 * 8192, 8192};
        gemm_main<2>(acc, af, bf, 256, smem, tid);
        const float* hbuf = (const float*)(ws + OFF_H);
        gemm_epi<2>(acc, m0, n0, tid, [&](int m, int n, float a, float b, float c, float d) {
          const float4 xv = *(const float4*)(hbuf + (size_t)m * 2048 + n);
          *(float4*)(p.out + (size_t)m * 2048 + n) = make_float4(xv.x + a, xv.y + b, xv.z + c, xv.w + d);
        });
      }
    } break;
    case 15: {
      for (int it = bid; it < 1024; it += G) {
        const int row = it * 8 + (tid >> 6);
        rmsnorm_row(p.out + (size_t)row * 2048, p.final_norm_w, nullptr, p.out + (size_t)row * 2048, tid);
      }
    } break;
    default: break;
  }
}

__global__ void __launch_bounds__(512, 2) mega(Params p) {
  extern __shared__ __attribute__((aligned(1024))) char smem[];
  __shared__ int slot;
  cg::grid_group grid = cg::this_grid();
  const int wave_s = __builtin_amdgcn_readfirstlane((int)(threadIdx.x >> 6));
  for (int ph = p.ph_lo; ph < p.ph_hi; ++ph) {
    run_phase(p, ph, smem, &slot, wave_s, 0);
#ifdef PROBE_PH
    if (ph == PROBE_PH)
      for (int rep = 1; rep <= PROBE_N; ++rep) { grid.sync(); run_phase(p, ph, smem, &slot, wave_s, rep); }
#endif
    if (ph + 1 < p.ph_hi) grid.sync();
  }
}

extern "C" void kernel_launch(void* const* d_in, const int* in_sizes, int n_in, void* d_out, int out_size, void* d_ws,
                              size_t ws_size, hipStream_t stream) {
  static int grid_blocks = 0;
  if (!grid_blocks) {
    int dev = 0, cus = 0, per_cu = 0;
    (void)hipGetDevice(&dev);
    (void)hipDeviceGetAttribute(&cus, hipDeviceAttributeMultiprocessorCount, dev);
    (void)hipFuncSetAttribute((const void*)mega, hipFuncAttributeMaxDynamicSharedMemorySize, SMEM_BYTES);
    (void)hipOccupancyMaxActiveBlocksPerMultiprocessor(&per_cu, mega, NTHR, SMEM_BYTES);
    if (per_cu < 1) per_cu = 1;
    if (per_cu > 1) per_cu = 1;
    grid_blocks = cus * per_cu;
    grid_blocks &= ~7;
    if (ws_size < WS_END || n_in != 24) { fprintf(stderr, "kernel_launch: ws %zu < %zu or n_in %d\n", ws_size, (size_t)WS_END, n_in); grid_blocks = -1; }
  }
  if (grid_blocks < 0) return;
  Params p{};
  const float** pp = (const float**)&p;
  for (int i = 0; i < 24; ++i) pp[i] = (const float*)d_in[i];
  p.out = (float*)d_out;
  p.ws = (char*)d_ws;
#if ONE_LAUNCH
  p.ph_lo = 0; p.ph_hi = NPHASE;
  void* args[] = {&p};
  hipError_t e = hipLaunchCooperativeKernel((void*)mega, dim3(grid_blocks), dim3(NTHR), args, SMEM_BYTES, stream);
  if (e != hipSuccess) fprintf(stderr, "cooperative launch failed: %s (grid %d)\n", hipGetErrorString(e), grid_blocks);
#else
  for (int ph = 0; ph < NPHASE; ++ph) {
    p.ph_lo = ph; p.ph_hi = ph + 1;
    hipLaunchKernelGGL(mega, dim3(grid_blocks), dim3(NTHR), SMEM_BYTES, stream, p);
  }
#endif
}
```

```cpp
#include <hip/hip_runtime.h>
#include <hip/hip_cooperative_groups.h>
#include <cstdio>
namespace cg = cooperative_groups;

#ifndef ONE_LAUNCH
#define ONE_LAUNCH 1
#endif

#define DI __device__ __forceinline__
typedef unsigned short bfr;
using bf16x8 = __attribute__((ext_vector_type(8))) short;
using s16x4 = __attribute__((ext_vector_type(4))) short;
using f32x16 = __attribute__((ext_vector_type(16))) float;
using u32x4 = __attribute__((ext_vector_type(4))) unsigned;
#define MFMA(a, b, c) __builtin_amdgcn_mfma_f32_32x32x16_bf16((a), (b), (c), 0, 0, 0)

constexpr int DM = 2048, SEQ = 2048, NTOK = 8192;
constexpr int ZS = 15488;
constexpr int ZC_Q = 0, ZC_KC = 2048, ZC_VC = 2560, ZC_KS = 3072, ZC_VS = 3584, ZC_KW = 4096, ZC_VW = 4608,
              ZC_QR = 5120, ZC_KR = 6144, ZC_VR = 7168, ZC_GR = 9216, ZC_GA = 11264, ZC_GB = 13312, ZC_GN = 15360;
constexpr int NPHASE = 16;

constexpr int ZSP = 15616;
constexpr size_t SZ_WINT = (size_t)ZSP * 2048 * 2;
constexpr size_t SZ_ACT = (size_t)NTOK * 2048 * 2;
constexpr size_t OFF_WINT = 0;
constexpr size_t OFF_N = OFF_WINT + SZ_WINT;
constexpr size_t OFF_MERGED = OFF_WINT;
constexpr size_t OFF_ORET = OFF_N;
constexpr size_t OFF_WUPT = 0;
constexpr size_t OFF_WDOWNT = SZ_ACT;
constexpr size_t OFF_Z = OFF_N + SZ_ACT;
constexpr size_t SZ_Z = (size_t)NTOK * ZS * 2;
constexpr size_t OFF_HID = OFF_Z;
constexpr size_t OFF_H = OFF_Z + (size_t)NTOK * 8192 * 2;
constexpr size_t OFF_NX = OFF_H + (size_t)NTOK * 2048 * 4;
constexpr size_t OFF_QX = OFF_NX + SZ_ACT;
constexpr size_t OFF_OX = OFF_QX + (size_t)NTOK * 512 * 2;
static_assert(OFF_OX + (size_t)NTOK * 512 * 2 <= OFF_Z + SZ_Z, "alias overflow");
constexpr size_t OFF_ZC = OFF_Z + SZ_Z;
constexpr size_t OFF_MN = OFF_ZC + (size_t)NTOK * 2048 * 2;
constexpr size_t OFF_W1T = OFF_MN + (size_t)1024 * 2048 * 2;
constexpr size_t OFF_W2T = OFF_W1T + (size_t)2 * 1024 * 4096 * 2;
constexpr size_t OFF_WAT = OFF_W2T + (size_t)2 * 128 * 1024 * 2;
constexpr size_t OFF_WBT = OFF_WAT + (size_t)2048 * 2048 * 2;
constexpr size_t OFF_WOUTT = OFF_WBT + (size_t)2048 * 2048 * 2;
constexpr size_t OFF_WQT = OFF_WOUTT + (size_t)2048 * 2048 * 2;
constexpr size_t OFF_WKT = OFF_WQT + (size_t)512 * 2048 * 2;
constexpr size_t OFF_WVT = OFF_WKT + (size_t)512 * 2048 * 2;
constexpr size_t OFF_WOT = OFF_WVT + (size_t)512 * 2048 * 2;
constexpr size_t OFF_ROPE = OFF_WOT + (size_t)512 * 2048 * 2;
constexpr size_t OFF_HIDC = OFF_ROPE + (size_t)2048 * 64 * 8;
constexpr size_t OFF_KCVC = OFF_HIDC + (size_t)2 * 2048 * 1024 * 2;
constexpr size_t OFF_SELM = OFF_KCVC + (size_t)2 * 2048 * 128 * 2;
constexpr size_t OFF_ONSA = OFF_SELM + (size_t)16 * 2048 * 4;
constexpr size_t OFF_KX = OFF_ONSA + SZ_ACT;
constexpr size_t OFF_VX = OFF_KX + (size_t)1024 * 512 * 2;
constexpr size_t OFF_RSTAT = OFF_VX + (size_t)1024 * 512 * 2;
constexpr size_t OFF_CTR = OFF_RSTAT + (size_t)NTOK * 8 * 2 * 2 * 4;
constexpr size_t WS_END = OFF_CTR + 256;

struct Params {
  const float *x, *mem, *attn_norm_w, *w_in, *pe_k, *w1k, *w2k, *pe_v, *w1v, *w2v, *w_a, *gn_w, *w_b, *w_out, *x_norm_w,
      *mem_norm_w, *wq, *wk, *wv, *wo, *mlp_norm_w, *w_up, *w_down, *final_norm_w;
  float* out;
  char* ws;
  int ph_lo, ph_hi;
  int dbg, pad;
};

constexpr int NTHR = 512;
constexpr int SMEM_BYTES = 131072;
__device__ const float ROPE_INV[64] = {1.0f, 0.865964353f, 0.749894261f, 0.649381638f, 0.562341332f, 0.486967534f, 0.421696514f, 0.365174115f, 0.316227764f, 0.273841977f, 0.237137377f, 0.2053525f, 0.177827939f, 0.153992653f, 0.133352131f, 0.115478203f, 0.100000001f, 0.0865964293f, 0.0749894157f, 0.0649381652f, 0.0562341325f, 0.0486967526f, 0.0421696529f, 0.0365174115f, 0.0316227749f, 0.0273841973f, 0.0237137377f, 0.0205352511f, 0.0177827943f, 0.0153992651f, 0.0133352149f, 0.0115478206f, 0.00999999978f, 0.00865964312f, 0.00749894185f, 0.00649381615f, 0.00562341325f, 0.00486967526f, 0.00421696482f, 0.00365174119f, 0.00316227763f, 0.00273841969f, 0.00237137359f, 0.00205352483f, 0.00177827943f, 0.00153992651f, 0.00133352145f, 0.0011547819f, 0.00100000005f, 0.000865964335f, 0.000749894243f, 0.000649381662f, 0.000562341302f, 0.000486967532f, 0.000421696517f, 0.000365174143f, 0.000316227757f, 0.000273841957f, 0.00023713737f, 0.00020535251f, 0.00017782794f, 0.000153992645f, 0.00013335215f, 0.0001154782f};

DI unsigned pack2(float a, float b) {
  typedef float f2 __attribute__((ext_vector_type(2)));
  typedef __bf16 b2 __attribute__((ext_vector_type(2)));
  f2 v = {a, b};
  b2 r = __builtin_convertvector(v, b2);
  return __builtin_bit_cast(unsigned, r);
}
DI float bflo(unsigned u) { return __uint_as_float(u << 16); }
DI float bfhi(unsigned u) { return __uint_as_float(u & 0xffff0000u); }
DI void st_bf4(bfr* p, float a, float b, float c, float d) {
  uint2 v; v.x = pack2(a, b); v.y = pack2(c, d);
  *(uint2*)p = v;
}
DI float wave_sum(float v) {
#pragma unroll
  for (int o = 32; o > 0; o >>= 1) v += __shfl_xor(v, o);
  return v;
}
DI float sigmoidf_(float x) { return 1.f / (1.f + __expf(-x)); }
DI int crow(int i, int h) { return (i & 3) + 8 * (i >> 2) + 4 * h; }
DI bf16x8 pack8(const f32x16& x, int s) {
  unsigned a = pack2(x[8 * s], x[8 * s + 1]), b = pack2(x[8 * s + 2], x[8 * s + 3]), c = pack2(x[8 * s + 4], x[8 * s + 5]),
           d = pack2(x[8 * s + 6], x[8 * s + 7]);
  typedef unsigned u4 __attribute__((ext_vector_type(4)));
  u4 v = {a, b, c, d};
  return __builtin_bit_cast(bf16x8, v);
}
DI s16x4 tr_read(const bfr* p) {
  return __builtin_amdgcn_ds_read_tr16_b64_v4i16((__attribute__((address_space(3))) s16x4*)(p));
}

struct TJob { const float* src; bfr* dst; int K, N, ntn, perm; };
DI TJob get_tjob(const Params& p, int j) {
  TJob t;
  char* ws = p.ws;
  switch (j) {
    case 0: t = {p.w_in, (bfr*)(ws + OFF_WINT), 2048, 15408, 244, 1}; break;
    case 1: t = {p.w1k, (bfr*)(ws + OFF_W1T), 4096, 1024, 16, 0}; break;
    case 2: t = {p.w1v, (bfr*)(ws + OFF_W1T) + (size_t)1024 * 4096, 4096, 1024, 16, 0}; break;
    case 3: t = {p.w2k, (bfr*)(ws + OFF_W2T), 1024, 128, 2, 0}; break;
    case 4: t = {p.w2v, (bfr*)(ws + OFF_W2T) + (size_t)128 * 1024, 1024, 128, 2, 0}; break;
    case 5: t = {p.w_a, (bfr*)(ws + OFF_WAT), 2048, 2048, 32, 0}; break;
    case 6: t = {p.w_b, (bfr*)(ws + OFF_WBT), 2048, 2048, 32, 0}; break;
    case 7: t = {p.w_out, (bfr*)(ws + OFF_WOUTT), 2048, 2048, 32, 0}; break;
    case 8: t = {p.wq, (bfr*)(ws + OFF_WQT), 2048, 512, 8, 0}; break;
    case 9: t = {p.wk, (bfr*)(ws + OFF_WKT), 2048, 512, 8, 0}; break;
    case 10: t = {p.wv, (bfr*)(ws + OFF_WVT), 2048, 512, 8, 0}; break;
    case 11: t = {p.wo, (bfr*)(ws + OFF_WOT), 512, 2048, 32, 0}; break;
    case 12: t = {p.w_up, (bfr*)(ws + OFF_WUPT), 2048, 8192, 128, 0}; break;
    default: t = {p.w_down, (bfr*)(ws + OFF_WDOWNT), 8192, 2048, 32, 0}; break;
  }
  return t;
}
DI int tjob_tiles(int j) {
  switch (j) {
    case 0: return 244 * 16;
    case 1: case 2: return 16 * 32;
    case 3: case 4: return 2 * 8;
    case 5: case 6: case 7: return 32 * 16;
    case 8: case 9: case 10: return 8 * 16;
    case 11: return 32 * 4;
    case 12: return 128 * 16;
    default: return 32 * 64;
  }
}
struct TrRegs { float4 v[4]; };
DI void tr_load(const TJob& t, int tile, TrRegs& rg, const int tid) {
  const int nkt = t.K >> 7;
  const int kt = tile % nkt, nt = tile / nkt;
  const int k0 = kt * 128, d0 = nt * 64;
  int scol0 = d0, nvalid = 64;
  if (t.perm) {
    if (d0 < 5120) scol0 = d0;
    else if (d0 < 15360) scol0 = d0 + 48;
    else { scol0 = d0 - 15360 + 5120; nvalid = (d0 == 15360) ? 48 : 0; }
  }
#pragma unroll
  for (int i = 0; i < 4; ++i) {
    const int row = i * 32 + (tid >> 4), col = (tid & 15) * 4;
    rg.v[i] = make_float4(0.f, 0.f, 0.f, 0.f);
    if (col < nvalid) rg.v[i] = *(const float4*)(t.src + (size_t)(k0 + row) * t.N + scol0 + col);
  }
}
DI void tr_to_lds(const TrRegs& rg, float* sm, const int tid) {
#pragma unroll
  for (int i = 0; i < 4; ++i) {
    const int row = i * 32 + (tid >> 4), col = (tid & 15) * 4;
    float* d = sm + row * 65 + col;
    d[0] = rg.v[i].x; d[1] = rg.v[i].y; d[2] = rg.v[i].z; d[3] = rg.v[i].w;
  }
}
DI void tr_store(const TJob& t, int tile, const float* sm, const int tid) {
  const int nkt = t.K >> 7;
  const int kt = tile % nkt, nt = tile / nkt;
  const int k0 = kt * 128, d0 = nt * 64;
  const int n = tid >> 3, ks = (tid & 7) * 16;
  unsigned o[8];
#pragma unroll
  for (int j = 0; j < 8; ++j) o[j] = pack2(sm[(ks + 2 * j) * 65 + n], sm[(ks + 2 * j + 1) * 65 + n]);
  uint4* d = (uint4*)(t.dst + (size_t)(d0 + n) * t.K + k0 + ks);
  d[0] = make_uint4(o[0], o[1], o[2], o[3]);
  d[1] = make_uint4(o[4], o[5], o[6], o[7]);
}
DI void tr_decode(int it, int j_lo, int& j, int& rem) {
  j = j_lo; rem = it;
  while (rem >= tjob_tiles(j)) { rem -= tjob_tiles(j); ++j; }
}
DI void tr_run(const Params& p, int j_lo, int it0, int stride, int n_tiles, float* sm, const int tid) {
  if (it0 >= n_tiles) return;
  TrRegs rg;
  int j, rem;
  tr_decode(it0, j_lo, j, rem);
  TJob t = get_tjob(p, j);
  tr_load(t, rem, rg, tid);
  for (int it = it0; it < n_tiles; it += stride) {
    __syncthreads();
    tr_to_lds(rg, sm, tid);
    __syncthreads();
    const TJob tc = t;
    const int remc = rem;
    const int nx = it + stride;
    if (nx < n_tiles) {
      tr_decode(nx, j_lo, j, rem);
      t = get_tjob(p, j);
      tr_load(t, rem, rg, tid);
    }
    tr_store(tc, remc, sm, tid);
  }
  __syncthreads();
}

DI void rmsnorm_row(const float* xrow, const float* w, bfr* obf, float* of32, const int tid) {
  const int lane = tid & 63;
  float4 v[8];
  float ss = 0.f;
#pragma unroll
  for (int i = 0; i < 8; ++i) {
    v[i] = ((const float4*)xrow)[lane + 64 * i];
    ss += v[i].x * v[i].x + v[i].y * v[i].y + v[i].z * v[i].z + v[i].w * v[i].w;
  }
  ss = wave_sum(ss);
  const float rs = rsqrtf(ss * (1.f / 2048.f) + 1e-6f);
#pragma unroll
  for (int i = 0; i < 8; ++i) {
    const float4 ww = ((const float4*)w)[lane + 64 * i];
    const float a = v[i].x * rs * ww.x, b = v[i].y * rs * ww.y, c = v[i].z * rs * ww.z, d = v[i].w * rs * ww.w;
    if (obf) st_bf4(obf + (lane + 64 * i) * 4, a, b, c, d);
    else ((float4*)of32)[lane + 64 * i] = make_float4(a, b, c, d);
  }
}

struct PlainPtr {
  const bfr* base; int ld;
  DI int rowoff(int row) const { return row * ld; }
  DI int koff(int k0) const { return k0; }
};
#define WAIT_V(n) asm volatile("s_waitcnt vmcnt(%0)" ::"n"(n) : "memory")
#define WAIT_L(n) asm volatile("s_waitcnt lgkmcnt(%0)" ::"n"(n) : "memory")
#define RAW_BARRIER() do { WAIT_L(0); __builtin_amdgcn_s_barrier(); } while (0)
typedef __attribute__((address_space(3))) unsigned lds_u32;
constexpr int STAGE_B = 65536;
template <int NI, class AF, class BF>
DI void gemm_main(f32x16 (&acc)[NI][4], const AF& af, const BF& bf, int nk, char* smem, const int tid) {
  const int lane = tid & 63, r = lane & 31, h = lane >> 5;
  const int w = __builtin_amdgcn_readfirstlane(tid >> 6);
  const int wm = w & 1, wn = w >> 1;
  int ao[4], bo[2 * NI];
  {
    const int rl = lane >> 3, kc = (lane & 7) ^ (((w & 1) * 4 + (lane >> 4)) & 7);
#pragma unroll
    for (int i = 0; i < 4; ++i) ao[i] = af.rowoff((w + 8 * i) * 8 + rl) + 8 * kc;
#pragma unroll
    for (int i = 0; i < 2 * NI; ++i) bo[i] = bf.rowoff((w + 8 * i) * 8 + rl) + 8 * kc;
  }
  auto stage = [&](int buf, int kt) {
    const int ka = af.koff(kt * 64), kb = bf.koff(kt * 64);
    char* sbase = smem + buf * STAGE_B + w * 1024;
#pragma unroll
    for (int i = 0; i < 4; ++i)
      __builtin_amdgcn_global_load_lds((const unsigned*)(af.base + (ao[i] + ka)), (lds_u32*)(sbase + i * 8192), 16, 0, 0);
#pragma unroll
    for (int i = 0; i < 2 * NI; ++i)
      __builtin_amdgcn_global_load_lds((const unsigned*)(bf.base + (bo[i] + kb)), (lds_u32*)(sbase + 32768 + i * 8192), 16, 0, 0);
  };
  const int xr = (r >> 1) & 7;
  const int arow = (wm * 128 + r) * 128, brow = 32768 + (wn * 32 * NI + r) * 128;
  WAIT_V(0);
  __syncthreads();
  stage(0, 0);
  WAIT_V(0);
  RAW_BARRIER();
#pragma unroll 1
  for (int kt = 0; kt < nk; ++kt) {
    if (kt + 1 < nk) stage((kt + 1) & 1, kt + 1);
    const char* sb = smem + (kt & 1) * STAGE_B;
#pragma unroll
    for (int ks = 0; ks < 4; ++ks) {
      const int off = ((2 * ks + h) ^ xr) * 16;
      bf16x8 wf[NI], xf[4];
#pragma unroll
      for (int i = 0; i < NI; ++i) wf[i] = *(const bf16x8*)(sb + brow + i * 4096 + off);
#pragma unroll
      for (int i = 0; i < 4; ++i) xf[i] = *(const bf16x8*)(sb + arow + i * 4096 + off);
#pragma unroll
      for (int mi = 0; mi < 4; ++mi)
#pragma unroll
        for (int ni = 0; ni < NI; ++ni) acc[ni][mi] = MFMA(wf[ni], xf[mi], acc[ni][mi]);
    }
    WAIT_V(0);
    RAW_BARRIER();
  }
}
template <int NI>
DI void acc_zero(f32x16 (&acc)[NI][4]) {
#pragma unroll
  for (int a = 0; a < NI; ++a)
#pragma unroll
    for (int b = 0; b < 4; ++b)
#pragma unroll
      for (int i = 0; i < 16; ++i) acc[a][b][i] = 0.f;
}
template <int NI, class EPI>
DI void gemm_epi(const f32x16 (&acc)[NI][4], int m0, int n0, const int tid_in, const EPI& epi) {
  int tid = tid_in;
  asm volatile("" : "+v"(tid));
  const int lane = tid & 63, w = tid >> 6, r = lane & 31, h = lane >> 5;
  const int wm = w & 1, wn = w >> 1;
#pragma unroll
  for (int mi = 0; mi < 4; ++mi)
#pragma unroll
    for (int ni = 0; ni < NI; ++ni)
#pragma unroll
      for (int g = 0; g < 4; ++g) {
        const int n = n0 + wn * 32 * NI + ni * 32 + 8 * g + 4 * h;
        const int m = m0 + wm * 128 + mi * 32 + r;
        epi(m, n, acc[ni][mi][4 * g], acc[ni][mi][4 * g + 1], acc[ni][mi][4 * g + 2], acc[ni][mi][4 * g + 3]);
      }
}
DI void map_tile32(int v, int& mt, int& nt) {
  const int xcd = v & 7, j = v >> 3;
  nt = j >> 2;
  mt = xcd * 4 + (j & 3);
}

enum { MODE_WIN = 0, MODE_SEL = 1, MODE_X = 2, MODE_RET = 3 };
constexpr int KP = 136;

template <int MODE>
DI void attn_item(const Params& p, int item, char* smem, const int tid) {
  constexpr int VP = 136;
  bfr* Ks = (bfr*)smem;
  bfr* Vs = Ks + 64 * KP;
  const int w = tid >> 6, lane = tid & 63, r = lane & 31, h = lane >> 5;
  bfr* Qw = Vs + 64 * VP + w * 32 * KP;
  char* ws = p.ws;
  const bfr* z = (const bfr*)(ws + OFF_Z);

  int b, t0, tq0, jlo, jhi, head = 0, grp = 0, vh = 0;
  const bfr *qbase, *kbase, *vbase;
  int ldq, ldk;
  unsigned selm = 0, umask = 0xffffffffu;
  if (MODE == MODE_WIN) {
    const int tb = item >> 4, bg = item & 15;
    b = bg >> 2; grp = bg & 3; t0 = tb * 64; tq0 = t0 + 32 * (w >> 2); head = grp * 4 + (w & 3);
    qbase = z + (size_t)(b * SEQ + tq0) * ZS + ZC_Q + head * 128; ldq = ZS;
    kbase = z + (size_t)(b * SEQ) * ZS + ZC_KW + grp * 128;
    vbase = z + (size_t)(b * SEQ) * ZS + ZC_VW + grp * 128;
    ldk = ZS;
    jlo = (t0 - 511 > 0 ? t0 - 511 : 0) >> 6;
    jhi = tb;
  } else if (MODE == MODE_SEL) {
    const int tb = 31 - (item >> 4), bg = item & 15;
    b = bg >> 2; grp = bg & 3; t0 = tb * 64; tq0 = t0 + 32 * (w >> 2); head = grp * 4 + (w & 3);
    qbase = z + (size_t)(b * SEQ + tq0) * ZS + ZC_Q + head * 128; ldq = ZS;
    kbase = z + (size_t)(b * SEQ) * ZS + ZC_KS + grp * 128;
    vbase = z + (size_t)(b * SEQ) * ZS + ZC_VS + grp * 128;
    ldk = ZS;
    jlo = 0;
    jhi = tb;
    const unsigned* sm = (const unsigned*)(ws + OFF_SELM) + (b * 4 + grp) * SEQ;
    selm = sm[tq0 + r];
    unsigned u = sm[t0 + lane];
#pragma unroll
    for (int o = 32; o > 0; o >>= 1) u |= (unsigned)__shfl_xor((int)u, o);
    umask = (unsigned)__builtin_amdgcn_readfirstlane((int)u);
    umask &= (jhi >= 31) ? 0xffffffffu : ((1u << (jhi + 1)) - 1u);
  } else if (MODE == MODE_X) {
    const int tb = item >> 4, bh = item & 15;
    b = bh >> 2; head = bh & 3; t0 = tb * 256; tq0 = t0 + 32 * w;
    qbase = (const bfr*)(ws + OFF_QX) + (size_t)(b * SEQ + tq0) * 512 + head * 128; ldq = 512;
    kbase = (const bfr*)(ws + OFF_KX) + (size_t)(b * 256) * 512 + head * 128;
    vbase = (const bfr*)(ws + OFF_VX) + (size_t)(b * 256) * 512 + head * 128;
    ldk = 512;
    jlo = 0; jhi = 3;
  } else {
    const int tb = 7 - (item >> 6), rest = item & 63;
    b = rest >> 4; head = (rest >> 1) & 7; vh = rest & 1; t0 = tb * 256; tq0 = t0 + 32 * w;
    qbase = z + (size_t)(b * SEQ + tq0) * ZS + ZC_QR + head * 128; ldq = ZS;
    kbase = z + (size_t)(b * SEQ) * ZS + ZC_KR + head * 128;
    vbase = z + (size_t)(b * SEQ) * ZS + ZC_VR + head * 256 + vh * 128;
    ldk = ZS;
    jlo = 0; jhi = 4 * tb + 3;
  }
  const int tq = tq0 + r;

  f32x16 o[4];
#pragma unroll
  for (int dt = 0; dt < 4; ++dt)
#pragma unroll
    for (int i = 0; i < 16; ++i) o[dt][i] = 0.f;
  float m_run = -INFINITY, l_run = 0.f;
  float lg = 0.f;
  float rf[16];
  if (MODE == MODE_RET) {
    lg = log1pf(-exp2f(-5.f - (float)head)) * 1.4426950408889634f;
#pragma unroll
    for (int i = 0; i < 16; ++i) rf[i] = __builtin_amdgcn_exp2f(-lg * (float)crow(i, h));
  }

  u32x4 kreg[2], vreg[2];
  auto gload = [&](int j) {
    const int k0 = j * 64;
#pragma unroll
    for (int i = 0; i < 2; ++i) {
      const int c = tid + 512 * i, row = c >> 4, cc = c & 15;
      kreg[i] = *(const u32x4*)(kbase + (size_t)(k0 + row) * ldk + cc * 8);
      vreg[i] = *(const u32x4*)(vbase + (size_t)(k0 + row) * ldk + cc * 8);
    }
  };
  auto swrite = [&]() {
#pragma unroll
    for (int i = 0; i < 2; ++i) {
      const int c = tid + 512 * i, row = c >> 4, cc = c & 15;
      *(u32x4*)(Ks + row * KP + cc * 8) = kreg[i];
      *(u32x4*)(Vs + row * VP + cc * 8) = vreg[i];
    }
  };
  auto next_j = [&](int j) -> int {
    if (MODE == MODE_SEL) {
      const unsigned rem = (j >= 31) ? 0u : (umask & ~((2u << j) - 1u));
      return rem ? (__builtin_ctz(rem)) : 64;
    }
    return j + 1;
  };
  int j = jlo;
  if (MODE == MODE_SEL) j = __builtin_ctz(umask);
  gload(j);
  __syncthreads();
  {
    u32x4 qreg[8];
#pragma unroll
    for (int i = 0; i < 8; ++i) {
      const int c = lane + 64 * i, row = c >> 4, cc = c & 15;
      qreg[i] = *(const u32x4*)(qbase + (size_t)row * ldq + cc * 8);
    }
#pragma unroll
    for (int i = 0; i < 8; ++i) {
      const int c = lane + 64 * i, row = c >> 4, cc = c & 15;
      *(u32x4*)(Qw + row * KP + cc * 8) = qreg[i];
    }
  }
  const float csc = 0.08838834764831845f * 1.4426950408889634f;
  const int q4 = (lane & 15) >> 2, p4 = lane & 3, blk = (lane >> 4) & 1;
  bool first = true;
#pragma unroll 1
  while (j <= jhi) {
    if (!first) __syncthreads();
    first = false;
    swrite();
    __syncthreads();
    const int jn = next_j(j);
    if (jn <= jhi) gload(jn);
    const int k0 = j * 64;
    if (MODE == MODE_RET && k0 > tq0 + 31) { j = jn; continue; }
    bf16x8 pf[2][2];
    if (MODE == MODE_RET) {
#pragma unroll
      for (int sub = 0; sub < 2; ++sub) {
        f32x16 sx;
#pragma unroll
        for (int i = 0; i < 16; ++i) sx[i] = 0.f;
#pragma unroll
        for (int s = 0; s < 8; ++s) {
          const bf16x8 kf = *(const bf16x8*)(Ks + (32 * sub + r) * KP + 16 * s + 8 * h);
          const bf16x8 qf = *(const bf16x8*)(Qw + r * KP + 16 * s + 8 * h);
          sx = MFMA(kf, qf, sx);
        }
        {
          const int dq = tq - (k0 + 32 * sub);
          const float cf = __builtin_amdgcn_exp2f(lg * (float)dq);
#pragma unroll
          for (int i = 0; i < 16; ++i) sx[i] = (crow(i, h) <= dq) ? sx[i] * (cf * rf[i]) : 0.f;
        }
        pf[sub][0] = pack8(sx, 0);
        pf[sub][1] = pack8(sx, 1);
      }
    } else {
      f32x16 s0, s1;
#pragma unroll
      for (int i = 0; i < 16; ++i) { s0[i] = 0.f; s1[i] = 0.f; }
#pragma unroll
      for (int s = 0; s < 8; ++s) {
        const bf16x8 k0f = *(const bf16x8*)(Ks + r * KP + 16 * s + 8 * h);
        const bf16x8 k1f = *(const bf16x8*)(Ks + (32 + r) * KP + 16 * s + 8 * h);
        const bf16x8 qf = *(const bf16x8*)(Qw + r * KP + 16 * s + 8 * h);
        s0 = MFMA(k0f, qf, s0);
        s1 = MFMA(k1f, qf, s1);
      }
      bool need_mask = false;
      if (MODE == MODE_WIN) need_mask = (k0 + 63 > tq0) || (k0 < tq0 + 31 - 511);
      if (MODE == MODE_SEL) need_mask = (k0 + 63 > tq0);
      const bool lanesel = (MODE == MODE_SEL) ? ((selm >> j) & 1u) : true;
      float mx = -INFINITY;
      if (need_mask) {
#pragma unroll
        for (int i = 0; i < 16; ++i) {
          const int tk0 = k0 + crow(i, h), tk1 = tk0 + 32;
          bool ok0 = true, ok1 = true;
          if (MODE == MODE_WIN) { ok0 = (tk0 <= tq) && (tq - tk0 < 512); ok1 = (tk1 <= tq) && (tq - tk1 < 512); }
          if (MODE == MODE_SEL) { ok0 = lanesel && (tk0 <= tq); ok1 = lanesel && (tk1 <= tq); }
          s0[i] = ok0 ? s0[i] * csc : -INFINITY;
          s1[i] = ok1 ? s1[i] * csc : -INFINITY;
          mx = fmaxf(mx, fmaxf(s0[i], s1[i]));
        }
      } else {
#pragma unroll
        for (int i = 0; i < 16; ++i) {
          s0[i] = lanesel ? s0[i] * csc : -INFINITY;
          s1[i] = lanesel ? s1[i] * csc : -INFINITY;
          mx = fmaxf(mx, fmaxf(s0[i], s1[i]));
        }
      }
      mx = fmaxf(mx, __shfl_xor(mx, 32));
      const float mnew = fmaxf(m_run, mx);
      const float muse = (mnew == -INFINITY) ? 0.f : mnew;
      const float alpha = __builtin_amdgcn_exp2f(m_run - muse);
      float ls = 0.f;
#pragma unroll
      for (int i = 0; i < 16; ++i) {
        s0[i] = __builtin_amdgcn_exp2f(s0[i] - muse);
        s1[i] = __builtin_amdgcn_exp2f(s1[i] - muse);
        ls += s0[i] + s1[i];
      }
      ls += __shfl_xor(ls, 32);
      l_run = l_run * alpha + ls;
      m_run = mnew;
      if (__builtin_amdgcn_ballot_w64(alpha != 1.f) != 0) {
#pragma unroll
        for (int dt = 0; dt < 4; ++dt)
#pragma unroll
          for (int i = 0; i < 16; ++i) o[dt][i] *= alpha;
      }
      pf[0][0] = pack8(s0, 0); pf[0][1] = pack8(s0, 1);
      pf[1][0] = pack8(s1, 0); pf[1][1] = pack8(s1, 1);
    }
#pragma unroll
    for (int dt = 0; dt < 4; ++dt)
#pragma unroll
      for (int sub = 0; sub < 2; ++sub)
#pragma unroll
        for (int st = 0; st < 2; ++st) {
          const int key0 = 32 * sub + 16 * st + 4 * h;
          const bfr* vp = Vs + (key0 + q4) * VP + 32 * dt + 16 * blk + 4 * p4;
          const s16x4 lo = tr_read(vp);
          const s16x4 hi = tr_read(vp + 8 * VP);
          const bf16x8 vf = __builtin_shufflevector(lo, hi, 0, 1, 2, 3, 4, 5, 6, 7);
          o[dt] = MFMA(vf, pf[sub][st], o[dt]);
        }
    j = jn;
  }

  if (MODE == MODE_SEL && p.dbg) return;
  const size_t mrow = (size_t)(b * SEQ + tq);
  if (MODE == MODE_WIN || MODE == MODE_SEL) {
    const float inv = (l_run > 0.f) ? 1.f / l_run : 0.f;
    const float gate = bflo(z[mrow * ZS + ZC_GN + head * 3 + (MODE == MODE_WIN ? 2 : 1)]);
    bfr* orow = (bfr*)(ws + OFF_ONSA) + mrow * 2048 + head * 128;
    const float sc = inv * gate;
#pragma unroll
    for (int dt = 0; dt < 4; ++dt)
#pragma unroll
      for (int g = 0; g < 4; ++g) {
        bfr* dst = orow + 32 * dt + 8 * g + 4 * h;
        float a = o[dt][4 * g] * sc, bb = o[dt][4 * g + 1] * sc, c = o[dt][4 * g + 2] * sc, d = o[dt][4 * g + 3] * sc;
        if (MODE == MODE_SEL) {
          const uint2 old = *(const uint2*)dst;
          a += bflo(old.x); bb += bfhi(old.x); c += bflo(old.y); d += bfhi(old.y);
        }
        st_bf4(dst, a, bb, c, d);
      }
  } else if (MODE == MODE_X) {
    const float inv = 1.f / l_run;
    bfr* orow = (bfr*)(ws + OFF_OX) + mrow * 512 + head * 128;
#pragma unroll
    for (int dt = 0; dt < 4; ++dt)
#pragma unroll
      for (int g = 0; g < 4; ++g)
        st_bf4(orow + 32 * dt + 8 * g + 4 * h, o[dt][4 * g] * inv, o[dt][4 * g + 1] * inv, o[dt][4 * g + 2] * inv,
               o[dt][4 * g + 3] * inv);
  } else {
    float sm = 0.f, sq = 0.f;
#pragma unroll
    for (int dt = 0; dt < 4; ++dt)
#pragma unroll
      for (int i = 0; i < 16; ++i) { sm += o[dt][i]; sq += o[dt][i] * o[dt][i]; }
    sm += __shfl_xor(sm, 32);
    sq += __shfl_xor(sq, 32);
    if (h == 0) *(float2*)((float*)(ws + OFF_RSTAT) + ((mrow * 8 + head) * 2 + vh) * 2) = make_float2(sm, sq);
    bfr* orow = (bfr*)(ws + OFF_ORET) + mrow * 2048 + head * 256 + vh * 128;
#pragma unroll
    for (int dt = 0; dt < 4; ++dt)
#pragma unroll
      for (int g = 0; g < 4; ++g)
        st_bf4(orow + 32 * dt + 8 * g + 4 * h, o[dt][4 * g], o[dt][4 * g + 1], o[dt][4 * g + 2], o[dt][4 * g + 3]);
  }
}

DI void ret_finish_row(const Params& p, int row, const int t) {
  char* ws = p.ws;
  const bfr* z = (const bfr*)(ws + OFF_Z);
  const int col = t * 8, head = t >> 5;
  const float4 st = *(const float4*)((const float*)(ws + OFF_RSTAT) + ((size_t)row * 8 + head) * 4);
  const float mu = (st.x + st.z) * (1.f / 256.f);
  const float var = fmaxf((st.y + st.w) * (1.f / 256.f) - mu * mu, 0.f);
  const float rstd = rsqrtf(var + 1e-6f);
  bfr* op = (bfr*)(ws + OFF_ORET) + (size_t)row * 2048 + col;
  const u32x4 ov = *(const u32x4*)op;
  const u32x4 gv = *(const u32x4*)(z + (size_t)row * ZS + ZC_GR + col);
  const float4 w0 = *(const float4*)(p.gn_w + col), w1 = *(const float4*)(p.gn_w + col + 4);
  u32x4 res;
  res[0] = pack2((bflo(ov[0]) - mu) * rstd * w0.x * bflo(gv[0]), (bfhi(ov[0]) - mu) * rstd * w0.y * bfhi(gv[0]));
  res[1] = pack2((bflo(ov[1]) - mu) * rstd * w0.z * bflo(gv[1]), (bfhi(ov[1]) - mu) * rstd * w0.w * bfhi(gv[1]));
  res[2] = pack2((bflo(ov[2]) - mu) * rstd * w1.x * bflo(gv[2]), (bfhi(ov[2]) - mu) * rstd * w1.y * bfhi(gv[2]));
  res[3] = pack2((bflo(ov[3]) - mu) * rstd * w1.z * bflo(gv[3]), (bfhi(ov[3]) - mu) * rstd * w1.w * bfhi(gv[3]));
  *(u32x4*)op = res;
}

DI void cmp_item(const Params& p, int item, char* smem, const int tid) {
  bfr* Ks = (bfr*)smem;
  float* impw = (float*)(smem + 128 * KP * 2);
  const int w = tid >> 6, lane = tid & 63, r = lane & 31, h = lane >> 5;
  char* ws = p.ws;
  const bfr* z = (const bfr*)(ws + OFF_Z);
  const int tb = item >> 4, bg = item & 15, b = bg >> 2, grp = bg & 3;
  const int t0 = tb * 64, ti = 32 * (w >> 2) + r, tq = t0 + ti, hw = w & 3, head = grp * 4 + hw;
  const bfr* qrow = z + (size_t)(b * SEQ + tq) * ZS + ZC_Q + head * 128;
  const bfr* kc = (const bfr*)(ws + OFF_KCVC) + (size_t)((b * 4 + grp) * 128) * 128;
  const bfr* vc = kc + (size_t)2048 * 128;
  bf16x8 qf[8];
#pragma unroll
  for (int s = 0; s < 8; ++s) qf[s] = *(const bf16x8*)(qrow + 16 * s + 8 * h);
  u32x4 reg[4];
#pragma unroll
  for (int i = 0; i < 4; ++i) {
    const int c = tid + 512 * i, row = c >> 4, cc = c & 15;
    reg[i] = *(const u32x4*)(kc + row * 128 + cc * 8);
  }
  __syncthreads();
#pragma unroll
  for (int i = 0; i < 4; ++i) {
    const int c = tid + 512 * i, row = c >> 4, cc = c & 15;
    *(u32x4*)(Ks + row * KP + cc * 8) = reg[i];
  }
  __syncthreads();
  f32x16 s[4];
#pragma unroll
  for (int kt = 0; kt < 4; ++kt) {
#pragma unroll
    for (int i = 0; i < 16; ++i) s[kt][i] = 0.f;
#pragma unroll
    for (int ss = 0; ss < 8; ++ss) {
      const bf16x8 kf = *(const bf16x8*)(Ks + (32 * kt + r) * KP + 16 * ss + 8 * h);
      s[kt] = MFMA(kf, qf[ss], s[kt]);
    }
  }
  const float csc = 0.08838834764831845f * 1.4426950408889634f;
  float mx = -INFINITY;
#pragma unroll
  for (int kt = 0; kt < 4; ++kt)
#pragma unroll
    for (int i = 0; i < 16; ++i) {
      const int c = 32 * kt + crow(i, h);
      const bool ok = (c * 16 + 31 <= tq) && (c < 127);
      s[kt][i] = ok ? s[kt][i] * csc : -INFINITY;
      mx = fmaxf(mx, s[kt][i]);
    }
  mx = fmaxf(mx, __shfl_xor(mx, 32));
  const float muse = (mx == -INFINITY) ? 0.f : mx;
  float ls = 0.f;
#pragma unroll
  for (int kt = 0; kt < 4; ++kt)
#pragma unroll
    for (int i = 0; i < 16; ++i) {
      s[kt][i] = __builtin_amdgcn_exp2f(s[kt][i] - muse);
      ls += s[kt][i];
    }
  ls += __shfl_xor(ls, 32);
  const float inv = (ls > 0.f) ? 1.f / ls : 0.f;
#pragma unroll
  for (int kt = 0; kt < 4; ++kt)
#pragma unroll
    for (int i = 0; i < 16; ++i) s[kt][i] *= inv;
  float plast[16];
#pragma unroll
  for (int kt = 0; kt < 4; ++kt)
#pragma unroll
    for (int g = 0; g < 4; ++g) plast[kt * 4 + g] = __shfl_xor(s[kt][4 * g + 3], 32);
#pragma unroll
  for (int kt = 0; kt < 4; ++kt)
#pragma unroll
    for (int g = 0; g < 4; ++g) {
      const int slot = kt * 4 + g;
      const float sum4 = s[kt][4 * g] + s[kt][4 * g + 1] + s[kt][4 * g + 2] + s[kt][4 * g + 3];
      const float prevl = (slot > 0) ? plast[slot > 0 ? slot - 1 : 0] : 0.f;
      const float add = h ? plast[slot] : prevl;
      impw[(hw * 64 + ti) * 32 + 8 * kt + 2 * g + h] = sum4 + add;
    }
  bf16x8 pf[4][2];
#pragma unroll
  for (int kt = 0; kt < 4; ++kt) { pf[kt][0] = pack8(s[kt], 0); pf[kt][1] = pack8(s[kt], 1); }
#pragma unroll
  for (int i = 0; i < 4; ++i) {
    const int c = tid + 512 * i, row = c >> 4, cc = c & 15;
    reg[i] = *(const u32x4*)(vc + row * 128 + cc * 8);
  }
  __syncthreads();
#pragma unroll
  for (int i = 0; i < 4; ++i) {
    const int c = tid + 512 * i, row = c >> 4, cc = c & 15;
    *(u32x4*)(Ks + row * KP + cc * 8) = reg[i];
  }
  __syncthreads();
  f32x16 o[4];
#pragma unroll
  for (int dt = 0; dt < 4; ++dt)
#pragma unroll
    for (int i = 0; i < 16; ++i) o[dt][i] = 0.f;
  const int q4 = (lane & 15) >> 2, p4 = lane & 3, blk = (lane >> 4) & 1;
#pragma unroll
  for (int dt = 0; dt < 4; ++dt)
#pragma unroll
    for (int kt = 0; kt < 4; ++kt)
#pragma unroll
      for (int st = 0; st < 2; ++st) {
        const int key0 = 32 * kt + 16 * st + 4 * h;
        const bfr* vp = Ks + (key0 + q4) * KP + 32 * dt + 16 * blk + 4 * p4;
        const s16x4 lo = tr_read(vp);
        const s16x4 hi = tr_read(vp + 8 * KP);
        const bf16x8 vf = __builtin_shufflevector(lo, hi, 0, 1, 2, 3, 4, 5, 6, 7);
        o[dt] = MFMA(vf, pf[kt][st], o[dt]);
      }
  {
    const size_t mrow = (size_t)(b * SEQ + tq);
    const float gate = bflo(z[mrow * ZS + ZC_GN + head * 3 + 0]);
    bfr* orow = (bfr*)(ws + OFF_ONSA) + mrow * 2048 + head * 128;
#pragma unroll
    for (int dt = 0; dt < 4; ++dt)
#pragma unroll
      for (int g = 0; g < 4; ++g) {
        bfr* dst = orow + 32 * dt + 8 * g + 4 * h;
        const uint2 old = *(const uint2*)dst;
        st_bf4(dst, o[dt][4 * g] * gate + bflo(old.x), o[dt][4 * g + 1] * gate + bfhi(old.x),
               o[dt][4 * g + 2] * gate + bflo(old.y), o[dt][4 * g + 3] * gate + bfhi(old.y));
      }
  }
  {
    const int i = tid >> 3, jg = tid & 7;
    const int cur = (t0 + i) >> 6;
    float vm[4];
#pragma unroll
    for (int e = 0; e < 4; ++e) {
      const int jme = 4 * jg + e;
      const float a = impw[(0 * 64 + i) * 32 + jme] + impw[(1 * 64 + i) * 32 + jme] + impw[(2 * 64 + i) * 32 + jme] + impw[(3 * 64 + i) * 32 + jme];
      const bool forced = (jme == 0) || (jme == cur) || (jme == cur - 1);
      vm[e] = forced ? INFINITY : ((jme > cur) ? -INFINITY : a);
    }
#pragma unroll
    for (int e = 0; e < 4; ++e) impw[i * 32 + 4 * jg + e] = vm[e];
    __syncthreads();
    int rank[4] = {0, 0, 0, 0};
#pragma unroll 4
    for (int k = 0; k < 32; ++k) {
      const float vk = impw[i * 32 + k];
#pragma unroll
      for (int e = 0; e < 4; ++e) rank[e] += (vk > vm[e] || (vk == vm[e] && k < 4 * jg + e)) ? 1 : 0;
    }
    unsigned bits = 0;
#pragma unroll
    for (int e = 0; e < 4; ++e)
      if (rank[e] < 16 && 4 * jg + e <= cur) bits |= 1u << (4 * jg + e);
    bits |= (unsigned)__shfl_xor((int)bits, 1);
    bits |= (unsigned)__shfl_xor((int)bits, 2);
    bits |= (unsigned)__shfl_xor((int)bits, 4);
    if (jg == 0) ((unsigned*)(ws + OFF_SELM))[(b * 4 + grp) * SEQ + t0 + i] = bits;
  }
  __syncthreads();
}

DI int grab(unsigned* ctr, int* slot, const int tid) {
  __syncthreads();
  if (tid == 0) *slot = (int)atomicAdd(ctr, 1u);
  __syncthreads();
  return *slot;
}

DI void run_phase(const Params& p0, int ph, char* smem, int* slot, const int wave_s, const int rep) {
  char* ws = p0.ws;
  asm volatile("" : "+s"(ws));
  Params p = p0;
  p.ws = ws;
  p.dbg = rep;
  const int G = gridDim.x;
  int bid = blockIdx.x;
  int tid = wave_s * 64 + (int)__builtin_amdgcn_mbcnt_hi(~0u, __builtin_amdgcn_mbcnt_lo(~0u, 0u));
  asm volatile("" : "+s"(bid));
  asm volatile("" : "+v"(tid));
  bfr* z = (bfr*)(ws + OFF_Z);
  unsigned* ctr = (unsigned*)(ws + OFF_CTR) + rep * 8;
  switch (ph) {
    case 0: {
      if (bid == 0 && tid < 64) ((unsigned*)(ws + OFF_CTR))[tid] = 0u;
      int tot = 0;
      for (int j = 0; j < 12; ++j) tot += tjob_tiles(j);
      const int n_norm = 1024 + 128, n_rope = 256;
      tr_run(p, 0, bid, G, tot, (float*)smem, tid);
      for (int it = tot + bid; it < tot + n_norm + n_rope; it += G) {
        if (it < tot + n_norm) {
          const int row = (it - tot) * 8 + (tid >> 6);
          if (row < NTOK) rmsnorm_row(p.x + (size_t)row * 2048, p.attn_norm_w, (bfr*)(ws + OFF_N) + (size_t)row * 2048, nullptr, tid);
          else rmsnorm_row(p.mem + (size_t)(row - NTOK) * 2048, p.mem_norm_w, (bfr*)(ws + OFF_MN) + (size_t)(row - NTOK) * 2048, nullptr, tid);
        } else {
          const int e = (it - tot - n_norm) * 512 + tid;
          const int t = e >> 6, i = e & 63;
          const float ang = (float)t * ROPE_INV[i];
          const float kk = rintf(ang * 0.15915494309189535f);
          float rr = fmaf(-kk, 6.2831854820251465f, ang);
          rr = fmaf(-kk, -1.7484555e-7f, rr);
          const float fr = rr * 0.15915494309189535f;
          ((float2*)(ws + OFF_ROPE))[e] = make_float2(__builtin_amdgcn_cosf(fr), __builtin_amdgcn_sinf(fr));
        }
      }
    } break;
    case 1: {
      const int nt_main = 32 * 61;
      for (int v = bid; v < nt_main + 32; v += G) {
        if (v < nt_main) {
          f32x16 acc[2][4];
          acc_zero<2>(acc);
          int mt, nt;
          map_tile32(v, mt, nt);
          const int m0 = mt * 256, n0 = nt * 256;
          PlainPtr af{(const bfr*)(ws + OFF_N) + (size_t)m0 * 2048, 2048};
          PlainPtr bf{(const bfr*)(ws + OFF_WINT) + (size_t)n0 * 2048, 2048};
          gemm_main<2>(acc, af, bf, 32, smem, tid);
          bfr* zcb = (bfr*)(ws + OFF_ZC);
          const float2* rope = (const float2*)(ws + OFF_ROPE);
          gemm_epi<2>(acc, m0, n0, tid, [&](int m, int n, float a, float b, float c, float d) {
            if (n >= ZS) return;
            bfr* dst = z + (size_t)m * ZS + n;
            const int t = m & 2047;
            if (n >= ZC_KC && n < ZC_KS) {
              const float* pe = (n < ZC_VC) ? p.pe_k : p.pe_v;
              const int dd = n & 127;
              const float4 plo = *(const float4*)(pe + (t & 15) * 128 + dd);
              const float4 phi = *(const float4*)(pe + (16 + (t & 15)) * 128 + dd);
              st_bf4(zcb + (size_t)m * 2048 + (n - ZC_KC), a + plo.x, b + plo.y, c + plo.z, d + plo.w);
              st_bf4(zcb + (size_t)m * 2048 + 1024 + (n - ZC_KC), a + phi.x, b + phi.y, c + phi.z, d + phi.w);
            } else if (n >= ZC_QR && n < ZC_VR) {
              const int i0 = (n & 127) >> 1;
              const float2 c0 = rope[t * 64 + i0], c1 = rope[t * 64 + i0 + 1];
              float o0 = a * c0.x - b * c0.y, o1 = a * c0.y + b * c0.x;
              float o2 = c * c1.x - d * c1.y, o3 = c * c1.y + d * c1.x;
              if (n >= ZC_KR) { const float sc = 0.08838834764831845f; o0 *= sc; o1 *= sc; o2 *= sc; o3 *= sc; }
              st_bf4(dst, o0, o1, o2, o3);
            } else if (n >= ZC_GR && n < ZC_GA) {
              st_bf4(dst, a * sigmoidf_(a), b * sigmoidf_(b), c * sigmoidf_(c), d * sigmoidf_(d));
            } else if (n >= ZC_GA) {
              st_bf4(dst, sigmoidf_(a), sigmoidf_(b), sigmoidf_(c), sigmoidf_(d));
            } else {
              st_bf4(dst, a, b, c, d);
            }
          });
        } else {
          f32x16 acc[1][4];
          acc_zero<1>(acc);
          const int u = v - nt_main, which = u >> 4, mt = (u & 15) >> 2, nt = u & 3;
          const int m0 = mt * 256, n0 = nt * 128;
          PlainPtr af{(const bfr*)(ws + OFF_MN) + (size_t)m0 * 2048, 2048};
          PlainPtr bf{(const bfr*)(ws + (which ? OFF_WVT : OFF_WKT)) + (size_t)n0 * 2048, 2048};
          gemm_main<1>(acc, af, bf, 32, smem, tid);
          bfr* dstb = (bfr*)(ws + (which ? OFF_VX : OFF_KX));
          gemm_epi<1>(acc, m0, n0, tid, [&](int m, int n, float a, float b, float c, float d) { st_bf4(dstb + (size_t)m * 512 + n, a, b, c, d); });
        }
      }
    } break;
    case 2: {
      for (int it = grab(ctr + 0, slot, tid); it < 128; it = grab(ctr + 0, slot, tid)) {
        const int which = it >> 6, mt = (it & 63) >> 3, nt = it & 7;
        const int m0 = mt * 256, n0 = nt * 128;
        f32x16 acc[1][4];
        acc_zero<1>(acc);
        struct GatherA {
          const bfr* base; int m0;
          DI int rowoff(int row) const {
            const int R = m0 + row;
            const int bb = R >> 9, g = (R >> 7) & 3;
            int c = R & 127; c = c > 126 ? 126 : c;
            return (bb * SEQ + c * 16) * 2048 + g * 128;
          }
          DI int koff(int kk) const { const int l = kk >> 7; return l * 2048 + ((l >> 4) << 10) + (kk & 127); }
        };
        GatherA af{(const bfr*)(ws + OFF_ZC) + which * 512, m0};
        PlainPtr bf{(const bfr*)(ws + OFF_W1T) + (size_t)which * 1024 * 4096 + (size_t)n0 * 4096, 4096};
        gemm_main<1>(acc, af, bf, 64, smem, tid);
        bfr* hid = (bfr*)(ws + OFF_HIDC) + (size_t)which * 2048 * 1024;
        gemm_epi<1>(acc, m0, n0, tid, [&](int m, int n, float a, float b, float c, float d) {
          st_bf4(hid + (size_t)m * 1024 + n, a * sigmoidf_(a), b * sigmoidf_(b), c * sigmoidf_(c), d * sigmoidf_(d));
        });
      }
      for (int it = grab(ctr + 1, slot, tid); it < 1024; it = grab(ctr + 1, slot, tid)) {
        if (it < 512) attn_item<MODE_RET>(p, it, smem, tid);
        else attn_item<MODE_WIN>(p, it - 512, smem, tid);
      }
    } break;
    case 3: {
      for (int it = bid; it < 16 + NTOK / 2; it += G) {
        if (it >= 16) { ret_finish_row(p, (it - 16) * 2 + (tid >> 8), tid & 255); continue; }
        const int which = it >> 3, mt = it & 7;
        const int m0 = mt * 256;
        f32x16 acc[1][4];
        acc_zero<1>(acc);
        PlainPtr af{(const bfr*)(ws + OFF_HIDC) + (size_t)which * 2048 * 1024 + (size_t)m0 * 1024, 1024};
        PlainPtr bf{(const bfr*)(ws + OFF_W2T) + (size_t)which * 128 * 1024, 1024};
        gemm_main<1>(acc, af, bf, 16, smem, tid);
        bfr* dstb = (bfr*)(ws + OFF_KCVC) + (size_t)which * 2048 * 128;
        gemm_epi<1>(acc, m0, 0, tid, [&](int m, int n, float a, float b, float c, float d) { st_bf4(dstb + (size_t)m * 128 + n, a, b, c, d); });
      }
    } break;
    case 4: {
      for (int it = bid; it < 512; it += G) cmp_item(p, it, smem, tid);
    } break;
    case 5: {
      for (int it = grab(ctr + 2, slot, tid); it < 512; it = grab(ctr + 2, slot, tid)) attn_item<MODE_SEL>(p, it, smem, tid);
    } break;
    case 6: {
      for (int v = bid; v < 32 * 8; v += G) {
        int mt, nt;
        map_tile32(v, mt, nt);
        const int m0 = mt * 256, n0 = nt * 256;
        f32x16 acc[2][4];
        acc_zero<2>(acc);
        bfr* mg = (bfr*)(ws + OFF_MERGED);
        {
          PlainPtr af{(const bfr*)(ws + OFF_ONSA) + (size_t)m0 * 2048, 2048};
          PlainPtr bf{(const bfr*)(ws + OFF_WAT) + (size_t)n0 * 2048, 2048};
          gemm_main<2>(acc, af, bf, 32, smem, tid);
          gemm_epi<2>(acc, m0, n0, tid, [&](int m, int n, float a, float b, float c, float d) {
            const uint2 ga = *(const uint2*)(z + (size_t)m * ZS + ZC_GA + n);
            st_bf4(mg + (size_t)m * 2048 + n, bflo(ga.x) * a, bfhi(ga.x) * b, bflo(ga.y) * c, bfhi(ga.y) * d);
          });
        }
        acc_zero<2>(acc);
        {
          PlainPtr af{(const bfr*)(ws + OFF_ORET) + (size_t)m0 * 2048, 2048};
          PlainPtr bf{(const bfr*)(ws + OFF_WBT) + (size_t)n0 * 2048, 2048};
          gemm_main<2>(acc, af, bf, 32, smem, tid);
          gemm_epi<2>(acc, m0, n0, tid, [&](int m, int n, float a, float b, float c, float d) {
            const uint2 gb = *(const uint2*)(z + (size_t)m * ZS + ZC_GB + n);
            bfr* dst = mg + (size_t)m * 2048 + n;
            const uint2 old = *(const uint2*)dst;
            st_bf4(dst, bflo(old.x) + bflo(gb.x) * a, bfhi(old.x) + bfhi(gb.x) * b, bflo(old.y) + bflo(gb.y) * c, bfhi(old.y) + bfhi(gb.y) * d);
          });
        }
      }
    } break;
    case 7: {
      for (int v = bid; v < 32 * 8; v += G) {
        int mt, nt;
        map_tile32(v, mt, nt);
        const int m0 = mt * 256, n0 = nt * 256;
        f32x16 acc[2][4];
        acc_zero<2>(acc);
        PlainPtr af{(const bfr*)(ws + OFF_MERGED) + (size_t)m0 * 2048, 2048};
        PlainPtr bf{(const bfr*)(ws + OFF_WOUTT) + (size_t)n0 * 2048, 2048};
        gemm_main<2>(acc, af, bf, 32, smem, tid);
        float* hbuf = (float*)(ws + OFF_H);
        gemm_epi<2>(acc, m0, n0, tid, [&](int m, int n, float a, float b, float c, float d) {
          const float4 xv = *(const float4*)(p.x + (size_t)m * 2048 + n);
          *(float4*)(hbuf + (size_t)m * 2048 + n) = make_float4(xv.x + a, xv.y + b, xv.z + c, xv.w + d);
        });
      }
    } break;
    case 8: case 12: {
      const float* w = (ph == 8) ? p.x_norm_w : p.mlp_norm_w;
      for (int it = bid; it < 1024; it += G) {
        const int row = it * 8 + (tid >> 6);
        rmsnorm_row((const float*)(ws + OFF_H) + (size_t)row * 2048, w, (bfr*)(ws + OFF_NX) + (size_t)row * 2048, nullptr, tid);
      }
    } break;
    case 9: {
      const int ng = (G > 128) ? 128 : G;
      if (G > 128) { if (bid >= 128) tr_run(p, 12, bid - 128, G - 128, tjob_tiles(12), (float*)smem, tid); }
      else tr_run(p, 12, bid, G, tjob_tiles(12), (float*)smem, tid);
      if (bid < ng)
      for (int v = bid; v < 32 * 4; v += ng) {
        int mt, nt;
        map_tile32(v, mt, nt);
        const int m0 = mt * 256, n0 = nt * 128;
        f32x16 acc[1][4];
        acc_zero<1>(acc);
        PlainPtr af{(const bfr*)(ws + OFF_NX) + (size_t)m0 * 2048, 2048};
        PlainPtr bf{(const bfr*)(ws + OFF_WQT) + (size_t)n0 * 2048, 2048};
        gemm_main<1>(acc, af, bf, 32, smem, tid);
        bfr* qx = (bfr*)(ws + OFF_QX);
        gemm_epi<1>(acc, m0, n0, tid, [&](int m, int n, float a, float b, float c, float d) { st_bf4(qx + (size_t)m * 512 + n, a, b, c, d); });
      }
    } break;
    case 10: {
      const int ng = (G > 128) ? 128 : G;
      if (G > 128) { if (bid >= 128) tr_run(p, 13, bid - 128, G - 128, tjob_tiles(13), (float*)smem, tid); }
      else tr_run(p, 13, bid, G, tjob_tiles(13), (float*)smem, tid);
      if (bid < ng)
        for (int it = bid; it < 128; it += ng) attn_item<MODE_X>(p, it, smem, tid);
    } break;
    case 11: {
      for (int v = bid; v < 32 * 8; v += G) {
        int mt, nt;
        map_tile32(v, mt, nt);
        const int m0 = mt * 256, n0 = nt * 256;
        f32x16 acc[2][4];
        acc_zero<2>(acc);
        PlainPtr af{(const bfr*)(ws + OFF_OX) + (size_t)m0 * 512, 512};
        PlainPtr bf{(const bfr*)(ws + OFF_WOT) + (size_t)n0 * 512, 512};
        gemm_main<2>(acc, af, bf, 8, smem, tid);
        float* hbuf = (float*)(ws + OFF_H);
        gemm_epi<2>(acc, m0, n0, tid, [&](int m, int n, float a, float b, float c, float d) {
          float4* hp = (float4*)(hbuf + (size_t)m * 2048 + n);
          const float4 xv = *hp;
          *hp = make_float4(xv.x + a, xv.y + b, xv.z + c, xv.w + d);
        });
      }
    } break;
    case 13: {
      for (int v = bid; v < 32 * 32; v += G) {
        int mt, nt;
        map_tile32(v, mt, nt);
        const int m0 = mt * 256, n0 = nt * 256;
        f32x16 acc[2][4];
        acc_zero<2>(acc);
        PlainPtr af{(const bfr*)(ws + OFF_NX) + (size_t)m0 * 2048, 2048};
        PlainPtr bf{(const bfr*)(ws + OFF_WUPT) + (size_t)n0 * 2048, 2048};
        gemm_main<2>(acc, af, bf, 32, smem, tid);
        bfr* hid = (bfr*)(ws + OFF_HID);
        gemm_epi<2>(acc, m0, n0, tid, [&](int m, int n, float a, float b, float c, float d) {
          a = fmaxf(a, 0.f); b = fmaxf(b, 0.f); c = fmaxf(c, 0.f); d = fmaxf(d, 0.f);
          st_bf4(hid + (size_t)m * 8192 + n, a * a, b * b, c * c, d * d);
        });
      }
    } break;
    case 14: {
      for (int v = bid; v < 32 * 8; v += G) {
        int mt, nt;
        map_tile32(v, mt, nt);
        const int m0 = mt * 256, n0 = nt * 256;
        f32x16 acc[2][4];
        acc_zero<2>(acc);
        PlainPtr af{(const bfr*)(ws + OFF_HID) + (size_t)m0 * 8192, 8192};
        PlainPtr bf{(const bfr*)(ws + OFF_WDOWNT) + (size_t)n0 * 8192, 8192};
        gemm_main<2>(acc, af, bf, 128, smem, tid);
        const float* hbuf = (const float*)(ws + OFF_H);
        gemm_epi<2>(acc, m0, n0, tid, [&](int m, int n, float a, float b, float c, float d) {
          const float4 xv = *(const float4*)(hbuf + (size_t)m * 2048 + n);
          *(float4*)(p.out + (size_t)m * 2048 + n) = make_float4(xv.x + a, xv.y + b, xv.z + c, xv.w + d);
        });
      }
    } break;
    case 15: {
      for (int it = bid; it < 1024; it += G) {
        const int row = it * 8 + (tid >> 6);
        rmsnorm_row(p.out + (size_t)row * 2048, p.final_norm_w, nullptr, p.out + (size_t)row * 2048, tid);
      }
    } break;
    default: break;
  }
}

__global__ void __launch_bounds__(512, 2) mega(Params p) {
  extern __shared__ __attribute__((aligned(1024))) char smem[];
  __shared__ int slot;
  cg::grid_group grid = cg::this_grid();
  const int wave_s = __builtin_amdgcn_readfirstlane((int)(threadIdx.x >> 6));
  for (int ph = p.ph_lo; ph < p.ph_hi; ++ph) {
    run_phase(p, ph, smem, &slot, wave_s, 0);
#ifdef PROBE_PH
    if (ph == PROBE_PH)
      for (int rep = 1; rep <= PROBE_N; ++rep) { grid.sync(); run_phase(p, ph, smem, &slot, wave_s, rep); }
#endif
    if (ph + 1 < p.ph_hi) grid.sync();
  }
}

extern "C" void kernel_launch(void* const* d_in, const int* in_sizes, int n_in, void* d_out, int out_size, void* d_ws,
                              size_t ws_size, hipStream_t stream) {
  static int grid_blocks = 0;
  if (!grid_blocks) {
    int dev = 0, cus = 0, per_cu = 0;
    (void)hipGetDevice(&dev);
    (void)hipDeviceGetAttribute(&cus, hipDeviceAttributeMultiprocessorCount, dev);
    (void)hipFuncSetAttribute((const void*)mega, hipFuncAttributeMaxDynamicSharedMemorySize, SMEM_BYTES);
    (void)hipOccupancyMaxActiveBlocksPerMultiprocessor(&per_cu, mega, NTHR, SMEM_BYTES);
    if (per_cu < 1) per_cu = 1;
    if (per_cu > 1) per_cu = 1;
    grid_blocks = cus * per_cu;
    grid_blocks &= ~7;
    if (ws_size < WS_END || n_in != 24) { fprintf(stderr, "kernel_launch: ws %zu < %zu or n_in %d\n", ws_size, (size_t)WS_END, n_in); grid_blocks = -1; }
  }
  if (grid_blocks < 0) return;
  Params p{};
  const float** pp = (const float**)&p;
  for (int i = 0; i < 24; ++i) pp[i] = (const float*)d_in[i];
  p.out = (float*)d_out;
  p.ws = (char*)d_ws;
#if ONE_LAUNCH
  p.ph_lo = 0; p.ph_hi = NPHASE;
  void* args[] = {&p};
  hipError_t e = hipLaunchCooperativeKernel((void*)mega, dim3(grid_blocks), dim3(NTHR), args, SMEM_BYTES, stream);
  if (e != hipSuccess) fprintf(stderr, "cooperative launch failed: %s (grid %d)\n", hipGetErrorString(e), grid_blocks);
#else
  for (int ph = 0; ph < NPHASE; ++ph) {
    p.ph_lo = ph; p.ph_hi = ph + 1;
    hipLaunchKernelGGL(mega, dim3(grid_blocks), dim3(NTHR), SMEM_BYTES, stream, p);
  }
#endif
}
```

```cpp
#include <hip/hip_runtime.h>
#include <hip/hip_cooperative_groups.h>
#include <cstdio>
namespace cg = cooperative_groups;

#ifndef ONE_LAUNCH
#define ONE_LAUNCH 1
#endif

#define DI __device__ __forceinline__
typedef unsigned short bfr;
using bf16x8 = __attribute__((ext_vector_type(8))) short;
using s16x4 = __attribute__((ext_vector_type(4))) short;
using f32x16 = __attribute__((ext_vector_type(16))) float;
using u32x4 = __attribute__((ext_vector_type(4))) unsigned;
#define MFMA(a, b, c) __builtin_amdgcn_mfma_f32_32x32x16_bf16((a), (b), (c), 0, 0, 0)

constexpr int DM = 2048, SEQ = 2048, NTOK = 8192;
constexpr int ZS = 15488;
constexpr int ZC_Q = 0, ZC_KC = 2048, ZC_VC = 2560, ZC_KS = 3072, ZC_VS = 3584, ZC_KW = 4096, ZC_VW = 4608,
              ZC_QR = 5120, ZC_KR = 6144, ZC_VR = 7168, ZC_GR = 9216, ZC_GA = 11264, ZC_GB = 13312, ZC_GN = 15360;
constexpr int NPHASE = 16;

constexpr int ZSP = 15616;
constexpr size_t SZ_WINT = (size_t)ZSP * 2048 * 2;
constexpr size_t SZ_ACT = (size_t)NTOK * 2048 * 2;
constexpr size_t OFF_WINT = 0;
constexpr size_t OFF_N = OFF_WINT + SZ_WINT;
constexpr size_t OFF_MERGED = OFF_WINT;
constexpr size_t OFF_ORET = OFF_N;
constexpr size_t OFF_WUPT = 0;
constexpr size_t OFF_WDOWNT = SZ_ACT;
constexpr size_t OFF_Z = OFF_N + SZ_ACT;
constexpr size_t SZ_Z = (size_t)NTOK * ZS * 2;
constexpr size_t OFF_HID = OFF_Z;
constexpr size_t OFF_H = OFF_Z + (size_t)NTOK * 8192 * 2;
constexpr size_t OFF_NX = OFF_H + (size_t)NTOK * 2048 * 4;
constexpr size_t OFF_QX = OFF_NX + SZ_ACT;
constexpr size_t OFF_OX = OFF_QX + (size_t)NTOK * 512 * 2;
static_assert(OFF_OX + (size_t)NTOK * 512 * 2 <= OFF_Z + SZ_Z, "alias overflow");
constexpr size_t OFF_ZC = OFF_Z + SZ_Z;
constexpr size_t OFF_MN = OFF_ZC + (size_t)NTOK * 2048 * 2;
constexpr size_t OFF_W1T = OFF_MN + (size_t)1024 * 2048 * 2;
constexpr size_t OFF_W2T = OFF_W1T + (size_t)2 * 1024 * 4096 * 2;
constexpr size_t OFF_WAT = OFF_W2T + (size_t)2 * 128 * 1024 * 2;
constexpr size_t OFF_WBT = OFF_WAT + (size_t)2048 * 2048 * 2;
constexpr size_t OFF_WOUTT = OFF_WBT + (size_t)2048 * 2048 * 2;
constexpr size_t OFF_WQT = OFF_WOUTT + (size_t)2048 * 2048 * 2;
constexpr size_t OFF_WKT = OFF_WQT + (size_t)512 * 2048 * 2;
constexpr size_t OFF_WVT = OFF_WKT + (size_t)512 * 2048 * 2;
constexpr size_t OFF_WOT = OFF_WVT + (size_t)512 * 2048 * 2;
constexpr size_t OFF_ROPE = OFF_WOT + (size_t)512 * 2048 * 2;
constexpr size_t OFF_HIDC = OFF_ROPE + (size_t)2048 * 64 * 8;
constexpr size_t OFF_KCVC = OFF_HIDC + (size_t)2 * 2048 * 1024 * 2;
constexpr size_t OFF_SELM = OFF_KCVC + (size_t)2 * 2048 * 128 * 2;
constexpr size_t OFF_ONSA = OFF_SELM + (size_t)16 * 2048 * 4;
constexpr size_t OFF_KX = OFF_ONSA + SZ_ACT;
constexpr size_t OFF_VX = OFF_KX + (size_t)1024 * 512 * 2;
constexpr size_t OFF_RSTAT = OFF_VX + (size_t)1024 * 512 * 2;
constexpr size_t OFF_CTR = OFF_RSTAT + (size_t)NTOK * 8 * 2 * 2 * 4;
constexpr size_t OFF_ROWSS = OFF_CTR + 256;
constexpr size_t WS_END = OFF_ROWSS + (size_t)2 * NTOK * 4;

struct Params {
  const float *x, *mem, *attn_norm_w, *w_in, *pe_k, *w1k, *w2k, *pe_v, *w1v, *w2v, *w_a, *gn_w, *w_b, *w_out, *x_norm_w,
      *mem_norm_w, *wq, *wk, *wv, *wo, *mlp_norm_w, *w_up, *w_down, *final_norm_w;
  float* out;
  char* ws;
  int ph_lo, ph_hi;
  int dbg, pad;
};

constexpr int NTHR = 512;
constexpr int SMEM_BYTES = 131072;
__device__ const float ROPE_INV[64] = {1.0f, 0.865964353f, 0.749894261f, 0.649381638f, 0.562341332f, 0.486967534f, 0.421696514f, 0.365174115f, 0.316227764f, 0.273841977f, 0.237137377f, 0.2053525f, 0.177827939f, 0.153992653f, 0.133352131f, 0.115478203f, 0.100000001f, 0.0865964293f, 0.0749894157f, 0.0649381652f, 0.0562341325f, 0.0486967526f, 0.0421696529f, 0.0365174115f, 0.0316227749f, 0.0273841973f, 0.0237137377f, 0.0205352511f, 0.0177827943f, 0.0153992651f, 0.0133352149f, 0.0115478206f, 0.00999999978f, 0.00865964312f, 0.00749894185f, 0.00649381615f, 0.00562341325f, 0.00486967526f, 0.00421696482f, 0.00365174119f, 0.00316227763f, 0.00273841969f, 0.00237137359f, 0.00205352483f, 0.00177827943f, 0.00153992651f, 0.00133352145f, 0.0011547819f, 0.00100000005f, 0.000865964335f, 0.000749894243f, 0.000649381662f, 0.000562341302f, 0.000486967532f, 0.000421696517f, 0.000365174143f, 0.000316227757f, 0.000273841957f, 0.00023713737f, 0.00020535251f, 0.00017782794f, 0.000153992645f, 0.00013335215f, 0.0001154782f};

DI unsigned pack2(float a, float b) {
  typedef float f2 __attribute__((ext_vector_type(2)));
  typedef __bf16 b2 __attribute__((ext_vector_type(2)));
  f2 v = {a, b};
  b2 r = __builtin_convertvector(v, b2);
  return __builtin_bit_cast(unsigned, r);
}
DI float bflo(unsigned u) { return __uint_as_float(u << 16); }
DI float bfhi(unsigned u) { return __uint_as_float(u & 0xffff0000u); }
DI void st_bf4(bfr* p, float a, float b, float c, float d) {
  uint2 v; v.x = pack2(a, b); v.y = pack2(c, d);
  *(uint2*)p = v;
}
DI float wave_sum(float v) {
#pragma unroll
  for (int o = 32; o > 0; o >>= 1) v += __shfl_xor(v, o);
  return v;
}
DI float sigmoidf_(float x) { return 1.f / (1.f + __expf(-x)); }
DI int crow(int i, int h) { return (i & 3) + 8 * (i >> 2) + 4 * h; }
DI bf16x8 pack8(const f32x16& x, int s) {
  unsigned a = pack2(x[8 * s], x[8 * s + 1]), b = pack2(x[8 * s + 2], x[8 * s + 3]), c = pack2(x[8 * s + 4], x[8 * s + 5]),
           d = pack2(x[8 * s + 6], x[8 * s + 7]);
  typedef unsigned u4 __attribute__((ext_vector_type(4)));
  u4 v = {a, b, c, d};
  return __builtin_bit_cast(bf16x8, v);
}
DI s16x4 tr_read(const bfr* p) {
  return __builtin_amdgcn_ds_read_tr16_b64_v4i16((__attribute__((address_space(3))) s16x4*)(p));
}

struct TJob { const float* src; bfr* dst; int K, N, ntn, perm; const float* kscale; };
DI TJob get_tjob(const Params& p, int j) {
  TJob t;
  char* ws = p.ws;
  switch (j) {
    case 0: t = {p.w_in, (bfr*)(ws + OFF_WINT), 2048, 15408, 244, 1, nullptr}; break;
    case 1: t = {p.w1k, (bfr*)(ws + OFF_W1T), 4096, 1024, 16, 0, nullptr}; break;
    case 2: t = {p.w1v, (bfr*)(ws + OFF_W1T) + (size_t)1024 * 4096, 4096, 1024, 16, 0, nullptr}; break;
    case 3: t = {p.w2k, (bfr*)(ws + OFF_W2T), 1024, 128, 2, 0, nullptr}; break;
    case 4: t = {p.w2v, (bfr*)(ws + OFF_W2T) + (size_t)128 * 1024, 1024, 128, 2, 0, nullptr}; break;
    case 5: t = {p.w_a, (bfr*)(ws + OFF_WAT), 2048, 2048, 32, 0, nullptr}; break;
    case 6: t = {p.w_b, (bfr*)(ws + OFF_WBT), 2048, 2048, 32, 0, nullptr}; break;
    case 7: t = {p.w_out, (bfr*)(ws + OFF_WOUTT), 2048, 2048, 32, 0, nullptr}; break;
    case 8: t = {p.wq, (bfr*)(ws + OFF_WQT), 2048, 512, 8, 0, p.x_norm_w}; break;
    case 9: t = {p.wk, (bfr*)(ws + OFF_WKT), 2048, 512, 8, 0, nullptr}; break;
    case 10: t = {p.wv, (bfr*)(ws + OFF_WVT), 2048, 512, 8, 0, nullptr}; break;
    case 11: t = {p.wo, (bfr*)(ws + OFF_WOT), 512, 2048, 32, 0, nullptr}; break;
    case 12: t = {p.w_up, (bfr*)(ws + OFF_WUPT), 2048, 8192, 128, 0, p.mlp_norm_w}; break;
    default: t = {p.w_down, (bfr*)(ws + OFF_WDOWNT), 8192, 2048, 32, 0, nullptr}; break;
  }
  return t;
}
DI int tjob_tiles(int j) {
  switch (j) {
    case 0: return 244 * 16;
    case 1: case 2: return 16 * 32;
    case 3: case 4: return 2 * 8;
    case 5: case 6: case 7: return 32 * 16;
    case 8: case 9: case 10: return 8 * 16;
    case 11: return 32 * 4;
    case 12: return 128 * 16;
    default: return 32 * 64;
  }
}
struct TrRegs { float4 v[4]; };
DI void tr_load(const TJob& t, int tile, TrRegs& rg, const int tid) {
  const int nkt = t.K >> 7;
  const int kt = tile % nkt, nt = tile / nkt;
  const int k0 = kt * 128, d0 = nt * 64;
  int scol0 = d0, nvalid = 64;
  if (t.perm) {
    if (d0 < 5120) scol0 = d0;
    else if (d0 < 15360) scol0 = d0 + 48;
    else { scol0 = d0 - 15360 + 5120; nvalid = (d0 == 15360) ? 48 : 0; }
  }
#pragma unroll
  for (int i = 0; i < 4; ++i) {
    const int row = i * 32 + (tid >> 4), col = (tid & 15) * 4;
    rg.v[i] = make_float4(0.f, 0.f, 0.f, 0.f);
    if (col < nvalid) rg.v[i] = *(const float4*)(t.src + (size_t)(k0 + row) * t.N + scol0 + col);
    if (t.kscale) { const float sc = t.kscale[k0 + row]; rg.v[i].x *= sc; rg.v[i].y *= sc; rg.v[i].z *= sc; rg.v[i].w *= sc; }
  }
}
DI void tr_to_lds(const TrRegs& rg, float* sm, const int tid) {
#pragma unroll
  for (int i = 0; i < 4; ++i) {
    const int row = i * 32 + (tid >> 4), col = (tid & 15) * 4;
    float* d = sm + row * 65 + col;
    d[0] = rg.v[i].x; d[1] = rg.v[i].y; d[2] = rg.v[i].z; d[3] = rg.v[i].w;
  }
}
DI void tr_store(const TJob& t, int tile, const float* sm, const int tid) {
  const int nkt = t.K >> 7;
  const int kt = tile % nkt, nt = tile / nkt;
  const int k0 = kt * 128, d0 = nt * 64;
  const int n = tid >> 3, ks = (tid & 7) * 16;
  unsigned o[8];
#pragma unroll
  for (int j = 0; j < 8; ++j) o[j] = pack2(sm[(ks + 2 * j) * 65 + n], sm[(ks + 2 * j + 1) * 65 + n]);
  uint4* d = (uint4*)(t.dst + (size_t)(d0 + n) * t.K + k0 + ks);
  d[0] = make_uint4(o[0], o[1], o[2], o[3]);
  d[1] = make_uint4(o[4], o[5], o[6], o[7]);
}
DI void tr_decode(int it, int j_lo, int& j, int& rem) {
  j = j_lo; rem = it;
  while (rem >= tjob_tiles(j)) { rem -= tjob_tiles(j); ++j; }
}
DI void tr_run(const Params& p, int j_lo, int it0, int stride, int n_tiles, float* sm, const int tid) {
  if (it0 >= n_tiles) return;
  TrRegs rg;
  int j, rem;
  tr_decode(it0, j_lo, j, rem);
  TJob t = get_tjob(p, j);
  tr_load(t, rem, rg, tid);
  for (int it = it0; it < n_tiles; it += stride) {
    __syncthreads();
    tr_to_lds(rg, sm, tid);
    __syncthreads();
    const TJob tc = t;
    const int remc = rem;
    const int nx = it + stride;
    if (nx < n_tiles) {
      tr_decode(nx, j_lo, j, rem);
      t = get_tjob(p, j);
      tr_load(t, rem, rg, tid);
    }
    tr_store(tc, remc, sm, tid);
  }
  __syncthreads();
}

DI void rmsnorm_row(const float* xrow, const float* w, bfr* obf, float* of32, const int tid) {
  const int lane = tid & 63;
  float4 v[8];
  float ss = 0.f;
#pragma unroll
  for (int i = 0; i < 8; ++i) {
    v[i] = ((const float4*)xrow)[lane + 64 * i];
    ss += v[i].x * v[i].x + v[i].y * v[i].y + v[i].z * v[i].z + v[i].w * v[i].w;
  }
  ss = wave_sum(ss);
  const float rs = rsqrtf(ss * (1.f / 2048.f) + 1e-6f);
#pragma unroll
  for (int i = 0; i < 8; ++i) {
    const float4 ww = ((const float4*)w)[lane + 64 * i];
    const float a = v[i].x * rs * ww.x, b = v[i].y * rs * ww.y, c = v[i].z * rs * ww.z, d = v[i].w * rs * ww.w;
    if (obf) st_bf4(obf + (lane + 64 * i) * 4, a, b, c, d);
    else ((float4*)of32)[lane + 64 * i] = make_float4(a, b, c, d);
  }
}

struct PlainPtr {
  const bfr* base; int ld;
  DI int rowoff(int row) const { return row * ld; }
  DI int koff(int k0) const { return k0; }
};
#define WAIT_V(n) asm volatile("s_waitcnt vmcnt(%0)" ::"n"(n) : "memory")
#define WAIT_L(n) asm volatile("s_waitcnt lgkmcnt(%0)" ::"n"(n) : "memory")
#define RAW_BARRIER() do { WAIT_L(0); __builtin_amdgcn_s_barrier(); } while (0)
typedef __attribute__((address_space(3))) unsigned lds_u32;
constexpr int STAGE_B = 65536;
template <int NI, class AF, class BF>
DI void gemm_main(f32x16 (&acc)[NI][4], const AF& af, const BF& bf, int nk, char* smem, const int tid) {
  const int lane = tid & 63, r = lane & 31, h = lane >> 5;
  const int w = __builtin_amdgcn_readfirstlane(tid >> 6);
  const int wm = w & 1, wn = w >> 1;
  int ao[4], bo[2 * NI];
  {
    const int rl = lane >> 3, kc = (lane & 7) ^ (((w & 1) * 4 + (lane >> 4)) & 7);
#pragma unroll
    for (int i = 0; i < 4; ++i) ao[i] = af.rowoff((w + 8 * i) * 8 + rl) + 8 * kc;
#pragma unroll
    for (int i = 0; i < 2 * NI; ++i) bo[i] = bf.rowoff((w + 8 * i) * 8 + rl) + 8 * kc;
  }
  auto stage = [&](int buf, int kt) {
    const int ka = af.koff(kt * 64), kb = bf.koff(kt * 64);
    char* sbase = smem + buf * STAGE_B + w * 1024;
#pragma unroll
    for (int i = 0; i < 4; ++i)
      __builtin_amdgcn_global_load_lds((const unsigned*)(af.base + (ao[i] + ka)), (lds_u32*)(sbase + i * 8192), 16, 0, 0);
#pragma unroll
    for (int i = 0; i < 2 * NI; ++i)
      __builtin_amdgcn_global_load_lds((const unsigned*)(bf.base + (bo[i] + kb)), (lds_u32*)(sbase + 32768 + i * 8192), 16, 0, 0);
  };
  const int xr = (r >> 1) & 7;
  const int arow = (wm * 128 + r) * 128, brow = 32768 + (wn * 32 * NI + r) * 128;
  WAIT_V(0);
  __syncthreads();
  stage(0, 0);
  WAIT_V(0);
  RAW_BARRIER();
#pragma unroll 1
  for (int kt = 0; kt < nk; ++kt) {
    if (kt + 1 < nk) stage((kt + 1) & 1, kt + 1);
    const char* sb = smem + (kt & 1) * STAGE_B;
#pragma unroll
    for (int ks = 0; ks < 4; ++ks) {
      const int off = ((2 * ks + h) ^ xr) * 16;
      bf16x8 wf[NI], xf[4];
#pragma unroll
      for (int i = 0; i < NI; ++i) wf[i] = *(const bf16x8*)(sb + brow + i * 4096 + off);
#pragma unroll
      for (int i = 0; i < 4; ++i) xf[i] = *(const bf16x8*)(sb + arow + i * 4096 + off);
#pragma unroll
      for (int mi = 0; mi < 4; ++mi)
#pragma unroll
        for (int ni = 0; ni < NI; ++ni) acc[ni][mi] = MFMA(wf[ni], xf[mi], acc[ni][mi]);
    }
    WAIT_V(0);
    RAW_BARRIER();
  }
}
template <int NI>
DI void acc_zero(f32x16 (&acc)[NI][4]) {
#pragma unroll
  for (int a = 0; a < NI; ++a)
#pragma unroll
    for (int b = 0; b < 4; ++b)
#pragma unroll
      for (int i = 0; i < 16; ++i) acc[a][b][i] = 0.f;
}
template <int NI, class EPI>
DI void gemm_epi(const f32x16 (&acc)[NI][4], int m0, int n0, const int tid_in, const EPI& epi) {
  int tid = tid_in;
  asm volatile("" : "+v"(tid));
  const int lane = tid & 63, w = tid >> 6, r = lane & 31, h = lane >> 5;
  const int wm = w & 1, wn = w >> 1;
#pragma unroll
  for (int mi = 0; mi < 4; ++mi)
#pragma unroll
    for (int ni = 0; ni < NI; ++ni)
#pragma unroll
      for (int g = 0; g < 4; ++g) {
        const int n = n0 + wn * 32 * NI + ni * 32 + 8 * g + 4 * h;
        const int m = m0 + wm * 128 + mi * 32 + r;
        epi(m, n, acc[ni][mi][4 * g], acc[ni][mi][4 * g + 1], acc[ni][mi][4 * g + 2], acc[ni][mi][4 * g + 3]);
      }
}
DI void gemm_epi_resid(const f32x16 (&acc)[2][4], int m0, int n0, const int tid_in, const float* hsrc, float* hdst, bfr* hb, float* rowss) {
  int tid = tid_in;
  asm volatile("" : "+v"(tid));
  const int lane = tid & 63, w = tid >> 6, r = lane & 31, h = lane >> 5;
  const int wm = w & 1, wn = w >> 1;
#pragma unroll
  for (int mi = 0; mi < 4; ++mi) {
    const int m = m0 + wm * 128 + mi * 32 + r;
    float ss = 0.f;
#pragma unroll
    for (int ni = 0; ni < 2; ++ni)
#pragma unroll
      for (int g = 0; g < 4; ++g) {
        const int n = n0 + wn * 64 + ni * 32 + 8 * g + 4 * h;
        const float4 xv = *(const float4*)(hsrc + (size_t)m * 2048 + n);
        const float a = xv.x + acc[ni][mi][4 * g], b = xv.y + acc[ni][mi][4 * g + 1], c = xv.z + acc[ni][mi][4 * g + 2], d = xv.w + acc[ni][mi][4 * g + 3];
        *(float4*)(hdst + (size_t)m * 2048 + n) = make_float4(a, b, c, d);
        st_bf4(hb + (size_t)m * 2048 + n, a, b, c, d);
        ss += a * a + b * b + c * c + d * d;
      }
    ss += __shfl_xor(ss, 32);
    if (h == 0) atomicAdd(rowss + m, ss);
  }
}
DI void map_tile32(int v, int& mt, int& nt) {
  const int xcd = v & 7, j = v >> 3;
  nt = j >> 2;
  mt = xcd * 4 + (j & 3);
}

enum { MODE_WIN = 0, MODE_SEL = 1, MODE_X = 2, MODE_RET = 3 };
constexpr int KP = 136;

template <int MODE>
DI void attn_item(const Params& p, int item, char* smem, const int tid) {
  constexpr int VP = 136;
  bfr* Ks = (bfr*)smem;
  bfr* Vs = Ks + 64 * KP;
  const int w = tid >> 6, lane = tid & 63, r = lane & 31, h = lane >> 5;
  bfr* Qw = Vs + 64 * VP + w * 32 * KP;
  char* ws = p.ws;
  const bfr* z = (const bfr*)(ws + OFF_Z);

  int b, t0, tq0, jlo, jhi, head = 0, grp = 0, vh = 0;
  const bfr *qbase, *kbase, *vbase;
  int ldq, ldk;
  unsigned selm = 0, umask = 0xffffffffu;
  if (MODE == MODE_WIN) {
    const int tb = item >> 4, bg = item & 15;
    b = bg >> 2; grp = bg & 3; t0 = tb * 64; tq0 = t0 + 32 * (w >> 2); head = grp * 4 + (w & 3);
    qbase = z + (size_t)(b * SEQ + tq0) * ZS + ZC_Q + head * 128; ldq = ZS;
    kbase = z + (size_t)(b * SEQ) * ZS + ZC_KW + grp * 128;
    vbase = z + (size_t)(b * SEQ) * ZS + ZC_VW + grp * 128;
    ldk = ZS;
    jlo = (t0 - 511 > 0 ? t0 - 511 : 0) >> 6;
    jhi = tb;
  } else if (MODE == MODE_SEL) {
    const int tb = 31 - (item >> 4), bg = item & 15;
    b = bg >> 2; grp = bg & 3; t0 = tb * 64; tq0 = t0 + 32 * (w >> 2); head = grp * 4 + (w & 3);
    qbase = z + (size_t)(b * SEQ + tq0) * ZS + ZC_Q + head * 128; ldq = ZS;
    kbase = z + (size_t)(b * SEQ) * ZS + ZC_KS + grp * 128;
    vbase = z + (size_t)(b * SEQ) * ZS + ZC_VS + grp * 128;
    ldk = ZS;
    jlo = 0;
    jhi = tb;
    const unsigned* sm = (const unsigned*)(ws + OFF_SELM) + (b * 4 + grp) * SEQ;
    selm = sm[tq0 + r];
    unsigned u = sm[t0 + lane];
#pragma unroll
    for (int o = 32; o > 0; o >>= 1) u |= (unsigned)__shfl_xor((int)u, o);
    umask = (unsigned)__builtin_amdgcn_readfirstlane((int)u);
    umask &= (jhi >= 31) ? 0xffffffffu : ((1u << (jhi + 1)) - 1u);
  } else if (MODE == MODE_X) {
    const int tb = item >> 4, bh = item & 15;
    b = bh >> 2; head = bh & 3; t0 = tb * 256; tq0 = t0 + 32 * w;
    qbase = (const bfr*)(ws + OFF_QX) + (size_t)(b * SEQ + tq0) * 512 + head * 128; ldq = 512;
    kbase = (const bfr*)(ws + OFF_KX) + (size_t)(b * 256) * 512 + head * 128;
    vbase = (const bfr*)(ws + OFF_VX) + (size_t)(b * 256) * 512 + head * 128;
    ldk = 512;
    jlo = 0; jhi = 3;
  } else {
    const int tb = 7 - (item >> 6), rest = item & 63;
    b = rest >> 4; head = (rest >> 1) & 7; vh = rest & 1; t0 = tb * 256; tq0 = t0 + 32 * w;
    qbase = z + (size_t)(b * SEQ + tq0) * ZS + ZC_QR + head * 128; ldq = ZS;
    kbase = z + (size_t)(b * SEQ) * ZS + ZC_KR + head * 128;
    vbase = z + (size_t)(b * SEQ) * ZS + ZC_VR + head * 256 + vh * 128;
    ldk = ZS;
    jlo = 0; jhi = 4 * tb + 3;
  }
  const int tq = tq0 + r;

  f32x16 o[4];
#pragma unroll
  for (int dt = 0; dt < 4; ++dt)
#pragma unroll
    for (int i = 0; i < 16; ++i) o[dt][i] = 0.f;
  float m_run = -INFINITY, l_run = 0.f;
  float lg = 0.f;
  float rf[16];
  if (MODE == MODE_RET) {
    lg = log1pf(-exp2f(-5.f - (float)head)) * 1.4426950408889634f;
#pragma unroll
    for (int i = 0; i < 16; ++i) rf[i] = __builtin_amdgcn_exp2f(-lg * (float)crow(i, h));
  }

  u32x4 kreg[2], vreg[2];
  auto gload = [&](int j) {
    const int k0 = j * 64;
#pragma unroll
    for (int i = 0; i < 2; ++i) {
      const int c = tid + 512 * i, row = c >> 4, cc = c & 15;
      kreg[i] = *(const u32x4*)(kbase + (size_t)(k0 + row) * ldk + cc * 8);
      vreg[i] = *(const u32x4*)(vbase + (size_t)(k0 + row) * ldk + cc * 8);
    }
  };
  auto swrite = [&]() {
#pragma unroll
    for (int i = 0; i < 2; ++i) {
      const int c = tid + 512 * i, row = c >> 4, cc = c & 15;
      *(u32x4*)(Ks + row * KP + cc * 8) = kreg[i];
      *(u32x4*)(Vs + row * VP + cc * 8) = vreg[i];
    }
  };
  auto next_j = [&](int j) -> int {
    if (MODE == MODE_SEL) {
      const unsigned rem = (j >= 31) ? 0u : (umask & ~((2u << j) - 1u));
      return rem ? (__builtin_ctz(rem)) : 64;
    }
    return j + 1;
  };
  int j = jlo;
  if (MODE == MODE_SEL) j = __builtin_ctz(umask);
  gload(j);
  __syncthreads();
  {
    u32x4 qreg[8];
#pragma unroll
    for (int i = 0; i < 8; ++i) {
      const int c = lane + 64 * i, row = c >> 4, cc = c & 15;
      qreg[i] = *(const u32x4*)(qbase + (size_t)row * ldq + cc * 8);
    }
#pragma unroll
    for (int i = 0; i < 8; ++i) {
      const int c = lane + 64 * i, row = c >> 4, cc = c & 15;
      *(u32x4*)(Qw + row * KP + cc * 8) = qreg[i];
    }
  }
  const float csc = 0.08838834764831845f * 1.4426950408889634f;
  const int q4 = (lane & 15) >> 2, p4 = lane & 3, blk = (lane >> 4) & 1;
  bool first = true;
#pragma unroll 1
  while (j <= jhi) {
    if (!first) __syncthreads();
    first = false;
    swrite();
    __syncthreads();
    const int jn = next_j(j);
    if (jn <= jhi) gload(jn);
    const int k0 = j * 64;
    if (MODE == MODE_RET && k0 > tq0 + 31) { j = jn; continue; }
    bf16x8 pf[2][2];
    if (MODE == MODE_RET) {
#pragma unroll
      for (int sub = 0; sub < 2; ++sub) {
        f32x16 sx;
#pragma unroll
        for (int i = 0; i < 16; ++i) sx[i] = 0.f;
#pragma unroll
        for (int s = 0; s < 8; ++s) {
          const bf16x8 kf = *(const bf16x8*)(Ks + (32 * sub + r) * KP + 16 * s + 8 * h);
          const bf16x8 qf = *(const bf16x8*)(Qw + r * KP + 16 * s + 8 * h);
          sx = MFMA(kf, qf, sx);
        }
        {
          const int dq = tq - (k0 + 32 * sub);
          const float cf = __builtin_amdgcn_exp2f(lg * (float)dq);
#pragma unroll
          for (int i = 0; i < 16; ++i) sx[i] = (crow(i, h) <= dq) ? sx[i] * (cf * rf[i]) : 0.f;
        }
        pf[sub][0] = pack8(sx, 0);
        pf[sub][1] = pack8(sx, 1);
      }
    } else {
      f32x16 s0, s1;
#pragma unroll
      for (int i = 0; i < 16; ++i) { s0[i] = 0.f; s1[i] = 0.f; }
#pragma unroll
      for (int s = 0; s < 8; ++s) {
        const bf16x8 k0f = *(const bf16x8*)(Ks + r * KP + 16 * s + 8 * h);
        const bf16x8 k1f = *(const bf16x8*)(Ks + (32 + r) * KP + 16 * s + 8 * h);
        const bf16x8 qf = *(const bf16x8*)(Qw + r * KP + 16 * s + 8 * h);
        s0 = MFMA(k0f, qf, s0);
        s1 = MFMA(k1f, qf, s1);
      }
      bool need_mask = false;
      if (MODE == MODE_WIN) need_mask = (k0 + 63 > tq0) || (k0 < tq0 + 31 - 511);
      if (MODE == MODE_SEL) need_mask = (k0 + 63 > tq0);
      const bool lanesel = (MODE == MODE_SEL) ? ((selm >> j) & 1u) : true;
      float mx = -INFINITY;
      if (need_mask) {
#pragma unroll
        for (int i = 0; i < 16; ++i) {
          const int tk0 = k0 + crow(i, h), tk1 = tk0 + 32;
          bool ok0 = true, ok1 = true;
          if (MODE == MODE_WIN) { ok0 = (tk0 <= tq) && (tq - tk0 < 512); ok1 = (tk1 <= tq) && (tq - tk1 < 512); }
          if (MODE == MODE_SEL) { ok0 = lanesel && (tk0 <= tq); ok1 = lanesel && (tk1 <= tq); }
          s0[i] = ok0 ? s0[i] * csc : -INFINITY;
          s1[i] = ok1 ? s1[i] * csc : -INFINITY;
          mx = fmaxf(mx, fmaxf(s0[i], s1[i]));
        }
      } else {
#pragma unroll
        for (int i = 0; i < 16; ++i) {
          s0[i] = lanesel ? s0[i] * csc : -INFINITY;
          s1[i] = lanesel ? s1[i] * csc : -INFINITY;
          mx = fmaxf(mx, fmaxf(s0[i], s1[i]));
        }
      }
      mx = fmaxf(mx, __shfl_xor(mx, 32));
      const float mnew = fmaxf(m_run, mx);
      const float muse = (mnew == -INFINITY) ? 0.f : mnew;
      const float alpha = __builtin_amdgcn_exp2f(m_run - muse);
      float ls = 0.f;
#pragma unroll
      for (int i = 0; i < 16; ++i) {
        s0[i] = __builtin_amdgcn_exp2f(s0[i] - muse);
        s1[i] = __builtin_amdgcn_exp2f(s1[i] - muse);
        ls += s0[i] + s1[i];
      }
      ls += __shfl_xor(ls, 32);
      l_run = l_run * alpha + ls;
      m_run = mnew;
      if (__builtin_amdgcn_ballot_w64(alpha != 1.f) != 0) {
#pragma unroll
        for (int dt = 0; dt < 4; ++dt)
#pragma unroll
          for (int i = 0; i < 16; ++i) o[dt][i] *= alpha;
      }
      pf[0][0] = pack8(s0, 0); pf[0][1] = pack8(s0, 1);
      pf[1][0] = pack8(s1, 0); pf[1][1] = pack8(s1, 1);
    }
#pragma unroll
    for (int dt = 0; dt < 4; ++dt)
#pragma unroll
      for (int sub = 0; sub < 2; ++sub)
#pragma unroll
        for (int st = 0; st < 2; ++st) {
          const int key0 = 32 * sub + 16 * st + 4 * h;
          const bfr* vp = Vs + (key0 + q4) * VP + 32 * dt + 16 * blk + 4 * p4;
          const s16x4 lo = tr_read(vp);
          const s16x4 hi = tr_read(vp + 8 * VP);
          const bf16x8 vf = __builtin_shufflevector(lo, hi, 0, 1, 2, 3, 4, 5, 6, 7);
          o[dt] = MFMA(vf, pf[sub][st], o[dt]);
        }
    j = jn;
  }

  if (MODE == MODE_SEL && p.dbg) return;
  const size_t mrow = (size_t)(b * SEQ + tq);
  if (MODE == MODE_WIN || MODE == MODE_SEL) {
    const float inv = (l_run > 0.f) ? 1.f / l_run : 0.f;
    const float gate = bflo(z[mrow * ZS + ZC_GN + head * 3 + (MODE == MODE_WIN ? 2 : 1)]);
    bfr* orow = (bfr*)(ws + OFF_ONSA) + mrow * 2048 + head * 128;
    const float sc = inv * gate;
#pragma unroll
    for (int dt = 0; dt < 4; ++dt)
#pragma unroll
      for (int g = 0; g < 4; ++g) {
        bfr* dst = orow + 32 * dt + 8 * g + 4 * h;
        float a = o[dt][4 * g] * sc, bb = o[dt][4 * g + 1] * sc, c = o[dt][4 * g + 2] * sc, d = o[dt][4 * g + 3] * sc;
        if (MODE == MODE_SEL) {
          const uint2 old = *(const uint2*)dst;
          a += bflo(old.x); bb += bfhi(old.x); c += bflo(old.y); d += bfhi(old.y);
        }
        st_bf4(dst, a, bb, c, d);
      }
  } else if (MODE == MODE_X) {
    const float inv = 1.f / l_run;
    bfr* orow = (bfr*)(ws + OFF_OX) + mrow * 512 + head * 128;
#pragma unroll
    for (int dt = 0; dt < 4; ++dt)
#pragma unroll
      for (int g = 0; g < 4; ++g)
        st_bf4(orow + 32 * dt + 8 * g + 4 * h, o[dt][4 * g] * inv, o[dt][4 * g + 1] * inv, o[dt][4 * g + 2] * inv,
               o[dt][4 * g + 3] * inv);
  } else {
    float sm = 0.f, sq = 0.f;
#pragma unroll
    for (int dt = 0; dt < 4; ++dt)
#pragma unroll
      for (int i = 0; i < 16; ++i) { sm += o[dt][i]; sq += o[dt][i] * o[dt][i]; }
    sm += __shfl_xor(sm, 32);
    sq += __shfl_xor(sq, 32);
    if (h == 0) *(float2*)((float*)(ws + OFF_RSTAT) + ((mrow * 8 + head) * 2 + vh) * 2) = make_float2(sm, sq);
    bfr* orow = (bfr*)(ws + OFF_ORET) + mrow * 2048 + head * 256 + vh * 128;
#pragma unroll
    for (int dt = 0; dt < 4; ++dt)
#pragma unroll
      for (int g = 0; g < 4; ++g)
        st_bf4(orow + 32 * dt + 8 * g + 4 * h, o[dt][4 * g], o[dt][4 * g + 1], o[dt][4 * g + 2], o[dt][4 * g + 3]);
  }
}

DI void ret_finish_row(const Params& p, int row, const int t) {
  char* ws = p.ws;
  const bfr* z = (const bfr*)(ws + OFF_Z);
  const int col = t * 8, head = t >> 5;
  const float4 st = *(const float4*)((const float*)(ws + OFF_RSTAT) + ((size_t)row * 8 + head) * 4);
  const float mu = (st.x + st.z) * (1.f / 256.f);
  const float var = fmaxf((st.y + st.w) * (1.f / 256.f) - mu * mu, 0.f);
  const float rstd = rsqrtf(var + 1e-6f);
  bfr* op = (bfr*)(ws + OFF_ORET) + (size_t)row * 2048 + col;
  const u32x4 ov = *(const u32x4*)op;
  const u32x4 gv = *(const u32x4*)(z + (size_t)row * ZS + ZC_GR + col);
  const float4 w0 = *(const float4*)(p.gn_w + col), w1 = *(const float4*)(p.gn_w + col + 4);
  u32x4 res;
  res[0] = pack2((bflo(ov[0]) - mu) * rstd * w0.x * bflo(gv[0]), (bfhi(ov[0]) - mu) * rstd * w0.y * bfhi(gv[0]));
  res[1] = pack2((bflo(ov[1]) - mu) * rstd * w0.z * bflo(gv[1]), (bfhi(ov[1]) - mu) * rstd * w0.w * bfhi(gv[1]));
  res[2] = pack2((bflo(ov[2]) - mu) * rstd * w1.x * bflo(gv[2]), (bfhi(ov[2]) - mu) * rstd * w1.y * bfhi(gv[2]));
  res[3] = pack2((bflo(ov[3]) - mu) * rstd * w1.z * bflo(gv[3]), (bfhi(ov[3]) - mu) * rstd * w1.w * bfhi(gv[3]));
  *(u32x4*)op = res;
}

DI void cmp_item(const Params& p, int item, char* smem, const int tid) {
  bfr* Ks = (bfr*)smem;
  float* impw = (float*)(smem + 128 * KP * 2);
  const int w = tid >> 6, lane = tid & 63, r = lane & 31, h = lane >> 5;
  char* ws = p.ws;
  const bfr* z = (const bfr*)(ws + OFF_Z);
  const int tb = item >> 4, bg = item & 15, b = bg >> 2, grp = bg & 3;
  const int t0 = tb * 64, ti = 32 * (w >> 2) + r, tq = t0 + ti, hw = w & 3, head = grp * 4 + hw;
  const bfr* qrow = z + (size_t)(b * SEQ + tq) * ZS + ZC_Q + head * 128;
  const bfr* kc = (const bfr*)(ws + OFF_KCVC) + (size_t)((b * 4 + grp) * 128) * 128;
  const bfr* vc = kc + (size_t)2048 * 128;
  bf16x8 qf[8];
#pragma unroll
  for (int s = 0; s < 8; ++s) qf[s] = *(const bf16x8*)(qrow + 16 * s + 8 * h);
  u32x4 reg[4];
#pragma unroll
  for (int i = 0; i < 4; ++i) {
    const int c = tid + 512 * i, row = c >> 4, cc = c & 15;
    reg[i] = *(const u32x4*)(kc + row * 128 + cc * 8);
  }
  __syncthreads();
#pragma unroll
  for (int i = 0; i < 4; ++i) {
    const int c = tid + 512 * i, row = c >> 4, cc = c & 15;
    *(u32x4*)(Ks + row * KP + cc * 8) = reg[i];
  }
  __syncthreads();
  f32x16 s[4];
#pragma unroll
  for (int kt = 0; kt < 4; ++kt) {
#pragma unroll
    for (int i = 0; i < 16; ++i) s[kt][i] = 0.f;
#pragma unroll
    for (int ss = 0; ss < 8; ++ss) {
      const bf16x8 kf = *(const bf16x8*)(Ks + (32 * kt + r) * KP + 16 * ss + 8 * h);
      s[kt] = MFMA(kf, qf[ss], s[kt]);
    }
  }
  const float csc = 0.08838834764831845f * 1.4426950408889634f;
  float mx = -INFINITY;
#pragma unroll
  for (int kt = 0; kt < 4; ++kt)
#pragma unroll
    for (int i = 0; i < 16; ++i) {
      const int c = 32 * kt + crow(i, h);
      const bool ok = (c * 16 + 31 <= tq) && (c < 127);
      s[kt][i] = ok ? s[kt][i] * csc : -INFINITY;
      mx = fmaxf(mx, s[kt][i]);
    }
  mx = fmaxf(mx, __shfl_xor(mx, 32));
  const float muse = (mx == -INFINITY) ? 0.f : mx;
  float ls = 0.f;
#pragma unroll
  for (int kt = 0; kt < 4; ++kt)
#pragma unroll
    for (int i = 0; i < 16; ++i) {
      s[kt][i] = __builtin_amdgcn_exp2f(s[kt][i] - muse);
      ls += s[kt][i];
    }
  ls += __shfl_xor(ls, 32);
  const float inv = (ls > 0.f) ? 1.f / ls : 0.f;
#pragma unroll
  for (int kt = 0; kt < 4; ++kt)
#pragma unroll
    for (int i = 0; i < 16; ++i) s[kt][i] *= inv;
  float plast[16];
#pragma unroll
  for (int kt = 0; kt < 4; ++kt)
#pragma unroll
    for (int g = 0; g < 4; ++g) plast[kt * 4 + g] = __shfl_xor(s[kt][4 * g + 3], 32);
#pragma unroll
  for (int kt = 0; kt < 4; ++kt)
#pragma unroll
    for (int g = 0; g < 4; ++g) {
      const int slot = kt * 4 + g;
      const float sum4 = s[kt][4 * g] + s[kt][4 * g + 1] + s[kt][4 * g + 2] + s[kt][4 * g + 3];
      const float prevl = (slot > 0) ? plast[slot > 0 ? slot - 1 : 0] : 0.f;
      const float add = h ? plast[slot] : prevl;
      impw[(hw * 64 + ti) * 32 + 8 * kt + 2 * g + h] = sum4 + add;
    }
  bf16x8 pf[4][2];
#pragma unroll
  for (int kt = 0; kt < 4; ++kt) { pf[kt][0] = pack8(s[kt], 0); pf[kt][1] = pack8(s[kt], 1); }
#pragma unroll
  for (int i = 0; i < 4; ++i) {
    const int c = tid + 512 * i, row = c >> 4, cc = c & 15;
    reg[i] = *(const u32x4*)(vc + row * 128 + cc * 8);
  }
  __syncthreads();
#pragma unroll
  for (int i = 0; i < 4; ++i) {
    const int c = tid + 512 * i, row = c >> 4, cc = c & 15;
    *(u32x4*)(Ks + row * KP + cc * 8) = reg[i];
  }
  __syncthreads();
  f32x16 o[4];
#pragma unroll
  for (int dt = 0; dt < 4; ++dt)
#pragma unroll
    for (int i = 0; i < 16; ++i) o[dt][i] = 0.f;
  const int q4 = (lane & 15) >> 2, p4 = lane & 3, blk = (lane >> 4) & 1;
#pragma unroll
  for (int dt = 0; dt < 4; ++dt)
#pragma unroll
    for (int kt = 0; kt < 4; ++kt)
#pragma unroll
      for (int st = 0; st < 2; ++st) {
        const int key0 = 32 * kt + 16 * st + 4 * h;
        const bfr* vp = Ks + (key0 + q4) * KP + 32 * dt + 16 * blk + 4 * p4;
        const s16x4 lo = tr_read(vp);
        const s16x4 hi = tr_read(vp + 8 * KP);
        const bf16x8 vf = __builtin_shufflevector(lo, hi, 0, 1, 2, 3, 4, 5, 6, 7);
        o[dt] = MFMA(vf, pf[kt][st], o[dt]);
      }
  {
    const size_t mrow = (size_t)(b * SEQ + tq);
    const float gate = bflo(z[mrow * ZS + ZC_GN + head * 3 + 0]);
    bfr* orow = (bfr*)(ws + OFF_ONSA) + mrow * 2048 + head * 128;
#pragma unroll
    for (int dt = 0; dt < 4; ++dt)
#pragma unroll
      for (int g = 0; g < 4; ++g) {
        bfr* dst = orow + 32 * dt + 8 * g + 4 * h;
        const uint2 old = *(const uint2*)dst;
        st_bf4(dst, o[dt][4 * g] * gate + bflo(old.x), o[dt][4 * g + 1] * gate + bfhi(old.x),
               o[dt][4 * g + 2] * gate + bflo(old.y), o[dt][4 * g + 3] * gate + bfhi(old.y));
      }
  }
  {
    const int i = tid >> 3, jg = tid & 7;
    const int cur = (t0 + i) >> 6;
    float vm[4];
#pragma unroll
    for (int e = 0; e < 4; ++e) {
      const int jme = 4 * jg + e;
      const float a = impw[(0 * 64 + i) * 32 + jme] + impw[(1 * 64 + i) * 32 + jme] + impw[(2 * 64 + i) * 32 + jme] + impw[(3 * 64 + i) * 32 + jme];
      const bool forced = (jme == 0) || (jme == cur) || (jme == cur - 1);
      vm[e] = forced ? INFINITY : ((jme > cur) ? -INFINITY : a);
    }
#pragma unroll
    for (int e = 0; e < 4; ++e) impw[i * 32 + 4 * jg + e] = vm[e];
    __syncthreads();
    int rank[4] = {0, 0, 0, 0};
#pragma unroll 4
    for (int k = 0; k < 32; ++k) {
      const float vk = impw[i * 32 + k];
#pragma unroll
      for (int e = 0; e < 4; ++e) rank[e] += (vk > vm[e] || (vk == vm[e] && k < 4 * jg + e)) ? 1 : 0;
    }
    unsigned bits = 0;
#pragma unroll
    for (int e = 0; e < 4; ++e)
      if (rank[e] < 16 && 4 * jg + e <= cur) bits |= 1u << (4 * jg + e);
    bits |= (unsigned)__shfl_xor((int)bits, 1);
    bits |= (unsigned)__shfl_xor((int)bits, 2);
    bits |= (unsigned)__shfl_xor((int)bits, 4);
    if (jg == 0) ((unsigned*)(ws + OFF_SELM))[(b * 4 + grp) * SEQ + t0 + i] = bits;
  }
  __syncthreads();
}

DI int grab(unsigned* ctr, int* slot, const int tid) {
  __syncthreads();
  if (tid == 0) *slot = (int)atomicAdd(ctr, 1u);
  __syncthreads();
  return *slot;
}

DI void run_phase(const Params& p0, int ph, char* smem, int* slot, const int wave_s, const int rep) {
  char* ws = p0.ws;
  asm volatile("" : "+s"(ws));
  Params p = p0;
  p.ws = ws;
  p.dbg = rep;
  const int G = gridDim.x;
  int bid = blockIdx.x;
  int tid = wave_s * 64 + (int)__builtin_amdgcn_mbcnt_hi(~0u, __builtin_amdgcn_mbcnt_lo(~0u, 0u));
  asm volatile("" : "+s"(bid));
  asm volatile("" : "+v"(tid));
  bfr* z = (bfr*)(ws + OFF_Z);
  unsigned* ctr = (unsigned*)(ws + OFF_CTR) + rep * 8;
  switch (ph) {
    case 0: {
      if (bid == 0 && tid < 64) ((unsigned*)(ws + OFF_CTR))[tid] = 0u;
      for (int i = bid * NTHR + tid; i < 2 * NTOK; i += G * NTHR) ((float*)(ws + OFF_ROWSS))[i] = 0.f;
      int tot = 0;
      for (int j = 0; j < 12; ++j) tot += tjob_tiles(j);
      const int n_norm = 1024 + 128, n_rope = 256;
      tr_run(p, 0, bid, G, tot, (float*)smem, tid);
      for (int it = tot + bid; it < tot + n_norm + n_rope; it += G) {
        if (it < tot + n_norm) {
          const int row = (it - tot) * 8 + (tid >> 6);
          if (row < NTOK) rmsnorm_row(p.x + (size_t)row * 2048, p.attn_norm_w, (bfr*)(ws + OFF_N) + (size_t)row * 2048, nullptr, tid);
          else rmsnorm_row(p.mem + (size_t)(row - NTOK) * 2048, p.mem_norm_w, (bfr*)(ws + OFF_MN) + (size_t)(row - NTOK) * 2048, nullptr, tid);
        } else {
          const int e = (it - tot - n_norm) * 512 + tid;
          const int t = e >> 6, i = e & 63;
          const float ang = (float)t * ROPE_INV[i];
          const float kk = rintf(ang * 0.15915494309189535f);
          float rr = fmaf(-kk, 6.2831854820251465f, ang);
          rr = fmaf(-kk, -1.7484555e-7f, rr);
          const float fr = rr * 0.15915494309189535f;
          ((float2*)(ws + OFF_ROPE))[e] = make_float2(__builtin_amdgcn_cosf(fr), __builtin_amdgcn_sinf(fr));
        }
      }
    } break;
    case 1: {
      const int nt_main = 32 * 61;
      for (int v = bid; v < nt_main + 32; v += G) {
        if (v < nt_main) {
          f32x16 acc[2][4];
          acc_zero<2>(acc);
          int mt, nt;
          map_tile32(v, mt, nt);
          const int m0 = mt * 256, n0 = nt * 256;
          PlainPtr af{(const bfr*)(ws + OFF_N) + (size_t)m0 * 2048, 2048};
          PlainPtr bf{(const bfr*)(ws + OFF_WINT) + (size_t)n0 * 2048, 2048};
          gemm_main<2>(acc, af, bf, 32, smem, tid);
          bfr* zcb = (bfr*)(ws + OFF_ZC);
          const float2* rope = (const float2*)(ws + OFF_ROPE);
          gemm_epi<2>(acc, m0, n0, tid, [&](int m, int n, float a, float b, float c, float d) {
            if (n >= ZS) return;
            bfr* dst = z + (size_t)m * ZS + n;
            const int t = m & 2047;
            if (n >= ZC_KC && n < ZC_KS) {
              const float* pe = (n < ZC_VC) ? p.pe_k : p.pe_v;
              const int dd = n & 127;
              const float4 plo = *(const float4*)(pe + (t & 15) * 128 + dd);
              const float4 phi = *(const float4*)(pe + (16 + (t & 15)) * 128 + dd);
              st_bf4(zcb + (size_t)m * 2048 + (n - ZC_KC), a + plo.x, b + plo.y, c + plo.z, d + plo.w);
              st_bf4(zcb + (size_t)m * 2048 + 1024 + (n - ZC_KC), a + phi.x, b + phi.y, c + phi.z, d + phi.w);
            } else if (n >= ZC_QR && n < ZC_VR) {
              const int i0 = (n & 127) >> 1;
              const float2 c0 = rope[t * 64 + i0], c1 = rope[t * 64 + i0 + 1];
              float o0 = a * c0.x - b * c0.y, o1 = a * c0.y + b * c0.x;
              float o2 = c * c1.x - d * c1.y, o3 = c * c1.y + d * c1.x;
              if (n >= ZC_KR) { const float sc = 0.08838834764831845f; o0 *= sc; o1 *= sc; o2 *= sc; o3 *= sc; }
              st_bf4(dst, o0, o1, o2, o3);
            } else if (n >= ZC_GR && n < ZC_GA) {
              st_bf4(dst, a * sigmoidf_(a), b * sigmoidf_(b), c * sigmoidf_(c), d * sigmoidf_(d));
            } else if (n >= ZC_GA) {
              st_bf4(dst, sigmoidf_(a), sigmoidf_(b), sigmoidf_(c), sigmoidf_(d));
            } else {
              st_bf4(dst, a, b, c, d);
            }
          });
        } else {
          f32x16 acc[1][4];
          acc_zero<1>(acc);
          const int u = v - nt_main, which = u >> 4, mt = (u & 15) >> 2, nt = u & 3;
          const int m0 = mt * 256, n0 = nt * 128;
          PlainPtr af{(const bfr*)(ws + OFF_MN) + (size_t)m0 * 2048, 2048};
          PlainPtr bf{(const bfr*)(ws + (which ? OFF_WVT : OFF_WKT)) + (size_t)n0 * 2048, 2048};
          gemm_main<1>(acc, af, bf, 32, smem, tid);
          bfr* dstb = (bfr*)(ws + (which ? OFF_VX : OFF_KX));
          gemm_epi<1>(acc, m0, n0, tid, [&](int m, int n, float a, float b, float c, float d) { st_bf4(dstb + (size_t)m * 512 + n, a, b, c, d); });
        }
      }
    } break;
    case 2: {
      for (int it = grab(ctr + 0, slot, tid); it < 128; it = grab(ctr + 0, slot, tid)) {
        const int which = it >> 6, mt = (it & 63) >> 3, nt = it & 7;
        const int m0 = mt * 256, n0 = nt * 128;
        f32x16 acc[1][4];
        acc_zero<1>(acc);
        struct GatherA {
          const bfr* base; int m0;
          DI int rowoff(int row) const {
            const int R = m0 + row;
            const int bb = R >> 9, g = (R >> 7) & 3;
            int c = R & 127; c = c > 126 ? 126 : c;
            return (bb * SEQ + c * 16) * 2048 + g * 128;
          }
          DI int koff(int kk) const { const int l = kk >> 7; return l * 2048 + ((l >> 4) << 10) + (kk & 127); }
        };
        GatherA af{(const bfr*)(ws + OFF_ZC) + which * 512, m0};
        PlainPtr bf{(const bfr*)(ws + OFF_W1T) + (size_t)which * 1024 * 4096 + (size_t)n0 * 4096, 4096};
        gemm_main<1>(acc, af, bf, 64, smem, tid);
        bfr* hid = (bfr*)(ws + OFF_HIDC) + (size_t)which * 2048 * 1024;
        gemm_epi<1>(acc, m0, n0, tid, [&](int m, int n, float a, float b, float c, float d) {
          st_bf4(hid + (size_t)m * 1024 + n, a * sigmoidf_(a), b * sigmoidf_(b), c * sigmoidf_(c), d * sigmoidf_(d));
        });
      }
      for (int it = grab(ctr + 1, slot, tid); it < 1024; it = grab(ctr + 1, slot, tid)) {
        if (it < 512) attn_item<MODE_RET>(p, it, smem, tid);
        else attn_item<MODE_WIN>(p, it - 512, smem, tid);
      }
    } break;
    case 3: {
      for (int it = bid; it < 16 + NTOK / 2; it += G) {
        if (it >= 16) { ret_finish_row(p, (it - 16) * 2 + (tid >> 8), tid & 255); continue; }
        const int which = it >> 3, mt = it & 7;
        const int m0 = mt * 256;
        f32x16 acc[1][4];
        acc_zero<1>(acc);
        PlainPtr af{(const bfr*)(ws + OFF_HIDC) + (size_t)which * 2048 * 1024 + (size_t)m0 * 1024, 1024};
        PlainPtr bf{(const bfr*)(ws + OFF_W2T) + (size_t)which * 128 * 1024, 1024};
        gemm_main<1>(acc, af, bf, 16, smem, tid);
        bfr* dstb = (bfr*)(ws + OFF_KCVC) + (size_t)which * 2048 * 128;
        gemm_epi<1>(acc, m0, 0, tid, [&](int m, int n, float a, float b, float c, float d) { st_bf4(dstb + (size_t)m * 128 + n, a, b, c, d); });
      }
    } break;
    case 4: {
      for (int it = bid; it < 512; it += G) cmp_item(p, it, smem, tid);
    } break;
    case 5: {
      for (int it = grab(ctr + 2, slot, tid); it < 512; it = grab(ctr + 2, slot, tid)) attn_item<MODE_SEL>(p, it, smem, tid);
    } break;
    case 6: {
      for (int v = bid; v < 32 * 8; v += G) {
        int mt, nt;
        map_tile32(v, mt, nt);
        const int m0 = mt * 256, n0 = nt * 256;
        f32x16 acc[2][4];
        acc_zero<2>(acc);
        bfr* mg = (bfr*)(ws + OFF_MERGED);
        {
          PlainPtr af{(const bfr*)(ws + OFF_ONSA) + (size_t)m0 * 2048, 2048};
          PlainPtr bf{(const bfr*)(ws + OFF_WAT) + (size_t)n0 * 2048, 2048};
          gemm_main<2>(acc, af, bf, 32, smem, tid);
          gemm_epi<2>(acc, m0, n0, tid, [&](int m, int n, float a, float b, float c, float d) {
            const uint2 ga = *(const uint2*)(z + (size_t)m * ZS + ZC_GA + n);
            st_bf4(mg + (size_t)m * 2048 + n, bflo(ga.x) * a, bfhi(ga.x) * b, bflo(ga.y) * c, bfhi(ga.y) * d);
          });
        }
        acc_zero<2>(acc);
        {
          PlainPtr af{(const bfr*)(ws + OFF_ORET) + (size_t)m0 * 2048, 2048};
          PlainPtr bf{(const bfr*)(ws + OFF_WBT) + (size_t)n0 * 2048, 2048};
          gemm_main<2>(acc, af, bf, 32, smem, tid);
          gemm_epi<2>(acc, m0, n0, tid, [&](int m, int n, float a, float b, float c, float d) {
            const uint2 gb = *(const uint2*)(z + (size_t)m * ZS + ZC_GB + n);
            bfr* dst = mg + (size_t)m * 2048 + n;
            const uint2 old = *(const uint2*)dst;
            st_bf4(dst, bflo(old.x) + bflo(gb.x) * a, bfhi(old.x) + bfhi(gb.x) * b, bflo(old.y) + bflo(gb.y) * c, bfhi(old.y) + bfhi(gb.y) * d);
          });
        }
      }
    } break;
    case 7: {
      for (int v = bid; v < 32 * 8; v += G) {
        int mt, nt;
        map_tile32(v, mt, nt);
        const int m0 = mt * 256, n0 = nt * 256;
        f32x16 acc[2][4];
        acc_zero<2>(acc);
        PlainPtr af{(const bfr*)(ws + OFF_MERGED) + (size_t)m0 * 2048, 2048};
        PlainPtr bf{(const bfr*)(ws + OFF_WOUTT) + (size_t)n0 * 2048, 2048};
        gemm_main<2>(acc, af, bf, 32, smem, tid);
        gemm_epi_resid(acc, m0, n0, tid, p.x, (float*)(ws + OFF_H), (bfr*)(ws + OFF_NX), (float*)(ws + OFF_ROWSS));
      }
    } break;
    case 8: case 12: break;
    case 9: {
      const int ng = (G > 128) ? 128 : G;
      if (G > 128) { if (bid >= 128) tr_run(p, 12, bid - 128, G - 128, tjob_tiles(12), (float*)smem, tid); }
      else tr_run(p, 12, bid, G, tjob_tiles(12), (float*)smem, tid);
      if (bid < ng)
      for (int v = bid; v < 32 * 4; v += ng) {
        int mt, nt;
        map_tile32(v, mt, nt);
        const int m0 = mt * 256, n0 = nt * 128;
        f32x16 acc[1][4];
        acc_zero<1>(acc);
        PlainPtr af{(const bfr*)(ws + OFF_NX) + (size_t)m0 * 2048, 2048};
        PlainPtr bf{(const bfr*)(ws + OFF_WQT) + (size_t)n0 * 2048, 2048};
        gemm_main<1>(acc, af, bf, 32, smem, tid);
        bfr* qx = (bfr*)(ws + OFF_QX);
        const float* rss = (const float*)(ws + OFF_ROWSS);
        gemm_epi<1>(acc, m0, n0, tid, [&](int m, int n, float a, float b, float c, float d) {
          const float rs = rsqrtf(rss[m] * (1.f / 2048.f) + 1e-6f);
          st_bf4(qx + (size_t)m * 512 + n, a * rs, b * rs, c * rs, d * rs);
        });
      }
    } break;
    case 10: {
      const int ng = (G > 128) ? 128 : G;
      if (G > 128) { if (bid >= 128) tr_run(p, 13, bid - 128, G - 128, tjob_tiles(13), (float*)smem, tid); }
      else tr_run(p, 13, bid, G, tjob_tiles(13), (float*)smem, tid);
      if (bid < ng)
        for (int it = bid; it < 128; it += ng) attn_item<MODE_X>(p, it, smem, tid);
    } break;
    case 11: {
      for (int v = bid; v < 32 * 8; v += G) {
        int mt, nt;
        map_tile32(v, mt, nt);
        const int m0 = mt * 256, n0 = nt * 256;
        f32x16 acc[2][4];
        acc_zero<2>(acc);
        PlainPtr af{(const bfr*)(ws + OFF_OX) + (size_t)m0 * 512, 512};
        PlainPtr bf{(const bfr*)(ws + OFF_WOT) + (size_t)n0 * 512, 512};
        gemm_main<2>(acc, af, bf, 8, smem, tid);
        gemm_epi_resid(acc, m0, n0, tid, (const float*)(ws + OFF_H), (float*)(ws + OFF_H), (bfr*)(ws + OFF_NX), (float*)(ws + OFF_ROWSS) + NTOK);
      }
    } break;
    case 13: {
      for (int v = bid; v < 32 * 32; v += G) {
        int mt, nt;
        map_tile32(v, mt, nt);
        const int m0 = mt * 256, n0 = nt * 256;
        f32x16 acc[2][4];
        acc_zero<2>(acc);
        PlainPtr af{(const bfr*)(ws + OFF_NX) + (size_t)m0 * 2048, 2048};
        PlainPtr bf{(const bfr*)(ws + OFF_WUPT) + (size_t)n0 * 2048, 2048};
        gemm_main<2>(acc, af, bf, 32, smem, tid);
        bfr* hid = (bfr*)(ws + OFF_HID);
        const float* rss = (const float*)(ws + OFF_ROWSS) + NTOK;
        gemm_epi<2>(acc, m0, n0, tid, [&](int m, int n, float a, float b, float c, float d) {
          const float rs = rsqrtf(rss[m] * (1.f / 2048.f) + 1e-6f);
          a = fmaxf(a, 0.f) * rs; b = fmaxf(b, 0.f) * rs; c = fmaxf(c, 0.f) * rs; d = fmaxf(d, 0.f) * rs;
          st_bf4(hid + (size_t)m * 8192 + n, a * a, b * b, c * c, d * d);
        });
      }
    } break;
    case 14: {
      for (int v = bid; v < 32 * 8; v += G) {
        int mt, nt;
        map_tile32(v, mt, nt);
        const int m0 = mt * 256, n0 = nt * 256;
        f32x16 acc[2][4];
        acc_zero<2>(acc);
        PlainPtr af{(const bfr*)(ws + OFF_HID) + (size_t)m0 * 8192, 8192};
        PlainPtr bf{(const bfr*)(ws + OFF_WDOWNT) + (size_t)n0 * 8192, 8192};
        gemm_main<2>(acc, af, bf, 128, smem, tid);
        const float* hbuf = (const float*)(ws + OFF_H);
        gemm_epi<2>(acc, m0, n0, tid, [&](int m, int n, float a, float b, float c, float d) {
          const float4 xv = *(const float4*)(hbuf + (size_t)m * 2048 + n);
          *(float4*)(p.out + (size_t)m * 2048 + n) = make_float4(xv.x + a, xv.y + b, xv.z + c, xv.w + d);
        });
      }
    } break;
    case 15: {
      for (int it = bid; it < 1024; it += G) {
        const int row = it * 8 + (tid >> 6);
        rmsnorm_row(p.out + (size_t)row * 2048, p.final_norm_w, nullptr, p.out + (size_t)row * 2048, tid);
      }
    } break;
    default: break;
  }
}

__global__ void __launch_bounds__(512, 2) mega(Params p) {
  extern __shared__ __attribute__((aligned(1024))) char smem[];
  __shared__ int slot;
  cg::grid_group grid = cg::this_grid();
  const int wave_s = __builtin_amdgcn_readfirstlane((int)(threadIdx.x >> 6));
  for (int ph = p.ph_lo; ph < p.ph_hi; ++ph) {
    if (ph == 8 || ph == 12) continue;
    run_phase(p, ph, smem, &slot, wave_s, 0);
#ifdef PROBE_PH
    if (ph == PROBE_PH)
      for (int rep = 1; rep <= PROBE_N; ++rep) { grid.sync(); run_phase(p, ph, smem, &slot, wave_s, rep); }
#endif
    if (ph + 1 < p.ph_hi) grid.sync();
  }
}

extern "C" void kernel_launch(void* const* d_in, const int* in_sizes, int n_in, void* d_out, int out_size, void* d_ws,
                              size_t ws_size, hipStream_t stream) {
  static int grid_blocks = 0;
  if (!grid_blocks) {
    int dev = 0, cus = 0, per_cu = 0;
    (void)hipGetDevice(&dev);
    (void)hipDeviceGetAttribute(&cus, hipDeviceAttributeMultiprocessorCount, dev);
    (void)hipFuncSetAttribute((const void*)mega, hipFuncAttributeMaxDynamicSharedMemorySize, SMEM_BYTES);
    (void)hipOccupancyMaxActiveBlocksPerMultiprocessor(&per_cu, mega, NTHR, SMEM_BYTES);
    if (per_cu < 1) per_cu = 1;
    if (per_cu > 1) per_cu = 1;
    grid_blocks = cus * per_cu;
    grid_blocks &= ~7;
    if (ws_size < WS_END || n_in != 24) { fprintf(stderr, "kernel_launch: ws %zu < %zu or n_in %d\n", ws_size, (size_t)WS_END, n_in); grid_blocks = -1; }
  }
  if (grid_blocks < 0) return;
  Params p{};
  const float** pp = (const float**)&p;
  for (int i = 0; i < 24; ++i) pp[i] = (const float*)d_in[i];
  p.out = (float*)d_out;
  p.ws = (char*)d_ws;
#if ONE_LAUNCH
  p.ph_lo = 0; p.ph_hi = NPHASE;
  void* args[] = {&p};
  hipError_t e = hipLaunchCooperativeKernel((void*)mega, dim3(grid_blocks), dim3(NTHR), args, SMEM_BYTES, stream);
  if (e != hipSuccess) fprintf(stderr, "cooperative launch failed: %s (grid %d)\n", hipGetErrorString(e), grid_blocks);
#else
  for (int ph = 0; ph < NPHASE; ++ph) {
    p.ph_lo = ph; p.ph_hi = ph + 1;
    hipLaunchKernelGGL(mega, dim3(grid_blocks), dim3(NTHR), SMEM_BYTES, stream, p);
  }
#endif
}
```

```cpp
#include <hip/hip_runtime.h>
#include <hip/hip_cooperative_groups.h>
#include <cstdio>
namespace cg = cooperative_groups;

#ifndef ONE_LAUNCH
#define ONE_LAUNCH 1
#endif

#define DI __device__ __forceinline__
typedef unsigned short bfr;
using bf16x8 = __attribute__((ext_vector_type(8))) short;
using s16x4 = __attribute__((ext_vector_type(4))) short;
using f32x16 = __attribute__((ext_vector_type(16))) float;
using u32x4 = __attribute__((ext_vector_type(4))) unsigned;
#define MFMA(a, b, c) __builtin_amdgcn_mfma_f32_32x32x16_bf16((a), (b), (c), 0, 0, 0)

constexpr int DM = 2048, SEQ = 2048, NTOK = 8192;
constexpr int ZS = 15488;
constexpr int ZC_Q = 0, ZC_KC = 2048, ZC_VC = 2560, ZC_KS = 3072, ZC_VS = 3584, ZC_KW = 4096, ZC_VW = 4608,
              ZC_QR = 5120, ZC_KR = 6144, ZC_VR = 7168, ZC_GR = 9216, ZC_GA = 11264, ZC_GB = 13312, ZC_GN = 15360;
constexpr int NPHASE = 16;

constexpr int ZSP = 15616;
constexpr size_t SZ_WINT = (size_t)ZSP * 2048 * 2;
constexpr size_t SZ_ACT = (size_t)NTOK * 2048 * 2;
constexpr size_t OFF_WINT = 0;
constexpr size_t OFF_N = OFF_WINT + SZ_WINT;
constexpr size_t OFF_MERGED = OFF_WINT;
constexpr size_t OFF_ORET = OFF_N;
constexpr size_t OFF_WUPT = 0;
constexpr size_t OFF_WDOWNT = SZ_ACT;
constexpr size_t OFF_Z = OFF_N + SZ_ACT;
constexpr size_t SZ_Z = (size_t)NTOK * ZS * 2;
constexpr size_t OFF_HID = OFF_Z;
constexpr size_t OFF_H = OFF_Z + (size_t)NTOK * 8192 * 2;
constexpr size_t OFF_NX = OFF_H + (size_t)NTOK * 2048 * 4;
constexpr size_t OFF_QX = OFF_NX + SZ_ACT;
constexpr size_t OFF_OX = OFF_QX + (size_t)NTOK * 512 * 2;
static_assert(OFF_OX + (size_t)NTOK * 512 * 2 <= OFF_Z + SZ_Z, "alias overflow");
constexpr size_t OFF_ZC = OFF_Z + SZ_Z;
constexpr size_t OFF_MN = OFF_ZC + (size_t)NTOK * 2048 * 2;
constexpr size_t OFF_W1T = OFF_MN + (size_t)1024 * 2048 * 2;
constexpr size_t OFF_W2T = OFF_W1T + (size_t)2 * 1024 * 4096 * 2;
constexpr size_t OFF_WAT = OFF_W2T + (size_t)2 * 128 * 1024 * 2;
constexpr size_t OFF_WBT = OFF_WAT + (size_t)2048 * 2048 * 2;
constexpr size_t OFF_WOUTT = OFF_WBT + (size_t)2048 * 2048 * 2;
constexpr size_t OFF_WQT = OFF_WOUTT + (size_t)2048 * 2048 * 2;
constexpr size_t OFF_WKT = OFF_WQT + (size_t)512 * 2048 * 2;
constexpr size_t OFF_WVT = OFF_WKT + (size_t)512 * 2048 * 2;
constexpr size_t OFF_WOT = OFF_WVT + (size_t)512 * 2048 * 2;
constexpr size_t OFF_ROPE = OFF_WOT + (size_t)512 * 2048 * 2;
constexpr size_t OFF_HIDC = OFF_ROPE + (size_t)2048 * 64 * 8;
constexpr size_t OFF_KCVC = OFF_HIDC + (size_t)2 * 2048 * 1024 * 2;
constexpr size_t OFF_SELM = OFF_KCVC + (size_t)2 * 2048 * 128 * 2;
constexpr size_t OFF_ONSA = OFF_SELM + (size_t)16 * 2048 * 4;
constexpr size_t OFF_KX = OFF_ONSA + SZ_ACT;
constexpr size_t OFF_VX = OFF_KX + (size_t)1024 * 512 * 2;
constexpr size_t OFF_RSTAT = OFF_VX + (size_t)1024 * 512 * 2;
constexpr size_t OFF_CTR = OFF_RSTAT + (size_t)NTOK * 8 * 2 * 2 * 4;
constexpr size_t OFF_ROWSS = OFF_CTR + 256;
constexpr size_t WS_END = OFF_ROWSS + (size_t)2 * NTOK * 4;

struct Params {
  const float *x, *mem, *attn_norm_w, *w_in, *pe_k, *w1k, *w2k, *pe_v, *w1v, *w2v, *w_a, *gn_w, *w_b, *w_out, *x_norm_w,
      *mem_norm_w, *wq, *wk, *wv, *wo, *mlp_norm_w, *w_up, *w_down, *final_norm_w;
  float* out;
  char* ws;
  int ph_lo, ph_hi;
  int dbg, pad;
};

constexpr int NTHR = 512;
constexpr int SMEM_BYTES = 131072;
__device__ const float ROPE_INV[64] = {1.0f, 0.865964353f, 0.749894261f, 0.649381638f, 0.562341332f, 0.486967534f, 0.421696514f, 0.365174115f, 0.316227764f, 0.273841977f, 0.237137377f, 0.2053525f, 0.177827939f, 0.153992653f, 0.133352131f, 0.115478203f, 0.100000001f, 0.0865964293f, 0.0749894157f, 0.0649381652f, 0.0562341325f, 0.0486967526f, 0.0421696529f, 0.0365174115f, 0.0316227749f, 0.0273841973f, 0.0237137377f, 0.0205352511f, 0.0177827943f, 0.0153992651f, 0.0133352149f, 0.0115478206f, 0.00999999978f, 0.00865964312f, 0.00749894185f, 0.00649381615f, 0.00562341325f, 0.00486967526f, 0.00421696482f, 0.00365174119f, 0.00316227763f, 0.00273841969f, 0.00237137359f, 0.00205352483f, 0.00177827943f, 0.00153992651f, 0.00133352145f, 0.0011547819f, 0.00100000005f, 0.000865964335f, 0.000749894243f, 0.000649381662f, 0.000562341302f, 0.000486967532f, 0.000421696517f, 0.000365174143f, 0.000316227757f, 0.000273841957f, 0.00023713737f, 0.00020535251f, 0.00017782794f, 0.000153992645f, 0.00013335215f, 0.0001154782f};

DI unsigned pack2(float a, float b) {
  typedef float f2 __attribute__((ext_vector_type(2)));
  typedef __bf16 b2 __attribute__((ext_vector_type(2)));
  f2 v = {a, b};
  b2 r = __builtin_convertvector(v, b2);
  return __builtin_bit_cast(unsigned, r);
}
DI float bflo(unsigned u) { return __uint_as_float(u << 16); }
DI float bfhi(unsigned u) { return __uint_as_float(u & 0xffff0000u); }
DI void st_bf4(bfr* p, float a, float b, float c, float d) {
  uint2 v; v.x = pack2(a, b); v.y = pack2(c, d);
  *(uint2*)p = v;
}
DI float wave_sum(float v) {
#pragma unroll
  for (int o = 32; o > 0; o >>= 1) v += __shfl_xor(v, o);
  return v;
}
DI float sigmoidf_(float x) { return 1.f / (1.f + __expf(-x)); }
DI int crow(int i, int h) { return (i & 3) + 8 * (i >> 2) + 4 * h; }
DI bf16x8 pack8(const f32x16& x, int s) {
  unsigned a = pack2(x[8 * s], x[8 * s + 1]), b = pack2(x[8 * s + 2], x[8 * s + 3]), c = pack2(x[8 * s + 4], x[8 * s + 5]),
           d = pack2(x[8 * s + 6], x[8 * s + 7]);
  typedef unsigned u4 __attribute__((ext_vector_type(4)));
  u4 v = {a, b, c, d};
  return __builtin_bit_cast(bf16x8, v);
}
DI s16x4 tr_read(const bfr* p) {
  return __builtin_amdgcn_ds_read_tr16_b64_v4i16((__attribute__((address_space(3))) s16x4*)(p));
}

struct TJob { const float* src; bfr* dst; int K, N, ntn, perm; const float* kscale; };
DI TJob get_tjob(const Params& p, int j) {
  TJob t;
  char* ws = p.ws;
  switch (j) {
    case 0: t = {p.w_in, (bfr*)(ws + OFF_WINT), 2048, 15408, 122, 1, nullptr}; break;
    case 1: t = {p.w1k, (bfr*)(ws + OFF_W1T), 4096, 1024, 8, 0, nullptr}; break;
    case 2: t = {p.w1v, (bfr*)(ws + OFF_W1T) + (size_t)1024 * 4096, 4096, 1024, 8, 0, nullptr}; break;
    case 3: t = {p.w2k, (bfr*)(ws + OFF_W2T), 1024, 128, 1, 0, nullptr}; break;
    case 4: t = {p.w2v, (bfr*)(ws + OFF_W2T) + (size_t)128 * 1024, 1024, 128, 1, 0, nullptr}; break;
    case 5: t = {p.w_a, (bfr*)(ws + OFF_WAT), 2048, 2048, 16, 0, nullptr}; break;
    case 6: t = {p.w_b, (bfr*)(ws + OFF_WBT), 2048, 2048, 16, 0, nullptr}; break;
    case 7: t = {p.w_out, (bfr*)(ws + OFF_WOUTT), 2048, 2048, 16, 0, nullptr}; break;
    case 8: t = {p.wq, (bfr*)(ws + OFF_WQT), 2048, 512, 4, 0, p.x_norm_w}; break;
    case 9: t = {p.wk, (bfr*)(ws + OFF_WKT), 2048, 512, 4, 0, nullptr}; break;
    case 10: t = {p.wv, (bfr*)(ws + OFF_WVT), 2048, 512, 4, 0, nullptr}; break;
    case 11: t = {p.wo, (bfr*)(ws + OFF_WOT), 512, 2048, 16, 0, nullptr}; break;
    case 12: t = {p.w_up, (bfr*)(ws + OFF_WUPT), 2048, 8192, 64, 0, p.mlp_norm_w}; break;
    default: t = {p.w_down, (bfr*)(ws + OFF_WDOWNT), 8192, 2048, 16, 0, nullptr}; break;
  }
  return t;
}
DI int tjob_tiles(int j) {
  switch (j) {
    case 0: return 122 * 16;
    case 1: case 2: return 8 * 32;
    case 3: case 4: return 1 * 8;
    case 5: case 6: case 7: return 16 * 16;
    case 8: case 9: case 10: return 4 * 16;
    case 11: return 16 * 4;
    case 12: return 64 * 16;
    default: return 16 * 64;
  }
}
struct TrRegs { float4 v[8]; };
DI void tr_load(const TJob& t, int tile, TrRegs& rg, const int tid) {
  const int nkt = t.K >> 7;
  const int kt = tile % nkt, nt = tile / nkt;
  const int k0 = kt * 128, d0 = nt * 128;
  int scol0 = d0, nvalid = 128;
  if (t.perm) {
    if (d0 < 5120) scol0 = d0;
    else if (d0 < 15360) scol0 = d0 + 48;
    else { scol0 = d0 - 15360 + 5120; nvalid = (d0 == 15360) ? 48 : 0; }
  }
#pragma unroll
  for (int i = 0; i < 8; ++i) {
    const int row = i * 16 + (tid >> 5), col = (tid & 31) * 4;
    rg.v[i] = make_float4(0.f, 0.f, 0.f, 0.f);
    if (col < nvalid) rg.v[i] = *(const float4*)(t.src + (size_t)(k0 + row) * t.N + scol0 + col);
    if (t.kscale) { const float sc = t.kscale[k0 + row]; rg.v[i].x *= sc; rg.v[i].y *= sc; rg.v[i].z *= sc; rg.v[i].w *= sc; }
  }
}
DI void tr_to_lds(const TrRegs& rg, float* sm, const int tid) {
#pragma unroll
  for (int i = 0; i < 8; ++i) {
    const int row = i * 16 + (tid >> 5), col = (tid & 31) * 4;
    float* d = sm + row * 129 + col;
    d[0] = rg.v[i].x; d[1] = rg.v[i].y; d[2] = rg.v[i].z; d[3] = rg.v[i].w;
  }
}
DI void tr_store(const TJob& t, int tile, const float* sm, const int tid) {
  const int nkt = t.K >> 7;
  const int kt = tile % nkt, nt = tile / nkt;
  const int k0 = kt * 128, d0 = nt * 128;
  const int n = tid >> 2, kq = (tid & 3) * 8;
  bfr* drow = t.dst + (size_t)(d0 + n) * t.K + k0 + kq;
#pragma unroll
  for (int q = 0; q < 4; ++q) {
    const int kb = kq + 32 * q;
    const unsigned o0 = pack2(sm[(kb + 0) * 129 + n], sm[(kb + 1) * 129 + n]);
    const unsigned o1 = pack2(sm[(kb + 2) * 129 + n], sm[(kb + 3) * 129 + n]);
    const unsigned o2 = pack2(sm[(kb + 4) * 129 + n], sm[(kb + 5) * 129 + n]);
    const unsigned o3 = pack2(sm[(kb + 6) * 129 + n], sm[(kb + 7) * 129 + n]);
    *(uint4*)(drow + 32 * q) = make_uint4(o0, o1, o2, o3);
  }
}
DI void tr_decode(int it, int j_lo, int& j, int& rem) {
  j = j_lo; rem = it;
  while (rem >= tjob_tiles(j)) { rem -= tjob_tiles(j); ++j; }
}
DI void tr_run(const Params& p, int j_lo, int it0, int stride, int n_tiles, float* sm, const int tid) {
  if (it0 >= n_tiles) return;
  TrRegs rg;
  int j, rem;
  tr_decode(it0, j_lo, j, rem);
  TJob t = get_tjob(p, j);
  tr_load(t, rem, rg, tid);
  for (int it = it0; it < n_tiles; it += stride) {
    __syncthreads();
    tr_to_lds(rg, sm, tid);
    __syncthreads();
    const TJob tc = t;
    const int remc = rem;
    const int nx = it + stride;
    if (nx < n_tiles) {
      tr_decode(nx, j_lo, j, rem);
      t = get_tjob(p, j);
      tr_load(t, rem, rg, tid);
    }
    tr_store(tc, remc, sm, tid);
  }
  __syncthreads();
}

DI void rmsnorm_row(const float* xrow, const float* w, bfr* obf, float* of32, const int tid) {
  const int lane = tid & 63;
  float4 v[8];
  float ss = 0.f;
#pragma unroll
  for (int i = 0; i < 8; ++i) {
    v[i] = ((const float4*)xrow)[lane + 64 * i];
    ss += v[i].x * v[i].x + v[i].y * v[i].y + v[i].z * v[i].z + v[i].w * v[i].w;
  }
  ss = wave_sum(ss);
  const float rs = rsqrtf(ss * (1.f / 2048.f) + 1e-6f);
#pragma unroll
  for (int i = 0; i < 8; ++i) {
    const float4 ww = ((const float4*)w)[lane + 64 * i];
    const float a = v[i].x * rs * ww.x, b = v[i].y * rs * ww.y, c = v[i].z * rs * ww.z, d = v[i].w * rs * ww.w;
    if (obf) st_bf4(obf + (lane + 64 * i) * 4, a, b, c, d);
    else ((float4*)of32)[lane + 64 * i] = make_float4(a, b, c, d);
  }
}

struct PlainPtr {
  const bfr* base; int ld;
  DI int rowoff(int row) const { return row * ld; }
  DI int koff(int k0) const { return k0; }
};
#define WAIT_V(n) asm volatile("s_waitcnt vmcnt(%0)" ::"n"(n) : "memory")
#define WAIT_L(n) asm volatile("s_waitcnt lgkmcnt(%0)" ::"n"(n) : "memory")
#define RAW_BARRIER() do { WAIT_L(0); __builtin_amdgcn_s_barrier(); } while (0)
typedef __attribute__((address_space(3))) unsigned lds_u32;
constexpr int STAGE_B = 65536;
template <int NI, class AF, class BF>
DI void gemm_main(f32x16 (&acc)[NI][4], const AF& af, const BF& bf, int nk, char* smem, const int tid) {
  const int lane = tid & 63, r = lane & 31, h = lane >> 5;
  const int w = __builtin_amdgcn_readfirstlane(tid >> 6);
  const int wm = w & 1, wn = w >> 1;
  int ao[4], bo[2 * NI];
  {
    const int rl = lane >> 3, kc = (lane & 7) ^ (((w & 1) * 4 + (lane >> 4)) & 7);
#pragma unroll
    for (int i = 0; i < 4; ++i) ao[i] = af.rowoff((w + 8 * i) * 8 + rl) + 8 * kc;
#pragma unroll
    for (int i = 0; i < 2 * NI; ++i) bo[i] = bf.rowoff((w + 8 * i) * 8 + rl) + 8 * kc;
  }
  auto stage = [&](int buf, int kt) {
    const int ka = af.koff(kt * 64), kb = bf.koff(kt * 64);
    char* sbase = smem + buf * STAGE_B + w * 1024;
#pragma unroll
    for (int i = 0; i < 4; ++i)
      __builtin_amdgcn_global_load_lds((const unsigned*)(af.base + (ao[i] + ka)), (lds_u32*)(sbase + i * 8192), 16, 0, 0);
#pragma unroll
    for (int i = 0; i < 2 * NI; ++i)
      __builtin_amdgcn_global_load_lds((const unsigned*)(bf.base + (bo[i] + kb)), (lds_u32*)(sbase + 32768 + i * 8192), 16, 0, 0);
  };
  const int xr = (r >> 1) & 7;
  const int arow = (wm * 128 + r) * 128, brow = 32768 + (wn * 32 * NI + r) * 128;
  WAIT_V(0);
  __syncthreads();
  stage(0, 0);
  WAIT_V(0);
  RAW_BARRIER();
#pragma unroll 1
  for (int kt = 0; kt < nk; ++kt) {
    if (kt + 1 < nk) stage((kt + 1) & 1, kt + 1);
    const char* sb = smem + (kt & 1) * STAGE_B;
#pragma unroll
    for (int ks = 0; ks < 4; ++ks) {
      const int off = ((2 * ks + h) ^ xr) * 16;
      bf16x8 wf[NI], xf[4];
#pragma unroll
      for (int i = 0; i < NI; ++i) wf[i] = *(const bf16x8*)(sb + brow + i * 4096 + off);
#pragma unroll
      for (int i = 0; i < 4; ++i) xf[i] = *(const bf16x8*)(sb + arow + i * 4096 + off);
#pragma unroll
      for (int mi = 0; mi < 4; ++mi)
#pragma unroll
        for (int ni = 0; ni < NI; ++ni) acc[ni][mi] = MFMA(wf[ni], xf[mi], acc[ni][mi]);
    }
    WAIT_V(0);
    RAW_BARRIER();
  }
}
template <int NI>
DI void acc_zero(f32x16 (&acc)[NI][4]) {
#pragma unroll
  for (int a = 0; a < NI; ++a)
#pragma unroll
    for (int b = 0; b < 4; ++b)
#pragma unroll
      for (int i = 0; i < 16; ++i) acc[a][b][i] = 0.f;
}
template <int NI, class EPI>
DI void gemm_epi(const f32x16 (&acc)[NI][4], int m0, int n0, const int tid_in, const EPI& epi) {
  int tid = tid_in;
  asm volatile("" : "+v"(tid));
  const int lane = tid & 63, w = tid >> 6, r = lane & 31, h = lane >> 5;
  const int wm = w & 1, wn = w >> 1;
#pragma unroll
  for (int mi = 0; mi < 4; ++mi)
#pragma unroll
    for (int ni = 0; ni < NI; ++ni)
#pragma unroll
      for (int g = 0; g < 4; ++g) {
        const int n = n0 + wn * 32 * NI + ni * 32 + 8 * g + 4 * h;
        const int m = m0 + wm * 128 + mi * 32 + r;
        epi(m, n, acc[ni][mi][4 * g], acc[ni][mi][4 * g + 1], acc[ni][mi][4 * g + 2], acc[ni][mi][4 * g + 3]);
      }
}
DI void gemm_epi_resid(const f32x16 (&acc)[2][4], int m0, int n0, const int tid_in, const float* hsrc, float* hdst, bfr* hb, float* rowss) {
  int tid = tid_in;
  asm volatile("" : "+v"(tid));
  const int lane = tid & 63, w = tid >> 6, r = lane & 31, h = lane >> 5;
  const int wm = w & 1, wn = w >> 1;
#pragma unroll
  for (int mi = 0; mi < 4; ++mi) {
    const int m = m0 + wm * 128 + mi * 32 + r;
    float ss = 0.f;
#pragma unroll
    for (int ni = 0; ni < 2; ++ni)
#pragma unroll
      for (int g = 0; g < 4; ++g) {
        const int n = n0 + wn * 64 + ni * 32 + 8 * g + 4 * h;
        const float4 xv = *(const float4*)(hsrc + (size_t)m * 2048 + n);
        const float a = xv.x + acc[ni][mi][4 * g], b = xv.y + acc[ni][mi][4 * g + 1], c = xv.z + acc[ni][mi][4 * g + 2], d = xv.w + acc[ni][mi][4 * g + 3];
        *(float4*)(hdst + (size_t)m * 2048 + n) = make_float4(a, b, c, d);
        st_bf4(hb + (size_t)m * 2048 + n, a, b, c, d);
        ss += a * a + b * b + c * c + d * d;
      }
    ss += __shfl_xor(ss, 32);
    if (h == 0) atomicAdd(rowss + m, ss);
  }
}
DI void map_tile32(int v, int& mt, int& nt) {
  const int xcd = v & 7, j = v >> 3;
  nt = j >> 2;
  mt = xcd * 4 + (j & 3);
}

enum { MODE_WIN = 0, MODE_SEL = 1, MODE_X = 2, MODE_RET = 3 };
constexpr int KP = 136;

template <int MODE>
DI void attn_item(const Params& p, int item, char* smem, const int tid) {
  constexpr int VP = 136;
  bfr* Ks = (bfr*)smem;
  bfr* Vs = Ks + 64 * KP;
  const int w = tid >> 6, lane = tid & 63, r = lane & 31, h = lane >> 5;
  bfr* Qw = Vs + 64 * VP + w * 32 * KP;
  char* ws = p.ws;
  const bfr* z = (const bfr*)(ws + OFF_Z);

  int b, t0, tq0, jlo, jhi, head = 0, grp = 0, vh = 0;
  const bfr *qbase, *kbase, *vbase;
  int ldq, ldk;
  unsigned selm = 0, umask = 0xffffffffu;
  if (MODE == MODE_WIN) {
    const int tb = item >> 4, bg = item & 15;
    b = bg >> 2; grp = bg & 3; t0 = tb * 64; tq0 = t0 + 32 * (w >> 2); head = grp * 4 + (w & 3);
    qbase = z + (size_t)(b * SEQ + tq0) * ZS + ZC_Q + head * 128; ldq = ZS;
    kbase = z + (size_t)(b * SEQ) * ZS + ZC_KW + grp * 128;
    vbase = z + (size_t)(b * SEQ) * ZS + ZC_VW + grp * 128;
    ldk = ZS;
    jlo = (t0 - 511 > 0 ? t0 - 511 : 0) >> 6;
    jhi = tb;
  } else if (MODE == MODE_SEL) {
    const int tb = 31 - (item >> 4), bg = item & 15;
    b = bg >> 2; grp = bg & 3; t0 = tb * 64; tq0 = t0 + 32 * (w >> 2); head = grp * 4 + (w & 3);
    qbase = z + (size_t)(b * SEQ + tq0) * ZS + ZC_Q + head * 128; ldq = ZS;
    kbase = z + (size_t)(b * SEQ) * ZS + ZC_KS + grp * 128;
    vbase = z + (size_t)(b * SEQ) * ZS + ZC_VS + grp * 128;
    ldk = ZS;
    jlo = 0;
    jhi = tb;
    const unsigned* sm = (const unsigned*)(ws + OFF_SELM) + (b * 4 + grp) * SEQ;
    selm = sm[tq0 + r];
    unsigned u = sm[t0 + lane];
#pragma unroll
    for (int o = 32; o > 0; o >>= 1) u |= (unsigned)__shfl_xor((int)u, o);
    umask = (unsigned)__builtin_amdgcn_readfirstlane((int)u);
    umask &= (jhi >= 31) ? 0xffffffffu : ((1u << (jhi + 1)) - 1u);
  } else if (MODE == MODE_X) {
    const int tb = item >> 4, bh = item & 15;
    b = bh >> 2; head = bh & 3; t0 = tb * 256; tq0 = t0 + 32 * w;
    qbase = (const bfr*)(ws + OFF_QX) + (size_t)(b * SEQ + tq0) * 512 + head * 128; ldq = 512;
    kbase = (const bfr*)(ws + OFF_KX) + (size_t)(b * 256) * 512 + head * 128;
    vbase = (const bfr*)(ws + OFF_VX) + (size_t)(b * 256) * 512 + head * 128;
    ldk = 512;
    jlo = 0; jhi = 3;
  } else {
    const int tb = 7 - (item >> 6), rest = item & 63;
    b = rest >> 4; head = (rest >> 1) & 7; vh = rest & 1; t0 = tb * 256; tq0 = t0 + 32 * w;
    qbase = z + (size_t)(b * SEQ + tq0) * ZS + ZC_QR + head * 128; ldq = ZS;
    kbase = z + (size_t)(b * SEQ) * ZS + ZC_KR + head * 128;
    vbase = z + (size_t)(b * SEQ) * ZS + ZC_VR + head * 256 + vh * 128;
    ldk = ZS;
    jlo = 0; jhi = 4 * tb + 3;
  }
  const int tq = tq0 + r;

  f32x16 o[4];
#pragma unroll
  for (int dt = 0; dt < 4; ++dt)
#pragma unroll
    for (int i = 0; i < 16; ++i) o[dt][i] = 0.f;
  float m_run = -INFINITY, l_run = 0.f;
  float lg = 0.f;
  float rf[16];
  if (MODE == MODE_RET) {
    lg = log1pf(-exp2f(-5.f - (float)head)) * 1.4426950408889634f;
#pragma unroll
    for (int i = 0; i < 16; ++i) rf[i] = __builtin_amdgcn_exp2f(-lg * (float)crow(i, h));
  }

  u32x4 kreg[2], vreg[2];
  auto gload = [&](int j) {
    const int k0 = j * 64;
#pragma unroll
    for (int i = 0; i < 2; ++i) {
      const int c = tid + 512 * i, row = c >> 4, cc = c & 15;
      kreg[i] = *(const u32x4*)(kbase + (size_t)(k0 + row) * ldk + cc * 8);
      vreg[i] = *(const u32x4*)(vbase + (size_t)(k0 + row) * ldk + cc * 8);
    }
  };
  auto swrite = [&]() {
#pragma unroll
    for (int i = 0; i < 2; ++i) {
      const int c = tid + 512 * i, row = c >> 4, cc = c & 15;
      *(u32x4*)(Ks + row * KP + cc * 8) = kreg[i];
      *(u32x4*)(Vs + row * VP + cc * 8) = vreg[i];
    }
  };
  auto next_j = [&](int j) -> int {
    if (MODE == MODE_SEL) {
      const unsigned rem = (j >= 31) ? 0u : (umask & ~((2u << j) - 1u));
      return rem ? (__builtin_ctz(rem)) : 64;
    }
    return j + 1;
  };
  int j = jlo;
  if (MODE == MODE_SEL) j = __builtin_ctz(umask);
  gload(j);
  __syncthreads();
  {
    u32x4 qreg[8];
#pragma unroll
    for (int i = 0; i < 8; ++i) {
      const int c = lane + 64 * i, row = c >> 4, cc = c & 15;
      qreg[i] = *(const u32x4*)(qbase + (size_t)row * ldq + cc * 8);
    }
#pragma unroll
    for (int i = 0; i < 8; ++i) {
      const int c = lane + 64 * i, row = c >> 4, cc = c & 15;
      *(u32x4*)(Qw + row * KP + cc * 8) = qreg[i];
    }
  }
  const float csc = 0.08838834764831845f * 1.4426950408889634f;
  const int q4 = (lane & 15) >> 2, p4 = lane & 3, blk = (lane >> 4) & 1;
  bool first = true;
#pragma unroll 1
  while (j <= jhi) {
    if (!first) __syncthreads();
    first = false;
    swrite();
    __syncthreads();
    const int jn = next_j(j);
    if (jn <= jhi) gload(jn);
    const int k0 = j * 64;
    if (MODE == MODE_RET && k0 > tq0 + 31) { j = jn; continue; }
    bf16x8 pf[2][2];
    if (MODE == MODE_RET) {
#pragma unroll
      for (int sub = 0; sub < 2; ++sub) {
        f32x16 sx;
#pragma unroll
        for (int i = 0; i < 16; ++i) sx[i] = 0.f;
#pragma unroll
        for (int s = 0; s < 8; ++s) {
          const bf16x8 kf = *(const bf16x8*)(Ks + (32 * sub + r) * KP + 16 * s + 8 * h);
          const bf16x8 qf = *(const bf16x8*)(Qw + r * KP + 16 * s + 8 * h);
          sx = MFMA(kf, qf, sx);
        }
        {
          const int dq = tq - (k0 + 32 * sub);
          const float cf = __builtin_amdgcn_exp2f(lg * (float)dq);
#pragma unroll
          for (int i = 0; i < 16; ++i) sx[i] = (crow(i, h) <= dq) ? sx[i] * (cf * rf[i]) : 0.f;
        }
        pf[sub][0] = pack8(sx, 0);
        pf[sub][1] = pack8(sx, 1);
      }
    } else {
      f32x16 s0, s1;
#pragma unroll
      for (int i = 0; i < 16; ++i) { s0[i] = 0.f; s1[i] = 0.f; }
#pragma unroll
      for (int s = 0; s < 8; ++s) {
        const bf16x8 k0f = *(const bf16x8*)(Ks + r * KP + 16 * s + 8 * h);
        const bf16x8 k1f = *(const bf16x8*)(Ks + (32 + r) * KP + 16 * s + 8 * h);
        const bf16x8 qf = *(const bf16x8*)(Qw + r * KP + 16 * s + 8 * h);
        s0 = MFMA(k0f, qf, s0);
        s1 = MFMA(k1f, qf, s1);
      }
      bool need_mask = false;
      if (MODE == MODE_WIN) need_mask = (k0 + 63 > tq0) || (k0 < tq0 + 31 - 511);
      if (MODE == MODE_SEL) need_mask = (k0 + 63 > tq0);
      const bool lanesel = (MODE == MODE_SEL) ? ((selm >> j) & 1u) : true;
      float mx = -INFINITY;
      if (need_mask) {
#pragma unroll
        for (int i = 0; i < 16; ++i) {
          const int tk0 = k0 + crow(i, h), tk1 = tk0 + 32;
          bool ok0 = true, ok1 = true;
          if (MODE == MODE_WIN) { ok0 = (tk0 <= tq) && (tq - tk0 < 512); ok1 = (tk1 <= tq) && (tq - tk1 < 512); }
          if (MODE == MODE_SEL) { ok0 = lanesel && (tk0 <= tq); ok1 = lanesel && (tk1 <= tq); }
          s0[i] = ok0 ? s0[i] * csc : -INFINITY;
          s1[i] = ok1 ? s1[i] * csc : -INFINITY;
          mx = fmaxf(mx, fmaxf(s0[i], s1[i]));
        }
      } else {
#pragma unroll
        for (int i = 0; i < 16; ++i) {
          s0[i] = lanesel ? s0[i] * csc : -INFINITY;
          s1[i] = lanesel ? s1[i] * csc : -INFINITY;
          mx = fmaxf(mx, fmaxf(s0[i], s1[i]));
        }
      }
      mx = fmaxf(mx, __shfl_xor(mx, 32));
      const float mnew = fmaxf(m_run, mx);
      const float muse = (mnew == -INFINITY) ? 0.f : mnew;
      const float alpha = __builtin_amdgcn_exp2f(m_run - muse);
      float ls = 0.f;
#pragma unroll
      for (int i = 0; i < 16; ++i) {
        s0[i] = __builtin_amdgcn_exp2f(s0[i] - muse);
        s1[i] = __builtin_amdgcn_exp2f(s1[i] - muse);
        ls += s0[i] + s1[i];
      }
      ls += __shfl_xor(ls, 32);
      l_run = l_run * alpha + ls;
      m_run = mnew;
      if (__builtin_amdgcn_ballot_w64(alpha != 1.f) != 0) {
#pragma unroll
        for (int dt = 0; dt < 4; ++dt)
#pragma unroll
          for (int i = 0; i < 16; ++i) o[dt][i] *= alpha;
      }
      pf[0][0] = pack8(s0, 0); pf[0][1] = pack8(s0, 1);
      pf[1][0] = pack8(s1, 0); pf[1][1] = pack8(s1, 1);
    }
#pragma unroll
    for (int dt = 0; dt < 4; ++dt)
#pragma unroll
      for (int sub = 0; sub < 2; ++sub)
#pragma unroll
        for (int st = 0; st < 2; ++st) {
          const int key0 = 32 * sub + 16 * st + 4 * h;
          const bfr* vp = Vs + (key0 + q4) * VP + 32 * dt + 16 * blk + 4 * p4;
          const s16x4 lo = tr_read(vp);
          const s16x4 hi = tr_read(vp + 8 * VP);
          const bf16x8 vf = __builtin_shufflevector(lo, hi, 0, 1, 2, 3, 4, 5, 6, 7);
          o[dt] = MFMA(vf, pf[sub][st], o[dt]);
        }
    j = jn;
  }

  if (MODE == MODE_SEL && p.dbg) return;
  const size_t mrow = (size_t)(b * SEQ + tq);
  if (MODE == MODE_WIN || MODE == MODE_SEL) {
    const float inv = (l_run > 0.f) ? 1.f / l_run : 0.f;
    const float gate = bflo(z[mrow * ZS + ZC_GN + head * 3 + (MODE == MODE_WIN ? 2 : 1)]);
    bfr* orow = (bfr*)(ws + OFF_ONSA) + mrow * 2048 + head * 128;
    const float sc = inv * gate;
#pragma unroll
    for (int dt = 0; dt < 4; ++dt)
#pragma unroll
      for (int g = 0; g < 4; ++g) {
        bfr* dst = orow + 32 * dt + 8 * g + 4 * h;
        float a = o[dt][4 * g] * sc, bb = o[dt][4 * g + 1] * sc, c = o[dt][4 * g + 2] * sc, d = o[dt][4 * g + 3] * sc;
        if (MODE == MODE_SEL) {
          const uint2 old = *(const uint2*)dst;
          a += bflo(old.x); bb += bfhi(old.x); c += bflo(old.y); d += bfhi(old.y);
        }
        st_bf4(dst, a, bb, c, d);
      }
  } else if (MODE == MODE_X) {
    const float inv = 1.f / l_run;
    bfr* orow = (bfr*)(ws + OFF_OX) + mrow * 512 + head * 128;
#pragma unroll
    for (int dt = 0; dt < 4; ++dt)
#pragma unroll
      for (int g = 0; g < 4; ++g)
        st_bf4(orow + 32 * dt + 8 * g + 4 * h, o[dt][4 * g] * inv, o[dt][4 * g + 1] * inv, o[dt][4 * g + 2] * inv,
               o[dt][4 * g + 3] * inv);
  } else {
    float sm = 0.f, sq = 0.f;
#pragma unroll
    for (int dt = 0; dt < 4; ++dt)
#pragma unroll
      for (int i = 0; i < 16; ++i) { sm += o[dt][i]; sq += o[dt][i] * o[dt][i]; }
    sm += __shfl_xor(sm, 32);
    sq += __shfl_xor(sq, 32);
    if (h == 0) *(float2*)((float*)(ws + OFF_RSTAT) + ((mrow * 8 + head) * 2 + vh) * 2) = make_float2(sm, sq);
    bfr* orow = (bfr*)(ws + OFF_ORET) + mrow * 2048 + head * 256 + vh * 128;
#pragma unroll
    for (int dt = 0; dt < 4; ++dt)
#pragma unroll
      for (int g = 0; g < 4; ++g)
        st_bf4(orow + 32 * dt + 8 * g + 4 * h, o[dt][4 * g], o[dt][4 * g + 1], o[dt][4 * g + 2], o[dt][4 * g + 3]);
  }
}

DI void ret_finish_row(const Params& p, int row, const int t) {
  char* ws = p.ws;
  const bfr* z = (const bfr*)(ws + OFF_Z);
  const int col = t * 8, head = t >> 5;
  const float4 st = *(const float4*)((const float*)(ws + OFF_RSTAT) + ((size_t)row * 8 + head) * 4);
  const float mu = (st.x + st.z) * (1.f / 256.f);
  const float var = fmaxf((st.y + st.w) * (1.f / 256.f) - mu * mu, 0.f);
  const float rstd = rsqrtf(var + 1e-6f);
  bfr* op = (bfr*)(ws + OFF_ORET) + (size_t)row * 2048 + col;
  const u32x4 ov = *(const u32x4*)op;
  const u32x4 gv = *(const u32x4*)(z + (size_t)row * ZS + ZC_GR + col);
  const float4 w0 = *(const float4*)(p.gn_w + col), w1 = *(const float4*)(p.gn_w + col + 4);
  u32x4 res;
  res[0] = pack2((bflo(ov[0]) - mu) * rstd * w0.x * bflo(gv[0]), (bfhi(ov[0]) - mu) * rstd * w0.y * bfhi(gv[0]));
  res[1] = pack2((bflo(ov[1]) - mu) * rstd * w0.z * bflo(gv[1]), (bfhi(ov[1]) - mu) * rstd * w0.w * bfhi(gv[1]));
  res[2] = pack2((bflo(ov[2]) - mu) * rstd * w1.x * bflo(gv[2]), (bfhi(ov[2]) - mu) * rstd * w1.y * bfhi(gv[2]));
  res[3] = pack2((bflo(ov[3]) - mu) * rstd * w1.z * bflo(gv[3]), (bfhi(ov[3]) - mu) * rstd * w1.w * bfhi(gv[3]));
  *(u32x4*)op = res;
}

DI void cmp_item(const Params& p, int item, char* smem, const int tid) {
  bfr* Ks = (bfr*)smem;
  float* impw = (float*)(smem + 128 * KP * 2);
  const int w = tid >> 6, lane = tid & 63, r = lane & 31, h = lane >> 5;
  char* ws = p.ws;
  const bfr* z = (const bfr*)(ws + OFF_Z);
  const int tb = item >> 4, bg = item & 15, b = bg >> 2, grp = bg & 3;
  const int t0 = tb * 64, ti = 32 * (w >> 2) + r, tq = t0 + ti, hw = w & 3, head = grp * 4 + hw;
  const bfr* qrow = z + (size_t)(b * SEQ + tq) * ZS + ZC_Q + head * 128;
  const bfr* kc = (const bfr*)(ws + OFF_KCVC) + (size_t)((b * 4 + grp) * 128) * 128;
  const bfr* vc = kc + (size_t)2048 * 128;
  bf16x8 qf[8];
#pragma unroll
  for (int s = 0; s < 8; ++s) qf[s] = *(const bf16x8*)(qrow + 16 * s + 8 * h);
  u32x4 reg[4];
#pragma unroll
  for (int i = 0; i < 4; ++i) {
    const int c = tid + 512 * i, row = c >> 4, cc = c & 15;
    reg[i] = *(const u32x4*)(kc + row * 128 + cc * 8);
  }
  __syncthreads();
#pragma unroll
  for (int i = 0; i < 4; ++i) {
    const int c = tid + 512 * i, row = c >> 4, cc = c & 15;
    *(u32x4*)(Ks + row * KP + cc * 8) = reg[i];
  }
  __syncthreads();
  f32x16 s[4];
#pragma unroll
  for (int kt = 0; kt < 4; ++kt) {
#pragma unroll
    for (int i = 0; i < 16; ++i) s[kt][i] = 0.f;
#pragma unroll
    for (int ss = 0; ss < 8; ++ss) {
      const bf16x8 kf = *(const bf16x8*)(Ks + (32 * kt + r) * KP + 16 * ss + 8 * h);
      s[kt] = MFMA(kf, qf[ss], s[kt]);
    }
  }
  const float csc = 0.08838834764831845f * 1.4426950408889634f;
  float mx = -INFINITY;
#pragma unroll
  for (int kt = 0; kt < 4; ++kt)
#pragma unroll
    for (int i = 0; i < 16; ++i) {
      const int c = 32 * kt + crow(i, h);
      const bool ok = (c * 16 + 31 <= tq) && (c < 127);
      s[kt][i] = ok ? s[kt][i] * csc : -INFINITY;
      mx = fmaxf(mx, s[kt][i]);
    }
  mx = fmaxf(mx, __shfl_xor(mx, 32));
  const float muse = (mx == -INFINITY) ? 0.f : mx;
  float ls = 0.f;
#pragma unroll
  for (int kt = 0; kt < 4; ++kt)
#pragma unroll
    for (int i = 0; i < 16; ++i) {
      s[kt][i] = __builtin_amdgcn_exp2f(s[kt][i] - muse);
      ls += s[kt][i];
    }
  ls += __shfl_xor(ls, 32);
  const float inv = (ls > 0.f) ? 1.f / ls : 0.f;
#pragma unroll
  for (int kt = 0; kt < 4; ++kt)
#pragma unroll
    for (int i = 0; i < 16; ++i) s[kt][i] *= inv;
  float plast[16];
#pragma unroll
  for (int kt = 0; kt < 4; ++kt)
#pragma unroll
    for (int g = 0; g < 4; ++g) plast[kt * 4 + g] = __shfl_xor(s[kt][4 * g + 3], 32);
#pragma unroll
  for (int kt = 0; kt < 4; ++kt)
#pragma unroll
    for (int g = 0; g < 4; ++g) {
      const int slot = kt * 4 + g;
      const float sum4 = s[kt][4 * g] + s[kt][4 * g + 1] + s[kt][4 * g + 2] + s[kt][4 * g + 3];
      const float prevl = (slot > 0) ? plast[slot > 0 ? slot - 1 : 0] : 0.f;
      const float add = h ? plast[slot] : prevl;
      impw[(hw * 64 + ti) * 32 + 8 * kt + 2 * g + h] = sum4 + add;
    }
  bf16x8 pf[4][2];
#pragma unroll
  for (int kt = 0; kt < 4; ++kt) { pf[kt][0] = pack8(s[kt], 0); pf[kt][1] = pack8(s[kt], 1); }
#pragma unroll
  for (int i = 0; i < 4; ++i) {
    const int c = tid + 512 * i, row = c >> 4, cc = c & 15;
    reg[i] = *(const u32x4*)(vc + row * 128 + cc * 8);
  }
  __syncthreads();
#pragma unroll
  for (int i = 0; i < 4; ++i) {
    const int c = tid + 512 * i, row = c >> 4, cc = c & 15;
    *(u32x4*)(Ks + row * KP + cc * 8) = reg[i];
  }
  __syncthreads();
  f32x16 o[4];
#pragma unroll
  for (int dt = 0; dt < 4; ++dt)
#pragma unroll
    for (int i = 0; i < 16; ++i) o[dt][i] = 0.f;
  const int q4 = (lane & 15) >> 2, p4 = lane & 3, blk = (lane >> 4) & 1;
#pragma unroll
  for (int dt = 0; dt < 4; ++dt)
#pragma unroll
    for (int kt = 0; kt < 4; ++kt)
#pragma unroll
      for (int st = 0; st < 2; ++st) {
        const int key0 = 32 * kt + 16 * st + 4 * h;
        const bfr* vp = Ks + (key0 + q4) * KP + 32 * dt + 16 * blk + 4 * p4;
        const s16x4 lo = tr_read(vp);
        const s16x4 hi = tr_read(vp + 8 * KP);
        const bf16x8 vf = __builtin_shufflevector(lo, hi, 0, 1, 2, 3, 4, 5, 6, 7);
        o[dt] = MFMA(vf, pf[kt][st], o[dt]);
      }
  {
    const size_t mrow = (size_t)(b * SEQ + tq);
    const float gate = bflo(z[mrow * ZS + ZC_GN + head * 3 + 0]);
    bfr* orow = (bfr*)(ws + OFF_ONSA) + mrow * 2048 + head * 128;
#pragma unroll
    for (int dt = 0; dt < 4; ++dt)
#pragma unroll
      for (int g = 0; g < 4; ++g) {
        bfr* dst = orow + 32 * dt + 8 * g + 4 * h;
        const uint2 old = *(const uint2*)dst;
        st_bf4(dst, o[dt][4 * g] * gate + bflo(old.x), o[dt][4 * g + 1] * gate + bfhi(old.x),
               o[dt][4 * g + 2] * gate + bflo(old.y), o[dt][4 * g + 3] * gate + bfhi(old.y));
      }
  }
  {
    const int i = tid >> 3, jg = tid & 7;
    const int cur = (t0 + i) >> 6;
    float vm[4];
#pragma unroll
    for (int e = 0; e < 4; ++e) {
      const int jme = 4 * jg + e;
      const float a = impw[(0 * 64 + i) * 32 + jme] + impw[(1 * 64 + i) * 32 + jme] + impw[(2 * 64 + i) * 32 + jme] + impw[(3 * 64 + i) * 32 + jme];
      const bool forced = (jme == 0) || (jme == cur) || (jme == cur - 1);
      vm[e] = forced ? INFINITY : ((jme > cur) ? -INFINITY : a);
    }
#pragma unroll
    for (int e = 0; e < 4; ++e) impw[i * 32 + 4 * jg + e] = vm[e];
    __syncthreads();
    int rank[4] = {0, 0, 0, 0};
#pragma unroll 4
    for (int k = 0; k < 32; ++k) {
      const float vk = impw[i * 32 + k];
#pragma unroll
      for (int e = 0; e < 4; ++e) rank[e] += (vk > vm[e] || (vk == vm[e] && k < 4 * jg + e)) ? 1 : 0;
    }
    unsigned bits = 0;
#pragma unroll
    for (int e = 0; e < 4; ++e)
      if (rank[e] < 16 && 4 * jg + e <= cur) bits |= 1u << (4 * jg + e);
    bits |= (unsigned)__shfl_xor((int)bits, 1);
    bits |= (unsigned)__shfl_xor((int)bits, 2);
    bits |= (unsigned)__shfl_xor((int)bits, 4);
    if (jg == 0) ((unsigned*)(ws + OFF_SELM))[(b * 4 + grp) * SEQ + t0 + i] = bits;
  }
  __syncthreads();
}

DI int grab(unsigned* ctr, int* slot, const int tid) {
  __syncthreads();
  if (tid == 0) *slot = (int)atomicAdd(ctr, 1u);
  __syncthreads();
  return *slot;
}

DI void run_phase(const Params& p0, int ph, char* smem, int* slot, const int wave_s, const int rep) {
  char* ws = p0.ws;
  asm volatile("" : "+s"(ws));
  Params p = p0;
  p.ws = ws;
  p.dbg = rep;
  const int G = gridDim.x;
  int bid = blockIdx.x;
  int tid = wave_s * 64 + (int)__builtin_amdgcn_mbcnt_hi(~0u, __builtin_amdgcn_mbcnt_lo(~0u, 0u));
  asm volatile("" : "+s"(bid));
  asm volatile("" : "+v"(tid));
  bfr* z = (bfr*)(ws + OFF_Z);
  unsigned* ctr = (unsigned*)(ws + OFF_CTR) + rep * 8;
  switch (ph) {
    case 0: {
      if (bid == 0 && tid < 64) ((unsigned*)(ws + OFF_CTR))[tid] = 0u;
      for (int i = bid * NTHR + tid; i < 2 * NTOK; i += G * NTHR) ((float*)(ws + OFF_ROWSS))[i] = 0.f;
      int tot = 0;
      for (int j = 0; j < 12; ++j) tot += tjob_tiles(j);
      const int n_norm = 1024 + 128, n_rope = 256;
      tr_run(p, 0, bid, G, tot, (float*)smem, tid);
      for (int it = tot + bid; it < tot + n_norm + n_rope; it += G) {
        if (it < tot + n_norm) {
          const int row = (it - tot) * 8 + (tid >> 6);
          if (row < NTOK) rmsnorm_row(p.x + (size_t)row * 2048, p.attn_norm_w, (bfr*)(ws + OFF_N) + (size_t)row * 2048, nullptr, tid);
          else rmsnorm_row(p.mem + (size_t)(row - NTOK) * 2048, p.mem_norm_w, (bfr*)(ws + OFF_MN) + (size_t)(row - NTOK) * 2048, nullptr, tid);
        } else {
          const int e = (it - tot - n_norm) * 512 + tid;
          const int t = e >> 6, i = e & 63;
          const float ang = (float)t * ROPE_INV[i];
          const float kk = rintf(ang * 0.15915494309189535f);
          float rr = fmaf(-kk, 6.2831854820251465f, ang);
          rr = fmaf(-kk, -1.7484555e-7f, rr);
          const float fr = rr * 0.15915494309189535f;
          ((float2*)(ws + OFF_ROPE))[e] = make_float2(__builtin_amdgcn_cosf(fr), __builtin_amdgcn_sinf(fr));
        }
      }
    } break;
    case 1: {
      const int nt_main = 32 * 61;
      for (int v = bid; v < nt_main + 32; v += G) {
        if (v < nt_main) {
          f32x16 acc[2][4];
          acc_zero<2>(acc);
          int mt, nt;
          map_tile32(v, mt, nt);
          const int m0 = mt * 256, n0 = nt * 256;
          PlainPtr af{(const bfr*)(ws + OFF_N) + (size_t)m0 * 2048, 2048};
          PlainPtr bf{(const bfr*)(ws + OFF_WINT) + (size_t)n0 * 2048, 2048};
          gemm_main<2>(acc, af, bf, 32, smem, tid);
          bfr* zcb = (bfr*)(ws + OFF_ZC);
          const float2* rope = (const float2*)(ws + OFF_ROPE);
          gemm_epi<2>(acc, m0, n0, tid, [&](int m, int n, float a, float b, float c, float d) {
            if (n >= ZS) return;
            bfr* dst = z + (size_t)m * ZS + n;
            const int t = m & 2047;
            if (n >= ZC_KC && n < ZC_KS) {
              const float* pe = (n < ZC_VC) ? p.pe_k : p.pe_v;
              const int dd = n & 127;
              const float4 plo = *(const float4*)(pe + (t & 15) * 128 + dd);
              const float4 phi = *(const float4*)(pe + (16 + (t & 15)) * 128 + dd);
              st_bf4(zcb + (size_t)m * 2048 + (n - ZC_KC), a + plo.x, b + plo.y, c + plo.z, d + plo.w);
              st_bf4(zcb + (size_t)m * 2048 + 1024 + (n - ZC_KC), a + phi.x, b + phi.y, c + phi.z, d + phi.w);
            } else if (n >= ZC_QR && n < ZC_VR) {
              const int i0 = (n & 127) >> 1;
              const float2 c0 = rope[t * 64 + i0], c1 = rope[t * 64 + i0 + 1];
              float o0 = a * c0.x - b * c0.y, o1 = a * c0.y + b * c0.x;
              float o2 = c * c1.x - d * c1.y, o3 = c * c1.y + d * c1.x;
              if (n >= ZC_KR) { const float sc = 0.08838834764831845f; o0 *= sc; o1 *= sc; o2 *= sc; o3 *= sc; }
              st_bf4(dst, o0, o1, o2, o3);
            } else if (n >= ZC_GR && n < ZC_GA) {
              st_bf4(dst, a * sigmoidf_(a), b * sigmoidf_(b), c * sigmoidf_(c), d * sigmoidf_(d));
            } else if (n >= ZC_GA) {
              st_bf4(dst, sigmoidf_(a), sigmoidf_(b), sigmoidf_(c), sigmoidf_(d));
            } else {
              st_bf4(dst, a, b, c, d);
            }
          });
        } else {
          f32x16 acc[1][4];
          acc_zero<1>(acc);
          const int u = v - nt_main, which = u >> 4, mt = (u & 15) >> 2, nt = u & 3;
          const int m0 = mt * 256, n0 = nt * 128;
          PlainPtr af{(const bfr*)(ws + OFF_MN) + (size_t)m0 * 2048, 2048};
          PlainPtr bf{(const bfr*)(ws + (which ? OFF_WVT : OFF_WKT)) + (size_t)n0 * 2048, 2048};
          gemm_main<1>(acc, af, bf, 32, smem, tid);
          bfr* dstb = (bfr*)(ws + (which ? OFF_VX : OFF_KX));
          gemm_epi<1>(acc, m0, n0, tid, [&](int m, int n, float a, float b, float c, float d) { st_bf4(dstb + (size_t)m * 512 + n, a, b, c, d); });
        }
      }
    } break;
    case 2: {
      for (int it = grab(ctr + 0, slot, tid); it < 128; it = grab(ctr + 0, slot, tid)) {
        const int which = it >> 6, mt = (it & 63) >> 3, nt = it & 7;
        const int m0 = mt * 256, n0 = nt * 128;
        f32x16 acc[1][4];
        acc_zero<1>(acc);
        struct GatherA {
          const bfr* base; int m0;
          DI int rowoff(int row) const {
            const int R = m0 + row;
            const int bb = R >> 9, g = (R >> 7) & 3;
            int c = R & 127; c = c > 126 ? 126 : c;
            return (bb * SEQ + c * 16) * 2048 + g * 128;
          }
          DI int koff(int kk) const { const int l = kk >> 7; return l * 2048 + ((l >> 4) << 10) + (kk & 127); }
        };
        GatherA af{(const bfr*)(ws + OFF_ZC) + which * 512, m0};
        PlainPtr bf{(const bfr*)(ws + OFF_W1T) + (size_t)which * 1024 * 4096 + (size_t)n0 * 4096, 4096};
        gemm_main<1>(acc, af, bf, 64, smem, tid);
        bfr* hid = (bfr*)(ws + OFF_HIDC) + (size_t)which * 2048 * 1024;
        gemm_epi<1>(acc, m0, n0, tid, [&](int m, int n, float a, float b, float c, float d) {
          st_bf4(hid + (size_t)m * 1024 + n, a * sigmoidf_(a), b * sigmoidf_(b), c * sigmoidf_(c), d * sigmoidf_(d));
        });
      }
      for (int it = grab(ctr + 1, slot, tid); it < 1024; it = grab(ctr + 1, slot, tid)) {
        if (it < 512) attn_item<MODE_RET>(p, it, smem, tid);
        else attn_item<MODE_WIN>(p, it - 512, smem, tid);
      }
    } break;
    case 3: {
      for (int it = bid; it < 16 + NTOK / 2; it += G) {
        if (it >= 16) { ret_finish_row(p, (it - 16) * 2 + (tid >> 8), tid & 255); continue; }
        const int which = it >> 3, mt = it & 7;
        const int m0 = mt * 256;
        f32x16 acc[1][4];
        acc_zero<1>(acc);
        PlainPtr af{(const bfr*)(ws + OFF_HIDC) + (size_t)which * 2048 * 1024 + (size_t)m0 * 1024, 1024};
        PlainPtr bf{(const bfr*)(ws + OFF_W2T) + (size_t)which * 128 * 1024, 1024};
        gemm_main<1>(acc, af, bf, 16, smem, tid);
        bfr* dstb = (bfr*)(ws + OFF_KCVC) + (size_t)which * 2048 * 128;
        gemm_epi<1>(acc, m0, 0, tid, [&](int m, int n, float a, float b, float c, float d) { st_bf4(dstb + (size_t)m * 128 + n, a, b, c, d); });
      }
    } break;
    case 4: {
      for (int it = bid; it < 512; it += G) cmp_item(p, it, smem, tid);
    } break;
    case 5: {
      for (int it = grab(ctr + 2, slot, tid); it < 512; it = grab(ctr + 2, slot, tid)) attn_item<MODE_SEL>(p, it, smem, tid);
    } break;
    case 6: {
      for (int v = bid; v < 32 * 8; v += G) {
        int mt, nt;
        map_tile32(v, mt, nt);
        const int m0 = mt * 256, n0 = nt * 256;
        f32x16 acc[2][4];
        acc_zero<2>(acc);
        bfr* mg = (bfr*)(ws + OFF_MERGED);
        {
          PlainPtr af{(const bfr*)(ws + OFF_ONSA) + (size_t)m0 * 2048, 2048};
          PlainPtr bf{(const bfr*)(ws + OFF_WAT) + (size_t)n0 * 2048, 2048};
          gemm_main<2>(acc, af, bf, 32, smem, tid);
          gemm_epi<2>(acc, m0, n0, tid, [&](int m, int n, float a, float b, float c, float d) {
            const uint2 ga = *(const uint2*)(z + (size_t)m * ZS + ZC_GA + n);
            st_bf4(mg + (size_t)m * 2048 + n, bflo(ga.x) * a, bfhi(ga.x) * b, bflo(ga.y) * c, bfhi(ga.y) * d);
          });
        }
        acc_zero<2>(acc);
        {
          PlainPtr af{(const bfr*)(ws + OFF_ORET) + (size_t)m0 * 2048, 2048};
          PlainPtr bf{(const bfr*)(ws + OFF_WBT) + (size_t)n0 * 2048, 2048};
          gemm_main<2>(acc, af, bf, 32, smem, tid);
          gemm_epi<2>(acc, m0, n0, tid, [&](int m, int n, float a, float b, float c, float d) {
            const uint2 gb = *(const uint2*)(z + (size_t)m * ZS + ZC_GB + n);
            bfr* dst = mg + (size_t)m * 2048 + n;
            const uint2 old = *(const uint2*)dst;
            st_bf4(dst, bflo(old.x) + bflo(gb.x) * a, bfhi(old.x) + bfhi(gb.x) * b, bflo(old.y) + bflo(gb.y) * c, bfhi(old.y) + bfhi(gb.y) * d);
          });
        }
      }
    } break;
    case 7: {
      for (int v = bid; v < 32 * 8; v += G) {
        int mt, nt;
        map_tile32(v, mt, nt);
        const int m0 = mt * 256, n0 = nt * 256;
        f32x16 acc[2][4];
        acc_zero<2>(acc);
        PlainPtr af{(const bfr*)(ws + OFF_MERGED) + (size_t)m0 * 2048, 2048};
        PlainPtr bf{(const bfr*)(ws + OFF_WOUTT) + (size_t)n0 * 2048, 2048};
        gemm_main<2>(acc, af, bf, 32, smem, tid);
        gemm_epi_resid(acc, m0, n0, tid, p.x, (float*)(ws + OFF_H), (bfr*)(ws + OFF_NX), (float*)(ws + OFF_ROWSS));
      }
    } break;
    case 8: case 12: break;
    case 9: {
      const int ng = (G > 128) ? 128 : G;
      if (G > 128) { if (bid >= 128) tr_run(p, 12, bid - 128, G - 128, tjob_tiles(12), (float*)smem, tid); }
      else tr_run(p, 12, bid, G, tjob_tiles(12), (float*)smem, tid);
      if (bid < ng)
      for (int v = bid; v < 32 * 4; v += ng) {
        int mt, nt;
        map_tile32(v, mt, nt);
        const int m0 = mt * 256, n0 = nt * 128;
        f32x16 acc[1][4];
        acc_zero<1>(acc);
        PlainPtr af{(const bfr*)(ws + OFF_NX) + (size_t)m0 * 2048, 2048};
        PlainPtr bf{(const bfr*)(ws + OFF_WQT) + (size_t)n0 * 2048, 2048};
        gemm_main<1>(acc, af, bf, 32, smem, tid);
        bfr* qx = (bfr*)(ws + OFF_QX);
        const float* rss = (const float*)(ws + OFF_ROWSS);
        gemm_epi<1>(acc, m0, n0, tid, [&](int m, int n, float a, float b, float c, float d) {
          const float rs = rsqrtf(rss[m] * (1.f / 2048.f) + 1e-6f);
          st_bf4(qx + (size_t)m * 512 + n, a * rs, b * rs, c * rs, d * rs);
        });
      }
    } break;
    case 10: {
      const int ng = (G > 128) ? 128 : G;
      if (G > 128) { if (bid >= 128) tr_run(p, 13, bid - 128, G - 128, tjob_tiles(13), (float*)smem, tid); }
      else tr_run(p, 13, bid, G, tjob_tiles(13), (float*)smem, tid);
      if (bid < ng)
        for (int it = bid; it < 128; it += ng) attn_item<MODE_X>(p, it, smem, tid);
    } break;
    case 11: {
      for (int v = bid; v < 32 * 8; v += G) {
        int mt, nt;
        map_tile32(v, mt, nt);
        const int m0 = mt * 256, n0 = nt * 256;
        f32x16 acc[2][4];
        acc_zero<2>(acc);
        PlainPtr af{(const bfr*)(ws + OFF_OX) + (size_t)m0 * 512, 512};
        PlainPtr bf{(const bfr*)(ws + OFF_WOT) + (size_t)n0 * 512, 512};
        gemm_main<2>(acc, af, bf, 8, smem, tid);
        gemm_epi_resid(acc, m0, n0, tid, (const float*)(ws + OFF_H), (float*)(ws + OFF_H), (bfr*)(ws + OFF_NX), (float*)(ws + OFF_ROWSS) + NTOK);
      }
    } break;
    case 13: {
      for (int v = bid; v < 32 * 32; v += G) {
        int mt, nt;
        map_tile32(v, mt, nt);
        const int m0 = mt * 256, n0 = nt * 256;
        f32x16 acc[2][4];
        acc_zero<2>(acc);
        PlainPtr af{(const bfr*)(ws + OFF_NX) + (size_t)m0 * 2048, 2048};
        PlainPtr bf{(const bfr*)(ws + OFF_WUPT) + (size_t)n0 * 2048, 2048};
        gemm_main<2>(acc, af, bf, 32, smem, tid);
        bfr* hid = (bfr*)(ws + OFF_HID);
        const float* rss = (const float*)(ws + OFF_ROWSS) + NTOK;
        gemm_epi<2>(acc, m0, n0, tid, [&](int m, int n, float a, float b, float c, float d) {
          const float rs = rsqrtf(rss[m] * (1.f / 2048.f) + 1e-6f);
          a = fmaxf(a, 0.f) * rs; b = fmaxf(b, 0.f) * rs; c = fmaxf(c, 0.f) * rs; d = fmaxf(d, 0.f) * rs;
          st_bf4(hid + (size_t)m * 8192 + n, a * a, b * b, c * c, d * d);
        });
      }
    } break;
    case 14: {
      for (int v = bid; v < 32 * 8; v += G) {
        int mt, nt;
        map_tile32(v, mt, nt);
        const int m0 = mt * 256, n0 = nt * 256;
        f32x16 acc[2][4];
        acc_zero<2>(acc);
        PlainPtr af{(const bfr*)(ws + OFF_HID) + (size_t)m0 * 8192, 8192};
        PlainPtr bf{(const bfr*)(ws + OFF_WDOWNT) + (size_t)n0 * 8192, 8192};
        gemm_main<2>(acc, af, bf, 128, smem, tid);
        const float* hbuf = (const float*)(ws + OFF_H);
        gemm_epi<2>(acc, m0, n0, tid, [&](int m, int n, float a, float b, float c, float d) {
          const float4 xv = *(const float4*)(hbuf + (size_t)m * 2048 + n);
          *(float4*)(p.out + (size_t)m * 2048 + n) = make_float4(xv.x + a, xv.y + b, xv.z + c, xv.w + d);
        });
      }
    } break;
    case 15: {
      for (int it = bid; it < 1024; it += G) {
        const int row = it * 8 + (tid >> 6);
        rmsnorm_row(p.out + (size_t)row * 2048, p.final_norm_w, nullptr, p.out + (size_t)row * 2048, tid);
      }
    } break;
    default: break;
  }
}

__global__ void __launch_bounds__(512, 2) mega(Params p) {
  extern __shared__ __attribute__((aligned(1024))) char smem[];
  __shared__ int slot;
  cg::grid_group grid = cg::this_grid();
  const int wave_s = __builtin_amdgcn_readfirstlane((int)(threadIdx.x >> 6));
  for (int ph = p.ph_lo; ph < p.ph_hi; ++ph) {
    if (ph == 8 || ph == 12) continue;
    run_phase(p, ph, smem, &slot, wave_s, 0);
#ifdef PROBE_PH
    if (ph == PROBE_PH)
      for (int rep = 1; rep <= PROBE_N; ++rep) { grid.sync(); run_phase(p, ph, smem, &slot, wave_s, rep); }
#endif
    if (ph + 1 < p.ph_hi) grid.sync();
  }
}

extern "C" void kernel_launch(void* const* d_in, const int* in_sizes, int n_in, void* d_out, int out_size, void* d_ws,
                              size_t ws_size, hipStream_t stream) {
  static int grid_blocks = 0;
  if (!grid_blocks) {
    int dev = 0, cus = 0, per_cu = 0;
    (void)hipGetDevice(&dev);
    (void)hipDeviceGetAttribute(&cus, hipDeviceAttributeMultiprocessorCount, dev);
    (void)hipFuncSetAttribute((const void*)mega, hipFuncAttributeMaxDynamicSharedMemorySize, SMEM_BYTES);
    (void)hipOccupancyMaxActiveBlocksPerMultiprocessor(&per_cu, mega, NTHR, SMEM_BYTES);
    if (per_cu < 1) per_cu = 1;
    if (per_cu > 1) per_cu = 1;
    grid_blocks = cus * per_cu;
    grid_blocks &= ~7;
    if (ws_size < WS_END || n_in != 24) { fprintf(stderr, "kernel_launch: ws %zu < %zu or n_in %d\n", ws_size, (size_t)WS_END, n_in); grid_blocks = -1; }
  }
  if (grid_blocks < 0) return;
  Params p{};
  const float** pp = (const float**)&p;
  for (int i = 0; i < 24; ++i) pp[i] = (const float*)d_in[i];
  p.out = (float*)d_out;
  p.ws = (char*)d_ws;
#if ONE_LAUNCH
  p.ph_lo = 0; p.ph_hi = NPHASE;
  void* args[] = {&p};
  hipError_t e = hipLaunchCooperativeKernel((void*)mega, dim3(grid_blocks), dim3(NTHR), args, SMEM_BYTES, stream);
  if (e != hipSuccess) fprintf(stderr, "cooperative launch failed: %s (grid %d)\n", hipGetErrorString(e), grid_blocks);
#else
  for (int ph = 0; ph < NPHASE; ++ph) {
    p.ph_lo = ph; p.ph_hi = ph + 1;
    hipLaunchKernelGGL(mega, dim3(grid_blocks), dim3(NTHR), SMEM_BYTES, stream, p);
  }
#endif
}
```

```cpp
#include <hip/hip_runtime.h>
#include <hip/hip_cooperative_groups.h>
#include <cstdio>
namespace cg = cooperative_groups;

#ifndef ONE_LAUNCH
#define ONE_LAUNCH 1
#endif

#define DI __device__ __forceinline__
typedef unsigned short bfr;
using bf16x8 = __attribute__((ext_vector_type(8))) short;
using s16x4 = __attribute__((ext_vector_type(4))) short;
using f32x16 = __attribute__((ext_vector_type(16))) float;
using u32x4 = __attribute__((ext_vector_type(4))) unsigned;
#define MFMA(a, b, c) __builtin_amdgcn_mfma_f32_32x32x16_bf16((a), (b), (c), 0, 0, 0)

constexpr int DM = 2048, SEQ = 2048, NTOK = 8192;
constexpr int ZS = 15488;
constexpr int ZC_Q = 0, ZC_KC = 2048, ZC_VC = 2560, ZC_KS = 3072, ZC_VS = 3584, ZC_KW = 4096, ZC_VW = 4608,
              ZC_QR = 5120, ZC_KR = 6144, ZC_VR = 7168, ZC_GR = 9216, ZC_GA = 11264, ZC_GB = 13312, ZC_GN = 15360;
constexpr int NPHASE = 16;

constexpr int ZSP = 15616;
constexpr size_t SZ_WINT = (size_t)ZSP * 2048 * 2;
constexpr size_t SZ_ACT = (size_t)NTOK * 2048 * 2;
constexpr size_t OFF_WINT = 0;
constexpr size_t OFF_N = OFF_WINT + SZ_WINT;
constexpr size_t OFF_MERGED = OFF_WINT;
constexpr size_t OFF_ORET = OFF_N;
constexpr size_t OFF_WUPT = 0;
constexpr size_t OFF_WDOWNT = SZ_ACT;
constexpr size_t OFF_Z = OFF_N + SZ_ACT;
constexpr size_t SZ_Z = (size_t)NTOK * ZS * 2;
constexpr size_t OFF_HID = OFF_Z;
constexpr size_t OFF_H = OFF_Z + (size_t)NTOK * 8192 * 2;
constexpr size_t OFF_NX = OFF_H + (size_t)NTOK * 2048 * 4;
constexpr size_t OFF_QX = OFF_NX + SZ_ACT;
constexpr size_t OFF_OX = OFF_QX + (size_t)NTOK * 512 * 2;
static_assert(OFF_OX + (size_t)NTOK * 512 * 2 <= OFF_Z + SZ_Z, "alias overflow");
constexpr size_t OFF_ZC = OFF_Z + SZ_Z;
constexpr size_t OFF_MN = OFF_ZC + (size_t)NTOK * 2048 * 2;
constexpr size_t OFF_W1T = OFF_MN + (size_t)1024 * 2048 * 2;
constexpr size_t OFF_W2T = OFF_W1T + (size_t)2 * 1024 * 4096 * 2;
constexpr size_t OFF_WAT = OFF_W2T + (size_t)2 * 128 * 1024 * 2;
constexpr size_t OFF_WBT = OFF_WAT + (size_t)2048 * 2048 * 2;
constexpr size_t OFF_WOUTT = OFF_WBT + (size_t)2048 * 2048 * 2;
constexpr size_t OFF_WQT = OFF_WOUTT + (size_t)2048 * 2048 * 2;
constexpr size_t OFF_WKT = OFF_WQT + (size_t)512 * 2048 * 2;
constexpr size_t OFF_WVT = OFF_WKT + (size_t)512 * 2048 * 2;
constexpr size_t OFF_WOT = OFF_WVT + (size_t)512 * 2048 * 2;
constexpr size_t OFF_ROPE = OFF_WOT + (size_t)512 * 2048 * 2;
constexpr size_t OFF_HIDC = OFF_ROPE + (size_t)2048 * 64 * 8;
constexpr size_t OFF_KCVC = OFF_HIDC + (size_t)2 * 2048 * 1024 * 2;
constexpr size_t OFF_SELM = OFF_KCVC + (size_t)2 * 2048 * 128 * 2;
constexpr size_t OFF_ONSA = OFF_SELM + (size_t)16 * 2048 * 4;
constexpr size_t OFF_KX = OFF_ONSA + SZ_ACT;
constexpr size_t OFF_VX = OFF_KX + (size_t)1024 * 512 * 2;
constexpr size_t OFF_RSTAT = OFF_VX + (size_t)1024 * 512 * 2;
constexpr size_t OFF_CTR = OFF_RSTAT + (size_t)NTOK * 8 * 2 * 2 * 4;
constexpr size_t OFF_ROWSS = OFF_CTR + 256;
constexpr size_t WS_END = OFF_ROWSS + (size_t)2 * NTOK * 4;

struct Params {
  const float *x, *mem, *attn_norm_w, *w_in, *pe_k, *w1k, *w2k, *pe_v, *w1v, *w2v, *w_a, *gn_w, *w_b, *w_out, *x_norm_w,
      *mem_norm_w, *wq, *wk, *wv, *wo, *mlp_norm_w, *w_up, *w_down, *final_norm_w;
  float* out;
  char* ws;
  int ph_lo, ph_hi;
  int dbg, pad;
};

constexpr int NTHR = 512;
constexpr int SMEM_BYTES = 131072;
__device__ const float ROPE_INV[64] = {1.0f, 0.865964353f, 0.749894261f, 0.649381638f, 0.562341332f, 0.486967534f, 0.421696514f, 0.365174115f, 0.316227764f, 0.273841977f, 0.237137377f, 0.2053525f, 0.177827939f, 0.153992653f, 0.133352131f, 0.115478203f, 0.100000001f, 0.0865964293f, 0.0749894157f, 0.0649381652f, 0.0562341325f, 0.0486967526f, 0.0421696529f, 0.0365174115f, 0.0316227749f, 0.0273841973f, 0.0237137377f, 0.0205352511f, 0.0177827943f, 0.0153992651f, 0.0133352149f, 0.0115478206f, 0.00999999978f, 0.00865964312f, 0.00749894185f, 0.00649381615f, 0.00562341325f, 0.00486967526f, 0.00421696482f, 0.00365174119f, 0.00316227763f, 0.00273841969f, 0.00237137359f, 0.00205352483f, 0.00177827943f, 0.00153992651f, 0.00133352145f, 0.0011547819f, 0.00100000005f, 0.000865964335f, 0.000749894243f, 0.000649381662f, 0.000562341302f, 0.000486967532f, 0.000421696517f, 0.000365174143f, 0.000316227757f, 0.000273841957f, 0.00023713737f, 0.00020535251f, 0.00017782794f, 0.000153992645f, 0.00013335215f, 0.0001154782f};

DI unsigned pack2(float a, float b) {
  typedef float f2 __attribute__((ext_vector_type(2)));
  typedef __bf16 b2 __attribute__((ext_vector_type(2)));
  f2 v = {a, b};
  b2 r = __builtin_convertvector(v, b2);
  return __builtin_bit_cast(unsigned, r);
}
DI float bflo(unsigned u) { return __uint_as_float(u << 16); }
DI float bfhi(unsigned u) { return __uint_as_float(u & 0xffff0000u); }
DI void st_bf4(bfr* p, float a, float b, float c, float d) {
  uint2 v; v.x = pack2(a, b); v.y = pack2(c, d);
  *(uint2*)p = v;
}
DI float wave_sum(float v) {
#pragma unroll
  for (int o = 32; o > 0; o >>= 1) v += __shfl_xor(v, o);
  return v;
}
DI float sigmoidf_(float x) { return 1.f / (1.f + __expf(-x)); }
DI int crow(int i, int h) { return (i & 3) + 8 * (i >> 2) + 4 * h; }
DI bf16x8 pack8(const f32x16& x, int s) {
  unsigned a = pack2(x[8 * s], x[8 * s + 1]), b = pack2(x[8 * s + 2], x[8 * s + 3]), c = pack2(x[8 * s + 4], x[8 * s + 5]),
           d = pack2(x[8 * s + 6], x[8 * s + 7]);
  typedef unsigned u4 __attribute__((ext_vector_type(4)));
  u4 v = {a, b, c, d};
  return __builtin_bit_cast(bf16x8, v);
}
DI s16x4 tr_read(const bfr* p) {
  return __builtin_amdgcn_ds_read_tr16_b64_v4i16((__attribute__((address_space(3))) s16x4*)(p));
}

struct TJob { const float* src; bfr* dst; int K, N, ntn, perm; const float* kscale; };
DI TJob get_tjob(const Params& p, int j) {
  TJob t;
  char* ws = p.ws;
  switch (j) {
    case 0: t = {p.w_in, (bfr*)(ws + OFF_WINT), 2048, 15408, 122, 1, nullptr}; break;
    case 1: t = {p.w1k, (bfr*)(ws + OFF_W1T), 4096, 1024, 8, 0, nullptr}; break;
    case 2: t = {p.w1v, (bfr*)(ws + OFF_W1T) + (size_t)1024 * 4096, 4096, 1024, 8, 0, nullptr}; break;
    case 3: t = {p.w2k, (bfr*)(ws + OFF_W2T), 1024, 128, 1, 0, nullptr}; break;
    case 4: t = {p.w2v, (bfr*)(ws + OFF_W2T) + (size_t)128 * 1024, 1024, 128, 1, 0, nullptr}; break;
    case 5: t = {p.w_a, (bfr*)(ws + OFF_WAT), 2048, 2048, 16, 0, nullptr}; break;
    case 6: t = {p.w_b, (bfr*)(ws + OFF_WBT), 2048, 2048, 16, 0, nullptr}; break;
    case 7: t = {p.w_out, (bfr*)(ws + OFF_WOUTT), 2048, 2048, 16, 0, nullptr}; break;
    case 8: t = {p.wq, (bfr*)(ws + OFF_WQT), 2048, 512, 4, 0, p.x_norm_w}; break;
    case 9: t = {p.wk, (bfr*)(ws + OFF_WKT), 2048, 512, 4, 0, nullptr}; break;
    case 10: t = {p.wv, (bfr*)(ws + OFF_WVT), 2048, 512, 4, 0, nullptr}; break;
    case 11: t = {p.wo, (bfr*)(ws + OFF_WOT), 512, 2048, 16, 0, nullptr}; break;
    case 12: t = {p.w_up, (bfr*)(ws + OFF_WUPT), 2048, 8192, 64, 0, p.mlp_norm_w}; break;
    default: t = {p.w_down, (bfr*)(ws + OFF_WDOWNT), 8192, 2048, 16, 0, nullptr}; break;
  }
  return t;
}
DI int tjob_tiles(int j) {
  switch (j) {
    case 0: return 122 * 16;
    case 1: case 2: return 8 * 32;
    case 3: case 4: return 1 * 8;
    case 5: case 6: case 7: return 16 * 16;
    case 8: case 9: case 10: return 4 * 16;
    case 11: return 16 * 4;
    case 12: return 64 * 16;
    default: return 16 * 64;
  }
}
struct TrRegs { float4 v[8]; };
DI void tr_load(const TJob& t, int tile, TrRegs& rg, const int tid) {
  const int nkt = t.K >> 7;
  const int kt = tile % nkt, nt = tile / nkt;
  const int k0 = kt * 128, d0 = nt * 128;
  int scol0 = d0, nvalid = 128;
  if (t.perm) {
    if (d0 < 5120) scol0 = d0;
    else if (d0 < 15360) scol0 = d0 + 48;
    else { scol0 = d0 - 15360 + 5120; nvalid = (d0 == 15360) ? 48 : 0; }
  }
#pragma unroll
  for (int i = 0; i < 8; ++i) {
    const int row = i * 16 + (tid >> 5), col = (tid & 31) * 4;
    rg.v[i] = make_float4(0.f, 0.f, 0.f, 0.f);
    if (col < nvalid) rg.v[i] = *(const float4*)(t.src + (size_t)(k0 + row) * t.N + scol0 + col);
    if (t.kscale) { const float sc = t.kscale[k0 + row]; rg.v[i].x *= sc; rg.v[i].y *= sc; rg.v[i].z *= sc; rg.v[i].w *= sc; }
  }
}
DI void tr_to_lds(const TrRegs& rg, float* sm, const int tid) {
#pragma unroll
  for (int i = 0; i < 8; ++i) {
    const int row = i * 16 + (tid >> 5), col = (tid & 31) * 4;
    float* d = sm + row * 129 + col;
    d[0] = rg.v[i].x; d[1] = rg.v[i].y; d[2] = rg.v[i].z; d[3] = rg.v[i].w;
  }
}
DI void tr_store(const TJob& t, int tile, const float* sm, const int tid) {
  const int nkt = t.K >> 7;
  const int kt = tile % nkt, nt = tile / nkt;
  const int k0 = kt * 128, d0 = nt * 128;
  const int n = tid >> 2, kq = (tid & 3) * 8;
  bfr* drow = t.dst + (size_t)(d0 + n) * t.K + k0 + kq;
#pragma unroll
  for (int q = 0; q < 4; ++q) {
    const int kb = kq + 32 * q;
    const unsigned o0 = pack2(sm[(kb + 0) * 129 + n], sm[(kb + 1) * 129 + n]);
    const unsigned o1 = pack2(sm[(kb + 2) * 129 + n], sm[(kb + 3) * 129 + n]);
    const unsigned o2 = pack2(sm[(kb + 4) * 129 + n], sm[(kb + 5) * 129 + n]);
    const unsigned o3 = pack2(sm[(kb + 6) * 129 + n], sm[(kb + 7) * 129 + n]);
    *(uint4*)(drow + 32 * q) = make_uint4(o0, o1, o2, o3);
  }
}
DI void tr_decode(int it, int j_lo, int& j, int& rem) {
  j = j_lo; rem = it;
  while (rem >= tjob_tiles(j)) { rem -= tjob_tiles(j); ++j; }
}
DI void tr_run(const Params& p, int j_lo, int it0, int stride, int n_tiles, float* sm, const int tid) {
  if (it0 >= n_tiles) return;
  TrRegs rg;
  int j, rem;
  tr_decode(it0, j_lo, j, rem);
  TJob t = get_tjob(p, j);
  tr_load(t, rem, rg, tid);
  for (int it = it0; it < n_tiles; it += stride) {
    __syncthreads();
    tr_to_lds(rg, sm, tid);
    __syncthreads();
    const TJob tc = t;
    const int remc = rem;
    const int nx = it + stride;
    if (nx < n_tiles) {
      tr_decode(nx, j_lo, j, rem);
      t = get_tjob(p, j);
      tr_load(t, rem, rg, tid);
    }
    tr_store(tc, remc, sm, tid);
  }
  __syncthreads();
}

DI void rmsnorm_row(const float* xrow, const float* w, bfr* obf, float* of32, const int tid) {
  const int lane = tid & 63;
  float4 v[8];
  float ss = 0.f;
#pragma unroll
  for (int i = 0; i < 8; ++i) {
    v[i] = ((const float4*)xrow)[lane + 64 * i];
    ss += v[i].x * v[i].x + v[i].y * v[i].y + v[i].z * v[i].z + v[i].w * v[i].w;
  }
  ss = wave_sum(ss);
  const float rs = rsqrtf(ss * (1.f / 2048.f) + 1e-6f);
#pragma unroll
  for (int i = 0; i < 8; ++i) {
    const float4 ww = ((const float4*)w)[lane + 64 * i];
    const float a = v[i].x * rs * ww.x, b = v[i].y * rs * ww.y, c = v[i].z * rs * ww.z, d = v[i].w * rs * ww.w;
    if (obf) st_bf4(obf + (lane + 64 * i) * 4, a, b, c, d);
    else ((float4*)of32)[lane + 64 * i] = make_float4(a, b, c, d);
  }
}

struct PlainPtr {
  const bfr* base; int ld;
  DI int rowoff(int row) const { return row * ld; }
  DI int koff(int k0) const { return k0; }
};
#define WAIT_V(n) asm volatile("s_waitcnt vmcnt(%0)" ::"n"(n) : "memory")
#define WAIT_L(n) asm volatile("s_waitcnt lgkmcnt(%0)" ::"n"(n) : "memory")
#define RAW_BARRIER() do { WAIT_L(0); __builtin_amdgcn_s_barrier(); } while (0)
typedef __attribute__((address_space(3))) unsigned lds_u32;
constexpr int STAGE_B = 65536;
template <int NI, class AF, class BF>
DI void gemm_main(f32x16 (&acc)[NI][4], const AF& af, const BF& bf, int nk, char* smem, const int tid) {
  const int lane = tid & 63, r = lane & 31, h = lane >> 5;
  const int w = __builtin_amdgcn_readfirstlane(tid >> 6);
  const int wm = w & 1, wn = w >> 1;
  int ao[4], bo[2 * NI];
  {
    const int rl = lane >> 3, kc = (lane & 7) ^ (((w & 1) * 4 + (lane >> 4)) & 7);
#pragma unroll
    for (int i = 0; i < 4; ++i) ao[i] = af.rowoff((w + 8 * i) * 8 + rl) + 8 * kc;
#pragma unroll
    for (int i = 0; i < 2 * NI; ++i) bo[i] = bf.rowoff((w + 8 * i) * 8 + rl) + 8 * kc;
  }
  auto stage = [&](int buf, int kt) {
    const int ka = af.koff(kt * 64), kb = bf.koff(kt * 64);
    char* sbase = smem + buf * STAGE_B + w * 1024;
#pragma unroll
    for (int i = 0; i < 4; ++i)
      __builtin_amdgcn_global_load_lds((const unsigned*)(af.base + (ao[i] + ka)), (lds_u32*)(sbase + i * 8192), 16, 0, 0);
#pragma unroll
    for (int i = 0; i < 2 * NI; ++i)
      __builtin_amdgcn_global_load_lds((const unsigned*)(bf.base + (bo[i] + kb)), (lds_u32*)(sbase + 32768 + i * 8192), 16, 0, 0);
  };
  const int xr = (r >> 1) & 7;
  const int arow = (wm * 128 + r) * 128, brow = 32768 + (wn * 32 * NI + r) * 128;
  WAIT_V(0);
  __syncthreads();
  stage(0, 0);
  WAIT_V(0);
  RAW_BARRIER();
#pragma unroll 1
  for (int kt = 0; kt < nk; ++kt) {
    if (kt + 1 < nk) stage((kt + 1) & 1, kt + 1);
    const char* sb = smem + (kt & 1) * STAGE_B;
#pragma unroll
    for (int ks = 0; ks < 4; ++ks) {
      const int off = ((2 * ks + h) ^ xr) * 16;
      bf16x8 wf[NI], xf[4];
#pragma unroll
      for (int i = 0; i < NI; ++i) wf[i] = *(const bf16x8*)(sb + brow + i * 4096 + off);
#pragma unroll
      for (int i = 0; i < 4; ++i) xf[i] = *(const bf16x8*)(sb + arow + i * 4096 + off);
#pragma unroll
      for (int mi = 0; mi < 4; ++mi)
#pragma unroll
        for (int ni = 0; ni < NI; ++ni) acc[ni][mi] = MFMA(wf[ni], xf[mi], acc[ni][mi]);
    }
    WAIT_V(0);
    RAW_BARRIER();
  }
}
template <int NI>
DI void acc_zero(f32x16 (&acc)[NI][4]) {
#pragma unroll
  for (int a = 0; a < NI; ++a)
#pragma unroll
    for (int b = 0; b < 4; ++b)
#pragma unroll
      for (int i = 0; i < 16; ++i) acc[a][b][i] = 0.f;
}
template <int NI, class EPI>
DI void gemm_epi(const f32x16 (&acc)[NI][4], int m0, int n0, const int tid_in, const EPI& epi) {
  int tid = tid_in;
  asm volatile("" : "+v"(tid));
  const int lane = tid & 63, w = tid >> 6, r = lane & 31, h = lane >> 5;
  const int wm = w & 1, wn = w >> 1;
#pragma unroll
  for (int mi = 0; mi < 4; ++mi)
#pragma unroll
    for (int ni = 0; ni < NI; ++ni)
#pragma unroll
      for (int g = 0; g < 4; ++g) {
        const int n = n0 + wn * 32 * NI + ni * 32 + 8 * g + 4 * h;
        const int m = m0 + wm * 128 + mi * 32 + r;
        epi(m, n, acc[ni][mi][4 * g], acc[ni][mi][4 * g + 1], acc[ni][mi][4 * g + 2], acc[ni][mi][4 * g + 3]);
      }
}
DI void gemm_epi_resid(const f32x16 (&acc)[2][4], int m0, int n0, const int tid_in, const float* hsrc, float* hdst, bfr* hb, float* rowss) {
  int tid = tid_in;
  asm volatile("" : "+v"(tid));
  const int lane = tid & 63, w = tid >> 6, r = lane & 31, h = lane >> 5;
  const int wm = w & 1, wn = w >> 1;
#pragma unroll
  for (int mi = 0; mi < 4; ++mi) {
    const int m = m0 + wm * 128 + mi * 32 + r;
    float ss = 0.f;
#pragma unroll
    for (int ni = 0; ni < 2; ++ni)
#pragma unroll
      for (int g = 0; g < 4; ++g) {
        const int n = n0 + wn * 64 + ni * 32 + 8 * g + 4 * h;
        const float4 xv = *(const float4*)(hsrc + (size_t)m * 2048 + n);
        const float a = xv.x + acc[ni][mi][4 * g], b = xv.y + acc[ni][mi][4 * g + 1], c = xv.z + acc[ni][mi][4 * g + 2], d = xv.w + acc[ni][mi][4 * g + 3];
        *(float4*)(hdst + (size_t)m * 2048 + n) = make_float4(a, b, c, d);
        st_bf4(hb + (size_t)m * 2048 + n, a, b, c, d);
        ss += a * a + b * b + c * c + d * d;
      }
    ss += __shfl_xor(ss, 32);
    if (h == 0) atomicAdd(rowss + m, ss);
  }
}
DI void map_tile32(int v, int& mt, int& nt) {
  const int xcd = v & 7, j = v >> 3;
  nt = j >> 2;
  mt = xcd * 4 + (j & 3);
}

enum { MODE_WIN = 0, MODE_SEL = 1, MODE_X = 2, MODE_RET = 3 };
constexpr int KP = 136;

template <int MODE>
DI void attn_item(const Params& p, int item, char* smem, const int tid) {
  constexpr int VP = 136;
  bfr* Ks = (bfr*)smem;
  bfr* Vs = Ks + 64 * KP;
  const int w = tid >> 6, lane = tid & 63, r = lane & 31, h = lane >> 5;
  bfr* Qw = Vs + 64 * VP + w * 32 * KP;
  char* ws = p.ws;
  const bfr* z = (const bfr*)(ws + OFF_Z);

  int b, t0, tq0, jlo, jhi, head = 0, grp = 0, vh = 0;
  const bfr *qbase, *kbase, *vbase;
  int ldq, ldk;
  unsigned selm = 0, umask = 0xffffffffu;
  if (MODE == MODE_WIN) {
    const int tb = item >> 4, bg = item & 15;
    b = bg >> 2; grp = bg & 3; t0 = tb * 64; tq0 = t0 + 32 * (w >> 2); head = grp * 4 + (w & 3);
    qbase = z + (size_t)(b * SEQ + tq0) * ZS + ZC_Q + head * 128; ldq = ZS;
    kbase = z + (size_t)(b * SEQ) * ZS + ZC_KW + grp * 128;
    vbase = z + (size_t)(b * SEQ) * ZS + ZC_VW + grp * 128;
    ldk = ZS;
    jlo = (t0 - 511 > 0 ? t0 - 511 : 0) >> 6;
    jhi = tb;
  } else if (MODE == MODE_SEL) {
    const int tb = 31 - (item >> 4), bg = item & 15;
    b = bg >> 2; grp = bg & 3; t0 = tb * 64; tq0 = t0 + 32 * (w >> 2); head = grp * 4 + (w & 3);
    qbase = z + (size_t)(b * SEQ + tq0) * ZS + ZC_Q + head * 128; ldq = ZS;
    kbase = z + (size_t)(b * SEQ) * ZS + ZC_KS + grp * 128;
    vbase = z + (size_t)(b * SEQ) * ZS + ZC_VS + grp * 128;
    ldk = ZS;
    jlo = 0;
    jhi = tb;
    const unsigned* sm = (const unsigned*)(ws + OFF_SELM) + (b * 4 + grp) * SEQ;
    selm = sm[tq0 + r];
    unsigned u = sm[t0 + lane];
#pragma unroll
    for (int o = 32; o > 0; o >>= 1) u |= (unsigned)__shfl_xor((int)u, o);
    umask = (unsigned)__builtin_amdgcn_readfirstlane((int)u);
    umask &= (jhi >= 31) ? 0xffffffffu : ((1u << (jhi + 1)) - 1u);
  } else if (MODE == MODE_X) {
    const int tb = item >> 4, bh = item & 15;
    b = bh >> 2; head = bh & 3; t0 = tb * 256; tq0 = t0 + 32 * w;
    qbase = (const bfr*)(ws + OFF_QX) + (size_t)(b * SEQ + tq0) * 512 + head * 128; ldq = 512;
    kbase = (const bfr*)(ws + OFF_KX) + (size_t)(b * 256) * 512 + head * 128;
    vbase = (const bfr*)(ws + OFF_VX) + (size_t)(b * 256) * 512 + head * 128;
    ldk = 512;
    jlo = 0; jhi = 3;
  } else {
    const int tb = 7 - (item >> 6), rest = item & 63;
    b = rest >> 4; head = (rest >> 1) & 7; vh = rest & 1; t0 = tb * 256; tq0 = t0 + 32 * w;
    qbase = z + (size_t)(b * SEQ + tq0) * ZS + ZC_QR + head * 128; ldq = ZS;
    kbase = z + (size_t)(b * SEQ) * ZS + ZC_KR + head * 128;
    vbase = z + (size_t)(b * SEQ) * ZS + ZC_VR + head * 256 + vh * 128;
    ldk = ZS;
    jlo = 0; jhi = 4 * tb + 3;
  }
  const int tq = tq0 + r;

  f32x16 o[4];
#pragma unroll
  for (int dt = 0; dt < 4; ++dt)
#pragma unroll
    for (int i = 0; i < 16; ++i) o[dt][i] = 0.f;
  float m_run = -INFINITY, l_run = 0.f;
  float lg = 0.f;
  float rf[16];
  if (MODE == MODE_RET) {
    lg = log1pf(-exp2f(-5.f - (float)head)) * 1.4426950408889634f;
#pragma unroll
    for (int i = 0; i < 16; ++i) rf[i] = __builtin_amdgcn_exp2f(-lg * (float)crow(i, h));
  }

  u32x4 kreg[2], vreg[2];
  auto gload = [&](int j) {
    const int k0 = j * 64;
#pragma unroll
    for (int i = 0; i < 2; ++i) {
      const int c = tid + 512 * i, row = c >> 4, cc = c & 15;
      kreg[i] = *(const u32x4*)(kbase + (size_t)(k0 + row) * ldk + cc * 8);
      vreg[i] = *(const u32x4*)(vbase + (size_t)(k0 + row) * ldk + cc * 8);
    }
  };
  auto swrite = [&]() {
#pragma unroll
    for (int i = 0; i < 2; ++i) {
      const int c = tid + 512 * i, row = c >> 4, cc = c & 15;
      *(u32x4*)(Ks + row * KP + cc * 8) = kreg[i];
      *(u32x4*)(Vs + row * VP + cc * 8) = vreg[i];
    }
  };
  auto next_j = [&](int j) -> int {
    if (MODE == MODE_SEL) {
      const unsigned rem = (j >= 31) ? 0u : (umask & ~((2u << j) - 1u));
      return rem ? (__builtin_ctz(rem)) : 64;
    }
    return j + 1;
  };
  int j = jlo;
  if (MODE == MODE_SEL) j = __builtin_ctz(umask);
  gload(j);
  __syncthreads();
  {
    u32x4 qreg[8];
#pragma unroll
    for (int i = 0; i < 8; ++i) {
      const int c = lane + 64 * i, row = c >> 4, cc = c & 15;
      qreg[i] = *(const u32x4*)(qbase + (size_t)row * ldq + cc * 8);
    }
#pragma unroll
    for (int i = 0; i < 8; ++i) {
      const int c = lane + 64 * i, row = c >> 4, cc = c & 15;
      *(u32x4*)(Qw + row * KP + cc * 8) = qreg[i];
    }
  }
  const float csc = 0.08838834764831845f * 1.4426950408889634f;
  const int q4 = (lane & 15) >> 2, p4 = lane & 3, blk = (lane >> 4) & 1;
  bool first = true;
#pragma unroll 1
  while (j <= jhi) {
    if (!first) __syncthreads();
    first = false;
    swrite();
    __syncthreads();
    const int jn = next_j(j);
    if (jn <= jhi) gload(jn);
    const int k0 = j * 64;
    if (MODE == MODE_RET && k0 > tq0 + 31) { j = jn; continue; }
    bf16x8 pf[2][2];
    if (MODE == MODE_RET) {
#pragma unroll
      for (int sub = 0; sub < 2; ++sub) {
        f32x16 sx;
#pragma unroll
        for (int i = 0; i < 16; ++i) sx[i] = 0.f;
#pragma unroll
        for (int s = 0; s < 8; ++s) {
          const bf16x8 kf = *(const bf16x8*)(Ks + (32 * sub + r) * KP + 16 * s + 8 * h);
          const bf16x8 qf = *(const bf16x8*)(Qw + r * KP + 16 * s + 8 * h);
          sx = MFMA(kf, qf, sx);
        }
        {
          const int dq = tq - (k0 + 32 * sub);
          const float cf = __builtin_amdgcn_exp2f(lg * (float)dq);
#pragma unroll
          for (int i = 0; i < 16; ++i) sx[i] = (crow(i, h) <= dq) ? sx[i] * (cf * rf[i]) : 0.f;
        }
        pf[sub][0] = pack8(sx, 0);
        pf[sub][1] = pack8(sx, 1);
      }
    } else {
      f32x16 s0, s1;
#pragma unroll
      for (int i = 0; i < 16; ++i) { s0[i] = 0.f; s1[i] = 0.f; }
#pragma unroll
      for (int s = 0; s < 8; ++s) {
        const bf16x8 k0f = *(const bf16x8*)(Ks + r * KP + 16 * s + 8 * h);
        const bf16x8 k1f = *(const bf16x8*)(Ks + (32 + r) * KP + 16 * s + 8 * h);
        const bf16x8 qf = *(const bf16x8*)(Qw + r * KP + 16 * s + 8 * h);
        s0 = MFMA(k0f, qf, s0);
        s1 = MFMA(k1f, qf, s1);
      }
      bool need_mask = false;
      if (MODE == MODE_WIN) need_mask = (k0 + 63 > tq0) || (k0 < tq0 + 31 - 511);
      if (MODE == MODE_SEL) need_mask = (k0 + 63 > tq0);
      const bool lanesel = (MODE == MODE_SEL) ? ((selm >> j) & 1u) : true;
      float mx = -INFINITY;
      if (need_mask) {
#pragma unroll
        for (int i = 0; i < 16; ++i) {
          const int tk0 = k0 + crow(i, h), tk1 = tk0 + 32;
          bool ok0 = true, ok1 = true;
          if (MODE == MODE_WIN) { ok0 = (tk0 <= tq) && (tq - tk0 < 512); ok1 = (tk1 <= tq) && (tq - tk1 < 512); }
          if (MODE == MODE_SEL) { ok0 = lanesel && (tk0 <= tq); ok1 = lanesel && (tk1 <= tq); }
          s0[i] = ok0 ? s0[i] * csc : -INFINITY;
          s1[i] = ok1 ? s1[i] * csc : -INFINITY;
          mx = fmaxf(mx, fmaxf(s0[i], s1[i]));
        }
      } else {
#pragma unroll
        for (int i = 0; i < 16; ++i) {
          s0[i] = lanesel ? s0[i] * csc : -INFINITY;
          s1[i] = lanesel ? s1[i] * csc : -INFINITY;
          mx = fmaxf(mx, fmaxf(s0[i], s1[i]));
        }
      }
      mx = fmaxf(mx, __shfl_xor(mx, 32));
      const float mnew = fmaxf(m_run, mx);
      const float muse = (mnew == -INFINITY) ? 0.f : mnew;
      const float alpha = __builtin_amdgcn_exp2f(m_run - muse);
      float ls = 0.f;
#pragma unroll
      for (int i = 0; i < 16; ++i) {
        s0[i] = __builtin_amdgcn_exp2f(s0[i] - muse);
        s1[i] = __builtin_amdgcn_exp2f(s1[i] - muse);
        ls += s0[i] + s1[i];
      }
      ls += __shfl_xor(ls, 32);
      l_run = l_run * alpha + ls;
      m_run = mnew;
      if (__builtin_amdgcn_ballot_w64(alpha != 1.f) != 0) {
#pragma unroll
        for (int dt = 0; dt < 4; ++dt)
#pragma unroll
          for (int i = 0; i < 16; ++i) o[dt][i] *= alpha;
      }
      pf[0][0] = pack8(s0, 0); pf[0][1] = pack8(s0, 1);
      pf[1][0] = pack8(s1, 0); pf[1][1] = pack8(s1, 1);
    }
#pragma unroll
    for (int dt = 0; dt < 4; ++dt)
#pragma unroll
      for (int sub = 0; sub < 2; ++sub)
#pragma unroll
        for (int st = 0; st < 2; ++st) {
          const int key0 = 32 * sub + 16 * st + 4 * h;
          const bfr* vp = Vs + (key0 + q4) * VP + 32 * dt + 16 * blk + 4 * p4;
          const s16x4 lo = tr_read(vp);
          const s16x4 hi = tr_read(vp + 8 * VP);
          const bf16x8 vf = __builtin_shufflevector(lo, hi, 0, 1, 2, 3, 4, 5, 6, 7);
          o[dt] = MFMA(vf, pf[sub][st], o[dt]);
        }
    j = jn;
  }

  if (MODE == MODE_SEL && p.dbg) return;
  const size_t mrow = (size_t)(b * SEQ + tq);
  if (MODE == MODE_WIN || MODE == MODE_SEL) {
    const float inv = (l_run > 0.f) ? 1.f / l_run : 0.f;
    const float gate = bflo(z[mrow * ZS + ZC_GN + head * 3 + (MODE == MODE_WIN ? 2 : 1)]);
    bfr* orow = (bfr*)(ws + OFF_ONSA) + mrow * 2048 + head * 128;
    const float sc = inv * gate;
#pragma unroll
    for (int dt = 0; dt < 4; ++dt)
#pragma unroll
      for (int g = 0; g < 4; ++g) {
        bfr* dst = orow + 32 * dt + 8 * g + 4 * h;
        float a = o[dt][4 * g] * sc, bb = o[dt][4 * g + 1] * sc, c = o[dt][4 * g + 2] * sc, d = o[dt][4 * g + 3] * sc;
        if (MODE == MODE_SEL) {
          const uint2 old = *(const uint2*)dst;
          a += bflo(old.x); bb += bfhi(old.x); c += bflo(old.y); d += bfhi(old.y);
        }
        st_bf4(dst, a, bb, c, d);
      }
  } else if (MODE == MODE_X) {
    const float inv = 1.f / l_run;
    bfr* orow = (bfr*)(ws + OFF_OX) + mrow * 512 + head * 128;
#pragma unroll
    for (int dt = 0; dt < 4; ++dt)
#pragma unroll
      for (int g = 0; g < 4; ++g)
        st_bf4(orow + 32 * dt + 8 * g + 4 * h, o[dt][4 * g] * inv, o[dt][4 * g + 1] * inv, o[dt][4 * g + 2] * inv,
               o[dt][4 * g + 3] * inv);
  } else {
    float sm = 0.f, sq = 0.f;
#pragma unroll
    for (int dt = 0; dt < 4; ++dt)
#pragma unroll
      for (int i = 0; i < 16; ++i) { sm += o[dt][i]; sq += o[dt][i] * o[dt][i]; }
    sm += __shfl_xor(sm, 32);
    sq += __shfl_xor(sq, 32);
    if (h == 0) *(float2*)((float*)(ws + OFF_RSTAT) + ((mrow * 8 + head) * 2 + vh) * 2) = make_float2(sm, sq);
    bfr* orow = (bfr*)(ws + OFF_ORET) + mrow * 2048 + head * 256 + vh * 128;
#pragma unroll
    for (int dt = 0; dt < 4; ++dt)
#pragma unroll
      for (int g = 0; g < 4; ++g)
        st_bf4(orow + 32 * dt + 8 * g + 4 * h, o[dt][4 * g], o[dt][4 * g + 1], o[dt][4 * g + 2], o[dt][4 * g + 3]);
  }
}

DI void ret_finish_row(const Params& p, int row, const int t) {
  char* ws = p.ws;
  const bfr* z = (const bfr*)(ws + OFF_Z);
  const int col = t * 8, head = t >> 5;
  const float4 st = *(const float4*)((const float*)(ws + OFF_RSTAT) + ((size_t)row * 8 + head) * 4);
  const float mu = (st.x + st.z) * (1.f / 256.f);
  const float var = fmaxf((st.y + st.w) * (1.f / 256.f) - mu * mu, 0.f);
  const float rstd = rsqrtf(var + 1e-6f);
  bfr* op = (bfr*)(ws + OFF_ORET) + (size_t)row * 2048 + col;
  const u32x4 ov = *(const u32x4*)op;
  const u32x4 gv = *(const u32x4*)(z + (size_t)row * ZS + ZC_GR + col);
  const float4 w0 = *(const float4*)(p.gn_w + col), w1 = *(const float4*)(p.gn_w + col + 4);
  u32x4 res;
  res[0] = pack2((bflo(ov[0]) - mu) * rstd * w0.x * bflo(gv[0]), (bfhi(ov[0]) - mu) * rstd * w0.y * bfhi(gv[0]));
  res[1] = pack2((bflo(ov[1]) - mu) * rstd * w0.z * bflo(gv[1]), (bfhi(ov[1]) - mu) * rstd * w0.w * bfhi(gv[1]));
  res[2] = pack2((bflo(ov[2]) - mu) * rstd * w1.x * bflo(gv[2]), (bfhi(ov[2]) - mu) * rstd * w1.y * bfhi(gv[2]));
  res[3] = pack2((bflo(ov[3]) - mu) * rstd * w1.z * bflo(gv[3]), (bfhi(ov[3]) - mu) * rstd * w1.w * bfhi(gv[3]));
  *(u32x4*)op = res;
}

DI void cmp_item(const Params& p, int item, char* smem, const int tid) {
  bfr* Ks = (bfr*)smem;
  float* impw = (float*)(smem + 128 * KP * 2);
  const int w = tid >> 6, lane = tid & 63, r = lane & 31, h = lane >> 5;
  char* ws = p.ws;
  const bfr* z = (const bfr*)(ws + OFF_Z);
  const int tb = item >> 4, bg = item & 15, b = bg >> 2, grp = bg & 3;
  const int t0 = tb * 64, ti = 32 * (w >> 2) + r, tq = t0 + ti, hw = w & 3, head = grp * 4 + hw;
  const bfr* qrow = z + (size_t)(b * SEQ + tq) * ZS + ZC_Q + head * 128;
  const bfr* kc = (const bfr*)(ws + OFF_KCVC) + (size_t)((b * 4 + grp) * 128) * 128;
  const bfr* vc = kc + (size_t)2048 * 128;
  bf16x8 qf[8];
#pragma unroll
  for (int s = 0; s < 8; ++s) qf[s] = *(const bf16x8*)(qrow + 16 * s + 8 * h);
  u32x4 reg[4];
#pragma unroll
  for (int i = 0; i < 4; ++i) {
    const int c = tid + 512 * i, row = c >> 4, cc = c & 15;
    reg[i] = *(const u32x4*)(kc + row * 128 + cc * 8);
  }
  __syncthreads();
#pragma unroll
  for (int i = 0; i < 4; ++i) {
    const int c = tid + 512 * i, row = c >> 4, cc = c & 15;
    *(u32x4*)(Ks + row * KP + cc * 8) = reg[i];
  }
  __syncthreads();
  f32x16 s[4];
#pragma unroll
  for (int kt = 0; kt < 4; ++kt) {
#pragma unroll
    for (int i = 0; i < 16; ++i) s[kt][i] = 0.f;
#pragma unroll
    for (int ss = 0; ss < 8; ++ss) {
      const bf16x8 kf = *(const bf16x8*)(Ks + (32 * kt + r) * KP + 16 * ss + 8 * h);
      s[kt] = MFMA(kf, qf[ss], s[kt]);
    }
  }
  const float csc = 0.08838834764831845f * 1.4426950408889634f;
  float mx = -INFINITY;
#pragma unroll
  for (int kt = 0; kt < 4; ++kt)
#pragma unroll
    for (int i = 0; i < 16; ++i) {
      const int c = 32 * kt + crow(i, h);
      const bool ok = (c * 16 + 31 <= tq) && (c < 127);
      s[kt][i] = ok ? s[kt][i] * csc : -INFINITY;
      mx = fmaxf(mx, s[kt][i]);
    }
  mx = fmaxf(mx, __shfl_xor(mx, 32));
  const float muse = (mx == -INFINITY) ? 0.f : mx;
  float ls = 0.f;
#pragma unroll
  for (int kt = 0; kt < 4; ++kt)
#pragma unroll
    for (int i = 0; i < 16; ++i) {
      s[kt][i] = __builtin_amdgcn_exp2f(s[kt][i] - muse);
      ls += s[kt][i];
    }
  ls += __shfl_xor(ls, 32);
  const float inv = (ls > 0.f) ? 1.f / ls : 0.f;
#pragma unroll
  for (int kt = 0; kt < 4; ++kt)
#pragma unroll
    for (int i = 0; i < 16; ++i) s[kt][i] *= inv;
  float plast[16];
#pragma unroll
  for (int kt = 0; kt < 4; ++kt)
#pragma unroll
    for (int g = 0; g < 4; ++g) plast[kt * 4 + g] = __shfl_xor(s[kt][4 * g + 3], 32);
#pragma unroll
  for (int kt = 0; kt < 4; ++kt)
#pragma unroll
    for (int g = 0; g < 4; ++g) {
      const int slot = kt * 4 + g;
      const float sum4 = s[kt][4 * g] + s[kt][4 * g + 1] + s[kt][4 * g + 2] + s[kt][4 * g + 3];
      const float prevl = (slot > 0) ? plast[slot > 0 ? slot - 1 : 0] : 0.f;
      const float add = h ? plast[slot] : prevl;
      impw[(hw * 64 + ti) * 32 + 8 * kt + 2 * g + h] = sum4 + add;
    }
  bf16x8 pf[4][2];
#pragma unroll
  for (int kt = 0; kt < 4; ++kt) { pf[kt][0] = pack8(s[kt], 0); pf[kt][1] = pack8(s[kt], 1); }
#pragma unroll
  for (int i = 0; i < 4; ++i) {
    const int c = tid + 512 * i, row = c >> 4, cc = c & 15;
    reg[i] = *(const u32x4*)(vc + row * 128 + cc * 8);
  }
  __syncthreads();
#pragma unroll
  for (int i = 0; i < 4; ++i) {
    const int c = tid + 512 * i, row = c >> 4, cc = c & 15;
    *(u32x4*)(Ks + row * KP + cc * 8) = reg[i];
  }
  __syncthreads();
  f32x16 o[4];
#pragma unroll
  for (int dt = 0; dt < 4; ++dt)
#pragma unroll
    for (int i = 0; i < 16; ++i) o[dt][i] = 0.f;
  const int q4 = (lane & 15) >> 2, p4 = lane & 3, blk = (lane >> 4) & 1;
#pragma unroll
  for (int dt = 0; dt < 4; ++dt)
#pragma unroll
    for (int kt = 0; kt < 4; ++kt)
#pragma unroll
      for (int st = 0; st < 2; ++st) {
        const int key0 = 32 * kt + 16 * st + 4 * h;
        const bfr* vp = Ks + (key0 + q4) * KP + 32 * dt + 16 * blk + 4 * p4;
        const s16x4 lo = tr_read(vp);
        const s16x4 hi = tr_read(vp + 8 * KP);
        const bf16x8 vf = __builtin_shufflevector(lo, hi, 0, 1, 2, 3, 4, 5, 6, 7);
        o[dt] = MFMA(vf, pf[kt][st], o[dt]);
      }
  {
    const size_t mrow = (size_t)(b * SEQ + tq);
    const float gate = bflo(z[mrow * ZS + ZC_GN + head * 3 + 0]);
    bfr* orow = (bfr*)(ws + OFF_ONSA) + mrow * 2048 + head * 128;
#pragma unroll
    for (int dt = 0; dt < 4; ++dt)
#pragma unroll
      for (int g = 0; g < 4; ++g) {
        bfr* dst = orow + 32 * dt + 8 * g + 4 * h;
        const uint2 old = *(const uint2*)dst;
        st_bf4(dst, o[dt][4 * g] * gate + bflo(old.x), o[dt][4 * g + 1] * gate + bfhi(old.x),
               o[dt][4 * g + 2] * gate + bflo(old.y), o[dt][4 * g + 3] * gate + bfhi(old.y));
      }
  }
  {
    const int i = tid >> 3, jg = tid & 7;
    const int cur = (t0 + i) >> 6;
    float vm[4];
#pragma unroll
    for (int e = 0; e < 4; ++e) {
      const int jme = 4 * jg + e;
      const float a = impw[(0 * 64 + i) * 32 + jme] + impw[(1 * 64 + i) * 32 + jme] + impw[(2 * 64 + i) * 32 + jme] + impw[(3 * 64 + i) * 32 + jme];
      const bool forced = (jme == 0) || (jme == cur) || (jme == cur - 1);
      vm[e] = forced ? INFINITY : ((jme > cur) ? -INFINITY : a);
    }
#pragma unroll
    for (int e = 0; e < 4; ++e) impw[i * 32 + 4 * jg + e] = vm[e];
    __syncthreads();
    int rank[4] = {0, 0, 0, 0};
#pragma unroll 4
    for (int k = 0; k < 32; ++k) {
      const float vk = impw[i * 32 + k];
#pragma unroll
      for (int e = 0; e < 4; ++e) rank[e] += (vk > vm[e] || (vk == vm[e] && k < 4 * jg + e)) ? 1 : 0;
    }
    unsigned bits = 0;
#pragma unroll
    for (int e = 0; e < 4; ++e)
      if (rank[e] < 16 && 4 * jg + e <= cur) bits |= 1u << (4 * jg + e);
    bits |= (unsigned)__shfl_xor((int)bits, 1);
    bits |= (unsigned)__shfl_xor((int)bits, 2);
    bits |= (unsigned)__shfl_xor((int)bits, 4);
    if (jg == 0) ((unsigned*)(ws + OFF_SELM))[(b * 4 + grp) * SEQ + t0 + i] = bits;
  }
  __syncthreads();
}

DI int grab(unsigned* ctr, int* slot, const int tid) {
  __syncthreads();
  if (tid == 0) *slot = (int)atomicAdd(ctr, 1u);
  __syncthreads();
  return *slot;
}

DI void run_phase(const Params& p0, int ph, char* smem, int* slot, const int wave_s, const int rep) {
  char* ws = p0.ws;
  asm volatile("" : "+s"(ws));
  Params p = p0;
  p.ws = ws;
  p.dbg = rep;
  const int G = gridDim.x;
  int bid = blockIdx.x;
  int tid = wave_s * 64 + (int)__builtin_amdgcn_mbcnt_hi(~0u, __builtin_amdgcn_mbcnt_lo(~0u, 0u));
  asm volatile("" : "+s"(bid));
  asm volatile("" : "+v"(tid));
  bfr* z = (bfr*)(ws + OFF_Z);
  unsigned* ctr = (unsigned*)(ws + OFF_CTR) + rep * 8;
  switch (ph) {
    case 0: {
      if (bid == 0 && tid < 64) ((unsigned*)(ws + OFF_CTR))[tid] = 0u;
      for (int i = bid * NTHR + tid; i < 2 * NTOK; i += G * NTHR) ((float*)(ws + OFF_ROWSS))[i] = 0.f;
      int tot = 0;
      for (int j = 0; j < 12; ++j) tot += tjob_tiles(j);
      const int n_norm = 1024 + 128, n_rope = 256;
      tr_run(p, 0, bid, G, tot, (float*)smem, tid);
      for (int it = tot + bid; it < tot + n_norm + n_rope; it += G) {
        if (it < tot + n_norm) {
          const int row = (it - tot) * 8 + (tid >> 6);
          if (row < NTOK) rmsnorm_row(p.x + (size_t)row * 2048, p.attn_norm_w, (bfr*)(ws + OFF_N) + (size_t)row * 2048, nullptr, tid);
          else rmsnorm_row(p.mem + (size_t)(row - NTOK) * 2048, p.mem_norm_w, (bfr*)(ws + OFF_MN) + (size_t)(row - NTOK) * 2048, nullptr, tid);
        } else {
          const int e = (it - tot - n_norm) * 512 + tid;
          const int t = e >> 6, i = e & 63;
          const float ang = (float)t * ROPE_INV[i];
          const float kk = rintf(ang * 0.15915494309189535f);
          float rr = fmaf(-kk, 6.2831854820251465f, ang);
          rr = fmaf(-kk, -1.7484555e-7f, rr);
          const float fr = rr * 0.15915494309189535f;
          ((float2*)(ws + OFF_ROPE))[e] = make_float2(__builtin_amdgcn_cosf(fr), __builtin_amdgcn_sinf(fr));
        }
      }
    } break;
    case 1: {
      const int nt_main = 32 * 61;
      for (int v = bid; v < nt_main + 32; v += G) {
        if (v < nt_main) {
          f32x16 acc[2][4];
          acc_zero<2>(acc);
          int mt, nt;
          map_tile32(v, mt, nt);
          const int m0 = mt * 256, n0 = nt * 256;
          PlainPtr af{(const bfr*)(ws + OFF_N) + (size_t)m0 * 2048, 2048};
          PlainPtr bf{(const bfr*)(ws + OFF_WINT) + (size_t)n0 * 2048, 2048};
          gemm_main<2>(acc, af, bf, 32, smem, tid);
          bfr* zcb = (bfr*)(ws + OFF_ZC);
          const float2* rope = (const float2*)(ws + OFF_ROPE);
          gemm_epi<2>(acc, m0, n0, tid, [&](int m, int n, float a, float b, float c, float d) {
            if (n >= ZS) return;
            bfr* dst = z + (size_t)m * ZS + n;
            const int t = m & 2047;
            if (n >= ZC_KC && n < ZC_KS) {
              const float* pe = (n < ZC_VC) ? p.pe_k : p.pe_v;
              const int dd = n & 127;
              const float4 plo = *(const float4*)(pe + (t & 15) * 128 + dd);
              const float4 phi = *(const float4*)(pe + (16 + (t & 15)) * 128 + dd);
              st_bf4(zcb + (size_t)m * 2048 + (n - ZC_KC), a + plo.x, b + plo.y, c + plo.z, d + plo.w);
              st_bf4(zcb + (size_t)m * 2048 + 1024 + (n - ZC_KC), a + phi.x, b + phi.y, c + phi.z, d + phi.w);
            } else if (n >= ZC_QR && n < ZC_VR) {
              const int i0 = (n & 127) >> 1;
              const float2 c0 = rope[t * 64 + i0], c1 = rope[t * 64 + i0 + 1];
              float o0 = a * c0.x - b * c0.y, o1 = a * c0.y + b * c0.x;
              float o2 = c * c1.x - d * c1.y, o3 = c * c1.y + d * c1.x;
              if (n >= ZC_KR) { const float sc = 0.08838834764831845f; o0 *= sc; o1 *= sc; o2 *= sc; o3 *= sc; }
              st_bf4(dst, o0, o1, o2, o3);
            } else if (n >= ZC_GR && n < ZC_GA) {
              st_bf4(dst, a * sigmoidf_(a), b * sigmoidf_(b), c * sigmoidf_(c), d * sigmoidf_(d));
            } else if (n >= ZC_GA) {
              st_bf4(dst, sigmoidf_(a), sigmoidf_(b), sigmoidf_(c), sigmoidf_(d));
            } else {
              st_bf4(dst, a, b, c, d);
            }
          });
        } else {
          f32x16 acc[1][4];
          acc_zero<1>(acc);
          const int u = v - nt_main, which = u >> 4, mt = (u & 15) >> 2, nt = u & 3;
          const int m0 = mt * 256, n0 = nt * 128;
          PlainPtr af{(const bfr*)(ws + OFF_MN) + (size_t)m0 * 2048, 2048};
          PlainPtr bf{(const bfr*)(ws + (which ? OFF_WVT : OFF_WKT)) + (size_t)n0 * 2048, 2048};
          gemm_main<1>(acc, af, bf, 32, smem, tid);
          bfr* dstb = (bfr*)(ws + (which ? OFF_VX : OFF_KX));
          gemm_epi<1>(acc, m0, n0, tid, [&](int m, int n, float a, float b, float c, float d) { st_bf4(dstb + (size_t)m * 512 + n, a, b, c, d); });
        }
      }
    } break;
    case 2: {
      for (int it = grab(ctr + 0, slot, tid); it < 64; it = grab(ctr + 0, slot, tid)) {
        const int which = it >> 5, mt = (it & 31) >> 2, nt = it & 3;
        const int m0 = mt * 256, n0 = nt * 256;
        f32x16 acc[2][4];
        acc_zero<2>(acc);
        struct GatherA {
          const bfr* base; int m0;
          DI int rowoff(int row) const {
            const int R = m0 + row;
            const int bb = R >> 9, g = (R >> 7) & 3;
            int c = R & 127; c = c > 126 ? 126 : c;
            return (bb * SEQ + c * 16) * 2048 + g * 128;
          }
          DI int koff(int kk) const { const int l = kk >> 7; return l * 2048 + ((l >> 4) << 10) + (kk & 127); }
        };
        GatherA af{(const bfr*)(ws + OFF_ZC) + which * 512, m0};
        PlainPtr bf{(const bfr*)(ws + OFF_W1T) + (size_t)which * 1024 * 4096 + (size_t)n0 * 4096, 4096};
        gemm_main<2>(acc, af, bf, 64, smem, tid);
        bfr* hid = (bfr*)(ws + OFF_HIDC) + (size_t)which * 2048 * 1024;
        gemm_epi<2>(acc, m0, n0, tid, [&](int m, int n, float a, float b, float c, float d) {
          st_bf4(hid + (size_t)m * 1024 + n, a * sigmoidf_(a), b * sigmoidf_(b), c * sigmoidf_(c), d * sigmoidf_(d));
        });
      }
      for (int it = grab(ctr + 1, slot, tid); it < 1024; it = grab(ctr + 1, slot, tid)) {
        if (it < 512) attn_item<MODE_RET>(p, it, smem, tid);
        else attn_item<MODE_WIN>(p, it - 512, smem, tid);
      }
    } break;
    case 3: {
      for (int it = bid; it < 16 + NTOK / 2; it += G) {
        if (it >= 16) { ret_finish_row(p, (it - 16) * 2 + (tid >> 8), tid & 255); continue; }
        const int which = it >> 3, mt = it & 7;
        const int m0 = mt * 256;
        f32x16 acc[1][4];
        acc_zero<1>(acc);
        PlainPtr af{(const bfr*)(ws + OFF_HIDC) + (size_t)which * 2048 * 1024 + (size_t)m0 * 1024, 1024};
        PlainPtr bf{(const bfr*)(ws + OFF_W2T) + (size_t)which * 128 * 1024, 1024};
        gemm_main<1>(acc, af, bf, 16, smem, tid);
        bfr* dstb = (bfr*)(ws + OFF_KCVC) + (size_t)which * 2048 * 128;
        gemm_epi<1>(acc, m0, 0, tid, [&](int m, int n, float a, float b, float c, float d) { st_bf4(dstb + (size_t)m * 128 + n, a, b, c, d); });
      }
    } break;
    case 4: {
      for (int it = bid; it < 512; it += G) cmp_item(p, it, smem, tid);
    } break;
    case 5: {
      for (int it = grab(ctr + 2, slot, tid); it < 512; it = grab(ctr + 2, slot, tid)) attn_item<MODE_SEL>(p, it, smem, tid);
    } break;
    case 6: {
      for (int v = bid; v < 32 * 8; v += G) {
        int mt, nt;
        map_tile32(v, mt, nt);
        const int m0 = mt * 256, n0 = nt * 256;
        f32x16 acc[2][4];
        acc_zero<2>(acc);
        bfr* mg = (bfr*)(ws + OFF_MERGED);
        {
          PlainPtr af{(const bfr*)(ws + OFF_ONSA) + (size_t)m0 * 2048, 2048};
          PlainPtr bf{(const bfr*)(ws + OFF_WAT) + (size_t)n0 * 2048, 2048};
          gemm_main<2>(acc, af, bf, 32, smem, tid);
          gemm_epi<2>(acc, m0, n0, tid, [&](int m, int n, float a, float b, float c, float d) {
            const uint2 ga = *(const uint2*)(z + (size_t)m * ZS + ZC_GA + n);
            st_bf4(mg + (size_t)m * 2048 + n, bflo(ga.x) * a, bfhi(ga.x) * b, bflo(ga.y) * c, bfhi(ga.y) * d);
          });
        }
        acc_zero<2>(acc);
        {
          PlainPtr af{(const bfr*)(ws + OFF_ORET) + (size_t)m0 * 2048, 2048};
          PlainPtr bf{(const bfr*)(ws + OFF_WBT) + (size_t)n0 * 2048, 2048};
          gemm_main<2>(acc, af, bf, 32, smem, tid);
          gemm_epi<2>(acc, m0, n0, tid, [&](int m, int n, float a, float b, float c, float d) {
            const uint2 gb = *(const uint2*)(z + (size_t)m * ZS + ZC_GB + n);
            bfr* dst = mg + (size_t)m * 2048 + n;
            const uint2 old = *(const uint2*)dst;
            st_bf4(dst, bflo(old.x) + bflo(gb.x) * a, bfhi(old.x) + bfhi(gb.x) * b, bflo(old.y) + bflo(gb.y) * c, bfhi(old.y) + bfhi(gb.y) * d);
          });
        }
      }
    } break;
    case 7: {
      for (int v = bid; v < 32 * 8; v += G) {
        int mt, nt;
        map_tile32(v, mt, nt);
        const int m0 = mt * 256, n0 = nt * 256;
        f32x16 acc[2][4];
        acc_zero<2>(acc);
        PlainPtr af{(const bfr*)(ws + OFF_MERGED) + (size_t)m0 * 2048, 2048};
        PlainPtr bf{(const bfr*)(ws + OFF_WOUTT) + (size_t)n0 * 2048, 2048};
        gemm_main<2>(acc, af, bf, 32, smem, tid);
        gemm_epi_resid(acc, m0, n0, tid, p.x, (float*)(ws + OFF_H), (bfr*)(ws + OFF_NX), (float*)(ws + OFF_ROWSS));
      }
    } break;
    case 8: case 12: break;
    case 9: {
      const int ng = (G > 128) ? 128 : G;
      if (G > 128) { if (bid >= 128) tr_run(p, 12, bid - 128, G - 128, tjob_tiles(12), (float*)smem, tid); }
      else tr_run(p, 12, bid, G, tjob_tiles(12), (float*)smem, tid);
      if (bid < ng)
      for (int v = bid; v < 32 * 4; v += ng) {
        int mt, nt;
        map_tile32(v, mt, nt);
        const int m0 = mt * 256, n0 = nt * 128;
        f32x16 acc[1][4];
        acc_zero<1>(acc);
        PlainPtr af{(const bfr*)(ws + OFF_NX) + (size_t)m0 * 2048, 2048};
        PlainPtr bf{(const bfr*)(ws + OFF_WQT) + (size_t)n0 * 2048, 2048};
        gemm_main<1>(acc, af, bf, 32, smem, tid);
        bfr* qx = (bfr*)(ws + OFF_QX);
        const float* rss = (const float*)(ws + OFF_ROWSS);
        gemm_epi<1>(acc, m0, n0, tid, [&](int m, int n, float a, float b, float c, float d) {
          const float rs = rsqrtf(rss[m] * (1.f / 2048.f) + 1e-6f);
          st_bf4(qx + (size_t)m * 512 + n, a * rs, b * rs, c * rs, d * rs);
        });
      }
    } break;
    case 10: {
      const int ng = (G > 128) ? 128 : G;
      if (G > 128) { if (bid >= 128) tr_run(p, 13, bid - 128, G - 128, tjob_tiles(13), (float*)smem, tid); }
      else tr_run(p, 13, bid, G, tjob_tiles(13), (float*)smem, tid);
      if (bid < ng)
        for (int it = bid; it < 128; it += ng) attn_item<MODE_X>(p, it, smem, tid);
    } break;
    case 11: {
      for (int v = bid; v < 32 * 8; v += G) {
        int mt, nt;
        map_tile32(v, mt, nt);
        const int m0 = mt * 256, n0 = nt * 256;
        f32x16 acc[2][4];
        acc_zero<2>(acc);
        PlainPtr af{(const bfr*)(ws + OFF_OX) + (size_t)m0 * 512, 512};
        PlainPtr bf{(const bfr*)(ws + OFF_WOT) + (size_t)n0 * 512, 512};
        gemm_main<2>(acc, af, bf, 8, smem, tid);
        gemm_epi_resid(acc, m0, n0, tid, (const float*)(ws + OFF_H), (float*)(ws + OFF_H), (bfr*)(ws + OFF_NX), (float*)(ws + OFF_ROWSS) + NTOK);
      }
    } break;
    case 13: {
      for (int v = bid; v < 32 * 32; v += G) {
        int mt, nt;
        map_tile32(v, mt, nt);
        const int m0 = mt * 256, n0 = nt * 256;
        f32x16 acc[2][4];
        acc_zero<2>(acc);
        PlainPtr af{(const bfr*)(ws + OFF_NX) + (size_t)m0 * 2048, 2048};
        PlainPtr bf{(const bfr*)(ws + OFF_WUPT) + (size_t)n0 * 2048, 2048};
        gemm_main<2>(acc, af, bf, 32, smem, tid);
        bfr* hid = (bfr*)(ws + OFF_HID);
        const float* rss = (const float*)(ws + OFF_ROWSS) + NTOK;
        gemm_epi<2>(acc, m0, n0, tid, [&](int m, int n, float a, float b, float c, float d) {
          const float rs = rsqrtf(rss[m] * (1.f / 2048.f) + 1e-6f);
          a = fmaxf(a, 0.f) * rs; b = fmaxf(b, 0.f) * rs; c = fmaxf(c, 0.f) * rs; d = fmaxf(d, 0.f) * rs;
          st_bf4(hid + (size_t)m * 8192 + n, a * a, b * b, c * c, d * d);
        });
      }
    } break;
    case 14: {
      for (int v = bid; v < 32 * 8; v += G) {
        int mt, nt;
        map_tile32(v, mt, nt);
        const int m0 = mt * 256, n0 = nt * 256;
        f32x16 acc[2][4];
        acc_zero<2>(acc);
        PlainPtr af{(const bfr*)(ws + OFF_HID) + (size_t)m0 * 8192, 8192};
        PlainPtr bf{(const bfr*)(ws + OFF_WDOWNT) + (size_t)n0 * 8192, 8192};
        gemm_main<2>(acc, af, bf, 128, smem, tid);
        const float* hbuf = (const float*)(ws + OFF_H);
        gemm_epi<2>(acc, m0, n0, tid, [&](int m, int n, float a, float b, float c, float d) {
          const float4 xv = *(const float4*)(hbuf + (size_t)m * 2048 + n);
          *(float4*)(p.out + (size_t)m * 2048 + n) = make_float4(xv.x + a, xv.y + b, xv.z + c, xv.w + d);
        });
      }
    } break;
    case 15: {
      for (int it = bid; it < 1024; it += G) {
        const int row = it * 8 + (tid >> 6);
        rmsnorm_row(p.out + (size_t)row * 2048, p.final_norm_w, nullptr, p.out + (size_t)row * 2048, tid);
      }
    } break;
    default: break;
  }
}

__global__ void __launch_bounds__(512, 2) mega(Params p) {
  extern __shared__ __attribute__((aligned(1024))) char smem[];
  __shared__ int slot;
  cg::grid_group grid = cg::this_grid();
  const int wave_s = __builtin_amdgcn_readfirstlane((int)(threadIdx.x >> 6));
  for (int ph = p.ph_lo; ph < p.ph_hi; ++ph) {
    if (ph == 8 || ph == 12) continue;
    run_phase(p, ph, smem, &slot, wave_s, 0);
#ifdef PROBE_PH
    if (ph == PROBE_PH)
      for (int rep = 1; rep <= PROBE_N; ++rep) { grid.sync(); run_phase(p, ph, smem, &slot, wave_s, rep); }
#endif
    if (ph + 1 < p.ph_hi) grid.sync();
  }
}

extern "C" void kernel_launch(void* const* d_in, const int* in_sizes, int n_in, void* d_out, int out_size, void* d_ws,
                              size_t ws_size, hipStream_t stream) {
  static int grid_blocks = 0;
  if (!grid_blocks) {
    int dev = 0, cus = 0, per_cu = 0;
    (void)hipGetDevice(&dev);
    (void)hipDeviceGetAttribute(&cus, hipDeviceAttributeMultiprocessorCount, dev);
    (void)hipFuncSetAttribute((const void*)mega, hipFuncAttributeMaxDynamicSharedMemorySize, SMEM_BYTES);
    (void)hipOccupancyMaxActiveBlocksPerMultiprocessor(&per_cu, mega, NTHR, SMEM_BYTES);
    if (per_cu < 1) per_cu = 1;
    if (per_cu > 1) per_cu = 1;
    grid_blocks = cus * per_cu;
    grid_blocks &= ~7;
    if (ws_size < WS_END || n_in != 24) { fprintf(stderr, "kernel_launch: ws %zu < %zu or n_in %d\n", ws_size, (size_t)WS_END, n_in); grid_blocks = -1; }
  }
  if (grid_blocks < 0) return;
  Params p{};
  const float** pp = (const float**)&p;
  for (int i = 0; i < 24; ++i) pp[i] = (const float*)d_in[i];
  p.out = (float*)d_out;
  p.ws = (char*)d_ws;
#if ONE_LAUNCH
  p.ph_lo = 0; p.ph_hi = NPHASE;
  void* args[] = {&p};
  hipError_t e = hipLaunchCooperativeKernel((void*)mega, dim3(grid_blocks), dim3(NTHR), args, SMEM_BYTES, stream);
  if (e != hipSuccess) fprintf(stderr, "cooperative launch failed: %s (grid %d)\n", hipGetErrorString(e), grid_blocks);
#else
  for (int ph = 0; ph < NPHASE; ++ph) {
    p.ph_lo = ph; p.ph_hi = ph + 1;
    hipLaunchKernelGGL(mega, dim3(grid_blocks), dim3(NTHR), SMEM_BYTES, stream, p);
  }
#endif
}
```

```cpp
#include <hip/hip_runtime.h>
#include <hip/hip_cooperative_groups.h>
#include <cstdio>
namespace cg = cooperative_groups;

#ifndef ONE_LAUNCH
#define ONE_LAUNCH 1
#endif

#define DI __device__ __forceinline__
typedef unsigned short bfr;
using bf16x8 = __attribute__((ext_vector_type(8))) short;
using s16x4 = __attribute__((ext_vector_type(4))) short;
using f32x16 = __attribute__((ext_vector_type(16))) float;
using u32x4 = __attribute__((ext_vector_type(4))) unsigned;
#define MFMA(a, b, c) __builtin_amdgcn_mfma_f32_32x32x16_bf16((a), (b), (c), 0, 0, 0)

constexpr int DM = 2048, SEQ = 2048, NTOK = 8192;
constexpr int ZS = 15488;
constexpr int ZC_Q = 0, ZC_KC = 2048, ZC_VC = 2560, ZC_KS = 3072, ZC_VS = 3584, ZC_KW = 4096, ZC_VW = 4608,
              ZC_QR = 5120, ZC_KR = 6144, ZC_VR = 7168, ZC_GR = 9216, ZC_GA = 11264, ZC_GB = 13312, ZC_GN = 15360;
constexpr int NPHASE = 16;

constexpr int ZSP = 15616;
constexpr size_t SZ_WINT = (size_t)ZSP * 2048 * 2;
constexpr size_t SZ_ACT = (size_t)NTOK * 2048 * 2;
constexpr size_t OFF_WINT = 0;
constexpr size_t OFF_N = OFF_WINT + SZ_WINT;
constexpr size_t OFF_MERGED = OFF_WINT;
constexpr size_t OFF_ORET = OFF_N;
constexpr size_t OFF_WUPT = 0;
constexpr size_t OFF_WDOWNT = SZ_ACT;
constexpr size_t OFF_Z = OFF_N + SZ_ACT;
constexpr size_t SZ_Z = (size_t)NTOK * ZS * 2;
constexpr size_t OFF_HID = OFF_Z;
constexpr size_t OFF_H = OFF_Z + (size_t)NTOK * 8192 * 2;
constexpr size_t OFF_NX = OFF_H + (size_t)NTOK * 2048 * 4;
constexpr size_t OFF_QX = OFF_NX + SZ_ACT;
constexpr size_t OFF_OX = OFF_QX + (size_t)NTOK * 512 * 2;
static_assert(OFF_OX + (size_t)NTOK * 512 * 2 <= OFF_Z + SZ_Z, "alias overflow");
constexpr size_t OFF_ZC = OFF_Z + SZ_Z;
constexpr size_t OFF_MN = OFF_ZC + (size_t)NTOK * 2048 * 2;
constexpr size_t OFF_W1T = OFF_MN + (size_t)1024 * 2048 * 2;
constexpr size_t OFF_W2T = OFF_W1T + (size_t)2 * 1024 * 4096 * 2;
constexpr size_t OFF_WAT = OFF_W2T + (size_t)2 * 128 * 1024 * 2;
constexpr size_t OFF_WBT = OFF_WAT + (size_t)2048 * 2048 * 2;
constexpr size_t OFF_WOUTT = OFF_WBT + (size_t)2048 * 2048 * 2;
constexpr size_t OFF_WQT = OFF_WOUTT + (size_t)2048 * 2048 * 2;
constexpr size_t OFF_WKT = OFF_WQT + (size_t)512 * 2048 * 2;
constexpr size_t OFF_WVT = OFF_WKT + (size_t)512 * 2048 * 2;
constexpr size_t OFF_WOT = OFF_WVT + (size_t)512 * 2048 * 2;
constexpr size_t OFF_ROPE = OFF_WOT + (size_t)512 * 2048 * 2;
constexpr size_t OFF_HIDC = OFF_ROPE + (size_t)2048 * 64 * 8;
constexpr size_t OFF_KCVC = OFF_HIDC + (size_t)2 * 2048 * 1024 * 2;
constexpr size_t OFF_SELM = OFF_KCVC + (size_t)2 * 2048 * 128 * 2;
constexpr size_t OFF_ONSA = OFF_SELM + (size_t)16 * 2048 * 4;
constexpr size_t OFF_KX = OFF_ONSA + SZ_ACT;
constexpr size_t OFF_VX = OFF_KX + (size_t)1024 * 512 * 2;
constexpr size_t OFF_RSTAT = OFF_VX + (size_t)1024 * 512 * 2;
constexpr size_t OFF_CTR = OFF_RSTAT + (size_t)NTOK * 8 * 2 * 2 * 4;
constexpr size_t OFF_ROWSS = OFF_CTR + 256;
constexpr size_t WS_END = OFF_ROWSS + (size_t)2 * NTOK * 4;

struct Params {
  const float *x, *mem, *attn_norm_w, *w_in, *pe_k, *w1k, *w2k, *pe_v, *w1v, *w2v, *w_a, *gn_w, *w_b, *w_out, *x_norm_w,
      *mem_norm_w, *wq, *wk, *wv, *wo, *mlp_norm_w, *w_up, *w_down, *final_norm_w;
  float* out;
  char* ws;
  int ph_lo, ph_hi;
  int dbg, pad;
};

constexpr int NTHR = 512;
constexpr int SMEM_BYTES = 131072;
__device__ const float ROPE_INV[64] = {1.0f, 0.865964353f, 0.749894261f, 0.649381638f, 0.562341332f, 0.486967534f, 0.421696514f, 0.365174115f, 0.316227764f, 0.273841977f, 0.237137377f, 0.2053525f, 0.177827939f, 0.153992653f, 0.133352131f, 0.115478203f, 0.100000001f, 0.0865964293f, 0.0749894157f, 0.0649381652f, 0.0562341325f, 0.0486967526f, 0.0421696529f, 0.0365174115f, 0.0316227749f, 0.0273841973f, 0.0237137377f, 0.0205352511f, 0.0177827943f, 0.0153992651f, 0.0133352149f, 0.0115478206f, 0.00999999978f, 0.00865964312f, 0.00749894185f, 0.00649381615f, 0.00562341325f, 0.00486967526f, 0.00421696482f, 0.00365174119f, 0.00316227763f, 0.00273841969f, 0.00237137359f, 0.00205352483f, 0.00177827943f, 0.00153992651f, 0.00133352145f, 0.0011547819f, 0.00100000005f, 0.000865964335f, 0.000749894243f, 0.000649381662f, 0.000562341302f, 0.000486967532f, 0.000421696517f, 0.000365174143f, 0.000316227757f, 0.000273841957f, 0.00023713737f, 0.00020535251f, 0.00017782794f, 0.000153992645f, 0.00013335215f, 0.0001154782f};

DI unsigned pack2(float a, float b) {
  typedef float f2 __attribute__((ext_vector_type(2)));
  typedef __bf16 b2 __attribute__((ext_vector_type(2)));
  f2 v = {a, b};
  b2 r = __builtin_convertvector(v, b2);
  return __builtin_bit_cast(unsigned, r);
}
DI float bflo(unsigned u) { return __uint_as_float(u << 16); }
DI float bfhi(unsigned u) { return __uint_as_float(u & 0xffff0000u); }
DI void st_bf4(bfr* p, float a, float b, float c, float d) {
  uint2 v; v.x = pack2(a, b); v.y = pack2(c, d);
  *(uint2*)p = v;
}
DI float wave_sum(float v) {
#pragma unroll
  for (int o = 32; o > 0; o >>= 1) v += __shfl_xor(v, o);
  return v;
}
DI float sigmoidf_(float x) { return 1.f / (1.f + __expf(-x)); }
DI int crow(int i, int h) { return (i & 3) + 8 * (i >> 2) + 4 * h; }
DI bf16x8 pack8(const f32x16& x, int s) {
  unsigned a = pack2(x[8 * s], x[8 * s + 1]), b = pack2(x[8 * s + 2], x[8 * s + 3]), c = pack2(x[8 * s + 4], x[8 * s + 5]),
           d = pack2(x[8 * s + 6], x[8 * s + 7]);
  typedef unsigned u4 __attribute__((ext_vector_type(4)));
  u4 v = {a, b, c, d};
  return __builtin_bit_cast(bf16x8, v);
}
DI s16x4 tr_read(const bfr* p) {
  return __builtin_amdgcn_ds_read_tr16_b64_v4i16((__attribute__((address_space(3))) s16x4*)(p));
}

struct TJob { const float* src; bfr* dst; int K, N, ntn, perm; const float* kscale; };
DI TJob get_tjob(const Params& p, int j) {
  TJob t;
  char* ws = p.ws;
  switch (j) {
    case 0: t = {p.w_in, (bfr*)(ws + OFF_WINT), 2048, 15408, 122, 1, nullptr}; break;
    case 1: t = {p.w1k, (bfr*)(ws + OFF_W1T), 4096, 1024, 8, 0, nullptr}; break;
    case 2: t = {p.w1v, (bfr*)(ws + OFF_W1T) + (size_t)1024 * 4096, 4096, 1024, 8, 0, nullptr}; break;
    case 3: t = {p.w2k, (bfr*)(ws + OFF_W2T), 1024, 128, 1, 0, nullptr}; break;
    case 4: t = {p.w2v, (bfr*)(ws + OFF_W2T) + (size_t)128 * 1024, 1024, 128, 1, 0, nullptr}; break;
    case 5: t = {p.w_a, (bfr*)(ws + OFF_WAT), 2048, 2048, 16, 0, nullptr}; break;
    case 6: t = {p.w_b, (bfr*)(ws + OFF_WBT), 2048, 2048, 16, 0, nullptr}; break;
    case 7: t = {p.w_out, (bfr*)(ws + OFF_WOUTT), 2048, 2048, 16, 0, nullptr}; break;
    case 8: t = {p.wq, (bfr*)(ws + OFF_WQT), 2048, 512, 4, 0, p.x_norm_w}; break;
    case 9: t = {p.wk, (bfr*)(ws + OFF_WKT), 2048, 512, 4, 0, nullptr}; break;
    case 10: t = {p.wv, (bfr*)(ws + OFF_WVT), 2048, 512, 4, 0, nullptr}; break;
    case 11: t = {p.wo, (bfr*)(ws + OFF_WOT), 512, 2048, 16, 0, nullptr}; break;
    case 12: t = {p.w_up, (bfr*)(ws + OFF_WUPT), 2048, 8192, 64, 0, p.mlp_norm_w}; break;
    default: t = {p.w_down, (bfr*)(ws + OFF_WDOWNT), 8192, 2048, 16, 0, nullptr}; break;
  }
  return t;
}
DI int tjob_tiles(int j) {
  switch (j) {
    case 0: return 122 * 16;
    case 1: case 2: return 8 * 32;
    case 3: case 4: return 1 * 8;
    case 5: case 6: case 7: return 16 * 16;
    case 8: case 9: case 10: return 4 * 16;
    case 11: return 16 * 4;
    case 12: return 64 * 16;
    default: return 16 * 64;
  }
}
struct TrRegs { float4 v[8]; };
DI void tr_load(const TJob& t, int tile, TrRegs& rg, const int tid) {
  const int nkt = t.K >> 7;
  const int kt = tile % nkt, nt = tile / nkt;
  const int k0 = kt * 128, d0 = nt * 128;
  int scol0 = d0, nvalid = 128;
  if (t.perm) {
    if (d0 < 5120) scol0 = d0;
    else if (d0 < 15360) scol0 = d0 + 48;
    else { scol0 = d0 - 15360 + 5120; nvalid = (d0 == 15360) ? 48 : 0; }
  }
#pragma unroll
  for (int i = 0; i < 8; ++i) {
    const int row = i * 16 + (tid >> 5), col = (tid & 31) * 4;
    rg.v[i] = make_float4(0.f, 0.f, 0.f, 0.f);
    if (col < nvalid) rg.v[i] = *(const float4*)(t.src + (size_t)(k0 + row) * t.N + scol0 + col);
    if (t.kscale) { const float sc = t.kscale[k0 + row]; rg.v[i].x *= sc; rg.v[i].y *= sc; rg.v[i].z *= sc; rg.v[i].w *= sc; }
  }
}
DI void tr_to_lds(const TrRegs& rg, float* sm, const int tid) {
#pragma unroll
  for (int i = 0; i < 8; ++i) {
    const int row = i * 16 + (tid >> 5), col = (tid & 31) * 4;
    float* d = sm + row * 129 + col;
    d[0] = rg.v[i].x; d[1] = rg.v[i].y; d[2] = rg.v[i].z; d[3] = rg.v[i].w;
  }
}
DI void tr_store(const TJob& t, int tile, const float* sm, const int tid) {
  const int nkt = t.K >> 7;
  const int kt = tile % nkt, nt = tile / nkt;
  const int k0 = kt * 128, d0 = nt * 128;
  const int n = tid >> 2, kq = (tid & 3) * 8;
  bfr* drow = t.dst + (size_t)(d0 + n) * t.K + k0 + kq;
#pragma unroll
  for (int q = 0; q < 4; ++q) {
    const int kb = kq + 32 * q;
    const unsigned o0 = pack2(sm[(kb + 0) * 129 + n], sm[(kb + 1) * 129 + n]);
    const unsigned o1 = pack2(sm[(kb + 2) * 129 + n], sm[(kb + 3) * 129 + n]);
    const unsigned o2 = pack2(sm[(kb + 4) * 129 + n], sm[(kb + 5) * 129 + n]);
    const unsigned o3 = pack2(sm[(kb + 6) * 129 + n], sm[(kb + 7) * 129 + n]);
    *(uint4*)(drow + 32 * q) = make_uint4(o0, o1, o2, o3);
  }
}
DI void tr_decode(int it, int j_lo, int& j, int& rem) {
  j = j_lo; rem = it;
  while (rem >= tjob_tiles(j)) { rem -= tjob_tiles(j); ++j; }
}
DI void tr_run(const Params& p, int j_lo, int it0, int stride, int n_tiles, float* sm, const int tid) {
  if (it0 >= n_tiles) return;
  TrRegs rg;
  int j, rem;
  tr_decode(it0, j_lo, j, rem);
  TJob t = get_tjob(p, j);
  tr_load(t, rem, rg, tid);
  for (int it = it0; it < n_tiles; it += stride) {
    __syncthreads();
    tr_to_lds(rg, sm, tid);
    __syncthreads();
    const TJob tc = t;
    const int remc = rem;
    const int nx = it + stride;
    if (nx < n_tiles) {
      tr_decode(nx, j_lo, j, rem);
      t = get_tjob(p, j);
      tr_load(t, rem, rg, tid);
    }
    tr_store(tc, remc, sm, tid);
  }
  __syncthreads();
}

DI void rmsnorm_row(const float* xrow, const float* w, bfr* obf, float* of32, const int tid) {
  const int lane = tid & 63;
  float4 v[8];
  float ss = 0.f;
#pragma unroll
  for (int i = 0; i < 8; ++i) {
    v[i] = ((const float4*)xrow)[lane + 64 * i];
    ss += v[i].x * v[i].x + v[i].y * v[i].y + v[i].z * v[i].z + v[i].w * v[i].w;
  }
  ss = wave_sum(ss);
  const float rs = rsqrtf(ss * (1.f / 2048.f) + 1e-6f);
#pragma unroll
  for (int i = 0; i < 8; ++i) {
    const float4 ww = ((const float4*)w)[lane + 64 * i];
    const float a = v[i].x * rs * ww.x, b = v[i].y * rs * ww.y, c = v[i].z * rs * ww.z, d = v[i].w * rs * ww.w;
    if (obf) st_bf4(obf + (lane + 64 * i) * 4, a, b, c, d);
    else ((float4*)of32)[lane + 64 * i] = make_float4(a, b, c, d);
  }
}

struct PlainPtr {
  const bfr* base; int ld;
  DI int rowoff(int row) const { return row * ld; }
  DI int koff(int k0) const { return k0; }
};
#define WAIT_V(n) asm volatile("s_waitcnt vmcnt(%0)" ::"n"(n) : "memory")
#define WAIT_L(n) asm volatile("s_waitcnt lgkmcnt(%0)" ::"n"(n) : "memory")
#define RAW_BARRIER() do { WAIT_L(0); __builtin_amdgcn_s_barrier(); } while (0)
typedef __attribute__((address_space(3))) unsigned lds_u32;
constexpr int STAGE_B = 65536;
template <int NI, class AF, class BF>
DI void gemm_main(f32x16 (&acc)[NI][4], const AF& af, const BF& bf, int nk, char* smem, const int tid) {
  const int lane = tid & 63, r = lane & 31, h = lane >> 5;
  const int w = __builtin_amdgcn_readfirstlane(tid >> 6);
  const int wm = w & 1, wn = w >> 1;
  int ao[4], bo[2 * NI];
  {
    const int rl = lane >> 3, kc = (lane & 7) ^ (((w & 1) * 4 + (lane >> 4)) & 7);
#pragma unroll
    for (int i = 0; i < 4; ++i) ao[i] = af.rowoff((w + 8 * i) * 8 + rl) + 8 * kc;
#pragma unroll
    for (int i = 0; i < 2 * NI; ++i) bo[i] = bf.rowoff((w + 8 * i) * 8 + rl) + 8 * kc;
  }
  auto stage = [&](int buf, int kt) {
    const int ka = af.koff(kt * 64), kb = bf.koff(kt * 64);
    char* sbase = smem + buf * STAGE_B + w * 1024;
#pragma unroll
    for (int i = 0; i < 4; ++i)
      __builtin_amdgcn_global_load_lds((const unsigned*)(af.base + (ao[i] + ka)), (lds_u32*)(sbase + i * 8192), 16, 0, 0);
#pragma unroll
    for (int i = 0; i < 2 * NI; ++i)
      __builtin_amdgcn_global_load_lds((const unsigned*)(bf.base + (bo[i] + kb)), (lds_u32*)(sbase + 32768 + i * 8192), 16, 0, 0);
  };
  const int xr = (r >> 1) & 7;
  const int arow = (wm * 128 + r) * 128, brow = 32768 + (wn * 32 * NI + r) * 128;
  WAIT_V(0);
  __syncthreads();
  stage(0, 0);
  WAIT_V(0);
  RAW_BARRIER();
#pragma unroll 1
  for (int kt = 0; kt < nk; ++kt) {
    if (kt + 1 < nk) stage((kt + 1) & 1, kt + 1);
    const char* sb = smem + (kt & 1) * STAGE_B;
#pragma unroll
    for (int ks = 0; ks < 4; ++ks) {
      const int off = ((2 * ks + h) ^ xr) * 16;
      bf16x8 wf[NI], xf[4];
#pragma unroll
      for (int i = 0; i < NI; ++i) wf[i] = *(const bf16x8*)(sb + brow + i * 4096 + off);
#pragma unroll
      for (int i = 0; i < 4; ++i) xf[i] = *(const bf16x8*)(sb + arow + i * 4096 + off);
#pragma unroll
      for (int mi = 0; mi < 4; ++mi)
#pragma unroll
        for (int ni = 0; ni < NI; ++ni) acc[ni][mi] = MFMA(wf[ni], xf[mi], acc[ni][mi]);
    }
    WAIT_V(0);
    RAW_BARRIER();
  }
}
template <int NI>
DI void acc_zero(f32x16 (&acc)[NI][4]) {
#pragma unroll
  for (int a = 0; a < NI; ++a)
#pragma unroll
    for (int b = 0; b < 4; ++b)
#pragma unroll
      for (int i = 0; i < 16; ++i) acc[a][b][i] = 0.f;
}
template <int NI, class EPI>
DI void gemm_epi(const f32x16 (&acc)[NI][4], int m0, int n0, const int tid_in, const EPI& epi) {
  int tid = tid_in;
  asm volatile("" : "+v"(tid));
  const int lane = tid & 63, w = tid >> 6, r = lane & 31, h = lane >> 5;
  const int wm = w & 1, wn = w >> 1;
#pragma unroll
  for (int mi = 0; mi < 4; ++mi)
#pragma unroll
    for (int ni = 0; ni < NI; ++ni)
#pragma unroll
      for (int g = 0; g < 4; ++g) {
        const int n = n0 + wn * 32 * NI + ni * 32 + 8 * g + 4 * h;
        const int m = m0 + wm * 128 + mi * 32 + r;
        epi(m, n, acc[ni][mi][4 * g], acc[ni][mi][4 * g + 1], acc[ni][mi][4 * g + 2], acc[ni][mi][4 * g + 3]);
      }
}
DI void gemm_epi_resid(const f32x16 (&acc)[2][4], int m0, int n0, const int tid_in, const float* hsrc, float* hdst, bfr* hb, float* rowss) {
  int tid = tid_in;
  asm volatile("" : "+v"(tid));
  const int lane = tid & 63, w = tid >> 6, r = lane & 31, h = lane >> 5;
  const int wm = w & 1, wn = w >> 1;
#pragma unroll
  for (int mi = 0; mi < 4; ++mi) {
    const int m = m0 + wm * 128 + mi * 32 + r;
    float ss = 0.f;
#pragma unroll
    for (int ni = 0; ni < 2; ++ni)
#pragma unroll
      for (int g = 0; g < 4; ++g) {
        const int n = n0 + wn * 64 + ni * 32 + 8 * g + 4 * h;
        const float4 xv = *(const float4*)(hsrc + (size_t)m * 2048 + n);
        const float a = xv.x + acc[ni][mi][4 * g], b = xv.y + acc[ni][mi][4 * g + 1], c = xv.z + acc[ni][mi][4 * g + 2], d = xv.w + acc[ni][mi][4 * g + 3];
        *(float4*)(hdst + (size_t)m * 2048 + n) = make_float4(a, b, c, d);
        st_bf4(hb + (size_t)m * 2048 + n, a, b, c, d);
        ss += a * a + b * b + c * c + d * d;
      }
    ss += __shfl_xor(ss, 32);
    if (h == 0) atomicAdd(rowss + m, ss);
  }
}
DI void map_tile32(int v, int& mt, int& nt) {
  const int xcd = v & 7, j = v >> 3;
  nt = j >> 2;
  mt = xcd * 4 + (j & 3);
}


using f32x4 = __attribute__((ext_vector_type(4))) float;
typedef __attribute__((address_space(3))) unsigned char lds_u8;
constexpr int HTB = 128 * 64 * 2;
DI int lds_byte8(int r, int c) { const int st = (r >> 4) * 2 + (c >> 5), rr = r & 15, cc = c & 31, ob = rr * 64 + cc * 2; return st * 1024 + (ob ^ (((ob >> 9) & 1) << 5)); }
DI void stage_rc8(int b, int& R, int& C) { const int st = b / 1024, sb = b % 1024, swz = sb ^ (((sb >> 9) & 1) << 5); R = (st >> 1) * 16 + swz / 64; C = (st & 1) * 32 + (swz % 64) / 2; }
DI int perm32(int rho) { const int n = rho >> 4, i = rho & 15; return 8 * (i >> 2) + 4 * n + (i & 3); }
DI bool unit_next(int i, int G, int bid, int nunits, int& pm, int& pn) {
  const int v = bid + i * G;
  if (v >= nunits) return false;
  const int xcd = v & 7, j = v >> 3;
  pn = j >> 2;
  pm = xcd * 4 + (j & 3);
  return true;
}
template <class Epi>
DI void gemm8_phase(char* smem, const bfr* A, const bfr* Bt, const int K, const int nunits, const int G, const int bid, const int tid, const Epi& E) {
  lds_u8* lds = (lds_u8*)smem;
  const int wid = __builtin_amdgcn_readfirstlane(tid >> 6), lane = tid & 63, wr = wid >> 2, wc = wid & 3, fr = lane & 15, fq = lane >> 4;
  const int nt = K / 64;
  unsigned voffA[2], voffB[2];
#pragma unroll
  for (int i = 0; i < 2; ++i) {
    int R, C;
    stage_rc8(tid * 16 + i * 8192, R, C);
    const int Rb = (R & ~31) + perm32(R & 31);
    voffA[i] = (unsigned)(R * K + C) * 2u;
    voffB[i] = (unsigned)(Rb * K + C) * 2u;
  }
  const size_t kstep = 128;
  const size_t hstep = (size_t)128 * K * 2;
  const size_t tstep = 2 * hstep;
  const unsigned ldsw = (unsigned)wid * 1024u;
  const int aoff = lds_byte8(wr * 64 + fr, fq * 8), boff = lds_byte8(wc * 32 + fr, fq * 8);
#define PG8_SA(b, h) (((b) * 2 + (h)) * HTB)
#define PG8_SB(b, h) ((4 + (b) * 2 + (h)) * HTB)
#define PG8_STAGE(bufoff, gbase, voff) do { _Pragma("unroll") for (int _i = 0; _i < 2; ++_i) \
    __builtin_amdgcn_global_load_lds((const unsigned*)((const char*)(gbase) + (voff)[_i]), (lds_u32*)(lds + (bufoff) + ldsw + _i * 8192), 16, 0, 0); } while (0)
#define PG8_LDA(dst, b, h) do { _Pragma("unroll") for (int m = 0; m < 4; ++m) _Pragma("unroll") for (int k = 0; k < 2; ++k) dst[m][k] = *(const __attribute__((address_space(3))) bf16x8*)(lds + PG8_SA(b, h) + aoff + m * 2048 + k * 1024); } while (0)
#define PG8_LDB(dst, b, h) do { _Pragma("unroll") for (int n = 0; n < 2; ++n) _Pragma("unroll") for (int k = 0; k < 2; ++k) dst[n][k] = *(const __attribute__((address_space(3))) bf16x8*)(lds + PG8_SB(b, h) + boff + n * 2048 + k * 1024); } while (0)
#define PG8_MMA(ai, bj, At, Bt_) do { __builtin_amdgcn_s_setprio(1); _Pragma("unroll") for (int m = 0; m < 4; ++m) _Pragma("unroll") for (int n = 0; n < 2; ++n) _Pragma("unroll") for (int k = 0; k < 2; ++k) \
    acc[ai][bj][m][n] = __builtin_amdgcn_mfma_f32_16x16x32_bf16(Bt_[n][k], At[m][k], acc[ai][bj][m][n], 0, 0, 0); __builtin_amdgcn_s_setprio(0); } while (0)
#define PG8_BAR __builtin_amdgcn_s_barrier()
#define PG8_SCHED __builtin_amdgcn_sched_barrier(0)
  int cpm, cpn, npm = 0, npn = 0, ui = 0;
  if (!unit_next(0, G, bid, nunits, cpm, cpn)) return;
  WAIT_V(0);
  __syncthreads();
  f32x4 acc[2][2][4][2];
#pragma unroll
  for (int a = 0; a < 2; ++a)
#pragma unroll
    for (int b = 0; b < 2; ++b)
#pragma unroll
      for (int m = 0; m < 4; ++m)
#pragma unroll
        for (int n = 0; n < 2; ++n) acc[a][b][m][n] = (f32x4){0.f, 0.f, 0.f, 0.f};
  bf16x8 At[4][2], B0[2][2], B1[2][2];
  const char* cA = (const char*)A + (size_t)cpm * tstep;
  const char* cB = (const char*)Bt + (size_t)cpn * tstep;
  PG8_STAGE(PG8_SB(0, 0), cB, voffB); PG8_STAGE(PG8_SA(0, 0), cA, voffA); PG8_STAGE(PG8_SB(0, 1), cB + hstep, voffB); PG8_STAGE(PG8_SA(0, 1), cA + hstep, voffA);
  if (wr == 1) PG8_BAR;
  WAIT_V(4); PG8_BAR;
  PG8_STAGE(PG8_SB(1, 0), cB + kstep, voffB); PG8_STAGE(PG8_SA(1, 0), cA + kstep, voffA); PG8_STAGE(PG8_SB(1, 1), cB + hstep + kstep, voffB);
  WAIT_V(6); PG8_BAR;
  for (;;) {
    const bool has_next = unit_next(ui + 1, G, bid, nunits, npm, npn);
    const char* nA = has_next ? (const char*)A + (size_t)npm * tstep : cA;
    const char* nB = has_next ? (const char*)Bt + (size_t)npn * tstep : cB;
#pragma unroll 1
    for (int t = 0; t < nt; t += 2) {
      const bool last = (t == nt - 2);
      const char* a1 = cA + (size_t)(t + 1) * kstep;
      const char* a2 = last ? nA : cA + (size_t)(t + 2) * kstep;
      const char* b2 = last ? nB : cB + (size_t)(t + 2) * kstep;
      const char* a3 = a2 + kstep;
      const char* b3 = b2 + kstep;
      PG8_LDB(B0, 0, 0); PG8_SCHED; PG8_LDA(At, 0, 0); PG8_STAGE(PG8_SA(1, 1), a1 + hstep, voffA);
      WAIT_L(8); PG8_BAR; WAIT_L(0); PG8_MMA(0, 0, At, B0); PG8_BAR; PG8_SCHED;
      PG8_LDB(B1, 0, 1); PG8_STAGE(PG8_SB(0, 0), b2, voffB);
      PG8_BAR; WAIT_L(0); PG8_MMA(0, 1, At, B1); PG8_BAR;
      PG8_LDA(At, 0, 1); PG8_STAGE(PG8_SA(0, 0), a2, voffA);
      PG8_BAR; WAIT_L(0); PG8_MMA(1, 0, At, B0); PG8_BAR; PG8_SCHED;
      PG8_STAGE(PG8_SB(0, 1), b2 + hstep, voffB);
      WAIT_V(6); PG8_BAR; PG8_MMA(1, 1, At, B1); PG8_BAR;
      PG8_LDB(B0, 1, 0); PG8_SCHED; PG8_LDA(At, 1, 0); PG8_STAGE(PG8_SA(0, 1), a2 + hstep, voffA);
      WAIT_L(8); PG8_BAR; WAIT_L(0); PG8_MMA(0, 0, At, B0); PG8_BAR; PG8_SCHED;
      PG8_LDB(B1, 1, 1); PG8_STAGE(PG8_SB(1, 0), b3, voffB);
      PG8_BAR; WAIT_L(0); PG8_MMA(0, 1, At, B1); PG8_BAR;
      PG8_LDA(At, 1, 1); PG8_STAGE(PG8_SA(1, 0), a3, voffA);
      PG8_BAR; WAIT_L(0); PG8_MMA(1, 0, At, B0); PG8_BAR; PG8_SCHED;
      PG8_STAGE(PG8_SB(1, 1), b3 + hstep, voffB);
      WAIT_V(6); PG8_BAR; PG8_MMA(1, 1, At, B1); PG8_BAR;
    }
    E(acc, cpm * 256, cpn * 256, wr, wc, fr, fq);
    if (!has_next) break;
#pragma unroll
    for (int a = 0; a < 2; ++a)
#pragma unroll
      for (int b = 0; b < 2; ++b)
#pragma unroll
        for (int m = 0; m < 4; ++m)
#pragma unroll
          for (int n = 0; n < 2; ++n) acc[a][b][m][n] = (f32x4){0.f, 0.f, 0.f, 0.f};
    cpm = npm; cpn = npn; cA = nA; cB = nB; ++ui;
  }
  WAIT_V(0);
  if (wr == 0) PG8_BAR;
  PG8_BAR;
#undef PG8_SA
#undef PG8_SB
#undef PG8_STAGE
#undef PG8_LDA
#undef PG8_LDB
#undef PG8_MMA
#undef PG8_BAR
#undef PG8_SCHED
}
template <class F>
DI void epi8_foreach(const f32x4 (&acc)[2][2][4][2], int m0, int n0, int wr, int wc, int fr, int fq, const F& f) {
#pragma unroll
  for (int ai = 0; ai < 2; ++ai)
#pragma unroll
    for (int m = 0; m < 4; ++m) {
      const int row = m0 + ai * 128 + wr * 64 + m * 16 + fr;
#pragma unroll
      for (int bj = 0; bj < 2; ++bj) f(row, n0 + bj * 128 + wc * 32 + 8 * fq, acc[ai][bj][m][0], acc[ai][bj][m][1]);
    }
}
DI void st_bf8(bfr* p, const f32x4& v0, const f32x4& v1) {
  u32x4 w;
  w[0] = pack2(v0[0], v0[1]); w[1] = pack2(v0[2], v0[3]); w[2] = pack2(v1[0], v1[1]); w[3] = pack2(v1[2], v1[3]);
  *(u32x4*)p = w;
}

DI void epi8_resid(const f32x4 (&acc)[2][2][4][2], int m0, int n0, int wr, int wc, int fr, int fq, const float* hsrc, float* hdst, bfr* hb, float* rowss) {
#pragma unroll
  for (int ai = 0; ai < 2; ++ai)
#pragma unroll
    for (int m = 0; m < 4; ++m) {
      const int row = m0 + ai * 128 + wr * 64 + m * 16 + fr;
      float ss = 0.f;
#pragma unroll
      for (int bj = 0; bj < 2; ++bj) {
        const int n = n0 + bj * 128 + wc * 32 + 8 * fq;
        const float* sp = hsrc + (size_t)row * 2048 + n;
        const f32x4 x0 = *(const f32x4*)sp, x1 = *(const f32x4*)(sp + 4);
        const f32x4 y0 = x0 + acc[ai][bj][m][0], y1 = x1 + acc[ai][bj][m][1];
        float* dp = hdst + (size_t)row * 2048 + n;
        *(f32x4*)dp = y0; *(f32x4*)(dp + 4) = y1;
        st_bf8(hb + (size_t)row * 2048 + n, y0, y1);
        ss += y0[0] * y0[0] + y0[1] * y0[1] + y0[2] * y0[2] + y0[3] * y0[3] + y1[0] * y1[0] + y1[1] * y1[1] + y1[2] * y1[2] + y1[3] * y1[3];
      }
      ss += __shfl_xor(ss, 16);
      ss += __shfl_xor(ss, 32);
      if (fq == 0) atomicAdd(rowss + row, ss);
    }
}
enum { MODE_WIN = 0, MODE_SEL = 1, MODE_X = 2, MODE_RET = 3 };
constexpr int KP = 136;

template <int MODE>
DI void attn_item(const Params& p, int item, char* smem, const int tid) {
  constexpr int VP = 136;
  bfr* Ks = (bfr*)smem;
  bfr* Vs = Ks + 64 * KP;
  const int w = tid >> 6, lane = tid & 63, r = lane & 31, h = lane >> 5;
  bfr* Qw = Vs + 64 * VP + w * 32 * KP;
  char* ws = p.ws;
  const bfr* z = (const bfr*)(ws + OFF_Z);

  int b, t0, tq0, jlo, jhi, head = 0, grp = 0, vh = 0;
  const bfr *qbase, *kbase, *vbase;
  int ldq, ldk;
  unsigned selm = 0, umask = 0xffffffffu;
  if (MODE == MODE_WIN) {
    const int tb = item >> 4, bg = item & 15;
    b = bg >> 2; grp = bg & 3; t0 = tb * 64; tq0 = t0 + 32 * (w >> 2); head = grp * 4 + (w & 3);
    qbase = z + (size_t)(b * SEQ + tq0) * ZS + ZC_Q + head * 128; ldq = ZS;
    kbase = z + (size_t)(b * SEQ) * ZS + ZC_KW + grp * 128;
    vbase = z + (size_t)(b * SEQ) * ZS + ZC_VW + grp * 128;
    ldk = ZS;
    jlo = (t0 - 511 > 0 ? t0 - 511 : 0) >> 6;
    jhi = tb;
  } else if (MODE == MODE_SEL) {
    const int tb = 31 - (item >> 4), bg = item & 15;
    b = bg >> 2; grp = bg & 3; t0 = tb * 64; tq0 = t0 + 32 * (w >> 2); head = grp * 4 + (w & 3);
    qbase = z + (size_t)(b * SEQ + tq0) * ZS + ZC_Q + head * 128; ldq = ZS;
    kbase = z + (size_t)(b * SEQ) * ZS + ZC_KS + grp * 128;
    vbase = z + (size_t)(b * SEQ) * ZS + ZC_VS + grp * 128;
    ldk = ZS;
    jlo = 0;
    jhi = tb;
    const unsigned* sm = (const unsigned*)(ws + OFF_SELM) + (b * 4 + grp) * SEQ;
    selm = sm[tq0 + r];
    unsigned u = sm[t0 + lane];
#pragma unroll
    for (int o = 32; o > 0; o >>= 1) u |= (unsigned)__shfl_xor((int)u, o);
    umask = (unsigned)__builtin_amdgcn_readfirstlane((int)u);
    umask &= (jhi >= 31) ? 0xffffffffu : ((1u << (jhi + 1)) - 1u);
  } else if (MODE == MODE_X) {
    const int tb = item >> 4, bh = item & 15;
    b = bh >> 2; head = bh & 3; t0 = tb * 256; tq0 = t0 + 32 * w;
    qbase = (const bfr*)(ws + OFF_QX) + (size_t)(b * SEQ + tq0) * 512 + head * 128; ldq = 512;
    kbase = (const bfr*)(ws + OFF_KX) + (size_t)(b * 256) * 512 + head * 128;
    vbase = (const bfr*)(ws + OFF_VX) + (size_t)(b * 256) * 512 + head * 128;
    ldk = 512;
    jlo = 0; jhi = 3;
  } else {
    const int tb = 7 - (item >> 6), rest = item & 63;
    b = rest >> 4; head = (rest >> 1) & 7; vh = rest & 1; t0 = tb * 256; tq0 = t0 + 32 * w;
    qbase = z + (size_t)(b * SEQ + tq0) * ZS + ZC_QR + head * 128; ldq = ZS;
    kbase = z + (size_t)(b * SEQ) * ZS + ZC_KR + head * 128;
    vbase = z + (size_t)(b * SEQ) * ZS + ZC_VR + head * 256 + vh * 128;
    ldk = ZS;
    jlo = 0; jhi = 4 * tb + 3;
  }
  const int tq = tq0 + r;

  f32x16 o[4];
#pragma unroll
  for (int dt = 0; dt < 4; ++dt)
#pragma unroll
    for (int i = 0; i < 16; ++i) o[dt][i] = 0.f;
  float m_run = -INFINITY, l_run = 0.f;
  float lg = 0.f;
  float rf[16];
  if (MODE == MODE_RET) {
    lg = log1pf(-exp2f(-5.f - (float)head)) * 1.4426950408889634f;
#pragma unroll
    for (int i = 0; i < 16; ++i) rf[i] = __builtin_amdgcn_exp2f(-lg * (float)crow(i, h));
  }

  u32x4 kreg[2], vreg[2];
  auto gload = [&](int j) {
    const int k0 = j * 64;
#pragma unroll
    for (int i = 0; i < 2; ++i) {
      const int c = tid + 512 * i, row = c >> 4, cc = c & 15;
      kreg[i] = *(const u32x4*)(kbase + (size_t)(k0 + row) * ldk + cc * 8);
      vreg[i] = *(const u32x4*)(vbase + (size_t)(k0 + row) * ldk + cc * 8);
    }
  };
  auto swrite = [&]() {
#pragma unroll
    for (int i = 0; i < 2; ++i) {
      const int c = tid + 512 * i, row = c >> 4, cc = c & 15;
      *(u32x4*)(Ks + row * KP + cc * 8) = kreg[i];
      *(u32x4*)(Vs + row * VP + cc * 8) = vreg[i];
    }
  };
  auto next_j = [&](int j) -> int {
    if (MODE == MODE_SEL) {
      const unsigned rem = (j >= 31) ? 0u : (umask & ~((2u << j) - 1u));
      return rem ? (__builtin_ctz(rem)) : 64;
    }
    return j + 1;
  };
  int j = jlo;
  if (MODE == MODE_SEL) j = __builtin_ctz(umask);
  gload(j);
  __syncthreads();
  {
    u32x4 qreg[8];
#pragma unroll
    for (int i = 0; i < 8; ++i) {
      const int c = lane + 64 * i, row = c >> 4, cc = c & 15;
      qreg[i] = *(const u32x4*)(qbase + (size_t)row * ldq + cc * 8);
    }
#pragma unroll
    for (int i = 0; i < 8; ++i) {
      const int c = lane + 64 * i, row = c >> 4, cc = c & 15;
      *(u32x4*)(Qw + row * KP + cc * 8) = qreg[i];
    }
  }
  const float csc = 0.08838834764831845f * 1.4426950408889634f;
  const int q4 = (lane & 15) >> 2, p4 = lane & 3, blk = (lane >> 4) & 1;
  bool first = true;
#pragma unroll 1
  while (j <= jhi) {
    if (!first) __syncthreads();
    first = false;
    swrite();
    __syncthreads();
    const int jn = next_j(j);
    if (jn <= jhi) gload(jn);
    const int k0 = j * 64;
    if (MODE == MODE_RET && k0 > tq0 + 31) { j = jn; continue; }
    bf16x8 pf[2][2];
    if (MODE == MODE_RET) {
#pragma unroll
      for (int sub = 0; sub < 2; ++sub) {
        f32x16 sx;
#pragma unroll
        for (int i = 0; i < 16; ++i) sx[i] = 0.f;
#pragma unroll
        for (int s = 0; s < 8; ++s) {
          const bf16x8 kf = *(const bf16x8*)(Ks + (32 * sub + r) * KP + 16 * s + 8 * h);
          const bf16x8 qf = *(const bf16x8*)(Qw + r * KP + 16 * s + 8 * h);
          sx = MFMA(kf, qf, sx);
        }
        {
          const int dq = tq - (k0 + 32 * sub);
          const float cf = __builtin_amdgcn_exp2f(lg * (float)dq);
#pragma unroll
          for (int i = 0; i < 16; ++i) sx[i] = (crow(i, h) <= dq) ? sx[i] * (cf * rf[i]) : 0.f;
        }
        pf[sub][0] = pack8(sx, 0);
        pf[sub][1] = pack8(sx, 1);
      }
    } else {
      f32x16 s0, s1;
#pragma unroll
      for (int i = 0; i < 16; ++i) { s0[i] = 0.f; s1[i] = 0.f; }
#pragma unroll
      for (int s = 0; s < 8; ++s) {
        const bf16x8 k0f = *(const bf16x8*)(Ks + r * KP + 16 * s + 8 * h);
        const bf16x8 k1f = *(const bf16x8*)(Ks + (32 + r) * KP + 16 * s + 8 * h);
        const bf16x8 qf = *(const bf16x8*)(Qw + r * KP + 16 * s + 8 * h);
        s0 = MFMA(k0f, qf, s0);
        s1 = MFMA(k1f, qf, s1);
      }
      bool need_mask = false;
      if (MODE == MODE_WIN) need_mask = (k0 + 63 > tq0) || (k0 < tq0 + 31 - 511);
      if (MODE == MODE_SEL) need_mask = (k0 + 63 > tq0);
      const bool lanesel = (MODE == MODE_SEL) ? ((selm >> j) & 1u) : true;
      float mx = -INFINITY;
      if (need_mask) {
#pragma unroll
        for (int i = 0; i < 16; ++i) {
          const int tk0 = k0 + crow(i, h), tk1 = tk0 + 32;
          bool ok0 = true, ok1 = true;
          if (MODE == MODE_WIN) { ok0 = (tk0 <= tq) && (tq - tk0 < 512); ok1 = (tk1 <= tq) && (tq - tk1 < 512); }
          if (MODE == MODE_SEL) { ok0 = lanesel && (tk0 <= tq); ok1 = lanesel && (tk1 <= tq); }
          s0[i] = ok0 ? s0[i] * csc : -INFINITY;
          s1[i] = ok1 ? s1[i] * csc : -INFINITY;
          mx = fmaxf(mx, fmaxf(s0[i], s1[i]));
        }
      } else {
#pragma unroll
        for (int i = 0; i < 16; ++i) {
          s0[i] = lanesel ? s0[i] * csc : -INFINITY;
          s1[i] = lanesel ? s1[i] * csc : -INFINITY;
          mx = fmaxf(mx, fmaxf(s0[i], s1[i]));
        }
      }
      mx = fmaxf(mx, __shfl_xor(mx, 32));
      const float mnew = fmaxf(m_run, mx);
      const float muse = (mnew == -INFINITY) ? 0.f : mnew;
      const float alpha = __builtin_amdgcn_exp2f(m_run - muse);
      float ls = 0.f;
#pragma unroll
      for (int i = 0; i < 16; ++i) {
        s0[i] = __builtin_amdgcn_exp2f(s0[i] - muse);
        s1[i] = __builtin_amdgcn_exp2f(s1[i] - muse);
        ls += s0[i] + s1[i];
      }
      ls += __shfl_xor(ls, 32);
      l_run = l_run * alpha + ls;
      m_run = mnew;
      if (__builtin_amdgcn_ballot_w64(alpha != 1.f) != 0) {
#pragma unroll
        for (int dt = 0; dt < 4; ++dt)
#pragma unroll
          for (int i = 0; i < 16; ++i) o[dt][i] *= alpha;
      }
      pf[0][0] = pack8(s0, 0); pf[0][1] = pack8(s0, 1);
      pf[1][0] = pack8(s1, 0); pf[1][1] = pack8(s1, 1);
    }
#pragma unroll
    for (int dt = 0; dt < 4; ++dt)
#pragma unroll
      for (int sub = 0; sub < 2; ++sub)
#pragma unroll
        for (int st = 0; st < 2; ++st) {
          const int key0 = 32 * sub + 16 * st + 4 * h;
          const bfr* vp = Vs + (key0 + q4) * VP + 32 * dt + 16 * blk + 4 * p4;
          const s16x4 lo = tr_read(vp);
          const s16x4 hi = tr_read(vp + 8 * VP);
          const bf16x8 vf = __builtin_shufflevector(lo, hi, 0, 1, 2, 3, 4, 5, 6, 7);
          o[dt] = MFMA(vf, pf[sub][st], o[dt]);
        }
    j = jn;
  }

  if (MODE == MODE_SEL && p.dbg) return;
  const size_t mrow = (size_t)(b * SEQ + tq);
  if (MODE == MODE_WIN || MODE == MODE_SEL) {
    const float inv = (l_run > 0.f) ? 1.f / l_run : 0.f;
    const float gate = bflo(z[mrow * ZS + ZC_GN + head * 3 + (MODE == MODE_WIN ? 2 : 1)]);
    bfr* orow = (bfr*)(ws + OFF_ONSA) + mrow * 2048 + head * 128;
    const float sc = inv * gate;
#pragma unroll
    for (int dt = 0; dt < 4; ++dt)
#pragma unroll
      for (int g = 0; g < 4; ++g) {
        bfr* dst = orow + 32 * dt + 8 * g + 4 * h;
        float a = o[dt][4 * g] * sc, bb = o[dt][4 * g + 1] * sc, c = o[dt][4 * g + 2] * sc, d = o[dt][4 * g + 3] * sc;
        if (MODE == MODE_SEL) {
          const uint2 old = *(const uint2*)dst;
          a += bflo(old.x); bb += bfhi(old.x); c += bflo(old.y); d += bfhi(old.y);
        }
        st_bf4(dst, a, bb, c, d);
      }
  } else if (MODE == MODE_X) {
    const float inv = 1.f / l_run;
    bfr* orow = (bfr*)(ws + OFF_OX) + mrow * 512 + head * 128;
#pragma unroll
    for (int dt = 0; dt < 4; ++dt)
#pragma unroll
      for (int g = 0; g < 4; ++g)
        st_bf4(orow + 32 * dt + 8 * g + 4 * h, o[dt][4 * g] * inv, o[dt][4 * g + 1] * inv, o[dt][4 * g + 2] * inv,
               o[dt][4 * g + 3] * inv);
  } else {
    float sm = 0.f, sq = 0.f;
#pragma unroll
    for (int dt = 0; dt < 4; ++dt)
#pragma unroll
      for (int i = 0; i < 16; ++i) { sm += o[dt][i]; sq += o[dt][i] * o[dt][i]; }
    sm += __shfl_xor(sm, 32);
    sq += __shfl_xor(sq, 32);
    if (h == 0) *(float2*)((float*)(ws + OFF_RSTAT) + ((mrow * 8 + head) * 2 + vh) * 2) = make_float2(sm, sq);
    bfr* orow = (bfr*)(ws + OFF_ORET) + mrow * 2048 + head * 256 + vh * 128;
#pragma unroll
    for (int dt = 0; dt < 4; ++dt)
#pragma unroll
      for (int g = 0; g < 4; ++g)
        st_bf4(orow + 32 * dt + 8 * g + 4 * h, o[dt][4 * g], o[dt][4 * g + 1], o[dt][4 * g + 2], o[dt][4 * g + 3]);
  }
}

DI void ret_finish_row(const Params& p, int row, const int t) {
  char* ws = p.ws;
  const bfr* z = (const bfr*)(ws + OFF_Z);
  const int col = t * 8, head = t >> 5;
  const float4 st = *(const float4*)((const float*)(ws + OFF_RSTAT) + ((size_t)row * 8 + head) * 4);
  const float mu = (st.x + st.z) * (1.f / 256.f);
  const float var = fmaxf((st.y + st.w) * (1.f / 256.f) - mu * mu, 0.f);
  const float rstd = rsqrtf(var + 1e-6f);
  bfr* op = (bfr*)(ws + OFF_ORET) + (size_t)row * 2048 + col;
  const u32x4 ov = *(const u32x4*)op;
  const u32x4 gv = *(const u32x4*)(z + (size_t)row * ZS + ZC_GR + col);
  const float4 w0 = *(const float4*)(p.gn_w + col), w1 = *(const float4*)(p.gn_w + col + 4);
  u32x4 res;
  res[0] = pack2((bflo(ov[0]) - mu) * rstd * w0.x * bflo(gv[0]), (bfhi(ov[0]) - mu) * rstd * w0.y * bfhi(gv[0]));
  res[1] = pack2((bflo(ov[1]) - mu) * rstd * w0.z * bflo(gv[1]), (bfhi(ov[1]) - mu) * rstd * w0.w * bfhi(gv[1]));
  res[2] = pack2((bflo(ov[2]) - mu) * rstd * w1.x * bflo(gv[2]), (bfhi(ov[2]) - mu) * rstd * w1.y * bfhi(gv[2]));
  res[3] = pack2((bflo(ov[3]) - mu) * rstd * w1.z * bflo(gv[3]), (bfhi(ov[3]) - mu) * rstd * w1.w * bfhi(gv[3]));
  *(u32x4*)op = res;
}

DI void cmp_item(const Params& p, int item, char* smem, const int tid) {
  bfr* Ks = (bfr*)smem;
  float* impw = (float*)(smem + 128 * KP * 2);
  const int w = tid >> 6, lane = tid & 63, r = lane & 31, h = lane >> 5;
  char* ws = p.ws;
  const bfr* z = (const bfr*)(ws + OFF_Z);
  const int tb = item >> 4, bg = item & 15, b = bg >> 2, grp = bg & 3;
  const int t0 = tb * 64, ti = 32 * (w >> 2) + r, tq = t0 + ti, hw = w & 3, head = grp * 4 + hw;
  const bfr* qrow = z + (size_t)(b * SEQ + tq) * ZS + ZC_Q + head * 128;
  const bfr* kc = (const bfr*)(ws + OFF_KCVC) + (size_t)((b * 4 + grp) * 128) * 128;
  const bfr* vc = kc + (size_t)2048 * 128;
  bf16x8 qf[8];
#pragma unroll
  for (int s = 0; s < 8; ++s) qf[s] = *(const bf16x8*)(qrow + 16 * s + 8 * h);
  u32x4 reg[4];
#pragma unroll
  for (int i = 0; i < 4; ++i) {
    const int c = tid + 512 * i, row = c >> 4, cc = c & 15;
    reg[i] = *(const u32x4*)(kc + row * 128 + cc * 8);
  }
  __syncthreads();
#pragma unroll
  for (int i = 0; i < 4; ++i) {
    const int c = tid + 512 * i, row = c >> 4, cc = c & 15;
    *(u32x4*)(Ks + row * KP + cc * 8) = reg[i];
  }
  __syncthreads();
  f32x16 s[4];
#pragma unroll
  for (int kt = 0; kt < 4; ++kt) {
#pragma unroll
    for (int i = 0; i < 16; ++i) s[kt][i] = 0.f;
#pragma unroll
    for (int ss = 0; ss < 8; ++ss) {
      const bf16x8 kf = *(const bf16x8*)(Ks + (32 * kt + r) * KP + 16 * ss + 8 * h);
      s[kt] = MFMA(kf, qf[ss], s[kt]);
    }
  }
  const float csc = 0.08838834764831845f * 1.4426950408889634f;
  float mx = -INFINITY;
#pragma unroll
  for (int kt = 0; kt < 4; ++kt)
#pragma unroll
    for (int i = 0; i < 16; ++i) {
      const int c = 32 * kt + crow(i, h);
      const bool ok = (c * 16 + 31 <= tq) && (c < 127);
      s[kt][i] = ok ? s[kt][i] * csc : -INFINITY;
      mx = fmaxf(mx, s[kt][i]);
    }
  mx = fmaxf(mx, __shfl_xor(mx, 32));
  const float muse = (mx == -INFINITY) ? 0.f : mx;
  float ls = 0.f;
#pragma unroll
  for (int kt = 0; kt < 4; ++kt)
#pragma unroll
    for (int i = 0; i < 16; ++i) {
      s[kt][i] = __builtin_amdgcn_exp2f(s[kt][i] - muse);
      ls += s[kt][i];
    }
  ls += __shfl_xor(ls, 32);
  const float inv = (ls > 0.f) ? 1.f / ls : 0.f;
#pragma unroll
  for (int kt = 0; kt < 4; ++kt)
#pragma unroll
    for (int i = 0; i < 16; ++i) s[kt][i] *= inv;
  float plast[16];
#pragma unroll
  for (int kt = 0; kt < 4; ++kt)
#pragma unroll
    for (int g = 0; g < 4; ++g) plast[kt * 4 + g] = __shfl_xor(s[kt][4 * g + 3], 32);
#pragma unroll
  for (int kt = 0; kt < 4; ++kt)
#pragma unroll
    for (int g = 0; g < 4; ++g) {
      const int slot = kt * 4 + g;
      const float sum4 = s[kt][4 * g] + s[kt][4 * g + 1] + s[kt][4 * g + 2] + s[kt][4 * g + 3];
      const float prevl = (slot > 0) ? plast[slot > 0 ? slot - 1 : 0] : 0.f;
      const float add = h ? plast[slot] : prevl;
      impw[(hw * 64 + ti) * 32 + 8 * kt + 2 * g + h] = sum4 + add;
    }
  bf16x8 pf[4][2];
#pragma unroll
  for (int kt = 0; kt < 4; ++kt) { pf[kt][0] = pack8(s[kt], 0); pf[kt][1] = pack8(s[kt], 1); }
#pragma unroll
  for (int i = 0; i < 4; ++i) {
    const int c = tid + 512 * i, row = c >> 4, cc = c & 15;
    reg[i] = *(const u32x4*)(vc + row * 128 + cc * 8);
  }
  __syncthreads();
#pragma unroll
  for (int i = 0; i < 4; ++i) {
    const int c = tid + 512 * i, row = c >> 4, cc = c & 15;
    *(u32x4*)(Ks + row * KP + cc * 8) = reg[i];
  }
  __syncthreads();
  f32x16 o[4];
#pragma unroll
  for (int dt = 0; dt < 4; ++dt)
#pragma unroll
    for (int i = 0; i < 16; ++i) o[dt][i] = 0.f;
  const int q4 = (lane & 15) >> 2, p4 = lane & 3, blk = (lane >> 4) & 1;
#pragma unroll
  for (int dt = 0; dt < 4; ++dt)
#pragma unroll
    for (int kt = 0; kt < 4; ++kt)
#pragma unroll
      for (int st = 0; st < 2; ++st) {
        const int key0 = 32 * kt + 16 * st + 4 * h;
        const bfr* vp = Ks + (key0 + q4) * KP + 32 * dt + 16 * blk + 4 * p4;
        const s16x4 lo = tr_read(vp);
        const s16x4 hi = tr_read(vp + 8 * KP);
        const bf16x8 vf = __builtin_shufflevector(lo, hi, 0, 1, 2, 3, 4, 5, 6, 7);
        o[dt] = MFMA(vf, pf[kt][st], o[dt]);
      }
  {
    const size_t mrow = (size_t)(b * SEQ + tq);
    const float gate = bflo(z[mrow * ZS + ZC_GN + head * 3 + 0]);
    bfr* orow = (bfr*)(ws + OFF_ONSA) + mrow * 2048 + head * 128;
#pragma unroll
    for (int dt = 0; dt < 4; ++dt)
#pragma unroll
      for (int g = 0; g < 4; ++g) {
        bfr* dst = orow + 32 * dt + 8 * g + 4 * h;
        const uint2 old = *(const uint2*)dst;
        st_bf4(dst, o[dt][4 * g] * gate + bflo(old.x), o[dt][4 * g + 1] * gate + bfhi(old.x),
               o[dt][4 * g + 2] * gate + bflo(old.y), o[dt][4 * g + 3] * gate + bfhi(old.y));
      }
  }
  {
    const int i = tid >> 3, jg = tid & 7;
    const int cur = (t0 + i) >> 6;
    float vm[4];
#pragma unroll
    for (int e = 0; e < 4; ++e) {
      const int jme = 4 * jg + e;
      const float a = impw[(0 * 64 + i) * 32 + jme] + impw[(1 * 64 + i) * 32 + jme] + impw[(2 * 64 + i) * 32 + jme] + impw[(3 * 64 + i) * 32 + jme];
      const bool forced = (jme == 0) || (jme == cur) || (jme == cur - 1);
      vm[e] = forced ? INFINITY : ((jme > cur) ? -INFINITY : a);
    }
#pragma unroll
    for (int e = 0; e < 4; ++e) impw[i * 32 + 4 * jg + e] = vm[e];
    __syncthreads();
    int rank[4] = {0, 0, 0, 0};
#pragma unroll 4
    for (int k = 0; k < 32; ++k) {
      const float vk = impw[i * 32 + k];
#pragma unroll
      for (int e = 0; e < 4; ++e) rank[e] += (vk > vm[e] || (vk == vm[e] && k < 4 * jg + e)) ? 1 : 0;
    }
    unsigned bits = 0;
#pragma unroll
    for (int e = 0; e < 4; ++e)
      if (rank[e] < 16 && 4 * jg + e <= cur) bits |= 1u << (4 * jg + e);
    bits |= (unsigned)__shfl_xor((int)bits, 1);
    bits |= (unsigned)__shfl_xor((int)bits, 2);
    bits |= (unsigned)__shfl_xor((int)bits, 4);
    if (jg == 0) ((unsigned*)(ws + OFF_SELM))[(b * 4 + grp) * SEQ + t0 + i] = bits;
  }
  __syncthreads();
}

DI int grab(unsigned* ctr, int* slot, const int tid) {
  __syncthreads();
  if (tid == 0) *slot = (int)atomicAdd(ctr, 1u);
  __syncthreads();
  return *slot;
}

DI void run_phase(const Params& p0, int ph, char* smem, int* slot, const int wave_s, const int rep) {
  char* ws = p0.ws;
  asm volatile("" : "+s"(ws));
  Params p = p0;
  p.ws = ws;
  p.dbg = rep;
  const int G = gridDim.x;
  int bid = blockIdx.x;
  int tid = wave_s * 64 + (int)__builtin_amdgcn_mbcnt_hi(~0u, __builtin_amdgcn_mbcnt_lo(~0u, 0u));
  asm volatile("" : "+s"(bid));
  asm volatile("" : "+v"(tid));
  bfr* z = (bfr*)(ws + OFF_Z);
  unsigned* ctr = (unsigned*)(ws + OFF_CTR) + rep * 8;
  switch (ph) {
    case 0: {
      if (bid == 0 && tid < 64) ((unsigned*)(ws + OFF_CTR))[tid] = 0u;
      for (int i = bid * NTHR + tid; i < 2 * NTOK; i += G * NTHR) ((float*)(ws + OFF_ROWSS))[i] = 0.f;
      int tot = 0;
      for (int j = 0; j < 12; ++j) tot += tjob_tiles(j);
      const int n_norm = 1024 + 128, n_rope = 256;
      tr_run(p, 0, bid, G, tot, (float*)smem, tid);
      for (int it = tot + bid; it < tot + n_norm + n_rope; it += G) {
        if (it < tot + n_norm) {
          const int row = (it - tot) * 8 + (tid >> 6);
          if (row < NTOK) rmsnorm_row(p.x + (size_t)row * 2048, p.attn_norm_w, (bfr*)(ws + OFF_N) + (size_t)row * 2048, nullptr, tid);
          else rmsnorm_row(p.mem + (size_t)(row - NTOK) * 2048, p.mem_norm_w, (bfr*)(ws + OFF_MN) + (size_t)(row - NTOK) * 2048, nullptr, tid);
        } else {
          const int e = (it - tot - n_norm) * 512 + tid;
          const int t = e >> 6, i = e & 63;
          const float ang = (float)t * ROPE_INV[i];
          const float kk = rintf(ang * 0.15915494309189535f);
          float rr = fmaf(-kk, 6.2831854820251465f, ang);
          rr = fmaf(-kk, -1.7484555e-7f, rr);
          const float fr = rr * 0.15915494309189535f;
          ((float2*)(ws + OFF_ROPE))[e] = make_float2(__builtin_amdgcn_cosf(fr), __builtin_amdgcn_sinf(fr));
        }
      }
    } break;
    case 1: {
      {
        bfr* zcb = (bfr*)(ws + OFF_ZC);
        const float2* rope = (const float2*)(ws + OFF_ROPE);
        auto epi4 = [&](int m, int n, float a, float b, float c, float d) {
          bfr* dst = z + (size_t)m * ZS + n;
          const int t = m & 2047;
          if (n >= ZC_KC && n < ZC_KS) {
            const float* pe = (n < ZC_VC) ? p.pe_k : p.pe_v;
            const int dd = n & 127;
            const float4 plo = *(const float4*)(pe + (t & 15) * 128 + dd);
            const float4 phi = *(const float4*)(pe + (16 + (t & 15)) * 128 + dd);
            st_bf4(zcb + (size_t)m * 2048 + (n - ZC_KC), a + plo.x, b + plo.y, c + plo.z, d + plo.w);
            st_bf4(zcb + (size_t)m * 2048 + 1024 + (n - ZC_KC), a + phi.x, b + phi.y, c + phi.z, d + phi.w);
          } else if (n >= ZC_QR && n < ZC_VR) {
            const int i0 = (n & 127) >> 1;
            const float2 c0 = rope[t * 64 + i0], c1 = rope[t * 64 + i0 + 1];
            float o0 = a * c0.x - b * c0.y, o1 = a * c0.y + b * c0.x;
            float o2 = c * c1.x - d * c1.y, o3 = c * c1.y + d * c1.x;
            if (n >= ZC_KR) { const float sc = 0.08838834764831845f; o0 *= sc; o1 *= sc; o2 *= sc; o3 *= sc; }
            st_bf4(dst, o0, o1, o2, o3);
          } else if (n >= ZC_GR && n < ZC_GA) {
            st_bf4(dst, a * sigmoidf_(a), b * sigmoidf_(b), c * sigmoidf_(c), d * sigmoidf_(d));
          } else {
            st_bf4(dst, sigmoidf_(a), sigmoidf_(b), sigmoidf_(c), sigmoidf_(d));
          }
        };
        gemm8_phase(smem, (const bfr*)(ws + OFF_N), (const bfr*)(ws + OFF_WINT), 2048, 32 * 61, G, bid, tid,
          [&](const f32x4 (&acc)[2][2][4][2], int m0, int n0, int wr, int wc, int fr, int fq) {
            epi8_foreach(acc, m0, n0, wr, wc, fr, fq, [&](int m, int n, const f32x4& v0, const f32x4& v1) {
              if (n >= ZS) return;
              const bool plain = (n < ZC_KC) || (n >= ZC_KS && n < ZC_QR) || (n >= ZC_VR && n < ZC_GR);
              if (plain) st_bf8(z + (size_t)m * ZS + n, v0, v1);
              else { epi4(m, n, v0[0], v0[1], v0[2], v0[3]); epi4(m, n + 4, v1[0], v1[1], v1[2], v1[3]); }
            });
          });
      }
      const int nt_main = 0;
      for (int v = bid; v < nt_main + 32; v += G) {
        if (false) {
        } else {
          f32x16 acc[1][4];
          acc_zero<1>(acc);
          const int u = v - nt_main, which = u >> 4, mt = (u & 15) >> 2, nt = u & 3;
          const int m0 = mt * 256, n0 = nt * 128;
          PlainPtr af{(const bfr*)(ws + OFF_MN) + (size_t)m0 * 2048, 2048};
          PlainPtr bf{(const bfr*)(ws + (which ? OFF_WVT : OFF_WKT)) + (size_t)n0 * 2048, 2048};
          gemm_main<1>(acc, af, bf, 32, smem, tid);
          bfr* dstb = (bfr*)(ws + (which ? OFF_VX : OFF_KX));
          gemm_epi<1>(acc, m0, n0, tid, [&](int m, int n, float a, float b, float c, float d) { st_bf4(dstb + (size_t)m * 512 + n, a, b, c, d); });
        }
      }
    } break;
    case 2: {
      for (int it = grab(ctr + 0, slot, tid); it < 64; it = grab(ctr + 0, slot, tid)) {
        const int which = it >> 5, mt = (it & 31) >> 2, nt = it & 3;
        const int m0 = mt * 256, n0 = nt * 256;
        f32x16 acc[2][4];
        acc_zero<2>(acc);
        struct GatherA {
          const bfr* base; int m0;
          DI int rowoff(int row) const {
            const int R = m0 + row;
            const int bb = R >> 9, g = (R >> 7) & 3;
            int c = R & 127; c = c > 126 ? 126 : c;
            return (bb * SEQ + c * 16) * 2048 + g * 128;
          }
          DI int koff(int kk) const { const int l = kk >> 7; return l * 2048 + ((l >> 4) << 10) + (kk & 127); }
        };
        GatherA af{(const bfr*)(ws + OFF_ZC) + which * 512, m0};
        PlainPtr bf{(const bfr*)(ws + OFF_W1T) + (size_t)which * 1024 * 4096 + (size_t)n0 * 4096, 4096};
        gemm_main<2>(acc, af, bf, 64, smem, tid);
        bfr* hid = (bfr*)(ws + OFF_HIDC) + (size_t)which * 2048 * 1024;
        gemm_epi<2>(acc, m0, n0, tid, [&](int m, int n, float a, float b, float c, float d) {
          st_bf4(hid + (size_t)m * 1024 + n, a * sigmoidf_(a), b * sigmoidf_(b), c * sigmoidf_(c), d * sigmoidf_(d));
        });
      }
      for (int it = grab(ctr + 1, slot, tid); it < 1024; it = grab(ctr + 1, slot, tid)) {
        if (it < 512) attn_item<MODE_RET>(p, it, smem, tid);
        else attn_item<MODE_WIN>(p, it - 512, smem, tid);
      }
    } break;
    case 3: {
      for (int it = bid; it < 16 + NTOK / 2; it += G) {
        if (it >= 16) { ret_finish_row(p, (it - 16) * 2 + (tid >> 8), tid & 255); continue; }
        const int which = it >> 3, mt = it & 7;
        const int m0 = mt * 256;
        f32x16 acc[1][4];
        acc_zero<1>(acc);
        PlainPtr af{(const bfr*)(ws + OFF_HIDC) + (size_t)which * 2048 * 1024 + (size_t)m0 * 1024, 1024};
        PlainPtr bf{(const bfr*)(ws + OFF_W2T) + (size_t)which * 128 * 1024, 1024};
        gemm_main<1>(acc, af, bf, 16, smem, tid);
        bfr* dstb = (bfr*)(ws + OFF_KCVC) + (size_t)which * 2048 * 128;
        gemm_epi<1>(acc, m0, 0, tid, [&](int m, int n, float a, float b, float c, float d) { st_bf4(dstb + (size_t)m * 128 + n, a, b, c, d); });
      }
    } break;
    case 4: {
      for (int it = bid; it < 512; it += G) cmp_item(p, it, smem, tid);
    } break;
    case 5: {
      for (int it = grab(ctr + 2, slot, tid); it < 512; it = grab(ctr + 2, slot, tid)) attn_item<MODE_SEL>(p, it, smem, tid);
    } break;
    case 6: {
      bfr* mg = (bfr*)(ws + OFF_MERGED);
      gemm8_phase(smem, (const bfr*)(ws + OFF_ONSA), (const bfr*)(ws + OFF_WAT), 2048, 32 * 8, G, bid, tid,
        [&](const f32x4 (&acc)[2][2][4][2], int m0, int n0, int wr, int wc, int fr, int fq) {
          epi8_foreach(acc, m0, n0, wr, wc, fr, fq, [&](int m, int n, const f32x4& v0, const f32x4& v1) {
            const u32x4 ga = *(const u32x4*)(z + (size_t)m * ZS + ZC_GA + n);
            f32x4 a0 = {bflo(ga[0]) * v0[0], bfhi(ga[0]) * v0[1], bflo(ga[1]) * v0[2], bfhi(ga[1]) * v0[3]};
            f32x4 a1 = {bflo(ga[2]) * v1[0], bfhi(ga[2]) * v1[1], bflo(ga[3]) * v1[2], bfhi(ga[3]) * v1[3]};
            st_bf8(mg + (size_t)m * 2048 + n, a0, a1);
          });
        });
      gemm8_phase(smem, (const bfr*)(ws + OFF_ORET), (const bfr*)(ws + OFF_WBT), 2048, 32 * 8, G, bid, tid,
        [&](const f32x4 (&acc)[2][2][4][2], int m0, int n0, int wr, int wc, int fr, int fq) {
          epi8_foreach(acc, m0, n0, wr, wc, fr, fq, [&](int m, int n, const f32x4& v0, const f32x4& v1) {
            const u32x4 gb = *(const u32x4*)(z + (size_t)m * ZS + ZC_GB + n);
            bfr* dst = mg + (size_t)m * 2048 + n;
            const u32x4 old = *(const u32x4*)dst;
            f32x4 a0 = {bflo(old[0]) + bflo(gb[0]) * v0[0], bfhi(old[0]) + bfhi(gb[0]) * v0[1], bflo(old[1]) + bflo(gb[1]) * v0[2], bfhi(old[1]) + bfhi(gb[1]) * v0[3]};
            f32x4 a1 = {bflo(old[2]) + bflo(gb[2]) * v1[0], bfhi(old[2]) + bfhi(gb[2]) * v1[1], bflo(old[3]) + bflo(gb[3]) * v1[2], bfhi(old[3]) + bfhi(gb[3]) * v1[3]};
            st_bf8(dst, a0, a1);
          });
        });
    } break;
    case 7: {
      gemm8_phase(smem, (const bfr*)(ws + OFF_MERGED), (const bfr*)(ws + OFF_WOUTT), 2048, 32 * 8, G, bid, tid,
        [&](const f32x4 (&acc)[2][2][4][2], int m0, int n0, int wr, int wc, int fr, int fq) {
          epi8_resid(acc, m0, n0, wr, wc, fr, fq, p.x, (float*)(ws + OFF_H), (bfr*)(ws + OFF_NX), (float*)(ws + OFF_ROWSS));
        });
    } break;
    case 8: case 12: break;
    case 9: {
      const int ng = (G > 128) ? 128 : G;
      if (G > 128) { if (bid >= 128) tr_run(p, 12, bid - 128, G - 128, tjob_tiles(12), (float*)smem, tid); }
      else tr_run(p, 12, bid, G, tjob_tiles(12), (float*)smem, tid);
      if (bid < ng)
      for (int v = bid; v < 32 * 4; v += ng) {
        int mt, nt;
        map_tile32(v, mt, nt);
        const int m0 = mt * 256, n0 = nt * 128;
        f32x16 acc[1][4];
        acc_zero<1>(acc);
        PlainPtr af{(const bfr*)(ws + OFF_NX) + (size_t)m0 * 2048, 2048};
        PlainPtr bf{(const bfr*)(ws + OFF_WQT) + (size_t)n0 * 2048, 2048};
        gemm_main<1>(acc, af, bf, 32, smem, tid);
        bfr* qx = (bfr*)(ws + OFF_QX);
        const float* rss = (const float*)(ws + OFF_ROWSS);
        gemm_epi<1>(acc, m0, n0, tid, [&](int m, int n, float a, float b, float c, float d) {
          const float rs = rsqrtf(rss[m] * (1.f / 2048.f) + 1e-6f);
          st_bf4(qx + (size_t)m * 512 + n, a * rs, b * rs, c * rs, d * rs);
        });
      }
    } break;
    case 10: {
      const int ng = (G > 128) ? 128 : G;
      if (G > 128) { if (bid >= 128) tr_run(p, 13, bid - 128, G - 128, tjob_tiles(13), (float*)smem, tid); }
      else tr_run(p, 13, bid, G, tjob_tiles(13), (float*)smem, tid);
      if (bid < ng)
        for (int it = bid; it < 128; it += ng) attn_item<MODE_X>(p, it, smem, tid);
    } break;
    case 11: {
      gemm8_phase(smem, (const bfr*)(ws + OFF_OX), (const bfr*)(ws + OFF_WOT), 512, 32 * 8, G, bid, tid,
        [&](const f32x4 (&acc)[2][2][4][2], int m0, int n0, int wr, int wc, int fr, int fq) {
          epi8_resid(acc, m0, n0, wr, wc, fr, fq, (const float*)(ws + OFF_H), (float*)(ws + OFF_H), (bfr*)(ws + OFF_NX), (float*)(ws + OFF_ROWSS) + NTOK);
        });
    } break;
    case 13: {
      bfr* hid = (bfr*)(ws + OFF_HID);
      const float* rss = (const float*)(ws + OFF_ROWSS) + NTOK;
      gemm8_phase(smem, (const bfr*)(ws + OFF_NX), (const bfr*)(ws + OFF_WUPT), 2048, 32 * 32, G, bid, tid,
        [&](const f32x4 (&acc)[2][2][4][2], int m0, int n0, int wr, int wc, int fr, int fq) {
          epi8_foreach(acc, m0, n0, wr, wc, fr, fq, [&](int m, int n, const f32x4& v0, const f32x4& v1) {
            const float rs = rsqrtf(rss[m] * (1.f / 2048.f) + 1e-6f);
            f32x4 a0, a1;
#pragma unroll
            for (int j = 0; j < 4; ++j) { const float t0 = fmaxf(v0[j], 0.f) * rs, t1 = fmaxf(v1[j], 0.f) * rs; a0[j] = t0 * t0; a1[j] = t1 * t1; }
            st_bf8(hid + (size_t)m * 8192 + n, a0, a1);
          });
        });
    } break;
    case 14: {
      const float* hbuf = (const float*)(ws + OFF_H);
      gemm8_phase(smem, (const bfr*)(ws + OFF_HID), (const bfr*)(ws + OFF_WDOWNT), 8192, 32 * 8, G, bid, tid,
        [&](const f32x4 (&acc)[2][2][4][2], int m0, int n0, int wr, int wc, int fr, int fq) {
          epi8_foreach(acc, m0, n0, wr, wc, fr, fq, [&](int m, int n, const f32x4& v0, const f32x4& v1) {
            const float* sp = hbuf + (size_t)m * 2048 + n;
            const f32x4 x0 = *(const f32x4*)sp, x1 = *(const f32x4*)(sp + 4);
            float* dp = p.out + (size_t)m * 2048 + n;
            *(f32x4*)dp = x0 + v0; *(f32x4*)(dp + 4) = x1 + v1;
          });
        });
    } break;
    case 15: {
      for (int it = bid; it < 1024; it += G) {
        const int row = it * 8 + (tid >> 6);
        rmsnorm_row(p.out + (size_t)row * 2048, p.final_norm_w, nullptr, p.out + (size_t)row * 2048, tid);
      }
    } break;
    default: break;
  }
}

__global__ void __launch_bounds__(512, 2) mega(Params p) {
  extern __shared__ __attribute__((aligned(1024))) char smem[];
  __shared__ int slot;
  cg::grid_group grid = cg::this_grid();
  const int wave_s = __builtin_amdgcn_readfirstlane((int)(threadIdx.x >> 6));
  for (int ph = p.ph_lo; ph < p.ph_hi; ++ph) {
    if (ph == 8 || ph == 12) continue;
    run_phase(p, ph, smem, &slot, wave_s, 0);
#ifdef PROBE_PH
    if (ph == PROBE_PH)
      for (int rep = 1; rep <= PROBE_N; ++rep) { grid.sync(); run_phase(p, ph, smem, &slot, wave_s, rep); }
#endif
    if (ph + 1 < p.ph_hi) grid.sync();
  }
}

extern "C" void kernel_launch(void* const* d_in, const int* in_sizes, int n_in, void* d_out, int out_size, void* d_ws,
                              size_t ws_size, hipStream_t stream) {
  static int grid_blocks = 0;
  if (!grid_blocks) {
    int dev = 0, cus = 0, per_cu = 0;
    (void)hipGetDevice(&dev);
    (void)hipDeviceGetAttribute(&cus, hipDeviceAttributeMultiprocessorCount, dev);
    (void)hipFuncSetAttribute((const void*)mega, hipFuncAttributeMaxDynamicSharedMemorySize, SMEM_BYTES);
    (void)hipOccupancyMaxActiveBlocksPerMultiprocessor(&per_cu, mega, NTHR, SMEM_BYTES);
    if (per_cu < 1) per_cu = 1;
    if (per_cu > 1) per_cu = 1;
    grid_blocks = cus * per_cu;
    grid_blocks &= ~7;
    if (ws_size < WS_END || n_in != 24) { fprintf(stderr, "kernel_launch: ws %zu < %zu or n_in %d\n", ws_size, (size_t)WS_END, n_in); grid_blocks = -1; }
  }
  if (grid_blocks < 0) return;
  Params p{};
  const float** pp = (const float**)&p;
  for (int i = 0; i < 24; ++i) pp[i] = (const float*)d_in[i];
  p.out = (float*)d_out;
  p.ws = (char*)d_ws;
#if ONE_LAUNCH
  p.ph_lo = 0; p.ph_hi = NPHASE;
  void* args[] = {&p};
  hipError_t e = hipLaunchCooperativeKernel((void*)mega, dim3(grid_blocks), dim3(NTHR), args, SMEM_BYTES, stream);
  if (e != hipSuccess) fprintf(stderr, "cooperative launch failed: %s (grid %d)\n", hipGetErrorString(e), grid_blocks);
#else
  for (int ph = 0; ph < NPHASE; ++ph) {
    p.ph_lo = ph; p.ph_hi = ph + 1;
    hipLaunchKernelGGL(mega, dim3(grid_blocks), dim3(NTHR), SMEM_BYTES, stream, p);
  }
#endif
}
```

```cpp
#include <hip/hip_runtime.h>
#include <hip/hip_cooperative_groups.h>
#include <cstdio>
namespace cg = cooperative_groups;

#ifndef ONE_LAUNCH
#define ONE_LAUNCH 1
#endif

#define DI __device__ __forceinline__
typedef unsigned short bfr;
using bf16x8 = __attribute__((ext_vector_type(8))) short;
using s16x4 = __attribute__((ext_vector_type(4))) short;
using f32x16 = __attribute__((ext_vector_type(16))) float;
using u32x4 = __attribute__((ext_vector_type(4))) unsigned;
#define MFMA(a, b, c) __builtin_amdgcn_mfma_f32_32x32x16_bf16((a), (b), (c), 0, 0, 0)

constexpr int DM = 2048, SEQ = 2048, NTOK = 8192;
constexpr int ZS = 15488;
constexpr int ZC_Q = 0, ZC_KC = 2048, ZC_VC = 2560, ZC_KS = 3072, ZC_VS = 3584, ZC_KW = 4096, ZC_VW = 4608,
              ZC_QR = 5120, ZC_KR = 6144, ZC_VR = 7168, ZC_GR = 9216, ZC_GA = 11264, ZC_GB = 13312, ZC_GN = 15360;
constexpr int NPHASE = 16;

constexpr int ZSP = 15616;
constexpr size_t SZ_WINT = (size_t)ZSP * 2048 * 2;
constexpr size_t SZ_ACT = (size_t)NTOK * 2048 * 2;
constexpr size_t OFF_WINT = 0;
constexpr size_t OFF_N = OFF_WINT + SZ_WINT;
constexpr size_t OFF_MERGED = OFF_WINT;
constexpr size_t OFF_ORET = OFF_N;
constexpr size_t OFF_WUPT = 0;
constexpr size_t OFF_WDOWNT = SZ_ACT;
constexpr size_t OFF_Z = OFF_N + SZ_ACT;
constexpr size_t SZ_Z = (size_t)NTOK * ZS * 2;
constexpr size_t OFF_HID = OFF_Z;
constexpr size_t OFF_H = OFF_Z + (size_t)NTOK * 8192 * 2;
constexpr size_t OFF_NX = OFF_H + (size_t)NTOK * 2048 * 4;
constexpr size_t OFF_QX = OFF_NX + SZ_ACT;
constexpr size_t OFF_OX = OFF_QX + (size_t)NTOK * 512 * 2;
static_assert(OFF_OX + (size_t)NTOK * 512 * 2 <= OFF_Z + SZ_Z, "alias overflow");
constexpr size_t OFF_ZC = OFF_Z + SZ_Z;
constexpr size_t OFF_MN = OFF_ZC + (size_t)NTOK * 2048 * 2;
constexpr size_t OFF_W1T = OFF_MN + (size_t)1024 * 2048 * 2;
constexpr size_t OFF_W2T = OFF_W1T + (size_t)2 * 1024 * 4096 * 2;
constexpr size_t OFF_WAT = OFF_W2T + (size_t)2 * 128 * 1024 * 2;
constexpr size_t OFF_WBT = OFF_WAT + (size_t)2048 * 2048 * 2;
constexpr size_t OFF_WOUTT = OFF_WBT + (size_t)2048 * 2048 * 2;
constexpr size_t OFF_WQT = OFF_WOUTT + (size_t)2048 * 2048 * 2;
constexpr size_t OFF_WKT = OFF_WQT + (size_t)512 * 2048 * 2;
constexpr size_t OFF_WVT = OFF_WKT + (size_t)512 * 2048 * 2;
constexpr size_t OFF_WOT = OFF_WVT + (size_t)512 * 2048 * 2;
constexpr size_t OFF_ROPE = OFF_WOT + (size_t)512 * 2048 * 2;
constexpr size_t OFF_HIDC = OFF_ROPE + (size_t)2048 * 64 * 8;
constexpr size_t OFF_KCVC = OFF_HIDC + (size_t)2 * 2048 * 1024 * 2;
constexpr size_t OFF_SELM = OFF_KCVC + (size_t)2 * 2048 * 128 * 2;
constexpr size_t OFF_ONSA = OFF_SELM + (size_t)16 * 2048 * 4;
constexpr size_t OFF_KX = OFF_ONSA + SZ_ACT;
constexpr size_t OFF_VX = OFF_KX + (size_t)1024 * 512 * 2;
constexpr size_t OFF_RSTAT = OFF_VX + (size_t)1024 * 512 * 2;
constexpr size_t OFF_CTR = OFF_RSTAT + (size_t)NTOK * 8 * 2 * 2 * 4;
constexpr size_t OFF_ROWSS = OFF_CTR + 256;
constexpr size_t WS_END = OFF_ROWSS + (size_t)2 * NTOK * 4;

struct Params {
  const float *x, *mem, *attn_norm_w, *w_in, *pe_k, *w1k, *w2k, *pe_v, *w1v, *w2v, *w_a, *gn_w, *w_b, *w_out, *x_norm_w,
      *mem_norm_w, *wq, *wk, *wv, *wo, *mlp_norm_w, *w_up, *w_down, *final_norm_w;
  float* out;
  char* ws;
  int ph_lo, ph_hi;
  int dbg, pad;
};

constexpr int NTHR = 512;
constexpr int SMEM_BYTES = 131072;
__device__ const float ROPE_INV[64] = {1.0f, 0.865964353f, 0.749894261f, 0.649381638f, 0.562341332f, 0.486967534f, 0.421696514f, 0.365174115f, 0.316227764f, 0.273841977f, 0.237137377f, 0.2053525f, 0.177827939f, 0.153992653f, 0.133352131f, 0.115478203f, 0.100000001f, 0.0865964293f, 0.0749894157f, 0.0649381652f, 0.0562341325f, 0.0486967526f, 0.0421696529f, 0.0365174115f, 0.0316227749f, 0.0273841973f, 0.0237137377f, 0.0205352511f, 0.0177827943f, 0.0153992651f, 0.0133352149f, 0.0115478206f, 0.00999999978f, 0.00865964312f, 0.00749894185f, 0.00649381615f, 0.00562341325f, 0.00486967526f, 0.00421696482f, 0.00365174119f, 0.00316227763f, 0.00273841969f, 0.00237137359f, 0.00205352483f, 0.00177827943f, 0.00153992651f, 0.00133352145f, 0.0011547819f, 0.00100000005f, 0.000865964335f, 0.000749894243f, 0.000649381662f, 0.000562341302f, 0.000486967532f, 0.000421696517f, 0.000365174143f, 0.000316227757f, 0.000273841957f, 0.00023713737f, 0.00020535251f, 0.00017782794f, 0.000153992645f, 0.00013335215f, 0.0001154782f};

DI unsigned pack2(float a, float b) {
  typedef float f2 __attribute__((ext_vector_type(2)));
  typedef __bf16 b2 __attribute__((ext_vector_type(2)));
  f2 v = {a, b};
  b2 r = __builtin_convertvector(v, b2);
  return __builtin_bit_cast(unsigned, r);
}
DI float bflo(unsigned u) { return __uint_as_float(u << 16); }
DI float bfhi(unsigned u) { return __uint_as_float(u & 0xffff0000u); }
DI void st_bf4(bfr* p, float a, float b, float c, float d) {
  uint2 v; v.x = pack2(a, b); v.y = pack2(c, d);
  *(uint2*)p = v;
}
DI float wave_sum(float v) {
#pragma unroll
  for (int o = 32; o > 0; o >>= 1) v += __shfl_xor(v, o);
  return v;
}
DI float sigmoidf_(float x) { return __builtin_amdgcn_rcpf(1.f + __expf(-x)); }
DI int crow(int i, int h) { return (i & 3) + 8 * (i >> 2) + 4 * h; }
DI bf16x8 pack8(const f32x16& x, int s) {
  unsigned a = pack2(x[8 * s], x[8 * s + 1]), b = pack2(x[8 * s + 2], x[8 * s + 3]), c = pack2(x[8 * s + 4], x[8 * s + 5]),
           d = pack2(x[8 * s + 6], x[8 * s + 7]);
  typedef unsigned u4 __attribute__((ext_vector_type(4)));
  u4 v = {a, b, c, d};
  return __builtin_bit_cast(bf16x8, v);
}
DI s16x4 tr_read(const bfr* p) {
  return __builtin_amdgcn_ds_read_tr16_b64_v4i16((__attribute__((address_space(3))) s16x4*)(p));
}

struct TJob { const float* src; bfr* dst; int K, N, ntn, perm; const float* kscale; };
DI TJob get_tjob(const Params& p, int j) {
  TJob t;
  char* ws = p.ws;
  switch (j) {
    case 0: t = {p.w_in, (bfr*)(ws + OFF_WINT), 2048, 15408, 122, 1, nullptr}; break;
    case 1: t = {p.wk, (bfr*)(ws + OFF_WKT), 2048, 512, 4, 0, nullptr}; break;
    case 2: t = {p.wv, (bfr*)(ws + OFF_WVT), 2048, 512, 4, 0, nullptr}; break;
    case 3: t = {p.w1k, (bfr*)(ws + OFF_W1T), 4096, 1024, 8, 0, nullptr}; break;
    case 4: t = {p.w1v, (bfr*)(ws + OFF_W1T) + (size_t)1024 * 4096, 4096, 1024, 8, 0, nullptr}; break;
    case 5: t = {p.w2k, (bfr*)(ws + OFF_W2T), 1024, 128, 1, 0, nullptr}; break;
    case 6: t = {p.w2v, (bfr*)(ws + OFF_W2T) + (size_t)128 * 1024, 1024, 128, 1, 0, nullptr}; break;
    case 7: t = {p.w_a, (bfr*)(ws + OFF_WAT), 2048, 2048, 16, 0, nullptr}; break;
    case 8: t = {p.w_b, (bfr*)(ws + OFF_WBT), 2048, 2048, 16, 0, nullptr}; break;
    case 9: t = {p.w_out, (bfr*)(ws + OFF_WOUTT), 2048, 2048, 16, 0, nullptr}; break;
    case 10: t = {p.wq, (bfr*)(ws + OFF_WQT), 2048, 512, 4, 0, p.x_norm_w}; break;
    case 11: t = {p.wo, (bfr*)(ws + OFF_WOT), 512, 2048, 16, 0, nullptr}; break;
    case 12: t = {p.w_up, (bfr*)(ws + OFF_WUPT), 2048, 8192, 64, 0, p.mlp_norm_w}; break;
    default: t = {p.w_down, (bfr*)(ws + OFF_WDOWNT), 8192, 2048, 16, 0, nullptr}; break;
  }
  return t;
}
DI int tjob_tiles(int j) {
  switch (j) {
    case 0: return 122 * 16;
    case 1: case 2: return 4 * 16;
    case 3: case 4: return 8 * 32;
    case 5: case 6: return 1 * 8;
    case 7: case 8: case 9: return 16 * 16;
    case 10: return 4 * 16;
    case 11: return 16 * 4;
    case 12: return 64 * 16;
    default: return 16 * 64;
  }
}
struct TrRegs { float4 v[8]; };
DI void tr_load(const TJob& t, int tile, TrRegs& rg, const int tid) {
  const int nkt = t.K >> 7;
  const int kt = tile % nkt, nt = tile / nkt;
  const int k0 = kt * 128, d0 = nt * 128;
  int scol0 = d0, nvalid = 128;
  if (t.perm) {
    if (d0 < 5120) scol0 = d0;
    else if (d0 < 15360) scol0 = d0 + 48;
    else { scol0 = d0 - 15360 + 5120; nvalid = (d0 == 15360) ? 48 : 0; }
  }
#pragma unroll
  for (int i = 0; i < 8; ++i) {
    const int row = i * 16 + (tid >> 5), col = (tid & 31) * 4;
    rg.v[i] = make_float4(0.f, 0.f, 0.f, 0.f);
    if (col < nvalid) rg.v[i] = *(const float4*)(t.src + (size_t)(k0 + row) * t.N + scol0 + col);
    if (t.kscale) { const float sc = t.kscale[k0 + row]; rg.v[i].x *= sc; rg.v[i].y *= sc; rg.v[i].z *= sc; rg.v[i].w *= sc; }
  }
}
DI void tr_to_lds(const TrRegs& rg, float* sm, const int tid) {
#pragma unroll
  for (int i = 0; i < 8; ++i) {
    const int row = i * 16 + (tid >> 5), col = (tid & 31) * 4;
    float* d = sm + row * 129 + col;
    d[0] = rg.v[i].x; d[1] = rg.v[i].y; d[2] = rg.v[i].z; d[3] = rg.v[i].w;
  }
}
DI void tr_store(const TJob& t, int tile, const float* sm, const int tid) {
  const int nkt = t.K >> 7;
  const int kt = tile % nkt, nt = tile / nkt;
  const int k0 = kt * 128, d0 = nt * 128;
  const int n = tid >> 2, kq = (tid & 3) * 8;
  bfr* drow = t.dst + (size_t)(d0 + n) * t.K + k0 + kq;
#pragma unroll
  for (int q = 0; q < 4; ++q) {
    const int kb = kq + 32 * q;
    const unsigned o0 = pack2(sm[(kb + 0) * 129 + n], sm[(kb + 1) * 129 + n]);
    const unsigned o1 = pack2(sm[(kb + 2) * 129 + n], sm[(kb + 3) * 129 + n]);
    const unsigned o2 = pack2(sm[(kb + 4) * 129 + n], sm[(kb + 5) * 129 + n]);
    const unsigned o3 = pack2(sm[(kb + 6) * 129 + n], sm[(kb + 7) * 129 + n]);
    *(uint4*)(drow + 32 * q) = make_uint4(o0, o1, o2, o3);
  }
}
DI void tr_decode(int it, int j_lo, int& j, int& rem) {
  j = j_lo; rem = it;
  while (rem >= tjob_tiles(j)) { rem -= tjob_tiles(j); ++j; }
}
DI void tr_run(const Params& p, int j_lo, int it0, int stride, int n_tiles, float* sm, const int tid) {
  if (it0 >= n_tiles) return;
  TrRegs rg;
  int j, rem;
  tr_decode(it0, j_lo, j, rem);
  TJob t = get_tjob(p, j);
  tr_load(t, rem, rg, tid);
  for (int it = it0; it < n_tiles; it += stride) {
    __syncthreads();
    tr_to_lds(rg, sm, tid);
    __syncthreads();
    const TJob tc = t;
    const int remc = rem;
    const int nx = it + stride;
    if (nx < n_tiles) {
      tr_decode(nx, j_lo, j, rem);
      t = get_tjob(p, j);
      tr_load(t, rem, rg, tid);
    }
    tr_store(tc, remc, sm, tid);
  }
  __syncthreads();
}

DI void rmsnorm_row(const float* xrow, const float* w, bfr* obf, float* of32, const int tid) {
  const int lane = tid & 63;
  float4 v[8];
  float ss = 0.f;
#pragma unroll
  for (int i = 0; i < 8; ++i) {
    v[i] = ((const float4*)xrow)[lane + 64 * i];
    ss += v[i].x * v[i].x + v[i].y * v[i].y + v[i].z * v[i].z + v[i].w * v[i].w;
  }
  ss = wave_sum(ss);
  const float rs = rsqrtf(ss * (1.f / 2048.f) + 1e-6f);
#pragma unroll
  for (int i = 0; i < 8; ++i) {
    const float4 ww = ((const float4*)w)[lane + 64 * i];
    const float a = v[i].x * rs * ww.x, b = v[i].y * rs * ww.y, c = v[i].z * rs * ww.z, d = v[i].w * rs * ww.w;
    if (obf) st_bf4(obf + (lane + 64 * i) * 4, a, b, c, d);
    else ((float4*)of32)[lane + 64 * i] = make_float4(a, b, c, d);
  }
}

struct PlainPtr {
  const bfr* base; int ld;
  DI int rowoff(int row) const { return row * ld; }
  DI int koff(int k0) const { return k0; }
};
#define WAIT_V(n) asm volatile("s_waitcnt vmcnt(%0)" ::"n"(n) : "memory")
#define WAIT_L(n) asm volatile("s_waitcnt lgkmcnt(%0)" ::"n"(n) : "memory")
#define RAW_BARRIER() do { WAIT_L(0); __builtin_amdgcn_s_barrier(); } while (0)
typedef __attribute__((address_space(3))) unsigned lds_u32;
constexpr int STAGE_B = 65536;
template <int NI, class AF, class BF>
DI void gemm_main(f32x16 (&acc)[NI][4], const AF& af, const BF& bf, int nk, char* smem, const int tid) {
  const int lane = tid & 63, r = lane & 31, h = lane >> 5;
  const int w = __builtin_amdgcn_readfirstlane(tid >> 6);
  const int wm = w & 1, wn = w >> 1;
  int ao[4], bo[2 * NI];
  {
    const int rl = lane >> 3, kc = (lane & 7) ^ (((w & 1) * 4 + (lane >> 4)) & 7);
#pragma unroll
    for (int i = 0; i < 4; ++i) ao[i] = af.rowoff((w + 8 * i) * 8 + rl) + 8 * kc;
#pragma unroll
    for (int i = 0; i < 2 * NI; ++i) bo[i] = bf.rowoff((w + 8 * i) * 8 + rl) + 8 * kc;
  }
  auto stage = [&](int buf, int kt) {
    const int ka = af.koff(kt * 64), kb = bf.koff(kt * 64);
    char* sbase = smem + buf * STAGE_B + w * 1024;
#pragma unroll
    for (int i = 0; i < 4; ++i)
      __builtin_amdgcn_global_load_lds((const unsigned*)(af.base + (ao[i] + ka)), (lds_u32*)(sbase + i * 8192), 16, 0, 0);
#pragma unroll
    for (int i = 0; i < 2 * NI; ++i)
      __builtin_amdgcn_global_load_lds((const unsigned*)(bf.base + (bo[i] + kb)), (lds_u32*)(sbase + 32768 + i * 8192), 16, 0, 0);
  };
  const int xr = (r >> 1) & 7;
  const int arow = (wm * 128 + r) * 128, brow = 32768 + (wn * 32 * NI + r) * 128;
  WAIT_V(0);
  __syncthreads();
  stage(0, 0);
  WAIT_V(0);
  RAW_BARRIER();
#pragma unroll 1
  for (int kt = 0; kt < nk; ++kt) {
    if (kt + 1 < nk) stage((kt + 1) & 1, kt + 1);
    const char* sb = smem + (kt & 1) * STAGE_B;
#pragma unroll
    for (int ks = 0; ks < 4; ++ks) {
      const int off = ((2 * ks + h) ^ xr) * 16;
      bf16x8 wf[NI], xf[4];
#pragma unroll
      for (int i = 0; i < NI; ++i) wf[i] = *(const bf16x8*)(sb + brow + i * 4096 + off);
#pragma unroll
      for (int i = 0; i < 4; ++i) xf[i] = *(const bf16x8*)(sb + arow + i * 4096 + off);
#pragma unroll
      for (int mi = 0; mi < 4; ++mi)
#pragma unroll
        for (int ni = 0; ni < NI; ++ni) acc[ni][mi] = MFMA(wf[ni], xf[mi], acc[ni][mi]);
    }
    WAIT_V(0);
    RAW_BARRIER();
  }
}
template <int NI>
DI void acc_zero(f32x16 (&acc)[NI][4]) {
#pragma unroll
  for (int a = 0; a < NI; ++a)
#pragma unroll
    for (int b = 0; b < 4; ++b)
#pragma unroll
      for (int i = 0; i < 16; ++i) acc[a][b][i] = 0.f;
}
template <int NI, class EPI>
DI void gemm_epi(const f32x16 (&acc)[NI][4], int m0, int n0, const int tid_in, const EPI& epi) {
  int tid = tid_in;
  asm volatile("" : "+v"(tid));
  const int lane = tid & 63, w = tid >> 6, r = lane & 31, h = lane >> 5;
  const int wm = w & 1, wn = w >> 1;
#pragma unroll
  for (int mi = 0; mi < 4; ++mi)
#pragma unroll
    for (int ni = 0; ni < NI; ++ni)
#pragma unroll
      for (int g = 0; g < 4; ++g) {
        const int n = n0 + wn * 32 * NI + ni * 32 + 8 * g + 4 * h;
        const int m = m0 + wm * 128 + mi * 32 + r;
        epi(m, n, acc[ni][mi][4 * g], acc[ni][mi][4 * g + 1], acc[ni][mi][4 * g + 2], acc[ni][mi][4 * g + 3]);
      }
}
DI void gemm_epi_resid(const f32x16 (&acc)[2][4], int m0, int n0, const int tid_in, const float* hsrc, float* hdst, bfr* hb, float* rowss) {
  int tid = tid_in;
  asm volatile("" : "+v"(tid));
  const int lane = tid & 63, w = tid >> 6, r = lane & 31, h = lane >> 5;
  const int wm = w & 1, wn = w >> 1;
#pragma unroll
  for (int mi = 0; mi < 4; ++mi) {
    const int m = m0 + wm * 128 + mi * 32 + r;
    float ss = 0.f;
#pragma unroll
    for (int ni = 0; ni < 2; ++ni)
#pragma unroll
      for (int g = 0; g < 4; ++g) {
        const int n = n0 + wn * 64 + ni * 32 + 8 * g + 4 * h;
        const float4 xv = *(const float4*)(hsrc + (size_t)m * 2048 + n);
        const float a = xv.x + acc[ni][mi][4 * g], b = xv.y + acc[ni][mi][4 * g + 1], c = xv.z + acc[ni][mi][4 * g + 2], d = xv.w + acc[ni][mi][4 * g + 3];
        *(float4*)(hdst + (size_t)m * 2048 + n) = make_float4(a, b, c, d);
        st_bf4(hb + (size_t)m * 2048 + n, a, b, c, d);
        ss += a * a + b * b + c * c + d * d;
      }
    ss += __shfl_xor(ss, 32);
    if (h == 0) atomicAdd(rowss + m, ss);
  }
}
DI void map_tile32(int v, int& mt, int& nt) {
  const int xcd = v & 7, j = v >> 3;
  nt = j >> 2;
  mt = xcd * 4 + (j & 3);
}


using f32x4 = __attribute__((ext_vector_type(4))) float;
typedef __attribute__((address_space(3))) unsigned char lds_u8;
constexpr int HTB = 128 * 64 * 2;
DI int lds_byte8(int r, int c) { const int st = (r >> 4) * 2 + (c >> 5), rr = r & 15, cc = c & 31, ob = rr * 64 + cc * 2; return st * 1024 + (ob ^ (((ob >> 9) & 1) << 5)); }
DI void stage_rc8(int b, int& R, int& C) { const int st = b / 1024, sb = b % 1024, swz = sb ^ (((sb >> 9) & 1) << 5); R = (st >> 1) * 16 + swz / 64; C = (st & 1) * 32 + (swz % 64) / 2; }
DI int perm32(int rho) { const int n = rho >> 4, i = rho & 15; return 8 * (i >> 2) + 4 * n + (i & 3); }
DI bool unit_next(int i, int G, int bid, int nunits, int& pm, int& pn) {
  const int v = bid + i * G;
  if (v >= nunits) return false;
  const int xcd = v & 7, j = v >> 3;
  pn = j >> 2;
  pm = xcd * 4 + (j & 3);
  return true;
}
template <class Epi>
DI void gemm8_phase(char* smem, const bfr* A, const bfr* Bt, const int K, const int nunits, const int G, const int bid, const int tid, const Epi& E) {
  lds_u8* lds = (lds_u8*)smem;
  const int wid = __builtin_amdgcn_readfirstlane(tid >> 6), lane = tid & 63, wr = wid >> 2, wc = wid & 3, fr = lane & 15, fq = lane >> 4;
  const int nt = K / 64;
  unsigned voffA[2], voffB[2];
#pragma unroll
  for (int i = 0; i < 2; ++i) {
    int R, C;
    stage_rc8(tid * 16 + i * 8192, R, C);
    const int Rb = (R & ~31) + perm32(R & 31);
    voffA[i] = (unsigned)(R * K + C) * 2u;
    voffB[i] = (unsigned)(Rb * K + C) * 2u;
  }
  const size_t kstep = 128;
  const size_t hstep = (size_t)128 * K * 2;
  const size_t tstep = 2 * hstep;
  const unsigned ldsw = (unsigned)wid * 1024u;
  const int aoff = lds_byte8(wr * 64 + fr, fq * 8), boff = lds_byte8(wc * 32 + fr, fq * 8);
#define PG8_SA(b, h) (((b) * 2 + (h)) * HTB)
#define PG8_SB(b, h) ((4 + (b) * 2 + (h)) * HTB)
#define PG8_STAGE(bufoff, gbase, voff) do { _Pragma("unroll") for (int _i = 0; _i < 2; ++_i) \
    __builtin_amdgcn_global_load_lds((const unsigned*)((const char*)(gbase) + (voff)[_i]), (lds_u32*)(lds + (bufoff) + ldsw + _i * 8192), 16, 0, 0); } while (0)
#define PG8_LDA(dst, b, h) do { _Pragma("unroll") for (int m = 0; m < 4; ++m) _Pragma("unroll") for (int k = 0; k < 2; ++k) dst[m][k] = *(const __attribute__((address_space(3))) bf16x8*)(lds + PG8_SA(b, h) + aoff + m * 2048 + k * 1024); } while (0)
#define PG8_LDB(dst, b, h) do { _Pragma("unroll") for (int n = 0; n < 2; ++n) _Pragma("unroll") for (int k = 0; k < 2; ++k) dst[n][k] = *(const __attribute__((address_space(3))) bf16x8*)(lds + PG8_SB(b, h) + boff + n * 2048 + k * 1024); } while (0)
#define PG8_MMA(ai, bj, At, Bt_) do { __builtin_amdgcn_s_setprio(1); _Pragma("unroll") for (int m = 0; m < 4; ++m) _Pragma("unroll") for (int n = 0; n < 2; ++n) _Pragma("unroll") for (int k = 0; k < 2; ++k) \
    acc[ai][bj][m][n] = __builtin_amdgcn_mfma_f32_16x16x32_bf16(Bt_[n][k], At[m][k], acc[ai][bj][m][n], 0, 0, 0); __builtin_amdgcn_s_setprio(0); } while (0)
#define PG8_BAR __builtin_amdgcn_s_barrier()
#define PG8_SCHED __builtin_amdgcn_sched_barrier(0)
  int cpm, cpn, npm = 0, npn = 0, ui = 0;
  if (!unit_next(0, G, bid, nunits, cpm, cpn)) return;
  WAIT_V(0);
  __syncthreads();
  f32x4 acc[2][2][4][2];
#pragma unroll
  for (int a = 0; a < 2; ++a)
#pragma unroll
    for (int b = 0; b < 2; ++b)
#pragma unroll
      for (int m = 0; m < 4; ++m)
#pragma unroll
        for (int n = 0; n < 2; ++n) acc[a][b][m][n] = (f32x4){0.f, 0.f, 0.f, 0.f};
  bf16x8 At[4][2], B0[2][2], B1[2][2];
  const char* cA = (const char*)A + (size_t)cpm * tstep;
  const char* cB = (const char*)Bt + (size_t)cpn * tstep;
  PG8_STAGE(PG8_SB(0, 0), cB, voffB); PG8_STAGE(PG8_SA(0, 0), cA, voffA); PG8_STAGE(PG8_SB(0, 1), cB + hstep, voffB); PG8_STAGE(PG8_SA(0, 1), cA + hstep, voffA);
  if (wr == 1) PG8_BAR;
  WAIT_V(4); PG8_BAR;
  PG8_STAGE(PG8_SB(1, 0), cB + kstep, voffB); PG8_STAGE(PG8_SA(1, 0), cA + kstep, voffA); PG8_STAGE(PG8_SB(1, 1), cB + hstep + kstep, voffB);
  WAIT_V(6); PG8_BAR;
  for (;;) {
    const bool has_next = unit_next(ui + 1, G, bid, nunits, npm, npn);
    const char* nA = has_next ? (const char*)A + (size_t)npm * tstep : cA;
    const char* nB = has_next ? (const char*)Bt + (size_t)npn * tstep : cB;
#pragma unroll 1
    for (int t = 0; t < nt; t += 2) {
      const bool last = (t == nt - 2);
      const char* a1 = cA + (size_t)(t + 1) * kstep;
      const char* a2 = last ? nA : cA + (size_t)(t + 2) * kstep;
      const char* b2 = last ? nB : cB + (size_t)(t + 2) * kstep;
      const char* a3 = a2 + kstep;
      const char* b3 = b2 + kstep;
      PG8_LDB(B0, 0, 0); PG8_SCHED; PG8_LDA(At, 0, 0); PG8_STAGE(PG8_SA(1, 1), a1 + hstep, voffA);
      WAIT_L(8); PG8_BAR; WAIT_L(0); PG8_MMA(0, 0, At, B0); PG8_BAR; PG8_SCHED;
      PG8_LDB(B1, 0, 1); PG8_STAGE(PG8_SB(0, 0), b2, voffB);
      PG8_BAR; WAIT_L(0); PG8_MMA(0, 1, At, B1); PG8_BAR;
      PG8_LDA(At, 0, 1); PG8_STAGE(PG8_SA(0, 0), a2, voffA);
      PG8_BAR; WAIT_L(0); PG8_MMA(1, 0, At, B0); PG8_BAR; PG8_SCHED;
      PG8_STAGE(PG8_SB(0, 1), b2 + hstep, voffB);
      WAIT_V(6); PG8_BAR; PG8_MMA(1, 1, At, B1); PG8_BAR;
      PG8_LDB(B0, 1, 0); PG8_SCHED; PG8_LDA(At, 1, 0); PG8_STAGE(PG8_SA(0, 1), a2 + hstep, voffA);
      WAIT_L(8); PG8_BAR; WAIT_L(0); PG8_MMA(0, 0, At, B0); PG8_BAR; PG8_SCHED;
      PG8_LDB(B1, 1, 1); PG8_STAGE(PG8_SB(1, 0), b3, voffB);
      PG8_BAR; WAIT_L(0); PG8_MMA(0, 1, At, B1); PG8_BAR;
      PG8_LDA(At, 1, 1); PG8_STAGE(PG8_SA(1, 0), a3, voffA);
      PG8_BAR; WAIT_L(0); PG8_MMA(1, 0, At, B0); PG8_BAR; PG8_SCHED;
      PG8_STAGE(PG8_SB(1, 1), b3 + hstep, voffB);
      WAIT_V(6); PG8_BAR; PG8_MMA(1, 1, At, B1); PG8_BAR;
    }
    E(acc, cpm * 256, cpn * 256, wr, wc, fr, fq);
    if (!has_next) break;
#pragma unroll
    for (int a = 0; a < 2; ++a)
#pragma unroll
      for (int b = 0; b < 2; ++b)
#pragma unroll
        for (int m = 0; m < 4; ++m)
#pragma unroll
          for (int n = 0; n < 2; ++n) acc[a][b][m][n] = (f32x4){0.f, 0.f, 0.f, 0.f};
    cpm = npm; cpn = npn; cA = nA; cB = nB; ++ui;
  }
  WAIT_V(0);
  if (wr == 0) PG8_BAR;
  PG8_BAR;
#undef PG8_SA
#undef PG8_SB
#undef PG8_STAGE
#undef PG8_LDA
#undef PG8_LDB
#undef PG8_MMA
#undef PG8_BAR
#undef PG8_SCHED
}
template <class F>
DI void epi8_foreach(const f32x4 (&acc)[2][2][4][2], int m0, int n0, int wr, int wc, int fr, int fq, const F& f) {
#pragma unroll
  for (int ai = 0; ai < 2; ++ai)
#pragma unroll
    for (int m = 0; m < 4; ++m) {
      const int row = m0 + ai * 128 + wr * 64 + m * 16 + fr;
#pragma unroll
      for (int bj = 0; bj < 2; ++bj) f(row, n0 + bj * 128 + wc * 32 + 8 * fq, acc[ai][bj][m][0], acc[ai][bj][m][1]);
    }
}
DI void st_bf8(bfr* p, const f32x4& v0, const f32x4& v1) {
  u32x4 w;
  w[0] = pack2(v0[0], v0[1]); w[1] = pack2(v0[2], v0[3]); w[2] = pack2(v1[0], v1[1]); w[3] = pack2(v1[2], v1[3]);
  *(u32x4*)p = w;
}

DI void epi8_resid(const f32x4 (&acc)[2][2][4][2], int m0, int n0, int wr, int wc, int fr, int fq, const float* hsrc, float* hdst, bfr* hb, float* rowss) {
#pragma unroll
  for (int ai = 0; ai < 2; ++ai)
#pragma unroll
    for (int m = 0; m < 4; ++m) {
      const int row = m0 + ai * 128 + wr * 64 + m * 16 + fr;
      float ss = 0.f;
#pragma unroll
      for (int bj = 0; bj < 2; ++bj) {
        const int n = n0 + bj * 128 + wc * 32 + 8 * fq;
        const float* sp = hsrc + (size_t)row * 2048 + n;
        const f32x4 x0 = *(const f32x4*)sp, x1 = *(const f32x4*)(sp + 4);
        const f32x4 y0 = x0 + acc[ai][bj][m][0], y1 = x1 + acc[ai][bj][m][1];
        float* dp = hdst + (size_t)row * 2048 + n;
        *(f32x4*)dp = y0; *(f32x4*)(dp + 4) = y1;
        st_bf8(hb + (size_t)row * 2048 + n, y0, y1);
        ss += y0[0] * y0[0] + y0[1] * y0[1] + y0[2] * y0[2] + y0[3] * y0[3] + y1[0] * y1[0] + y1[1] * y1[1] + y1[2] * y1[2] + y1[3] * y1[3];
      }
      ss += __shfl_xor(ss, 16);
      ss += __shfl_xor(ss, 32);
      if (fq == 0) atomicAdd(rowss + row, ss);
    }
}
enum { MODE_WIN = 0, MODE_SEL = 1, MODE_X = 2, MODE_RET = 3 };
constexpr int KP = 136;

template <int MODE>
DI void attn_item(const Params& p, int item, char* smem, const int tid) {
  constexpr int VP = 136;
  bfr* Ks = (bfr*)smem;
  bfr* Vs = Ks + 64 * KP;
  const int w = tid >> 6, lane = tid & 63, r = lane & 31, h = lane >> 5;
  bfr* Qw = Vs + 64 * VP + w * 32 * KP;
  char* ws = p.ws;
  const bfr* z = (const bfr*)(ws + OFF_Z);

  int b, t0, tq0, jlo, jhi, head = 0, grp = 0, vh = 0;
  const bfr *qbase, *kbase, *vbase;
  int ldq, ldk;
  unsigned selm = 0, umask = 0xffffffffu;
  if (MODE == MODE_WIN) {
    const int tb = item >> 4, bg = item & 15;
    b = bg >> 2; grp = bg & 3; t0 = tb * 64; tq0 = t0 + 32 * (w >> 2); head = grp * 4 + (w & 3);
    qbase = z + (size_t)(b * SEQ + tq0) * ZS + ZC_Q + head * 128; ldq = ZS;
    kbase = z + (size_t)(b * SEQ) * ZS + ZC_KW + grp * 128;
    vbase = z + (size_t)(b * SEQ) * ZS + ZC_VW + grp * 128;
    ldk = ZS;
    jlo = (t0 - 511 > 0 ? t0 - 511 : 0) >> 6;
    jhi = tb;
  } else if (MODE == MODE_SEL) {
    const int tb = 31 - (item >> 4), bg = item & 15;
    b = bg >> 2; grp = bg & 3; t0 = tb * 64; tq0 = t0 + 32 * (w >> 2); head = grp * 4 + (w & 3);
    qbase = z + (size_t)(b * SEQ + tq0) * ZS + ZC_Q + head * 128; ldq = ZS;
    kbase = z + (size_t)(b * SEQ) * ZS + ZC_KS + grp * 128;
    vbase = z + (size_t)(b * SEQ) * ZS + ZC_VS + grp * 128;
    ldk = ZS;
    jlo = 0;
    jhi = tb;
    const unsigned* sm = (const unsigned*)(ws + OFF_SELM) + (b * 4 + grp) * SEQ;
    selm = sm[tq0 + r];
    unsigned u = sm[t0 + lane];
#pragma unroll
    for (int o = 32; o > 0; o >>= 1) u |= (unsigned)__shfl_xor((int)u, o);
    umask = (unsigned)__builtin_amdgcn_readfirstlane((int)u);
    umask &= (jhi >= 31) ? 0xffffffffu : ((1u << (jhi + 1)) - 1u);
  } else if (MODE == MODE_X) {
    const int tb = item >> 4, bh = item & 15;
    b = bh >> 2; head = bh & 3; t0 = tb * 256; tq0 = t0 + 32 * w;
    qbase = (const bfr*)(ws + OFF_QX) + (size_t)(b * SEQ + tq0) * 512 + head * 128; ldq = 512;
    kbase = (const bfr*)(ws + OFF_KX) + (size_t)(b * 256) * 512 + head * 128;
    vbase = (const bfr*)(ws + OFF_VX) + (size_t)(b * 256) * 512 + head * 128;
    ldk = 512;
    jlo = 0; jhi = 3;
  } else {
    const int tb = 7 - (item >> 6), rest = item & 63;
    b = rest >> 4; head = (rest >> 1) & 7; vh = rest & 1; t0 = tb * 256; tq0 = t0 + 32 * w;
    qbase = z + (size_t)(b * SEQ + tq0) * ZS + ZC_QR + head * 128; ldq = ZS;
    kbase = z + (size_t)(b * SEQ) * ZS + ZC_KR + head * 128;
    vbase = z + (size_t)(b * SEQ) * ZS + ZC_VR + head * 256 + vh * 128;
    ldk = ZS;
    jlo = 0; jhi = 4 * tb + 3;
  }
  const int tq = tq0 + r;

  f32x16 o[4];
#pragma unroll
  for (int dt = 0; dt < 4; ++dt)
#pragma unroll
    for (int i = 0; i < 16; ++i) o[dt][i] = 0.f;
  float m_run = -INFINITY, l_run = 0.f;
  float lg = 0.f;
  float rf[16];
  if (MODE == MODE_RET) {
    lg = log1pf(-exp2f(-5.f - (float)head)) * 1.4426950408889634f;
#pragma unroll
    for (int i = 0; i < 16; ++i) rf[i] = __builtin_amdgcn_exp2f(-lg * (float)crow(i, h));
  }

  u32x4 kreg[2], vreg[2];
  auto gload = [&](int j) {
    const int k0 = j * 64;
#pragma unroll
    for (int i = 0; i < 2; ++i) {
      const int c = tid + 512 * i, row = c >> 4, cc = c & 15;
      kreg[i] = *(const u32x4*)(kbase + (size_t)(k0 + row) * ldk + cc * 8);
      vreg[i] = *(const u32x4*)(vbase + (size_t)(k0 + row) * ldk + cc * 8);
    }
  };
  auto swrite = [&]() {
#pragma unroll
    for (int i = 0; i < 2; ++i) {
      const int c = tid + 512 * i, row = c >> 4, cc = c & 15;
      *(u32x4*)(Ks + row * KP + cc * 8) = kreg[i];
      *(u32x4*)(Vs + row * VP + cc * 8) = vreg[i];
    }
  };
  auto next_j = [&](int j) -> int {
    if (MODE == MODE_SEL) {
      const unsigned rem = (j >= 31) ? 0u : (umask & ~((2u << j) - 1u));
      return rem ? (__builtin_ctz(rem)) : 64;
    }
    return j + 1;
  };
  int j = jlo;
  if (MODE == MODE_SEL) j = __builtin_ctz(umask);
  gload(j);
  __syncthreads();
  {
    u32x4 qreg[8];
#pragma unroll
    for (int i = 0; i < 8; ++i) {
      const int c = lane + 64 * i, row = c >> 4, cc = c & 15;
      qreg[i] = *(const u32x4*)(qbase + (size_t)row * ldq + cc * 8);
    }
#pragma unroll
    for (int i = 0; i < 8; ++i) {
      const int c = lane + 64 * i, row = c >> 4, cc = c & 15;
      *(u32x4*)(Qw + row * KP + cc * 8) = qreg[i];
    }
  }
  const float csc = 0.08838834764831845f * 1.4426950408889634f;
  const int q4 = (lane & 15) >> 2, p4 = lane & 3, blk = (lane >> 4) & 1;
  bool first = true;
#pragma unroll 1
  while (j <= jhi) {
    if (!first) __syncthreads();
    first = false;
    swrite();
    __syncthreads();
    const int jn = next_j(j);
    if (jn <= jhi) gload(jn);
    const int k0 = j * 64;
    if (MODE == MODE_RET && k0 > tq0 + 31) { j = jn; continue; }
    bf16x8 pf[2][2];
    if (MODE == MODE_RET) {
#pragma unroll
      for (int sub = 0; sub < 2; ++sub) {
        f32x16 sx;
#pragma unroll
        for (int i = 0; i < 16; ++i) sx[i] = 0.f;
#pragma unroll
        for (int s = 0; s < 8; ++s) {
          const bf16x8 kf = *(const bf16x8*)(Ks + (32 * sub + r) * KP + 16 * s + 8 * h);
          const bf16x8 qf = *(const bf16x8*)(Qw + r * KP + 16 * s + 8 * h);
          sx = MFMA(kf, qf, sx);
        }
        {
          const int dq = tq - (k0 + 32 * sub);
          const float cf = __builtin_amdgcn_exp2f(lg * (float)dq);
#pragma unroll
          for (int i = 0; i < 16; ++i) sx[i] = (crow(i, h) <= dq) ? sx[i] * (cf * rf[i]) : 0.f;
        }
        pf[sub][0] = pack8(sx, 0);
        pf[sub][1] = pack8(sx, 1);
      }
    } else {
      f32x16 s0, s1;
#pragma unroll
      for (int i = 0; i < 16; ++i) { s0[i] = 0.f; s1[i] = 0.f; }
#pragma unroll
      for (int s = 0; s < 8; ++s) {
        const bf16x8 k0f = *(const bf16x8*)(Ks + r * KP + 16 * s + 8 * h);
        const bf16x8 k1f = *(const bf16x8*)(Ks + (32 + r) * KP + 16 * s + 8 * h);
        const bf16x8 qf = *(const bf16x8*)(Qw + r * KP + 16 * s + 8 * h);
        s0 = MFMA(k0f, qf, s0);
        s1 = MFMA(k1f, qf, s1);
      }
      bool need_mask = false;
      if (MODE == MODE_WIN) need_mask = (k0 + 63 > tq0) || (k0 < tq0 + 31 - 511);
      if (MODE == MODE_SEL) need_mask = (k0 + 63 > tq0);
      const bool lanesel = (MODE == MODE_SEL) ? ((selm >> j) & 1u) : true;
      float mx = -INFINITY;
      if (need_mask) {
#pragma unroll
        for (int i = 0; i < 16; ++i) {
          const int tk0 = k0 + crow(i, h), tk1 = tk0 + 32;
          bool ok0 = true, ok1 = true;
          if (MODE == MODE_WIN) { ok0 = (tk0 <= tq) && (tq - tk0 < 512); ok1 = (tk1 <= tq) && (tq - tk1 < 512); }
          if (MODE == MODE_SEL) { ok0 = lanesel && (tk0 <= tq); ok1 = lanesel && (tk1 <= tq); }
          s0[i] = ok0 ? s0[i] * csc : -INFINITY;
          s1[i] = ok1 ? s1[i] * csc : -INFINITY;
          mx = fmaxf(mx, fmaxf(s0[i], s1[i]));
        }
      } else {
#pragma unroll
        for (int i = 0; i < 16; ++i) {
          s0[i] = lanesel ? s0[i] * csc : -INFINITY;
          s1[i] = lanesel ? s1[i] * csc : -INFINITY;
          mx = fmaxf(mx, fmaxf(s0[i], s1[i]));
        }
      }
      mx = fmaxf(mx, __shfl_xor(mx, 32));
      const float mnew = fmaxf(m_run, mx);
      const float muse = (mnew == -INFINITY) ? 0.f : mnew;
      const float alpha = __builtin_amdgcn_exp2f(m_run - muse);
      float ls = 0.f;
#pragma unroll
      for (int i = 0; i < 16; ++i) {
        s0[i] = __builtin_amdgcn_exp2f(s0[i] - muse);
        s1[i] = __builtin_amdgcn_exp2f(s1[i] - muse);
        ls += s0[i] + s1[i];
      }
      ls += __shfl_xor(ls, 32);
      l_run = l_run * alpha + ls;
      m_run = mnew;
      if (__builtin_amdgcn_ballot_w64(alpha != 1.f) != 0) {
#pragma unroll
        for (int dt = 0; dt < 4; ++dt)
#pragma unroll
          for (int i = 0; i < 16; ++i) o[dt][i] *= alpha;
      }
      pf[0][0] = pack8(s0, 0); pf[0][1] = pack8(s0, 1);
      pf[1][0] = pack8(s1, 0); pf[1][1] = pack8(s1, 1);
    }
#pragma unroll
    for (int dt = 0; dt < 4; ++dt)
#pragma unroll
      for (int sub = 0; sub < 2; ++sub)
#pragma unroll
        for (int st = 0; st < 2; ++st) {
          const int key0 = 32 * sub + 16 * st + 4 * h;
          const bfr* vp = Vs + (key0 + q4) * VP + 32 * dt + 16 * blk + 4 * p4;
          const s16x4 lo = tr_read(vp);
          const s16x4 hi = tr_read(vp + 8 * VP);
          const bf16x8 vf = __builtin_shufflevector(lo, hi, 0, 1, 2, 3, 4, 5, 6, 7);
          o[dt] = MFMA(vf, pf[sub][st], o[dt]);
        }
    j = jn;
  }

  if (MODE == MODE_SEL && p.dbg) return;
  const size_t mrow = (size_t)(b * SEQ + tq);
  if (MODE == MODE_WIN || MODE == MODE_SEL) {
    const float inv = (l_run > 0.f) ? 1.f / l_run : 0.f;
    const float gate = bflo(z[mrow * ZS + ZC_GN + head * 3 + (MODE == MODE_WIN ? 2 : 1)]);
    bfr* orow = (bfr*)(ws + OFF_ONSA) + mrow * 2048 + head * 128;
    const float sc = inv * gate;
#pragma unroll
    for (int dt = 0; dt < 4; ++dt)
#pragma unroll
      for (int g = 0; g < 4; ++g) {
        bfr* dst = orow + 32 * dt + 8 * g + 4 * h;
        float a = o[dt][4 * g] * sc, bb = o[dt][4 * g + 1] * sc, c = o[dt][4 * g + 2] * sc, d = o[dt][4 * g + 3] * sc;
        if (MODE == MODE_SEL) {
          const uint2 old = *(const uint2*)dst;
          a += bflo(old.x); bb += bfhi(old.x); c += bflo(old.y); d += bfhi(old.y);
        }
        st_bf4(dst, a, bb, c, d);
      }
  } else if (MODE == MODE_X) {
    const float inv = 1.f / l_run;
    bfr* orow = (bfr*)(ws + OFF_OX) + mrow * 512 + head * 128;
#pragma unroll
    for (int dt = 0; dt < 4; ++dt)
#pragma unroll
      for (int g = 0; g < 4; ++g)
        st_bf4(orow + 32 * dt + 8 * g + 4 * h, o[dt][4 * g] * inv, o[dt][4 * g + 1] * inv, o[dt][4 * g + 2] * inv,
               o[dt][4 * g + 3] * inv);
  } else {
    float sm = 0.f, sq = 0.f;
#pragma unroll
    for (int dt = 0; dt < 4; ++dt)
#pragma unroll
      for (int i = 0; i < 16; ++i) { sm += o[dt][i]; sq += o[dt][i] * o[dt][i]; }
    sm += __shfl_xor(sm, 32);
    sq += __shfl_xor(sq, 32);
    if (h == 0) *(float2*)((float*)(ws + OFF_RSTAT) + ((mrow * 8 + head) * 2 + vh) * 2) = make_float2(sm, sq);
    bfr* orow = (bfr*)(ws + OFF_ORET) + mrow * 2048 + head * 256 + vh * 128;
#pragma unroll
    for (int dt = 0; dt < 4; ++dt)
#pragma unroll
      for (int g = 0; g < 4; ++g)
        st_bf4(orow + 32 * dt + 8 * g + 4 * h, o[dt][4 * g], o[dt][4 * g + 1], o[dt][4 * g + 2], o[dt][4 * g + 3]);
  }
}

DI void ret_finish_row(const Params& p, int row, const int t) {
  char* ws = p.ws;
  const bfr* z = (const bfr*)(ws + OFF_Z);
  const int col = t * 8, head = t >> 5;
  const float4 st = *(const float4*)((const float*)(ws + OFF_RSTAT) + ((size_t)row * 8 + head) * 4);
  const float mu = (st.x + st.z) * (1.f / 256.f);
  const float var = fmaxf((st.y + st.w) * (1.f / 256.f) - mu * mu, 0.f);
  const float rstd = rsqrtf(var + 1e-6f);
  bfr* op = (bfr*)(ws + OFF_ORET) + (size_t)row * 2048 + col;
  const u32x4 ov = *(const u32x4*)op;
  const u32x4 gv = *(const u32x4*)(z + (size_t)row * ZS + ZC_GR + col);
  const float4 w0 = *(const float4*)(p.gn_w + col), w1 = *(const float4*)(p.gn_w + col + 4);
  u32x4 res;
  res[0] = pack2((bflo(ov[0]) - mu) * rstd * w0.x * bflo(gv[0]), (bfhi(ov[0]) - mu) * rstd * w0.y * bfhi(gv[0]));
  res[1] = pack2((bflo(ov[1]) - mu) * rstd * w0.z * bflo(gv[1]), (bfhi(ov[1]) - mu) * rstd * w0.w * bfhi(gv[1]));
  res[2] = pack2((bflo(ov[2]) - mu) * rstd * w1.x * bflo(gv[2]), (bfhi(ov[2]) - mu) * rstd * w1.y * bfhi(gv[2]));
  res[3] = pack2((bflo(ov[3]) - mu) * rstd * w1.z * bflo(gv[3]), (bfhi(ov[3]) - mu) * rstd * w1.w * bfhi(gv[3]));
  *(u32x4*)op = res;
}

DI void cmp_item(const Params& p, int item, char* smem, const int tid) {
  bfr* Ks = (bfr*)smem;
  float* impw = (float*)(smem + 128 * KP * 2);
  const int w = tid >> 6, lane = tid & 63, r = lane & 31, h = lane >> 5;
  char* ws = p.ws;
  const bfr* z = (const bfr*)(ws + OFF_Z);
  const int tb = item >> 4, bg = item & 15, b = bg >> 2, grp = bg & 3;
  const int t0 = tb * 64, ti = 32 * (w >> 2) + r, tq = t0 + ti, hw = w & 3, head = grp * 4 + hw;
  const bfr* qrow = z + (size_t)(b * SEQ + tq) * ZS + ZC_Q + head * 128;
  const bfr* kc = (const bfr*)(ws + OFF_KCVC) + (size_t)((b * 4 + grp) * 128) * 128;
  const bfr* vc = kc + (size_t)2048 * 128;
  bf16x8 qf[8];
#pragma unroll
  for (int s = 0; s < 8; ++s) qf[s] = *(const bf16x8*)(qrow + 16 * s + 8 * h);
  u32x4 reg[4];
#pragma unroll
  for (int i = 0; i < 4; ++i) {
    const int c = tid + 512 * i, row = c >> 4, cc = c & 15;
    reg[i] = *(const u32x4*)(kc + row * 128 + cc * 8);
  }
  __syncthreads();
#pragma unroll
  for (int i = 0; i < 4; ++i) {
    const int c = tid + 512 * i, row = c >> 4, cc = c & 15;
    *(u32x4*)(Ks + row * KP + cc * 8) = reg[i];
  }
  __syncthreads();
  f32x16 s[4];
#pragma unroll
  for (int kt = 0; kt < 4; ++kt) {
#pragma unroll
    for (int i = 0; i < 16; ++i) s[kt][i] = 0.f;
#pragma unroll
    for (int ss = 0; ss < 8; ++ss) {
      const bf16x8 kf = *(const bf16x8*)(Ks + (32 * kt + r) * KP + 16 * ss + 8 * h);
      s[kt] = MFMA(kf, qf[ss], s[kt]);
    }
  }
  const float csc = 0.08838834764831845f * 1.4426950408889634f;
  float mx = -INFINITY;
#pragma unroll
  for (int kt = 0; kt < 4; ++kt)
#pragma unroll
    for (int i = 0; i < 16; ++i) {
      const int c = 32 * kt + crow(i, h);
      const bool ok = (c * 16 + 31 <= tq) && (c < 127);
      s[kt][i] = ok ? s[kt][i] * csc : -INFINITY;
      mx = fmaxf(mx, s[kt][i]);
    }
  mx = fmaxf(mx, __shfl_xor(mx, 32));
  const float muse = (mx == -INFINITY) ? 0.f : mx;
  float ls = 0.f;
#pragma unroll
  for (int kt = 0; kt < 4; ++kt)
#pragma unroll
    for (int i = 0; i < 16; ++i) {
      s[kt][i] = __builtin_amdgcn_exp2f(s[kt][i] - muse);
      ls += s[kt][i];
    }
  ls += __shfl_xor(ls, 32);
  const float inv = (ls > 0.f) ? 1.f / ls : 0.f;
#pragma unroll
  for (int kt = 0; kt < 4; ++kt)
#pragma unroll
    for (int i = 0; i < 16; ++i) s[kt][i] *= inv;
  float plast[16];
#pragma unroll
  for (int kt = 0; kt < 4; ++kt)
#pragma unroll
    for (int g = 0; g < 4; ++g) plast[kt * 4 + g] = __shfl_xor(s[kt][4 * g + 3], 32);
#pragma unroll
  for (int kt = 0; kt < 4; ++kt)
#pragma unroll
    for (int g = 0; g < 4; ++g) {
      const int slot = kt * 4 + g;
      const float sum4 = s[kt][4 * g] + s[kt][4 * g + 1] + s[kt][4 * g + 2] + s[kt][4 * g + 3];
      const float prevl = (slot > 0) ? plast[slot > 0 ? slot - 1 : 0] : 0.f;
      const float add = h ? plast[slot] : prevl;
      impw[(hw * 64 + ti) * 32 + 8 * kt + 2 * g + h] = sum4 + add;
    }
  bf16x8 pf[4][2];
#pragma unroll
  for (int kt = 0; kt < 4; ++kt) { pf[kt][0] = pack8(s[kt], 0); pf[kt][1] = pack8(s[kt], 1); }
#pragma unroll
  for (int i = 0; i < 4; ++i) {
    const int c = tid + 512 * i, row = c >> 4, cc = c & 15;
    reg[i] = *(const u32x4*)(vc + row * 128 + cc * 8);
  }
  __syncthreads();
#pragma unroll
  for (int i = 0; i < 4; ++i) {
    const int c = tid + 512 * i, row = c >> 4, cc = c & 15;
    *(u32x4*)(Ks + row * KP + cc * 8) = reg[i];
  }
  __syncthreads();
  f32x16 o[4];
#pragma unroll
  for (int dt = 0; dt < 4; ++dt)
#pragma unroll
    for (int i = 0; i < 16; ++i) o[dt][i] = 0.f;
  const int q4 = (lane & 15) >> 2, p4 = lane & 3, blk = (lane >> 4) & 1;
#pragma unroll
  for (int dt = 0; dt < 4; ++dt)
#pragma unroll
    for (int kt = 0; kt < 4; ++kt)
#pragma unroll
      for (int st = 0; st < 2; ++st) {
        const int key0 = 32 * kt + 16 * st + 4 * h;
        const bfr* vp = Ks + (key0 + q4) * KP + 32 * dt + 16 * blk + 4 * p4;
        const s16x4 lo = tr_read(vp);
        const s16x4 hi = tr_read(vp + 8 * KP);
        const bf16x8 vf = __builtin_shufflevector(lo, hi, 0, 1, 2, 3, 4, 5, 6, 7);
        o[dt] = MFMA(vf, pf[kt][st], o[dt]);
      }
  {
    const size_t mrow = (size_t)(b * SEQ + tq);
    const float gate = bflo(z[mrow * ZS + ZC_GN + head * 3 + 0]);
    bfr* orow = (bfr*)(ws + OFF_ONSA) + mrow * 2048 + head * 128;
#pragma unroll
    for (int dt = 0; dt < 4; ++dt)
#pragma unroll
      for (int g = 0; g < 4; ++g) {
        bfr* dst = orow + 32 * dt + 8 * g + 4 * h;
        const uint2 old = *(const uint2*)dst;
        st_bf4(dst, o[dt][4 * g] * gate + bflo(old.x), o[dt][4 * g + 1] * gate + bfhi(old.x),
               o[dt][4 * g + 2] * gate + bflo(old.y), o[dt][4 * g + 3] * gate + bfhi(old.y));
      }
  }
  {
    const int i = tid >> 3, jg = tid & 7;
    const int cur = (t0 + i) >> 6;
    float vm[4];
#pragma unroll
    for (int e = 0; e < 4; ++e) {
      const int jme = 4 * jg + e;
      const float a = impw[(0 * 64 + i) * 32 + jme] + impw[(1 * 64 + i) * 32 + jme] + impw[(2 * 64 + i) * 32 + jme] + impw[(3 * 64 + i) * 32 + jme];
      const bool forced = (jme == 0) || (jme == cur) || (jme == cur - 1);
      vm[e] = forced ? INFINITY : ((jme > cur) ? -INFINITY : a);
    }
#pragma unroll
    for (int e = 0; e < 4; ++e) impw[i * 32 + 4 * jg + e] = vm[e];
    __syncthreads();
    int rank[4] = {0, 0, 0, 0};
#pragma unroll 4
    for (int k = 0; k < 32; ++k) {
      const float vk = impw[i * 32 + k];
#pragma unroll
      for (int e = 0; e < 4; ++e) rank[e] += (vk > vm[e] || (vk == vm[e] && k < 4 * jg + e)) ? 1 : 0;
    }
    unsigned bits = 0;
#pragma unroll
    for (int e = 0; e < 4; ++e)
      if (rank[e] < 16 && 4 * jg + e <= cur) bits |= 1u << (4 * jg + e);
    bits |= (unsigned)__shfl_xor((int)bits, 1);
    bits |= (unsigned)__shfl_xor((int)bits, 2);
    bits |= (unsigned)__shfl_xor((int)bits, 4);
    if (jg == 0) ((unsigned*)(ws + OFF_SELM))[(b * 4 + grp) * SEQ + t0 + i] = bits;
  }
  __syncthreads();
}

DI int grab(unsigned* ctr, int* slot, const int tid) {
  __syncthreads();
  if (tid == 0) *slot = (int)atomicAdd(ctr, 1u);
  __syncthreads();
  return *slot;
}

DI void run_phase(const Params& p0, int ph, char* smem, int* slot, const int wave_s, const int rep) {
  char* ws = p0.ws;
  asm volatile("" : "+s"(ws));
  Params p = p0;
  p.ws = ws;
  p.dbg = rep;
  const int G = gridDim.x;
  int bid = blockIdx.x;
  int tid = wave_s * 64 + (int)__builtin_amdgcn_mbcnt_hi(~0u, __builtin_amdgcn_mbcnt_lo(~0u, 0u));
  asm volatile("" : "+s"(bid));
  asm volatile("" : "+v"(tid));
  bfr* z = (bfr*)(ws + OFF_Z);
  unsigned* ctr = (unsigned*)(ws + OFF_CTR) + rep * 8;
  switch (ph) {
    case 0: {
      if (bid == 0 && tid < 64) ((unsigned*)(ws + OFF_CTR))[tid] = 0u;
      for (int i = bid * NTHR + tid; i < 2 * NTOK; i += G * NTHR) ((float*)(ws + OFF_ROWSS))[i] = 0.f;
      int tot = 0;
      for (int j = 0; j < 3; ++j) tot += tjob_tiles(j);
      const int n_norm = 1024 + 128, n_rope = 256;
      tr_run(p, 0, bid, G, tot, (float*)smem, tid);
      for (int it = tot + bid; it < tot + n_norm + n_rope; it += G) {
        if (it < tot + n_norm) {
          const int row = (it - tot) * 8 + (tid >> 6);
          if (row < NTOK) rmsnorm_row(p.x + (size_t)row * 2048, p.attn_norm_w, (bfr*)(ws + OFF_N) + (size_t)row * 2048, nullptr, tid);
          else rmsnorm_row(p.mem + (size_t)(row - NTOK) * 2048, p.mem_norm_w, (bfr*)(ws + OFF_MN) + (size_t)(row - NTOK) * 2048, nullptr, tid);
        } else {
          const int e = (it - tot - n_norm) * 512 + tid;
          const int t = e >> 6, i = e & 63;
          const float ang = (float)t * ROPE_INV[i];
          const float kk = rintf(ang * 0.15915494309189535f);
          float rr = fmaf(-kk, 6.2831854820251465f, ang);
          rr = fmaf(-kk, -1.7484555e-7f, rr);
          const float fr = rr * 0.15915494309189535f;
          ((float2*)(ws + OFF_ROPE))[e] = make_float2(__builtin_amdgcn_cosf(fr), __builtin_amdgcn_sinf(fr));
        }
      }
    } break;
    case 1: {
      {
        bfr* zcb = (bfr*)(ws + OFF_ZC);
        const float2* rope = (const float2*)(ws + OFF_ROPE);
        auto epi4 = [&](int m, int n, float a, float b, float c, float d) {
          bfr* dst = z + (size_t)m * ZS + n;
          const int t = m & 2047;
          if (n >= ZC_KC && n < ZC_KS) {
            const float* pe = (n < ZC_VC) ? p.pe_k : p.pe_v;
            const int dd = n & 127;
            const float4 plo = *(const float4*)(pe + (t & 15) * 128 + dd);
            const float4 phi = *(const float4*)(pe + (16 + (t & 15)) * 128 + dd);
            st_bf4(zcb + (size_t)m * 2048 + (n - ZC_KC), a + plo.x, b + plo.y, c + plo.z, d + plo.w);
            st_bf4(zcb + (size_t)m * 2048 + 1024 + (n - ZC_KC), a + phi.x, b + phi.y, c + phi.z, d + phi.w);
          } else if (n >= ZC_QR && n < ZC_VR) {
            const int i0 = (n & 127) >> 1;
            const float2 c0 = rope[t * 64 + i0], c1 = rope[t * 64 + i0 + 1];
            float o0 = a * c0.x - b * c0.y, o1 = a * c0.y + b * c0.x;
            float o2 = c * c1.x - d * c1.y, o3 = c * c1.y + d * c1.x;
            if (n >= ZC_KR) { const float sc = 0.08838834764831845f; o0 *= sc; o1 *= sc; o2 *= sc; o3 *= sc; }
            st_bf4(dst, o0, o1, o2, o3);
          } else if (n >= ZC_GR && n < ZC_GA) {
            st_bf4(dst, a * sigmoidf_(a), b * sigmoidf_(b), c * sigmoidf_(c), d * sigmoidf_(d));
          } else {
            st_bf4(dst, sigmoidf_(a), sigmoidf_(b), sigmoidf_(c), sigmoidf_(d));
          }
        };
        gemm8_phase(smem, (const bfr*)(ws + OFF_N), (const bfr*)(ws + OFF_WINT), 2048, 32 * 61, G, bid, tid,
          [&](const f32x4 (&acc)[2][2][4][2], int m0, int n0, int wr, int wc, int fr, int fq) {
            epi8_foreach(acc, m0, n0, wr, wc, fr, fq, [&](int m, int n, const f32x4& v0, const f32x4& v1) {
              if (n >= ZS) return;
              const bool plain = (n < ZC_KC) || (n >= ZC_KS && n < ZC_QR) || (n >= ZC_VR && n < ZC_GR);
              if (plain) st_bf8(z + (size_t)m * ZS + n, v0, v1);
              else { epi4(m, n, v0[0], v0[1], v0[2], v0[3]); epi4(m, n + 4, v1[0], v1[1], v1[2], v1[3]); }
            });
          });
      }
      {
        const int nunits = 32 * 61;
        const int nlong = (nunits % G == 0) ? 0 : nunits % G;
        const int nshort = G - nlong;
        const int sb_ = bid - nlong;
        if (sb_ >= 0) {
          for (int u = sb_; u < 32; u += nshort) {
            f32x16 acc[1][4];
            acc_zero<1>(acc);
            const int which = u >> 4, mt = (u & 15) >> 2, nt = u & 3;
            const int m0 = mt * 256, n0 = nt * 128;
            PlainPtr af{(const bfr*)(ws + OFF_MN) + (size_t)m0 * 2048, 2048};
            PlainPtr bf{(const bfr*)(ws + (which ? OFF_WVT : OFF_WKT)) + (size_t)n0 * 2048, 2048};
            gemm_main<1>(acc, af, bf, 32, smem, tid);
            bfr* dstb = (bfr*)(ws + (which ? OFF_VX : OFF_KX));
            gemm_epi<1>(acc, m0, n0, tid, [&](int m, int n, float a, float b, float c, float d) { st_bf4(dstb + (size_t)m * 512 + n, a, b, c, d); });
          }
          int tot2 = 0;
          for (int j = 3; j < 12; ++j) tot2 += tjob_tiles(j);
          tr_run(p, 3, sb_, nshort, tot2, (float*)smem, tid);
        }
      }
    } break;
    case 2: {
      for (int it = grab(ctr + 0, slot, tid); it < 64; it = grab(ctr + 0, slot, tid)) {
        const int which = it >> 5, mt = (it & 31) >> 2, nt = it & 3;
        const int m0 = mt * 256, n0 = nt * 256;
        f32x16 acc[2][4];
        acc_zero<2>(acc);
        struct GatherA {
          const bfr* base; int m0;
          DI int rowoff(int row) const {
            const int R = m0 + row;
            const int bb = R >> 9, g = (R >> 7) & 3;
            int c = R & 127; c = c > 126 ? 126 : c;
            return (bb * SEQ + c * 16) * 2048 + g * 128;
          }
          DI int koff(int kk) const { const int l = kk >> 7; return l * 2048 + ((l >> 4) << 10) + (kk & 127); }
        };
        GatherA af{(const bfr*)(ws + OFF_ZC) + which * 512, m0};
        PlainPtr bf{(const bfr*)(ws + OFF_W1T) + (size_t)which * 1024 * 4096 + (size_t)n0 * 4096, 4096};
        gemm_main<2>(acc, af, bf, 64, smem, tid);
        bfr* hid = (bfr*)(ws + OFF_HIDC) + (size_t)which * 2048 * 1024;
        gemm_epi<2>(acc, m0, n0, tid, [&](int m, int n, float a, float b, float c, float d) {
          st_bf4(hid + (size_t)m * 1024 + n, a * sigmoidf_(a), b * sigmoidf_(b), c * sigmoidf_(c), d * sigmoidf_(d));
        });
      }
      for (int it = grab(ctr + 1, slot, tid); it < 1024; it = grab(ctr + 1, slot, tid)) {
        if (it < 512) attn_item<MODE_RET>(p, it, smem, tid);
        else attn_item<MODE_WIN>(p, it - 512, smem, tid);
      }
    } break;
    case 3: {
      for (int it = bid; it < 16 + NTOK / 2; it += G) {
        if (it >= 16) { ret_finish_row(p, (it - 16) * 2 + (tid >> 8), tid & 255); continue; }
        const int which = it >> 3, mt = it & 7;
        const int m0 = mt * 256;
        f32x16 acc[1][4];
        acc_zero<1>(acc);
        PlainPtr af{(const bfr*)(ws + OFF_HIDC) + (size_t)which * 2048 * 1024 + (size_t)m0 * 1024, 1024};
        PlainPtr bf{(const bfr*)(ws + OFF_W2T) + (size_t)which * 128 * 1024, 1024};
        gemm_main<1>(acc, af, bf, 16, smem, tid);
        bfr* dstb = (bfr*)(ws + OFF_KCVC) + (size_t)which * 2048 * 128;
        gemm_epi<1>(acc, m0, 0, tid, [&](int m, int n, float a, float b, float c, float d) { st_bf4(dstb + (size_t)m * 128 + n, a, b, c, d); });
      }
    } break;
    case 4: {
      for (int it = bid; it < 512; it += G) cmp_item(p, it, smem, tid);
    } break;
    case 5: {
      for (int it = grab(ctr + 2, slot, tid); it < 512; it = grab(ctr + 2, slot, tid)) attn_item<MODE_SEL>(p, it, smem, tid);
    } break;
    case 6: {
      bfr* mg = (bfr*)(ws + OFF_MERGED);
      gemm8_phase(smem, (const bfr*)(ws + OFF_ONSA), (const bfr*)(ws + OFF_WAT), 2048, 32 * 8, G, bid, tid,
        [&](const f32x4 (&acc)[2][2][4][2], int m0, int n0, int wr, int wc, int fr, int fq) {
          epi8_foreach(acc, m0, n0, wr, wc, fr, fq, [&](int m, int n, const f32x4& v0, const f32x4& v1) {
            const u32x4 ga = *(const u32x4*)(z + (size_t)m * ZS + ZC_GA + n);
            f32x4 a0 = {bflo(ga[0]) * v0[0], bfhi(ga[0]) * v0[1], bflo(ga[1]) * v0[2], bfhi(ga[1]) * v0[3]};
            f32x4 a1 = {bflo(ga[2]) * v1[0], bfhi(ga[2]) * v1[1], bflo(ga[3]) * v1[2], bfhi(ga[3]) * v1[3]};
            st_bf8(mg + (size_t)m * 2048 + n, a0, a1);
          });
        });
      gemm8_phase(smem, (const bfr*)(ws + OFF_ORET), (const bfr*)(ws + OFF_WBT), 2048, 32 * 8, G, bid, tid,
        [&](const f32x4 (&acc)[2][2][4][2], int m0, int n0, int wr, int wc, int fr, int fq) {
          epi8_foreach(acc, m0, n0, wr, wc, fr, fq, [&](int m, int n, const f32x4& v0, const f32x4& v1) {
            const u32x4 gb = *(const u32x4*)(z + (size_t)m * ZS + ZC_GB + n);
            bfr* dst = mg + (size_t)m * 2048 + n;
            const u32x4 old = *(const u32x4*)dst;
            f32x4 a0 = {bflo(old[0]) + bflo(gb[0]) * v0[0], bfhi(old[0]) + bfhi(gb[0]) * v0[1], bflo(old[1]) + bflo(gb[1]) * v0[2], bfhi(old[1]) + bfhi(gb[1]) * v0[3]};
            f32x4 a1 = {bflo(old[2]) + bflo(gb[2]) * v1[0], bfhi(old[2]) + bfhi(gb[2]) * v1[1], bflo(old[3]) + bflo(gb[3]) * v1[2], bfhi(old[3]) + bfhi(gb[3]) * v1[3]};
            st_bf8(dst, a0, a1);
          });
        });
    } break;
    case 7: {
      gemm8_phase(smem, (const bfr*)(ws + OFF_MERGED), (const bfr*)(ws + OFF_WOUTT), 2048, 32 * 8, G, bid, tid,
        [&](const f32x4 (&acc)[2][2][4][2], int m0, int n0, int wr, int wc, int fr, int fq) {
          epi8_resid(acc, m0, n0, wr, wc, fr, fq, p.x, (float*)(ws + OFF_H), (bfr*)(ws + OFF_NX), (float*)(ws + OFF_ROWSS));
        });
    } break;
    case 8: case 12: break;
    case 9: {
      const int ng = (G > 128) ? 128 : G;
      if (G > 128) { if (bid >= 128) tr_run(p, 12, bid - 128, G - 128, tjob_tiles(12), (float*)smem, tid); }
      else tr_run(p, 12, bid, G, tjob_tiles(12), (float*)smem, tid);
      if (bid < ng)
      for (int v = bid; v < 32 * 4; v += ng) {
        int mt, nt;
        map_tile32(v, mt, nt);
        const int m0 = mt * 256, n0 = nt * 128;
        f32x16 acc[1][4];
        acc_zero<1>(acc);
        PlainPtr af{(const bfr*)(ws + OFF_NX) + (size_t)m0 * 2048, 2048};
        PlainPtr bf{(const bfr*)(ws + OFF_WQT) + (size_t)n0 * 2048, 2048};
        gemm_main<1>(acc, af, bf, 32, smem, tid);
        bfr* qx = (bfr*)(ws + OFF_QX);
        const float* rss = (const float*)(ws + OFF_ROWSS);
        gemm_epi<1>(acc, m0, n0, tid, [&](int m, int n, float a, float b, float c, float d) {
          const float rs = rsqrtf(rss[m] * (1.f / 2048.f) + 1e-6f);
          st_bf4(qx + (size_t)m * 512 + n, a * rs, b * rs, c * rs, d * rs);
        });
      }
    } break;
    case 10: {
      const int ng = (G > 128) ? 128 : G;
      if (G > 128) { if (bid >= 128) tr_run(p, 13, bid - 128, G - 128, tjob_tiles(13), (float*)smem, tid); }
      else tr_run(p, 13, bid, G, tjob_tiles(13), (float*)smem, tid);
      if (bid < ng)
        for (int it = bid; it < 128; it += ng) attn_item<MODE_X>(p, it, smem, tid);
    } break;
    case 11: {
      gemm8_phase(smem, (const bfr*)(ws + OFF_OX), (const bfr*)(ws + OFF_WOT), 512, 32 * 8, G, bid, tid,
        [&](const f32x4 (&acc)[2][2][4][2], int m0, int n0, int wr, int wc, int fr, int fq) {
          epi8_resid(acc, m0, n0, wr, wc, fr, fq, (const float*)(ws + OFF_H), (float*)(ws + OFF_H), (bfr*)(ws + OFF_NX), (float*)(ws + OFF_ROWSS) + NTOK);
        });
    } break;
    case 13: {
      bfr* hid = (bfr*)(ws + OFF_HID);
      const float* rss = (const float*)(ws + OFF_ROWSS) + NTOK;
      gemm8_phase(smem, (const bfr*)(ws + OFF_NX), (const bfr*)(ws + OFF_WUPT), 2048, 32 * 32, G, bid, tid,
        [&](const f32x4 (&acc)[2][2][4][2], int m0, int n0, int wr, int wc, int fr, int fq) {
          epi8_foreach(acc, m0, n0, wr, wc, fr, fq, [&](int m, int n, const f32x4& v0, const f32x4& v1) {
            const float rs = rsqrtf(rss[m] * (1.f / 2048.f) + 1e-6f);
            f32x4 a0, a1;
#pragma unroll
            for (int j = 0; j < 4; ++j) { const float t0 = fmaxf(v0[j], 0.f) * rs, t1 = fmaxf(v1[j], 0.f) * rs; a0[j] = t0 * t0; a1[j] = t1 * t1; }
            st_bf8(hid + (size_t)m * 8192 + n, a0, a1);
          });
        });
    } break;
    case 14: {
      const float* hbuf = (const float*)(ws + OFF_H);
      gemm8_phase(smem, (const bfr*)(ws + OFF_HID), (const bfr*)(ws + OFF_WDOWNT), 8192, 32 * 8, G, bid, tid,
        [&](const f32x4 (&acc)[2][2][4][2], int m0, int n0, int wr, int wc, int fr, int fq) {
          epi8_foreach(acc, m0, n0, wr, wc, fr, fq, [&](int m, int n, const f32x4& v0, const f32x4& v1) {
            const float* sp = hbuf + (size_t)m * 2048 + n;
            const f32x4 x0 = *(const f32x4*)sp, x1 = *(const f32x4*)(sp + 4);
            float* dp = p.out + (size_t)m * 2048 + n;
            *(f32x4*)dp = x0 + v0; *(f32x4*)(dp + 4) = x1 + v1;
          });
        });
    } break;
    case 15: {
      for (int it = bid; it < 1024; it += G) {
        const int row = it * 8 + (tid >> 6);
        rmsnorm_row(p.out + (size_t)row * 2048, p.final_norm_w, nullptr, p.out + (size_t)row * 2048, tid);
      }
    } break;
    default: break;
  }
}

__global__ void __launch_bounds__(512, 2) mega(Params p) {
  extern __shared__ __attribute__((aligned(1024))) char smem[];
  __shared__ int slot;
  cg::grid_group grid = cg::this_grid();
  const int wave_s = __builtin_amdgcn_readfirstlane((int)(threadIdx.x >> 6));
  for (int ph = p.ph_lo; ph < p.ph_hi; ++ph) {
    if (ph == 8 || ph == 12) continue;
    run_phase(p, ph, smem, &slot, wave_s, 0);
#ifdef PROBE_PH
    if (ph == PROBE_PH)
      for (int rep = 1; rep <= PROBE_N; ++rep) { grid.sync(); run_phase(p, ph, smem, &slot, wave_s, rep); }
#endif
    if (ph + 1 < p.ph_hi) grid.sync();
  }
}

extern "C" void kernel_launch(void* const* d_in, const int* in_sizes, int n_in, void* d_out, int out_size, void* d_ws,
                              size_t ws_size, hipStream_t stream) {
  static int grid_blocks = 0;
  if (!grid_blocks) {
    int dev = 0, cus = 0, per_cu = 0;
    (void)hipGetDevice(&dev);
    (void)hipDeviceGetAttribute(&cus, hipDeviceAttributeMultiprocessorCount, dev);
    (void)hipFuncSetAttribute((const void*)mega, hipFuncAttributeMaxDynamicSharedMemorySize, SMEM_BYTES);
    (void)hipOccupancyMaxActiveBlocksPerMultiprocessor(&per_cu, mega, NTHR, SMEM_BYTES);
    if (per_cu < 1) per_cu = 1;
    if (per_cu > 1) per_cu = 1;
    grid_blocks = cus * per_cu;
    grid_blocks &= ~7;
    if (ws_size < WS_END || n_in != 24) { fprintf(stderr, "kernel_launch: ws %zu < %zu or n_in %d\n", ws_size, (size_t)WS_END, n_in); grid_blocks = -1; }
  }
  if (grid_blocks < 0) return;
  Params p{};
  const float** pp = (const float**)&p;
  for (int i = 0; i < 24; ++i) pp[i] = (const float*)d_in[i];
  p.out = (float*)d_out;
  p.ws = (char*)d_ws;
#if ONE_LAUNCH
  p.ph_lo = 0; p.ph_hi = NPHASE;
  void* args[] = {&p};
  hipError_t e = hipLaunchCooperativeKernel((void*)mega, dim3(grid_blocks), dim3(NTHR), args, SMEM_BYTES, stream);
  if (e != hipSuccess) fprintf(stderr, "cooperative launch failed: %s (grid %d)\n", hipGetErrorString(e), grid_blocks);
#else
  for (int ph = 0; ph < NPHASE; ++ph) {
    p.ph_lo = ph; p.ph_hi = ph + 1;
    hipLaunchKernelGGL(mega, dim3(grid_blocks), dim3(NTHR), SMEM_BYTES, stream, p);
  }
#endif
}
```

```cpp
#include <hip/hip_runtime.h>
#include <hip/hip_cooperative_groups.h>
#include <cstdio>
namespace cg = cooperative_groups;

#ifndef ONE_LAUNCH
#define ONE_LAUNCH 1
#endif

#define DI __device__ __forceinline__
typedef unsigned short bfr;
using bf16x8 = __attribute__((ext_vector_type(8))) short;
using s16x4 = __attribute__((ext_vector_type(4))) short;
using f32x16 = __attribute__((ext_vector_type(16))) float;
using u32x4 = __attribute__((ext_vector_type(4))) unsigned;
#define MFMA(a, b, c) __builtin_amdgcn_mfma_f32_32x32x16_bf16((a), (b), (c), 0, 0, 0)

constexpr int DM = 2048, SEQ = 2048, NTOK = 8192;
constexpr int ZS = 15488;
constexpr int ZC_Q = 0, ZC_KC = 2048, ZC_VC = 2560, ZC_KS = 3072, ZC_VS = 3584, ZC_KW = 4096, ZC_VW = 4608,
              ZC_QR = 5120, ZC_KR = 6144, ZC_VR = 7168, ZC_GR = 9216, ZC_GA = 11264, ZC_GB = 13312, ZC_GN = 15360;
constexpr int NPHASE = 16;

constexpr int ZSP = 15616;
constexpr size_t SZ_WINT = (size_t)ZSP * 2048 * 2;
constexpr size_t SZ_ACT = (size_t)NTOK * 2048 * 2;
constexpr size_t OFF_WINT = 0;
constexpr size_t OFF_N = OFF_WINT + SZ_WINT;
constexpr size_t OFF_MERGED = OFF_WINT;
constexpr size_t OFF_ORET = OFF_N;
constexpr size_t OFF_WUPT = 0;
constexpr size_t OFF_WDOWNT = SZ_ACT;
constexpr size_t OFF_Z = OFF_N + SZ_ACT;
constexpr size_t SZ_Z = (size_t)NTOK * ZS * 2;
constexpr size_t OFF_HID = OFF_Z;
constexpr size_t OFF_H = OFF_Z + (size_t)NTOK * 8192 * 2;
constexpr size_t OFF_NX = OFF_H + (size_t)NTOK * 2048 * 4;
constexpr size_t OFF_QX = OFF_NX + SZ_ACT;
constexpr size_t OFF_OX = OFF_QX + (size_t)NTOK * 512 * 2;
static_assert(OFF_OX + (size_t)NTOK * 512 * 2 <= OFF_Z + SZ_Z, "alias overflow");
constexpr size_t OFF_ZC = OFF_Z + SZ_Z;
constexpr size_t OFF_MN = OFF_ZC + (size_t)NTOK * 2048 * 2;
constexpr size_t OFF_W1T = OFF_MN + (size_t)1024 * 2048 * 2;
constexpr size_t OFF_W2T = OFF_W1T + (size_t)2 * 1024 * 4096 * 2;
constexpr size_t OFF_WAT = OFF_W2T + (size_t)2 * 128 * 1024 * 2;
constexpr size_t OFF_WBT = OFF_WAT + (size_t)2048 * 2048 * 2;
constexpr size_t OFF_WOUTT = OFF_WBT + (size_t)2048 * 2048 * 2;
constexpr size_t OFF_WQT = OFF_WOUTT + (size_t)2048 * 2048 * 2;
constexpr size_t OFF_WKT = OFF_WQT + (size_t)512 * 2048 * 2;
constexpr size_t OFF_WVT = OFF_WKT + (size_t)512 * 2048 * 2;
constexpr size_t OFF_WOT = OFF_WVT + (size_t)512 * 2048 * 2;
constexpr size_t OFF_ROPE = OFF_WOT + (size_t)512 * 2048 * 2;
constexpr size_t OFF_HIDC = OFF_ROPE + (size_t)2048 * 64 * 8;
constexpr size_t OFF_KCVC = OFF_HIDC + (size_t)2 * 2048 * 1024 * 2;
constexpr size_t OFF_SELM = OFF_KCVC + (size_t)2 * 2048 * 128 * 2;
constexpr size_t OFF_ONSA = OFF_SELM + (size_t)16 * 2048 * 4;
constexpr size_t OFF_KX = OFF_ONSA + SZ_ACT;
constexpr size_t OFF_VX = OFF_KX + (size_t)1024 * 512 * 2;
constexpr size_t OFF_RSTAT = OFF_VX + (size_t)1024 * 512 * 2;
constexpr size_t OFF_CTR = OFF_RSTAT + (size_t)NTOK * 8 * 2 * 2 * 4;
constexpr size_t OFF_ROWSS = OFF_CTR + 256;
constexpr size_t WS_END = OFF_ROWSS + (size_t)2 * NTOK * 4;

struct Params {
  const float *x, *mem, *attn_norm_w, *w_in, *pe_k, *w1k, *w2k, *pe_v, *w1v, *w2v, *w_a, *gn_w, *w_b, *w_out, *x_norm_w,
      *mem_norm_w, *wq, *wk, *wv, *wo, *mlp_norm_w, *w_up, *w_down, *final_norm_w;
  float* out;
  char* ws;
  int ph_lo, ph_hi;
  int dbg, pad;
};

constexpr int NTHR = 512;
constexpr int SMEM_BYTES = 131072;
__device__ const float ROPE_INV[64] = {1.0f, 0.865964353f, 0.749894261f, 0.649381638f, 0.562341332f, 0.486967534f, 0.421696514f, 0.365174115f, 0.316227764f, 0.273841977f, 0.237137377f, 0.2053525f, 0.177827939f, 0.153992653f, 0.133352131f, 0.115478203f, 0.100000001f, 0.0865964293f, 0.0749894157f, 0.0649381652f, 0.0562341325f, 0.0486967526f, 0.0421696529f, 0.0365174115f, 0.0316227749f, 0.0273841973f, 0.0237137377f, 0.0205352511f, 0.0177827943f, 0.0153992651f, 0.0133352149f, 0.0115478206f, 0.00999999978f, 0.00865964312f, 0.00749894185f, 0.00649381615f, 0.00562341325f, 0.00486967526f, 0.00421696482f, 0.00365174119f, 0.00316227763f, 0.00273841969f, 0.00237137359f, 0.00205352483f, 0.00177827943f, 0.00153992651f, 0.00133352145f, 0.0011547819f, 0.00100000005f, 0.000865964335f, 0.000749894243f, 0.000649381662f, 0.000562341302f, 0.000486967532f, 0.000421696517f, 0.000365174143f, 0.000316227757f, 0.000273841957f, 0.00023713737f, 0.00020535251f, 0.00017782794f, 0.000153992645f, 0.00013335215f, 0.0001154782f};

DI unsigned pack2(float a, float b) {
  typedef float f2 __attribute__((ext_vector_type(2)));
  typedef __bf16 b2 __attribute__((ext_vector_type(2)));
  f2 v = {a, b};
  b2 r = __builtin_convertvector(v, b2);
  return __builtin_bit_cast(unsigned, r);
}
DI float bflo(unsigned u) { return __uint_as_float(u << 16); }
DI float bfhi(unsigned u) { return __uint_as_float(u & 0xffff0000u); }
DI void st_bf4(bfr* p, float a, float b, float c, float d) {
  uint2 v; v.x = pack2(a, b); v.y = pack2(c, d);
  *(uint2*)p = v;
}
DI float wave_sum(float v) {
#pragma unroll
  for (int o = 32; o > 0; o >>= 1) v += __shfl_xor(v, o);
  return v;
}
DI float sigmoidf_(float x) { return __builtin_amdgcn_rcpf(1.f + __expf(-x)); }
DI int crow(int i, int h) { return (i & 3) + 8 * (i >> 2) + 4 * h; }
DI bf16x8 pack8(const f32x16& x, int s) {
  unsigned a = pack2(x[8 * s], x[8 * s + 1]), b = pack2(x[8 * s + 2], x[8 * s + 3]), c = pack2(x[8 * s + 4], x[8 * s + 5]),
           d = pack2(x[8 * s + 6], x[8 * s + 7]);
  typedef unsigned u4 __attribute__((ext_vector_type(4)));
  u4 v = {a, b, c, d};
  return __builtin_bit_cast(bf16x8, v);
}
DI s16x4 tr_read(const bfr* p) {
  return __builtin_amdgcn_ds_read_tr16_b64_v4i16((__attribute__((address_space(3))) s16x4*)(p));
}

struct TJob { const float* src; bfr* dst; int K, N, ntn, perm; const float* kscale; };
DI TJob get_tjob(const Params& p, int j) {
  TJob t;
  char* ws = p.ws;
  switch (j) {
    case 0: t = {p.w_in, (bfr*)(ws + OFF_WINT), 2048, 15408, 122, 1, nullptr}; break;
    case 1: t = {p.wk, (bfr*)(ws + OFF_WKT), 2048, 512, 4, 0, nullptr}; break;
    case 2: t = {p.wv, (bfr*)(ws + OFF_WVT), 2048, 512, 4, 0, nullptr}; break;
    case 3: t = {p.w1k, (bfr*)(ws + OFF_W1T), 4096, 1024, 8, 0, nullptr}; break;
    case 4: t = {p.w1v, (bfr*)(ws + OFF_W1T) + (size_t)1024 * 4096, 4096, 1024, 8, 0, nullptr}; break;
    case 5: t = {p.w2k, (bfr*)(ws + OFF_W2T), 1024, 128, 1, 0, nullptr}; break;
    case 6: t = {p.w2v, (bfr*)(ws + OFF_W2T) + (size_t)128 * 1024, 1024, 128, 1, 0, nullptr}; break;
    case 7: t = {p.w_a, (bfr*)(ws + OFF_WAT), 2048, 2048, 16, 0, nullptr}; break;
    case 8: t = {p.w_b, (bfr*)(ws + OFF_WBT), 2048, 2048, 16, 0, nullptr}; break;
    case 9: t = {p.w_out, (bfr*)(ws + OFF_WOUTT), 2048, 2048, 16, 0, nullptr}; break;
    case 10: t = {p.wq, (bfr*)(ws + OFF_WQT), 2048, 512, 4, 0, p.x_norm_w}; break;
    case 11: t = {p.wo, (bfr*)(ws + OFF_WOT), 512, 2048, 16, 0, nullptr}; break;
    case 12: t = {p.w_up, (bfr*)(ws + OFF_WUPT), 2048, 8192, 64, 0, p.mlp_norm_w}; break;
    default: t = {p.w_down, (bfr*)(ws + OFF_WDOWNT), 8192, 2048, 16, 0, nullptr}; break;
  }
  return t;
}
DI int tjob_tiles(int j) {
  switch (j) {
    case 0: return 122 * 16;
    case 1: case 2: return 4 * 16;
    case 3: case 4: return 8 * 32;
    case 5: case 6: return 1 * 8;
    case 7: case 8: case 9: return 16 * 16;
    case 10: return 4 * 16;
    case 11: return 16 * 4;
    case 12: return 64 * 16;
    default: return 16 * 64;
  }
}
struct TrRegs { float4 v[8]; };
DI void tr_load(const TJob& t, int tile, TrRegs& rg, const int tid) {
  const int nkt = t.K >> 7;
  const int kt = tile % nkt, nt = tile / nkt;
  const int k0 = kt * 128, d0 = nt * 128;
  int scol0 = d0, nvalid = 128;
  if (t.perm) {
    if (d0 < 5120) scol0 = d0;
    else if (d0 < 15360) scol0 = d0 + 48;
    else { scol0 = d0 - 15360 + 5120; nvalid = (d0 == 15360) ? 48 : 0; }
  }
#pragma unroll
  for (int i = 0; i < 8; ++i) {
    const int row = i * 16 + (tid >> 5), col = (tid & 31) * 4;
    rg.v[i] = make_float4(0.f, 0.f, 0.f, 0.f);
    if (col < nvalid) rg.v[i] = *(const float4*)(t.src + (size_t)(k0 + row) * t.N + scol0 + col);
    if (t.kscale) { const float sc = t.kscale[k0 + row]; rg.v[i].x *= sc; rg.v[i].y *= sc; rg.v[i].z *= sc; rg.v[i].w *= sc; }
  }
}
DI void tr_to_lds(const TrRegs& rg, float* sm, const int tid) {
#pragma unroll
  for (int i = 0; i < 8; ++i) {
    const int row = i * 16 + (tid >> 5), col = (tid & 31) * 4;
    float* d = sm + row * 129 + col;
    d[0] = rg.v[i].x; d[1] = rg.v[i].y; d[2] = rg.v[i].z; d[3] = rg.v[i].w;
  }
}
DI void tr_store(const TJob& t, int tile, const float* sm, const int tid) {
  const int nkt = t.K >> 7;
  const int kt = tile % nkt, nt = tile / nkt;
  const int k0 = kt * 128, d0 = nt * 128;
  const int n = tid >> 2, kq = (tid & 3) * 8;
  bfr* drow = t.dst + (size_t)(d0 + n) * t.K + k0 + kq;
#pragma unroll
  for (int q = 0; q < 4; ++q) {
    const int kb = kq + 32 * q;
    const unsigned o0 = pack2(sm[(kb + 0) * 129 + n], sm[(kb + 1) * 129 + n]);
    const unsigned o1 = pack2(sm[(kb + 2) * 129 + n], sm[(kb + 3) * 129 + n]);
    const unsigned o2 = pack2(sm[(kb + 4) * 129 + n], sm[(kb + 5) * 129 + n]);
    const unsigned o3 = pack2(sm[(kb + 6) * 129 + n], sm[(kb + 7) * 129 + n]);
    *(uint4*)(drow + 32 * q) = make_uint4(o0, o1, o2, o3);
  }
}
DI void tr_decode(int it, int j_lo, int& j, int& rem) {
  j = j_lo; rem = it;
  while (rem >= tjob_tiles(j)) { rem -= tjob_tiles(j); ++j; }
}
DI void tr_run(const Params& p, int j_lo, int it0, int stride, int n_tiles, float* sm, const int tid) {
  if (it0 >= n_tiles) return;
  TrRegs rg;
  int j, rem;
  tr_decode(it0, j_lo, j, rem);
  TJob t = get_tjob(p, j);
  tr_load(t, rem, rg, tid);
  for (int it = it0; it < n_tiles; it += stride) {
    __syncthreads();
    tr_to_lds(rg, sm, tid);
    __syncthreads();
    const TJob tc = t;
    const int remc = rem;
    const int nx = it + stride;
    if (nx < n_tiles) {
      tr_decode(nx, j_lo, j, rem);
      t = get_tjob(p, j);
      tr_load(t, rem, rg, tid);
    }
    tr_store(tc, remc, sm, tid);
  }
  __syncthreads();
}

DI void rmsnorm_row(const float* xrow, const float* w, bfr* obf, float* of32, const int tid) {
  const int lane = tid & 63;
  float4 v[8];
  float ss = 0.f;
#pragma unroll
  for (int i = 0; i < 8; ++i) {
    v[i] = ((const float4*)xrow)[lane + 64 * i];
    ss += v[i].x * v[i].x + v[i].y * v[i].y + v[i].z * v[i].z + v[i].w * v[i].w;
  }
  ss = wave_sum(ss);
  const float rs = rsqrtf(ss * (1.f / 2048.f) + 1e-6f);
#pragma unroll
  for (int i = 0; i < 8; ++i) {
    const float4 ww = ((const float4*)w)[lane + 64 * i];
    const float a = v[i].x * rs * ww.x, b = v[i].y * rs * ww.y, c = v[i].z * rs * ww.z, d = v[i].w * rs * ww.w;
    if (obf) st_bf4(obf + (lane + 64 * i) * 4, a, b, c, d);
    else ((float4*)of32)[lane + 64 * i] = make_float4(a, b, c, d);
  }
}

struct PlainPtr {
  const bfr* base; int ld;
  DI int rowoff(int row) const { return row * ld; }
  DI int koff(int k0) const { return k0; }
};
#define WAIT_V(n) asm volatile("s_waitcnt vmcnt(%0)" ::"n"(n) : "memory")
#define WAIT_L(n) asm volatile("s_waitcnt lgkmcnt(%0)" ::"n"(n) : "memory")
#define RAW_BARRIER() do { WAIT_L(0); __builtin_amdgcn_s_barrier(); } while (0)
typedef __attribute__((address_space(3))) unsigned lds_u32;
constexpr int STAGE_B = 65536;
template <int NI, class AF, class BF>
DI void gemm_main(f32x16 (&acc)[NI][4], const AF& af, const BF& bf, int nk, char* smem, const int tid) {
  const int lane = tid & 63, r = lane & 31, h = lane >> 5;
  const int w = __builtin_amdgcn_readfirstlane(tid >> 6);
  const int wm = w & 1, wn = w >> 1;
  int ao[4], bo[2 * NI];
  {
    const int rl = lane >> 3, kc = (lane & 7) ^ (((w & 1) * 4 + (lane >> 4)) & 7);
#pragma unroll
    for (int i = 0; i < 4; ++i) ao[i] = af.rowoff((w + 8 * i) * 8 + rl) + 8 * kc;
#pragma unroll
    for (int i = 0; i < 2 * NI; ++i) bo[i] = bf.rowoff((w + 8 * i) * 8 + rl) + 8 * kc;
  }
  auto stage = [&](int buf, int kt) {
    const int ka = af.koff(kt * 64), kb = bf.koff(kt * 64);
    char* sbase = smem + buf * STAGE_B + w * 1024;
#pragma unroll
    for (int i = 0; i < 4; ++i)
      __builtin_amdgcn_global_load_lds((const unsigned*)(af.base + (ao[i] + ka)), (lds_u32*)(sbase + i * 8192), 16, 0, 0);
#pragma unroll
    for (int i = 0; i < 2 * NI; ++i)
      __builtin_amdgcn_global_load_lds((const unsigned*)(bf.base + (bo[i] + kb)), (lds_u32*)(sbase + 32768 + i * 8192), 16, 0, 0);
  };
  const int xr = (r >> 1) & 7;
  const int arow = (wm * 128 + r) * 128, brow = 32768 + (wn * 32 * NI + r) * 128;
  WAIT_V(0);
  __syncthreads();
  stage(0, 0);
  WAIT_V(0);
  RAW_BARRIER();
#pragma unroll 1
  for (int kt = 0; kt < nk; ++kt) {
    if (kt + 1 < nk) stage((kt + 1) & 1, kt + 1);
    const char* sb = smem + (kt & 1) * STAGE_B;
#pragma unroll
    for (int ks = 0; ks < 4; ++ks) {
      const int off = ((2 * ks + h) ^ xr) * 16;
      bf16x8 wf[NI], xf[4];
#pragma unroll
      for (int i = 0; i < NI; ++i) wf[i] = *(const bf16x8*)(sb + brow + i * 4096 + off);
#pragma unroll
      for (int i = 0; i < 4; ++i) xf[i] = *(const bf16x8*)(sb + arow + i * 4096 + off);
#pragma unroll
      for (int mi = 0; mi < 4; ++mi)
#pragma unroll
        for (int ni = 0; ni < NI; ++ni) acc[ni][mi] = MFMA(wf[ni], xf[mi], acc[ni][mi]);
    }
    WAIT_V(0);
    RAW_BARRIER();
  }
}
template <int NI>
DI void acc_zero(f32x16 (&acc)[NI][4]) {
#pragma unroll
  for (int a = 0; a < NI; ++a)
#pragma unroll
    for (int b = 0; b < 4; ++b)
#pragma unroll
      for (int i = 0; i < 16; ++i) acc[a][b][i] = 0.f;
}
template <int NI, class EPI>
DI void gemm_epi(const f32x16 (&acc)[NI][4], int m0, int n0, const int tid_in, const EPI& epi) {
  int tid = tid_in;
  asm volatile("" : "+v"(tid));
  const int lane = tid & 63, w = tid >> 6, r = lane & 31, h = lane >> 5;
  const int wm = w & 1, wn = w >> 1;
#pragma unroll
  for (int mi = 0; mi < 4; ++mi)
#pragma unroll
    for (int ni = 0; ni < NI; ++ni)
#pragma unroll
      for (int g = 0; g < 4; ++g) {
        const int n = n0 + wn * 32 * NI + ni * 32 + 8 * g + 4 * h;
        const int m = m0 + wm * 128 + mi * 32 + r;
        epi(m, n, acc[ni][mi][4 * g], acc[ni][mi][4 * g + 1], acc[ni][mi][4 * g + 2], acc[ni][mi][4 * g + 3]);
      }
}
DI void gemm_epi_resid(const f32x16 (&acc)[2][4], int m0, int n0, const int tid_in, const float* hsrc, float* hdst, bfr* hb, float* rowss) {
  int tid = tid_in;
  asm volatile("" : "+v"(tid));
  const int lane = tid & 63, w = tid >> 6, r = lane & 31, h = lane >> 5;
  const int wm = w & 1, wn = w >> 1;
#pragma unroll
  for (int mi = 0; mi < 4; ++mi) {
    const int m = m0 + wm * 128 + mi * 32 + r;
    float ss = 0.f;
#pragma unroll
    for (int ni = 0; ni < 2; ++ni)
#pragma unroll
      for (int g = 0; g < 4; ++g) {
        const int n = n0 + wn * 64 + ni * 32 + 8 * g + 4 * h;
        const float4 xv = *(const float4*)(hsrc + (size_t)m * 2048 + n);
        const float a = xv.x + acc[ni][mi][4 * g], b = xv.y + acc[ni][mi][4 * g + 1], c = xv.z + acc[ni][mi][4 * g + 2], d = xv.w + acc[ni][mi][4 * g + 3];
        *(float4*)(hdst + (size_t)m * 2048 + n) = make_float4(a, b, c, d);
        st_bf4(hb + (size_t)m * 2048 + n, a, b, c, d);
        ss += a * a + b * b + c * c + d * d;
      }
    ss += __shfl_xor(ss, 32);
    if (h == 0) atomicAdd(rowss + m, ss);
  }
}
DI void map_tile32(int v, int& mt, int& nt) {
  const int xcd = v & 7, j = v >> 3;
  nt = j >> 2;
  mt = xcd * 4 + (j & 3);
}


using f32x4 = __attribute__((ext_vector_type(4))) float;
typedef __attribute__((address_space(3))) unsigned char lds_u8;
constexpr int HTB = 128 * 64 * 2;
DI int lds_byte8(int r, int c) { const int st = (r >> 4) * 2 + (c >> 5), rr = r & 15, cc = c & 31, ob = rr * 64 + cc * 2; return st * 1024 + (ob ^ (((ob >> 9) & 1) << 5)); }
DI void stage_rc8(int b, int& R, int& C) { const int st = b / 1024, sb = b % 1024, swz = sb ^ (((sb >> 9) & 1) << 5); R = (st >> 1) * 16 + swz / 64; C = (st & 1) * 32 + (swz % 64) / 2; }
DI int perm32(int rho) { const int n = rho >> 4, i = rho & 15; return 8 * (i >> 2) + 4 * n + (i & 3); }
DI bool unit_next(int i, int G, int bid, int nunits, int& pm, int& pn) {
  const int v = bid + i * G;
  if (v >= nunits) return false;
  const int xcd = v & 7, j = v >> 3;
  pn = j >> 2;
  pm = xcd * 4 + (j & 3);
  return true;
}
template <class Epi>
DI void gemm8_phase(char* smem, const bfr* A, const bfr* Bt, const int K, const int nunits, const int G, const int bid, const int tid, const Epi& E) {
  lds_u8* lds = (lds_u8*)smem;
  const int wid = __builtin_amdgcn_readfirstlane(tid >> 6), lane = tid & 63, wr = wid >> 2, wc = wid & 3, fr = lane & 15, fq = lane >> 4;
  const int nt = K / 64;
  unsigned voffA[2], voffB[2];
#pragma unroll
  for (int i = 0; i < 2; ++i) {
    int R, C;
    stage_rc8(tid * 16 + i * 8192, R, C);
    const int Rb = (R & ~31) + perm32(R & 31);
    voffA[i] = (unsigned)(R * K + C) * 2u;
    voffB[i] = (unsigned)(Rb * K + C) * 2u;
  }
  const size_t kstep = 128;
  const size_t hstep = (size_t)128 * K * 2;
  const size_t tstep = 2 * hstep;
  const unsigned ldsw = (unsigned)wid * 1024u;
  const int aoff = lds_byte8(wr * 64 + fr, fq * 8), boff = lds_byte8(wc * 32 + fr, fq * 8);
#define PG8_SA(b, h) (((b) * 2 + (h)) * HTB)
#define PG8_SB(b, h) ((4 + (b) * 2 + (h)) * HTB)
#define PG8_STAGE(bufoff, gbase, voff) do { _Pragma("unroll") for (int _i = 0; _i < 2; ++_i) \
    __builtin_amdgcn_global_load_lds((const unsigned*)((const char*)(gbase) + (voff)[_i]), (lds_u32*)(lds + (bufoff) + ldsw + _i * 8192), 16, 0, 0); } while (0)
#define PG8_LDA(dst, b, h) do { _Pragma("unroll") for (int m = 0; m < 4; ++m) _Pragma("unroll") for (int k = 0; k < 2; ++k) dst[m][k] = *(const __attribute__((address_space(3))) bf16x8*)(lds + PG8_SA(b, h) + aoff + m * 2048 + k * 1024); } while (0)
#define PG8_LDB(dst, b, h) do { _Pragma("unroll") for (int n = 0; n < 2; ++n) _Pragma("unroll") for (int k = 0; k < 2; ++k) dst[n][k] = *(const __attribute__((address_space(3))) bf16x8*)(lds + PG8_SB(b, h) + boff + n * 2048 + k * 1024); } while (0)
#define PG8_MMA(ai, bj, At, Bt_) do { __builtin_amdgcn_s_setprio(1); _Pragma("unroll") for (int m = 0; m < 4; ++m) _Pragma("unroll") for (int n = 0; n < 2; ++n) _Pragma("unroll") for (int k = 0; k < 2; ++k) \
    acc[ai][bj][m][n] = __builtin_amdgcn_mfma_f32_16x16x32_bf16(Bt_[n][k], At[m][k], acc[ai][bj][m][n], 0, 0, 0); __builtin_amdgcn_s_setprio(0); } while (0)
#define PG8_BAR __builtin_amdgcn_s_barrier()
#define PG8_SCHED __builtin_amdgcn_sched_barrier(0)
  int cpm, cpn, npm = 0, npn = 0, ui = 0;
  if (!unit_next(0, G, bid, nunits, cpm, cpn)) return;
  WAIT_V(0);
  __syncthreads();
  f32x4 acc[2][2][4][2];
#pragma unroll
  for (int a = 0; a < 2; ++a)
#pragma unroll
    for (int b = 0; b < 2; ++b)
#pragma unroll
      for (int m = 0; m < 4; ++m)
#pragma unroll
        for (int n = 0; n < 2; ++n) acc[a][b][m][n] = (f32x4){0.f, 0.f, 0.f, 0.f};
  bf16x8 At[4][2], B0[2][2], B1[2][2];
  const char* cA = (const char*)A + (size_t)cpm * tstep;
  const char* cB = (const char*)Bt + (size_t)cpn * tstep;
  PG8_STAGE(PG8_SB(0, 0), cB, voffB); PG8_STAGE(PG8_SA(0, 0), cA, voffA); PG8_STAGE(PG8_SB(0, 1), cB + hstep, voffB); PG8_STAGE(PG8_SA(0, 1), cA + hstep, voffA);
  if (wr == 1) PG8_BAR;
  WAIT_V(4); PG8_BAR;
  PG8_STAGE(PG8_SB(1, 0), cB + kstep, voffB); PG8_STAGE(PG8_SA(1, 0), cA + kstep, voffA); PG8_STAGE(PG8_SB(1, 1), cB + hstep + kstep, voffB);
  WAIT_V(6); PG8_BAR;
  for (;;) {
    const bool has_next = unit_next(ui + 1, G, bid, nunits, npm, npn);
    const char* nA = has_next ? (const char*)A + (size_t)npm * tstep : cA;
    const char* nB = has_next ? (const char*)Bt + (size_t)npn * tstep : cB;
#pragma unroll 1
    for (int t = 0; t < nt; t += 2) {
      const bool last = (t == nt - 2);
      const char* a1 = cA + (size_t)(t + 1) * kstep;
      const char* a2 = last ? nA : cA + (size_t)(t + 2) * kstep;
      const char* b2 = last ? nB : cB + (size_t)(t + 2) * kstep;
      const char* a3 = a2 + kstep;
      const char* b3 = b2 + kstep;
      PG8_LDB(B0, 0, 0); PG8_SCHED; PG8_LDA(At, 0, 0); PG8_STAGE(PG8_SA(1, 1), a1 + hstep, voffA);
      WAIT_L(8); PG8_BAR; WAIT_L(0); PG8_MMA(0, 0, At, B0); PG8_BAR; PG8_SCHED;
      PG8_LDB(B1, 0, 1); PG8_STAGE(PG8_SB(0, 0), b2, voffB);
      PG8_BAR; WAIT_L(0); PG8_MMA(0, 1, At, B1); PG8_BAR;
      PG8_LDA(At, 0, 1); PG8_STAGE(PG8_SA(0, 0), a2, voffA);
      PG8_BAR; WAIT_L(0); PG8_MMA(1, 0, At, B0); PG8_BAR; PG8_SCHED;
      PG8_STAGE(PG8_SB(0, 1), b2 + hstep, voffB);
      WAIT_V(6); PG8_BAR; PG8_MMA(1, 1, At, B1); PG8_BAR;
      PG8_LDB(B0, 1, 0); PG8_SCHED; PG8_LDA(At, 1, 0); PG8_STAGE(PG8_SA(0, 1), a2 + hstep, voffA);
      WAIT_L(8); PG8_BAR; WAIT_L(0); PG8_MMA(0, 0, At, B0); PG8_BAR; PG8_SCHED;
      PG8_LDB(B1, 1, 1); PG8_STAGE(PG8_SB(1, 0), b3, voffB);
      PG8_BAR; WAIT_L(0); PG8_MMA(0, 1, At, B1); PG8_BAR;
      PG8_LDA(At, 1, 1); PG8_STAGE(PG8_SA(1, 0), a3, voffA);
      PG8_BAR; WAIT_L(0); PG8_MMA(1, 0, At, B0); PG8_BAR; PG8_SCHED;
      PG8_STAGE(PG8_SB(1, 1), b3 + hstep, voffB);
      WAIT_V(6); PG8_BAR; PG8_MMA(1, 1, At, B1); PG8_BAR;
    }
    E(acc, cpm * 256, cpn * 256, wr, wc, fr, fq);
    if (!has_next) break;
#pragma unroll
    for (int a = 0; a < 2; ++a)
#pragma unroll
      for (int b = 0; b < 2; ++b)
#pragma unroll
        for (int m = 0; m < 4; ++m)
#pragma unroll
          for (int n = 0; n < 2; ++n) acc[a][b][m][n] = (f32x4){0.f, 0.f, 0.f, 0.f};
    cpm = npm; cpn = npn; cA = nA; cB = nB; ++ui;
  }
  WAIT_V(0);
  if (wr == 0) PG8_BAR;
  PG8_BAR;
#undef PG8_SA
#undef PG8_SB
#undef PG8_STAGE
#undef PG8_LDA
#undef PG8_LDB
#undef PG8_MMA
#undef PG8_BAR
#undef PG8_SCHED
}
template <class F>
DI void epi8_foreach(const f32x4 (&acc)[2][2][4][2], int m0, int n0, int wr, int wc, int fr, int fq, const F& f) {
#pragma unroll
  for (int ai = 0; ai < 2; ++ai)
#pragma unroll
    for (int m = 0; m < 4; ++m) {
      const int row = m0 + ai * 128 + wr * 64 + m * 16 + fr;
#pragma unroll
      for (int bj = 0; bj < 2; ++bj) f(row, n0 + bj * 128 + wc * 32 + 8 * fq, acc[ai][bj][m][0], acc[ai][bj][m][1]);
    }
}
DI void st_bf8(bfr* p, const f32x4& v0, const f32x4& v1) {
  u32x4 w;
  w[0] = pack2(v0[0], v0[1]); w[1] = pack2(v0[2], v0[3]); w[2] = pack2(v1[0], v1[1]); w[3] = pack2(v1[2], v1[3]);
  *(u32x4*)p = w;
}

DI void epi8_resid(const f32x4 (&acc)[2][2][4][2], int m0, int n0, int wr, int wc, int fr, int fq, const float* hsrc, float* hdst, bfr* hb, float* rowss) {
#pragma unroll
  for (int ai = 0; ai < 2; ++ai)
#pragma unroll
    for (int m = 0; m < 4; ++m) {
      const int row = m0 + ai * 128 + wr * 64 + m * 16 + fr;
      float ss = 0.f;
#pragma unroll
      for (int bj = 0; bj < 2; ++bj) {
        const int n = n0 + bj * 128 + wc * 32 + 8 * fq;
        const float* sp = hsrc + (size_t)row * 2048 + n;
        const f32x4 x0 = *(const f32x4*)sp, x1 = *(const f32x4*)(sp + 4);
        const f32x4 y0 = x0 + acc[ai][bj][m][0], y1 = x1 + acc[ai][bj][m][1];
        float* dp = hdst + (size_t)row * 2048 + n;
        *(f32x4*)dp = y0; *(f32x4*)(dp + 4) = y1;
        st_bf8(hb + (size_t)row * 2048 + n, y0, y1);
        ss += y0[0] * y0[0] + y0[1] * y0[1] + y0[2] * y0[2] + y0[3] * y0[3] + y1[0] * y1[0] + y1[1] * y1[1] + y1[2] * y1[2] + y1[3] * y1[3];
      }
      ss += __shfl_xor(ss, 16);
      ss += __shfl_xor(ss, 32);
      if (fq == 0) atomicAdd(rowss + row, ss);
    }
}
enum { MODE_WIN = 0, MODE_SEL = 1, MODE_X = 2, MODE_RET = 3 };
constexpr int KP = 136;

template <int MODE>
DI void attn_item(const Params& p, int item, char* smem, const int tid) {
  constexpr int VP = 136;
  bfr* Ks = (bfr*)smem;
  bfr* Vs = Ks + 64 * KP;
  const int w = tid >> 6, lane = tid & 63, r = lane & 31, h = lane >> 5;
  bfr* Qw = Vs + 64 * VP + w * 32 * KP;
  char* ws = p.ws;
  const bfr* z = (const bfr*)(ws + OFF_Z);

  int b, t0, tq0, jlo, jhi, head = 0, grp = 0, vh = 0;
  const bfr *qbase, *kbase, *vbase;
  int ldq, ldk;
  unsigned selm = 0, umask = 0xffffffffu;
  if (MODE == MODE_WIN) {
    const int tb = item >> 4, bg = item & 15;
    b = bg >> 2; grp = bg & 3; t0 = tb * 64; tq0 = t0 + 32 * (w >> 2); head = grp * 4 + (w & 3);
    qbase = z + (size_t)(b * SEQ + tq0) * ZS + ZC_Q + head * 128; ldq = ZS;
    kbase = z + (size_t)(b * SEQ) * ZS + ZC_KW + grp * 128;
    vbase = z + (size_t)(b * SEQ) * ZS + ZC_VW + grp * 128;
    ldk = ZS;
    jlo = (t0 - 511 > 0 ? t0 - 511 : 0) >> 6;
    jhi = tb;
  } else if (MODE == MODE_SEL) {
    const int tb = 31 - (item >> 4), bg = item & 15;
    b = bg >> 2; grp = bg & 3; t0 = tb * 64; tq0 = t0 + 32 * (w >> 2); head = grp * 4 + (w & 3);
    qbase = z + (size_t)(b * SEQ + tq0) * ZS + ZC_Q + head * 128; ldq = ZS;
    kbase = z + (size_t)(b * SEQ) * ZS + ZC_KS + grp * 128;
    vbase = z + (size_t)(b * SEQ) * ZS + ZC_VS + grp * 128;
    ldk = ZS;
    jlo = 0;
    jhi = tb;
    const unsigned* sm = (const unsigned*)(ws + OFF_SELM) + (b * 4 + grp) * SEQ;
    selm = sm[tq0 + r];
    unsigned u = sm[t0 + lane];
#pragma unroll
    for (int o = 32; o > 0; o >>= 1) u |= (unsigned)__shfl_xor((int)u, o);
    umask = (unsigned)__builtin_amdgcn_readfirstlane((int)u);
    umask &= (jhi >= 31) ? 0xffffffffu : ((1u << (jhi + 1)) - 1u);
  } else if (MODE == MODE_X) {
    const int tb = item >> 4, bh = item & 15;
    b = bh >> 2; head = bh & 3; t0 = tb * 256; tq0 = t0 + 32 * w;
    qbase = (const bfr*)(ws + OFF_QX) + (size_t)(b * SEQ + tq0) * 512 + head * 128; ldq = 512;
    kbase = (const bfr*)(ws + OFF_KX) + (size_t)(b * 256) * 512 + head * 128;
    vbase = (const bfr*)(ws + OFF_VX) + (size_t)(b * 256) * 512 + head * 128;
    ldk = 512;
    jlo = 0; jhi = 3;
  } else {
    const int tb = 7 - (item >> 6), rest = item & 63;
    b = rest >> 4; head = (rest >> 1) & 7; vh = rest & 1; t0 = tb * 256; tq0 = t0 + 32 * w;
    qbase = z + (size_t)(b * SEQ + tq0) * ZS + ZC_QR + head * 128; ldq = ZS;
    kbase = z + (size_t)(b * SEQ) * ZS + ZC_KR + head * 128;
    vbase = z + (size_t)(b * SEQ) * ZS + ZC_VR + head * 256 + vh * 128;
    ldk = ZS;
    jlo = 0; jhi = 4 * tb + 3;
  }
  const int tq = tq0 + r;

  f32x16 o[4];
#pragma unroll
  for (int dt = 0; dt < 4; ++dt)
#pragma unroll
    for (int i = 0; i < 16; ++i) o[dt][i] = 0.f;
  float m_run = -INFINITY, l_run = 0.f;
  float lg = 0.f;
  float rf[16];
  if (MODE == MODE_RET) {
    lg = log1pf(-exp2f(-5.f - (float)head)) * 1.4426950408889634f;
#pragma unroll
    for (int i = 0; i < 16; ++i) rf[i] = __builtin_amdgcn_exp2f(-lg * (float)crow(i, h));
  }

  u32x4 kreg[2], vreg[2];
  auto gload = [&](int j) {
    const int k0 = j * 64;
#pragma unroll
    for (int i = 0; i < 2; ++i) {
      const int c = tid + 512 * i, row = c >> 4, cc = c & 15;
      kreg[i] = *(const u32x4*)(kbase + (size_t)(k0 + row) * ldk + cc * 8);
      vreg[i] = *(const u32x4*)(vbase + (size_t)(k0 + row) * ldk + cc * 8);
    }
  };
  auto swrite = [&]() {
#pragma unroll
    for (int i = 0; i < 2; ++i) {
      const int c = tid + 512 * i, row = c >> 4, cc = c & 15;
      *(u32x4*)(Ks + row * KP + cc * 8) = kreg[i];
      *(u32x4*)(Vs + row * VP + cc * 8) = vreg[i];
    }
  };
  auto next_j = [&](int j) -> int {
    if (MODE == MODE_SEL) {
      const unsigned rem = (j >= 31) ? 0u : (umask & ~((2u << j) - 1u));
      return rem ? (__builtin_ctz(rem)) : 64;
    }
    return j + 1;
  };
  int j = jlo;
  if (MODE == MODE_SEL) j = __builtin_ctz(umask);
  gload(j);
  __syncthreads();
  {
    u32x4 qreg[8];
#pragma unroll
    for (int i = 0; i < 8; ++i) {
      const int c = lane + 64 * i, row = c >> 4, cc = c & 15;
      qreg[i] = *(const u32x4*)(qbase + (size_t)row * ldq + cc * 8);
    }
#pragma unroll
    for (int i = 0; i < 8; ++i) {
      const int c = lane + 64 * i, row = c >> 4, cc = c & 15;
      *(u32x4*)(Qw + row * KP + cc * 8) = qreg[i];
    }
  }
  const float csc = 0.08838834764831845f * 1.4426950408889634f;
  const int q4 = (lane & 15) >> 2, p4 = lane & 3, blk = (lane >> 4) & 1;
  bool first = true;
#pragma unroll 1
  while (j <= jhi) {
    if (!first) __syncthreads();
    first = false;
    swrite();
    __syncthreads();
    const int jn = next_j(j);
    if (jn <= jhi) gload(jn);
    const int k0 = j * 64;
    if (MODE == MODE_RET && k0 > tq0 + 31) { j = jn; continue; }
    bf16x8 pf[2][2];
    if (MODE == MODE_RET) {
#pragma unroll
      for (int sub = 0; sub < 2; ++sub) {
        f32x16 sx;
#pragma unroll
        for (int i = 0; i < 16; ++i) sx[i] = 0.f;
#pragma unroll
        for (int s = 0; s < 8; ++s) {
          const bf16x8 kf = *(const bf16x8*)(Ks + (32 * sub + r) * KP + 16 * s + 8 * h);
          const bf16x8 qf = *(const bf16x8*)(Qw + r * KP + 16 * s + 8 * h);
          sx = MFMA(kf, qf, sx);
        }
        {
          const int dq = tq - (k0 + 32 * sub);
          const float cf = __builtin_amdgcn_exp2f(lg * (float)dq);
#pragma unroll
          for (int i = 0; i < 16; ++i) sx[i] = (crow(i, h) <= dq) ? sx[i] * (cf * rf[i]) : 0.f;
        }
        pf[sub][0] = pack8(sx, 0);
        pf[sub][1] = pack8(sx, 1);
      }
    } else {
      f32x16 s0, s1;
#pragma unroll
      for (int i = 0; i < 16; ++i) { s0[i] = 0.f; s1[i] = 0.f; }
#pragma unroll
      for (int s = 0; s < 8; ++s) {
        const bf16x8 k0f = *(const bf16x8*)(Ks + r * KP + 16 * s + 8 * h);
        const bf16x8 k1f = *(const bf16x8*)(Ks + (32 + r) * KP + 16 * s + 8 * h);
        const bf16x8 qf = *(const bf16x8*)(Qw + r * KP + 16 * s + 8 * h);
        s0 = MFMA(k0f, qf, s0);
        s1 = MFMA(k1f, qf, s1);
      }
      bool need_mask = false;
      if (MODE == MODE_WIN) need_mask = (k0 + 63 > tq0) || (k0 < tq0 + 31 - 511);
      if (MODE == MODE_SEL) need_mask = (k0 + 63 > tq0);
      const bool lanesel = (MODE == MODE_SEL) ? ((selm >> j) & 1u) : true;
      float mx = -INFINITY;
      if (need_mask) {
#pragma unroll
        for (int i = 0; i < 16; ++i) {
          const int tk0 = k0 + crow(i, h), tk1 = tk0 + 32;
          bool ok0 = true, ok1 = true;
          if (MODE == MODE_WIN) { ok0 = (tk0 <= tq) && (tq - tk0 < 512); ok1 = (tk1 <= tq) && (tq - tk1 < 512); }
          if (MODE == MODE_SEL) { ok0 = lanesel && (tk0 <= tq); ok1 = lanesel && (tk1 <= tq); }
          s0[i] = ok0 ? s0[i] * csc : -INFINITY;
          s1[i] = ok1 ? s1[i] * csc : -INFINITY;
          mx = fmaxf(mx, fmaxf(s0[i], s1[i]));
        }
      } else {
#pragma unroll
        for (int i = 0; i < 16; ++i) {
          s0[i] = lanesel ? s0[i] * csc : -INFINITY;
          s1[i] = lanesel ? s1[i] * csc : -INFINITY;
          mx = fmaxf(mx, fmaxf(s0[i], s1[i]));
        }
      }
      mx = fmaxf(mx, __shfl_xor(mx, 32));
      const float mnew = fmaxf(m_run, mx);
      const float muse = (mnew == -INFINITY) ? 0.f : mnew;
      const float alpha = __builtin_amdgcn_exp2f(m_run - muse);
      float ls = 0.f;
#pragma unroll
      for (int i = 0; i < 16; ++i) {
        s0[i] = __builtin_amdgcn_exp2f(s0[i] - muse);
        s1[i] = __builtin_amdgcn_exp2f(s1[i] - muse);
        ls += s0[i] + s1[i];
      }
      ls += __shfl_xor(ls, 32);
      l_run = l_run * alpha + ls;
      m_run = mnew;
      if (__builtin_amdgcn_ballot_w64(alpha != 1.f) != 0) {
#pragma unroll
        for (int dt = 0; dt < 4; ++dt)
#pragma unroll
          for (int i = 0; i < 16; ++i) o[dt][i] *= alpha;
      }
      pf[0][0] = pack8(s0, 0); pf[0][1] = pack8(s0, 1);
      pf[1][0] = pack8(s1, 0); pf[1][1] = pack8(s1, 1);
    }
#pragma unroll
    for (int dt = 0; dt < 4; ++dt)
#pragma unroll
      for (int sub = 0; sub < 2; ++sub)
#pragma unroll
        for (int st = 0; st < 2; ++st) {
          const int key0 = 32 * sub + 16 * st + 4 * h;
          const bfr* vp = Vs + (key0 + q4) * VP + 32 * dt + 16 * blk + 4 * p4;
          const s16x4 lo = tr_read(vp);
          const s16x4 hi = tr_read(vp + 8 * VP);
          const bf16x8 vf = __builtin_shufflevector(lo, hi, 0, 1, 2, 3, 4, 5, 6, 7);
          o[dt] = MFMA(vf, pf[sub][st], o[dt]);
        }
    j = jn;
  }

  if (MODE == MODE_SEL && p.dbg) return;
  const size_t mrow = (size_t)(b * SEQ + tq);
  if (MODE == MODE_WIN || MODE == MODE_SEL) {
    const float inv = (l_run > 0.f) ? 1.f / l_run : 0.f;
    const float gate = bflo(z[mrow * ZS + ZC_GN + head * 3 + (MODE == MODE_WIN ? 2 : 1)]);
    bfr* orow = (bfr*)(ws + OFF_ONSA) + mrow * 2048 + head * 128;
    const float sc = inv * gate;
#pragma unroll
    for (int dt = 0; dt < 4; ++dt)
#pragma unroll
      for (int g = 0; g < 4; ++g) {
        bfr* dst = orow + 32 * dt + 8 * g + 4 * h;
        float a = o[dt][4 * g] * sc, bb = o[dt][4 * g + 1] * sc, c = o[dt][4 * g + 2] * sc, d = o[dt][4 * g + 3] * sc;
        if (MODE == MODE_SEL) {
          const uint2 old = *(const uint2*)dst;
          a += bflo(old.x); bb += bfhi(old.x); c += bflo(old.y); d += bfhi(old.y);
        }
        st_bf4(dst, a, bb, c, d);
      }
  } else if (MODE == MODE_X) {
    const float inv = 1.f / l_run;
    bfr* orow = (bfr*)(ws + OFF_OX) + mrow * 512 + head * 128;
#pragma unroll
    for (int dt = 0; dt < 4; ++dt)
#pragma unroll
      for (int g = 0; g < 4; ++g)
        st_bf4(orow + 32 * dt + 8 * g + 4 * h, o[dt][4 * g] * inv, o[dt][4 * g + 1] * inv, o[dt][4 * g + 2] * inv,
               o[dt][4 * g + 3] * inv);
  } else {
    float sm = 0.f, sq = 0.f;
#pragma unroll
    for (int dt = 0; dt < 4; ++dt)
#pragma unroll
      for (int i = 0; i < 16; ++i) { sm += o[dt][i]; sq += o[dt][i] * o[dt][i]; }
    sm += __shfl_xor(sm, 32);
    sq += __shfl_xor(sq, 32);
    if (h == 0) *(float2*)((float*)(ws + OFF_RSTAT) + ((mrow * 8 + head) * 2 + vh) * 2) = make_float2(sm, sq);
    bfr* orow = (bfr*)(ws + OFF_ORET) + mrow * 2048 + head * 256 + vh * 128;
#pragma unroll
    for (int dt = 0; dt < 4; ++dt)
#pragma unroll
      for (int g = 0; g < 4; ++g)
        st_bf4(orow + 32 * dt + 8 * g + 4 * h, o[dt][4 * g], o[dt][4 * g + 1], o[dt][4 * g + 2], o[dt][4 * g + 3]);
  }
}

DI void ret_finish_row(const Params& p, int row, const int t) {
  char* ws = p.ws;
  const bfr* z = (const bfr*)(ws + OFF_Z);
  const int col = t * 8, head = t >> 5;
  const float4 st = *(const float4*)((const float*)(ws + OFF_RSTAT) + ((size_t)row * 8 + head) * 4);
  const float mu = (st.x + st.z) * (1.f / 256.f);
  const float var = fmaxf((st.y + st.w) * (1.f / 256.f) - mu * mu, 0.f);
  const float rstd = rsqrtf(var + 1e-6f);
  bfr* op = (bfr*)(ws + OFF_ORET) + (size_t)row * 2048 + col;
  const u32x4 ov = *(const u32x4*)op;
  const u32x4 gv = *(const u32x4*)(z + (size_t)row * ZS + ZC_GR + col);
  const float4 w0 = *(const float4*)(p.gn_w + col), w1 = *(const float4*)(p.gn_w + col + 4);
  u32x4 res;
  res[0] = pack2((bflo(ov[0]) - mu) * rstd * w0.x * bflo(gv[0]), (bfhi(ov[0]) - mu) * rstd * w0.y * bfhi(gv[0]));
  res[1] = pack2((bflo(ov[1]) - mu) * rstd * w0.z * bflo(gv[1]), (bfhi(ov[1]) - mu) * rstd * w0.w * bfhi(gv[1]));
  res[2] = pack2((bflo(ov[2]) - mu) * rstd * w1.x * bflo(gv[2]), (bfhi(ov[2]) - mu) * rstd * w1.y * bfhi(gv[2]));
  res[3] = pack2((bflo(ov[3]) - mu) * rstd * w1.z * bflo(gv[3]), (bfhi(ov[3]) - mu) * rstd * w1.w * bfhi(gv[3]));
  *(u32x4*)op = res;
}

DI void cmp_item(const Params& p, int item, char* smem, const int tid) {
  bfr* Ks = (bfr*)smem;
  float* impw = (float*)(smem + 128 * KP * 2);
  const int w = tid >> 6, lane = tid & 63, r = lane & 31, h = lane >> 5;
  char* ws = p.ws;
  const bfr* z = (const bfr*)(ws + OFF_Z);
  const int tb = item >> 4, bg = item & 15, b = bg >> 2, grp = bg & 3;
  const int t0 = tb * 64, ti = 32 * (w >> 2) + r, tq = t0 + ti, hw = w & 3, head = grp * 4 + hw;
  const bfr* qrow = z + (size_t)(b * SEQ + tq) * ZS + ZC_Q + head * 128;
  const bfr* kc = (const bfr*)(ws + OFF_KCVC) + (size_t)((b * 4 + grp) * 128) * 128;
  const bfr* vc = kc + (size_t)2048 * 128;
  bf16x8 qf[8];
#pragma unroll
  for (int s = 0; s < 8; ++s) qf[s] = *(const bf16x8*)(qrow + 16 * s + 8 * h);
  u32x4 reg[4];
#pragma unroll
  for (int i = 0; i < 4; ++i) {
    const int c = tid + 512 * i, row = c >> 4, cc = c & 15;
    reg[i] = *(const u32x4*)(kc + row * 128 + cc * 8);
  }
  __syncthreads();
#pragma unroll
  for (int i = 0; i < 4; ++i) {
    const int c = tid + 512 * i, row = c >> 4, cc = c & 15;
    *(u32x4*)(Ks + row * KP + cc * 8) = reg[i];
  }
  __syncthreads();
  f32x16 s[4];
#pragma unroll
  for (int kt = 0; kt < 4; ++kt) {
#pragma unroll
    for (int i = 0; i < 16; ++i) s[kt][i] = 0.f;
#pragma unroll
    for (int ss = 0; ss < 8; ++ss) {
      const bf16x8 kf = *(const bf16x8*)(Ks + (32 * kt + r) * KP + 16 * ss + 8 * h);
      s[kt] = MFMA(kf, qf[ss], s[kt]);
    }
  }
  const float csc = 0.08838834764831845f * 1.4426950408889634f;
  float mx = -INFINITY;
#pragma unroll
  for (int kt = 0; kt < 4; ++kt)
#pragma unroll
    for (int i = 0; i < 16; ++i) {
      const int c = 32 * kt + crow(i, h);
      const bool ok = (c * 16 + 31 <= tq) && (c < 127);
      s[kt][i] = ok ? s[kt][i] * csc : -INFINITY;
      mx = fmaxf(mx, s[kt][i]);
    }
  mx = fmaxf(mx, __shfl_xor(mx, 32));
  const float muse = (mx == -INFINITY) ? 0.f : mx;
  float ls = 0.f;
#pragma unroll
  for (int kt = 0; kt < 4; ++kt)
#pragma unroll
    for (int i = 0; i < 16; ++i) {
      s[kt][i] = __builtin_amdgcn_exp2f(s[kt][i] - muse);
      ls += s[kt][i];
    }
  ls += __shfl_xor(ls, 32);
  const float inv = (ls > 0.f) ? 1.f / ls : 0.f;
#pragma unroll
  for (int kt = 0; kt < 4; ++kt)
#pragma unroll
    for (int i = 0; i < 16; ++i) s[kt][i] *= inv;
  float plast[16];
#pragma unroll
  for (int kt = 0; kt < 4; ++kt)
#pragma unroll
    for (int g = 0; g < 4; ++g) plast[kt * 4 + g] = __shfl_xor(s[kt][4 * g + 3], 32);
#pragma unroll
  for (int kt = 0; kt < 4; ++kt)
#pragma unroll
    for (int g = 0; g < 4; ++g) {
      const int slot = kt * 4 + g;
      const float sum4 = s[kt][4 * g] + s[kt][4 * g + 1] + s[kt][4 * g + 2] + s[kt][4 * g + 3];
      const float prevl = (slot > 0) ? plast[slot > 0 ? slot - 1 : 0] : 0.f;
      const float add = h ? plast[slot] : prevl;
      impw[(hw * 64 + ti) * 32 + 8 * kt + 2 * g + h] = sum4 + add;
    }
  bf16x8 pf[4][2];
#pragma unroll
  for (int kt = 0; kt < 4; ++kt) { pf[kt][0] = pack8(s[kt], 0); pf[kt][1] = pack8(s[kt], 1); }
#pragma unroll
  for (int i = 0; i < 4; ++i) {
    const int c = tid + 512 * i, row = c >> 4, cc = c & 15;
    reg[i] = *(const u32x4*)(vc + row * 128 + cc * 8);
  }
  __syncthreads();
#pragma unroll
  for (int i = 0; i < 4; ++i) {
    const int c = tid + 512 * i, row = c >> 4, cc = c & 15;
    *(u32x4*)(Ks + row * KP + cc * 8) = reg[i];
  }
  __syncthreads();
  f32x16 o[4];
#pragma unroll
  for (int dt = 0; dt < 4; ++dt)
#pragma unroll
    for (int i = 0; i < 16; ++i) o[dt][i] = 0.f;
  const int q4 = (lane & 15) >> 2, p4 = lane & 3, blk = (lane >> 4) & 1;
#pragma unroll
  for (int dt = 0; dt < 4; ++dt)
#pragma unroll
    for (int kt = 0; kt < 4; ++kt)
#pragma unroll
      for (int st = 0; st < 2; ++st) {
        const int key0 = 32 * kt + 16 * st + 4 * h;
        const bfr* vp = Ks + (key0 + q4) * KP + 32 * dt + 16 * blk + 4 * p4;
        const s16x4 lo = tr_read(vp);
        const s16x4 hi = tr_read(vp + 8 * KP);
        const bf16x8 vf = __builtin_shufflevector(lo, hi, 0, 1, 2, 3, 4, 5, 6, 7);
        o[dt] = MFMA(vf, pf[kt][st], o[dt]);
      }
  {
    const size_t mrow = (size_t)(b * SEQ + tq);
    const float gate = bflo(z[mrow * ZS + ZC_GN + head * 3 + 0]);
    bfr* orow = (bfr*)(ws + OFF_ONSA) + mrow * 2048 + head * 128;
#pragma unroll
    for (int dt = 0; dt < 4; ++dt)
#pragma unroll
      for (int g = 0; g < 4; ++g) {
        bfr* dst = orow + 32 * dt + 8 * g + 4 * h;
        const uint2 old = *(const uint2*)dst;
        st_bf4(dst, o[dt][4 * g] * gate + bflo(old.x), o[dt][4 * g + 1] * gate + bfhi(old.x),
               o[dt][4 * g + 2] * gate + bflo(old.y), o[dt][4 * g + 3] * gate + bfhi(old.y));
      }
  }
  {
    const int i = tid >> 3, jg = tid & 7;
    const int cur = (t0 + i) >> 6;
    float vm[4];
#pragma unroll
    for (int e = 0; e < 4; ++e) {
      const int jme = 4 * jg + e;
      const float a = impw[(0 * 64 + i) * 32 + jme] + impw[(1 * 64 + i) * 32 + jme] + impw[(2 * 64 + i) * 32 + jme] + impw[(3 * 64 + i) * 32 + jme];
      const bool forced = (jme == 0) || (jme == cur) || (jme == cur - 1);
      vm[e] = forced ? INFINITY : ((jme > cur) ? -INFINITY : a);
    }
#pragma unroll
    for (int e = 0; e < 4; ++e) impw[i * 32 + 4 * jg + e] = vm[e];
    __syncthreads();
    int rank[4] = {0, 0, 0, 0};
#pragma unroll 4
    for (int k = 0; k < 32; ++k) {
      const float vk = impw[i * 32 + k];
#pragma unroll
      for (int e = 0; e < 4; ++e) rank[e] += (vk > vm[e] || (vk == vm[e] && k < 4 * jg + e)) ? 1 : 0;
    }
    unsigned bits = 0;
#pragma unroll
    for (int e = 0; e < 4; ++e)
      if (rank[e] < 16 && 4 * jg + e <= cur) bits |= 1u << (4 * jg + e);
    bits |= (unsigned)__shfl_xor((int)bits, 1);
    bits |= (unsigned)__shfl_xor((int)bits, 2);
    bits |= (unsigned)__shfl_xor((int)bits, 4);
    if (jg == 0) ((unsigned*)(ws + OFF_SELM))[(b * 4 + grp) * SEQ + t0 + i] = bits;
  }
  __syncthreads();
}

DI int grab(unsigned* ctr, int* slot, const int tid) {
  __syncthreads();
  if (tid == 0) *slot = (int)atomicAdd(ctr, 1u);
  __syncthreads();
  return *slot;
}

DI void run_phase(const Params& p0, int ph, char* smem, int* slot, const int wave_s, const int rep) {
  char* ws = p0.ws;
  asm volatile("" : "+s"(ws));
  Params p = p0;
  p.ws = ws;
  p.dbg = rep;
  const int G = gridDim.x;
  int bid = blockIdx.x;
  int tid = wave_s * 64 + (int)__builtin_amdgcn_mbcnt_hi(~0u, __builtin_amdgcn_mbcnt_lo(~0u, 0u));
  asm volatile("" : "+s"(bid));
  asm volatile("" : "+v"(tid));
  bfr* z = (bfr*)(ws + OFF_Z);
  unsigned* ctr = (unsigned*)(ws + OFF_CTR) + rep * 8;
  switch (ph) {
    case 0: {
      if (bid == 0 && tid < 64) ((unsigned*)(ws + OFF_CTR))[tid] = 0u;
      for (int i = bid * NTHR + tid; i < 2 * NTOK; i += G * NTHR) ((float*)(ws + OFF_ROWSS))[i] = 0.f;
      int tot = 0;
      for (int j = 0; j < 3; ++j) tot += tjob_tiles(j);
      const int n_norm = 1024 + 128, n_rope = 256;
      tr_run(p, 0, bid, G, tot, (float*)smem, tid);
      for (int it = tot + bid; it < tot + n_norm + n_rope; it += G) {
        if (it < tot + n_norm) {
          const int row = (it - tot) * 8 + (tid >> 6);
          if (row < NTOK) rmsnorm_row(p.x + (size_t)row * 2048, p.attn_norm_w, (bfr*)(ws + OFF_N) + (size_t)row * 2048, nullptr, tid);
          else rmsnorm_row(p.mem + (size_t)(row - NTOK) * 2048, p.mem_norm_w, (bfr*)(ws + OFF_MN) + (size_t)(row - NTOK) * 2048, nullptr, tid);
        } else {
          const int e = (it - tot - n_norm) * 512 + tid;
          const int t = e >> 6, i = e & 63;
          const float ang = (float)t * ROPE_INV[i];
          const float kk = rintf(ang * 0.15915494309189535f);
          float rr = fmaf(-kk, 6.2831854820251465f, ang);
          rr = fmaf(-kk, -1.7484555e-7f, rr);
          const float fr = rr * 0.15915494309189535f;
          ((float2*)(ws + OFF_ROPE))[e] = make_float2(__builtin_amdgcn_cosf(fr), __builtin_amdgcn_sinf(fr));
        }
      }
    } break;
    case 1: {
      {
        bfr* zcb = (bfr*)(ws + OFF_ZC);
        const float2* rope = (const float2*)(ws + OFF_ROPE);
        auto epi4 = [&](int m, int n, float a, float b, float c, float d) {
          bfr* dst = z + (size_t)m * ZS + n;
          const int t = m & 2047;
          if (n >= ZC_KC && n < ZC_KS) {
            const float* pe = (n < ZC_VC) ? p.pe_k : p.pe_v;
            const int dd = n & 127;
            const float4 plo = *(const float4*)(pe + (t & 15) * 128 + dd);
            const float4 phi = *(const float4*)(pe + (16 + (t & 15)) * 128 + dd);
            st_bf4(zcb + (size_t)m * 2048 + (n - ZC_KC), a + plo.x, b + plo.y, c + plo.z, d + plo.w);
            st_bf4(zcb + (size_t)m * 2048 + 1024 + (n - ZC_KC), a + phi.x, b + phi.y, c + phi.z, d + phi.w);
          } else if (n >= ZC_QR && n < ZC_VR) {
            const int i0 = (n & 127) >> 1;
            const float2 c0 = rope[t * 64 + i0], c1 = rope[t * 64 + i0 + 1];
            float o0 = a * c0.x - b * c0.y, o1 = a * c0.y + b * c0.x;
            float o2 = c * c1.x - d * c1.y, o3 = c * c1.y + d * c1.x;
            if (n >= ZC_KR) { const float sc = 0.08838834764831845f; o0 *= sc; o1 *= sc; o2 *= sc; o3 *= sc; }
            st_bf4(dst, o0, o1, o2, o3);
          } else if (n >= ZC_GR && n < ZC_GA) {
            st_bf4(dst, a * sigmoidf_(a), b * sigmoidf_(b), c * sigmoidf_(c), d * sigmoidf_(d));
          } else {
            st_bf4(dst, sigmoidf_(a), sigmoidf_(b), sigmoidf_(c), sigmoidf_(d));
          }
        };
        gemm8_phase(smem, (const bfr*)(ws + OFF_N), (const bfr*)(ws + OFF_WINT), 2048, 32 * 61, G, bid, tid,
          [&](const f32x4 (&acc)[2][2][4][2], int m0, int n0, int wr, int wc, int fr, int fq) {
            epi8_foreach(acc, m0, n0, wr, wc, fr, fq, [&](int m, int n, const f32x4& v0, const f32x4& v1) {
              if (n >= ZS) return;
              const bool plain = (n < ZC_KC) || (n >= ZC_KS && n < ZC_QR) || (n >= ZC_VR && n < ZC_GR);
              if (plain) st_bf8(z + (size_t)m * ZS + n, v0, v1);
              else { epi4(m, n, v0[0], v0[1], v0[2], v0[3]); epi4(m, n + 4, v1[0], v1[1], v1[2], v1[3]); }
            });
          });
      }
      {
        const int nunits = 32 * 61;
        const int nlong = (nunits % G == 0) ? 0 : nunits % G;
        const int nshort = G - nlong;
        const int sb_ = bid - nlong;
        if (sb_ >= 0) {
          for (int u = sb_; u < 32; u += nshort) {
            f32x16 acc[1][4];
            acc_zero<1>(acc);
            const int which = u >> 4, mt = (u & 15) >> 2, nt = u & 3;
            const int m0 = mt * 256, n0 = nt * 128;
            PlainPtr af{(const bfr*)(ws + OFF_MN) + (size_t)m0 * 2048, 2048};
            PlainPtr bf{(const bfr*)(ws + (which ? OFF_WVT : OFF_WKT)) + (size_t)n0 * 2048, 2048};
            gemm_main<1>(acc, af, bf, 32, smem, tid);
            bfr* dstb = (bfr*)(ws + (which ? OFF_VX : OFF_KX));
            gemm_epi<1>(acc, m0, n0, tid, [&](int m, int n, float a, float b, float c, float d) { st_bf4(dstb + (size_t)m * 512 + n, a, b, c, d); });
          }
          int tot2 = 0;
          for (int j = 3; j < 12; ++j) tot2 += tjob_tiles(j);
          tr_run(p, 3, sb_, nshort, tot2, (float*)smem, tid);
        }
      }
    } break;
    case 2: {
      for (int it = grab(ctr + 0, slot, tid); it < 64; it = grab(ctr + 0, slot, tid)) {
        const int which = it >> 5, mt = (it & 31) >> 2, nt = it & 3;
        const int m0 = mt * 256, n0 = nt * 256;
        f32x16 acc[2][4];
        acc_zero<2>(acc);
        struct GatherA {
          const bfr* base; int m0;
          DI int rowoff(int row) const {
            const int R = m0 + row;
            const int bb = R >> 9, g = (R >> 7) & 3;
            int c = R & 127; c = c > 126 ? 126 : c;
            return (bb * SEQ + c * 16) * 2048 + g * 128;
          }
          DI int koff(int kk) const { const int l = kk >> 7; return l * 2048 + ((l >> 4) << 10) + (kk & 127); }
        };
        GatherA af{(const bfr*)(ws + OFF_ZC) + which * 512, m0};
        PlainPtr bf{(const bfr*)(ws + OFF_W1T) + (size_t)which * 1024 * 4096 + (size_t)n0 * 4096, 4096};
        gemm_main<2>(acc, af, bf, 64, smem, tid);
        bfr* hid = (bfr*)(ws + OFF_HIDC) + (size_t)which * 2048 * 1024;
        gemm_epi<2>(acc, m0, n0, tid, [&](int m, int n, float a, float b, float c, float d) {
          st_bf4(hid + (size_t)m * 1024 + n, a * sigmoidf_(a), b * sigmoidf_(b), c * sigmoidf_(c), d * sigmoidf_(d));
        });
      }
      for (int it = grab(ctr + 1, slot, tid); it < 1024; it = grab(ctr + 1, slot, tid)) {
        if (it < 512) attn_item<MODE_RET>(p, it, smem, tid);
        else attn_item<MODE_WIN>(p, it - 512, smem, tid);
      }
    } break;
    case 3: {
      for (int it = bid; it < 16 + NTOK / 2; it += G) {
        if (it >= 16) { ret_finish_row(p, (it - 16) * 2 + (tid >> 8), tid & 255); continue; }
        const int which = it >> 3, mt = it & 7;
        const int m0 = mt * 256;
        f32x16 acc[1][4];
        acc_zero<1>(acc);
        PlainPtr af{(const bfr*)(ws + OFF_HIDC) + (size_t)which * 2048 * 1024 + (size_t)m0 * 1024, 1024};
        PlainPtr bf{(const bfr*)(ws + OFF_W2T) + (size_t)which * 128 * 1024, 1024};
        gemm_main<1>(acc, af, bf, 16, smem, tid);
        bfr* dstb = (bfr*)(ws + OFF_KCVC) + (size_t)which * 2048 * 128;
        gemm_epi<1>(acc, m0, 0, tid, [&](int m, int n, float a, float b, float c, float d) { st_bf4(dstb + (size_t)m * 128 + n, a, b, c, d); });
      }
    } break;
    case 4: {
      for (int it = bid; it < 512; it += G) cmp_item(p, it, smem, tid);
    } break;
    case 5: {
      for (int it = grab(ctr + 2, slot, tid); it < 512; it = grab(ctr + 2, slot, tid)) attn_item<MODE_SEL>(p, it, smem, tid);
    } break;
    case 6: {
      bfr* mg = (bfr*)(ws + OFF_MERGED);
      gemm8_phase(smem, (const bfr*)(ws + OFF_ONSA), (const bfr*)(ws + OFF_WAT), 2048, 32 * 8, G, bid, tid,
        [&](const f32x4 (&acc)[2][2][4][2], int m0, int n0, int wr, int wc, int fr, int fq) {
          epi8_foreach(acc, m0, n0, wr, wc, fr, fq, [&](int m, int n, const f32x4& v0, const f32x4& v1) {
            const u32x4 ga = *(const u32x4*)(z + (size_t)m * ZS + ZC_GA + n);
            f32x4 a0 = {bflo(ga[0]) * v0[0], bfhi(ga[0]) * v0[1], bflo(ga[1]) * v0[2], bfhi(ga[1]) * v0[3]};
            f32x4 a1 = {bflo(ga[2]) * v1[0], bfhi(ga[2]) * v1[1], bflo(ga[3]) * v1[2], bfhi(ga[3]) * v1[3]};
            st_bf8(mg + (size_t)m * 2048 + n, a0, a1);
          });
        });
      gemm8_phase(smem, (const bfr*)(ws + OFF_ORET), (const bfr*)(ws + OFF_WBT), 2048, 32 * 8, G, bid, tid,
        [&](const f32x4 (&acc)[2][2][4][2], int m0, int n0, int wr, int wc, int fr, int fq) {
          epi8_foreach(acc, m0, n0, wr, wc, fr, fq, [&](int m, int n, const f32x4& v0, const f32x4& v1) {
            const u32x4 gb = *(const u32x4*)(z + (size_t)m * ZS + ZC_GB + n);
            bfr* dst = mg + (size_t)m * 2048 + n;
            const u32x4 old = *(const u32x4*)dst;
            f32x4 a0 = {bflo(old[0]) + bflo(gb[0]) * v0[0], bfhi(old[0]) + bfhi(gb[0]) * v0[1], bflo(old[1]) + bflo(gb[1]) * v0[2], bfhi(old[1]) + bfhi(gb[1]) * v0[3]};
            f32x4 a1 = {bflo(old[2]) + bflo(gb[2]) * v1[0], bfhi(old[2]) + bfhi(gb[2]) * v1[1], bflo(old[3]) + bflo(gb[3]) * v1[2], bfhi(old[3]) + bfhi(gb[3]) * v1[3]};
            st_bf8(dst, a0, a1);
          });
        });
    } break;
    case 7: {
      gemm8_phase(smem, (const bfr*)(ws + OFF_MERGED), (const bfr*)(ws + OFF_WOUTT), 2048, 32 * 8, G, bid, tid,
        [&](const f32x4 (&acc)[2][2][4][2], int m0, int n0, int wr, int wc, int fr, int fq) {
          epi8_resid(acc, m0, n0, wr, wc, fr, fq, p.x, (float*)(ws + OFF_H), (bfr*)(ws + OFF_NX), (float*)(ws + OFF_ROWSS));
        });
    } break;
    case 8: case 12: break;
    case 9: {
      const int ng = (G > 128) ? 128 : G;
      if (G > 128) { if (bid >= 128) tr_run(p, 12, bid - 128, G - 128, tjob_tiles(12), (float*)smem, tid); }
      else tr_run(p, 12, bid, G, tjob_tiles(12), (float*)smem, tid);
      if (bid < ng)
      for (int v = bid; v < 32 * 4; v += ng) {
        int mt, nt;
        map_tile32(v, mt, nt);
        const int m0 = mt * 256, n0 = nt * 128;
        f32x16 acc[1][4];
        acc_zero<1>(acc);
        PlainPtr af{(const bfr*)(ws + OFF_NX) + (size_t)m0 * 2048, 2048};
        PlainPtr bf{(const bfr*)(ws + OFF_WQT) + (size_t)n0 * 2048, 2048};
        gemm_main<1>(acc, af, bf, 32, smem, tid);
        bfr* qx = (bfr*)(ws + OFF_QX);
        const float* rss = (const float*)(ws + OFF_ROWSS);
        gemm_epi<1>(acc, m0, n0, tid, [&](int m, int n, float a, float b, float c, float d) {
          const float rs = rsqrtf(rss[m] * (1.f / 2048.f) + 1e-6f);
          st_bf4(qx + (size_t)m * 512 + n, a * rs, b * rs, c * rs, d * rs);
        });
      }
    } break;
    case 10: {
      const int ng = (G > 128) ? 128 : G;
      if (G > 128) { if (bid >= 128) tr_run(p, 13, bid - 128, G - 128, tjob_tiles(13), (float*)smem, tid); }
      else tr_run(p, 13, bid, G, tjob_tiles(13), (float*)smem, tid);
      if (bid < ng)
        for (int it = bid; it < 128; it += ng) attn_item<MODE_X>(p, it, smem, tid);
    } break;
    case 11: {
      gemm8_phase(smem, (const bfr*)(ws + OFF_OX), (const bfr*)(ws + OFF_WOT), 512, 32 * 8, G, bid, tid,
        [&](const f32x4 (&acc)[2][2][4][2], int m0, int n0, int wr, int wc, int fr, int fq) {
          epi8_resid(acc, m0, n0, wr, wc, fr, fq, (const float*)(ws + OFF_H), (float*)(ws + OFF_H), (bfr*)(ws + OFF_NX), (float*)(ws + OFF_ROWSS) + NTOK);
        });
    } break;
    case 13: {
      bfr* hid = (bfr*)(ws + OFF_HID);
      const float* rss = (const float*)(ws + OFF_ROWSS) + NTOK;
      gemm8_phase(smem, (const bfr*)(ws + OFF_NX), (const bfr*)(ws + OFF_WUPT), 2048, 32 * 32, G, bid, tid,
        [&](const f32x4 (&acc)[2][2][4][2], int m0, int n0, int wr, int wc, int fr, int fq) {
          epi8_foreach(acc, m0, n0, wr, wc, fr, fq, [&](int m, int n, const f32x4& v0, const f32x4& v1) {
            const float rs = rsqrtf(rss[m] * (1.f / 2048.f) + 1e-6f);
            f32x4 a0, a1;
#pragma unroll
            for (int j = 0; j < 4; ++j) { const float t0 = fmaxf(v0[j], 0.f) * rs, t1 = fmaxf(v1[j], 0.f) * rs; a0[j] = t0 * t0; a1[j] = t1 * t1; }
            st_bf8(hid + (size_t)m * 8192 + n, a0, a1);
          });
        });
    } break;
    case 14: {
      const float* hbuf = (const float*)(ws + OFF_H);
      gemm8_phase(smem, (const bfr*)(ws + OFF_HID), (const bfr*)(ws + OFF_WDOWNT), 8192, 32 * 8, G, bid, tid,
        [&](const f32x4 (&acc)[2][2][4][2], int m0, int n0, int wr, int wc, int fr, int fq) {
          epi8_foreach(acc, m0, n0, wr, wc, fr, fq, [&](int m, int n, const f32x4& v0, const f32x4& v1) {
            const float* sp = hbuf + (size_t)m * 2048 + n;
            const f32x4 x0 = *(const f32x4*)sp, x1 = *(const f32x4*)(sp + 4);
            float* dp = p.out + (size_t)m * 2048 + n;
            *(f32x4*)dp = x0 + v0; *(f32x4*)(dp + 4) = x1 + v1;
          });
        });
    } break;
    case 15: {
      for (int it = bid; it < 1024; it += G) {
        const int row = it * 8 + (tid >> 6);
        rmsnorm_row(p.out + (size_t)row * 2048, p.final_norm_w, nullptr, p.out + (size_t)row * 2048, tid);
      }
    } break;
    default: break;
  }
}

DI void fast_grid_barrier(unsigned* ctr, const unsigned target) {
  asm volatile("s_waitcnt vmcnt(0)" ::: "memory");
  __syncthreads();
  if (threadIdx.x == 0) {
    __builtin_amdgcn_fence(__ATOMIC_RELEASE, "agent");
    asm volatile("s_waitcnt vmcnt(0)" ::: "memory");
    __hip_atomic_fetch_add(ctr, 1u, __ATOMIC_RELAXED, __HIP_MEMORY_SCOPE_AGENT);
    unsigned sp = 0;
    while (__hip_atomic_load(ctr, __ATOMIC_RELAXED, __HIP_MEMORY_SCOPE_AGENT) < target) {
      __builtin_amdgcn_s_sleep(1);
      if (++sp > (1u << 22)) break;
    }
    __builtin_amdgcn_fence(__ATOMIC_ACQUIRE, "agent");
    asm volatile("s_waitcnt vmcnt(0)" ::: "memory");
  }
  __syncthreads();
}

__global__ void __launch_bounds__(512, 2) mega(Params p) {
  extern __shared__ __attribute__((aligned(1024))) char smem[];
  __shared__ int slot;
  cg::grid_group grid = cg::this_grid();
  const int wave_s = __builtin_amdgcn_readfirstlane((int)(threadIdx.x >> 6));
  unsigned nbar = 0;
  for (int ph = p.ph_lo; ph < p.ph_hi; ++ph) {
    if (ph == 8 || ph == 12) continue;
    run_phase(p, ph, smem, &slot, wave_s, 0);
#ifdef PROBE_PH
    if (ph == PROBE_PH)
      for (int rep = 1; rep <= PROBE_N; ++rep) { grid.sync(); run_phase(p, ph, smem, &slot, wave_s, rep); }
#endif
    if (ph + 1 < p.ph_hi) {
      if (ph == p.ph_lo) grid.sync();
      else { ++nbar; fast_grid_barrier((unsigned*)(p.ws + OFF_CTR) + 48, nbar * gridDim.x); }
    }
  }
}

extern "C" void kernel_launch(void* const* d_in, const int* in_sizes, int n_in, void* d_out, int out_size, void* d_ws,
                              size_t ws_size, hipStream_t stream) {
  static int grid_blocks = 0;
  if (!grid_blocks) {
    int dev = 0, cus = 0, per_cu = 0;
    (void)hipGetDevice(&dev);
    (void)hipDeviceGetAttribute(&cus, hipDeviceAttributeMultiprocessorCount, dev);
    (void)hipFuncSetAttribute((const void*)mega, hipFuncAttributeMaxDynamicSharedMemorySize, SMEM_BYTES);
    (void)hipOccupancyMaxActiveBlocksPerMultiprocessor(&per_cu, mega, NTHR, SMEM_BYTES);
    if (per_cu < 1) per_cu = 1;
    if (per_cu > 1) per_cu = 1;
    grid_blocks = cus * per_cu;
    grid_blocks &= ~7;
    if (ws_size < WS_END || n_in != 24) { fprintf(stderr, "kernel_launch: ws %zu < %zu or n_in %d\n", ws_size, (size_t)WS_END, n_in); grid_blocks = -1; }
  }
  if (grid_blocks < 0) return;
  Params p{};
  const float** pp = (const float**)&p;
  for (int i = 0; i < 24; ++i) pp[i] = (const float*)d_in[i];
  p.out = (float*)d_out;
  p.ws = (char*)d_ws;
#if ONE_LAUNCH
  p.ph_lo = 0; p.ph_hi = NPHASE;
  void* args[] = {&p};
  hipError_t e = hipLaunchCooperativeKernel((void*)mega, dim3(grid_blocks), dim3(NTHR), args, SMEM_BYTES, stream);
  if (e != hipSuccess) fprintf(stderr, "cooperative launch failed: %s (grid %d)\n", hipGetErrorString(e), grid_blocks);
#else
  for (int ph = 0; ph < NPHASE; ++ph) {
    p.ph_lo = ph; p.ph_hi = ph + 1;
    hipLaunchKernelGGL(mega, dim3(grid_blocks), dim3(NTHR), SMEM_BYTES, stream, p);
  }
#endif
}
```

```cpp
#include <hip/hip_runtime.h>
#include <hip/hip_cooperative_groups.h>
#include <cstdio>
namespace cg = cooperative_groups;

#ifndef ONE_LAUNCH
#define ONE_LAUNCH 1
#endif

#define DI __device__ __forceinline__
typedef unsigned short bfr;
using bf16x8 = __attribute__((ext_vector_type(8))) short;
using s16x4 = __attribute__((ext_vector_type(4))) short;
using f32x16 = __attribute__((ext_vector_type(16))) float;
using u32x4 = __attribute__((ext_vector_type(4))) unsigned;
#define MFMA(a, b, c) __builtin_amdgcn_mfma_f32_32x32x16_bf16((a), (b), (c), 0, 0, 0)

constexpr int DM = 2048, SEQ = 2048, NTOK = 8192;
constexpr int ZS = 15488;
constexpr int ZC_Q = 0, ZC_KC = 2048, ZC_VC = 2560, ZC_KS = 3072, ZC_VS = 3584, ZC_KW = 4096, ZC_VW = 4608,
              ZC_QR = 5120, ZC_KR = 6144, ZC_VR = 7168, ZC_GR = 9216, ZC_GA = 11264, ZC_GB = 13312, ZC_GN = 15360;
constexpr int NPHASE = 16;

constexpr int ZSP = 15616;
constexpr size_t SZ_WINT = (size_t)ZSP * 2048 * 2;
constexpr size_t SZ_ACT = (size_t)NTOK * 2048 * 2;
constexpr size_t OFF_WINT = 0;
constexpr size_t OFF_N = OFF_WINT + SZ_WINT;
constexpr size_t OFF_MERGED = OFF_WINT;
constexpr size_t OFF_ORET = OFF_N;
constexpr size_t OFF_WUPT = 0;
constexpr size_t OFF_WDOWNT = SZ_ACT;
constexpr size_t OFF_Z = OFF_N + SZ_ACT;
constexpr size_t SZ_Z = (size_t)NTOK * ZS * 2;
constexpr size_t OFF_HID = OFF_Z;
constexpr size_t OFF_H = OFF_Z + (size_t)NTOK * 8192 * 2;
constexpr size_t OFF_NX = OFF_H + (size_t)NTOK * 2048 * 4;
constexpr size_t OFF_QX = OFF_NX + SZ_ACT;
constexpr size_t OFF_OX = OFF_QX + (size_t)NTOK * 512 * 2;
static_assert(OFF_OX + (size_t)NTOK * 512 * 2 <= OFF_Z + SZ_Z, "alias overflow");
constexpr size_t OFF_ZC = OFF_Z + SZ_Z;
constexpr size_t OFF_MN = OFF_ZC + (size_t)NTOK * 2048 * 2;
constexpr size_t OFF_W1T = OFF_MN + (size_t)1024 * 2048 * 2;
constexpr size_t OFF_W2T = OFF_W1T + (size_t)2 * 1024 * 4096 * 2;
constexpr size_t OFF_WAT = OFF_W2T + (size_t)2 * 128 * 1024 * 2;
constexpr size_t OFF_WBT = OFF_WAT + (size_t)2048 * 2048 * 2;
constexpr size_t OFF_WOUTT = OFF_WBT + (size_t)2048 * 2048 * 2;
constexpr size_t OFF_WQT = OFF_WOUTT + (size_t)2048 * 2048 * 2;
constexpr size_t OFF_WKT = OFF_WQT + (size_t)512 * 2048 * 2;
constexpr size_t OFF_WVT = OFF_WKT + (size_t)512 * 2048 * 2;
constexpr size_t OFF_WOT = OFF_WVT + (size_t)512 * 2048 * 2;
constexpr size_t OFF_ROPE = OFF_WOT + (size_t)512 * 2048 * 2;
constexpr size_t OFF_HIDC = OFF_ROPE + (size_t)2048 * 64 * 8;
constexpr size_t OFF_KCVC = OFF_HIDC + (size_t)2 * 2048 * 1024 * 2;
constexpr size_t OFF_SELM = OFF_KCVC + (size_t)2 * 2048 * 128 * 2;
constexpr size_t OFF_ONSA = OFF_SELM + (size_t)16 * 2048 * 4;
constexpr size_t OFF_KX = OFF_ONSA + SZ_ACT;
constexpr size_t OFF_VX = OFF_KX + (size_t)1024 * 512 * 2;
constexpr size_t OFF_RSTAT = OFF_VX + (size_t)1024 * 512 * 2;
constexpr size_t OFF_CTR = OFF_RSTAT + (size_t)NTOK * 8 * 2 * 2 * 4;
constexpr size_t OFF_BAR = OFF_CTR + 256;
constexpr size_t OFF_ROWSS = OFF_BAR + 256;
constexpr size_t WS_END = OFF_ROWSS + (size_t)2 * NTOK * 4;

struct Params {
  const float *x, *mem, *attn_norm_w, *w_in, *pe_k, *w1k, *w2k, *pe_v, *w1v, *w2v, *w_a, *gn_w, *w_b, *w_out, *x_norm_w,
      *mem_norm_w, *wq, *wk, *wv, *wo, *mlp_norm_w, *w_up, *w_down, *final_norm_w;
  float* out;
  char* ws;
  int ph_lo, ph_hi;
  int dbg, pad;
};

constexpr int NTHR = 512;
constexpr int SMEM_BYTES = 131072;
__device__ const float ROPE_INV[64] = {1.0f, 0.865964353f, 0.749894261f, 0.649381638f, 0.562341332f, 0.486967534f, 0.421696514f, 0.365174115f, 0.316227764f, 0.273841977f, 0.237137377f, 0.2053525f, 0.177827939f, 0.153992653f, 0.133352131f, 0.115478203f, 0.100000001f, 0.0865964293f, 0.0749894157f, 0.0649381652f, 0.0562341325f, 0.0486967526f, 0.0421696529f, 0.0365174115f, 0.0316227749f, 0.0273841973f, 0.0237137377f, 0.0205352511f, 0.0177827943f, 0.0153992651f, 0.0133352149f, 0.0115478206f, 0.00999999978f, 0.00865964312f, 0.00749894185f, 0.00649381615f, 0.00562341325f, 0.00486967526f, 0.00421696482f, 0.00365174119f, 0.00316227763f, 0.00273841969f, 0.00237137359f, 0.00205352483f, 0.00177827943f, 0.00153992651f, 0.00133352145f, 0.0011547819f, 0.00100000005f, 0.000865964335f, 0.000749894243f, 0.000649381662f, 0.000562341302f, 0.000486967532f, 0.000421696517f, 0.000365174143f, 0.000316227757f, 0.000273841957f, 0.00023713737f, 0.00020535251f, 0.00017782794f, 0.000153992645f, 0.00013335215f, 0.0001154782f};

DI unsigned pack2(float a, float b) {
  typedef float f2 __attribute__((ext_vector_type(2)));
  typedef __bf16 b2 __attribute__((ext_vector_type(2)));
  f2 v = {a, b};
  b2 r = __builtin_convertvector(v, b2);
  return __builtin_bit_cast(unsigned, r);
}
DI float bflo(unsigned u) { return __uint_as_float(u << 16); }
DI float bfhi(unsigned u) { return __uint_as_float(u & 0xffff0000u); }
DI void st_bf4(bfr* p, float a, float b, float c, float d) {
  uint2 v; v.x = pack2(a, b); v.y = pack2(c, d);
  *(uint2*)p = v;
}
DI float wave_sum(float v) {
#pragma unroll
  for (int o = 32; o > 0; o >>= 1) v += __shfl_xor(v, o);
  return v;
}
DI float sigmoidf_(float x) { return __builtin_amdgcn_rcpf(1.f + __expf(-x)); }
DI int crow(int i, int h) { return (i & 3) + 8 * (i >> 2) + 4 * h; }
DI bf16x8 pack8(const f32x16& x, int s) {
  unsigned a = pack2(x[8 * s], x[8 * s + 1]), b = pack2(x[8 * s + 2], x[8 * s + 3]), c = pack2(x[8 * s + 4], x[8 * s + 5]),
           d = pack2(x[8 * s + 6], x[8 * s + 7]);
  typedef unsigned u4 __attribute__((ext_vector_type(4)));
  u4 v = {a, b, c, d};
  return __builtin_bit_cast(bf16x8, v);
}
DI s16x4 tr_read(const bfr* p) {
  return __builtin_amdgcn_ds_read_tr16_b64_v4i16((__attribute__((address_space(3))) s16x4*)(p));
}

struct TJob { const float* src; bfr* dst; int K, N, ntn, perm; const float* kscale; };
DI TJob get_tjob(const Params& p, int j) {
  TJob t;
  char* ws = p.ws;
  switch (j) {
    case 0: t = {p.w_in, (bfr*)(ws + OFF_WINT), 2048, 15408, 122, 1, nullptr}; break;
    case 1: t = {p.wk, (bfr*)(ws + OFF_WKT), 2048, 512, 4, 0, nullptr}; break;
    case 2: t = {p.wv, (bfr*)(ws + OFF_WVT), 2048, 512, 4, 0, nullptr}; break;
    case 3: t = {p.w1k, (bfr*)(ws + OFF_W1T), 4096, 1024, 8, 0, nullptr}; break;
    case 4: t = {p.w1v, (bfr*)(ws + OFF_W1T) + (size_t)1024 * 4096, 4096, 1024, 8, 0, nullptr}; break;
    case 5: t = {p.w2k, (bfr*)(ws + OFF_W2T), 1024, 128, 1, 0, nullptr}; break;
    case 6: t = {p.w2v, (bfr*)(ws + OFF_W2T) + (size_t)128 * 1024, 1024, 128, 1, 0, nullptr}; break;
    case 7: t = {p.w_a, (bfr*)(ws + OFF_WAT), 2048, 2048, 16, 0, nullptr}; break;
    case 8: t = {p.w_b, (bfr*)(ws + OFF_WBT), 2048, 2048, 16, 0, nullptr}; break;
    case 9: t = {p.w_out, (bfr*)(ws + OFF_WOUTT), 2048, 2048, 16, 0, nullptr}; break;
    case 10: t = {p.wq, (bfr*)(ws + OFF_WQT), 2048, 512, 4, 0, p.x_norm_w}; break;
    case 11: t = {p.wo, (bfr*)(ws + OFF_WOT), 512, 2048, 16, 0, nullptr}; break;
    case 12: t = {p.w_up, (bfr*)(ws + OFF_WUPT), 2048, 8192, 64, 0, p.mlp_norm_w}; break;
    default: t = {p.w_down, (bfr*)(ws + OFF_WDOWNT), 8192, 2048, 16, 0, nullptr}; break;
  }
  return t;
}
DI int tjob_tiles(int j) {
  switch (j) {
    case 0: return 122 * 16;
    case 1: case 2: return 4 * 16;
    case 3: case 4: return 8 * 32;
    case 5: case 6: return 1 * 8;
    case 7: case 8: case 9: return 16 * 16;
    case 10: return 4 * 16;
    case 11: return 16 * 4;
    case 12: return 64 * 16;
    default: return 16 * 64;
  }
}
struct TrRegs { float4 v[8]; };
DI void tr_load(const TJob& t, int tile, TrRegs& rg, const int tid) {
  const int nkt = t.K >> 7;
  const int kt = tile % nkt, nt = tile / nkt;
  const int k0 = kt * 128, d0 = nt * 128;
  int scol0 = d0, nvalid = 128;
  if (t.perm) {
    if (d0 < 5120) scol0 = d0;
    else if (d0 < 15360) scol0 = d0 + 48;
    else { scol0 = d0 - 15360 + 5120; nvalid = (d0 == 15360) ? 48 : 0; }
  }
#pragma unroll
  for (int i = 0; i < 8; ++i) {
    const int row = i * 16 + (tid >> 5), col = (tid & 31) * 4;
    rg.v[i] = make_float4(0.f, 0.f, 0.f, 0.f);
    if (col < nvalid) rg.v[i] = *(const float4*)(t.src + (size_t)(k0 + row) * t.N + scol0 + col);
    if (t.kscale) { const float sc = t.kscale[k0 + row]; rg.v[i].x *= sc; rg.v[i].y *= sc; rg.v[i].z *= sc; rg.v[i].w *= sc; }
  }
}
DI void tr_to_lds(const TrRegs& rg, float* sm, const int tid) {
#pragma unroll
  for (int i = 0; i < 8; ++i) {
    const int row = i * 16 + (tid >> 5), col = (tid & 31) * 4;
    float* d = sm + row * 129 + col;
    d[0] = rg.v[i].x; d[1] = rg.v[i].y; d[2] = rg.v[i].z; d[3] = rg.v[i].w;
  }
}
DI void tr_store(const TJob& t, int tile, const float* sm, const int tid) {
  const int nkt = t.K >> 7;
  const int kt = tile % nkt, nt = tile / nkt;
  const int k0 = kt * 128, d0 = nt * 128;
  const int n = tid >> 2, kq = (tid & 3) * 8;
  bfr* drow = t.dst + (size_t)(d0 + n) * t.K + k0 + kq;
#pragma unroll
  for (int q = 0; q < 4; ++q) {
    const int kb = kq + 32 * q;
    const unsigned o0 = pack2(sm[(kb + 0) * 129 + n], sm[(kb + 1) * 129 + n]);
    const unsigned o1 = pack2(sm[(kb + 2) * 129 + n], sm[(kb + 3) * 129 + n]);
    const unsigned o2 = pack2(sm[(kb + 4) * 129 + n], sm[(kb + 5) * 129 + n]);
    const unsigned o3 = pack2(sm[(kb + 6) * 129 + n], sm[(kb + 7) * 129 + n]);
    *(uint4*)(drow + 32 * q) = make_uint4(o0, o1, o2, o3);
  }
}
DI void tr_decode(int it, int j_lo, int& j, int& rem) {
  j = j_lo; rem = it;
  while (rem >= tjob_tiles(j)) { rem -= tjob_tiles(j); ++j; }
}
DI void tr_run(const Params& p, int j_lo, int it0, int stride, int n_tiles, float* sm, const int tid) {
  if (it0 >= n_tiles) return;
  TrRegs rg;
  int j, rem;
  tr_decode(it0, j_lo, j, rem);
  TJob t = get_tjob(p, j);
  tr_load(t, rem, rg, tid);
  for (int it = it0; it < n_tiles; it += stride) {
    __syncthreads();
    tr_to_lds(rg, sm, tid);
    __syncthreads();
    const TJob tc = t;
    const int remc = rem;
    const int nx = it + stride;
    if (nx < n_tiles) {
      tr_decode(nx, j_lo, j, rem);
      t = get_tjob(p, j);
      tr_load(t, rem, rg, tid);
    }
    tr_store(tc, remc, sm, tid);
  }
  __syncthreads();
}

DI void rmsnorm_row(const float* xrow, const float* w, bfr* obf, float* of32, const int tid) {
  const int lane = tid & 63;
  float4 v[8];
  float ss = 0.f;
#pragma unroll
  for (int i = 0; i < 8; ++i) {
    v[i] = ((const float4*)xrow)[lane + 64 * i];
    ss += v[i].x * v[i].x + v[i].y * v[i].y + v[i].z * v[i].z + v[i].w * v[i].w;
  }
  ss = wave_sum(ss);
  const float rs = rsqrtf(ss * (1.f / 2048.f) + 1e-6f);
#pragma unroll
  for (int i = 0; i < 8; ++i) {
    const float4 ww = ((const float4*)w)[lane + 64 * i];
    const float a = v[i].x * rs * ww.x, b = v[i].y * rs * ww.y, c = v[i].z * rs * ww.z, d = v[i].w * rs * ww.w;
    if (obf) st_bf4(obf + (lane + 64 * i) * 4, a, b, c, d);
    else ((float4*)of32)[lane + 64 * i] = make_float4(a, b, c, d);
  }
}

struct PlainPtr {
  const bfr* base; int ld;
  DI int rowoff(int row) const { return row * ld; }
  DI int koff(int k0) const { return k0; }
};
#define WAIT_V(n) asm volatile("s_waitcnt vmcnt(%0)" ::"n"(n) : "memory")
#define WAIT_L(n) asm volatile("s_waitcnt lgkmcnt(%0)" ::"n"(n) : "memory")
#define RAW_BARRIER() do { WAIT_L(0); __builtin_amdgcn_s_barrier(); } while (0)
typedef __attribute__((address_space(3))) unsigned lds_u32;
constexpr int STAGE_B = 65536;
template <int NI, class AF, class BF>
DI void gemm_main(f32x16 (&acc)[NI][4], const AF& af, const BF& bf, int nk, char* smem, const int tid) {
  const int lane = tid & 63, r = lane & 31, h = lane >> 5;
  const int w = __builtin_amdgcn_readfirstlane(tid >> 6);
  const int wm = w & 1, wn = w >> 1;
  int ao[4], bo[2 * NI];
  {
    const int rl = lane >> 3, kc = (lane & 7) ^ (((w & 1) * 4 + (lane >> 4)) & 7);
#pragma unroll
    for (int i = 0; i < 4; ++i) ao[i] = af.rowoff((w + 8 * i) * 8 + rl) + 8 * kc;
#pragma unroll
    for (int i = 0; i < 2 * NI; ++i) bo[i] = bf.rowoff((w + 8 * i) * 8 + rl) + 8 * kc;
  }
  auto stage = [&](int buf, int kt) {
    const int ka = af.koff(kt * 64), kb = bf.koff(kt * 64);
    char* sbase = smem + buf * STAGE_B + w * 1024;
#pragma unroll
    for (int i = 0; i < 4; ++i)
      __builtin_amdgcn_global_load_lds((const unsigned*)(af.base + (ao[i] + ka)), (lds_u32*)(sbase + i * 8192), 16, 0, 0);
#pragma unroll
    for (int i = 0; i < 2 * NI; ++i)
      __builtin_amdgcn_global_load_lds((const unsigned*)(bf.base + (bo[i] + kb)), (lds_u32*)(sbase + 32768 + i * 8192), 16, 0, 0);
  };
  const int xr = (r >> 1) & 7;
  const int arow = (wm * 128 + r) * 128, brow = 32768 + (wn * 32 * NI + r) * 128;
  WAIT_V(0);
  __syncthreads();
  stage(0, 0);
  WAIT_V(0);
  RAW_BARRIER();
#pragma unroll 1
  for (int kt = 0; kt < nk; ++kt) {
    if (kt + 1 < nk) stage((kt + 1) & 1, kt + 1);
    const char* sb = smem + (kt & 1) * STAGE_B;
#pragma unroll
    for (int ks = 0; ks < 4; ++ks) {
      const int off = ((2 * ks + h) ^ xr) * 16;
      bf16x8 wf[NI], xf[4];
#pragma unroll
      for (int i = 0; i < NI; ++i) wf[i] = *(const bf16x8*)(sb + brow + i * 4096 + off);
#pragma unroll
      for (int i = 0; i < 4; ++i) xf[i] = *(const bf16x8*)(sb + arow + i * 4096 + off);
#pragma unroll
      for (int mi = 0; mi < 4; ++mi)
#pragma unroll
        for (int ni = 0; ni < NI; ++ni) acc[ni][mi] = MFMA(wf[ni], xf[mi], acc[ni][mi]);
    }
    WAIT_V(0);
    RAW_BARRIER();
  }
}
template <int NI>
DI void acc_zero(f32x16 (&acc)[NI][4]) {
#pragma unroll
  for (int a = 0; a < NI; ++a)
#pragma unroll
    for (int b = 0; b < 4; ++b)
#pragma unroll
      for (int i = 0; i < 16; ++i) acc[a][b][i] = 0.f;
}
template <int NI, class EPI>
DI void gemm_epi(const f32x16 (&acc)[NI][4], int m0, int n0, const int tid_in, const EPI& epi) {
  int tid = tid_in;
  asm volatile("" : "+v"(tid));
  const int lane = tid & 63, w = tid >> 6, r = lane & 31, h = lane >> 5;
  const int wm = w & 1, wn = w >> 1;
#pragma unroll
  for (int mi = 0; mi < 4; ++mi)
#pragma unroll
    for (int ni = 0; ni < NI; ++ni)
#pragma unroll
      for (int g = 0; g < 4; ++g) {
        const int n = n0 + wn * 32 * NI + ni * 32 + 8 * g + 4 * h;
        const int m = m0 + wm * 128 + mi * 32 + r;
        epi(m, n, acc[ni][mi][4 * g], acc[ni][mi][4 * g + 1], acc[ni][mi][4 * g + 2], acc[ni][mi][4 * g + 3]);
      }
}
DI void gemm_epi_resid(const f32x16 (&acc)[2][4], int m0, int n0, const int tid_in, const float* hsrc, float* hdst, bfr* hb, float* rowss) {
  int tid = tid_in;
  asm volatile("" : "+v"(tid));
  const int lane = tid & 63, w = tid >> 6, r = lane & 31, h = lane >> 5;
  const int wm = w & 1, wn = w >> 1;
#pragma unroll
  for (int mi = 0; mi < 4; ++mi) {
    const int m = m0 + wm * 128 + mi * 32 + r;
    float ss = 0.f;
#pragma unroll
    for (int ni = 0; ni < 2; ++ni)
#pragma unroll
      for (int g = 0; g < 4; ++g) {
        const int n = n0 + wn * 64 + ni * 32 + 8 * g + 4 * h;
        const float4 xv = *(const float4*)(hsrc + (size_t)m * 2048 + n);
        const float a = xv.x + acc[ni][mi][4 * g], b = xv.y + acc[ni][mi][4 * g + 1], c = xv.z + acc[ni][mi][4 * g + 2], d = xv.w + acc[ni][mi][4 * g + 3];
        *(float4*)(hdst + (size_t)m * 2048 + n) = make_float4(a, b, c, d);
        st_bf4(hb + (size_t)m * 2048 + n, a, b, c, d);
        ss += a * a + b * b + c * c + d * d;
      }
    ss += __shfl_xor(ss, 32);
    if (h == 0) atomicAdd(rowss + m, ss);
  }
}
DI void map_tile32(int v, int& mt, int& nt) {
  const int xcd = v & 7, j = v >> 3;
  nt = j >> 2;
  mt = xcd * 4 + (j & 3);
}


using f32x4 = __attribute__((ext_vector_type(4))) float;
typedef __attribute__((address_space(3))) unsigned char lds_u8;
constexpr int HTB = 128 * 64 * 2;
DI int lds_byte8(int r, int c) { const int st = (r >> 4) * 2 + (c >> 5), rr = r & 15, cc = c & 31, ob = rr * 64 + cc * 2; return st * 1024 + (ob ^ (((ob >> 9) & 1) << 5)); }
DI void stage_rc8(int b, int& R, int& C) { const int st = b / 1024, sb = b % 1024, swz = sb ^ (((sb >> 9) & 1) << 5); R = (st >> 1) * 16 + swz / 64; C = (st & 1) * 32 + (swz % 64) / 2; }
DI int perm32(int rho) { const int n = rho >> 4, i = rho & 15; return 8 * (i >> 2) + 4 * n + (i & 3); }
DI bool unit_next(int i, int G, int bid, int nunits, int& pm, int& pn) {
  const int v = bid + i * G;
  if (v >= nunits) return false;
  const int xcd = v & 7, j = v >> 3;
  pn = j >> 2;
  pm = xcd * 4 + (j & 3);
  return true;
}
template <class Epi>
DI void gemm8_phase(char* smem, const bfr* A, const bfr* Bt, const int K, const int nunits, const int G, const int bid, const int tid, const Epi& E) {
  lds_u8* lds = (lds_u8*)smem;
  const int wid = __builtin_amdgcn_readfirstlane(tid >> 6), lane = tid & 63, wr = wid >> 2, wc = wid & 3, fr = lane & 15, fq = lane >> 4;
  const int nt = K / 64;
  unsigned voffA[2], voffB[2];
#pragma unroll
  for (int i = 0; i < 2; ++i) {
    int R, C;
    stage_rc8(tid * 16 + i * 8192, R, C);
    const int Rb = (R & ~31) + perm32(R & 31);
    voffA[i] = (unsigned)(R * K + C) * 2u;
    voffB[i] = (unsigned)(Rb * K + C) * 2u;
  }
  const size_t kstep = 128;
  const size_t hstep = (size_t)128 * K * 2;
  const size_t tstep = 2 * hstep;
  const unsigned ldsw = (unsigned)wid * 1024u;
  const int aoff = lds_byte8(wr * 64 + fr, fq * 8), boff = lds_byte8(wc * 32 + fr, fq * 8);
#define PG8_SA(b, h) (((b) * 2 + (h)) * HTB)
#define PG8_SB(b, h) ((4 + (b) * 2 + (h)) * HTB)
#define PG8_STAGE(bufoff, gbase, voff) do { _Pragma("unroll") for (int _i = 0; _i < 2; ++_i) \
    __builtin_amdgcn_global_load_lds((const unsigned*)((const char*)(gbase) + (voff)[_i]), (lds_u32*)(lds + (bufoff) + ldsw + _i * 8192), 16, 0, 0); } while (0)
#define PG8_LDA(dst, b, h) do { _Pragma("unroll") for (int m = 0; m < 4; ++m) _Pragma("unroll") for (int k = 0; k < 2; ++k) dst[m][k] = *(const __attribute__((address_space(3))) bf16x8*)(lds + PG8_SA(b, h) + aoff + m * 2048 + k * 1024); } while (0)
#define PG8_LDB(dst, b, h) do { _Pragma("unroll") for (int n = 0; n < 2; ++n) _Pragma("unroll") for (int k = 0; k < 2; ++k) dst[n][k] = *(const __attribute__((address_space(3))) bf16x8*)(lds + PG8_SB(b, h) + boff + n * 2048 + k * 1024); } while (0)
#define PG8_MMA(ai, bj, At, Bt_) do { __builtin_amdgcn_s_setprio(1); _Pragma("unroll") for (int m = 0; m < 4; ++m) _Pragma("unroll") for (int n = 0; n < 2; ++n) _Pragma("unroll") for (int k = 0; k < 2; ++k) \
    acc[ai][bj][m][n] = __builtin_amdgcn_mfma_f32_16x16x32_bf16(Bt_[n][k], At[m][k], acc[ai][bj][m][n], 0, 0, 0); __builtin_amdgcn_s_setprio(0); } while (0)
#define PG8_BAR __builtin_amdgcn_s_barrier()
#define PG8_SCHED __builtin_amdgcn_sched_barrier(0)
  int cpm, cpn, npm = 0, npn = 0, ui = 0;
  if (!unit_next(0, G, bid, nunits, cpm, cpn)) return;
  WAIT_V(0);
  __syncthreads();
  f32x4 acc[2][2][4][2];
#pragma unroll
  for (int a = 0; a < 2; ++a)
#pragma unroll
    for (int b = 0; b < 2; ++b)
#pragma unroll
      for (int m = 0; m < 4; ++m)
#pragma unroll
        for (int n = 0; n < 2; ++n) acc[a][b][m][n] = (f32x4){0.f, 0.f, 0.f, 0.f};
  bf16x8 At[4][2], B0[2][2], B1[2][2];
  const char* cA = (const char*)A + (size_t)cpm * tstep;
  const char* cB = (const char*)Bt + (size_t)cpn * tstep;
  PG8_STAGE(PG8_SB(0, 0), cB, voffB); PG8_STAGE(PG8_SA(0, 0), cA, voffA); PG8_STAGE(PG8_SB(0, 1), cB + hstep, voffB); PG8_STAGE(PG8_SA(0, 1), cA + hstep, voffA);
  if (wr == 1) PG8_BAR;
  WAIT_V(4); PG8_BAR;
  PG8_STAGE(PG8_SB(1, 0), cB + kstep, voffB); PG8_STAGE(PG8_SA(1, 0), cA + kstep, voffA); PG8_STAGE(PG8_SB(1, 1), cB + hstep + kstep, voffB);
  WAIT_V(6); PG8_BAR;
  for (;;) {
    const bool has_next = unit_next(ui + 1, G, bid, nunits, npm, npn);
    const char* nA = has_next ? (const char*)A + (size_t)npm * tstep : cA;
    const char* nB = has_next ? (const char*)Bt + (size_t)npn * tstep : cB;
#pragma unroll 1
    for (int t = 0; t < nt; t += 2) {
      const bool last = (t == nt - 2);
      const char* a1 = cA + (size_t)(t + 1) * kstep;
      const char* a2 = last ? nA : cA + (size_t)(t + 2) * kstep;
      const char* b2 = last ? nB : cB + (size_t)(t + 2) * kstep;
      const char* a3 = a2 + kstep;
      const char* b3 = b2 + kstep;
      PG8_LDB(B0, 0, 0); PG8_SCHED; PG8_LDA(At, 0, 0); PG8_STAGE(PG8_SA(1, 1), a1 + hstep, voffA);
      WAIT_L(8); PG8_BAR; WAIT_L(0); PG8_MMA(0, 0, At, B0); PG8_BAR; PG8_SCHED;
      PG8_LDB(B1, 0, 1); PG8_STAGE(PG8_SB(0, 0), b2, voffB);
      PG8_BAR; WAIT_L(0); PG8_MMA(0, 1, At, B1); PG8_BAR;
      PG8_LDA(At, 0, 1); PG8_STAGE(PG8_SA(0, 0), a2, voffA);
      PG8_BAR; WAIT_L(0); PG8_MMA(1, 0, At, B0); PG8_BAR; PG8_SCHED;
      PG8_STAGE(PG8_SB(0, 1), b2 + hstep, voffB);
      WAIT_V(6); PG8_BAR; PG8_MMA(1, 1, At, B1); PG8_BAR;
      PG8_LDB(B0, 1, 0); PG8_SCHED; PG8_LDA(At, 1, 0); PG8_STAGE(PG8_SA(0, 1), a2 + hstep, voffA);
      WAIT_L(8); PG8_BAR; WAIT_L(0); PG8_MMA(0, 0, At, B0); PG8_BAR; PG8_SCHED;
      PG8_LDB(B1, 1, 1); PG8_STAGE(PG8_SB(1, 0), b3, voffB);
      PG8_BAR; WAIT_L(0); PG8_MMA(0, 1, At, B1); PG8_BAR;
      PG8_LDA(At, 1, 1); PG8_STAGE(PG8_SA(1, 0), a3, voffA);
      PG8_BAR; WAIT_L(0); PG8_MMA(1, 0, At, B0); PG8_BAR; PG8_SCHED;
      PG8_STAGE(PG8_SB(1, 1), b3 + hstep, voffB);
      WAIT_V(6); PG8_BAR; PG8_MMA(1, 1, At, B1); PG8_BAR;
    }
    E(acc, cpm * 256, cpn * 256, wr, wc, fr, fq);
    if (!has_next) break;
#pragma unroll
    for (int a = 0; a < 2; ++a)
#pragma unroll
      for (int b = 0; b < 2; ++b)
#pragma unroll
        for (int m = 0; m < 4; ++m)
#pragma unroll
          for (int n = 0; n < 2; ++n) acc[a][b][m][n] = (f32x4){0.f, 0.f, 0.f, 0.f};
    cpm = npm; cpn = npn; cA = nA; cB = nB; ++ui;
  }
  WAIT_V(0);
  if (wr == 0) PG8_BAR;
  PG8_BAR;
#undef PG8_SA
#undef PG8_SB
#undef PG8_STAGE
#undef PG8_LDA
#undef PG8_LDB
#undef PG8_MMA
#undef PG8_BAR
#undef PG8_SCHED
}
template <class F>
DI void epi8_foreach(const f32x4 (&acc)[2][2][4][2], int m0, int n0, int wr, int wc, int fr, int fq, const F& f) {
#pragma unroll
  for (int ai = 0; ai < 2; ++ai)
#pragma unroll
    for (int m = 0; m < 4; ++m) {
      const int row = m0 + ai * 128 + wr * 64 + m * 16 + fr;
#pragma unroll
      for (int bj = 0; bj < 2; ++bj) f(row, n0 + bj * 128 + wc * 32 + 8 * fq, acc[ai][bj][m][0], acc[ai][bj][m][1]);
    }
}
DI void st_bf8(bfr* p, const f32x4& v0, const f32x4& v1) {
  u32x4 w;
  w[0] = pack2(v0[0], v0[1]); w[1] = pack2(v0[2], v0[3]); w[2] = pack2(v1[0], v1[1]); w[3] = pack2(v1[2], v1[3]);
  *(u32x4*)p = w;
}

DI void epi8_resid(const f32x4 (&acc)[2][2][4][2], int m0, int n0, int wr, int wc, int fr, int fq, const float* hsrc, float* hdst, bfr* hb, float* rowss) {
#pragma unroll
  for (int ai = 0; ai < 2; ++ai)
#pragma unroll
    for (int m = 0; m < 4; ++m) {
      const int row = m0 + ai * 128 + wr * 64 + m * 16 + fr;
      float ss = 0.f;
#pragma unroll
      for (int bj = 0; bj < 2; ++bj) {
        const int n = n0 + bj * 128 + wc * 32 + 8 * fq;
        const float* sp = hsrc + (size_t)row * 2048 + n;
        const f32x4 x0 = *(const f32x4*)sp, x1 = *(const f32x4*)(sp + 4);
        const f32x4 y0 = x0 + acc[ai][bj][m][0], y1 = x1 + acc[ai][bj][m][1];
        float* dp = hdst + (size_t)row * 2048 + n;
        *(f32x4*)dp = y0; *(f32x4*)(dp + 4) = y1;
        st_bf8(hb + (size_t)row * 2048 + n, y0, y1);
        ss += y0[0] * y0[0] + y0[1] * y0[1] + y0[2] * y0[2] + y0[3] * y0[3] + y1[0] * y1[0] + y1[1] * y1[1] + y1[2] * y1[2] + y1[3] * y1[3];
      }
      ss += __shfl_xor(ss, 16);
      ss += __shfl_xor(ss, 32);
      if (fq == 0) atomicAdd(rowss + row, ss);
    }
}
enum { MODE_WIN = 0, MODE_SEL = 1, MODE_X = 2, MODE_RET = 3 };
constexpr int KP = 136;

template <int MODE>
DI void attn_item(const Params& p, int item, char* smem, const int tid) {
  constexpr int VP = 136;
  bfr* Ks = (bfr*)smem;
  bfr* Vs = Ks + 64 * KP;
  const int w = tid >> 6, lane = tid & 63, r = lane & 31, h = lane >> 5;
  bfr* Qw = Vs + 64 * VP + w * 32 * KP;
  char* ws = p.ws;
  const bfr* z = (const bfr*)(ws + OFF_Z);

  int b, t0, tq0, jlo, jhi, head = 0, grp = 0, vh = 0;
  const bfr *qbase, *kbase, *vbase;
  int ldq, ldk;
  unsigned selm = 0, umask = 0xffffffffu;
  if (MODE == MODE_WIN) {
    const int tb = item >> 4, bg = item & 15;
    b = bg >> 2; grp = bg & 3; t0 = tb * 64; tq0 = t0 + 32 * (w >> 2); head = grp * 4 + (w & 3);
    qbase = z + (size_t)(b * SEQ + tq0) * ZS + ZC_Q + head * 128; ldq = ZS;
    kbase = z + (size_t)(b * SEQ) * ZS + ZC_KW + grp * 128;
    vbase = z + (size_t)(b * SEQ) * ZS + ZC_VW + grp * 128;
    ldk = ZS;
    jlo = (t0 - 511 > 0 ? t0 - 511 : 0) >> 6;
    jhi = tb;
  } else if (MODE == MODE_SEL) {
    const int tb = 31 - (item >> 4), bg = item & 15;
    b = bg >> 2; grp = bg & 3; t0 = tb * 64; tq0 = t0 + 32 * (w >> 2); head = grp * 4 + (w & 3);
    qbase = z + (size_t)(b * SEQ + tq0) * ZS + ZC_Q + head * 128; ldq = ZS;
    kbase = z + (size_t)(b * SEQ) * ZS + ZC_KS + grp * 128;
    vbase = z + (size_t)(b * SEQ) * ZS + ZC_VS + grp * 128;
    ldk = ZS;
    jlo = 0;
    jhi = tb;
    const unsigned* sm = (const unsigned*)(ws + OFF_SELM) + (b * 4 + grp) * SEQ;
    selm = sm[tq0 + r];
    unsigned u = sm[t0 + lane];
#pragma unroll
    for (int o = 32; o > 0; o >>= 1) u |= (unsigned)__shfl_xor((int)u, o);
    umask = (unsigned)__builtin_amdgcn_readfirstlane((int)u);
    umask &= (jhi >= 31) ? 0xffffffffu : ((1u << (jhi + 1)) - 1u);
  } else if (MODE == MODE_X) {
    const int tb = item >> 4, bh = item & 15;
    b = bh >> 2; head = bh & 3; t0 = tb * 256; tq0 = t0 + 32 * w;
    qbase = (const bfr*)(ws + OFF_QX) + (size_t)(b * SEQ + tq0) * 512 + head * 128; ldq = 512;
    kbase = (const bfr*)(ws + OFF_KX) + (size_t)(b * 256) * 512 + head * 128;
    vbase = (const bfr*)(ws + OFF_VX) + (size_t)(b * 256) * 512 + head * 128;
    ldk = 512;
    jlo = 0; jhi = 3;
  } else {
    const int tb = 7 - (item >> 6), rest = item & 63;
    b = rest >> 4; head = (rest >> 1) & 7; vh = rest & 1; t0 = tb * 256; tq0 = t0 + 32 * w;
    qbase = z + (size_t)(b * SEQ + tq0) * ZS + ZC_QR + head * 128; ldq = ZS;
    kbase = z + (size_t)(b * SEQ) * ZS + ZC_KR + head * 128;
    vbase = z + (size_t)(b * SEQ) * ZS + ZC_VR + head * 256 + vh * 128;
    ldk = ZS;
    jlo = 0; jhi = 4 * tb + 3;
  }
  const int tq = tq0 + r;

  f32x16 o[4];
#pragma unroll
  for (int dt = 0; dt < 4; ++dt)
#pragma unroll
    for (int i = 0; i < 16; ++i) o[dt][i] = 0.f;
  float m_run = -INFINITY, l_run = 0.f;
  float lg = 0.f;
  float rf[16];
  if (MODE == MODE_RET) {
    lg = log1pf(-exp2f(-5.f - (float)head)) * 1.4426950408889634f;
#pragma unroll
    for (int i = 0; i < 16; ++i) rf[i] = __builtin_amdgcn_exp2f(-lg * (float)crow(i, h));
  }

  u32x4 kreg[2], vreg[2];
  auto gload = [&](int j) {
    const int k0 = j * 64;
#pragma unroll
    for (int i = 0; i < 2; ++i) {
      const int c = tid + 512 * i, row = c >> 4, cc = c & 15;
      kreg[i] = *(const u32x4*)(kbase + (size_t)(k0 + row) * ldk + cc * 8);
      vreg[i] = *(const u32x4*)(vbase + (size_t)(k0 + row) * ldk + cc * 8);
    }
  };
  auto swrite = [&]() {
#pragma unroll
    for (int i = 0; i < 2; ++i) {
      const int c = tid + 512 * i, row = c >> 4, cc = c & 15;
      *(u32x4*)(Ks + row * KP + cc * 8) = kreg[i];
      *(u32x4*)(Vs + row * VP + cc * 8) = vreg[i];
    }
  };
  auto next_j = [&](int j) -> int {
    if (MODE == MODE_SEL) {
      const unsigned rem = (j >= 31) ? 0u : (umask & ~((2u << j) - 1u));
      return rem ? (__builtin_ctz(rem)) : 64;
    }
    return j + 1;
  };
  int j = jlo;
  if (MODE == MODE_SEL) j = __builtin_ctz(umask);
  gload(j);
  __syncthreads();
  {
    u32x4 qreg[8];
#pragma unroll
    for (int i = 0; i < 8; ++i) {
      const int c = lane + 64 * i, row = c >> 4, cc = c & 15;
      qreg[i] = *(const u32x4*)(qbase + (size_t)row * ldq + cc * 8);
    }
#pragma unroll
    for (int i = 0; i < 8; ++i) {
      const int c = lane + 64 * i, row = c >> 4, cc = c & 15;
      *(u32x4*)(Qw + row * KP + cc * 8) = qreg[i];
    }
  }
  const float csc = 0.08838834764831845f * 1.4426950408889634f;
  const int q4 = (lane & 15) >> 2, p4 = lane & 3, blk = (lane >> 4) & 1;
  bool first = true;
#pragma unroll 1
  while (j <= jhi) {
    if (!first) __syncthreads();
    first = false;
    swrite();
    __syncthreads();
    const int jn = next_j(j);
    if (jn <= jhi) gload(jn);
    const int k0 = j * 64;
    if (MODE == MODE_RET && k0 > tq0 + 31) { j = jn; continue; }
    bf16x8 pf[2][2];
    if (MODE == MODE_RET) {
#pragma unroll
      for (int sub = 0; sub < 2; ++sub) {
        f32x16 sx;
#pragma unroll
        for (int i = 0; i < 16; ++i) sx[i] = 0.f;
#pragma unroll
        for (int s = 0; s < 8; ++s) {
          const bf16x8 kf = *(const bf16x8*)(Ks + (32 * sub + r) * KP + 16 * s + 8 * h);
          const bf16x8 qf = *(const bf16x8*)(Qw + r * KP + 16 * s + 8 * h);
          sx = MFMA(kf, qf, sx);
        }
        {
          const int dq = tq - (k0 + 32 * sub);
          const float cf = __builtin_amdgcn_exp2f(lg * (float)dq);
#pragma unroll
          for (int i = 0; i < 16; ++i) sx[i] = (crow(i, h) <= dq) ? sx[i] * (cf * rf[i]) : 0.f;
        }
        pf[sub][0] = pack8(sx, 0);
        pf[sub][1] = pack8(sx, 1);
      }
    } else {
      f32x16 s0, s1;
#pragma unroll
      for (int i = 0; i < 16; ++i) { s0[i] = 0.f; s1[i] = 0.f; }
#pragma unroll
      for (int s = 0; s < 8; ++s) {
        const bf16x8 k0f = *(const bf16x8*)(Ks + r * KP + 16 * s + 8 * h);
        const bf16x8 k1f = *(const bf16x8*)(Ks + (32 + r) * KP + 16 * s + 8 * h);
        const bf16x8 qf = *(const bf16x8*)(Qw + r * KP + 16 * s + 8 * h);
        s0 = MFMA(k0f, qf, s0);
        s1 = MFMA(k1f, qf, s1);
      }
      bool need_mask = false;
      if (MODE == MODE_WIN) need_mask = (k0 + 63 > tq0) || (k0 < tq0 + 31 - 511);
      if (MODE == MODE_SEL) need_mask = (k0 + 63 > tq0);
      const bool lanesel = (MODE == MODE_SEL) ? ((selm >> j) & 1u) : true;
      float mx = -INFINITY;
      if (need_mask) {
#pragma unroll
        for (int i = 0; i < 16; ++i) {
          const int tk0 = k0 + crow(i, h), tk1 = tk0 + 32;
          bool ok0 = true, ok1 = true;
          if (MODE == MODE_WIN) { ok0 = (tk0 <= tq) && (tq - tk0 < 512); ok1 = (tk1 <= tq) && (tq - tk1 < 512); }
          if (MODE == MODE_SEL) { ok0 = lanesel && (tk0 <= tq); ok1 = lanesel && (tk1 <= tq); }
          s0[i] = ok0 ? s0[i] * csc : -INFINITY;
          s1[i] = ok1 ? s1[i] * csc : -INFINITY;
          mx = fmaxf(mx, fmaxf(s0[i], s1[i]));
        }
      } else {
#pragma unroll
        for (int i = 0; i < 16; ++i) {
          s0[i] = lanesel ? s0[i] * csc : -INFINITY;
          s1[i] = lanesel ? s1[i] * csc : -INFINITY;
          mx = fmaxf(mx, fmaxf(s0[i], s1[i]));
        }
      }
      mx = fmaxf(mx, __shfl_xor(mx, 32));
      const float mnew = fmaxf(m_run, mx);
      const float muse = (mnew == -INFINITY) ? 0.f : mnew;
      const float alpha = __builtin_amdgcn_exp2f(m_run - muse);
      float ls = 0.f;
#pragma unroll
      for (int i = 0; i < 16; ++i) {
        s0[i] = __builtin_amdgcn_exp2f(s0[i] - muse);
        s1[i] = __builtin_amdgcn_exp2f(s1[i] - muse);
        ls += s0[i] + s1[i];
      }
      ls += __shfl_xor(ls, 32);
      l_run = l_run * alpha + ls;
      m_run = mnew;
      if (__builtin_amdgcn_ballot_w64(alpha != 1.f) != 0) {
#pragma unroll
        for (int dt = 0; dt < 4; ++dt)
#pragma unroll
          for (int i = 0; i < 16; ++i) o[dt][i] *= alpha;
      }
      pf[0][0] = pack8(s0, 0); pf[0][1] = pack8(s0, 1);
      pf[1][0] = pack8(s1, 0); pf[1][1] = pack8(s1, 1);
    }
#pragma unroll
    for (int dt = 0; dt < 4; ++dt)
#pragma unroll
      for (int sub = 0; sub < 2; ++sub)
#pragma unroll
        for (int st = 0; st < 2; ++st) {
          const int key0 = 32 * sub + 16 * st + 4 * h;
          const bfr* vp = Vs + (key0 + q4) * VP + 32 * dt + 16 * blk + 4 * p4;
          const s16x4 lo = tr_read(vp);
          const s16x4 hi = tr_read(vp + 8 * VP);
          const bf16x8 vf = __builtin_shufflevector(lo, hi, 0, 1, 2, 3, 4, 5, 6, 7);
          o[dt] = MFMA(vf, pf[sub][st], o[dt]);
        }
    j = jn;
  }

  if (MODE == MODE_SEL && p.dbg) return;
  const size_t mrow = (size_t)(b * SEQ + tq);
  if (MODE == MODE_WIN || MODE == MODE_SEL) {
    const float inv = (l_run > 0.f) ? 1.f / l_run : 0.f;
    const float gate = bflo(z[mrow * ZS + ZC_GN + head * 3 + (MODE == MODE_WIN ? 2 : 1)]);
    bfr* orow = (bfr*)(ws + OFF_ONSA) + mrow * 2048 + head * 128;
    const float sc = inv * gate;
#pragma unroll
    for (int dt = 0; dt < 4; ++dt)
#pragma unroll
      for (int g = 0; g < 4; ++g) {
        bfr* dst = orow + 32 * dt + 8 * g + 4 * h;
        float a = o[dt][4 * g] * sc, bb = o[dt][4 * g + 1] * sc, c = o[dt][4 * g + 2] * sc, d = o[dt][4 * g + 3] * sc;
        if (MODE == MODE_SEL) {
          const uint2 old = *(const uint2*)dst;
          a += bflo(old.x); bb += bfhi(old.x); c += bflo(old.y); d += bfhi(old.y);
        }
        st_bf4(dst, a, bb, c, d);
      }
  } else if (MODE == MODE_X) {
    const float inv = 1.f / l_run;
    bfr* orow = (bfr*)(ws + OFF_OX) + mrow * 512 + head * 128;
#pragma unroll
    for (int dt = 0; dt < 4; ++dt)
#pragma unroll
      for (int g = 0; g < 4; ++g)
        st_bf4(orow + 32 * dt + 8 * g + 4 * h, o[dt][4 * g] * inv, o[dt][4 * g + 1] * inv, o[dt][4 * g + 2] * inv,
               o[dt][4 * g + 3] * inv);
  } else {
    float sm = 0.f, sq = 0.f;
#pragma unroll
    for (int dt = 0; dt < 4; ++dt)
#pragma unroll
      for (int i = 0; i < 16; ++i) { sm += o[dt][i]; sq += o[dt][i] * o[dt][i]; }
    sm += __shfl_xor(sm, 32);
    sq += __shfl_xor(sq, 32);
    if (h == 0) *(float2*)((float*)(ws + OFF_RSTAT) + ((mrow * 8 + head) * 2 + vh) * 2) = make_float2(sm, sq);
    bfr* orow = (bfr*)(ws + OFF_ORET) + mrow * 2048 + head * 256 + vh * 128;
#pragma unroll
    for (int dt = 0; dt < 4; ++dt)
#pragma unroll
      for (int g = 0; g < 4; ++g)
        st_bf4(orow + 32 * dt + 8 * g + 4 * h, o[dt][4 * g], o[dt][4 * g + 1], o[dt][4 * g + 2], o[dt][4 * g + 3]);
  }
}

DI void ret_finish_row(const Params& p, int row, const int t) {
  char* ws = p.ws;
  const bfr* z = (const bfr*)(ws + OFF_Z);
  const int col = t * 8, head = t >> 5;
  const float4 st = *(const float4*)((const float*)(ws + OFF_RSTAT) + ((size_t)row * 8 + head) * 4);
  const float mu = (st.x + st.z) * (1.f / 256.f);
  const float var = fmaxf((st.y + st.w) * (1.f / 256.f) - mu * mu, 0.f);
  const float rstd = rsqrtf(var + 1e-6f);
  bfr* op = (bfr*)(ws + OFF_ORET) + (size_t)row * 2048 + col;
  const u32x4 ov = *(const u32x4*)op;
  const u32x4 gv = *(const u32x4*)(z + (size_t)row * ZS + ZC_GR + col);
  const float4 w0 = *(const float4*)(p.gn_w + col), w1 = *(const float4*)(p.gn_w + col + 4);
  u32x4 res;
  res[0] = pack2((bflo(ov[0]) - mu) * rstd * w0.x * bflo(gv[0]), (bfhi(ov[0]) - mu) * rstd * w0.y * bfhi(gv[0]));
  res[1] = pack2((bflo(ov[1]) - mu) * rstd * w0.z * bflo(gv[1]), (bfhi(ov[1]) - mu) * rstd * w0.w * bfhi(gv[1]));
  res[2] = pack2((bflo(ov[2]) - mu) * rstd * w1.x * bflo(gv[2]), (bfhi(ov[2]) - mu) * rstd * w1.y * bfhi(gv[2]));
  res[3] = pack2((bflo(ov[3]) - mu) * rstd * w1.z * bflo(gv[3]), (bfhi(ov[3]) - mu) * rstd * w1.w * bfhi(gv[3]));
  *(u32x4*)op = res;
}

DI void cmp_item(const Params& p, int item, char* smem, const int tid) {
  bfr* Ks = (bfr*)smem;
  float* impw = (float*)(smem + 128 * KP * 2);
  const int w = tid >> 6, lane = tid & 63, r = lane & 31, h = lane >> 5;
  char* ws = p.ws;
  const bfr* z = (const bfr*)(ws + OFF_Z);
  const int tb = item >> 4, bg = item & 15, b = bg >> 2, grp = bg & 3;
  const int t0 = tb * 64, ti = 32 * (w >> 2) + r, tq = t0 + ti, hw = w & 3, head = grp * 4 + hw;
  const bfr* qrow = z + (size_t)(b * SEQ + tq) * ZS + ZC_Q + head * 128;
  const bfr* kc = (const bfr*)(ws + OFF_KCVC) + (size_t)((b * 4 + grp) * 128) * 128;
  const bfr* vc = kc + (size_t)2048 * 128;
  bf16x8 qf[8];
#pragma unroll
  for (int s = 0; s < 8; ++s) qf[s] = *(const bf16x8*)(qrow + 16 * s + 8 * h);
  u32x4 reg[4];
#pragma unroll
  for (int i = 0; i < 4; ++i) {
    const int c = tid + 512 * i, row = c >> 4, cc = c & 15;
    reg[i] = *(const u32x4*)(kc + row * 128 + cc * 8);
  }
  __syncthreads();
#pragma unroll
  for (int i = 0; i < 4; ++i) {
    const int c = tid + 512 * i, row = c >> 4, cc = c & 15;
    *(u32x4*)(Ks + row * KP + cc * 8) = reg[i];
  }
  __syncthreads();
  f32x16 s[4];
#pragma unroll
  for (int kt = 0; kt < 4; ++kt) {
#pragma unroll
    for (int i = 0; i < 16; ++i) s[kt][i] = 0.f;
#pragma unroll
    for (int ss = 0; ss < 8; ++ss) {
      const bf16x8 kf = *(const bf16x8*)(Ks + (32 * kt + r) * KP + 16 * ss + 8 * h);
      s[kt] = MFMA(kf, qf[ss], s[kt]);
    }
  }
  const float csc = 0.08838834764831845f * 1.4426950408889634f;
  float mx = -INFINITY;
#pragma unroll
  for (int kt = 0; kt < 4; ++kt)
#pragma unroll
    for (int i = 0; i < 16; ++i) {
      const int c = 32 * kt + crow(i, h);
      const bool ok = (c * 16 + 31 <= tq) && (c < 127);
      s[kt][i] = ok ? s[kt][i] * csc : -INFINITY;
      mx = fmaxf(mx, s[kt][i]);
    }
  mx = fmaxf(mx, __shfl_xor(mx, 32));
  const float muse = (mx == -INFINITY) ? 0.f : mx;
  float ls = 0.f;
#pragma unroll
  for (int kt = 0; kt < 4; ++kt)
#pragma unroll
    for (int i = 0; i < 16; ++i) {
      s[kt][i] = __builtin_amdgcn_exp2f(s[kt][i] - muse);
      ls += s[kt][i];
    }
  ls += __shfl_xor(ls, 32);
  const float inv = (ls > 0.f) ? 1.f / ls : 0.f;
#pragma unroll
  for (int kt = 0; kt < 4; ++kt)
#pragma unroll
    for (int i = 0; i < 16; ++i) s[kt][i] *= inv;
  float plast[16];
#pragma unroll
  for (int kt = 0; kt < 4; ++kt)
#pragma unroll
    for (int g = 0; g < 4; ++g) plast[kt * 4 + g] = __shfl_xor(s[kt][4 * g + 3], 32);
#pragma unroll
  for (int kt = 0; kt < 4; ++kt)
#pragma unroll
    for (int g = 0; g < 4; ++g) {
      const int slot = kt * 4 + g;
      const float sum4 = s[kt][4 * g] + s[kt][4 * g + 1] + s[kt][4 * g + 2] + s[kt][4 * g + 3];
      const float prevl = (slot > 0) ? plast[slot > 0 ? slot - 1 : 0] : 0.f;
      const float add = h ? plast[slot] : prevl;
      impw[(hw * 64 + ti) * 32 + 8 * kt + 2 * g + h] = sum4 + add;
    }
  bf16x8 pf[4][2];
#pragma unroll
  for (int kt = 0; kt < 4; ++kt) { pf[kt][0] = pack8(s[kt], 0); pf[kt][1] = pack8(s[kt], 1); }
#pragma unroll
  for (int i = 0; i < 4; ++i) {
    const int c = tid + 512 * i, row = c >> 4, cc = c & 15;
    reg[i] = *(const u32x4*)(vc + row * 128 + cc * 8);
  }
  __syncthreads();
#pragma unroll
  for (int i = 0; i < 4; ++i) {
    const int c = tid + 512 * i, row = c >> 4, cc = c & 15;
    *(u32x4*)(Ks + row * KP + cc * 8) = reg[i];
  }
  __syncthreads();
  f32x16 o[4];
#pragma unroll
  for (int dt = 0; dt < 4; ++dt)
#pragma unroll
    for (int i = 0; i < 16; ++i) o[dt][i] = 0.f;
  const int q4 = (lane & 15) >> 2, p4 = lane & 3, blk = (lane >> 4) & 1;
#pragma unroll
  for (int dt = 0; dt < 4; ++dt)
#pragma unroll
    for (int kt = 0; kt < 4; ++kt)
#pragma unroll
      for (int st = 0; st < 2; ++st) {
        const int key0 = 32 * kt + 16 * st + 4 * h;
        const bfr* vp = Ks + (key0 + q4) * KP + 32 * dt + 16 * blk + 4 * p4;
        const s16x4 lo = tr_read(vp);
        const s16x4 hi = tr_read(vp + 8 * KP);
        const bf16x8 vf = __builtin_shufflevector(lo, hi, 0, 1, 2, 3, 4, 5, 6, 7);
        o[dt] = MFMA(vf, pf[kt][st], o[dt]);
      }
  {
    const size_t mrow = (size_t)(b * SEQ + tq);
    const float gate = bflo(z[mrow * ZS + ZC_GN + head * 3 + 0]);
    bfr* orow = (bfr*)(ws + OFF_ONSA) + mrow * 2048 + head * 128;
#pragma unroll
    for (int dt = 0; dt < 4; ++dt)
#pragma unroll
      for (int g = 0; g < 4; ++g) {
        bfr* dst = orow + 32 * dt + 8 * g + 4 * h;
        const uint2 old = *(const uint2*)dst;
        st_bf4(dst, o[dt][4 * g] * gate + bflo(old.x), o[dt][4 * g + 1] * gate + bfhi(old.x),
               o[dt][4 * g + 2] * gate + bflo(old.y), o[dt][4 * g + 3] * gate + bfhi(old.y));
      }
  }
  {
    const int i = tid >> 3, jg = tid & 7;
    const int cur = (t0 + i) >> 6;
    float vm[4];
#pragma unroll
    for (int e = 0; e < 4; ++e) {
      const int jme = 4 * jg + e;
      const float a = impw[(0 * 64 + i) * 32 + jme] + impw[(1 * 64 + i) * 32 + jme] + impw[(2 * 64 + i) * 32 + jme] + impw[(3 * 64 + i) * 32 + jme];
      const bool forced = (jme == 0) || (jme == cur) || (jme == cur - 1);
      vm[e] = forced ? INFINITY : ((jme > cur) ? -INFINITY : a);
    }
#pragma unroll
    for (int e = 0; e < 4; ++e) impw[i * 32 + 4 * jg + e] = vm[e];
    __syncthreads();
    int rank[4] = {0, 0, 0, 0};
#pragma unroll 4
    for (int k = 0; k < 32; ++k) {
      const float vk = impw[i * 32 + k];
#pragma unroll
      for (int e = 0; e < 4; ++e) rank[e] += (vk > vm[e] || (vk == vm[e] && k < 4 * jg + e)) ? 1 : 0;
    }
    unsigned bits = 0;
#pragma unroll
    for (int e = 0; e < 4; ++e)
      if (rank[e] < 16 && 4 * jg + e <= cur) bits |= 1u << (4 * jg + e);
    bits |= (unsigned)__shfl_xor((int)bits, 1);
    bits |= (unsigned)__shfl_xor((int)bits, 2);
    bits |= (unsigned)__shfl_xor((int)bits, 4);
    if (jg == 0) ((unsigned*)(ws + OFF_SELM))[(b * 4 + grp) * SEQ + t0 + i] = bits;
  }
  __syncthreads();
}

DI int grab(unsigned* ctr, int* slot, const int tid) {
  __syncthreads();
  if (tid == 0) *slot = (int)atomicAdd(ctr, 1u);
  __syncthreads();
  return *slot;
}

DI void run_phase(const Params& p0, int ph, char* smem, int* slot, const int wave_s, const int rep) {
  char* ws = p0.ws;
  asm volatile("" : "+s"(ws));
  Params p = p0;
  p.ws = ws;
  p.dbg = rep;
  const int G = gridDim.x;
  int bid = blockIdx.x;
  int tid = wave_s * 64 + (int)__builtin_amdgcn_mbcnt_hi(~0u, __builtin_amdgcn_mbcnt_lo(~0u, 0u));
  asm volatile("" : "+s"(bid));
  asm volatile("" : "+v"(tid));
  bfr* z = (bfr*)(ws + OFF_Z);
  unsigned* ctr = (unsigned*)(ws + OFF_CTR) + rep * 8;
  switch (ph) {
    case 0: {
      if (bid == 0 && tid < 64) ((unsigned*)(ws + OFF_CTR))[tid] = 0u;
      for (int i = bid * NTHR + tid; i < 2 * NTOK; i += G * NTHR) ((float*)(ws + OFF_ROWSS))[i] = 0.f;
      int tot = 0;
      for (int j = 0; j < 3; ++j) tot += tjob_tiles(j);
      const int n_norm = 1024 + 128, n_rope = 256;
      tr_run(p, 0, bid, G, tot, (float*)smem, tid);
      for (int it = tot + bid; it < tot + n_norm + n_rope; it += G) {
        if (it < tot + n_norm) {
          const int row = (it - tot) * 8 + (tid >> 6);
          if (row < NTOK) rmsnorm_row(p.x + (size_t)row * 2048, p.attn_norm_w, (bfr*)(ws + OFF_N) + (size_t)row * 2048, nullptr, tid);
          else rmsnorm_row(p.mem + (size_t)(row - NTOK) * 2048, p.mem_norm_w, (bfr*)(ws + OFF_MN) + (size_t)(row - NTOK) * 2048, nullptr, tid);
        } else {
          const int e = (it - tot - n_norm) * 512 + tid;
          const int t = e >> 6, i = e & 63;
          const float ang = (float)t * ROPE_INV[i];
          const float kk = rintf(ang * 0.15915494309189535f);
          float rr = fmaf(-kk, 6.2831854820251465f, ang);
          rr = fmaf(-kk, -1.7484555e-7f, rr);
          const float fr = rr * 0.15915494309189535f;
          ((float2*)(ws + OFF_ROPE))[e] = make_float2(__builtin_amdgcn_cosf(fr), __builtin_amdgcn_sinf(fr));
        }
      }
    } break;
    case 1: {
      {
        bfr* zcb = (bfr*)(ws + OFF_ZC);
        const float* rope = (const float*)(ws + OFF_ROPE);
        gemm8_phase(smem, (const bfr*)(ws + OFF_N), (const bfr*)(ws + OFF_WINT), 2048, 32 * 61, G, bid, tid,
          [&](const f32x4 (&acc)[2][2][4][2], int m0, int n0, int wr, int wc, int fr, int fq) {
            if (n0 < ZC_KC || (n0 >= ZC_KS && n0 < ZC_QR) || (n0 >= ZC_VR && n0 < ZC_GR)) {
              epi8_foreach(acc, m0, n0, wr, wc, fr, fq, [&](int m, int n, const f32x4& v0, const f32x4& v1) { st_bf8(z + (size_t)m * ZS + n, v0, v1); });
            } else if (n0 < ZC_KS) {
              const float* pe = (n0 < ZC_VC) ? p.pe_k : p.pe_v;
              epi8_foreach(acc, m0, n0, wr, wc, fr, fq, [&](int m, int n, const f32x4& v0, const f32x4& v1) {
                const int t = m & 2047, dd = n & 127;
                const float* pl = pe + (t & 15) * 128 + dd;
                const float* ph_ = pl + 16 * 128;
                const f32x4 l0 = *(const f32x4*)pl, l1 = *(const f32x4*)(pl + 4), h0 = *(const f32x4*)ph_, h1 = *(const f32x4*)(ph_ + 4);
                bfr* d = zcb + (size_t)m * 2048 + (n - ZC_KC);
                st_bf8(d, v0 + l0, v1 + l1);
                st_bf8(d + 1024, v0 + h0, v1 + h1);
              });
            } else if (n0 < ZC_VR) {
              const float sc = (n0 >= ZC_KR) ? 0.08838834764831845f : 1.f;
              epi8_foreach(acc, m0, n0, wr, wc, fr, fq, [&](int m, int n, const f32x4& v0, const f32x4& v1) {
                const int t = m & 2047, i0 = (n & 127) >> 1;
                const float* rp = rope + (size_t)(t * 64 + i0) * 2;
                const f32x4 c01 = *(const f32x4*)rp, c23 = *(const f32x4*)(rp + 4);
                f32x4 a0, a1;
                a0[0] = (v0[0] * c01[0] - v0[1] * c01[1]) * sc; a0[1] = (v0[0] * c01[1] + v0[1] * c01[0]) * sc;
                a0[2] = (v0[2] * c01[2] - v0[3] * c01[3]) * sc; a0[3] = (v0[2] * c01[3] + v0[3] * c01[2]) * sc;
                a1[0] = (v1[0] * c23[0] - v1[1] * c23[1]) * sc; a1[1] = (v1[0] * c23[1] + v1[1] * c23[0]) * sc;
                a1[2] = (v1[2] * c23[2] - v1[3] * c23[3]) * sc; a1[3] = (v1[2] * c23[3] + v1[3] * c23[2]) * sc;
                st_bf8(z + (size_t)m * ZS + n, a0, a1);
              });
            } else if (n0 < ZC_GA) {
              epi8_foreach(acc, m0, n0, wr, wc, fr, fq, [&](int m, int n, const f32x4& v0, const f32x4& v1) {
                f32x4 a0, a1;
#pragma unroll
                for (int j = 0; j < 4; ++j) { a0[j] = v0[j] * sigmoidf_(v0[j]); a1[j] = v1[j] * sigmoidf_(v1[j]); }
                st_bf8(z + (size_t)m * ZS + n, a0, a1);
              });
            } else {
              epi8_foreach(acc, m0, n0, wr, wc, fr, fq, [&](int m, int n, const f32x4& v0, const f32x4& v1) {
                if (n >= ZS) return;
                f32x4 a0, a1;
#pragma unroll
                for (int j = 0; j < 4; ++j) { a0[j] = sigmoidf_(v0[j]); a1[j] = sigmoidf_(v1[j]); }
                st_bf8(z + (size_t)m * ZS + n, a0, a1);
              });
            }
          });
      }
      {
        const int nunits = 32 * 61;
        const int nlong = (nunits % G == 0) ? 0 : nunits % G;
        const int nshort = G - nlong;
        const int sb_ = bid - nlong;
        if (sb_ >= 0) {
          for (int u = sb_; u < 32; u += nshort) {
            f32x16 acc[1][4];
            acc_zero<1>(acc);
            const int which = u >> 4, mt = (u & 15) >> 2, nt = u & 3;
            const int m0 = mt * 256, n0 = nt * 128;
            PlainPtr af{(const bfr*)(ws + OFF_MN) + (size_t)m0 * 2048, 2048};
            PlainPtr bf{(const bfr*)(ws + (which ? OFF_WVT : OFF_WKT)) + (size_t)n0 * 2048, 2048};
            gemm_main<1>(acc, af, bf, 32, smem, tid);
            bfr* dstb = (bfr*)(ws + (which ? OFF_VX : OFF_KX));
            gemm_epi<1>(acc, m0, n0, tid, [&](int m, int n, float a, float b, float c, float d) { st_bf4(dstb + (size_t)m * 512 + n, a, b, c, d); });
          }
          int tot2 = 0;
          for (int j = 3; j < 12; ++j) tot2 += tjob_tiles(j);
          tr_run(p, 3, sb_, nshort, tot2, (float*)smem, tid);
        }
      }
    } break;
    case 2: {
      for (int it = grab(ctr + 0, slot, tid); it < 64; it = grab(ctr + 0, slot, tid)) {
        const int which = it >> 5, mt = (it & 31) >> 2, nt = it & 3;
        const int m0 = mt * 256, n0 = nt * 256;
        f32x16 acc[2][4];
        acc_zero<2>(acc);
        struct GatherA {
          const bfr* base; int m0;
          DI int rowoff(int row) const {
            const int R = m0 + row;
            const int bb = R >> 9, g = (R >> 7) & 3;
            int c = R & 127; c = c > 126 ? 126 : c;
            return (bb * SEQ + c * 16) * 2048 + g * 128;
          }
          DI int koff(int kk) const { const int l = kk >> 7; return l * 2048 + ((l >> 4) << 10) + (kk & 127); }
        };
        GatherA af{(const bfr*)(ws + OFF_ZC) + which * 512, m0};
        PlainPtr bf{(const bfr*)(ws + OFF_W1T) + (size_t)which * 1024 * 4096 + (size_t)n0 * 4096, 4096};
        gemm_main<2>(acc, af, bf, 64, smem, tid);
        bfr* hid = (bfr*)(ws + OFF_HIDC) + (size_t)which * 2048 * 1024;
        gemm_epi<2>(acc, m0, n0, tid, [&](int m, int n, float a, float b, float c, float d) {
          st_bf4(hid + (size_t)m * 1024 + n, a * sigmoidf_(a), b * sigmoidf_(b), c * sigmoidf_(c), d * sigmoidf_(d));
        });
      }
      for (int it = grab(ctr + 1, slot, tid); it < 1024; it = grab(ctr + 1, slot, tid)) {
        if (it < 512) attn_item<MODE_RET>(p, it, smem, tid);
        else attn_item<MODE_WIN>(p, it - 512, smem, tid);
      }
    } break;
    case 3: {
      for (int it = bid; it < 16 + NTOK / 2; it += G) {
        if (it >= 16) { ret_finish_row(p, (it - 16) * 2 + (tid >> 8), tid & 255); continue; }
        const int which = it >> 3, mt = it & 7;
        const int m0 = mt * 256;
        f32x16 acc[1][4];
        acc_zero<1>(acc);
        PlainPtr af{(const bfr*)(ws + OFF_HIDC) + (size_t)which * 2048 * 1024 + (size_t)m0 * 1024, 1024};
        PlainPtr bf{(const bfr*)(ws + OFF_W2T) + (size_t)which * 128 * 1024, 1024};
        gemm_main<1>(acc, af, bf, 16, smem, tid);
        bfr* dstb = (bfr*)(ws + OFF_KCVC) + (size_t)which * 2048 * 128;
        gemm_epi<1>(acc, m0, 0, tid, [&](int m, int n, float a, float b, float c, float d) { st_bf4(dstb + (size_t)m * 128 + n, a, b, c, d); });
      }
    } break;
    case 4: {
      for (int it = bid; it < 512; it += G) cmp_item(p, it, smem, tid);
    } break;
    case 5: {
      for (int it = grab(ctr + 2, slot, tid); it < 512; it = grab(ctr + 2, slot, tid)) attn_item<MODE_SEL>(p, it, smem, tid);
    } break;
    case 6: {
      bfr* mg = (bfr*)(ws + OFF_MERGED);
      gemm8_phase(smem, (const bfr*)(ws + OFF_ONSA), (const bfr*)(ws + OFF_WAT), 2048, 32 * 8, G, bid, tid,
        [&](const f32x4 (&acc)[2][2][4][2], int m0, int n0, int wr, int wc, int fr, int fq) {
          epi8_foreach(acc, m0, n0, wr, wc, fr, fq, [&](int m, int n, const f32x4& v0, const f32x4& v1) {
            const u32x4 ga = *(const u32x4*)(z + (size_t)m * ZS + ZC_GA + n);
            f32x4 a0 = {bflo(ga[0]) * v0[0], bfhi(ga[0]) * v0[1], bflo(ga[1]) * v0[2], bfhi(ga[1]) * v0[3]};
            f32x4 a1 = {bflo(ga[2]) * v1[0], bfhi(ga[2]) * v1[1], bflo(ga[3]) * v1[2], bfhi(ga[3]) * v1[3]};
            st_bf8(mg + (size_t)m * 2048 + n, a0, a1);
          });
        });
      gemm8_phase(smem, (const bfr*)(ws + OFF_ORET), (const bfr*)(ws + OFF_WBT), 2048, 32 * 8, G, bid, tid,
        [&](const f32x4 (&acc)[2][2][4][2], int m0, int n0, int wr, int wc, int fr, int fq) {
          epi8_foreach(acc, m0, n0, wr, wc, fr, fq, [&](int m, int n, const f32x4& v0, const f32x4& v1) {
            const u32x4 gb = *(const u32x4*)(z + (size_t)m * ZS + ZC_GB + n);
            bfr* dst = mg + (size_t)m * 2048 + n;
            const u32x4 old = *(const u32x4*)dst;
            f32x4 a0 = {bflo(old[0]) + bflo(gb[0]) * v0[0], bfhi(old[0]) + bfhi(gb[0]) * v0[1], bflo(old[1]) + bflo(gb[1]) * v0[2], bfhi(old[1]) + bfhi(gb[1]) * v0[3]};
            f32x4 a1 = {bflo(old[2]) + bflo(gb[2]) * v1[0], bfhi(old[2]) + bfhi(gb[2]) * v1[1], bflo(old[3]) + bflo(gb[3]) * v1[2], bfhi(old[3]) + bfhi(gb[3]) * v1[3]};
            st_bf8(dst, a0, a1);
          });
        });
    } break;
    case 7: {
      gemm8_phase(smem, (const bfr*)(ws + OFF_MERGED), (const bfr*)(ws + OFF_WOUTT), 2048, 32 * 8, G, bid, tid,
        [&](const f32x4 (&acc)[2][2][4][2], int m0, int n0, int wr, int wc, int fr, int fq) {
          epi8_resid(acc, m0, n0, wr, wc, fr, fq, p.x, (float*)(ws + OFF_H), (bfr*)(ws + OFF_NX), (float*)(ws + OFF_ROWSS));
        });
    } break;
    case 8: case 12: break;
    case 9: {
      const int ng = (G > 128) ? 128 : G;
      if (bid < ng)
      for (int v = bid; v < 32 * 4; v += ng) {
        int mt, nt;
        map_tile32(v, mt, nt);
        const int m0 = mt * 256, n0 = nt * 128;
        f32x16 acc[1][4];
        acc_zero<1>(acc);
        PlainPtr af{(const bfr*)(ws + OFF_NX) + (size_t)m0 * 2048, 2048};
        PlainPtr bf{(const bfr*)(ws + OFF_WQT) + (size_t)n0 * 2048, 2048};
        gemm_main<1>(acc, af, bf, 32, smem, tid);
        bfr* qx = (bfr*)(ws + OFF_QX);
        const float* rss = (const float*)(ws + OFF_ROWSS);
        gemm_epi<1>(acc, m0, n0, tid, [&](int m, int n, float a, float b, float c, float d) {
          const float rs = rsqrtf(rss[m] * (1.f / 2048.f) + 1e-6f);
          st_bf4(qx + (size_t)m * 512 + n, a * rs, b * rs, c * rs, d * rs);
        });
      }
      {
        const int nt12 = tjob_tiles(12);
        for (int c = grab(ctr + 3, slot, tid); c * 8 < nt12; c = grab(ctr + 3, slot, tid))
          tr_run(p, 12, c * 8, 1, (c * 8 + 8 < nt12) ? c * 8 + 8 : nt12, (float*)smem, tid);
      }
    } break;
    case 10: {
      const int ng = (G > 128) ? 128 : G;
      if (bid < ng)
        for (int it = bid; it < 128; it += ng) attn_item<MODE_X>(p, it, smem, tid);
      {
        const int nt13 = tjob_tiles(13);
        for (int c = grab(ctr + 4, slot, tid); c * 8 < nt13; c = grab(ctr + 4, slot, tid))
          tr_run(p, 13, c * 8, 1, (c * 8 + 8 < nt13) ? c * 8 + 8 : nt13, (float*)smem, tid);
      }
    } break;
    case 11: {
      gemm8_phase(smem, (const bfr*)(ws + OFF_OX), (const bfr*)(ws + OFF_WOT), 512, 32 * 8, G, bid, tid,
        [&](const f32x4 (&acc)[2][2][4][2], int m0, int n0, int wr, int wc, int fr, int fq) {
          epi8_resid(acc, m0, n0, wr, wc, fr, fq, (const float*)(ws + OFF_H), (float*)(ws + OFF_H), (bfr*)(ws + OFF_NX), (float*)(ws + OFF_ROWSS) + NTOK);
        });
    } break;
    case 13: {
      bfr* hid = (bfr*)(ws + OFF_HID);
      const float* rss = (const float*)(ws + OFF_ROWSS) + NTOK;
      gemm8_phase(smem, (const bfr*)(ws + OFF_NX), (const bfr*)(ws + OFF_WUPT), 2048, 32 * 32, G, bid, tid,
        [&](const f32x4 (&acc)[2][2][4][2], int m0, int n0, int wr, int wc, int fr, int fq) {
          epi8_foreach(acc, m0, n0, wr, wc, fr, fq, [&](int m, int n, const f32x4& v0, const f32x4& v1) {
            const float rs = rsqrtf(rss[m] * (1.f / 2048.f) + 1e-6f);
            f32x4 a0, a1;
#pragma unroll
            for (int j = 0; j < 4; ++j) { const float t0 = fmaxf(v0[j], 0.f) * rs, t1 = fmaxf(v1[j], 0.f) * rs; a0[j] = t0 * t0; a1[j] = t1 * t1; }
            st_bf8(hid + (size_t)m * 8192 + n, a0, a1);
          });
        });
    } break;
    case 14: {
      const float* hbuf = (const float*)(ws + OFF_H);
      gemm8_phase(smem, (const bfr*)(ws + OFF_HID), (const bfr*)(ws + OFF_WDOWNT), 8192, 32 * 8, G, bid, tid,
        [&](const f32x4 (&acc)[2][2][4][2], int m0, int n0, int wr, int wc, int fr, int fq) {
          epi8_foreach(acc, m0, n0, wr, wc, fr, fq, [&](int m, int n, const f32x4& v0, const f32x4& v1) {
            const float* sp = hbuf + (size_t)m * 2048 + n;
            const f32x4 x0 = *(const f32x4*)sp, x1 = *(const f32x4*)(sp + 4);
            float* dp = p.out + (size_t)m * 2048 + n;
            *(f32x4*)dp = x0 + v0; *(f32x4*)(dp + 4) = x1 + v1;
          });
        });
    } break;
    case 15: {
      for (int it = bid; it < 1024; it += G) {
        const int row = it * 8 + (tid >> 6);
        rmsnorm_row(p.out + (size_t)row * 2048, p.final_norm_w, nullptr, p.out + (size_t)row * 2048, tid);
      }
    } break;
    default: break;
  }
}

DI void fast_grid_barrier(unsigned* ctr, const unsigned target) {
  asm volatile("s_waitcnt vmcnt(0)" ::: "memory");
  __syncthreads();
  if (threadIdx.x == 0) {
    __builtin_amdgcn_fence(__ATOMIC_RELEASE, "agent");
    asm volatile("s_waitcnt vmcnt(0)" ::: "memory");
    __hip_atomic_fetch_add(ctr, 1u, __ATOMIC_RELAXED, __HIP_MEMORY_SCOPE_AGENT);
    unsigned sp = 0;
    while (__hip_atomic_load(ctr, __ATOMIC_RELAXED, __HIP_MEMORY_SCOPE_AGENT) < target) {
      __builtin_amdgcn_s_sleep(1);
      if (++sp > (1u << 22)) break;
    }
    __builtin_amdgcn_fence(__ATOMIC_ACQUIRE, "agent");
    asm volatile("s_waitcnt vmcnt(0)" ::: "memory");
  }
  __syncthreads();
}

__global__ void __launch_bounds__(512, 2) mega(Params p) {
  extern __shared__ __attribute__((aligned(1024))) char smem[];
  __shared__ int slot;
  cg::grid_group grid = cg::this_grid();
  const int wave_s = __builtin_amdgcn_readfirstlane((int)(threadIdx.x >> 6));
  unsigned nbar = 0;
  for (int ph = p.ph_lo; ph < p.ph_hi; ++ph) {
    if (ph == 8 || ph == 12) continue;
    run_phase(p, ph, smem, &slot, wave_s, 0);
#ifdef PROBE_PH
    if (ph == PROBE_PH)
      for (int rep = 1; rep <= PROBE_N; ++rep) { grid.sync(); run_phase(p, ph, smem, &slot, wave_s, rep); }
#endif
    if (ph + 1 < p.ph_hi) {
      if (p.dbg == 12345) grid.sync();
      ++nbar; fast_grid_barrier((unsigned*)(p.ws + OFF_BAR), nbar * gridDim.x);
    }
  }
}

extern "C" void kernel_launch(void* const* d_in, const int* in_sizes, int n_in, void* d_out, int out_size, void* d_ws,
                              size_t ws_size, hipStream_t stream) {
  static int grid_blocks = 0;
  if (!grid_blocks) {
    int dev = 0, cus = 0, per_cu = 0;
    (void)hipGetDevice(&dev);
    (void)hipDeviceGetAttribute(&cus, hipDeviceAttributeMultiprocessorCount, dev);
    (void)hipFuncSetAttribute((const void*)mega, hipFuncAttributeMaxDynamicSharedMemorySize, SMEM_BYTES);
    (void)hipOccupancyMaxActiveBlocksPerMultiprocessor(&per_cu, mega, NTHR, SMEM_BYTES);
    if (per_cu < 1) per_cu = 1;
    if (per_cu > 1) per_cu = 1;
    grid_blocks = cus * per_cu;
    grid_blocks &= ~7;
    if (ws_size < WS_END || n_in != 24) { fprintf(stderr, "kernel_launch: ws %zu < %zu or n_in %d\n", ws_size, (size_t)WS_END, n_in); grid_blocks = -1; }
  }
  if (grid_blocks < 0) return;
  Params p{};
  const float** pp = (const float**)&p;
  for (int i = 0; i < 24; ++i) pp[i] = (const float*)d_in[i];
  p.out = (float*)d_out;
  p.ws = (char*)d_ws;
#if ONE_LAUNCH
  p.ph_lo = 0; p.ph_hi = NPHASE;
  (void)hipMemsetAsync((char*)d_ws + OFF_BAR, 0, 256, stream);
  void* args[] = {&p};
  hipError_t e = hipLaunchCooperativeKernel((void*)mega, dim3(grid_blocks), dim3(NTHR), args, SMEM_BYTES, stream);
  if (e != hipSuccess) fprintf(stderr, "cooperative launch failed: %s (grid %d)\n", hipGetErrorString(e), grid_blocks);
#else
  for (int ph = 0; ph < NPHASE; ++ph) {
    p.ph_lo = ph; p.ph_hi = ph + 1;
    hipLaunchKernelGGL(mega, dim3(grid_blocks), dim3(NTHR), SMEM_BYTES, stream, p);
  }
#endif
}
```

```cpp
#include <hip/hip_runtime.h>
#include <hip/hip_cooperative_groups.h>
#include <cstdio>
namespace cg = cooperative_groups;

#ifndef ONE_LAUNCH
#define ONE_LAUNCH 1
#endif

#define DI __device__ __forceinline__
typedef unsigned short bfr;
using bf16x8 = __attribute__((ext_vector_type(8))) short;
using s16x4 = __attribute__((ext_vector_type(4))) short;
using f32x16 = __attribute__((ext_vector_type(16))) float;
using u32x4 = __attribute__((ext_vector_type(4))) unsigned;
#define MFMA(a, b, c) __builtin_amdgcn_mfma_f32_32x32x16_bf16((a), (b), (c), 0, 0, 0)

constexpr int DM = 2048, SEQ = 2048, NTOK = 8192;
constexpr int ZS = 15488;
constexpr int ZC_Q = 0, ZC_KC = 2048, ZC_VC = 2560, ZC_KS = 3072, ZC_VS = 3584, ZC_KW = 4096, ZC_VW = 4608,
              ZC_QR = 5120, ZC_KR = 6144, ZC_VR = 7168, ZC_GR = 9216, ZC_GA = 11264, ZC_GB = 13312, ZC_GN = 15360;
constexpr int NPHASE = 16;

constexpr int ZSP = 15616;
constexpr size_t SZ_WINT = (size_t)ZSP * 2048 * 2;
constexpr size_t SZ_ACT = (size_t)NTOK * 2048 * 2;
constexpr size_t OFF_WINT = 0;
constexpr size_t OFF_N = OFF_WINT + SZ_WINT;
constexpr size_t OFF_MERGED = OFF_WINT;
constexpr size_t OFF_ORET = OFF_N;
constexpr size_t OFF_WUPT = 0;
constexpr size_t OFF_WDOWNT = SZ_ACT;
constexpr size_t OFF_Z = OFF_N + SZ_ACT;
constexpr size_t SZ_Z = (size_t)NTOK * ZS * 2;
constexpr size_t OFF_HID = OFF_Z;
constexpr size_t OFF_H = OFF_Z + (size_t)NTOK * 8192 * 2;
constexpr size_t OFF_NX = OFF_H + (size_t)NTOK * 2048 * 4;
constexpr size_t OFF_QX = OFF_NX + SZ_ACT;
constexpr size_t OFF_OX = OFF_QX + (size_t)NTOK * 512 * 2;
static_assert(OFF_OX + (size_t)NTOK * 512 * 2 <= OFF_Z + SZ_Z, "alias overflow");
constexpr size_t OFF_ZC = OFF_Z + SZ_Z;
constexpr size_t OFF_MN = OFF_ZC + (size_t)NTOK * 2048 * 2;
constexpr size_t OFF_W1T = OFF_MN + (size_t)1024 * 2048 * 2;
constexpr size_t OFF_W2T = OFF_W1T + (size_t)2 * 1024 * 4096 * 2;
constexpr size_t OFF_WAT = OFF_W2T + (size_t)2 * 128 * 1024 * 2;
constexpr size_t OFF_WBT = OFF_WAT + (size_t)2048 * 2048 * 2;
constexpr size_t OFF_WOUTT = OFF_WBT + (size_t)2048 * 2048 * 2;
constexpr size_t OFF_WQT = OFF_WOUTT + (size_t)2048 * 2048 * 2;
constexpr size_t OFF_WKT = OFF_WQT + (size_t)512 * 2048 * 2;
constexpr size_t OFF_WVT = OFF_WKT + (size_t)512 * 2048 * 2;
constexpr size_t OFF_WOT = OFF_WVT + (size_t)512 * 2048 * 2;
constexpr size_t OFF_ROPE = OFF_WOT + (size_t)512 * 2048 * 2;
constexpr size_t OFF_HIDC = OFF_ROPE + (size_t)2048 * 64 * 8;
constexpr size_t OFF_KCVC = OFF_HIDC + (size_t)2 * 2048 * 1024 * 2;
constexpr size_t OFF_SELM = OFF_KCVC + (size_t)2 * 2048 * 128 * 2;
constexpr size_t OFF_ONSA = OFF_SELM + (size_t)16 * 2048 * 4;
constexpr size_t OFF_KX = OFF_ONSA + SZ_ACT;
constexpr size_t OFF_VX = OFF_KX + (size_t)1024 * 512 * 2;
constexpr size_t OFF_RSTAT = OFF_VX + (size_t)1024 * 512 * 2;
constexpr size_t OFF_CTR = OFF_RSTAT + (size_t)NTOK * 8 * 2 * 2 * 4;
constexpr size_t OFF_BAR = OFF_CTR + 256;
constexpr size_t BAR_BYTES = 16384;
constexpr size_t OFF_ROWSS = OFF_BAR + BAR_BYTES;
constexpr size_t WS_END = OFF_ROWSS + (size_t)2 * NTOK * 4;

struct Params {
  const float *x, *mem, *attn_norm_w, *w_in, *pe_k, *w1k, *w2k, *pe_v, *w1v, *w2v, *w_a, *gn_w, *w_b, *w_out, *x_norm_w,
      *mem_norm_w, *wq, *wk, *wv, *wo, *mlp_norm_w, *w_up, *w_down, *final_norm_w;
  float* out;
  char* ws;
  int ph_lo, ph_hi;
  int dbg, pad;
};

constexpr int NTHR = 512;
constexpr int SMEM_BYTES = 131072;
__device__ const float ROPE_INV[64] = {1.0f, 0.865964353f, 0.749894261f, 0.649381638f, 0.562341332f, 0.486967534f, 0.421696514f, 0.365174115f, 0.316227764f, 0.273841977f, 0.237137377f, 0.2053525f, 0.177827939f, 0.153992653f, 0.133352131f, 0.115478203f, 0.100000001f, 0.0865964293f, 0.0749894157f, 0.0649381652f, 0.0562341325f, 0.0486967526f, 0.0421696529f, 0.0365174115f, 0.0316227749f, 0.0273841973f, 0.0237137377f, 0.0205352511f, 0.0177827943f, 0.0153992651f, 0.0133352149f, 0.0115478206f, 0.00999999978f, 0.00865964312f, 0.00749894185f, 0.00649381615f, 0.00562341325f, 0.00486967526f, 0.00421696482f, 0.00365174119f, 0.00316227763f, 0.00273841969f, 0.00237137359f, 0.00205352483f, 0.00177827943f, 0.00153992651f, 0.00133352145f, 0.0011547819f, 0.00100000005f, 0.000865964335f, 0.000749894243f, 0.000649381662f, 0.000562341302f, 0.000486967532f, 0.000421696517f, 0.000365174143f, 0.000316227757f, 0.000273841957f, 0.00023713737f, 0.00020535251f, 0.00017782794f, 0.000153992645f, 0.00013335215f, 0.0001154782f};

DI unsigned pack2(float a, float b) {
  typedef float f2 __attribute__((ext_vector_type(2)));
  typedef __bf16 b2 __attribute__((ext_vector_type(2)));
  f2 v = {a, b};
  b2 r = __builtin_convertvector(v, b2);
  return __builtin_bit_cast(unsigned, r);
}
DI float bflo(unsigned u) { return __uint_as_float(u << 16); }
DI float bfhi(unsigned u) { return __uint_as_float(u & 0xffff0000u); }
DI void st_bf4(bfr* p, float a, float b, float c, float d) {
  uint2 v; v.x = pack2(a, b); v.y = pack2(c, d);
  *(uint2*)p = v;
}
DI float wave_sum(float v) {
#pragma unroll
  for (int o = 32; o > 0; o >>= 1) v += __shfl_xor(v, o);
  return v;
}
DI float sigmoidf_(float x) { return __builtin_amdgcn_rcpf(1.f + __expf(-x)); }
DI int crow(int i, int h) { return (i & 3) + 8 * (i >> 2) + 4 * h; }
DI bf16x8 pack8(const f32x16& x, int s) {
  unsigned a = pack2(x[8 * s], x[8 * s + 1]), b = pack2(x[8 * s + 2], x[8 * s + 3]), c = pack2(x[8 * s + 4], x[8 * s + 5]),
           d = pack2(x[8 * s + 6], x[8 * s + 7]);
  typedef unsigned u4 __attribute__((ext_vector_type(4)));
  u4 v = {a, b, c, d};
  return __builtin_bit_cast(bf16x8, v);
}
DI s16x4 tr_read(const bfr* p) {
  return __builtin_amdgcn_ds_read_tr16_b64_v4i16((__attribute__((address_space(3))) s16x4*)(p));
}

struct TJob { const float* src; bfr* dst; int K, N, ntn, perm; const float* kscale; };
DI TJob get_tjob(const Params& p, int j) {
  TJob t;
  char* ws = p.ws;
  switch (j) {
    case 0: t = {p.w_in, (bfr*)(ws + OFF_WINT), 2048, 15408, 122, 1, nullptr}; break;
    case 1: t = {p.wk, (bfr*)(ws + OFF_WKT), 2048, 512, 4, 0, nullptr}; break;
    case 2: t = {p.wv, (bfr*)(ws + OFF_WVT), 2048, 512, 4, 0, nullptr}; break;
    case 3: t = {p.w1k, (bfr*)(ws + OFF_W1T), 4096, 1024, 8, 0, nullptr}; break;
    case 4: t = {p.w1v, (bfr*)(ws + OFF_W1T) + (size_t)1024 * 4096, 4096, 1024, 8, 0, nullptr}; break;
    case 5: t = {p.w2k, (bfr*)(ws + OFF_W2T), 1024, 128, 1, 0, nullptr}; break;
    case 6: t = {p.w2v, (bfr*)(ws + OFF_W2T) + (size_t)128 * 1024, 1024, 128, 1, 0, nullptr}; break;
    case 7: t = {p.w_a, (bfr*)(ws + OFF_WAT), 2048, 2048, 16, 0, nullptr}; break;
    case 8: t = {p.w_b, (bfr*)(ws + OFF_WBT), 2048, 2048, 16, 0, nullptr}; break;
    case 9: t = {p.w_out, (bfr*)(ws + OFF_WOUTT), 2048, 2048, 16, 0, nullptr}; break;
    case 10: t = {p.wq, (bfr*)(ws + OFF_WQT), 2048, 512, 4, 0, p.x_norm_w}; break;
    case 11: t = {p.wo, (bfr*)(ws + OFF_WOT), 512, 2048, 16, 0, nullptr}; break;
    case 12: t = {p.w_up, (bfr*)(ws + OFF_WUPT), 2048, 8192, 64, 0, p.mlp_norm_w}; break;
    default: t = {p.w_down, (bfr*)(ws + OFF_WDOWNT), 8192, 2048, 16, 0, nullptr}; break;
  }
  return t;
}
DI int tjob_tiles(int j) {
  switch (j) {
    case 0: return 122 * 16;
    case 1: case 2: return 4 * 16;
    case 3: case 4: return 8 * 32;
    case 5: case 6: return 1 * 8;
    case 7: case 8: case 9: return 16 * 16;
    case 10: return 4 * 16;
    case 11: return 16 * 4;
    case 12: return 64 * 16;
    default: return 16 * 64;
  }
}
struct TrRegs { float4 v[8]; };
DI void tr_load(const TJob& t, int tile, TrRegs& rg, const int tid) {
  const int nkt = t.K >> 7;
  const int kt = tile % nkt, nt = tile / nkt;
  const int k0 = kt * 128, d0 = nt * 128;
  int scol0 = d0, nvalid = 128;
  if (t.perm) {
    if (d0 < 5120) scol0 = d0;
    else if (d0 < 15360) scol0 = d0 + 48;
    else { scol0 = d0 - 15360 + 5120; nvalid = (d0 == 15360) ? 48 : 0; }
  }
#pragma unroll
  for (int i = 0; i < 8; ++i) {
    const int row = i * 16 + (tid >> 5), col = (tid & 31) * 4;
    rg.v[i] = make_float4(0.f, 0.f, 0.f, 0.f);
    if (col < nvalid) rg.v[i] = *(const float4*)(t.src + (size_t)(k0 + row) * t.N + scol0 + col);
    if (t.kscale) { const float sc = t.kscale[k0 + row]; rg.v[i].x *= sc; rg.v[i].y *= sc; rg.v[i].z *= sc; rg.v[i].w *= sc; }
  }
}
DI void tr_to_lds(const TrRegs& rg, float* sm, const int tid) {
#pragma unroll
  for (int i = 0; i < 8; ++i) {
    const int row = i * 16 + (tid >> 5), col = (tid & 31) * 4;
    float* d = sm + row * 129 + col;
    d[0] = rg.v[i].x; d[1] = rg.v[i].y; d[2] = rg.v[i].z; d[3] = rg.v[i].w;
  }
}
DI void tr_store(const TJob& t, int tile, const float* sm, const int tid) {
  const int nkt = t.K >> 7;
  const int kt = tile % nkt, nt = tile / nkt;
  const int k0 = kt * 128, d0 = nt * 128;
  const int n = tid >> 2, kq = (tid & 3) * 8;
  bfr* drow = t.dst + (size_t)(d0 + n) * t.K + k0 + kq;
#pragma unroll
  for (int q = 0; q < 4; ++q) {
    const int kb = kq + 32 * q;
    const unsigned o0 = pack2(sm[(kb + 0) * 129 + n], sm[(kb + 1) * 129 + n]);
    const unsigned o1 = pack2(sm[(kb + 2) * 129 + n], sm[(kb + 3) * 129 + n]);
    const unsigned o2 = pack2(sm[(kb + 4) * 129 + n], sm[(kb + 5) * 129 + n]);
    const unsigned o3 = pack2(sm[(kb + 6) * 129 + n], sm[(kb + 7) * 129 + n]);
    *(uint4*)(drow + 32 * q) = make_uint4(o0, o1, o2, o3);
  }
}
DI void tr_decode(int it, int j_lo, int& j, int& rem) {
  j = j_lo; rem = it;
  while (rem >= tjob_tiles(j)) { rem -= tjob_tiles(j); ++j; }
}
DI void tr_run(const Params& p, int j_lo, int it0, int stride, int n_tiles, float* sm, const int tid) {
  if (it0 >= n_tiles) return;
  TrRegs rg;
  int j, rem;
  tr_decode(it0, j_lo, j, rem);
  TJob t = get_tjob(p, j);
  tr_load(t, rem, rg, tid);
  for (int it = it0; it < n_tiles; it += stride) {
    __syncthreads();
    tr_to_lds(rg, sm, tid);
    __syncthreads();
    const TJob tc = t;
    const int remc = rem;
    const int nx = it + stride;
    if (nx < n_tiles) {
      tr_decode(nx, j_lo, j, rem);
      t = get_tjob(p, j);
      tr_load(t, rem, rg, tid);
    }
    tr_store(tc, remc, sm, tid);
  }
  __syncthreads();
}

DI void rmsnorm_row(const float* xrow, const float* w, bfr* obf, float* of32, const int tid) {
  const int lane = tid & 63;
  float4 v[8];
  float ss = 0.f;
#pragma unroll
  for (int i = 0; i < 8; ++i) {
    v[i] = ((const float4*)xrow)[lane + 64 * i];
    ss += v[i].x * v[i].x + v[i].y * v[i].y + v[i].z * v[i].z + v[i].w * v[i].w;
  }
  ss = wave_sum(ss);
  const float rs = rsqrtf(ss * (1.f / 2048.f) + 1e-6f);
#pragma unroll
  for (int i = 0; i < 8; ++i) {
    const float4 ww = ((const float4*)w)[lane + 64 * i];
    const float a = v[i].x * rs * ww.x, b = v[i].y * rs * ww.y, c = v[i].z * rs * ww.z, d = v[i].w * rs * ww.w;
    if (obf) st_bf4(obf + (lane + 64 * i) * 4, a, b, c, d);
    else ((float4*)of32)[lane + 64 * i] = make_float4(a, b, c, d);
  }
}

struct PlainPtr {
  const bfr* base; int ld;
  DI int rowoff(int row) const { return row * ld; }
  DI int koff(int k0) const { return k0; }
};
#define WAIT_V(n) asm volatile("s_waitcnt vmcnt(%0)" ::"n"(n) : "memory")
#define WAIT_L(n) asm volatile("s_waitcnt lgkmcnt(%0)" ::"n"(n) : "memory")
#define RAW_BARRIER() do { WAIT_L(0); __builtin_amdgcn_s_barrier(); } while (0)
typedef __attribute__((address_space(3))) unsigned lds_u32;
constexpr int STAGE_B = 65536;
template <int NI, class AF, class BF>
DI void gemm_main(f32x16 (&acc)[NI][4], const AF& af, const BF& bf, int nk, char* smem, const int tid) {
  const int lane = tid & 63, r = lane & 31, h = lane >> 5;
  const int w = __builtin_amdgcn_readfirstlane(tid >> 6);
  const int wm = w & 1, wn = w >> 1;
  int ao[4], bo[2 * NI];
  {
    const int rl = lane >> 3, kc = (lane & 7) ^ (((w & 1) * 4 + (lane >> 4)) & 7);
#pragma unroll
    for (int i = 0; i < 4; ++i) ao[i] = af.rowoff((w + 8 * i) * 8 + rl) + 8 * kc;
#pragma unroll
    for (int i = 0; i < 2 * NI; ++i) bo[i] = bf.rowoff((w + 8 * i) * 8 + rl) + 8 * kc;
  }
  auto stage = [&](int buf, int kt) {
    const int ka = af.koff(kt * 64), kb = bf.koff(kt * 64);
    char* sbase = smem + buf * STAGE_B + w * 1024;
#pragma unroll
    for (int i = 0; i < 4; ++i)
      __builtin_amdgcn_global_load_lds((const unsigned*)(af.base + (ao[i] + ka)), (lds_u32*)(sbase + i * 8192), 16, 0, 0);
#pragma unroll
    for (int i = 0; i < 2 * NI; ++i)
      __builtin_amdgcn_global_load_lds((const unsigned*)(bf.base + (bo[i] + kb)), (lds_u32*)(sbase + 32768 + i * 8192), 16, 0, 0);
  };
  const int xr = (r >> 1) & 7;
  const int arow = (wm * 128 + r) * 128, brow = 32768 + (wn * 32 * NI + r) * 128;
  WAIT_V(0);
  __syncthreads();
  stage(0, 0);
  WAIT_V(0);
  RAW_BARRIER();
#pragma unroll 1
  for (int kt = 0; kt < nk; ++kt) {
    if (kt + 1 < nk) stage((kt + 1) & 1, kt + 1);
    const char* sb = smem + (kt & 1) * STAGE_B;
#pragma unroll
    for (int ks = 0; ks < 4; ++ks) {
      const int off = ((2 * ks + h) ^ xr) * 16;
      bf16x8 wf[NI], xf[4];
#pragma unroll
      for (int i = 0; i < NI; ++i) wf[i] = *(const bf16x8*)(sb + brow + i * 4096 + off);
#pragma unroll
      for (int i = 0; i < 4; ++i) xf[i] = *(const bf16x8*)(sb + arow + i * 4096 + off);
#pragma unroll
      for (int mi = 0; mi < 4; ++mi)
#pragma unroll
        for (int ni = 0; ni < NI; ++ni) acc[ni][mi] = MFMA(wf[ni], xf[mi], acc[ni][mi]);
    }
    WAIT_V(0);
    RAW_BARRIER();
  }
}
template <int NI>
DI void acc_zero(f32x16 (&acc)[NI][4]) {
#pragma unroll
  for (int a = 0; a < NI; ++a)
#pragma unroll
    for (int b = 0; b < 4; ++b)
#pragma unroll
      for (int i = 0; i < 16; ++i) acc[a][b][i] = 0.f;
}
template <int NI, class EPI>
DI void gemm_epi(const f32x16 (&acc)[NI][4], int m0, int n0, const int tid_in, const EPI& epi) {
  int tid = tid_in;
  asm volatile("" : "+v"(tid));
  const int lane = tid & 63, w = tid >> 6, r = lane & 31, h = lane >> 5;
  const int wm = w & 1, wn = w >> 1;
#pragma unroll
  for (int mi = 0; mi < 4; ++mi)
#pragma unroll
    for (int ni = 0; ni < NI; ++ni)
#pragma unroll
      for (int g = 0; g < 4; ++g) {
        const int n = n0 + wn * 32 * NI + ni * 32 + 8 * g + 4 * h;
        const int m = m0 + wm * 128 + mi * 32 + r;
        epi(m, n, acc[ni][mi][4 * g], acc[ni][mi][4 * g + 1], acc[ni][mi][4 * g + 2], acc[ni][mi][4 * g + 3]);
      }
}
DI void gemm_epi_resid(const f32x16 (&acc)[2][4], int m0, int n0, const int tid_in, const float* hsrc, float* hdst, bfr* hb, float* rowss) {
  int tid = tid_in;
  asm volatile("" : "+v"(tid));
  const int lane = tid & 63, w = tid >> 6, r = lane & 31, h = lane >> 5;
  const int wm = w & 1, wn = w >> 1;
#pragma unroll
  for (int mi = 0; mi < 4; ++mi) {
    const int m = m0 + wm * 128 + mi * 32 + r;
    float ss = 0.f;
#pragma unroll
    for (int ni = 0; ni < 2; ++ni)
#pragma unroll
      for (int g = 0; g < 4; ++g) {
        const int n = n0 + wn * 64 + ni * 32 + 8 * g + 4 * h;
        const float4 xv = *(const float4*)(hsrc + (size_t)m * 2048 + n);
        const float a = xv.x + acc[ni][mi][4 * g], b = xv.y + acc[ni][mi][4 * g + 1], c = xv.z + acc[ni][mi][4 * g + 2], d = xv.w + acc[ni][mi][4 * g + 3];
        *(float4*)(hdst + (size_t)m * 2048 + n) = make_float4(a, b, c, d);
        st_bf4(hb + (size_t)m * 2048 + n, a, b, c, d);
        ss += a * a + b * b + c * c + d * d;
      }
    ss += __shfl_xor(ss, 32);
    if (h == 0) atomicAdd(rowss + m, ss);
  }
}
DI void map_tile32(int v, int& mt, int& nt) {
  const int xcd = v & 7, j = v >> 3;
  nt = j >> 2;
  mt = xcd * 4 + (j & 3);
}


using f32x4 = __attribute__((ext_vector_type(4))) float;
typedef __attribute__((address_space(3))) unsigned char lds_u8;
constexpr int HTB = 128 * 64 * 2;
DI int lds_byte8(int r, int c) { const int st = (r >> 4) * 2 + (c >> 5), rr = r & 15, cc = c & 31, ob = rr * 64 + cc * 2; return st * 1024 + (ob ^ (((ob >> 9) & 1) << 5)); }
DI void stage_rc8(int b, int& R, int& C) { const int st = b / 1024, sb = b % 1024, swz = sb ^ (((sb >> 9) & 1) << 5); R = (st >> 1) * 16 + swz / 64; C = (st & 1) * 32 + (swz % 64) / 2; }
DI int perm32(int rho) { const int n = rho >> 4, i = rho & 15; return 8 * (i >> 2) + 4 * n + (i & 3); }
DI bool unit_next(int i, int G, int bid, int nunits, int& pm, int& pn) {
  const int v = bid + i * G;
  if (v >= nunits) return false;
  const int xcd = v & 7, j = v >> 3;
  pn = j >> 2;
  pm = xcd * 4 + (j & 3);
  return true;
}
template <class Epi>
DI void gemm8_phase(char* smem, const bfr* A, const bfr* Bt, const int K, const int nunits, const int G, const int bid, const int tid, const Epi& E) {
  lds_u8* lds = (lds_u8*)smem;
  const int wid = __builtin_amdgcn_readfirstlane(tid >> 6), lane = tid & 63, wr = wid >> 2, wc = wid & 3, fr = lane & 15, fq = lane >> 4;
  const int nt = K / 64;
  unsigned voffA[2], voffB[2];
#pragma unroll
  for (int i = 0; i < 2; ++i) {
    int R, C;
    stage_rc8(tid * 16 + i * 8192, R, C);
    const int Rb = (R & ~31) + perm32(R & 31);
    voffA[i] = (unsigned)(R * K + C) * 2u;
    voffB[i] = (unsigned)(Rb * K + C) * 2u;
  }
  const size_t kstep = 128;
  const size_t hstep = (size_t)128 * K * 2;
  const size_t tstep = 2 * hstep;
  const unsigned ldsw = (unsigned)wid * 1024u;
  const int aoff = lds_byte8(wr * 64 + fr, fq * 8), boff = lds_byte8(wc * 32 + fr, fq * 8);
#define PG8_SA(b, h) (((b) * 2 + (h)) * HTB)
#define PG8_SB(b, h) ((4 + (b) * 2 + (h)) * HTB)
#define PG8_STAGE(bufoff, gbase, voff) do { _Pragma("unroll") for (int _i = 0; _i < 2; ++_i) \
    __builtin_amdgcn_global_load_lds((const unsigned*)((const char*)(gbase) + (voff)[_i]), (lds_u32*)(lds + (bufoff) + ldsw + _i * 8192), 16, 0, 0); } while (0)
#define PG8_LDA(dst, b, h) do { _Pragma("unroll") for (int m = 0; m < 4; ++m) _Pragma("unroll") for (int k = 0; k < 2; ++k) dst[m][k] = *(const __attribute__((address_space(3))) bf16x8*)(lds + PG8_SA(b, h) + aoff + m * 2048 + k * 1024); } while (0)
#define PG8_LDB(dst, b, h) do { _Pragma("unroll") for (int n = 0; n < 2; ++n) _Pragma("unroll") for (int k = 0; k < 2; ++k) dst[n][k] = *(const __attribute__((address_space(3))) bf16x8*)(lds + PG8_SB(b, h) + boff + n * 2048 + k * 1024); } while (0)
#define PG8_MMA(ai, bj, At, Bt_) do { __builtin_amdgcn_s_setprio(1); _Pragma("unroll") for (int m = 0; m < 4; ++m) _Pragma("unroll") for (int n = 0; n < 2; ++n) _Pragma("unroll") for (int k = 0; k < 2; ++k) \
    acc[ai][bj][m][n] = __builtin_amdgcn_mfma_f32_16x16x32_bf16(Bt_[n][k], At[m][k], acc[ai][bj][m][n], 0, 0, 0); __builtin_amdgcn_s_setprio(0); } while (0)
#define PG8_BAR __builtin_amdgcn_s_barrier()
#define PG8_SCHED __builtin_amdgcn_sched_barrier(0)
  int cpm, cpn, npm = 0, npn = 0, ui = 0;
  if (!unit_next(0, G, bid, nunits, cpm, cpn)) return;
  WAIT_V(0);
  __syncthreads();
  f32x4 acc[2][2][4][2];
#pragma unroll
  for (int a = 0; a < 2; ++a)
#pragma unroll
    for (int b = 0; b < 2; ++b)
#pragma unroll
      for (int m = 0; m < 4; ++m)
#pragma unroll
        for (int n = 0; n < 2; ++n) acc[a][b][m][n] = (f32x4){0.f, 0.f, 0.f, 0.f};
  bf16x8 At[4][2], B0[2][2], B1[2][2];
  const char* cA = (const char*)A + (size_t)cpm * tstep;
  const char* cB = (const char*)Bt + (size_t)cpn * tstep;
  PG8_STAGE(PG8_SB(0, 0), cB, voffB); PG8_STAGE(PG8_SA(0, 0), cA, voffA); PG8_STAGE(PG8_SB(0, 1), cB + hstep, voffB); PG8_STAGE(PG8_SA(0, 1), cA + hstep, voffA);
  if (wr == 1) PG8_BAR;
  WAIT_V(4); PG8_BAR;
  PG8_STAGE(PG8_SB(1, 0), cB + kstep, voffB); PG8_STAGE(PG8_SA(1, 0), cA + kstep, voffA); PG8_STAGE(PG8_SB(1, 1), cB + hstep + kstep, voffB);
  WAIT_V(6); PG8_BAR;
  for (;;) {
    const bool has_next = unit_next(ui + 1, G, bid, nunits, npm, npn);
    const char* nA = has_next ? (const char*)A + (size_t)npm * tstep : cA;
    const char* nB = has_next ? (const char*)Bt + (size_t)npn * tstep : cB;
#pragma unroll 1
    for (int t = 0; t < nt; t += 2) {
      const bool last = (t == nt - 2);
      const char* a1 = cA + (size_t)(t + 1) * kstep;
      const char* a2 = last ? nA : cA + (size_t)(t + 2) * kstep;
      const char* b2 = last ? nB : cB + (size_t)(t + 2) * kstep;
      const char* a3 = a2 + kstep;
      const char* b3 = b2 + kstep;
      PG8_LDB(B0, 0, 0); PG8_SCHED; PG8_LDA(At, 0, 0); PG8_STAGE(PG8_SA(1, 1), a1 + hstep, voffA);
      WAIT_L(8); PG8_BAR; WAIT_L(0); PG8_MMA(0, 0, At, B0); PG8_BAR; PG8_SCHED;
      PG8_LDB(B1, 0, 1); PG8_STAGE(PG8_SB(0, 0), b2, voffB);
      PG8_BAR; WAIT_L(0); PG8_MMA(0, 1, At, B1); PG8_BAR;
      PG8_LDA(At, 0, 1); PG8_STAGE(PG8_SA(0, 0), a2, voffA);
      PG8_BAR; WAIT_L(0); PG8_MMA(1, 0, At, B0); PG8_BAR; PG8_SCHED;
      PG8_STAGE(PG8_SB(0, 1), b2 + hstep, voffB);
      WAIT_V(6); PG8_BAR; PG8_MMA(1, 1, At, B1); PG8_BAR;
      PG8_LDB(B0, 1, 0); PG8_SCHED; PG8_LDA(At, 1, 0); PG8_STAGE(PG8_SA(0, 1), a2 + hstep, voffA);
      WAIT_L(8); PG8_BAR; WAIT_L(0); PG8_MMA(0, 0, At, B0); PG8_BAR; PG8_SCHED;
      PG8_LDB(B1, 1, 1); PG8_STAGE(PG8_SB(1, 0), b3, voffB);
      PG8_BAR; WAIT_L(0); PG8_MMA(0, 1, At, B1); PG8_BAR;
      PG8_LDA(At, 1, 1); PG8_STAGE(PG8_SA(1, 0), a3, voffA);
      PG8_BAR; WAIT_L(0); PG8_MMA(1, 0, At, B0); PG8_BAR; PG8_SCHED;
      PG8_STAGE(PG8_SB(1, 1), b3 + hstep, voffB);
      WAIT_V(6); PG8_BAR; PG8_MMA(1, 1, At, B1); PG8_BAR;
    }
    E(acc, cpm * 256, cpn * 256, wr, wc, fr, fq);
    if (!has_next) break;
#pragma unroll
    for (int a = 0; a < 2; ++a)
#pragma unroll
      for (int b = 0; b < 2; ++b)
#pragma unroll
        for (int m = 0; m < 4; ++m)
#pragma unroll
          for (int n = 0; n < 2; ++n) acc[a][b][m][n] = (f32x4){0.f, 0.f, 0.f, 0.f};
    cpm = npm; cpn = npn; cA = nA; cB = nB; ++ui;
  }
  WAIT_V(0);
  if (wr == 0) PG8_BAR;
  PG8_BAR;
#undef PG8_SA
#undef PG8_SB
#undef PG8_STAGE
#undef PG8_LDA
#undef PG8_LDB
#undef PG8_MMA
#undef PG8_BAR
#undef PG8_SCHED
}
template <class F>
DI void epi8_foreach(const f32x4 (&acc)[2][2][4][2], int m0, int n0, int wr, int wc, int fr, int fq, const F& f) {
#pragma unroll
  for (int ai = 0; ai < 2; ++ai)
#pragma unroll
    for (int m = 0; m < 4; ++m) {
      const int row = m0 + ai * 128 + wr * 64 + m * 16 + fr;
#pragma unroll
      for (int bj = 0; bj < 2; ++bj) f(row, n0 + bj * 128 + wc * 32 + 8 * fq, acc[ai][bj][m][0], acc[ai][bj][m][1]);
    }
}
DI void st_bf8(bfr* p, const f32x4& v0, const f32x4& v1) {
  u32x4 w;
  w[0] = pack2(v0[0], v0[1]); w[1] = pack2(v0[2], v0[3]); w[2] = pack2(v1[0], v1[1]); w[3] = pack2(v1[2], v1[3]);
  *(u32x4*)p = w;
}

DI void epi8_resid(const f32x4 (&acc)[2][2][4][2], int m0, int n0, int wr, int wc, int fr, int fq, const float* hsrc, float* hdst, bfr* hb, float* rowss) {
#pragma unroll
  for (int ai = 0; ai < 2; ++ai)
#pragma unroll
    for (int m = 0; m < 4; ++m) {
      const int row = m0 + ai * 128 + wr * 64 + m * 16 + fr;
      float ss = 0.f;
#pragma unroll
      for (int bj = 0; bj < 2; ++bj) {
        const int n = n0 + bj * 128 + wc * 32 + 8 * fq;
        const float* sp = hsrc + (size_t)row * 2048 + n;
        const f32x4 x0 = *(const f32x4*)sp, x1 = *(const f32x4*)(sp + 4);
        const f32x4 y0 = x0 + acc[ai][bj][m][0], y1 = x1 + acc[ai][bj][m][1];
        float* dp = hdst + (size_t)row * 2048 + n;
        *(f32x4*)dp = y0; *(f32x4*)(dp + 4) = y1;
        st_bf8(hb + (size_t)row * 2048 + n, y0, y1);
        ss += y0[0] * y0[0] + y0[1] * y0[1] + y0[2] * y0[2] + y0[3] * y0[3] + y1[0] * y1[0] + y1[1] * y1[1] + y1[2] * y1[2] + y1[3] * y1[3];
      }
      ss += __shfl_xor(ss, 16);
      ss += __shfl_xor(ss, 32);
      if (fq == 0) atomicAdd(rowss + row, ss);
    }
}
enum { MODE_WIN = 0, MODE_SEL = 1, MODE_X = 2, MODE_RET = 3 };
constexpr int KP = 136;

template <int MODE>
DI void attn_item(const Params& p, int item, char* smem, const int tid) {
  constexpr int VP = 136;
  bfr* Ks = (bfr*)smem;
  bfr* Vs = Ks + 64 * KP;
  const int w = tid >> 6, lane = tid & 63, r = lane & 31, h = lane >> 5;
  bfr* Qw = Vs + 64 * VP + w * 32 * KP;
  char* ws = p.ws;
  const bfr* z = (const bfr*)(ws + OFF_Z);

  int b, t0, tq0, jlo, jhi, head = 0, grp = 0, vh = 0;
  const bfr *qbase, *kbase, *vbase;
  int ldq, ldk;
  unsigned selm = 0, umask = 0xffffffffu;
  if (MODE == MODE_WIN) {
    const int tb = item >> 4, bg = item & 15;
    b = bg >> 2; grp = bg & 3; t0 = tb * 64; tq0 = t0 + 32 * (w >> 2); head = grp * 4 + (w & 3);
    qbase = z + (size_t)(b * SEQ + tq0) * ZS + ZC_Q + head * 128; ldq = ZS;
    kbase = z + (size_t)(b * SEQ) * ZS + ZC_KW + grp * 128;
    vbase = z + (size_t)(b * SEQ) * ZS + ZC_VW + grp * 128;
    ldk = ZS;
    jlo = (t0 - 511 > 0 ? t0 - 511 : 0) >> 6;
    jhi = tb;
  } else if (MODE == MODE_SEL) {
    const int tb = 31 - (item >> 4), bg = item & 15;
    b = bg >> 2; grp = bg & 3; t0 = tb * 64; tq0 = t0 + 32 * (w >> 2); head = grp * 4 + (w & 3);
    qbase = z + (size_t)(b * SEQ + tq0) * ZS + ZC_Q + head * 128; ldq = ZS;
    kbase = z + (size_t)(b * SEQ) * ZS + ZC_KS + grp * 128;
    vbase = z + (size_t)(b * SEQ) * ZS + ZC_VS + grp * 128;
    ldk = ZS;
    jlo = 0;
    jhi = tb;
    const unsigned* sm = (const unsigned*)(ws + OFF_SELM) + (b * 4 + grp) * SEQ;
    selm = sm[tq0 + r];
    unsigned u = sm[t0 + lane];
#pragma unroll
    for (int o = 32; o > 0; o >>= 1) u |= (unsigned)__shfl_xor((int)u, o);
    umask = (unsigned)__builtin_amdgcn_readfirstlane((int)u);
    umask &= (jhi >= 31) ? 0xffffffffu : ((1u << (jhi + 1)) - 1u);
  } else if (MODE == MODE_X) {
    const int tb = item >> 4, bh = item & 15;
    b = bh >> 2; head = bh & 3; t0 = tb * 256; tq0 = t0 + 32 * w;
    qbase = (const bfr*)(ws + OFF_QX) + (size_t)(b * SEQ + tq0) * 512 + head * 128; ldq = 512;
    kbase = (const bfr*)(ws + OFF_KX) + (size_t)(b * 256) * 512 + head * 128;
    vbase = (const bfr*)(ws + OFF_VX) + (size_t)(b * 256) * 512 + head * 128;
    ldk = 512;
    jlo = 0; jhi = 3;
  } else {
    const int tb = 7 - (item >> 6), rest = item & 63;
    b = rest >> 4; head = (rest >> 1) & 7; vh = rest & 1; t0 = tb * 256; tq0 = t0 + 32 * w;
    qbase = z + (size_t)(b * SEQ + tq0) * ZS + ZC_QR + head * 128; ldq = ZS;
    kbase = z + (size_t)(b * SEQ) * ZS + ZC_KR + head * 128;
    vbase = z + (size_t)(b * SEQ) * ZS + ZC_VR + head * 256 + vh * 128;
    ldk = ZS;
    jlo = 0; jhi = 4 * tb + 3;
  }
  const int tq = tq0 + r;

  f32x16 o[4];
#pragma unroll
  for (int dt = 0; dt < 4; ++dt)
#pragma unroll
    for (int i = 0; i < 16; ++i) o[dt][i] = 0.f;
  float m_run = -INFINITY, l_run = 0.f;
  float lg = 0.f;
  float rf[16];
  if (MODE == MODE_RET) {
    lg = log1pf(-exp2f(-5.f - (float)head)) * 1.4426950408889634f;
#pragma unroll
    for (int i = 0; i < 16; ++i) rf[i] = __builtin_amdgcn_exp2f(-lg * (float)crow(i, h));
  }

  u32x4 kreg[2], vreg[2];
  auto gload = [&](int j) {
    const int k0 = j * 64;
#pragma unroll
    for (int i = 0; i < 2; ++i) {
      const int c = tid + 512 * i, row = c >> 4, cc = c & 15;
      kreg[i] = *(const u32x4*)(kbase + (size_t)(k0 + row) * ldk + cc * 8);
      vreg[i] = *(const u32x4*)(vbase + (size_t)(k0 + row) * ldk + cc * 8);
    }
  };
  auto swrite = [&]() {
#pragma unroll
    for (int i = 0; i < 2; ++i) {
      const int c = tid + 512 * i, row = c >> 4, cc = c & 15;
      *(u32x4*)(Ks + row * KP + cc * 8) = kreg[i];
      *(u32x4*)(Vs + row * VP + cc * 8) = vreg[i];
    }
  };
  auto next_j = [&](int j) -> int {
    if (MODE == MODE_SEL) {
      const unsigned rem = (j >= 31) ? 0u : (umask & ~((2u << j) - 1u));
      return rem ? (__builtin_ctz(rem)) : 64;
    }
    return j + 1;
  };
  int j = jlo;
  if (MODE == MODE_SEL) j = __builtin_ctz(umask);
  gload(j);
  __syncthreads();
  {
    u32x4 qreg[8];
#pragma unroll
    for (int i = 0; i < 8; ++i) {
      const int c = lane + 64 * i, row = c >> 4, cc = c & 15;
      qreg[i] = *(const u32x4*)(qbase + (size_t)row * ldq + cc * 8);
    }
#pragma unroll
    for (int i = 0; i < 8; ++i) {
      const int c = lane + 64 * i, row = c >> 4, cc = c & 15;
      *(u32x4*)(Qw + row * KP + cc * 8) = qreg[i];
    }
  }
  const float csc = 0.08838834764831845f * 1.4426950408889634f;
  const int q4 = (lane & 15) >> 2, p4 = lane & 3, blk = (lane >> 4) & 1;
  bool first = true;
#pragma unroll 1
  while (j <= jhi) {
    if (!first) __syncthreads();
    first = false;
    swrite();
    __syncthreads();
    const int jn = next_j(j);
    if (jn <= jhi) gload(jn);
    const int k0 = j * 64;
    if (MODE == MODE_RET && k0 > tq0 + 31) { j = jn; continue; }
    bf16x8 pf[2][2];
    if (MODE == MODE_RET) {
#pragma unroll
      for (int sub = 0; sub < 2; ++sub) {
        f32x16 sx;
#pragma unroll
        for (int i = 0; i < 16; ++i) sx[i] = 0.f;
#pragma unroll
        for (int s = 0; s < 8; ++s) {
          const bf16x8 kf = *(const bf16x8*)(Ks + (32 * sub + r) * KP + 16 * s + 8 * h);
          const bf16x8 qf = *(const bf16x8*)(Qw + r * KP + 16 * s + 8 * h);
          sx = MFMA(kf, qf, sx);
        }
        {
          const int dq = tq - (k0 + 32 * sub);
          const float cf = __builtin_amdgcn_exp2f(lg * (float)dq);
#pragma unroll
          for (int i = 0; i < 16; ++i) sx[i] = (crow(i, h) <= dq) ? sx[i] * (cf * rf[i]) : 0.f;
        }
        pf[sub][0] = pack8(sx, 0);
        pf[sub][1] = pack8(sx, 1);
      }
    } else {
      f32x16 s0, s1;
#pragma unroll
      for (int i = 0; i < 16; ++i) { s0[i] = 0.f; s1[i] = 0.f; }
#pragma unroll
      for (int s = 0; s < 8; ++s) {
        const bf16x8 k0f = *(const bf16x8*)(Ks + r * KP + 16 * s + 8 * h);
        const bf16x8 k1f = *(const bf16x8*)(Ks + (32 + r) * KP + 16 * s + 8 * h);
        const bf16x8 qf = *(const bf16x8*)(Qw + r * KP + 16 * s + 8 * h);
        s0 = MFMA(k0f, qf, s0);
        s1 = MFMA(k1f, qf, s1);
      }
      bool need_mask = false;
      if (MODE == MODE_WIN) need_mask = (k0 + 63 > tq0) || (k0 < tq0 + 31 - 511);
      if (MODE == MODE_SEL) need_mask = (k0 + 63 > tq0);
      const bool lanesel = (MODE == MODE_SEL) ? ((selm >> j) & 1u) : true;
      float mx = -INFINITY;
      if (need_mask) {
#pragma unroll
        for (int i = 0; i < 16; ++i) {
          const int tk0 = k0 + crow(i, h), tk1 = tk0 + 32;
          bool ok0 = true, ok1 = true;
          if (MODE == MODE_WIN) { ok0 = (tk0 <= tq) && (tq - tk0 < 512); ok1 = (tk1 <= tq) && (tq - tk1 < 512); }
          if (MODE == MODE_SEL) { ok0 = lanesel && (tk0 <= tq); ok1 = lanesel && (tk1 <= tq); }
          s0[i] = ok0 ? s0[i] * csc : -INFINITY;
          s1[i] = ok1 ? s1[i] * csc : -INFINITY;
          mx = fmaxf(mx, fmaxf(s0[i], s1[i]));
        }
      } else {
#pragma unroll
        for (int i = 0; i < 16; ++i) {
          s0[i] = lanesel ? s0[i] * csc : -INFINITY;
          s1[i] = lanesel ? s1[i] * csc : -INFINITY;
          mx = fmaxf(mx, fmaxf(s0[i], s1[i]));
        }
      }
      mx = fmaxf(mx, __shfl_xor(mx, 32));
      const float mnew = fmaxf(m_run, mx);
      const float muse = (mnew == -INFINITY) ? 0.f : mnew;
      const float alpha = __builtin_amdgcn_exp2f(m_run - muse);
      float ls = 0.f;
#pragma unroll
      for (int i = 0; i < 16; ++i) {
        s0[i] = __builtin_amdgcn_exp2f(s0[i] - muse);
        s1[i] = __builtin_amdgcn_exp2f(s1[i] - muse);
        ls += s0[i] + s1[i];
      }
      ls += __shfl_xor(ls, 32);
      l_run = l_run * alpha + ls;
      m_run = mnew;
      if (__builtin_amdgcn_ballot_w64(alpha != 1.f) != 0) {
#pragma unroll
        for (int dt = 0; dt < 4; ++dt)
#pragma unroll
          for (int i = 0; i < 16; ++i) o[dt][i] *= alpha;
      }
      pf[0][0] = pack8(s0, 0); pf[0][1] = pack8(s0, 1);
      pf[1][0] = pack8(s1, 0); pf[1][1] = pack8(s1, 1);
    }
#pragma unroll
    for (int dt = 0; dt < 4; ++dt)
#pragma unroll
      for (int sub = 0; sub < 2; ++sub)
#pragma unroll
        for (int st = 0; st < 2; ++st) {
          const int key0 = 32 * sub + 16 * st + 4 * h;
          const bfr* vp = Vs + (key0 + q4) * VP + 32 * dt + 16 * blk + 4 * p4;
          const s16x4 lo = tr_read(vp);
          const s16x4 hi = tr_read(vp + 8 * VP);
          const bf16x8 vf = __builtin_shufflevector(lo, hi, 0, 1, 2, 3, 4, 5, 6, 7);
          o[dt] = MFMA(vf, pf[sub][st], o[dt]);
        }
    j = jn;
  }

  if (MODE == MODE_SEL && p.dbg) return;
  const size_t mrow = (size_t)(b * SEQ + tq);
  if (MODE == MODE_WIN || MODE == MODE_SEL) {
    const float inv = (l_run > 0.f) ? 1.f / l_run : 0.f;
    const float gate = bflo(z[mrow * ZS + ZC_GN + head * 3 + (MODE == MODE_WIN ? 2 : 1)]);
    bfr* orow = (bfr*)(ws + OFF_ONSA) + mrow * 2048 + head * 128;
    const float sc = inv * gate;
#pragma unroll
    for (int dt = 0; dt < 4; ++dt)
#pragma unroll
      for (int g = 0; g < 4; ++g) {
        bfr* dst = orow + 32 * dt + 8 * g + 4 * h;
        float a = o[dt][4 * g] * sc, bb = o[dt][4 * g + 1] * sc, c = o[dt][4 * g + 2] * sc, d = o[dt][4 * g + 3] * sc;
        if (MODE == MODE_SEL) {
          const uint2 old = *(const uint2*)dst;
          a += bflo(old.x); bb += bfhi(old.x); c += bflo(old.y); d += bfhi(old.y);
        }
        st_bf4(dst, a, bb, c, d);
      }
  } else if (MODE == MODE_X) {
    const float inv = 1.f / l_run;
    bfr* orow = (bfr*)(ws + OFF_OX) + mrow * 512 + head * 128;
#pragma unroll
    for (int dt = 0; dt < 4; ++dt)
#pragma unroll
      for (int g = 0; g < 4; ++g)
        st_bf4(orow + 32 * dt + 8 * g + 4 * h, o[dt][4 * g] * inv, o[dt][4 * g + 1] * inv, o[dt][4 * g + 2] * inv,
               o[dt][4 * g + 3] * inv);
  } else {
    float sm = 0.f, sq = 0.f;
#pragma unroll
    for (int dt = 0; dt < 4; ++dt)
#pragma unroll
      for (int i = 0; i < 16; ++i) { sm += o[dt][i]; sq += o[dt][i] * o[dt][i]; }
    sm += __shfl_xor(sm, 32);
    sq += __shfl_xor(sq, 32);
    if (h == 0) *(float2*)((float*)(ws + OFF_RSTAT) + ((mrow * 8 + head) * 2 + vh) * 2) = make_float2(sm, sq);
    bfr* orow = (bfr*)(ws + OFF_ORET) + mrow * 2048 + head * 256 + vh * 128;
#pragma unroll
    for (int dt = 0; dt < 4; ++dt)
#pragma unroll
      for (int g = 0; g < 4; ++g)
        st_bf4(orow + 32 * dt + 8 * g + 4 * h, o[dt][4 * g], o[dt][4 * g + 1], o[dt][4 * g + 2], o[dt][4 * g + 3]);
  }
}

DI void ret_finish_row(const Params& p, int row, const int t) {
  char* ws = p.ws;
  const bfr* z = (const bfr*)(ws + OFF_Z);
  const int col = t * 8, head = t >> 5;
  const float4 st = *(const float4*)((const float*)(ws + OFF_RSTAT) + ((size_t)row * 8 + head) * 4);
  const float mu = (st.x + st.z) * (1.f / 256.f);
  const float var = fmaxf((st.y + st.w) * (1.f / 256.f) - mu * mu, 0.f);
  const float rstd = rsqrtf(var + 1e-6f);
  bfr* op = (bfr*)(ws + OFF_ORET) + (size_t)row * 2048 + col;
  const u32x4 ov = *(const u32x4*)op;
  const u32x4 gv = *(const u32x4*)(z + (size_t)row * ZS + ZC_GR + col);
  const float4 w0 = *(const float4*)(p.gn_w + col), w1 = *(const float4*)(p.gn_w + col + 4);
  u32x4 res;
  res[0] = pack2((bflo(ov[0]) - mu) * rstd * w0.x * bflo(gv[0]), (bfhi(ov[0]) - mu) * rstd * w0.y * bfhi(gv[0]));
  res[1] = pack2((bflo(ov[1]) - mu) * rstd * w0.z * bflo(gv[1]), (bfhi(ov[1]) - mu) * rstd * w0.w * bfhi(gv[1]));
  res[2] = pack2((bflo(ov[2]) - mu) * rstd * w1.x * bflo(gv[2]), (bfhi(ov[2]) - mu) * rstd * w1.y * bfhi(gv[2]));
  res[3] = pack2((bflo(ov[3]) - mu) * rstd * w1.z * bflo(gv[3]), (bfhi(ov[3]) - mu) * rstd * w1.w * bfhi(gv[3]));
  *(u32x4*)op = res;
}

DI void ret_finish_rows4(const Params& p, int row0, const int t) {
  char* ws = p.ws;
  const bfr* z = (const bfr*)(ws + OFF_Z);
  const int col = t * 8, head = t >> 5;
  float4 st[4];
  u32x4 ov[4], gv[4];
#pragma unroll
  for (int q = 0; q < 4; ++q) {
    const size_t row = (size_t)(row0 + 2 * q);
    st[q] = *(const float4*)((const float*)(ws + OFF_RSTAT) + (row * 8 + head) * 4);
    ov[q] = *(const u32x4*)((const bfr*)(ws + OFF_ORET) + row * 2048 + col);
    gv[q] = *(const u32x4*)(z + row * ZS + ZC_GR + col);
  }
  const float4 w0 = *(const float4*)(p.gn_w + col), w1 = *(const float4*)(p.gn_w + col + 4);
#pragma unroll
  for (int q = 0; q < 4; ++q) {
    const float mu = (st[q].x + st[q].z) * (1.f / 256.f);
    const float var = fmaxf((st[q].y + st[q].w) * (1.f / 256.f) - mu * mu, 0.f);
    const float rstd = rsqrtf(var + 1e-6f);
    u32x4 res;
    res[0] = pack2((bflo(ov[q][0]) - mu) * rstd * w0.x * bflo(gv[q][0]), (bfhi(ov[q][0]) - mu) * rstd * w0.y * bfhi(gv[q][0]));
    res[1] = pack2((bflo(ov[q][1]) - mu) * rstd * w0.z * bflo(gv[q][1]), (bfhi(ov[q][1]) - mu) * rstd * w0.w * bfhi(gv[q][1]));
    res[2] = pack2((bflo(ov[q][2]) - mu) * rstd * w1.x * bflo(gv[q][2]), (bfhi(ov[q][2]) - mu) * rstd * w1.y * bfhi(gv[q][2]));
    res[3] = pack2((bflo(ov[q][3]) - mu) * rstd * w1.z * bflo(gv[q][3]), (bfhi(ov[q][3]) - mu) * rstd * w1.w * bfhi(gv[q][3]));
    *(u32x4*)((bfr*)(ws + OFF_ORET) + (size_t)(row0 + 2 * q) * 2048 + col) = res;
  }
}

DI void cmp_item(const Params& p, int item, char* smem, const int tid) {
  bfr* Ks = (bfr*)smem;
  float* impw = (float*)(smem + 128 * KP * 2);
  const int w = tid >> 6, lane = tid & 63, r = lane & 31, h = lane >> 5;
  char* ws = p.ws;
  const bfr* z = (const bfr*)(ws + OFF_Z);
  const int tb = item >> 4, bg = item & 15, b = bg >> 2, grp = bg & 3;
  const int t0 = tb * 64, ti = 32 * (w >> 2) + r, tq = t0 + ti, hw = w & 3, head = grp * 4 + hw;
  const bfr* qrow = z + (size_t)(b * SEQ + tq) * ZS + ZC_Q + head * 128;
  const bfr* kc = (const bfr*)(ws + OFF_KCVC) + (size_t)((b * 4 + grp) * 128) * 128;
  const bfr* vc = kc + (size_t)2048 * 128;
  bf16x8 qf[8];
#pragma unroll
  for (int s = 0; s < 8; ++s) qf[s] = *(const bf16x8*)(qrow + 16 * s + 8 * h);
  u32x4 reg[4];
#pragma unroll
  for (int i = 0; i < 4; ++i) {
    const int c = tid + 512 * i, row = c >> 4, cc = c & 15;
    reg[i] = *(const u32x4*)(kc + row * 128 + cc * 8);
  }
  __syncthreads();
#pragma unroll
  for (int i = 0; i < 4; ++i) {
    const int c = tid + 512 * i, row = c >> 4, cc = c & 15;
    *(u32x4*)(Ks + row * KP + cc * 8) = reg[i];
  }
  __syncthreads();
  f32x16 s[4];
#pragma unroll
  for (int kt = 0; kt < 4; ++kt) {
#pragma unroll
    for (int i = 0; i < 16; ++i) s[kt][i] = 0.f;
#pragma unroll
    for (int ss = 0; ss < 8; ++ss) {
      const bf16x8 kf = *(const bf16x8*)(Ks + (32 * kt + r) * KP + 16 * ss + 8 * h);
      s[kt] = MFMA(kf, qf[ss], s[kt]);
    }
  }
  const float csc = 0.08838834764831845f * 1.4426950408889634f;
  float mx = -INFINITY;
#pragma unroll
  for (int kt = 0; kt < 4; ++kt)
#pragma unroll
    for (int i = 0; i < 16; ++i) {
      const int c = 32 * kt + crow(i, h);
      const bool ok = (c * 16 + 31 <= tq) && (c < 127);
      s[kt][i] = ok ? s[kt][i] * csc : -INFINITY;
      mx = fmaxf(mx, s[kt][i]);
    }
  mx = fmaxf(mx, __shfl_xor(mx, 32));
  const float muse = (mx == -INFINITY) ? 0.f : mx;
  float ls = 0.f;
#pragma unroll
  for (int kt = 0; kt < 4; ++kt)
#pragma unroll
    for (int i = 0; i < 16; ++i) {
      s[kt][i] = __builtin_amdgcn_exp2f(s[kt][i] - muse);
      ls += s[kt][i];
    }
  ls += __shfl_xor(ls, 32);
  const float inv = (ls > 0.f) ? 1.f / ls : 0.f;
#pragma unroll
  for (int kt = 0; kt < 4; ++kt)
#pragma unroll
    for (int i = 0; i < 16; ++i) s[kt][i] *= inv;
  float plast[16];
#pragma unroll
  for (int kt = 0; kt < 4; ++kt)
#pragma unroll
    for (int g = 0; g < 4; ++g) plast[kt * 4 + g] = __shfl_xor(s[kt][4 * g + 3], 32);
#pragma unroll
  for (int kt = 0; kt < 4; ++kt)
#pragma unroll
    for (int g = 0; g < 4; ++g) {
      const int slot = kt * 4 + g;
      const float sum4 = s[kt][4 * g] + s[kt][4 * g + 1] + s[kt][4 * g + 2] + s[kt][4 * g + 3];
      const float prevl = (slot > 0) ? plast[slot > 0 ? slot - 1 : 0] : 0.f;
      const float add = h ? plast[slot] : prevl;
      impw[(hw * 64 + ti) * 32 + 8 * kt + 2 * g + h] = sum4 + add;
    }
  bf16x8 pf[4][2];
#pragma unroll
  for (int kt = 0; kt < 4; ++kt) { pf[kt][0] = pack8(s[kt], 0); pf[kt][1] = pack8(s[kt], 1); }
#pragma unroll
  for (int i = 0; i < 4; ++i) {
    const int c = tid + 512 * i, row = c >> 4, cc = c & 15;
    reg[i] = *(const u32x4*)(vc + row * 128 + cc * 8);
  }
  __syncthreads();
#pragma unroll
  for (int i = 0; i < 4; ++i) {
    const int c = tid + 512 * i, row = c >> 4, cc = c & 15;
    *(u32x4*)(Ks + row * KP + cc * 8) = reg[i];
  }
  __syncthreads();
  f32x16 o[4];
#pragma unroll
  for (int dt = 0; dt < 4; ++dt)
#pragma unroll
    for (int i = 0; i < 16; ++i) o[dt][i] = 0.f;
  const int q4 = (lane & 15) >> 2, p4 = lane & 3, blk = (lane >> 4) & 1;
#pragma unroll
  for (int dt = 0; dt < 4; ++dt)
#pragma unroll
    for (int kt = 0; kt < 4; ++kt)
#pragma unroll
      for (int st = 0; st < 2; ++st) {
        const int key0 = 32 * kt + 16 * st + 4 * h;
        const bfr* vp = Ks + (key0 + q4) * KP + 32 * dt + 16 * blk + 4 * p4;
        const s16x4 lo = tr_read(vp);
        const s16x4 hi = tr_read(vp + 8 * KP);
        const bf16x8 vf = __builtin_shufflevector(lo, hi, 0, 1, 2, 3, 4, 5, 6, 7);
        o[dt] = MFMA(vf, pf[kt][st], o[dt]);
      }
  {
    const size_t mrow = (size_t)(b * SEQ + tq);
    const float gate = bflo(z[mrow * ZS + ZC_GN + head * 3 + 0]);
    bfr* orow = (bfr*)(ws + OFF_ONSA) + mrow * 2048 + head * 128;
#pragma unroll
    for (int dt = 0; dt < 4; ++dt)
#pragma unroll
      for (int g = 0; g < 4; ++g) {
        bfr* dst = orow + 32 * dt + 8 * g + 4 * h;
        const uint2 old = *(const uint2*)dst;
        st_bf4(dst, o[dt][4 * g] * gate + bflo(old.x), o[dt][4 * g + 1] * gate + bfhi(old.x),
               o[dt][4 * g + 2] * gate + bflo(old.y), o[dt][4 * g + 3] * gate + bfhi(old.y));
      }
  }
  {
    const int i = tid >> 3, jg = tid & 7;
    const int cur = (t0 + i) >> 6;
    float vm[4];
#pragma unroll
    for (int e = 0; e < 4; ++e) {
      const int jme = 4 * jg + e;
      const float a = impw[(0 * 64 + i) * 32 + jme] + impw[(1 * 64 + i) * 32 + jme] + impw[(2 * 64 + i) * 32 + jme] + impw[(3 * 64 + i) * 32 + jme];
      const bool forced = (jme == 0) || (jme == cur) || (jme == cur - 1);
      vm[e] = forced ? INFINITY : ((jme > cur) ? -INFINITY : a);
    }
#pragma unroll
    for (int e = 0; e < 4; ++e) impw[i * 32 + 4 * jg + e] = vm[e];
    __syncthreads();
    int rank[4] = {0, 0, 0, 0};
#pragma unroll 4
    for (int k = 0; k < 32; ++k) {
      const float vk = impw[i * 32 + k];
#pragma unroll
      for (int e = 0; e < 4; ++e) rank[e] += (vk > vm[e] || (vk == vm[e] && k < 4 * jg + e)) ? 1 : 0;
    }
    unsigned bits = 0;
#pragma unroll
    for (int e = 0; e < 4; ++e)
      if (rank[e] < 16 && 4 * jg + e <= cur) bits |= 1u << (4 * jg + e);
    bits |= (unsigned)__shfl_xor((int)bits, 1);
    bits |= (unsigned)__shfl_xor((int)bits, 2);
    bits |= (unsigned)__shfl_xor((int)bits, 4);
    if (jg == 0) ((unsigned*)(ws + OFF_SELM))[(b * 4 + grp) * SEQ + t0 + i] = bits;
  }
  __syncthreads();
}

DI int grab(unsigned* ctr, int* slot, const int tid) {
  __syncthreads();
  if (tid == 0) *slot = (int)atomicAdd(ctr, 1u);
  __syncthreads();
  return *slot;
}

DI void run_phase(const Params& p0, int ph, char* smem, int* slot, const int wave_s, const int rep) {
  char* ws = p0.ws;
  asm volatile("" : "+s"(ws));
  Params p = p0;
  p.ws = ws;
  p.dbg = rep;
  const int G = gridDim.x;
  int bid = blockIdx.x;
  int tid = wave_s * 64 + (int)__builtin_amdgcn_mbcnt_hi(~0u, __builtin_amdgcn_mbcnt_lo(~0u, 0u));
  asm volatile("" : "+s"(bid));
  asm volatile("" : "+v"(tid));
  bfr* z = (bfr*)(ws + OFF_Z);
  unsigned* ctr = (unsigned*)(ws + OFF_CTR) + rep * 8;
  switch (ph) {
    case 0: {
      if (bid == 0 && tid < 64) ((unsigned*)(ws + OFF_CTR))[tid] = 0u;
      for (int i = bid * NTHR + tid; i < 2 * NTOK; i += G * NTHR) ((float*)(ws + OFF_ROWSS))[i] = 0.f;
      int tot = 0;
      for (int j = 0; j < 3; ++j) tot += tjob_tiles(j);
      const int n_norm = 1024 + 128, n_rope = 256;
      tr_run(p, 0, bid, G, tot, (float*)smem, tid);
      for (int it = tot + bid; it < tot + n_norm + n_rope; it += G) {
        if (it < tot + n_norm) {
          const int row = (it - tot) * 8 + (tid >> 6);
          if (row < NTOK) rmsnorm_row(p.x + (size_t)row * 2048, p.attn_norm_w, (bfr*)(ws + OFF_N) + (size_t)row * 2048, nullptr, tid);
          else rmsnorm_row(p.mem + (size_t)(row - NTOK) * 2048, p.mem_norm_w, (bfr*)(ws + OFF_MN) + (size_t)(row - NTOK) * 2048, nullptr, tid);
        } else {
          const int e = (it - tot - n_norm) * 512 + tid;
          const int t = e >> 6, i = e & 63;
          const float ang = (float)t * ROPE_INV[i];
          const float kk = rintf(ang * 0.15915494309189535f);
          float rr = fmaf(-kk, 6.2831854820251465f, ang);
          rr = fmaf(-kk, -1.7484555e-7f, rr);
          const float fr = rr * 0.15915494309189535f;
          ((float2*)(ws + OFF_ROPE))[e] = make_float2(__builtin_amdgcn_cosf(fr), __builtin_amdgcn_sinf(fr));
        }
      }
    } break;
    case 1: {
      {
        bfr* zcb = (bfr*)(ws + OFF_ZC);
        const float* rope = (const float*)(ws + OFF_ROPE);
        gemm8_phase(smem, (const bfr*)(ws + OFF_N), (const bfr*)(ws + OFF_WINT), 2048, 32 * 61, G, bid, tid,
          [&](const f32x4 (&acc)[2][2][4][2], int m0, int n0, int wr, int wc, int fr, int fq) {
            if (n0 < ZC_KC || (n0 >= ZC_KS && n0 < ZC_QR) || (n0 >= ZC_VR && n0 < ZC_GR)) {
              epi8_foreach(acc, m0, n0, wr, wc, fr, fq, [&](int m, int n, const f32x4& v0, const f32x4& v1) { st_bf8(z + (size_t)m * ZS + n, v0, v1); });
            } else if (n0 < ZC_KS) {
              const float* pe = (n0 < ZC_VC) ? p.pe_k : p.pe_v;
              epi8_foreach(acc, m0, n0, wr, wc, fr, fq, [&](int m, int n, const f32x4& v0, const f32x4& v1) {
                const int t = m & 2047, dd = n & 127;
                const float* pl = pe + (t & 15) * 128 + dd;
                const float* ph_ = pl + 16 * 128;
                const f32x4 l0 = *(const f32x4*)pl, l1 = *(const f32x4*)(pl + 4), h0 = *(const f32x4*)ph_, h1 = *(const f32x4*)(ph_ + 4);
                bfr* d = zcb + (size_t)m * 2048 + (n - ZC_KC);
                st_bf8(d, v0 + l0, v1 + l1);
                st_bf8(d + 1024, v0 + h0, v1 + h1);
              });
            } else if (n0 < ZC_VR) {
              const float sc = (n0 >= ZC_KR) ? 0.08838834764831845f : 1.f;
              epi8_foreach(acc, m0, n0, wr, wc, fr, fq, [&](int m, int n, const f32x4& v0, const f32x4& v1) {
                const int t = m & 2047, i0 = (n & 127) >> 1;
                const float* rp = rope + (size_t)(t * 64 + i0) * 2;
                const f32x4 c01 = *(const f32x4*)rp, c23 = *(const f32x4*)(rp + 4);
                f32x4 a0, a1;
                a0[0] = (v0[0] * c01[0] - v0[1] * c01[1]) * sc; a0[1] = (v0[0] * c01[1] + v0[1] * c01[0]) * sc;
                a0[2] = (v0[2] * c01[2] - v0[3] * c01[3]) * sc; a0[3] = (v0[2] * c01[3] + v0[3] * c01[2]) * sc;
                a1[0] = (v1[0] * c23[0] - v1[1] * c23[1]) * sc; a1[1] = (v1[0] * c23[1] + v1[1] * c23[0]) * sc;
                a1[2] = (v1[2] * c23[2] - v1[3] * c23[3]) * sc; a1[3] = (v1[2] * c23[3] + v1[3] * c23[2]) * sc;
                st_bf8(z + (size_t)m * ZS + n, a0, a1);
              });
            } else if (n0 < ZC_GA) {
              epi8_foreach(acc, m0, n0, wr, wc, fr, fq, [&](int m, int n, const f32x4& v0, const f32x4& v1) {
                f32x4 a0, a1;
#pragma unroll
                for (int j = 0; j < 4; ++j) { a0[j] = v0[j] * sigmoidf_(v0[j]); a1[j] = v1[j] * sigmoidf_(v1[j]); }
                st_bf8(z + (size_t)m * ZS + n, a0, a1);
              });
            } else {
              epi8_foreach(acc, m0, n0, wr, wc, fr, fq, [&](int m, int n, const f32x4& v0, const f32x4& v1) {
                if (n >= ZS) return;
                f32x4 a0, a1;
#pragma unroll
                for (int j = 0; j < 4; ++j) { a0[j] = sigmoidf_(v0[j]); a1[j] = sigmoidf_(v1[j]); }
                st_bf8(z + (size_t)m * ZS + n, a0, a1);
              });
            }
          });
      }
      {
        const int nunits = 32 * 61;
        const int nlong = (nunits % G == 0) ? 0 : nunits % G;
        const int nshort = G - nlong;
        const int sb_ = bid - nlong;
        if (sb_ >= 0) {
          for (int u = sb_; u < 32; u += nshort) {
            f32x16 acc[1][4];
            acc_zero<1>(acc);
            const int which = u >> 4, mt = (u & 15) >> 2, nt = u & 3;
            const int m0 = mt * 256, n0 = nt * 128;
            PlainPtr af{(const bfr*)(ws + OFF_MN) + (size_t)m0 * 2048, 2048};
            PlainPtr bf{(const bfr*)(ws + (which ? OFF_WVT : OFF_WKT)) + (size_t)n0 * 2048, 2048};
            gemm_main<1>(acc, af, bf, 32, smem, tid);
            bfr* dstb = (bfr*)(ws + (which ? OFF_VX : OFF_KX));
            gemm_epi<1>(acc, m0, n0, tid, [&](int m, int n, float a, float b, float c, float d) { st_bf4(dstb + (size_t)m * 512 + n, a, b, c, d); });
          }
          int tot2 = 0;
          for (int j = 3; j < 12; ++j) tot2 += tjob_tiles(j);
          tr_run(p, 3, sb_, nshort, tot2, (float*)smem, tid);
        }
      }
    } break;
    case 2: {
      for (int it = grab(ctr + 0, slot, tid); it < 64; it = grab(ctr + 0, slot, tid)) {
        const int which = it >> 5, mt = (it & 31) >> 2, nt = it & 3;
        const int m0 = mt * 256, n0 = nt * 256;
        f32x16 acc[2][4];
        acc_zero<2>(acc);
        struct GatherA {
          const bfr* base; int m0;
          DI int rowoff(int row) const {
            const int R = m0 + row;
            const int bb = R >> 9, g = (R >> 7) & 3;
            int c = R & 127; c = c > 126 ? 126 : c;
            return (bb * SEQ + c * 16) * 2048 + g * 128;
          }
          DI int koff(int kk) const { const int l = kk >> 7; return l * 2048 + ((l >> 4) << 10) + (kk & 127); }
        };
        GatherA af{(const bfr*)(ws + OFF_ZC) + which * 512, m0};
        PlainPtr bf{(const bfr*)(ws + OFF_W1T) + (size_t)which * 1024 * 4096 + (size_t)n0 * 4096, 4096};
        gemm_main<2>(acc, af, bf, 64, smem, tid);
        bfr* hid = (bfr*)(ws + OFF_HIDC) + (size_t)which * 2048 * 1024;
        gemm_epi<2>(acc, m0, n0, tid, [&](int m, int n, float a, float b, float c, float d) {
          st_bf4(hid + (size_t)m * 1024 + n, a * sigmoidf_(a), b * sigmoidf_(b), c * sigmoidf_(c), d * sigmoidf_(d));
        });
      }
      for (int it = grab(ctr + 1, slot, tid); it < 1024; it = grab(ctr + 1, slot, tid)) {
        if (it < 512) attn_item<MODE_RET>(p, it, smem, tid);
        else attn_item<MODE_WIN>(p, it - 512, smem, tid);
      }
    } break;
    case 3: {
      for (int it = bid; it < 16 + NTOK / 8; it += G) {
        if (it >= 16) { ret_finish_rows4(p, (it - 16) * 8 + (tid >> 8), tid & 255); continue; }
        const int which = it >> 3, mt = it & 7;
        const int m0 = mt * 256;
        f32x16 acc[1][4];
        acc_zero<1>(acc);
        PlainPtr af{(const bfr*)(ws + OFF_HIDC) + (size_t)which * 2048 * 1024 + (size_t)m0 * 1024, 1024};
        PlainPtr bf{(const bfr*)(ws + OFF_W2T) + (size_t)which * 128 * 1024, 1024};
        gemm_main<1>(acc, af, bf, 16, smem, tid);
        bfr* dstb = (bfr*)(ws + OFF_KCVC) + (size_t)which * 2048 * 128;
        gemm_epi<1>(acc, m0, 0, tid, [&](int m, int n, float a, float b, float c, float d) { st_bf4(dstb + (size_t)m * 128 + n, a, b, c, d); });
      }
    } break;
    case 4: {
      for (int it = bid; it < 512; it += G) cmp_item(p, it, smem, tid);
    } break;
    case 5: {
      for (int it = grab(ctr + 2, slot, tid); it < 512; it = grab(ctr + 2, slot, tid)) attn_item<MODE_SEL>(p, it, smem, tid);
    } break;
    case 6: {
      bfr* mg = (bfr*)(ws + OFF_MERGED);
      gemm8_phase(smem, (const bfr*)(ws + OFF_ONSA), (const bfr*)(ws + OFF_WAT), 2048, 32 * 8, G, bid, tid,
        [&](const f32x4 (&acc)[2][2][4][2], int m0, int n0, int wr, int wc, int fr, int fq) {
          epi8_foreach(acc, m0, n0, wr, wc, fr, fq, [&](int m, int n, const f32x4& v0, const f32x4& v1) {
            const u32x4 ga = *(const u32x4*)(z + (size_t)m * ZS + ZC_GA + n);
            f32x4 a0 = {bflo(ga[0]) * v0[0], bfhi(ga[0]) * v0[1], bflo(ga[1]) * v0[2], bfhi(ga[1]) * v0[3]};
            f32x4 a1 = {bflo(ga[2]) * v1[0], bfhi(ga[2]) * v1[1], bflo(ga[3]) * v1[2], bfhi(ga[3]) * v1[3]};
            st_bf8(mg + (size_t)m * 2048 + n, a0, a1);
          });
        });
      gemm8_phase(smem, (const bfr*)(ws + OFF_ORET), (const bfr*)(ws + OFF_WBT), 2048, 32 * 8, G, bid, tid,
        [&](const f32x4 (&acc)[2][2][4][2], int m0, int n0, int wr, int wc, int fr, int fq) {
          epi8_foreach(acc, m0, n0, wr, wc, fr, fq, [&](int m, int n, const f32x4& v0, const f32x4& v1) {
            const u32x4 gb = *(const u32x4*)(z + (size_t)m * ZS + ZC_GB + n);
            bfr* dst = mg + (size_t)m * 2048 + n;
            const u32x4 old = *(const u32x4*)dst;
            f32x4 a0 = {bflo(old[0]) + bflo(gb[0]) * v0[0], bfhi(old[0]) + bfhi(gb[0]) * v0[1], bflo(old[1]) + bflo(gb[1]) * v0[2], bfhi(old[1]) + bfhi(gb[1]) * v0[3]};
            f32x4 a1 = {bflo(old[2]) + bflo(gb[2]) * v1[0], bfhi(old[2]) + bfhi(gb[2]) * v1[1], bflo(old[3]) + bflo(gb[3]) * v1[2], bfhi(old[3]) + bfhi(gb[3]) * v1[3]};
            st_bf8(dst, a0, a1);
          });
        });
    } break;
    case 7: {
      gemm8_phase(smem, (const bfr*)(ws + OFF_MERGED), (const bfr*)(ws + OFF_WOUTT), 2048, 32 * 8, G, bid, tid,
        [&](const f32x4 (&acc)[2][2][4][2], int m0, int n0, int wr, int wc, int fr, int fq) {
          epi8_resid(acc, m0, n0, wr, wc, fr, fq, p.x, (float*)(ws + OFF_H), (bfr*)(ws + OFF_NX), (float*)(ws + OFF_ROWSS));
        });
    } break;
    case 8: case 12: break;
    case 9: {
      const int ng = (G > 128) ? 128 : G;
      if (bid < ng)
      for (int v = bid; v < 32 * 4; v += ng) {
        int mt, nt;
        map_tile32(v, mt, nt);
        const int m0 = mt * 256, n0 = nt * 128;
        f32x16 acc[1][4];
        acc_zero<1>(acc);
        PlainPtr af{(const bfr*)(ws + OFF_NX) + (size_t)m0 * 2048, 2048};
        PlainPtr bf{(const bfr*)(ws + OFF_WQT) + (size_t)n0 * 2048, 2048};
        gemm_main<1>(acc, af, bf, 32, smem, tid);
        bfr* qx = (bfr*)(ws + OFF_QX);
        const float* rss = (const float*)(ws + OFF_ROWSS);
        gemm_epi<1>(acc, m0, n0, tid, [&](int m, int n, float a, float b, float c, float d) {
          const float rs = rsqrtf(rss[m] * (1.f / 2048.f) + 1e-6f);
          st_bf4(qx + (size_t)m * 512 + n, a * rs, b * rs, c * rs, d * rs);
        });
      }
      {
        const int nt12 = tjob_tiles(12);
        for (int c = grab(ctr + 3, slot, tid); c * 8 < nt12; c = grab(ctr + 3, slot, tid))
          tr_run(p, 12, c * 8, 1, (c * 8 + 8 < nt12) ? c * 8 + 8 : nt12, (float*)smem, tid);
      }
    } break;
    case 10: {
      const int ng = (G > 128) ? 128 : G;
      if (bid < ng)
        for (int it = bid; it < 128; it += ng) attn_item<MODE_X>(p, it, smem, tid);
      {
        const int nt13 = tjob_tiles(13);
        for (int c = grab(ctr + 4, slot, tid); c * 8 < nt13; c = grab(ctr + 4, slot, tid))
          tr_run(p, 13, c * 8, 1, (c * 8 + 8 < nt13) ? c * 8 + 8 : nt13, (float*)smem, tid);
      }
    } break;
    case 11: {
      gemm8_phase(smem, (const bfr*)(ws + OFF_OX), (const bfr*)(ws + OFF_WOT), 512, 32 * 8, G, bid, tid,
        [&](const f32x4 (&acc)[2][2][4][2], int m0, int n0, int wr, int wc, int fr, int fq) {
          epi8_resid(acc, m0, n0, wr, wc, fr, fq, (const float*)(ws + OFF_H), (float*)(ws + OFF_H), (bfr*)(ws + OFF_NX), (float*)(ws + OFF_ROWSS) + NTOK);
        });
    } break;
    case 13: {
      bfr* hid = (bfr*)(ws + OFF_HID);
      const float* rss = (const float*)(ws + OFF_ROWSS) + NTOK;
      gemm8_phase(smem, (const bfr*)(ws + OFF_NX), (const bfr*)(ws + OFF_WUPT), 2048, 32 * 32, G, bid, tid,
        [&](const f32x4 (&acc)[2][2][4][2], int m0, int n0, int wr, int wc, int fr, int fq) {
          epi8_foreach(acc, m0, n0, wr, wc, fr, fq, [&](int m, int n, const f32x4& v0, const f32x4& v1) {
            const float rs = rsqrtf(rss[m] * (1.f / 2048.f) + 1e-6f);
            f32x4 a0, a1;
#pragma unroll
            for (int j = 0; j < 4; ++j) { const float t0 = fmaxf(v0[j], 0.f) * rs, t1 = fmaxf(v1[j], 0.f) * rs; a0[j] = t0 * t0; a1[j] = t1 * t1; }
            st_bf8(hid + (size_t)m * 8192 + n, a0, a1);
          });
        });
    } break;
    case 14: {
      const float* hbuf = (const float*)(ws + OFF_H);
      gemm8_phase(smem, (const bfr*)(ws + OFF_HID), (const bfr*)(ws + OFF_WDOWNT), 8192, 32 * 8, G, bid, tid,
        [&](const f32x4 (&acc)[2][2][4][2], int m0, int n0, int wr, int wc, int fr, int fq) {
          epi8_foreach(acc, m0, n0, wr, wc, fr, fq, [&](int m, int n, const f32x4& v0, const f32x4& v1) {
            const float* sp = hbuf + (size_t)m * 2048 + n;
            const f32x4 x0 = *(const f32x4*)sp, x1 = *(const f32x4*)(sp + 4);
            float* dp = p.out + (size_t)m * 2048 + n;
            *(f32x4*)dp = x0 + v0; *(f32x4*)(dp + 4) = x1 + v1;
          });
        });
    } break;
    case 15: {
      for (int it = bid; it < 1024; it += G) {
        const int row = it * 8 + (tid >> 6);
        rmsnorm_row(p.out + (size_t)row * 2048, p.final_norm_w, nullptr, p.out + (size_t)row * 2048, tid);
      }
    } break;
    default: break;
  }
}

#define XB_TMO      128
#define XB_XCNT(j)  (256  + 64 * (j))
#define XB_XSUB(j)  (1280 + 64 * (j))
#define XB_XGEN(j)  (2304 + 64 * (j))
#define XB_TOP      3328
#define XB_TOPGEN   3392
#define XB_SPIN_CAP (1u << 18)
DI unsigned xb_ld(unsigned* p) { return __hip_atomic_load(p, __ATOMIC_RELAXED, __HIP_MEMORY_SCOPE_AGENT); }
DI unsigned xb_add(unsigned* p, unsigned v) { return __hip_atomic_fetch_add(p, v, __ATOMIC_RELAXED, __HIP_MEMORY_SCOPE_AGENT); }
DI unsigned xb_xcc_id() { return (unsigned)__builtin_amdgcn_s_getreg((3 << 11) | 20) & 0xFu; }
#define XB_SPIN(cond, bar) do { unsigned _sp = 0; while (cond) { __builtin_amdgcn_s_sleep(1); \
    if ((++_sp & 255u) == 0u) { if (xb_ld(&(bar)[XB_TMO])) break; if (_sp > XB_SPIN_CAP) { atomicAdd(&(bar)[XB_TMO], 1u); break; } } } } while (0)
struct XcdBarrier { unsigned* bar; unsigned x; volatile unsigned* st; };
DI XcdBarrier xcd_barrier_post(unsigned* bar, volatile unsigned* st) {
  XcdBarrier b; b.bar = bar; b.x = xb_xcc_id(); b.st = st;
  if (threadIdx.x == 0) (void)xb_add(&bar[XB_XCNT(b.x)], 1u);
  return b;
}
DI void xcd_barrier_complete(unsigned* bar, unsigned x, unsigned& nloc, unsigned& nx) {
  const unsigned Gt = gridDim.x * gridDim.y * gridDim.z;
  unsigned sum, cnt, mine, sp = 0u;
  for (;;) {
    sum = 0u; cnt = 0u; mine = 0u;
#pragma unroll
    for (unsigned j = 0; j < 16; ++j) { const unsigned c = xb_ld(&bar[XB_XCNT(j)]); sum += c; cnt += (c > 0u) ? 1u : 0u; mine = (j == x) ? c : mine; }
    if (sum == Gt) break;
    __builtin_amdgcn_s_sleep(1);
    if ((++sp & 255u) == 0u) { if (xb_ld(&bar[XB_TMO])) break; if (sp > XB_SPIN_CAP) { atomicAdd(&bar[XB_TMO], 1u); break; } }
  }
  nloc = mine > 0u ? mine : 1u; nx = cnt > 0u ? cnt : 1u;
}
DI void xcd_barrier(const XcdBarrier& b) {
  asm volatile("s_waitcnt vmcnt(0)" ::: "memory");
  __syncthreads();
  if (threadIdx.x == 0) {
    unsigned* bar = b.bar;
    __builtin_amdgcn_s_waitcnt(0);
    unsigned nloc = b.st[0], nx = b.st[1];
    if (nloc == 0u) { xcd_barrier_complete(bar, b.x, nloc, nx); b.st[0] = nloc; b.st[1] = nx; }
    const unsigned old = xb_add(&bar[XB_XSUB(b.x)], 1u);
    const unsigned gen = old / nloc;
    if (old + 1u == (gen + 1u) * nloc) {
      __builtin_amdgcn_fence(__ATOMIC_RELEASE, "agent");
      asm volatile("s_waitcnt vmcnt(0)" ::: "memory");
      const unsigned og = xb_add(&bar[XB_TOP], 1u);
      const unsigned tg = og / nx;
      if (og + 1u == (tg + 1u) * nx) xb_add(&bar[XB_TOPGEN], 1u);
      else XB_SPIN(xb_ld(&bar[XB_TOPGEN]) == tg, bar);
      __builtin_amdgcn_fence(__ATOMIC_ACQUIRE, "agent");
      xb_add(&bar[XB_XGEN(b.x)], 1u);
      asm volatile("s_waitcnt vmcnt(0)" ::: "memory");
    } else {
      XB_SPIN(xb_ld(&bar[XB_XGEN(b.x)]) == gen, bar);
      __builtin_amdgcn_fence(__ATOMIC_ACQUIRE, "agent");
      asm volatile("s_waitcnt vmcnt(0)" ::: "memory");
    }
  }
  __syncthreads();
}

__global__ void __launch_bounds__(512, 2) mega(Params p) {
  extern __shared__ __attribute__((aligned(1024))) char smem[];
  __shared__ int slot;
  __shared__ unsigned xb_st[4];
  cg::grid_group grid = cg::this_grid();
  const int wave_s = __builtin_amdgcn_readfirstlane((int)(threadIdx.x >> 6));
  if (threadIdx.x < 4) xb_st[threadIdx.x] = 0u;
  __syncthreads();
  const XcdBarrier xb = xcd_barrier_post((unsigned*)(p.ws + OFF_BAR), xb_st);
  for (int ph = p.ph_lo; ph < p.ph_hi; ++ph) {
    if (ph == 8 || ph == 12) continue;
    run_phase(p, ph, smem, &slot, wave_s, 0);
#ifdef PROBE_PH
    if (ph == PROBE_PH)
      for (int rep = 1; rep <= PROBE_N; ++rep) { xcd_barrier(xb); run_phase(p, ph, smem, &slot, wave_s, rep); }
#endif
    if (ph + 1 < p.ph_hi) {
      if (p.dbg == 12345) grid.sync();
      xcd_barrier(xb);
    }
  }
}

extern "C" void kernel_launch(void* const* d_in, const int* in_sizes, int n_in, void* d_out, int out_size, void* d_ws,
                              size_t ws_size, hipStream_t stream) {
  static int grid_blocks = 0;
  if (!grid_blocks) {
    int dev = 0, cus = 0, per_cu = 0;
    (void)hipGetDevice(&dev);
    (void)hipDeviceGetAttribute(&cus, hipDeviceAttributeMultiprocessorCount, dev);
    (void)hipFuncSetAttribute((const void*)mega, hipFuncAttributeMaxDynamicSharedMemorySize, SMEM_BYTES);
    (void)hipOccupancyMaxActiveBlocksPerMultiprocessor(&per_cu, mega, NTHR, SMEM_BYTES);
    if (per_cu < 1) per_cu = 1;
    if (per_cu > 1) per_cu = 1;
    grid_blocks = cus * per_cu;
    grid_blocks &= ~7;
    if (ws_size < WS_END || n_in != 24) { fprintf(stderr, "kernel_launch: ws %zu < %zu or n_in %d\n", ws_size, (size_t)WS_END, n_in); grid_blocks = -1; }
  }
  if (grid_blocks < 0) return;
  Params p{};
  const float** pp = (const float**)&p;
  for (int i = 0; i < 24; ++i) pp[i] = (const float*)d_in[i];
  p.out = (float*)d_out;
  p.ws = (char*)d_ws;
#if ONE_LAUNCH
  p.ph_lo = 0; p.ph_hi = NPHASE;
  (void)hipMemsetAsync((char*)d_ws + OFF_BAR, 0, BAR_BYTES, stream);
  void* args[] = {&p};
  hipError_t e = hipLaunchCooperativeKernel((void*)mega, dim3(grid_blocks), dim3(NTHR), args, SMEM_BYTES, stream);
  if (e != hipSuccess) fprintf(stderr, "cooperative launch failed: %s (grid %d)\n", hipGetErrorString(e), grid_blocks);
#else
  for (int ph = 0; ph < NPHASE; ++ph) {
    p.ph_lo = ph; p.ph_hi = ph + 1;
    hipLaunchKernelGGL(mega, dim3(grid_blocks), dim3(NTHR), SMEM_BYTES, stream, p);
  }
#endif
}
```

```cpp
#include <hip/hip_runtime.h>
#include <hip/hip_cooperative_groups.h>
#include <cstdio>
namespace cg = cooperative_groups;

#ifndef ONE_LAUNCH
#define ONE_LAUNCH 1
#endif

#define DI __device__ __forceinline__
typedef unsigned short bfr;
using bf16x8 = __attribute__((ext_vector_type(8))) short;
using s16x4 = __attribute__((ext_vector_type(4))) short;
using f32x16 = __attribute__((ext_vector_type(16))) float;
using u32x4 = __attribute__((ext_vector_type(4))) unsigned;
#define MFMA(a, b, c) __builtin_amdgcn_mfma_f32_32x32x16_bf16((a), (b), (c), 0, 0, 0)

constexpr int DM = 2048, SEQ = 2048, NTOK = 8192;
constexpr int ZS = 15488;
constexpr int ZC_Q = 0, ZC_KC = 2048, ZC_VC = 2560, ZC_KS = 3072, ZC_VS = 3584, ZC_KW = 4096, ZC_VW = 4608,
              ZC_QR = 5120, ZC_KR = 6144, ZC_VR = 7168, ZC_GR = 9216, ZC_GA = 11264, ZC_GB = 13312, ZC_GN = 15360;
constexpr int NPHASE = 16;

constexpr int ZSP = 15616;
constexpr size_t SZ_WINT = (size_t)ZSP * 2048 * 2;
constexpr size_t SZ_ACT = (size_t)NTOK * 2048 * 2;
constexpr size_t OFF_WINT = 0;
constexpr size_t OFF_N = OFF_WINT + SZ_WINT;
constexpr size_t OFF_MERGED = OFF_WINT;
constexpr size_t OFF_RKV = OFF_WINT;
static_assert((size_t)224 * 128 * 256 * 4 <= SZ_WINT, "retention KV buffer must fit the dead w_in^T region");
constexpr size_t OFF_ORET = OFF_N;
constexpr size_t OFF_WUPT = 0;
constexpr size_t OFF_WDOWNT = SZ_ACT;
constexpr size_t OFF_Z = OFF_N + SZ_ACT;
constexpr size_t SZ_Z = (size_t)NTOK * ZS * 2;
constexpr size_t OFF_HID = OFF_Z;
constexpr size_t OFF_H = OFF_Z + (size_t)NTOK * 8192 * 2;
constexpr size_t OFF_NX = OFF_H + (size_t)NTOK * 2048 * 4;
constexpr size_t OFF_QX = OFF_NX + SZ_ACT;
constexpr size_t OFF_OX = OFF_QX + (size_t)NTOK * 512 * 2;
static_assert(OFF_OX + (size_t)NTOK * 512 * 2 <= OFF_Z + SZ_Z, "alias overflow");
constexpr size_t OFF_ZC = OFF_Z + SZ_Z;
constexpr size_t OFF_MN = OFF_ZC + (size_t)NTOK * 2048 * 2;
constexpr size_t OFF_W1T = OFF_MN + (size_t)1024 * 2048 * 2;
constexpr size_t OFF_W2T = OFF_W1T + (size_t)2 * 1024 * 4096 * 2;
constexpr size_t OFF_WAT = OFF_W2T + (size_t)2 * 128 * 1024 * 2;
constexpr size_t OFF_WBT = OFF_WAT + (size_t)2048 * 2048 * 2;
constexpr size_t OFF_WOUTT = OFF_WBT + (size_t)2048 * 2048 * 2;
constexpr size_t OFF_WQT = OFF_WOUTT + (size_t)2048 * 2048 * 2;
constexpr size_t OFF_WKT = OFF_WQT + (size_t)512 * 2048 * 2;
constexpr size_t OFF_WVT = OFF_WKT + (size_t)512 * 2048 * 2;
constexpr size_t OFF_WOT = OFF_WVT + (size_t)512 * 2048 * 2;
constexpr size_t OFF_ROPE = OFF_WOT + (size_t)512 * 2048 * 2;
constexpr size_t OFF_HIDC = OFF_ROPE + (size_t)2048 * 64 * 8;
constexpr size_t OFF_KCVC = OFF_HIDC + (size_t)2 * 2048 * 1024 * 2;
constexpr size_t OFF_SELM = OFF_KCVC + (size_t)2 * 2048 * 128 * 2;
constexpr size_t OFF_ONSA = OFF_SELM + (size_t)16 * 2048 * 4;
constexpr size_t OFF_KX = OFF_ONSA + SZ_ACT;
constexpr size_t OFF_VX = OFF_KX + (size_t)1024 * 512 * 2;
constexpr size_t OFF_RSTAT = OFF_VX + (size_t)1024 * 512 * 2;
constexpr size_t OFF_CTR = OFF_RSTAT + (size_t)NTOK * 8 * 2 * 2 * 4;
constexpr size_t OFF_BAR = OFF_CTR + 256;
constexpr size_t BAR_BYTES = 16384;
constexpr size_t OFF_ROWSS = OFF_BAR + BAR_BYTES;
constexpr size_t WS_END = OFF_ROWSS + (size_t)2 * NTOK * 4;

struct Params {
  const float *x, *mem, *attn_norm_w, *w_in, *pe_k, *w1k, *w2k, *pe_v, *w1v, *w2v, *w_a, *gn_w, *w_b, *w_out, *x_norm_w,
      *mem_norm_w, *wq, *wk, *wv, *wo, *mlp_norm_w, *w_up, *w_down, *final_norm_w;
  float* out;
  char* ws;
  int ph_lo, ph_hi;
  int dbg, pad;
};

constexpr int NTHR = 512;
constexpr int SMEM_BYTES = 139264;
__device__ const float ROPE_INV[64] = {1.0f, 0.865964353f, 0.749894261f, 0.649381638f, 0.562341332f, 0.486967534f, 0.421696514f, 0.365174115f, 0.316227764f, 0.273841977f, 0.237137377f, 0.2053525f, 0.177827939f, 0.153992653f, 0.133352131f, 0.115478203f, 0.100000001f, 0.0865964293f, 0.0749894157f, 0.0649381652f, 0.0562341325f, 0.0486967526f, 0.0421696529f, 0.0365174115f, 0.0316227749f, 0.0273841973f, 0.0237137377f, 0.0205352511f, 0.0177827943f, 0.0153992651f, 0.0133352149f, 0.0115478206f, 0.00999999978f, 0.00865964312f, 0.00749894185f, 0.00649381615f, 0.00562341325f, 0.00486967526f, 0.00421696482f, 0.00365174119f, 0.00316227763f, 0.00273841969f, 0.00237137359f, 0.00205352483f, 0.00177827943f, 0.00153992651f, 0.00133352145f, 0.0011547819f, 0.00100000005f, 0.000865964335f, 0.000749894243f, 0.000649381662f, 0.000562341302f, 0.000486967532f, 0.000421696517f, 0.000365174143f, 0.000316227757f, 0.000273841957f, 0.00023713737f, 0.00020535251f, 0.00017782794f, 0.000153992645f, 0.00013335215f, 0.0001154782f};

DI unsigned pack2(float a, float b) {
  typedef float f2 __attribute__((ext_vector_type(2)));
  typedef __bf16 b2 __attribute__((ext_vector_type(2)));
  f2 v = {a, b};
  b2 r = __builtin_convertvector(v, b2);
  return __builtin_bit_cast(unsigned, r);
}
DI float bflo(unsigned u) { return __uint_as_float(u << 16); }
DI float bfhi(unsigned u) { return __uint_as_float(u & 0xffff0000u); }
DI void st_bf4(bfr* p, float a, float b, float c, float d) {
  uint2 v; v.x = pack2(a, b); v.y = pack2(c, d);
  *(uint2*)p = v;
}
DI float wave_sum(float v) {
#pragma unroll
  for (int o = 32; o > 0; o >>= 1) v += __shfl_xor(v, o);
  return v;
}
DI float sigmoidf_(float x) { return __builtin_amdgcn_rcpf(1.f + __expf(-x)); }
DI int crow(int i, int h) { return (i & 3) + 8 * (i >> 2) + 4 * h; }
DI bf16x8 pack8(const f32x16& x, int s) {
  unsigned a = pack2(x[8 * s], x[8 * s + 1]), b = pack2(x[8 * s + 2], x[8 * s + 3]), c = pack2(x[8 * s + 4], x[8 * s + 5]),
           d = pack2(x[8 * s + 6], x[8 * s + 7]);
  typedef unsigned u4 __attribute__((ext_vector_type(4)));
  u4 v = {a, b, c, d};
  return __builtin_bit_cast(bf16x8, v);
}
DI s16x4 tr_read(const bfr* p) {
  return __builtin_amdgcn_ds_read_tr16_b64_v4i16((__attribute__((address_space(3))) s16x4*)(p));
}

struct TJob { const float* src; bfr* dst; int K, N, ntn, perm; const float* kscale; };
DI TJob get_tjob(const Params& p, int j) {
  TJob t;
  char* ws = p.ws;
  switch (j) {
    case 0: t = {p.w_in, (bfr*)(ws + OFF_WINT), 2048, 15408, 122, 1, nullptr}; break;
    case 1: t = {p.wk, (bfr*)(ws + OFF_WKT), 2048, 512, 4, 0, nullptr}; break;
    case 2: t = {p.wv, (bfr*)(ws + OFF_WVT), 2048, 512, 4, 0, nullptr}; break;
    case 3: t = {p.w1k, (bfr*)(ws + OFF_W1T), 4096, 1024, 8, 0, nullptr}; break;
    case 4: t = {p.w1v, (bfr*)(ws + OFF_W1T) + (size_t)1024 * 4096, 4096, 1024, 8, 0, nullptr}; break;
    case 5: t = {p.w2k, (bfr*)(ws + OFF_W2T), 1024, 128, 1, 0, nullptr}; break;
    case 6: t = {p.w2v, (bfr*)(ws + OFF_W2T) + (size_t)128 * 1024, 1024, 128, 1, 0, nullptr}; break;
    case 7: t = {p.w_a, (bfr*)(ws + OFF_WAT), 2048, 2048, 16, 0, nullptr}; break;
    case 8: t = {p.w_b, (bfr*)(ws + OFF_WBT), 2048, 2048, 16, 0, nullptr}; break;
    case 9: t = {p.w_out, (bfr*)(ws + OFF_WOUTT), 2048, 2048, 16, 0, nullptr}; break;
    case 10: t = {p.wq, (bfr*)(ws + OFF_WQT), 2048, 512, 4, 0, p.x_norm_w}; break;
    case 11: t = {p.wo, (bfr*)(ws + OFF_WOT), 512, 2048, 16, 0, nullptr}; break;
    case 12: t = {p.w_up, (bfr*)(ws + OFF_WUPT), 2048, 8192, 64, 0, p.mlp_norm_w}; break;
    default: t = {p.w_down, (bfr*)(ws + OFF_WDOWNT), 8192, 2048, 16, 0, nullptr}; break;
  }
  return t;
}
DI int tjob_tiles(int j) {
  switch (j) {
    case 0: return 122 * 16;
    case 1: case 2: return 4 * 16;
    case 3: case 4: return 8 * 32;
    case 5: case 6: return 1 * 8;
    case 7: case 8: case 9: return 16 * 16;
    case 10: return 4 * 16;
    case 11: return 16 * 4;
    case 12: return 64 * 16;
    default: return 16 * 64;
  }
}
struct TrRegs { float4 v[8]; };
DI void tr_load(const TJob& t, int tile, TrRegs& rg, const int tid) {
  const int nkt = t.K >> 7;
  const int kt = tile % nkt, nt = tile / nkt;
  const int k0 = kt * 128, d0 = nt * 128;
  int scol0 = d0, nvalid = 128;
  if (t.perm) {
    if (d0 < 5120) scol0 = d0;
    else if (d0 < 15360) scol0 = d0 + 48;
    else { scol0 = d0 - 15360 + 5120; nvalid = (d0 == 15360) ? 48 : 0; }
  }
#pragma unroll
  for (int i = 0; i < 8; ++i) {
    const int row = i * 16 + (tid >> 5), col = (tid & 31) * 4;
    rg.v[i] = make_float4(0.f, 0.f, 0.f, 0.f);
    if (col < nvalid) rg.v[i] = *(const float4*)(t.src + (size_t)(k0 + row) * t.N + scol0 + col);
    if (t.kscale) { const float sc = t.kscale[k0 + row]; rg.v[i].x *= sc; rg.v[i].y *= sc; rg.v[i].z *= sc; rg.v[i].w *= sc; }
  }
}
DI void tr_to_lds(const TrRegs& rg, float* sm, const int tid) {
#pragma unroll
  for (int i = 0; i < 8; ++i) {
    const int row = i * 16 + (tid >> 5), col = (tid & 31) * 4;
    float* d = sm + row * 129 + col;
    d[0] = rg.v[i].x; d[1] = rg.v[i].y; d[2] = rg.v[i].z; d[3] = rg.v[i].w;
  }
}
DI void tr_store(const TJob& t, int tile, const float* sm, const int tid) {
  const int nkt = t.K >> 7;
  const int kt = tile % nkt, nt = tile / nkt;
  const int k0 = kt * 128, d0 = nt * 128;
  const int n = tid >> 2, kq = (tid & 3) * 8;
  bfr* drow = t.dst + (size_t)(d0 + n) * t.K + k0 + kq;
#pragma unroll
  for (int q = 0; q < 4; ++q) {
    const int kb = kq + 32 * q;
    const unsigned o0 = pack2(sm[(kb + 0) * 129 + n], sm[(kb + 1) * 129 + n]);
    const unsigned o1 = pack2(sm[(kb + 2) * 129 + n], sm[(kb + 3) * 129 + n]);
    const unsigned o2 = pack2(sm[(kb + 4) * 129 + n], sm[(kb + 5) * 129 + n]);
    const unsigned o3 = pack2(sm[(kb + 6) * 129 + n], sm[(kb + 7) * 129 + n]);
    *(uint4*)(drow + 32 * q) = make_uint4(o0, o1, o2, o3);
  }
}
DI void tr_decode(int it, int j_lo, int& j, int& rem) {
  j = j_lo; rem = it;
  while (rem >= tjob_tiles(j)) { rem -= tjob_tiles(j); ++j; }
}
DI void tr_run(const Params& p, int j_lo, int it0, int stride, int n_tiles, float* sm, const int tid) {
  if (it0 >= n_tiles) return;
  TrRegs rg;
  int j, rem;
  tr_decode(it0, j_lo, j, rem);
  TJob t = get_tjob(p, j);
  tr_load(t, rem, rg, tid);
  for (int it = it0; it < n_tiles; it += stride) {
    __syncthreads();
    tr_to_lds(rg, sm, tid);
    __syncthreads();
    const TJob tc = t;
    const int remc = rem;
    const int nx = it + stride;
    if (nx < n_tiles) {
      tr_decode(nx, j_lo, j, rem);
      t = get_tjob(p, j);
      tr_load(t, rem, rg, tid);
    }
    tr_store(tc, remc, sm, tid);
  }
  __syncthreads();
}

DI void rmsnorm_row(const float* xrow, const float* w, bfr* obf, float* of32, const int tid) {
  const int lane = tid & 63;
  float4 v[8];
  float ss = 0.f;
#pragma unroll
  for (int i = 0; i < 8; ++i) {
    v[i] = ((const float4*)xrow)[lane + 64 * i];
    ss += v[i].x * v[i].x + v[i].y * v[i].y + v[i].z * v[i].z + v[i].w * v[i].w;
  }
  ss = wave_sum(ss);
  const float rs = rsqrtf(ss * (1.f / 2048.f) + 1e-6f);
#pragma unroll
  for (int i = 0; i < 8; ++i) {
    const float4 ww = ((const float4*)w)[lane + 64 * i];
    const float a = v[i].x * rs * ww.x, b = v[i].y * rs * ww.y, c = v[i].z * rs * ww.z, d = v[i].w * rs * ww.w;
    if (obf) st_bf4(obf + (lane + 64 * i) * 4, a, b, c, d);
    else ((float4*)of32)[lane + 64 * i] = make_float4(a, b, c, d);
  }
}

struct PlainPtr {
  const bfr* base; int ld;
  DI int rowoff(int row) const { return row * ld; }
  DI int koff(int k0) const { return k0; }
};
#define WAIT_V(n) asm volatile("s_waitcnt vmcnt(%0)" ::"n"(n) : "memory")
#define WAIT_L(n) asm volatile("s_waitcnt lgkmcnt(%0)" ::"n"(n) : "memory")
#define RAW_BARRIER() do { WAIT_L(0); __builtin_amdgcn_s_barrier(); } while (0)
typedef __attribute__((address_space(3))) unsigned lds_u32;
constexpr int STAGE_B = 65536;
template <int NI, class AF, class BF>
DI void gemm_main(f32x16 (&acc)[NI][4], const AF& af, const BF& bf, int nk, char* smem, const int tid) {
  const int lane = tid & 63, r = lane & 31, h = lane >> 5;
  const int w = __builtin_amdgcn_readfirstlane(tid >> 6);
  const int wm = w & 1, wn = w >> 1;
  int ao[4], bo[2 * NI];
  {
    const int rl = lane >> 3, kc = (lane & 7) ^ (((w & 1) * 4 + (lane >> 4)) & 7);
#pragma unroll
    for (int i = 0; i < 4; ++i) ao[i] = af.rowoff((w + 8 * i) * 8 + rl) + 8 * kc;
#pragma unroll
    for (int i = 0; i < 2 * NI; ++i) bo[i] = bf.rowoff((w + 8 * i) * 8 + rl) + 8 * kc;
  }
  auto stage = [&](int buf, int kt) {
    const int ka = af.koff(kt * 64), kb = bf.koff(kt * 64);
    char* sbase = smem + buf * STAGE_B + w * 1024;
#pragma unroll
    for (int i = 0; i < 4; ++i)
      __builtin_amdgcn_global_load_lds((const unsigned*)(af.base + (ao[i] + ka)), (lds_u32*)(sbase + i * 8192), 16, 0, 0);
#pragma unroll
    for (int i = 0; i < 2 * NI; ++i)
      __builtin_amdgcn_global_load_lds((const unsigned*)(bf.base + (bo[i] + kb)), (lds_u32*)(sbase + 32768 + i * 8192), 16, 0, 0);
  };
  const int xr = (r >> 1) & 7;
  const int arow = (wm * 128 + r) * 128, brow = 32768 + (wn * 32 * NI + r) * 128;
  WAIT_V(0);
  __syncthreads();
  stage(0, 0);
  WAIT_V(0);
  RAW_BARRIER();
#pragma unroll 1
  for (int kt = 0; kt < nk; ++kt) {
    if (kt + 1 < nk) stage((kt + 1) & 1, kt + 1);
    const char* sb = smem + (kt & 1) * STAGE_B;
#pragma unroll
    for (int ks = 0; ks < 4; ++ks) {
      const int off = ((2 * ks + h) ^ xr) * 16;
      bf16x8 wf[NI], xf[4];
#pragma unroll
      for (int i = 0; i < NI; ++i) wf[i] = *(const bf16x8*)(sb + brow + i * 4096 + off);
#pragma unroll
      for (int i = 0; i < 4; ++i) xf[i] = *(const bf16x8*)(sb + arow + i * 4096 + off);
#pragma unroll
      for (int mi = 0; mi < 4; ++mi)
#pragma unroll
        for (int ni = 0; ni < NI; ++ni) acc[ni][mi] = MFMA(wf[ni], xf[mi], acc[ni][mi]);
    }
    WAIT_V(0);
    RAW_BARRIER();
  }
}
template <int NI>
DI void acc_zero(f32x16 (&acc)[NI][4]) {
#pragma unroll
  for (int a = 0; a < NI; ++a)
#pragma unroll
    for (int b = 0; b < 4; ++b)
#pragma unroll
      for (int i = 0; i < 16; ++i) acc[a][b][i] = 0.f;
}
template <int NI, class EPI>
DI void gemm_epi(const f32x16 (&acc)[NI][4], int m0, int n0, const int tid_in, const EPI& epi) {
  int tid = tid_in;
  asm volatile("" : "+v"(tid));
  const int lane = tid & 63, w = tid >> 6, r = lane & 31, h = lane >> 5;
  const int wm = w & 1, wn = w >> 1;
#pragma unroll
  for (int mi = 0; mi < 4; ++mi)
#pragma unroll
    for (int ni = 0; ni < NI; ++ni)
#pragma unroll
      for (int g = 0; g < 4; ++g) {
        const int n = n0 + wn * 32 * NI + ni * 32 + 8 * g + 4 * h;
        const int m = m0 + wm * 128 + mi * 32 + r;
        epi(m, n, acc[ni][mi][4 * g], acc[ni][mi][4 * g + 1], acc[ni][mi][4 * g + 2], acc[ni][mi][4 * g + 3]);
      }
}
DI void gemm_epi_resid(const f32x16 (&acc)[2][4], int m0, int n0, const int tid_in, const float* hsrc, float* hdst, bfr* hb, float* rowss) {
  int tid = tid_in;
  asm volatile("" : "+v"(tid));
  const int lane = tid & 63, w = tid >> 6, r = lane & 31, h = lane >> 5;
  const int wm = w & 1, wn = w >> 1;
#pragma unroll
  for (int mi = 0; mi < 4; ++mi) {
    const int m = m0 + wm * 128 + mi * 32 + r;
    float ss = 0.f;
#pragma unroll
    for (int ni = 0; ni < 2; ++ni)
#pragma unroll
      for (int g = 0; g < 4; ++g) {
        const int n = n0 + wn * 64 + ni * 32 + 8 * g + 4 * h;
        const float4 xv = *(const float4*)(hsrc + (size_t)m * 2048 + n);
        const float a = xv.x + acc[ni][mi][4 * g], b = xv.y + acc[ni][mi][4 * g + 1], c = xv.z + acc[ni][mi][4 * g + 2], d = xv.w + acc[ni][mi][4 * g + 3];
        *(float4*)(hdst + (size_t)m * 2048 + n) = make_float4(a, b, c, d);
        st_bf4(hb + (size_t)m * 2048 + n, a, b, c, d);
        ss += a * a + b * b + c * c + d * d;
      }
    ss += __shfl_xor(ss, 32);
    if (h == 0) atomicAdd(rowss + m, ss);
  }
}
DI void map_tile32(int v, int& mt, int& nt) {
  const int xcd = v & 7, j = v >> 3;
  nt = j >> 2;
  mt = xcd * 4 + (j & 3);
}


using f32x4 = __attribute__((ext_vector_type(4))) float;
typedef __attribute__((address_space(3))) unsigned char lds_u8;
constexpr int HTB = 128 * 64 * 2;
DI int lds_byte8(int r, int c) { const int st = (r >> 4) * 2 + (c >> 5), rr = r & 15, cc = c & 31, ob = rr * 64 + cc * 2; return st * 1024 + (ob ^ (((ob >> 9) & 1) << 5)); }
DI void stage_rc8(int b, int& R, int& C) { const int st = b / 1024, sb = b % 1024, swz = sb ^ (((sb >> 9) & 1) << 5); R = (st >> 1) * 16 + swz / 64; C = (st & 1) * 32 + (swz % 64) / 2; }
DI int perm32(int rho) { const int n = rho >> 4, i = rho & 15; return 8 * (i >> 2) + 4 * n + (i & 3); }
DI bool unit_next(int i, int G, int bid, int nunits, int& pm, int& pn) {
  const int v = bid + i * G;
  if (v >= nunits) return false;
  const int xcd = v & 7, j = v >> 3;
  pn = j >> 2;
  pm = xcd * 4 + (j & 3);
  return true;
}
template <class Epi>
DI void gemm8_phase(char* smem, const bfr* A, const bfr* Bt, const int K, const int nunits, const int G, const int bid, const int tid, const Epi& E) {
  lds_u8* lds = (lds_u8*)smem;
  const int wid = __builtin_amdgcn_readfirstlane(tid >> 6), lane = tid & 63, wr = wid >> 2, wc = wid & 3, fr = lane & 15, fq = lane >> 4;
  const int nt = K / 64;
  unsigned voffA[2], voffB[2];
#pragma unroll
  for (int i = 0; i < 2; ++i) {
    int R, C;
    stage_rc8(tid * 16 + i * 8192, R, C);
    const int Rb = (R & ~31) + perm32(R & 31);
    voffA[i] = (unsigned)(R * K + C) * 2u;
    voffB[i] = (unsigned)(Rb * K + C) * 2u;
  }
  const size_t kstep = 128;
  const size_t hstep = (size_t)128 * K * 2;
  const size_t tstep = 2 * hstep;
  const unsigned ldsw = (unsigned)wid * 1024u;
  const int aoff = lds_byte8(wr * 64 + fr, fq * 8), boff = lds_byte8(wc * 32 + fr, fq * 8);
#define PG8_SA(b, h) (((b) * 2 + (h)) * HTB)
#define PG8_SB(b, h) ((4 + (b) * 2 + (h)) * HTB)
#define PG8_STAGE(bufoff, gbase, voff) do { _Pragma("unroll") for (int _i = 0; _i < 2; ++_i) \
    __builtin_amdgcn_global_load_lds((const unsigned*)((const char*)(gbase) + (voff)[_i]), (lds_u32*)(lds + (bufoff) + ldsw + _i * 8192), 16, 0, 0); } while (0)
#define PG8_LDA(dst, b, h) do { _Pragma("unroll") for (int m = 0; m < 4; ++m) _Pragma("unroll") for (int k = 0; k < 2; ++k) dst[m][k] = *(const __attribute__((address_space(3))) bf16x8*)(lds + PG8_SA(b, h) + aoff + m * 2048 + k * 1024); } while (0)
#define PG8_LDB(dst, b, h) do { _Pragma("unroll") for (int n = 0; n < 2; ++n) _Pragma("unroll") for (int k = 0; k < 2; ++k) dst[n][k] = *(const __attribute__((address_space(3))) bf16x8*)(lds + PG8_SB(b, h) + boff + n * 2048 + k * 1024); } while (0)
#define PG8_MMA(ai, bj, At, Bt_) do { __builtin_amdgcn_s_setprio(1); _Pragma("unroll") for (int m = 0; m < 4; ++m) _Pragma("unroll") for (int n = 0; n < 2; ++n) _Pragma("unroll") for (int k = 0; k < 2; ++k) \
    acc[ai][bj][m][n] = __builtin_amdgcn_mfma_f32_16x16x32_bf16(Bt_[n][k], At[m][k], acc[ai][bj][m][n], 0, 0, 0); __builtin_amdgcn_s_setprio(0); } while (0)
#define PG8_BAR __builtin_amdgcn_s_barrier()
#define PG8_SCHED __builtin_amdgcn_sched_barrier(0)
  int cpm, cpn, npm = 0, npn = 0, ui = 0;
  if (!unit_next(0, G, bid, nunits, cpm, cpn)) return;
  WAIT_V(0);
  __syncthreads();
  f32x4 acc[2][2][4][2];
#pragma unroll
  for (int a = 0; a < 2; ++a)
#pragma unroll
    for (int b = 0; b < 2; ++b)
#pragma unroll
      for (int m = 0; m < 4; ++m)
#pragma unroll
        for (int n = 0; n < 2; ++n) acc[a][b][m][n] = (f32x4){0.f, 0.f, 0.f, 0.f};
  bf16x8 At[4][2], B0[2][2], B1[2][2];
  const char* cA = (const char*)A + (size_t)cpm * tstep;
  const char* cB = (const char*)Bt + (size_t)cpn * tstep;
  PG8_STAGE(PG8_SB(0, 0), cB, voffB); PG8_STAGE(PG8_SA(0, 0), cA, voffA); PG8_STAGE(PG8_SB(0, 1), cB + hstep, voffB); PG8_STAGE(PG8_SA(0, 1), cA + hstep, voffA);
  if (wr == 1) PG8_BAR;
  WAIT_V(4); PG8_BAR;
  PG8_STAGE(PG8_SB(1, 0), cB + kstep, voffB); PG8_STAGE(PG8_SA(1, 0), cA + kstep, voffA); PG8_STAGE(PG8_SB(1, 1), cB + hstep + kstep, voffB);
  WAIT_V(6); PG8_BAR;
  for (;;) {
    const bool has_next = unit_next(ui + 1, G, bid, nunits, npm, npn);
    const char* nA = has_next ? (const char*)A + (size_t)npm * tstep : cA;
    const char* nB = has_next ? (const char*)Bt + (size_t)npn * tstep : cB;
#pragma unroll 1
    for (int t = 0; t < nt; t += 2) {
      const bool last = (t == nt - 2);
      const char* a1 = cA + (size_t)(t + 1) * kstep;
      const char* a2 = last ? nA : cA + (size_t)(t + 2) * kstep;
      const char* b2 = last ? nB : cB + (size_t)(t + 2) * kstep;
      const char* a3 = a2 + kstep;
      const char* b3 = b2 + kstep;
      PG8_LDB(B0, 0, 0); PG8_SCHED; PG8_LDA(At, 0, 0); PG8_STAGE(PG8_SA(1, 1), a1 + hstep, voffA);
      WAIT_L(8); PG8_BAR; WAIT_L(0); PG8_MMA(0, 0, At, B0); PG8_BAR; PG8_SCHED;
      PG8_LDB(B1, 0, 1); PG8_STAGE(PG8_SB(0, 0), b2, voffB);
      PG8_BAR; WAIT_L(0); PG8_MMA(0, 1, At, B1); PG8_BAR;
      PG8_LDA(At, 0, 1); PG8_STAGE(PG8_SA(0, 0), a2, voffA);
      PG8_BAR; WAIT_L(0); PG8_MMA(1, 0, At, B0); PG8_BAR; PG8_SCHED;
      PG8_STAGE(PG8_SB(0, 1), b2 + hstep, voffB);
      WAIT_V(6); PG8_BAR; PG8_MMA(1, 1, At, B1); PG8_BAR;
      PG8_LDB(B0, 1, 0); PG8_SCHED; PG8_LDA(At, 1, 0); PG8_STAGE(PG8_SA(0, 1), a2 + hstep, voffA);
      WAIT_L(8); PG8_BAR; WAIT_L(0); PG8_MMA(0, 0, At, B0); PG8_BAR; PG8_SCHED;
      PG8_LDB(B1, 1, 1); PG8_STAGE(PG8_SB(1, 0), b3, voffB);
      PG8_BAR; WAIT_L(0); PG8_MMA(0, 1, At, B1); PG8_BAR;
      PG8_LDA(At, 1, 1); PG8_STAGE(PG8_SA(1, 0), a3, voffA);
      PG8_BAR; WAIT_L(0); PG8_MMA(1, 0, At, B0); PG8_BAR; PG8_SCHED;
      PG8_STAGE(PG8_SB(1, 1), b3 + hstep, voffB);
      WAIT_V(6); PG8_BAR; PG8_MMA(1, 1, At, B1); PG8_BAR;
    }
    E(acc, cpm * 256, cpn * 256, wr, wc, fr, fq);
    if (!has_next) break;
#pragma unroll
    for (int a = 0; a < 2; ++a)
#pragma unroll
      for (int b = 0; b < 2; ++b)
#pragma unroll
        for (int m = 0; m < 4; ++m)
#pragma unroll
          for (int n = 0; n < 2; ++n) acc[a][b][m][n] = (f32x4){0.f, 0.f, 0.f, 0.f};
    cpm = npm; cpn = npn; cA = nA; cB = nB; ++ui;
  }
  WAIT_V(0);
  if (wr == 0) PG8_BAR;
  PG8_BAR;
#undef PG8_SA
#undef PG8_SB
#undef PG8_STAGE
#undef PG8_LDA
#undef PG8_LDB
#undef PG8_MMA
#undef PG8_BAR
#undef PG8_SCHED
}
template <class F>
DI void epi8_foreach(const f32x4 (&acc)[2][2][4][2], int m0, int n0, int wr, int wc, int fr, int fq, const F& f) {
#pragma unroll
  for (int ai = 0; ai < 2; ++ai)
#pragma unroll
    for (int m = 0; m < 4; ++m) {
      const int row = m0 + ai * 128 + wr * 64 + m * 16 + fr;
#pragma unroll
      for (int bj = 0; bj < 2; ++bj) f(row, n0 + bj * 128 + wc * 32 + 8 * fq, acc[ai][bj][m][0], acc[ai][bj][m][1]);
    }
}
DI void st_bf8(bfr* p, const f32x4& v0, const f32x4& v1) {
  u32x4 w;
  w[0] = pack2(v0[0], v0[1]); w[1] = pack2(v0[2], v0[3]); w[2] = pack2(v1[0], v1[1]); w[3] = pack2(v1[2], v1[3]);
  *(u32x4*)p = w;
}

DI void epi8_resid(const f32x4 (&acc)[2][2][4][2], int m0, int n0, int wr, int wc, int fr, int fq, const float* hsrc, float* hdst, bfr* hb, float* rowss) {
#pragma unroll
  for (int ai = 0; ai < 2; ++ai)
#pragma unroll
    for (int m = 0; m < 4; ++m) {
      const int row = m0 + ai * 128 + wr * 64 + m * 16 + fr;
      float ss = 0.f;
#pragma unroll
      for (int bj = 0; bj < 2; ++bj) {
        const int n = n0 + bj * 128 + wc * 32 + 8 * fq;
        const float* sp = hsrc + (size_t)row * 2048 + n;
        const f32x4 x0 = *(const f32x4*)sp, x1 = *(const f32x4*)(sp + 4);
        const f32x4 y0 = x0 + acc[ai][bj][m][0], y1 = x1 + acc[ai][bj][m][1];
        float* dp = hdst + (size_t)row * 2048 + n;
        *(f32x4*)dp = y0; *(f32x4*)(dp + 4) = y1;
        st_bf8(hb + (size_t)row * 2048 + n, y0, y1);
        ss += y0[0] * y0[0] + y0[1] * y0[1] + y0[2] * y0[2] + y0[3] * y0[3] + y1[0] * y1[0] + y1[1] * y1[1] + y1[2] * y1[2] + y1[3] * y1[3];
      }
      ss += __shfl_xor(ss, 16);
      ss += __shfl_xor(ss, 32);
      if (fq == 0) atomicAdd(rowss + row, ss);
    }
}
enum { MODE_WIN = 0, MODE_SEL = 1, MODE_X = 2, MODE_RET = 3 };
constexpr int KP = 136;

template <int MODE>
DI void attn_item(const Params& p, int item, char* smem, const int tid) {
  constexpr int VP = 136;
  bfr* Ks = (bfr*)smem;
  bfr* Vs = Ks + 64 * KP;
  const int w = tid >> 6, lane = tid & 63, r = lane & 31, h = lane >> 5;
  bfr* Qw = Vs + 64 * VP + w * 32 * KP;
  char* ws = p.ws;
  const bfr* z = (const bfr*)(ws + OFF_Z);

  int b, t0, tq0, jlo, jhi, head = 0, grp = 0, vh = 0;
  const bfr *qbase, *kbase, *vbase;
  int ldq, ldk;
  unsigned selm = 0, umask = 0xffffffffu;
  if (MODE == MODE_WIN) {
    const int tb = item >> 4, bg = item & 15;
    b = bg >> 2; grp = bg & 3; t0 = tb * 64; tq0 = t0 + 32 * (w >> 2); head = grp * 4 + (w & 3);
    qbase = z + (size_t)(b * SEQ + tq0) * ZS + ZC_Q + head * 128; ldq = ZS;
    kbase = z + (size_t)(b * SEQ) * ZS + ZC_KW + grp * 128;
    vbase = z + (size_t)(b * SEQ) * ZS + ZC_VW + grp * 128;
    ldk = ZS;
    jlo = (t0 - 511 > 0 ? t0 - 511 : 0) >> 6;
    jhi = tb;
  } else if (MODE == MODE_SEL) {
    const int tb = 31 - (item >> 4), bg = item & 15;
    b = bg >> 2; grp = bg & 3; t0 = tb * 64; tq0 = t0 + 32 * (w >> 2); head = grp * 4 + (w & 3);
    qbase = z + (size_t)(b * SEQ + tq0) * ZS + ZC_Q + head * 128; ldq = ZS;
    kbase = z + (size_t)(b * SEQ) * ZS + ZC_KS + grp * 128;
    vbase = z + (size_t)(b * SEQ) * ZS + ZC_VS + grp * 128;
    ldk = ZS;
    jlo = 0;
    jhi = tb;
    const unsigned* sm = (const unsigned*)(ws + OFF_SELM) + (b * 4 + grp) * SEQ;
    selm = sm[tq0 + r];
    unsigned u = sm[t0 + lane];
#pragma unroll
    for (int o = 32; o > 0; o >>= 1) u |= (unsigned)__shfl_xor((int)u, o);
    umask = (unsigned)__builtin_amdgcn_readfirstlane((int)u);
    umask &= (jhi >= 31) ? 0xffffffffu : ((1u << (jhi + 1)) - 1u);
  } else if (MODE == MODE_X) {
    const int tb = item >> 4, bh = item & 15;
    b = bh >> 2; head = bh & 3; t0 = tb * 256; tq0 = t0 + 32 * w;
    qbase = (const bfr*)(ws + OFF_QX) + (size_t)(b * SEQ + tq0) * 512 + head * 128; ldq = 512;
    kbase = (const bfr*)(ws + OFF_KX) + (size_t)(b * 256) * 512 + head * 128;
    vbase = (const bfr*)(ws + OFF_VX) + (size_t)(b * 256) * 512 + head * 128;
    ldk = 512;
    jlo = 0; jhi = 3;
  } else {
    const int tb = 7 - (item >> 6), rest = item & 63;
    b = rest >> 4; head = (rest >> 1) & 7; vh = rest & 1; t0 = tb * 256; tq0 = t0 + 32 * w;
    qbase = z + (size_t)(b * SEQ + tq0) * ZS + ZC_QR + head * 128; ldq = ZS;
    kbase = z + (size_t)(b * SEQ) * ZS + ZC_KR + head * 128;
    vbase = z + (size_t)(b * SEQ) * ZS + ZC_VR + head * 256 + vh * 128;
    ldk = ZS;
    jlo = 4 * tb; jhi = 4 * tb + 3;
  }
  const int tq = tq0 + r;

  f32x16 o[4];
#pragma unroll
  for (int dt = 0; dt < 4; ++dt)
#pragma unroll
    for (int i = 0; i < 16; ++i) o[dt][i] = 0.f;
  float m_run = -INFINITY, l_run = 0.f;
  float lg = 0.f;
  float rf[16];
  if (MODE == MODE_RET) {
    lg = log1pf(-exp2f(-5.f - (float)head)) * 1.4426950408889634f;
#pragma unroll
    for (int i = 0; i < 16; ++i) rf[i] = __builtin_amdgcn_exp2f(-lg * (float)crow(i, h));
  }

  u32x4 kreg[2], vreg[2];
  auto gload = [&](int j) {
    const int k0 = j * 64;
#pragma unroll
    for (int i = 0; i < 2; ++i) {
      const int c = tid + 512 * i, row = c >> 4, cc = c & 15;
      kreg[i] = *(const u32x4*)(kbase + (size_t)(k0 + row) * ldk + cc * 8);
      vreg[i] = *(const u32x4*)(vbase + (size_t)(k0 + row) * ldk + cc * 8);
    }
  };
  auto swrite = [&]() {
#pragma unroll
    for (int i = 0; i < 2; ++i) {
      const int c = tid + 512 * i, row = c >> 4, cc = c & 15;
      *(u32x4*)(Ks + row * KP + cc * 8) = kreg[i];
      *(u32x4*)(Vs + row * VP + cc * 8) = vreg[i];
    }
  };
  auto next_j = [&](int j) -> int {
    if (MODE == MODE_SEL) {
      const unsigned rem = (j >= 31) ? 0u : (umask & ~((2u << j) - 1u));
      return rem ? (__builtin_ctz(rem)) : 64;
    }
    return j + 1;
  };
  int j = jlo;
  if (MODE == MODE_SEL) j = __builtin_ctz(umask);
  gload(j);
  __syncthreads();
  {
    u32x4 qreg[8];
#pragma unroll
    for (int i = 0; i < 8; ++i) {
      const int c = lane + 64 * i, row = c >> 4, cc = c & 15;
      qreg[i] = *(const u32x4*)(qbase + (size_t)row * ldq + cc * 8);
    }
#pragma unroll
    for (int i = 0; i < 8; ++i) {
      const int c = lane + 64 * i, row = c >> 4, cc = c & 15;
      *(u32x4*)(Qw + row * KP + cc * 8) = qreg[i];
    }
  }
  const float csc = 0.08838834764831845f * 1.4426950408889634f;
  const int q4 = (lane & 15) >> 2, p4 = lane & 3, blk = (lane >> 4) & 1;
  if (MODE == MODE_RET) {
    const int c = t0 >> 8;
    if (c > 0) {
      bfr* Sb = Vs + 64 * VP + 8 * 32 * KP;
      const float* kvb = (const float*)(ws + OFF_RKV) + (size_t)((b * 8 + head) * 7) * (128 * 256) + vh * 128;
      const float g256 = __builtin_amdgcn_exp2f(lg * 256.f);
#pragma unroll 2
      for (int i = 0; i < 8; ++i) {
        const int e4 = tid + 512 * i, d = e4 >> 5, ec = (e4 & 31) * 4;
        f32x4 sum = {0.f, 0.f, 0.f, 0.f};
        float fac = 1.f;
        for (int jj = c - 1; jj >= 0; --jj) {
          const f32x4 kv = *(const f32x4*)(kvb + (size_t)jj * (128 * 256) + d * 256 + ec);
          sum += kv * fac;
          fac *= g256;
        }
        st_bf4(Sb + d * KP + ec, sum[0], sum[1], sum[2], sum[3]);
      }
      __syncthreads();
#pragma unroll
      for (int s = 0; s < 8; ++s) {
        const bf16x8 qf = *(const bf16x8*)(Qw + r * KP + 16 * s + 8 * h);
#pragma unroll
        for (int dt = 0; dt < 4; ++dt) {
          const bfr* sp = Sb + (16 * s + 8 * h + q4) * KP + 32 * dt + 16 * blk + 4 * p4;
          const s16x4 lo = tr_read(sp);
          const s16x4 hi = tr_read(sp + 4 * KP);
          const bf16x8 sf = __builtin_shufflevector(lo, hi, 0, 1, 2, 3, 4, 5, 6, 7);
          o[dt] = MFMA(sf, qf, o[dt]);
        }
      }
      const float fq_ = __builtin_amdgcn_exp2f(lg * (float)(tq - t0 + 1));
#pragma unroll
      for (int dt = 0; dt < 4; ++dt)
#pragma unroll
        for (int i = 0; i < 16; ++i) o[dt][i] *= fq_;
    }
  }
  bool first = true;
#pragma unroll 1
  while (j <= jhi) {
    if (!first) __syncthreads();
    first = false;
    swrite();
    __syncthreads();
    const int jn = next_j(j);
    if (jn <= jhi) gload(jn);
    const int k0 = j * 64;
    if (MODE == MODE_RET && k0 > tq0 + 31) { j = jn; continue; }
    bf16x8 pf[2][2];
    if (MODE == MODE_RET) {
#pragma unroll
      for (int sub = 0; sub < 2; ++sub) {
        f32x16 sx;
#pragma unroll
        for (int i = 0; i < 16; ++i) sx[i] = 0.f;
#pragma unroll
        for (int s = 0; s < 8; ++s) {
          const bf16x8 kf = *(const bf16x8*)(Ks + (32 * sub + r) * KP + 16 * s + 8 * h);
          const bf16x8 qf = *(const bf16x8*)(Qw + r * KP + 16 * s + 8 * h);
          sx = MFMA(kf, qf, sx);
        }
        {
          const int dq = tq - (k0 + 32 * sub);
          const float cf = __builtin_amdgcn_exp2f(lg * (float)dq);
#pragma unroll
          for (int i = 0; i < 16; ++i) sx[i] = (crow(i, h) <= dq) ? sx[i] * (cf * rf[i]) : 0.f;
        }
        pf[sub][0] = pack8(sx, 0);
        pf[sub][1] = pack8(sx, 1);
      }
    } else {
      f32x16 s0, s1;
#pragma unroll
      for (int i = 0; i < 16; ++i) { s0[i] = 0.f; s1[i] = 0.f; }
#pragma unroll
      for (int s = 0; s < 8; ++s) {
        const bf16x8 k0f = *(const bf16x8*)(Ks + r * KP + 16 * s + 8 * h);
        const bf16x8 k1f = *(const bf16x8*)(Ks + (32 + r) * KP + 16 * s + 8 * h);
        const bf16x8 qf = *(const bf16x8*)(Qw + r * KP + 16 * s + 8 * h);
        s0 = MFMA(k0f, qf, s0);
        s1 = MFMA(k1f, qf, s1);
      }
      bool need_mask = false;
      if (MODE == MODE_WIN) need_mask = (k0 + 63 > tq0) || (k0 < tq0 + 31 - 511);
      if (MODE == MODE_SEL) need_mask = (k0 + 63 > tq0);
      const bool lanesel = (MODE == MODE_SEL) ? ((selm >> j) & 1u) : true;
      float mx = -INFINITY;
      if (need_mask) {
#pragma unroll
        for (int i = 0; i < 16; ++i) {
          const int tk0 = k0 + crow(i, h), tk1 = tk0 + 32;
          bool ok0 = true, ok1 = true;
          if (MODE == MODE_WIN) { ok0 = (tk0 <= tq) && (tq - tk0 < 512); ok1 = (tk1 <= tq) && (tq - tk1 < 512); }
          if (MODE == MODE_SEL) { ok0 = lanesel && (tk0 <= tq); ok1 = lanesel && (tk1 <= tq); }
          s0[i] = ok0 ? s0[i] * csc : -INFINITY;
          s1[i] = ok1 ? s1[i] * csc : -INFINITY;
          mx = fmaxf(mx, fmaxf(s0[i], s1[i]));
        }
      } else {
#pragma unroll
        for (int i = 0; i < 16; ++i) {
          s0[i] = lanesel ? s0[i] * csc : -INFINITY;
          s1[i] = lanesel ? s1[i] * csc : -INFINITY;
          mx = fmaxf(mx, fmaxf(s0[i], s1[i]));
        }
      }
      mx = fmaxf(mx, __shfl_xor(mx, 32));
      const float mnew = fmaxf(m_run, mx);
      const float muse = (mnew == -INFINITY) ? 0.f : mnew;
      const float alpha = __builtin_amdgcn_exp2f(m_run - muse);
      float ls = 0.f;
#pragma unroll
      for (int i = 0; i < 16; ++i) {
        s0[i] = __builtin_amdgcn_exp2f(s0[i] - muse);
        s1[i] = __builtin_amdgcn_exp2f(s1[i] - muse);
        ls += s0[i] + s1[i];
      }
      ls += __shfl_xor(ls, 32);
      l_run = l_run * alpha + ls;
      m_run = mnew;
      if (__builtin_amdgcn_ballot_w64(alpha != 1.f) != 0) {
#pragma unroll
        for (int dt = 0; dt < 4; ++dt)
#pragma unroll
          for (int i = 0; i < 16; ++i) o[dt][i] *= alpha;
      }
      pf[0][0] = pack8(s0, 0); pf[0][1] = pack8(s0, 1);
      pf[1][0] = pack8(s1, 0); pf[1][1] = pack8(s1, 1);
    }
#pragma unroll
    for (int dt = 0; dt < 4; ++dt)
#pragma unroll
      for (int sub = 0; sub < 2; ++sub)
#pragma unroll
        for (int st = 0; st < 2; ++st) {
          const int key0 = 32 * sub + 16 * st + 4 * h;
          const bfr* vp = Vs + (key0 + q4) * VP + 32 * dt + 16 * blk + 4 * p4;
          const s16x4 lo = tr_read(vp);
          const s16x4 hi = tr_read(vp + 8 * VP);
          const bf16x8 vf = __builtin_shufflevector(lo, hi, 0, 1, 2, 3, 4, 5, 6, 7);
          o[dt] = MFMA(vf, pf[sub][st], o[dt]);
        }
    j = jn;
  }

  if (MODE == MODE_SEL && p.dbg) return;
  const size_t mrow = (size_t)(b * SEQ + tq);
  if (MODE == MODE_WIN || MODE == MODE_SEL) {
    const float inv = (l_run > 0.f) ? 1.f / l_run : 0.f;
    const float gate = bflo(z[mrow * ZS + ZC_GN + head * 3 + (MODE == MODE_WIN ? 2 : 1)]);
    bfr* orow = (bfr*)(ws + OFF_ONSA) + mrow * 2048 + head * 128;
    const float sc = inv * gate;
#pragma unroll
    for (int dt = 0; dt < 4; ++dt)
#pragma unroll
      for (int g = 0; g < 4; ++g) {
        bfr* dst = orow + 32 * dt + 8 * g + 4 * h;
        float a = o[dt][4 * g] * sc, bb = o[dt][4 * g + 1] * sc, c = o[dt][4 * g + 2] * sc, d = o[dt][4 * g + 3] * sc;
        if (MODE == MODE_SEL) {
          const uint2 old = *(const uint2*)dst;
          a += bflo(old.x); bb += bfhi(old.x); c += bflo(old.y); d += bfhi(old.y);
        }
        st_bf4(dst, a, bb, c, d);
      }
  } else if (MODE == MODE_X) {
    const float inv = 1.f / l_run;
    bfr* orow = (bfr*)(ws + OFF_OX) + mrow * 512 + head * 128;
#pragma unroll
    for (int dt = 0; dt < 4; ++dt)
#pragma unroll
      for (int g = 0; g < 4; ++g)
        st_bf4(orow + 32 * dt + 8 * g + 4 * h, o[dt][4 * g] * inv, o[dt][4 * g + 1] * inv, o[dt][4 * g + 2] * inv,
               o[dt][4 * g + 3] * inv);
  } else {
    float sm = 0.f, sq = 0.f;
#pragma unroll
    for (int dt = 0; dt < 4; ++dt)
#pragma unroll
      for (int i = 0; i < 16; ++i) { sm += o[dt][i]; sq += o[dt][i] * o[dt][i]; }
    sm += __shfl_xor(sm, 32);
    sq += __shfl_xor(sq, 32);
    if (h == 0) *(float2*)((float*)(ws + OFF_RSTAT) + ((mrow * 8 + head) * 2 + vh) * 2) = make_float2(sm, sq);
    bfr* orow = (bfr*)(ws + OFF_ORET) + mrow * 2048 + head * 256 + vh * 128;
#pragma unroll
    for (int dt = 0; dt < 4; ++dt)
#pragma unroll
      for (int g = 0; g < 4; ++g)
        st_bf4(orow + 32 * dt + 8 * g + 4 * h, o[dt][4 * g], o[dt][4 * g + 1], o[dt][4 * g + 2], o[dt][4 * g + 3]);
  }
}

DI void retkv_item(const Params& p, int item, char* smem, const int tid) {
  constexpr int VPW = 264;
  bfr* Kt = (bfr*)smem;
  bfr* Vt = Kt + 64 * KP;
  const int w = tid >> 6, lane = tid & 63, r = lane & 31, h = lane >> 5;
  const int c = item % 7, bh = item / 7, b = bh >> 3, head = bh & 7;
  char* ws = p.ws;
  const bfr* z = (const bfr*)(ws + OFF_Z);
  const bfr* kbase = z + (size_t)(b * SEQ + 256 * c) * ZS + ZC_KR + head * 128;
  const bfr* vbase = z + (size_t)(b * SEQ + 256 * c) * ZS + ZC_VR + head * 256;
  const float lg = log1pf(-exp2f(-5.f - (float)head)) * 1.4426950408889634f;
  const int dtile = w & 3, ehalf = w >> 2;
  const int q4 = (lane & 15) >> 2, p4 = lane & 3, blk = (lane >> 4) & 1;
  f32x16 acc[4];
#pragma unroll
  for (int et = 0; et < 4; ++et)
#pragma unroll
    for (int i = 0; i < 16; ++i) acc[et][i] = 0.f;
  float wj[8];
#pragma unroll
  for (int j = 0; j < 8; ++j) wj[j] = __builtin_amdgcn_exp2f(-lg * (float)j);
#pragma unroll 1
  for (int t = 0; t < 4; ++t) {
    u32x4 kr[2], vr[4];
#pragma unroll
    for (int i = 0; i < 2; ++i) {
      const int ch = tid + 512 * i, row = ch >> 4, cc = ch & 15;
      kr[i] = *(const u32x4*)(kbase + (size_t)(64 * t + row) * ZS + cc * 8);
    }
#pragma unroll
    for (int i = 0; i < 4; ++i) {
      const int ch = tid + 512 * i, row = ch >> 5, cc = ch & 31;
      vr[i] = *(const u32x4*)(vbase + (size_t)(64 * t + row) * ZS + cc * 8);
    }
    __syncthreads();
#pragma unroll
    for (int i = 0; i < 2; ++i) {
      const int ch = tid + 512 * i, row = ch >> 4, cc = ch & 15;
      *(u32x4*)(Kt + row * KP + cc * 8) = kr[i];
    }
#pragma unroll
    for (int i = 0; i < 4; ++i) {
      const int ch = tid + 512 * i, row = ch >> 5, cc = ch & 31;
      *(u32x4*)(Vt + row * VPW + cc * 8) = vr[i];
    }
    __syncthreads();
#pragma unroll
    for (int st = 0; st < 4; ++st) {
      const int m0 = 16 * st + 8 * h;
      const bfr* kp = Kt + (m0 + q4) * KP + 32 * dtile + 16 * blk + 4 * p4;
      const s16x4 klo = tr_read(kp);
      const s16x4 khi = tr_read(kp + 4 * KP);
      typedef unsigned u4_ __attribute__((ext_vector_type(4)));
      const u4_ ku = __builtin_bit_cast(u4_, __builtin_shufflevector(klo, khi, 0, 1, 2, 3, 4, 5, 6, 7));
      const float wb = __builtin_amdgcn_exp2f(lg * (float)(255 - 64 * t - m0));
      u4_ ks;
#pragma unroll
      for (int k = 0; k < 4; ++k) ks[k] = pack2(bflo(ku[k]) * (wb * wj[2 * k]), bfhi(ku[k]) * (wb * wj[2 * k + 1]));
      const bf16x8 af = __builtin_bit_cast(bf16x8, ks);
#pragma unroll
      for (int et = 0; et < 4; ++et) {
        const bfr* vp = Vt + (m0 + q4) * VPW + 128 * ehalf + 32 * et + 16 * blk + 4 * p4;
        const s16x4 vlo = tr_read(vp);
        const s16x4 vhi = tr_read(vp + 4 * VPW);
        const bf16x8 vf = __builtin_shufflevector(vlo, vhi, 0, 1, 2, 3, 4, 5, 6, 7);
        acc[et] = MFMA(af, vf, acc[et]);
      }
    }
  }
  float* kv = (float*)(ws + OFF_RKV) + (size_t)item * (128 * 256);
#pragma unroll
  for (int et = 0; et < 4; ++et)
#pragma unroll
    for (int i = 0; i < 16; ++i) kv[(32 * dtile + crow(i, h)) * 256 + 128 * ehalf + 32 * et + r] = acc[et][i];
  __syncthreads();
}

DI void ret_finish_row(const Params& p, int row, const int t) {
  char* ws = p.ws;
  const bfr* z = (const bfr*)(ws + OFF_Z);
  const int col = t * 8, head = t >> 5;
  const float4 st = *(const float4*)((const float*)(ws + OFF_RSTAT) + ((size_t)row * 8 + head) * 4);
  const float mu = (st.x + st.z) * (1.f / 256.f);
  const float var = fmaxf((st.y + st.w) * (1.f / 256.f) - mu * mu, 0.f);
  const float rstd = rsqrtf(var + 1e-6f);
  bfr* op = (bfr*)(ws + OFF_ORET) + (size_t)row * 2048 + col;
  const u32x4 ov = *(const u32x4*)op;
  const u32x4 gv = *(const u32x4*)(z + (size_t)row * ZS + ZC_GR + col);
  const float4 w0 = *(const float4*)(p.gn_w + col), w1 = *(const float4*)(p.gn_w + col + 4);
  u32x4 res;
  res[0] = pack2((bflo(ov[0]) - mu) * rstd * w0.x * bflo(gv[0]), (bfhi(ov[0]) - mu) * rstd * w0.y * bfhi(gv[0]));
  res[1] = pack2((bflo(ov[1]) - mu) * rstd * w0.z * bflo(gv[1]), (bfhi(ov[1]) - mu) * rstd * w0.w * bfhi(gv[1]));
  res[2] = pack2((bflo(ov[2]) - mu) * rstd * w1.x * bflo(gv[2]), (bfhi(ov[2]) - mu) * rstd * w1.y * bfhi(gv[2]));
  res[3] = pack2((bflo(ov[3]) - mu) * rstd * w1.z * bflo(gv[3]), (bfhi(ov[3]) - mu) * rstd * w1.w * bfhi(gv[3]));
  *(u32x4*)op = res;
}

DI void ret_finish_rows4(const Params& p, int row0, const int t) {
  char* ws = p.ws;
  const bfr* z = (const bfr*)(ws + OFF_Z);
  const int col = t * 8, head = t >> 5;
  float4 st[4];
  u32x4 ov[4], gv[4];
#pragma unroll
  for (int q = 0; q < 4; ++q) {
    const size_t row = (size_t)(row0 + 2 * q);
    st[q] = *(const float4*)((const float*)(ws + OFF_RSTAT) + (row * 8 + head) * 4);
    ov[q] = *(const u32x4*)((const bfr*)(ws + OFF_ORET) + row * 2048 + col);
    gv[q] = *(const u32x4*)(z + row * ZS + ZC_GR + col);
  }
  const float4 w0 = *(const float4*)(p.gn_w + col), w1 = *(const float4*)(p.gn_w + col + 4);
#pragma unroll
  for (int q = 0; q < 4; ++q) {
    const float mu = (st[q].x + st[q].z) * (1.f / 256.f);
    const float var = fmaxf((st[q].y + st[q].w) * (1.f / 256.f) - mu * mu, 0.f);
    const float rstd = rsqrtf(var + 1e-6f);
    u32x4 res;
    res[0] = pack2((bflo(ov[q][0]) - mu) * rstd * w0.x * bflo(gv[q][0]), (bfhi(ov[q][0]) - mu) * rstd * w0.y * bfhi(gv[q][0]));
    res[1] = pack2((bflo(ov[q][1]) - mu) * rstd * w0.z * bflo(gv[q][1]), (bfhi(ov[q][1]) - mu) * rstd * w0.w * bfhi(gv[q][1]));
    res[2] = pack2((bflo(ov[q][2]) - mu) * rstd * w1.x * bflo(gv[q][2]), (bfhi(ov[q][2]) - mu) * rstd * w1.y * bfhi(gv[q][2]));
    res[3] = pack2((bflo(ov[q][3]) - mu) * rstd * w1.z * bflo(gv[q][3]), (bfhi(ov[q][3]) - mu) * rstd * w1.w * bfhi(gv[q][3]));
    *(u32x4*)((bfr*)(ws + OFF_ORET) + (size_t)(row0 + 2 * q) * 2048 + col) = res;
  }
}

DI void cmp_item(const Params& p, int item, char* smem, const int tid) {
  bfr* Ks = (bfr*)smem;
  float* impw = (float*)(smem + 128 * KP * 2);
  const int w = tid >> 6, lane = tid & 63, r = lane & 31, h = lane >> 5;
  char* ws = p.ws;
  const bfr* z = (const bfr*)(ws + OFF_Z);
  const int tb = item >> 4, bg = item & 15, b = bg >> 2, grp = bg & 3;
  const int t0 = tb * 64, ti = 32 * (w >> 2) + r, tq = t0 + ti, hw = w & 3, head = grp * 4 + hw;
  const bfr* qrow = z + (size_t)(b * SEQ + tq) * ZS + ZC_Q + head * 128;
  const bfr* kc = (const bfr*)(ws + OFF_KCVC) + (size_t)((b * 4 + grp) * 128) * 128;
  const bfr* vc = kc + (size_t)2048 * 128;
  bf16x8 qf[8];
#pragma unroll
  for (int s = 0; s < 8; ++s) qf[s] = *(const bf16x8*)(qrow + 16 * s + 8 * h);
  u32x4 reg[4];
#pragma unroll
  for (int i = 0; i < 4; ++i) {
    const int c = tid + 512 * i, row = c >> 4, cc = c & 15;
    reg[i] = *(const u32x4*)(kc + row * 128 + cc * 8);
  }
  __syncthreads();
#pragma unroll
  for (int i = 0; i < 4; ++i) {
    const int c = tid + 512 * i, row = c >> 4, cc = c & 15;
    *(u32x4*)(Ks + row * KP + cc * 8) = reg[i];
  }
  __syncthreads();
  f32x16 s[4];
#pragma unroll
  for (int kt = 0; kt < 4; ++kt) {
#pragma unroll
    for (int i = 0; i < 16; ++i) s[kt][i] = 0.f;
#pragma unroll
    for (int ss = 0; ss < 8; ++ss) {
      const bf16x8 kf = *(const bf16x8*)(Ks + (32 * kt + r) * KP + 16 * ss + 8 * h);
      s[kt] = MFMA(kf, qf[ss], s[kt]);
    }
  }
  const float csc = 0.08838834764831845f * 1.4426950408889634f;
  float mx = -INFINITY;
#pragma unroll
  for (int kt = 0; kt < 4; ++kt)
#pragma unroll
    for (int i = 0; i < 16; ++i) {
      const int c = 32 * kt + crow(i, h);
      const bool ok = (c * 16 + 31 <= tq) && (c < 127);
      s[kt][i] = ok ? s[kt][i] * csc : -INFINITY;
      mx = fmaxf(mx, s[kt][i]);
    }
  mx = fmaxf(mx, __shfl_xor(mx, 32));
  const float muse = (mx == -INFINITY) ? 0.f : mx;
  float ls = 0.f;
#pragma unroll
  for (int kt = 0; kt < 4; ++kt)
#pragma unroll
    for (int i = 0; i < 16; ++i) {
      s[kt][i] = __builtin_amdgcn_exp2f(s[kt][i] - muse);
      ls += s[kt][i];
    }
  ls += __shfl_xor(ls, 32);
  const float inv = (ls > 0.f) ? 1.f / ls : 0.f;
#pragma unroll
  for (int kt = 0; kt < 4; ++kt)
#pragma unroll
    for (int i = 0; i < 16; ++i) s[kt][i] *= inv;
  float plast[16];
#pragma unroll
  for (int kt = 0; kt < 4; ++kt)
#pragma unroll
    for (int g = 0; g < 4; ++g) plast[kt * 4 + g] = __shfl_xor(s[kt][4 * g + 3], 32);
#pragma unroll
  for (int kt = 0; kt < 4; ++kt)
#pragma unroll
    for (int g = 0; g < 4; ++g) {
      const int slot = kt * 4 + g;
      const float sum4 = s[kt][4 * g] + s[kt][4 * g + 1] + s[kt][4 * g + 2] + s[kt][4 * g + 3];
      const float prevl = (slot > 0) ? plast[slot > 0 ? slot - 1 : 0] : 0.f;
      const float add = h ? plast[slot] : prevl;
      impw[(hw * 64 + ti) * 32 + 8 * kt + 2 * g + h] = sum4 + add;
    }
  bf16x8 pf[4][2];
#pragma unroll
  for (int kt = 0; kt < 4; ++kt) { pf[kt][0] = pack8(s[kt], 0); pf[kt][1] = pack8(s[kt], 1); }
#pragma unroll
  for (int i = 0; i < 4; ++i) {
    const int c = tid + 512 * i, row = c >> 4, cc = c & 15;
    reg[i] = *(const u32x4*)(vc + row * 128 + cc * 8);
  }
  __syncthreads();
#pragma unroll
  for (int i = 0; i < 4; ++i) {
    const int c = tid + 512 * i, row = c >> 4, cc = c & 15;
    *(u32x4*)(Ks + row * KP + cc * 8) = reg[i];
  }
  __syncthreads();
  f32x16 o[4];
#pragma unroll
  for (int dt = 0; dt < 4; ++dt)
#pragma unroll
    for (int i = 0; i < 16; ++i) o[dt][i] = 0.f;
  const int q4 = (lane & 15) >> 2, p4 = lane & 3, blk = (lane >> 4) & 1;
#pragma unroll
  for (int dt = 0; dt < 4; ++dt)
#pragma unroll
    for (int kt = 0; kt < 4; ++kt)
#pragma unroll
      for (int st = 0; st < 2; ++st) {
        const int key0 = 32 * kt + 16 * st + 4 * h;
        const bfr* vp = Ks + (key0 + q4) * KP + 32 * dt + 16 * blk + 4 * p4;
        const s16x4 lo = tr_read(vp);
        const s16x4 hi = tr_read(vp + 8 * KP);
        const bf16x8 vf = __builtin_shufflevector(lo, hi, 0, 1, 2, 3, 4, 5, 6, 7);
        o[dt] = MFMA(vf, pf[kt][st], o[dt]);
      }
  {
    const size_t mrow = (size_t)(b * SEQ + tq);
    const float gate = bflo(z[mrow * ZS + ZC_GN + head * 3 + 0]);
    bfr* orow = (bfr*)(ws + OFF_ONSA) + mrow * 2048 + head * 128;
#pragma unroll
    for (int dt = 0; dt < 4; ++dt)
#pragma unroll
      for (int g = 0; g < 4; ++g) {
        bfr* dst = orow + 32 * dt + 8 * g + 4 * h;
        const uint2 old = *(const uint2*)dst;
        st_bf4(dst, o[dt][4 * g] * gate + bflo(old.x), o[dt][4 * g + 1] * gate + bfhi(old.x),
               o[dt][4 * g + 2] * gate + bflo(old.y), o[dt][4 * g + 3] * gate + bfhi(old.y));
      }
  }
  {
    const int i = tid >> 3, jg = tid & 7;
    const int cur = (t0 + i) >> 6;
    float vm[4];
#pragma unroll
    for (int e = 0; e < 4; ++e) {
      const int jme = 4 * jg + e;
      const float a = impw[(0 * 64 + i) * 32 + jme] + impw[(1 * 64 + i) * 32 + jme] + impw[(2 * 64 + i) * 32 + jme] + impw[(3 * 64 + i) * 32 + jme];
      const bool forced = (jme == 0) || (jme == cur) || (jme == cur - 1);
      vm[e] = forced ? INFINITY : ((jme > cur) ? -INFINITY : a);
    }
#pragma unroll
    for (int e = 0; e < 4; ++e) impw[i * 32 + 4 * jg + e] = vm[e];
    __syncthreads();
    int rank[4] = {0, 0, 0, 0};
#pragma unroll 4
    for (int k = 0; k < 32; ++k) {
      const float vk = impw[i * 32 + k];
#pragma unroll
      for (int e = 0; e < 4; ++e) rank[e] += (vk > vm[e] || (vk == vm[e] && k < 4 * jg + e)) ? 1 : 0;
    }
    unsigned bits = 0;
#pragma unroll
    for (int e = 0; e < 4; ++e)
      if (rank[e] < 16 && 4 * jg + e <= cur) bits |= 1u << (4 * jg + e);
    bits |= (unsigned)__shfl_xor((int)bits, 1);
    bits |= (unsigned)__shfl_xor((int)bits, 2);
    bits |= (unsigned)__shfl_xor((int)bits, 4);
    if (jg == 0) ((unsigned*)(ws + OFF_SELM))[(b * 4 + grp) * SEQ + t0 + i] = bits;
  }
  __syncthreads();
}

DI int grab(unsigned* ctr, int* slot, const int tid) {
  __syncthreads();
  if (tid == 0) *slot = (int)atomicAdd(ctr, 1u);
  __syncthreads();
  return *slot;
}

DI void run_phase(const Params& p0, int ph, char* smem, int* slot, const int wave_s, const int rep) {
  char* ws = p0.ws;
  asm volatile("" : "+s"(ws));
  Params p = p0;
  p.ws = ws;
  p.dbg = rep;
  const int G = gridDim.x;
  int bid = blockIdx.x;
  int tid = wave_s * 64 + (int)__builtin_amdgcn_mbcnt_hi(~0u, __builtin_amdgcn_mbcnt_lo(~0u, 0u));
  asm volatile("" : "+s"(bid));
  asm volatile("" : "+v"(tid));
  bfr* z = (bfr*)(ws + OFF_Z);
  unsigned* ctr = (unsigned*)(ws + OFF_CTR) + rep * 8;
  switch (ph) {
    case 0: {
      if (bid == 0 && tid < 64) ((unsigned*)(ws + OFF_CTR))[tid] = 0u;
      if (bid < (2 * NTOK) / NTHR) ((float*)(ws + OFF_ROWSS))[bid * NTHR + tid] = 0.f;
      int tot = 0;
      for (int j = 0; j < 3; ++j) tot += tjob_tiles(j);
      const int n_norm = 1024 + 128, n_rope = 256;
      tr_run(p, 0, bid, G, tot, (float*)smem, tid);
      for (int it = tot + bid; it < tot + n_norm + n_rope; it += G) {
        if (it < tot + n_norm) {
          const int row = (it - tot) * 8 + (tid >> 6);
          if (row < NTOK) rmsnorm_row(p.x + (size_t)row * 2048, p.attn_norm_w, (bfr*)(ws + OFF_N) + (size_t)row * 2048, nullptr, tid);
          else rmsnorm_row(p.mem + (size_t)(row - NTOK) * 2048, p.mem_norm_w, (bfr*)(ws + OFF_MN) + (size_t)(row - NTOK) * 2048, nullptr, tid);
        } else {
          const int e = (it - tot - n_norm) * 512 + tid;
          const int t = e >> 6, i = e & 63;
          const float ang = (float)t * ROPE_INV[i];
          const float kk = rintf(ang * 0.15915494309189535f);
          float rr = fmaf(-kk, 6.2831854820251465f, ang);
          rr = fmaf(-kk, -1.7484555e-7f, rr);
          const float fr = rr * 0.15915494309189535f;
          ((float2*)(ws + OFF_ROPE))[e] = make_float2(__builtin_amdgcn_cosf(fr), __builtin_amdgcn_sinf(fr));
        }
      }
    } break;
    case 1: {
      {
        bfr* zcb = (bfr*)(ws + OFF_ZC);
        const float* rope = (const float*)(ws + OFF_ROPE);
        gemm8_phase(smem, (const bfr*)(ws + OFF_N), (const bfr*)(ws + OFF_WINT), 2048, 32 * 61, G, bid, tid,
          [&](const f32x4 (&acc)[2][2][4][2], int m0, int n0, int wr, int wc, int fr, int fq) {
            if (n0 < ZC_KC || (n0 >= ZC_KS && n0 < ZC_QR) || (n0 >= ZC_VR && n0 < ZC_GR)) {
              epi8_foreach(acc, m0, n0, wr, wc, fr, fq, [&](int m, int n, const f32x4& v0, const f32x4& v1) { st_bf8(z + (size_t)m * ZS + n, v0, v1); });
            } else if (n0 < ZC_KS) {
              const float* pe = (n0 < ZC_VC) ? p.pe_k : p.pe_v;
              epi8_foreach(acc, m0, n0, wr, wc, fr, fq, [&](int m, int n, const f32x4& v0, const f32x4& v1) {
                const int t = m & 2047, dd = n & 127;
                const float* pl = pe + (t & 15) * 128 + dd;
                const float* ph_ = pl + 16 * 128;
                const f32x4 l0 = *(const f32x4*)pl, l1 = *(const f32x4*)(pl + 4), h0 = *(const f32x4*)ph_, h1 = *(const f32x4*)(ph_ + 4);
                bfr* d = zcb + (size_t)m * 2048 + (n - ZC_KC);
                st_bf8(d, v0 + l0, v1 + l1);
                st_bf8(d + 1024, v0 + h0, v1 + h1);
              });
            } else if (n0 < ZC_VR) {
              const float sc = (n0 >= ZC_KR) ? 0.08838834764831845f : 1.f;
              epi8_foreach(acc, m0, n0, wr, wc, fr, fq, [&](int m, int n, const f32x4& v0, const f32x4& v1) {
                const int t = m & 2047, i0 = (n & 127) >> 1;
                const float* rp = rope + (size_t)(t * 64 + i0) * 2;
                const f32x4 c01 = *(const f32x4*)rp, c23 = *(const f32x4*)(rp + 4);
                f32x4 a0, a1;
                a0[0] = (v0[0] * c01[0] - v0[1] * c01[1]) * sc; a0[1] = (v0[0] * c01[1] + v0[1] * c01[0]) * sc;
                a0[2] = (v0[2] * c01[2] - v0[3] * c01[3]) * sc; a0[3] = (v0[2] * c01[3] + v0[3] * c01[2]) * sc;
                a1[0] = (v1[0] * c23[0] - v1[1] * c23[1]) * sc; a1[1] = (v1[0] * c23[1] + v1[1] * c23[0]) * sc;
                a1[2] = (v1[2] * c23[2] - v1[3] * c23[3]) * sc; a1[3] = (v1[2] * c23[3] + v1[3] * c23[2]) * sc;
                st_bf8(z + (size_t)m * ZS + n, a0, a1);
              });
            } else if (n0 < ZC_GA) {
              epi8_foreach(acc, m0, n0, wr, wc, fr, fq, [&](int m, int n, const f32x4& v0, const f32x4& v1) {
                f32x4 a0, a1;
#pragma unroll
                for (int j = 0; j < 4; ++j) { a0[j] = v0[j] * sigmoidf_(v0[j]); a1[j] = v1[j] * sigmoidf_(v1[j]); }
                st_bf8(z + (size_t)m * ZS + n, a0, a1);
              });
            } else {
              epi8_foreach(acc, m0, n0, wr, wc, fr, fq, [&](int m, int n, const f32x4& v0, const f32x4& v1) {
                if (n >= ZS) return;
                f32x4 a0, a1;
#pragma unroll
                for (int j = 0; j < 4; ++j) { a0[j] = sigmoidf_(v0[j]); a1[j] = sigmoidf_(v1[j]); }
                st_bf8(z + (size_t)m * ZS + n, a0, a1);
              });
            }
          });
      }
      {
        const int nunits = 32 * 61;
        const int nlong = (nunits % G == 0) ? 0 : nunits % G;
        const int nshort = G - nlong;
        const int sb_ = bid - nlong;
        if (sb_ >= 0) {
          for (int u = sb_; u < 32; u += nshort) {
            f32x16 acc[1][4];
            acc_zero<1>(acc);
            const int which = u >> 4, mt = (u & 15) >> 2, nt = u & 3;
            const int m0 = mt * 256, n0 = nt * 128;
            PlainPtr af{(const bfr*)(ws + OFF_MN) + (size_t)m0 * 2048, 2048};
            PlainPtr bf{(const bfr*)(ws + (which ? OFF_WVT : OFF_WKT)) + (size_t)n0 * 2048, 2048};
            gemm_main<1>(acc, af, bf, 32, smem, tid);
            bfr* dstb = (bfr*)(ws + (which ? OFF_VX : OFF_KX));
            gemm_epi<1>(acc, m0, n0, tid, [&](int m, int n, float a, float b, float c, float d) { st_bf4(dstb + (size_t)m * 512 + n, a, b, c, d); });
          }
          int tot2 = 0;
          for (int j = 3; j < 12; ++j) tot2 += tjob_tiles(j);
          tr_run(p, 3, sb_, nshort, tot2, (float*)smem, tid);
        }
      }
    } break;
    case 2: {
      for (int it = grab(ctr + 0, slot, tid); it < 64; it = grab(ctr + 0, slot, tid)) {
        const int which = it >> 5, mt = (it & 31) >> 2, nt = it & 3;
        const int m0 = mt * 256, n0 = nt * 256;
        f32x16 acc[2][4];
        acc_zero<2>(acc);
        struct GatherA {
          const bfr* base; int m0;
          DI int rowoff(int row) const {
            const int R = m0 + row;
            const int bb = R >> 9, g = (R >> 7) & 3;
            int c = R & 127; c = c > 126 ? 126 : c;
            return (bb * SEQ + c * 16) * 2048 + g * 128;
          }
          DI int koff(int kk) const { const int l = kk >> 7; return l * 2048 + ((l >> 4) << 10) + (kk & 127); }
        };
        GatherA af{(const bfr*)(ws + OFF_ZC) + which * 512, m0};
        PlainPtr bf{(const bfr*)(ws + OFF_W1T) + (size_t)which * 1024 * 4096 + (size_t)n0 * 4096, 4096};
        gemm_main<2>(acc, af, bf, 64, smem, tid);
        bfr* hid = (bfr*)(ws + OFF_HIDC) + (size_t)which * 2048 * 1024;
        gemm_epi<2>(acc, m0, n0, tid, [&](int m, int n, float a, float b, float c, float d) {
          st_bf4(hid + (size_t)m * 1024 + n, a * sigmoidf_(a), b * sigmoidf_(b), c * sigmoidf_(c), d * sigmoidf_(d));
        });
      }
      for (int it = grab(ctr + 6, slot, tid); it < 224; it = grab(ctr + 6, slot, tid)) retkv_item(p, it, smem, tid);
      for (int it = grab(ctr + 1, slot, tid); it < 512; it = grab(ctr + 1, slot, tid)) attn_item<MODE_WIN>(p, it, smem, tid);
    } break;
    case 3: {
      for (int it = bid; it < 16; it += G) {
        const int which = it >> 3, mt = it & 7;
        const int m0 = mt * 256;
        f32x16 acc[1][4];
        acc_zero<1>(acc);
        PlainPtr af{(const bfr*)(ws + OFF_HIDC) + (size_t)which * 2048 * 1024 + (size_t)m0 * 1024, 1024};
        PlainPtr bf{(const bfr*)(ws + OFF_W2T) + (size_t)which * 128 * 1024, 1024};
        gemm_main<1>(acc, af, bf, 16, smem, tid);
        bfr* dstb = (bfr*)(ws + OFF_KCVC) + (size_t)which * 2048 * 128;
        gemm_epi<1>(acc, m0, 0, tid, [&](int m, int n, float a, float b, float c, float d) { st_bf4(dstb + (size_t)m * 128 + n, a, b, c, d); });
      }
      for (int it = grab(ctr + 5, slot, tid); it < 512; it = grab(ctr + 5, slot, tid)) attn_item<MODE_RET>(p, it, smem, tid);
    } break;
    case 4: {
      for (int it = bid; it < 512; it += G) cmp_item(p, it, smem, tid);
      for (int it = bid; it < NTOK / 8; it += G) ret_finish_rows4(p, it * 8 + (tid >> 8), tid & 255);
    } break;
    case 5: {
      for (int it = grab(ctr + 2, slot, tid); it < 512; it = grab(ctr + 2, slot, tid)) attn_item<MODE_SEL>(p, it, smem, tid);
    } break;
    case 6: {
      bfr* mg = (bfr*)(ws + OFF_MERGED);
      gemm8_phase(smem, (const bfr*)(ws + OFF_ONSA), (const bfr*)(ws + OFF_WAT), 2048, 32 * 8, G, bid, tid,
        [&](const f32x4 (&acc)[2][2][4][2], int m0, int n0, int wr, int wc, int fr, int fq) {
          epi8_foreach(acc, m0, n0, wr, wc, fr, fq, [&](int m, int n, const f32x4& v0, const f32x4& v1) {
            const u32x4 ga = *(const u32x4*)(z + (size_t)m * ZS + ZC_GA + n);
            f32x4 a0 = {bflo(ga[0]) * v0[0], bfhi(ga[0]) * v0[1], bflo(ga[1]) * v0[2], bfhi(ga[1]) * v0[3]};
            f32x4 a1 = {bflo(ga[2]) * v1[0], bfhi(ga[2]) * v1[1], bflo(ga[3]) * v1[2], bfhi(ga[3]) * v1[3]};
            st_bf8(mg + (size_t)m * 2048 + n, a0, a1);
          });
        });
      gemm8_phase(smem, (const bfr*)(ws + OFF_ORET), (const bfr*)(ws + OFF_WBT), 2048, 32 * 8, G, bid, tid,
        [&](const f32x4 (&acc)[2][2][4][2], int m0, int n0, int wr, int wc, int fr, int fq) {
          epi8_foreach(acc, m0, n0, wr, wc, fr, fq, [&](int m, int n, const f32x4& v0, const f32x4& v1) {
            const u32x4 gb = *(const u32x4*)(z + (size_t)m * ZS + ZC_GB + n);
            bfr* dst = mg + (size_t)m * 2048 + n;
            const u32x4 old = *(const u32x4*)dst;
            f32x4 a0 = {bflo(old[0]) + bflo(gb[0]) * v0[0], bfhi(old[0]) + bfhi(gb[0]) * v0[1], bflo(old[1]) + bflo(gb[1]) * v0[2], bfhi(old[1]) + bfhi(gb[1]) * v0[3]};
            f32x4 a1 = {bflo(old[2]) + bflo(gb[2]) * v1[0], bfhi(old[2]) + bfhi(gb[2]) * v1[1], bflo(old[3]) + bflo(gb[3]) * v1[2], bfhi(old[3]) + bfhi(gb[3]) * v1[3]};
            st_bf8(dst, a0, a1);
          });
        });
    } break;
    case 7: {
      gemm8_phase(smem, (const bfr*)(ws + OFF_MERGED), (const bfr*)(ws + OFF_WOUTT), 2048, 32 * 8, G, bid, tid,
        [&](const f32x4 (&acc)[2][2][4][2], int m0, int n0, int wr, int wc, int fr, int fq) {
          epi8_resid(acc, m0, n0, wr, wc, fr, fq, p.x, (float*)(ws + OFF_H), (bfr*)(ws + OFF_NX), (float*)(ws + OFF_ROWSS));
        });
    } break;
    case 8: case 12: break;
    case 9: {
      const int ng = (G > 128) ? 128 : G;
      if (bid < ng)
      for (int v = bid; v < 32 * 4; v += ng) {
        int mt, nt;
        map_tile32(v, mt, nt);
        const int m0 = mt * 256, n0 = nt * 128;
        f32x16 acc[1][4];
        acc_zero<1>(acc);
        PlainPtr af{(const bfr*)(ws + OFF_NX) + (size_t)m0 * 2048, 2048};
        PlainPtr bf{(const bfr*)(ws + OFF_WQT) + (size_t)n0 * 2048, 2048};
        gemm_main<1>(acc, af, bf, 32, smem, tid);
        bfr* qx = (bfr*)(ws + OFF_QX);
        const float* rss = (const float*)(ws + OFF_ROWSS);
        gemm_epi<1>(acc, m0, n0, tid, [&](int m, int n, float a, float b, float c, float d) {
          const float rs = rsqrtf(rss[m] * (1.f / 2048.f) + 1e-6f);
          st_bf4(qx + (size_t)m * 512 + n, a * rs, b * rs, c * rs, d * rs);
        });
      }
      {
        const int nt12 = tjob_tiles(12);
        for (int c = grab(ctr + 3, slot, tid); c * 8 < nt12; c = grab(ctr + 3, slot, tid))
          tr_run(p, 12, c * 8, 1, (c * 8 + 8 < nt12) ? c * 8 + 8 : nt12, (float*)smem, tid);
      }
    } break;
    case 10: {
      const int ng = (G > 128) ? 128 : G;
      if (bid < ng)
        for (int it = bid; it < 128; it += ng) attn_item<MODE_X>(p, it, smem, tid);
      {
        const int nt13 = tjob_tiles(13);
        for (int c = grab(ctr + 4, slot, tid); c * 8 < nt13; c = grab(ctr + 4, slot, tid))
          tr_run(p, 13, c * 8, 1, (c * 8 + 8 < nt13) ? c * 8 + 8 : nt13, (float*)smem, tid);
      }
    } break;
    case 11: {
      gemm8_phase(smem, (const bfr*)(ws + OFF_OX), (const bfr*)(ws + OFF_WOT), 512, 32 * 8, G, bid, tid,
        [&](const f32x4 (&acc)[2][2][4][2], int m0, int n0, int wr, int wc, int fr, int fq) {
          epi8_resid(acc, m0, n0, wr, wc, fr, fq, (const float*)(ws + OFF_H), (float*)(ws + OFF_H), (bfr*)(ws + OFF_NX), (float*)(ws + OFF_ROWSS) + NTOK);
        });
    } break;
    case 13: {
      bfr* hid = (bfr*)(ws + OFF_HID);
      const float* rss = (const float*)(ws + OFF_ROWSS) + NTOK;
      gemm8_phase(smem, (const bfr*)(ws + OFF_NX), (const bfr*)(ws + OFF_WUPT), 2048, 32 * 32, G, bid, tid,
        [&](const f32x4 (&acc)[2][2][4][2], int m0, int n0, int wr, int wc, int fr, int fq) {
          epi8_foreach(acc, m0, n0, wr, wc, fr, fq, [&](int m, int n, const f32x4& v0, const f32x4& v1) {
            const float rs = rsqrtf(rss[m] * (1.f / 2048.f) + 1e-6f);
            f32x4 a0, a1;
#pragma unroll
            for (int j = 0; j < 4; ++j) { const float t0 = fmaxf(v0[j], 0.f) * rs, t1 = fmaxf(v1[j], 0.f) * rs; a0[j] = t0 * t0; a1[j] = t1 * t1; }
            st_bf8(hid + (size_t)m * 8192 + n, a0, a1);
          });
        });
    } break;
    case 14: {
      const float* hbuf = (const float*)(ws + OFF_H);
      gemm8_phase(smem, (const bfr*)(ws + OFF_HID), (const bfr*)(ws + OFF_WDOWNT), 8192, 32 * 8, G, bid, tid,
        [&](const f32x4 (&acc)[2][2][4][2], int m0, int n0, int wr, int wc, int fr, int fq) {
          epi8_foreach(acc, m0, n0, wr, wc, fr, fq, [&](int m, int n, const f32x4& v0, const f32x4& v1) {
            const float* sp = hbuf + (size_t)m * 2048 + n;
            const f32x4 x0 = *(const f32x4*)sp, x1 = *(const f32x4*)(sp + 4);
            float* dp = p.out + (size_t)m * 2048 + n;
            *(f32x4*)dp = x0 + v0; *(f32x4*)(dp + 4) = x1 + v1;
          });
        });
    } break;
    case 15: {
      for (int it = bid; it < 1024; it += G) {
        const int row = it * 8 + (tid >> 6);
        rmsnorm_row(p.out + (size_t)row * 2048, p.final_norm_w, nullptr, p.out + (size_t)row * 2048, tid);
      }
    } break;
    default: break;
  }
}

#define XB_TMO      128
#define XB_XCNT(j)  (256  + 64 * (j))
#define XB_XSUB(j)  (1280 + 64 * (j))
#define XB_XGEN(j)  (2304 + 64 * (j))
#define XB_TOP      3328
#define XB_TOPGEN   3392
#define XB_SPIN_CAP (1u << 18)
DI unsigned xb_ld(unsigned* p) { return __hip_atomic_load(p, __ATOMIC_RELAXED, __HIP_MEMORY_SCOPE_AGENT); }
DI unsigned xb_add(unsigned* p, unsigned v) { return __hip_atomic_fetch_add(p, v, __ATOMIC_RELAXED, __HIP_MEMORY_SCOPE_AGENT); }
DI unsigned xb_xcc_id() { return (unsigned)__builtin_amdgcn_s_getreg((3 << 11) | 20) & 0xFu; }
#define XB_SPIN(cond, bar) do { unsigned _sp = 0; while (cond) { __builtin_amdgcn_s_sleep(1); \
    if ((++_sp & 255u) == 0u) { if (xb_ld(&(bar)[XB_TMO])) break; if (_sp > XB_SPIN_CAP) { atomicAdd(&(bar)[XB_TMO], 1u); break; } } } } while (0)
typedef __attribute__((address_space(3))) volatile unsigned lds_vu;
struct XcdBarrier { unsigned* bar; unsigned x; lds_vu* st; };
DI lds_vu* xb_words() { __shared__ unsigned xbw[4]; return (lds_vu*)xbw; }
DI XcdBarrier xcd_barrier_post(unsigned* bar, lds_vu* st) {
  XcdBarrier b; b.bar = bar; b.x = xb_xcc_id(); b.st = st;
  if (threadIdx.x == 0) (void)xb_add(&bar[XB_XCNT(b.x)], 1u);
  return b;
}
DI void xcd_barrier_complete(unsigned* bar, unsigned x, unsigned& nloc, unsigned& nx) {
  const unsigned Gt = gridDim.x * gridDim.y * gridDim.z;
  unsigned sum, cnt, mine, sp = 0u;
  for (;;) {
    sum = 0u; cnt = 0u; mine = 0u;
#pragma unroll
    for (unsigned j = 0; j < 16; ++j) { const unsigned c = xb_ld(&bar[XB_XCNT(j)]); sum += c; cnt += (c > 0u) ? 1u : 0u; mine = (j == x) ? c : mine; }
    if (sum == Gt) break;
    __builtin_amdgcn_s_sleep(1);
    if ((++sp & 255u) == 0u) { if (xb_ld(&bar[XB_TMO])) break; if (sp > XB_SPIN_CAP) { atomicAdd(&bar[XB_TMO], 1u); break; } }
  }
  nloc = mine > 0u ? mine : 1u; nx = cnt > 0u ? cnt : 1u;
}
DI void xcd_barrier(unsigned* bar_in, const int wave_s) {
  lds_vu* st_in = xb_words();
  XcdBarrier b; b.bar = bar_in; b.st = st_in; b.x = xb_xcc_id();
  asm volatile("s_waitcnt vmcnt(0)" ::: "memory");
  __syncthreads();
  if (wave_s == 0 && __builtin_amdgcn_mbcnt_hi(~0u, __builtin_amdgcn_mbcnt_lo(~0u, 0u)) == 0u) {
    unsigned* bar = b.bar;
    __builtin_amdgcn_s_waitcnt(0);
    unsigned nloc = b.st[0], nx = b.st[1];
    if (nloc == 0u) { xcd_barrier_complete(bar, b.x, nloc, nx); b.st[0] = nloc; b.st[1] = nx; }
    const unsigned old = xb_add(&bar[XB_XSUB(b.x)], 1u);
    const unsigned gen = old / nloc;
    if (old + 1u == (gen + 1u) * nloc) {
      __builtin_amdgcn_fence(__ATOMIC_RELEASE, "agent");
      asm volatile("s_waitcnt vmcnt(0)" ::: "memory");
      const unsigned og = xb_add(&bar[XB_TOP], 1u);
      const unsigned tg = og / nx;
      if (og + 1u == (tg + 1u) * nx) xb_add(&bar[XB_TOPGEN], 1u);
      else XB_SPIN(xb_ld(&bar[XB_TOPGEN]) == tg, bar);
      __builtin_amdgcn_fence(__ATOMIC_ACQUIRE, "agent");
      xb_add(&bar[XB_XGEN(b.x)], 1u);
      asm volatile("s_waitcnt vmcnt(0)" ::: "memory");
    } else {
      XB_SPIN(xb_ld(&bar[XB_XGEN(b.x)]) == gen, bar);
      __builtin_amdgcn_fence(__ATOMIC_ACQUIRE, "agent");
      asm volatile("s_waitcnt vmcnt(0)" ::: "memory");
    }
  }
  __syncthreads();
}

__global__ void __launch_bounds__(512, 2) mega(Params p) {
  extern __shared__ __attribute__((aligned(1024))) char smem[];
  __shared__ int slot;
  cg::grid_group grid = cg::this_grid();
  const int wave_s = __builtin_amdgcn_readfirstlane((int)(threadIdx.x >> 6));
  if (p.dbg == 12345) grid.sync();
  if (threadIdx.x < 4) xb_words()[threadIdx.x] = 0u;
  __syncthreads();
  (void)xcd_barrier_post((unsigned*)(p.ws + OFF_BAR), xb_words());
  for (int ph = p.ph_lo; ph < p.ph_hi; ++ph) {
    if (ph == 8 || ph == 12) continue;
    run_phase(p, ph, smem, &slot, wave_s, 0);
#ifdef PROBE_PH
    if (ph == PROBE_PH)
      for (int rep = 1; rep <= PROBE_N; ++rep) { xcd_barrier((unsigned*)(p.ws + OFF_BAR), wave_s); run_phase(p, ph, smem, &slot, wave_s, rep); }
#endif
    if (ph + 1 < p.ph_hi) {
      xcd_barrier((unsigned*)(p.ws + OFF_BAR), wave_s);
    }
  }
}

extern "C" void kernel_launch(void* const* d_in, const int* in_sizes, int n_in, void* d_out, int out_size, void* d_ws,
                              size_t ws_size, hipStream_t stream) {
  static int grid_blocks = 0;
  if (!grid_blocks) {
    int dev = 0, cus = 0, per_cu = 0;
    (void)hipGetDevice(&dev);
    (void)hipDeviceGetAttribute(&cus, hipDeviceAttributeMultiprocessorCount, dev);
    (void)hipFuncSetAttribute((const void*)mega, hipFuncAttributeMaxDynamicSharedMemorySize, SMEM_BYTES);
    (void)hipOccupancyMaxActiveBlocksPerMultiprocessor(&per_cu, mega, NTHR, SMEM_BYTES);
    if (per_cu < 1) per_cu = 1;
    if (per_cu > 1) per_cu = 1;
    grid_blocks = cus * per_cu;
    grid_blocks &= ~7;
    if (ws_size < WS_END || n_in != 24) { fprintf(stderr, "kernel_launch: ws %zu < %zu or n_in %d\n", ws_size, (size_t)WS_END, n_in); grid_blocks = -1; }
  }
  if (grid_blocks < 0) return;
  Params p{};
  const float** pp = (const float**)&p;
  for (int i = 0; i < 24; ++i) pp[i] = (const float*)d_in[i];
  p.out = (float*)d_out;
  p.ws = (char*)d_ws;
#if ONE_LAUNCH
  p.ph_lo = 0; p.ph_hi = NPHASE;
  (void)hipMemsetAsync((char*)d_ws + OFF_BAR, 0, BAR_BYTES, stream);
  void* args[] = {&p};
  hipError_t e = hipLaunchCooperativeKernel((void*)mega, dim3(grid_blocks), dim3(NTHR), args, SMEM_BYTES, stream);
  if (e != hipSuccess) fprintf(stderr, "cooperative launch failed: %s (grid %d)\n", hipGetErrorString(e), grid_blocks);
#else
  for (int ph = 0; ph < NPHASE; ++ph) {
    p.ph_lo = ph; p.ph_hi = ph + 1;
    hipLaunchKernelGGL(mega, dim3(grid_blocks), dim3(NTHR), SMEM_BYTES, stream, p);
  }
#endif
}
```

```cpp
#include <hip/hip_runtime.h>
#include <hip/hip_cooperative_groups.h>
#include <cstdio>
namespace cg = cooperative_groups;

#ifndef ONE_LAUNCH
#define ONE_LAUNCH 1
#endif

#define DI __device__ __forceinline__
typedef unsigned short bfr;
using bf16x8 = __attribute__((ext_vector_type(8))) short;
using s16x4 = __attribute__((ext_vector_type(4))) short;
using f32x16 = __attribute__((ext_vector_type(16))) float;
using u32x4 = __attribute__((ext_vector_type(4))) unsigned;
#define MFMA(a, b, c) __builtin_amdgcn_mfma_f32_32x32x16_bf16((a), (b), (c), 0, 0, 0)

constexpr int DM = 2048, SEQ = 2048, NTOK = 8192;
constexpr int ZS = 15488;
constexpr int ZC_Q = 0, ZC_KC = 2048, ZC_VC = 2560, ZC_KS = 3072, ZC_VS = 3584, ZC_KW = 4096, ZC_VW = 4608,
              ZC_QR = 5120, ZC_KR = 6144, ZC_VR = 7168, ZC_GR = 9216, ZC_GA = 11264, ZC_GB = 13312, ZC_GN = 15360;
constexpr int NPHASE = 16;

constexpr int ZSP = 15616;
constexpr size_t SZ_WINT = (size_t)ZSP * 2048 * 2;
constexpr size_t SZ_ACT = (size_t)NTOK * 2048 * 2;
constexpr size_t OFF_WINT = 0;
constexpr size_t OFF_N = OFF_WINT + SZ_WINT;
constexpr size_t OFF_MERGED = OFF_WINT;
constexpr size_t OFF_RKV = OFF_WINT;
static_assert((size_t)224 * 128 * 256 * 4 <= SZ_WINT, "retention KV buffer must fit the dead w_in^T region");
constexpr size_t OFF_ORET = OFF_N;
constexpr size_t OFF_WUPT = 0;
constexpr size_t OFF_WDOWNT = SZ_ACT;
constexpr size_t OFF_Z = OFF_N + SZ_ACT;
constexpr size_t SZ_Z = (size_t)NTOK * ZS * 2;
constexpr size_t OFF_HID = OFF_Z;
constexpr size_t OFF_H = OFF_Z + (size_t)NTOK * 8192 * 2;
constexpr size_t OFF_NX = OFF_H + (size_t)NTOK * 2048 * 4;
constexpr size_t OFF_QX = OFF_NX + SZ_ACT;
constexpr size_t OFF_OX = OFF_QX + (size_t)NTOK * 512 * 2;
static_assert(OFF_OX + (size_t)NTOK * 512 * 2 <= OFF_Z + SZ_Z, "alias overflow");
constexpr size_t OFF_ZC = OFF_Z + SZ_Z;
constexpr size_t OFF_MN = OFF_ZC + (size_t)NTOK * 2048 * 2;
constexpr size_t OFF_W1T = OFF_MN + (size_t)1024 * 2048 * 2;
constexpr size_t OFF_W2T = OFF_W1T + (size_t)2 * 1024 * 4096 * 2;
constexpr size_t OFF_WAT = OFF_W2T + (size_t)2 * 128 * 1024 * 2;
constexpr size_t OFF_WBT = OFF_WAT + (size_t)2048 * 2048 * 2;
constexpr size_t OFF_WOUTT = OFF_WBT + (size_t)2048 * 2048 * 2;
constexpr size_t OFF_WQT = OFF_WOUTT + (size_t)2048 * 2048 * 2;
constexpr size_t OFF_WKT = OFF_WQT + (size_t)512 * 2048 * 2;
constexpr size_t OFF_WVT = OFF_WKT + (size_t)512 * 2048 * 2;
constexpr size_t OFF_WOT = OFF_WVT + (size_t)512 * 2048 * 2;
constexpr size_t OFF_ROPE = OFF_WOT + (size_t)512 * 2048 * 2;
constexpr size_t OFF_HIDC = OFF_ROPE + (size_t)2048 * 64 * 8;
constexpr size_t OFF_KCVC = OFF_HIDC + (size_t)2 * 2048 * 1024 * 2;
constexpr size_t OFF_SELM = OFF_KCVC + (size_t)2 * 2048 * 128 * 2;
constexpr size_t OFF_ONSA = OFF_SELM + (size_t)16 * 2048 * 4;
constexpr size_t OFF_KX = OFF_ONSA + SZ_ACT;
constexpr size_t OFF_VX = OFF_KX + (size_t)1024 * 512 * 2;
constexpr size_t OFF_RSTAT = OFF_VX + (size_t)1024 * 512 * 2;
constexpr size_t OFF_CTR = OFF_RSTAT + (size_t)NTOK * 8 * 2 * 2 * 4;
constexpr size_t OFF_BAR = OFF_CTR + 256;
constexpr size_t BAR_BYTES = 16384;
constexpr size_t OFF_ROWSS = OFF_BAR + BAR_BYTES;
constexpr size_t WS_END = OFF_ROWSS + (size_t)2 * NTOK * 4;

struct Params {
  const float *x, *mem, *attn_norm_w, *w_in, *pe_k, *w1k, *w2k, *pe_v, *w1v, *w2v, *w_a, *gn_w, *w_b, *w_out, *x_norm_w,
      *mem_norm_w, *wq, *wk, *wv, *wo, *mlp_norm_w, *w_up, *w_down, *final_norm_w;
  float* out;
  char* ws;
  int ph_lo, ph_hi;
  int dbg, pad;
};

constexpr int NTHR = 512;
constexpr int SMEM_BYTES = 139264;
__device__ const float ROPE_INV[64] = {1.0f, 0.865964353f, 0.749894261f, 0.649381638f, 0.562341332f, 0.486967534f, 0.421696514f, 0.365174115f, 0.316227764f, 0.273841977f, 0.237137377f, 0.2053525f, 0.177827939f, 0.153992653f, 0.133352131f, 0.115478203f, 0.100000001f, 0.0865964293f, 0.0749894157f, 0.0649381652f, 0.0562341325f, 0.0486967526f, 0.0421696529f, 0.0365174115f, 0.0316227749f, 0.0273841973f, 0.0237137377f, 0.0205352511f, 0.0177827943f, 0.0153992651f, 0.0133352149f, 0.0115478206f, 0.00999999978f, 0.00865964312f, 0.00749894185f, 0.00649381615f, 0.00562341325f, 0.00486967526f, 0.00421696482f, 0.00365174119f, 0.00316227763f, 0.00273841969f, 0.00237137359f, 0.00205352483f, 0.00177827943f, 0.00153992651f, 0.00133352145f, 0.0011547819f, 0.00100000005f, 0.000865964335f, 0.000749894243f, 0.000649381662f, 0.000562341302f, 0.000486967532f, 0.000421696517f, 0.000365174143f, 0.000316227757f, 0.000273841957f, 0.00023713737f, 0.00020535251f, 0.00017782794f, 0.000153992645f, 0.00013335215f, 0.0001154782f};

DI unsigned pack2(float a, float b) {
  typedef float f2 __attribute__((ext_vector_type(2)));
  typedef __bf16 b2 __attribute__((ext_vector_type(2)));
  f2 v = {a, b};
  b2 r = __builtin_convertvector(v, b2);
  return __builtin_bit_cast(unsigned, r);
}
DI float bflo(unsigned u) { return __uint_as_float(u << 16); }
DI float bfhi(unsigned u) { return __uint_as_float(u & 0xffff0000u); }
DI void st_bf4(bfr* p, float a, float b, float c, float d) {
  uint2 v; v.x = pack2(a, b); v.y = pack2(c, d);
  *(uint2*)p = v;
}
DI float wave_sum(float v) {
#pragma unroll
  for (int o = 32; o > 0; o >>= 1) v += __shfl_xor(v, o);
  return v;
}
DI float sigmoidf_(float x) { return __builtin_amdgcn_rcpf(1.f + __expf(-x)); }
DI int crow(int i, int h) { return (i & 3) + 8 * (i >> 2) + 4 * h; }
DI bf16x8 pack8(const f32x16& x, int s) {
  unsigned a = pack2(x[8 * s], x[8 * s + 1]), b = pack2(x[8 * s + 2], x[8 * s + 3]), c = pack2(x[8 * s + 4], x[8 * s + 5]),
           d = pack2(x[8 * s + 6], x[8 * s + 7]);
  typedef unsigned u4 __attribute__((ext_vector_type(4)));
  u4 v = {a, b, c, d};
  return __builtin_bit_cast(bf16x8, v);
}
DI s16x4 tr_read(const bfr* p) {
  return __builtin_amdgcn_ds_read_tr16_b64_v4i16((__attribute__((address_space(3))) s16x4*)(p));
}

struct TJob { const float* src; bfr* dst; int K, N, ntn, perm; const float* kscale; };
DI TJob get_tjob(const Params& p, int j) {
  TJob t;
  char* ws = p.ws;
  switch (j) {
    case 0: t = {p.w_in, (bfr*)(ws + OFF_WINT), 2048, 15408, 122, 1, nullptr}; break;
    case 1: t = {p.wk, (bfr*)(ws + OFF_WKT), 2048, 512, 4, 0, nullptr}; break;
    case 2: t = {p.wv, (bfr*)(ws + OFF_WVT), 2048, 512, 4, 0, nullptr}; break;
    case 3: t = {p.w1k, (bfr*)(ws + OFF_W1T), 4096, 1024, 8, 0, nullptr}; break;
    case 4: t = {p.w1v, (bfr*)(ws + OFF_W1T) + (size_t)1024 * 4096, 4096, 1024, 8, 0, nullptr}; break;
    case 5: t = {p.w2k, (bfr*)(ws + OFF_W2T), 1024, 128, 1, 0, nullptr}; break;
    case 6: t = {p.w2v, (bfr*)(ws + OFF_W2T) + (size_t)128 * 1024, 1024, 128, 1, 0, nullptr}; break;
    case 7: t = {p.w_a, (bfr*)(ws + OFF_WAT), 2048, 2048, 16, 0, nullptr}; break;
    case 8: t = {p.w_b, (bfr*)(ws + OFF_WBT), 2048, 2048, 16, 0, nullptr}; break;
    case 9: t = {p.w_out, (bfr*)(ws + OFF_WOUTT), 2048, 2048, 16, 0, nullptr}; break;
    case 10: t = {p.wq, (bfr*)(ws + OFF_WQT), 2048, 512, 4, 0, p.x_norm_w}; break;
    case 11: t = {p.wo, (bfr*)(ws + OFF_WOT), 512, 2048, 16, 0, nullptr}; break;
    case 12: t = {p.w_up, (bfr*)(ws + OFF_WUPT), 2048, 8192, 64, 0, p.mlp_norm_w}; break;
    default: t = {p.w_down, (bfr*)(ws + OFF_WDOWNT), 8192, 2048, 16, 0, nullptr}; break;
  }
  return t;
}
DI int tjob_tiles(int j) {
  switch (j) {
    case 0: return 122 * 16;
    case 1: case 2: return 4 * 16;
    case 3: case 4: return 8 * 32;
    case 5: case 6: return 1 * 8;
    case 7: case 8: case 9: return 16 * 16;
    case 10: return 4 * 16;
    case 11: return 16 * 4;
    case 12: return 64 * 16;
    default: return 16 * 64;
  }
}
struct TrRegs { float4 v[8]; };
DI void tr_load(const TJob& t, int tile, TrRegs& rg, const int tid) {
  const int nkt = t.K >> 7;
  const int kt = tile % nkt, nt = tile / nkt;
  const int k0 = kt * 128, d0 = nt * 128;
  int scol0 = d0, nvalid = 128;
  if (t.perm) {
    if (d0 < 5120) scol0 = d0;
    else if (d0 < 15360) scol0 = d0 + 48;
    else { scol0 = d0 - 15360 + 5120; nvalid = (d0 == 15360) ? 48 : 0; }
  }
#pragma unroll
  for (int i = 0; i < 8; ++i) {
    const int row = i * 16 + (tid >> 5), col = (tid & 31) * 4;
    rg.v[i] = make_float4(0.f, 0.f, 0.f, 0.f);
    if (col < nvalid) rg.v[i] = *(const float4*)(t.src + (size_t)(k0 + row) * t.N + scol0 + col);
    if (t.kscale) { const float sc = t.kscale[k0 + row]; rg.v[i].x *= sc; rg.v[i].y *= sc; rg.v[i].z *= sc; rg.v[i].w *= sc; }
  }
}
DI void tr_to_lds(const TrRegs& rg, float* sm, const int tid) {
#pragma unroll
  for (int i = 0; i < 8; ++i) {
    const int row = i * 16 + (tid >> 5), col = (tid & 31) * 4;
    float* d = sm + row * 129 + col;
    d[0] = rg.v[i].x; d[1] = rg.v[i].y; d[2] = rg.v[i].z; d[3] = rg.v[i].w;
  }
}
DI void tr_store(const TJob& t, int tile, const float* sm, const int tid) {
  const int nkt = t.K >> 7;
  const int kt = tile % nkt, nt = tile / nkt;
  const int k0 = kt * 128, d0 = nt * 128;
  const int n = tid >> 2, kq = (tid & 3) * 8;
  bfr* drow = t.dst + (size_t)(d0 + n) * t.K + k0 + kq;
#pragma unroll
  for (int q = 0; q < 4; ++q) {
    const int kb = kq + 32 * q;
    const unsigned o0 = pack2(sm[(kb + 0) * 129 + n], sm[(kb + 1) * 129 + n]);
    const unsigned o1 = pack2(sm[(kb + 2) * 129 + n], sm[(kb + 3) * 129 + n]);
    const unsigned o2 = pack2(sm[(kb + 4) * 129 + n], sm[(kb + 5) * 129 + n]);
    const unsigned o3 = pack2(sm[(kb + 6) * 129 + n], sm[(kb + 7) * 129 + n]);
    *(uint4*)(drow + 32 * q) = make_uint4(o0, o1, o2, o3);
  }
}
DI void tr_decode(int it, int j_lo, int& j, int& rem) {
  j = j_lo; rem = it;
  while (rem >= tjob_tiles(j)) { rem -= tjob_tiles(j); ++j; }
}
DI void tr_run(const Params& p, int j_lo, int it0, int stride, int n_tiles, float* sm, const int tid) {
  if (it0 >= n_tiles) return;
  TrRegs rg;
  int j, rem;
  tr_decode(it0, j_lo, j, rem);
  TJob t = get_tjob(p, j);
  tr_load(t, rem, rg, tid);
  for (int it = it0; it < n_tiles; it += stride) {
    __syncthreads();
    tr_to_lds(rg, sm, tid);
    __syncthreads();
    const TJob tc = t;
    const int remc = rem;
    const int nx = it + stride;
    if (nx < n_tiles) {
      tr_decode(nx, j_lo, j, rem);
      t = get_tjob(p, j);
      tr_load(t, rem, rg, tid);
    }
    tr_store(tc, remc, sm, tid);
  }
  __syncthreads();
}

DI void rmsnorm_row(const float* xrow, const float* w, bfr* obf, float* of32, const int tid) {
  const int lane = tid & 63;
  float4 v[8];
  float ss = 0.f;
#pragma unroll
  for (int i = 0; i < 8; ++i) {
    v[i] = ((const float4*)xrow)[lane + 64 * i];
    ss += v[i].x * v[i].x + v[i].y * v[i].y + v[i].z * v[i].z + v[i].w * v[i].w;
  }
  ss = wave_sum(ss);
  const float rs = rsqrtf(ss * (1.f / 2048.f) + 1e-6f);
#pragma unroll
  for (int i = 0; i < 8; ++i) {
    const float4 ww = ((const float4*)w)[lane + 64 * i];
    const float a = v[i].x * rs * ww.x, b = v[i].y * rs * ww.y, c = v[i].z * rs * ww.z, d = v[i].w * rs * ww.w;
    if (obf) st_bf4(obf + (lane + 64 * i) * 4, a, b, c, d);
    else ((float4*)of32)[lane + 64 * i] = make_float4(a, b, c, d);
  }
}

struct PlainPtr {
  const bfr* base; int ld;
  DI int rowoff(int row) const { return row * ld; }
  DI int koff(int k0) const { return k0; }
};
#define WAIT_V(n) asm volatile("s_waitcnt vmcnt(%0)" ::"n"(n) : "memory")
#define WAIT_L(n) asm volatile("s_waitcnt lgkmcnt(%0)" ::"n"(n) : "memory")
#define RAW_BARRIER() do { WAIT_L(0); __builtin_amdgcn_s_barrier(); } while (0)
typedef __attribute__((address_space(3))) unsigned lds_u32;
constexpr int STAGE_B = 65536;
template <int NI, class AF, class BF>
DI void gemm_main(f32x16 (&acc)[NI][4], const AF& af, const BF& bf, int nk, char* smem, const int tid) {
  const int lane = tid & 63, r = lane & 31, h = lane >> 5;
  const int w = __builtin_amdgcn_readfirstlane(tid >> 6);
  const int wm = w & 1, wn = w >> 1;
  int ao[4], bo[2 * NI];
  {
    const int rl = lane >> 3, kc = (lane & 7) ^ (((w & 1) * 4 + (lane >> 4)) & 7);
#pragma unroll
    for (int i = 0; i < 4; ++i) ao[i] = af.rowoff((w + 8 * i) * 8 + rl) + 8 * kc;
#pragma unroll
    for (int i = 0; i < 2 * NI; ++i) bo[i] = bf.rowoff((w + 8 * i) * 8 + rl) + 8 * kc;
  }
  auto stage = [&](int buf, int kt) {
    const int ka = af.koff(kt * 64), kb = bf.koff(kt * 64);
    char* sbase = smem + buf * STAGE_B + w * 1024;
#pragma unroll
    for (int i = 0; i < 4; ++i)
      __builtin_amdgcn_global_load_lds((const unsigned*)(af.base + (ao[i] + ka)), (lds_u32*)(sbase + i * 8192), 16, 0, 0);
#pragma unroll
    for (int i = 0; i < 2 * NI; ++i)
      __builtin_amdgcn_global_load_lds((const unsigned*)(bf.base + (bo[i] + kb)), (lds_u32*)(sbase + 32768 + i * 8192), 16, 0, 0);
  };
  const int xr = (r >> 1) & 7;
  const int arow = (wm * 128 + r) * 128, brow = 32768 + (wn * 32 * NI + r) * 128;
  WAIT_V(0);
  __syncthreads();
  stage(0, 0);
  WAIT_V(0);
  RAW_BARRIER();
#pragma unroll 1
  for (int kt = 0; kt < nk; ++kt) {
    if (kt + 1 < nk) stage((kt + 1) & 1, kt + 1);
    const char* sb = smem + (kt & 1) * STAGE_B;
#pragma unroll
    for (int ks = 0; ks < 4; ++ks) {
      const int off = ((2 * ks + h) ^ xr) * 16;
      bf16x8 wf[NI], xf[4];
#pragma unroll
      for (int i = 0; i < NI; ++i) wf[i] = *(const bf16x8*)(sb + brow + i * 4096 + off);
#pragma unroll
      for (int i = 0; i < 4; ++i) xf[i] = *(const bf16x8*)(sb + arow + i * 4096 + off);
#pragma unroll
      for (int mi = 0; mi < 4; ++mi)
#pragma unroll
        for (int ni = 0; ni < NI; ++ni) acc[ni][mi] = MFMA(wf[ni], xf[mi], acc[ni][mi]);
    }
    WAIT_V(0);
    RAW_BARRIER();
  }
}
template <int NI>
DI void acc_zero(f32x16 (&acc)[NI][4]) {
#pragma unroll
  for (int a = 0; a < NI; ++a)
#pragma unroll
    for (int b = 0; b < 4; ++b)
#pragma unroll
      for (int i = 0; i < 16; ++i) acc[a][b][i] = 0.f;
}
template <int NI, class EPI>
DI void gemm_epi(const f32x16 (&acc)[NI][4], int m0, int n0, const int tid_in, const EPI& epi) {
  int tid = tid_in;
  asm volatile("" : "+v"(tid));
  const int lane = tid & 63, w = tid >> 6, r = lane & 31, h = lane >> 5;
  const int wm = w & 1, wn = w >> 1;
#pragma unroll
  for (int mi = 0; mi < 4; ++mi)
#pragma unroll
    for (int ni = 0; ni < NI; ++ni)
#pragma unroll
      for (int g = 0; g < 4; ++g) {
        const int n = n0 + wn * 32 * NI + ni * 32 + 8 * g + 4 * h;
        const int m = m0 + wm * 128 + mi * 32 + r;
        epi(m, n, acc[ni][mi][4 * g], acc[ni][mi][4 * g + 1], acc[ni][mi][4 * g + 2], acc[ni][mi][4 * g + 3]);
      }
}
DI void gemm_epi_resid(const f32x16 (&acc)[2][4], int m0, int n0, const int tid_in, const float* hsrc, float* hdst, bfr* hb, float* rowss) {
  int tid = tid_in;
  asm volatile("" : "+v"(tid));
  const int lane = tid & 63, w = tid >> 6, r = lane & 31, h = lane >> 5;
  const int wm = w & 1, wn = w >> 1;
#pragma unroll
  for (int mi = 0; mi < 4; ++mi) {
    const int m = m0 + wm * 128 + mi * 32 + r;
    float ss = 0.f;
#pragma unroll
    for (int ni = 0; ni < 2; ++ni)
#pragma unroll
      for (int g = 0; g < 4; ++g) {
        const int n = n0 + wn * 64 + ni * 32 + 8 * g + 4 * h;
        const float4 xv = *(const float4*)(hsrc + (size_t)m * 2048 + n);
        const float a = xv.x + acc[ni][mi][4 * g], b = xv.y + acc[ni][mi][4 * g + 1], c = xv.z + acc[ni][mi][4 * g + 2], d = xv.w + acc[ni][mi][4 * g + 3];
        *(float4*)(hdst + (size_t)m * 2048 + n) = make_float4(a, b, c, d);
        st_bf4(hb + (size_t)m * 2048 + n, a, b, c, d);
        ss += a * a + b * b + c * c + d * d;
      }
    ss += __shfl_xor(ss, 32);
    if (h == 0) atomicAdd(rowss + m, ss);
  }
}
DI void map_tile32(int v, int& mt, int& nt) {
  const int xcd = v & 7, j = v >> 3;
  nt = j >> 2;
  mt = xcd * 4 + (j & 3);
}


using f32x4 = __attribute__((ext_vector_type(4))) float;
typedef __attribute__((address_space(3))) unsigned char lds_u8;
constexpr int HTB = 128 * 64 * 2;
DI int lds_byte8(int r, int c) { const int st = (r >> 4) * 2 + (c >> 5), rr = r & 15, cc = c & 31, ob = rr * 64 + cc * 2; return st * 1024 + (ob ^ (((ob >> 9) & 1) << 5)); }
DI void stage_rc8(int b, int& R, int& C) { const int st = b / 1024, sb = b % 1024, swz = sb ^ (((sb >> 9) & 1) << 5); R = (st >> 1) * 16 + swz / 64; C = (st & 1) * 32 + (swz % 64) / 2; }
DI int perm32(int rho) { const int n = rho >> 4, i = rho & 15; return 8 * (i >> 2) + 4 * n + (i & 3); }
DI bool unit_next(int i, int G, int bid, int nunits, int& pm, int& pn) {
  const int v = bid + i * G;
  if (v >= nunits) return false;
  const int xcd = v & 7, j = v >> 3;
  pn = j >> 2;
  pm = xcd * 4 + (j & 3);
  return true;
}
template <class Epi>
DI void gemm8_phase(char* smem, const bfr* A, const bfr* Bt, const int K, const int nunits, const int G, const int bid, const int tid, const Epi& E) {
  lds_u8* lds = (lds_u8*)smem;
  const int wid = __builtin_amdgcn_readfirstlane(tid >> 6), lane = tid & 63, wr = wid >> 2, wc = wid & 3, fr = lane & 15, fq = lane >> 4;
  const int nt = K / 64;
  unsigned voffA[2], voffB[2];
#pragma unroll
  for (int i = 0; i < 2; ++i) {
    int R, C;
    stage_rc8(tid * 16 + i * 8192, R, C);
    const int Rb = (R & ~31) + perm32(R & 31);
    voffA[i] = (unsigned)(R * K + C) * 2u;
    voffB[i] = (unsigned)(Rb * K + C) * 2u;
  }
  const size_t kstep = 128;
  const size_t hstep = (size_t)128 * K * 2;
  const size_t tstep = 2 * hstep;
  const unsigned ldsw = (unsigned)wid * 1024u;
  const int aoff = lds_byte8(wr * 64 + fr, fq * 8), boff = lds_byte8(wc * 32 + fr, fq * 8);
#define PG8_SA(b, h) (((b) * 2 + (h)) * HTB)
#define PG8_SB(b, h) ((4 + (b) * 2 + (h)) * HTB)
#define PG8_STAGE(bufoff, gbase, voff) do { _Pragma("unroll") for (int _i = 0; _i < 2; ++_i) \
    __builtin_amdgcn_global_load_lds((const unsigned*)((const char*)(gbase) + (voff)[_i]), (lds_u32*)(lds + (bufoff) + ldsw + _i * 8192), 16, 0, 0); } while (0)
#define PG8_LDA(dst, b, h) do { _Pragma("unroll") for (int m = 0; m < 4; ++m) _Pragma("unroll") for (int k = 0; k < 2; ++k) dst[m][k] = *(const __attribute__((address_space(3))) bf16x8*)(lds + PG8_SA(b, h) + aoff + m * 2048 + k * 1024); } while (0)
#define PG8_LDB(dst, b, h) do { _Pragma("unroll") for (int n = 0; n < 2; ++n) _Pragma("unroll") for (int k = 0; k < 2; ++k) dst[n][k] = *(const __attribute__((address_space(3))) bf16x8*)(lds + PG8_SB(b, h) + boff + n * 2048 + k * 1024); } while (0)
#define PG8_MMA(ai, bj, At, Bt_) do { __builtin_amdgcn_s_setprio(1); _Pragma("unroll") for (int m = 0; m < 4; ++m) _Pragma("unroll") for (int n = 0; n < 2; ++n) _Pragma("unroll") for (int k = 0; k < 2; ++k) \
    acc[ai][bj][m][n] = __builtin_amdgcn_mfma_f32_16x16x32_bf16(Bt_[n][k], At[m][k], acc[ai][bj][m][n], 0, 0, 0); __builtin_amdgcn_s_setprio(0); } while (0)
#define PG8_BAR __builtin_amdgcn_s_barrier()
#define PG8_SCHED __builtin_amdgcn_sched_barrier(0)
  int cpm, cpn, npm = 0, npn = 0, ui = 0;
  if (!unit_next(0, G, bid, nunits, cpm, cpn)) return;
  WAIT_V(0);
  __syncthreads();
  f32x4 acc[2][2][4][2];
#pragma unroll
  for (int a = 0; a < 2; ++a)
#pragma unroll
    for (int b = 0; b < 2; ++b)
#pragma unroll
      for (int m = 0; m < 4; ++m)
#pragma unroll
        for (int n = 0; n < 2; ++n) acc[a][b][m][n] = (f32x4){0.f, 0.f, 0.f, 0.f};
  bf16x8 At[4][2], B0[2][2], B1[2][2];
  const char* cA = (const char*)A + (size_t)cpm * tstep;
  const char* cB = (const char*)Bt + (size_t)cpn * tstep;
  PG8_STAGE(PG8_SB(0, 0), cB, voffB); PG8_STAGE(PG8_SA(0, 0), cA, voffA); PG8_STAGE(PG8_SB(0, 1), cB + hstep, voffB); PG8_STAGE(PG8_SA(0, 1), cA + hstep, voffA);
  if (wr == 1) PG8_BAR;
  WAIT_V(4); PG8_BAR;
  PG8_STAGE(PG8_SB(1, 0), cB + kstep, voffB); PG8_STAGE(PG8_SA(1, 0), cA + kstep, voffA); PG8_STAGE(PG8_SB(1, 1), cB + hstep + kstep, voffB);
  WAIT_V(6); PG8_BAR;
  for (;;) {
    const bool has_next = unit_next(ui + 1, G, bid, nunits, npm, npn);
    const char* nA = has_next ? (const char*)A + (size_t)npm * tstep : cA;
    const char* nB = has_next ? (const char*)Bt + (size_t)npn * tstep : cB;
#pragma unroll 1
    for (int t = 0; t < nt; t += 2) {
      const bool last = (t == nt - 2);
      const char* a1 = cA + (size_t)(t + 1) * kstep;
      const char* a2 = last ? nA : cA + (size_t)(t + 2) * kstep;
      const char* b2 = last ? nB : cB + (size_t)(t + 2) * kstep;
      const char* a3 = a2 + kstep;
      const char* b3 = b2 + kstep;
      PG8_LDB(B0, 0, 0); PG8_SCHED; PG8_LDA(At, 0, 0); PG8_STAGE(PG8_SA(1, 1), a1 + hstep, voffA);
      WAIT_L(8); PG8_BAR; WAIT_L(0); PG8_MMA(0, 0, At, B0); PG8_BAR; PG8_SCHED;
      PG8_LDB(B1, 0, 1); PG8_STAGE(PG8_SB(0, 0), b2, voffB);
      PG8_BAR; WAIT_L(0); PG8_MMA(0, 1, At, B1); PG8_BAR;
      PG8_LDA(At, 0, 1); PG8_STAGE(PG8_SA(0, 0), a2, voffA);
      PG8_BAR; WAIT_L(0); PG8_MMA(1, 0, At, B0); PG8_BAR; PG8_SCHED;
      PG8_STAGE(PG8_SB(0, 1), b2 + hstep, voffB);
      WAIT_V(6); PG8_BAR; PG8_MMA(1, 1, At, B1); PG8_BAR;
      PG8_LDB(B0, 1, 0); PG8_SCHED; PG8_LDA(At, 1, 0); PG8_STAGE(PG8_SA(0, 1), a2 + hstep, voffA);
      WAIT_L(8); PG8_BAR; WAIT_L(0); PG8_MMA(0, 0, At, B0); PG8_BAR; PG8_SCHED;
      PG8_LDB(B1, 1, 1); PG8_STAGE(PG8_SB(1, 0), b3, voffB);
      PG8_BAR; WAIT_L(0); PG8_MMA(0, 1, At, B1); PG8_BAR;
      PG8_LDA(At, 1, 1); PG8_STAGE(PG8_SA(1, 0), a3, voffA);
      PG8_BAR; WAIT_L(0); PG8_MMA(1, 0, At, B0); PG8_BAR; PG8_SCHED;
      PG8_STAGE(PG8_SB(1, 1), b3 + hstep, voffB);
      WAIT_V(6); PG8_BAR; PG8_MMA(1, 1, At, B1); PG8_BAR;
    }
    E(acc, cpm * 256, cpn * 256, wr, wc, fr, fq);
    if (!has_next) break;
#pragma unroll
    for (int a = 0; a < 2; ++a)
#pragma unroll
      for (int b = 0; b < 2; ++b)
#pragma unroll
        for (int m = 0; m < 4; ++m)
#pragma unroll
          for (int n = 0; n < 2; ++n) acc[a][b][m][n] = (f32x4){0.f, 0.f, 0.f, 0.f};
    cpm = npm; cpn = npn; cA = nA; cB = nB; ++ui;
  }
  WAIT_V(0);
  if (wr == 0) PG8_BAR;
  PG8_BAR;
#undef PG8_SA
#undef PG8_SB
#undef PG8_STAGE
#undef PG8_LDA
#undef PG8_LDB
#undef PG8_MMA
#undef PG8_BAR
#undef PG8_SCHED
}
template <class F>
DI void epi8_foreach(const f32x4 (&acc)[2][2][4][2], int m0, int n0, int wr, int wc, int fr, int fq, const F& f) {
#pragma unroll
  for (int ai = 0; ai < 2; ++ai)
#pragma unroll
    for (int m = 0; m < 4; ++m) {
      const int row = m0 + ai * 128 + wr * 64 + m * 16 + fr;
#pragma unroll
      for (int bj = 0; bj < 2; ++bj) f(row, n0 + bj * 128 + wc * 32 + 8 * fq, acc[ai][bj][m][0], acc[ai][bj][m][1]);
    }
}
DI void st_bf8(bfr* p, const f32x4& v0, const f32x4& v1) {
  u32x4 w;
  w[0] = pack2(v0[0], v0[1]); w[1] = pack2(v0[2], v0[3]); w[2] = pack2(v1[0], v1[1]); w[3] = pack2(v1[2], v1[3]);
  *(u32x4*)p = w;
}

DI void epi8_resid(const f32x4 (&acc)[2][2][4][2], int m0, int n0, int wr, int wc, int fr, int fq, const float* hsrc, float* hdst, bfr* hb, float* rowss) {
#pragma unroll
  for (int ai = 0; ai < 2; ++ai)
#pragma unroll
    for (int m = 0; m < 4; ++m) {
      const int row = m0 + ai * 128 + wr * 64 + m * 16 + fr;
      float ss = 0.f;
#pragma unroll
      for (int bj = 0; bj < 2; ++bj) {
        const int n = n0 + bj * 128 + wc * 32 + 8 * fq;
        const float* sp = hsrc + (size_t)row * 2048 + n;
        const f32x4 x0 = *(const f32x4*)sp, x1 = *(const f32x4*)(sp + 4);
        const f32x4 y0 = x0 + acc[ai][bj][m][0], y1 = x1 + acc[ai][bj][m][1];
        float* dp = hdst + (size_t)row * 2048 + n;
        *(f32x4*)dp = y0; *(f32x4*)(dp + 4) = y1;
        st_bf8(hb + (size_t)row * 2048 + n, y0, y1);
        ss += y0[0] * y0[0] + y0[1] * y0[1] + y0[2] * y0[2] + y0[3] * y0[3] + y1[0] * y1[0] + y1[1] * y1[1] + y1[2] * y1[2] + y1[3] * y1[3];
      }
      ss += __shfl_xor(ss, 16);
      ss += __shfl_xor(ss, 32);
      if (fq == 0) atomicAdd(rowss + row, ss);
    }
}
enum { MODE_WIN = 0, MODE_SEL = 1, MODE_X = 2, MODE_RET = 3 };
constexpr int KP = 136;

template <int MODE>
DI void attn_item(const Params& p, int item, char* smem, const int tid) {
  constexpr int VP = 136;
  bfr* Ks = (bfr*)smem;
  bfr* Vs = Ks + 64 * KP;
  const int w = tid >> 6, lane = tid & 63, r = lane & 31, h = lane >> 5;
  bfr* Qw = Vs + 64 * VP + w * 32 * KP;
  char* ws = p.ws;
  const bfr* z = (const bfr*)(ws + OFF_Z);

  int b, t0, tq0, jlo, jhi, head = 0, grp = 0, vh = 0;
  const bfr *qbase, *kbase, *vbase;
  int ldq, ldk;
  unsigned selm = 0, umask = 0xffffffffu;
  if (MODE == MODE_WIN) {
    const int tb = item >> 4, bg = item & 15;
    b = bg >> 2; grp = bg & 3; t0 = tb * 64; tq0 = t0 + 32 * (w >> 2); head = grp * 4 + (w & 3);
    qbase = z + (size_t)(b * SEQ + tq0) * ZS + ZC_Q + head * 128; ldq = ZS;
    kbase = z + (size_t)(b * SEQ) * ZS + ZC_KW + grp * 128;
    vbase = z + (size_t)(b * SEQ) * ZS + ZC_VW + grp * 128;
    ldk = ZS;
    jlo = (t0 - 511 > 0 ? t0 - 511 : 0) >> 6;
    jhi = tb;
  } else if (MODE == MODE_SEL) {
    const int tb = 31 - (item >> 4), bg = item & 15;
    b = bg >> 2; grp = bg & 3; t0 = tb * 64; tq0 = t0 + 32 * (w >> 2); head = grp * 4 + (w & 3);
    qbase = z + (size_t)(b * SEQ + tq0) * ZS + ZC_Q + head * 128; ldq = ZS;
    kbase = z + (size_t)(b * SEQ) * ZS + ZC_KS + grp * 128;
    vbase = z + (size_t)(b * SEQ) * ZS + ZC_VS + grp * 128;
    ldk = ZS;
    jlo = 0;
    jhi = tb;
    const unsigned* sm = (const unsigned*)(ws + OFF_SELM) + (b * 4 + grp) * SEQ;
    selm = sm[tq0 + r];
    unsigned u = sm[t0 + lane];
#pragma unroll
    for (int o = 32; o > 0; o >>= 1) u |= (unsigned)__shfl_xor((int)u, o);
    umask = (unsigned)__builtin_amdgcn_readfirstlane((int)u);
    umask &= (jhi >= 31) ? 0xffffffffu : ((1u << (jhi + 1)) - 1u);
  } else if (MODE == MODE_X) {
    const int tb = item >> 4, bh = item & 15;
    b = bh >> 2; head = bh & 3; t0 = tb * 256; tq0 = t0 + 32 * w;
    qbase = (const bfr*)(ws + OFF_QX) + (size_t)(b * SEQ + tq0) * 512 + head * 128; ldq = 512;
    kbase = (const bfr*)(ws + OFF_KX) + (size_t)(b * 256) * 512 + head * 128;
    vbase = (const bfr*)(ws + OFF_VX) + (size_t)(b * 256) * 512 + head * 128;
    ldk = 512;
    jlo = 0; jhi = 3;
  } else {
    const int tb = 7 - (item >> 6), rest = item & 63;
    b = rest >> 4; head = (rest >> 1) & 7; vh = rest & 1; t0 = tb * 256; tq0 = t0 + 32 * w;
    qbase = z + (size_t)(b * SEQ + tq0) * ZS + ZC_QR + head * 128; ldq = ZS;
    kbase = z + (size_t)(b * SEQ) * ZS + ZC_KR + head * 128;
    vbase = z + (size_t)(b * SEQ) * ZS + ZC_VR + head * 256 + vh * 128;
    ldk = ZS;
    jlo = 4 * tb; jhi = 4 * tb + 3;
  }
  const int tq = tq0 + r;

  f32x16 o[4];
#pragma unroll
  for (int dt = 0; dt < 4; ++dt)
#pragma unroll
    for (int i = 0; i < 16; ++i) o[dt][i] = 0.f;
  float m_run = -INFINITY, l_run = 0.f;
  float lg = 0.f;
  float rf[16];
  if (MODE == MODE_RET) {
    lg = log1pf(-exp2f(-5.f - (float)head)) * 1.4426950408889634f;
#pragma unroll
    for (int i = 0; i < 16; ++i) rf[i] = __builtin_amdgcn_exp2f(-lg * (float)crow(i, h));
  }

  u32x4 kreg[2], vreg[2];
  auto gload = [&](int j) {
    const int k0 = j * 64;
#pragma unroll
    for (int i = 0; i < 2; ++i) {
      const int c = tid + 512 * i, row = c >> 4, cc = c & 15;
      kreg[i] = *(const u32x4*)(kbase + (size_t)(k0 + row) * ldk + cc * 8);
      vreg[i] = *(const u32x4*)(vbase + (size_t)(k0 + row) * ldk + cc * 8);
    }
  };
  auto swrite = [&]() {
#pragma unroll
    for (int i = 0; i < 2; ++i) {
      const int c = tid + 512 * i, row = c >> 4, cc = c & 15;
      *(u32x4*)(Ks + row * KP + cc * 8) = kreg[i];
      *(u32x4*)(Vs + row * VP + cc * 8) = vreg[i];
    }
  };
  auto next_j = [&](int j) -> int {
    if (MODE == MODE_SEL) {
      const unsigned rem = (j >= 31) ? 0u : (umask & ~((2u << j) - 1u));
      return rem ? (__builtin_ctz(rem)) : 64;
    }
    return j + 1;
  };
  int j = jlo;
  if (MODE == MODE_SEL) j = __builtin_ctz(umask);
  gload(j);
  __syncthreads();
  {
    u32x4 qreg[8];
#pragma unroll
    for (int i = 0; i < 8; ++i) {
      const int c = lane + 64 * i, row = c >> 4, cc = c & 15;
      qreg[i] = *(const u32x4*)(qbase + (size_t)row * ldq + cc * 8);
    }
#pragma unroll
    for (int i = 0; i < 8; ++i) {
      const int c = lane + 64 * i, row = c >> 4, cc = c & 15;
      *(u32x4*)(Qw + row * KP + cc * 8) = qreg[i];
    }
  }
  const float csc = 0.08838834764831845f * 1.4426950408889634f;
  const int q4 = (lane & 15) >> 2, p4 = lane & 3, blk = (lane >> 4) & 1;
  if (MODE == MODE_RET) {
    const int c = t0 >> 8;
    if (c > 0) {
      bfr* Sb = Vs + 64 * VP + 8 * 32 * KP;
      const float* kvb = (const float*)(ws + OFF_RKV) + (size_t)((b * 8 + head) * 7) * (128 * 256) + vh * 128;
      const float g256 = __builtin_amdgcn_exp2f(lg * 256.f);
#pragma unroll 1
      for (int g = 0; g < 2; ++g) {
        f32x4 sum[4];
#pragma unroll
        for (int i = 0; i < 4; ++i) sum[i] = (f32x4){0.f, 0.f, 0.f, 0.f};
        float fac = 1.f;
#pragma unroll 1
        for (int jj = c - 1; jj >= 0; --jj) {
          const float* kj = kvb + (size_t)jj * (128 * 256);
          f32x4 kv[4];
#pragma unroll
          for (int i = 0; i < 4; ++i) { const int e4 = tid + 512 * (4 * g + i); kv[i] = *(const f32x4*)(kj + (e4 >> 5) * 256 + (e4 & 31) * 4); }
#pragma unroll
          for (int i = 0; i < 4; ++i) sum[i] += kv[i] * fac;
          fac *= g256;
        }
#pragma unroll
        for (int i = 0; i < 4; ++i) { const int e4 = tid + 512 * (4 * g + i); st_bf4(Sb + (e4 >> 5) * KP + (e4 & 31) * 4, sum[i][0], sum[i][1], sum[i][2], sum[i][3]); }
      }
      __syncthreads();
#pragma unroll
      for (int s = 0; s < 8; ++s) {
        const bf16x8 qf = *(const bf16x8*)(Qw + r * KP + 16 * s + 8 * h);
#pragma unroll
        for (int dt = 0; dt < 4; ++dt) {
          const bfr* sp = Sb + (16 * s + 8 * h + q4) * KP + 32 * dt + 16 * blk + 4 * p4;
          const s16x4 lo = tr_read(sp);
          const s16x4 hi = tr_read(sp + 4 * KP);
          const bf16x8 sf = __builtin_shufflevector(lo, hi, 0, 1, 2, 3, 4, 5, 6, 7);
          o[dt] = MFMA(sf, qf, o[dt]);
        }
      }
      const float fq_ = __builtin_amdgcn_exp2f(lg * (float)(tq - t0 + 1));
#pragma unroll
      for (int dt = 0; dt < 4; ++dt)
#pragma unroll
        for (int i = 0; i < 16; ++i) o[dt][i] *= fq_;
    }
  }
  bool first = true;
#pragma unroll 1
  while (j <= jhi) {
    if (!first) __syncthreads();
    first = false;
    swrite();
    __syncthreads();
    const int jn = next_j(j);
    if (jn <= jhi) gload(jn);
    const int k0 = j * 64;
    if (MODE == MODE_RET && k0 > tq0 + 31) { j = jn; continue; }
    bf16x8 pf[2][2];
    if (MODE == MODE_RET) {
#pragma unroll
      for (int sub = 0; sub < 2; ++sub) {
        f32x16 sx;
#pragma unroll
        for (int i = 0; i < 16; ++i) sx[i] = 0.f;
#pragma unroll
        for (int s = 0; s < 8; ++s) {
          const bf16x8 kf = *(const bf16x8*)(Ks + (32 * sub + r) * KP + 16 * s + 8 * h);
          const bf16x8 qf = *(const bf16x8*)(Qw + r * KP + 16 * s + 8 * h);
          sx = MFMA(kf, qf, sx);
        }
        {
          const int dq = tq - (k0 + 32 * sub);
          const float cf = __builtin_amdgcn_exp2f(lg * (float)dq);
#pragma unroll
          for (int i = 0; i < 16; ++i) sx[i] = (crow(i, h) <= dq) ? sx[i] * (cf * rf[i]) : 0.f;
        }
        pf[sub][0] = pack8(sx, 0);
        pf[sub][1] = pack8(sx, 1);
      }
    } else {
      f32x16 s0, s1;
#pragma unroll
      for (int i = 0; i < 16; ++i) { s0[i] = 0.f; s1[i] = 0.f; }
#pragma unroll
      for (int s = 0; s < 8; ++s) {
        const bf16x8 k0f = *(const bf16x8*)(Ks + r * KP + 16 * s + 8 * h);
        const bf16x8 k1f = *(const bf16x8*)(Ks + (32 + r) * KP + 16 * s + 8 * h);
        const bf16x8 qf = *(const bf16x8*)(Qw + r * KP + 16 * s + 8 * h);
        s0 = MFMA(k0f, qf, s0);
        s1 = MFMA(k1f, qf, s1);
      }
      bool need_mask = false;
      if (MODE == MODE_WIN) need_mask = (k0 + 63 > tq0) || (k0 < tq0 + 31 - 511);
      if (MODE == MODE_SEL) need_mask = (k0 + 63 > tq0);
      const bool lanesel = (MODE == MODE_SEL) ? ((selm >> j) & 1u) : true;
      float mx = -INFINITY;
      if (need_mask) {
#pragma unroll
        for (int i = 0; i < 16; ++i) {
          const int tk0 = k0 + crow(i, h), tk1 = tk0 + 32;
          bool ok0 = true, ok1 = true;
          if (MODE == MODE_WIN) { ok0 = (tk0 <= tq) && (tq - tk0 < 512); ok1 = (tk1 <= tq) && (tq - tk1 < 512); }
          if (MODE == MODE_SEL) { ok0 = lanesel && (tk0 <= tq); ok1 = lanesel && (tk1 <= tq); }
          s0[i] = ok0 ? s0[i] * csc : -INFINITY;
          s1[i] = ok1 ? s1[i] * csc : -INFINITY;
          mx = fmaxf(mx, fmaxf(s0[i], s1[i]));
        }
      } else {
#pragma unroll
        for (int i = 0; i < 16; ++i) {
          s0[i] = lanesel ? s0[i] * csc : -INFINITY;
          s1[i] = lanesel ? s1[i] * csc : -INFINITY;
          mx = fmaxf(mx, fmaxf(s0[i], s1[i]));
        }
      }
      mx = fmaxf(mx, __shfl_xor(mx, 32));
      const float mnew = fmaxf(m_run, mx);
      const float muse = (mnew == -INFINITY) ? 0.f : mnew;
      const float alpha = __builtin_amdgcn_exp2f(m_run - muse);
      float ls = 0.f;
#pragma unroll
      for (int i = 0; i < 16; ++i) {
        s0[i] = __builtin_amdgcn_exp2f(s0[i] - muse);
        s1[i] = __builtin_amdgcn_exp2f(s1[i] - muse);
        ls += s0[i] + s1[i];
      }
      ls += __shfl_xor(ls, 32);
      l_run = l_run * alpha + ls;
      m_run = mnew;
      if (__builtin_amdgcn_ballot_w64(alpha != 1.f) != 0) {
#pragma unroll
        for (int dt = 0; dt < 4; ++dt)
#pragma unroll
          for (int i = 0; i < 16; ++i) o[dt][i] *= alpha;
      }
      pf[0][0] = pack8(s0, 0); pf[0][1] = pack8(s0, 1);
      pf[1][0] = pack8(s1, 0); pf[1][1] = pack8(s1, 1);
    }
#pragma unroll
    for (int dt = 0; dt < 4; ++dt)
#pragma unroll
      for (int sub = 0; sub < 2; ++sub)
#pragma unroll
        for (int st = 0; st < 2; ++st) {
          const int key0 = 32 * sub + 16 * st + 4 * h;
          const bfr* vp = Vs + (key0 + q4) * VP + 32 * dt + 16 * blk + 4 * p4;
          const s16x4 lo = tr_read(vp);
          const s16x4 hi = tr_read(vp + 8 * VP);
          const bf16x8 vf = __builtin_shufflevector(lo, hi, 0, 1, 2, 3, 4, 5, 6, 7);
          o[dt] = MFMA(vf, pf[sub][st], o[dt]);
        }
    j = jn;
  }

  if (MODE == MODE_SEL && p.dbg) return;
  const size_t mrow = (size_t)(b * SEQ + tq);
  if (MODE == MODE_WIN || MODE == MODE_SEL) {
    const float inv = (l_run > 0.f) ? 1.f / l_run : 0.f;
    const float gate = bflo(z[mrow * ZS + ZC_GN + head * 3 + (MODE == MODE_WIN ? 2 : 1)]);
    bfr* orow = (bfr*)(ws + OFF_ONSA) + mrow * 2048 + head * 128;
    const float sc = inv * gate;
#pragma unroll
    for (int dt = 0; dt < 4; ++dt)
#pragma unroll
      for (int g = 0; g < 4; ++g) {
        bfr* dst = orow + 32 * dt + 8 * g + 4 * h;
        float a = o[dt][4 * g] * sc, bb = o[dt][4 * g + 1] * sc, c = o[dt][4 * g + 2] * sc, d = o[dt][4 * g + 3] * sc;
        if (MODE == MODE_SEL) {
          const uint2 old = *(const uint2*)dst;
          a += bflo(old.x); bb += bfhi(old.x); c += bflo(old.y); d += bfhi(old.y);
        }
        st_bf4(dst, a, bb, c, d);
      }
  } else if (MODE == MODE_X) {
    const float inv = 1.f / l_run;
    bfr* orow = (bfr*)(ws + OFF_OX) + mrow * 512 + head * 128;
#pragma unroll
    for (int dt = 0; dt < 4; ++dt)
#pragma unroll
      for (int g = 0; g < 4; ++g)
        st_bf4(orow + 32 * dt + 8 * g + 4 * h, o[dt][4 * g] * inv, o[dt][4 * g + 1] * inv, o[dt][4 * g + 2] * inv,
               o[dt][4 * g + 3] * inv);
  } else {
    float sm = 0.f, sq = 0.f;
#pragma unroll
    for (int dt = 0; dt < 4; ++dt)
#pragma unroll
      for (int i = 0; i < 16; ++i) { sm += o[dt][i]; sq += o[dt][i] * o[dt][i]; }
    sm += __shfl_xor(sm, 32);
    sq += __shfl_xor(sq, 32);
    if (h == 0) *(float2*)((float*)(ws + OFF_RSTAT) + ((mrow * 8 + head) * 2 + vh) * 2) = make_float2(sm, sq);
    bfr* orow = (bfr*)(ws + OFF_ORET) + mrow * 2048 + head * 256 + vh * 128;
#pragma unroll
    for (int dt = 0; dt < 4; ++dt)
#pragma unroll
      for (int g = 0; g < 4; ++g)
        st_bf4(orow + 32 * dt + 8 * g + 4 * h, o[dt][4 * g], o[dt][4 * g + 1], o[dt][4 * g + 2], o[dt][4 * g + 3]);
  }
}

DI void retkv_item(const Params& p, int item, char* smem, const int tid) {
  constexpr int VPW = 264;
  bfr* Kt = (bfr*)smem;
  bfr* Vt = Kt + 64 * KP;
  const int w = tid >> 6, lane = tid & 63, r = lane & 31, h = lane >> 5;
  const int c = item % 7, bh = item / 7, b = bh >> 3, head = bh & 7;
  char* ws = p.ws;
  const bfr* z = (const bfr*)(ws + OFF_Z);
  const bfr* kbase = z + (size_t)(b * SEQ + 256 * c) * ZS + ZC_KR + head * 128;
  const bfr* vbase = z + (size_t)(b * SEQ + 256 * c) * ZS + ZC_VR + head * 256;
  const float lg = log1pf(-exp2f(-5.f - (float)head)) * 1.4426950408889634f;
  const int dtile = w & 3, ehalf = w >> 2;
  const int q4 = (lane & 15) >> 2, p4 = lane & 3, blk = (lane >> 4) & 1;
  f32x16 acc[4];
#pragma unroll
  for (int et = 0; et < 4; ++et)
#pragma unroll
    for (int i = 0; i < 16; ++i) acc[et][i] = 0.f;
  float wj[8];
#pragma unroll
  for (int j = 0; j < 8; ++j) wj[j] = __builtin_amdgcn_exp2f(-lg * (float)j);
#pragma unroll 1
  for (int t = 0; t < 4; ++t) {
    u32x4 kr[2], vr[4];
#pragma unroll
    for (int i = 0; i < 2; ++i) {
      const int ch = tid + 512 * i, row = ch >> 4, cc = ch & 15;
      kr[i] = *(const u32x4*)(kbase + (size_t)(64 * t + row) * ZS + cc * 8);
    }
#pragma unroll
    for (int i = 0; i < 4; ++i) {
      const int ch = tid + 512 * i, row = ch >> 5, cc = ch & 31;
      vr[i] = *(const u32x4*)(vbase + (size_t)(64 * t + row) * ZS + cc * 8);
    }
    __syncthreads();
#pragma unroll
    for (int i = 0; i < 2; ++i) {
      const int ch = tid + 512 * i, row = ch >> 4, cc = ch & 15;
      *(u32x4*)(Kt + row * KP + cc * 8) = kr[i];
    }
#pragma unroll
    for (int i = 0; i < 4; ++i) {
      const int ch = tid + 512 * i, row = ch >> 5, cc = ch & 31;
      *(u32x4*)(Vt + row * VPW + cc * 8) = vr[i];
    }
    __syncthreads();
#pragma unroll
    for (int st = 0; st < 4; ++st) {
      const int m0 = 16 * st + 8 * h;
      const bfr* kp = Kt + (m0 + q4) * KP + 32 * dtile + 16 * blk + 4 * p4;
      const s16x4 klo = tr_read(kp);
      const s16x4 khi = tr_read(kp + 4 * KP);
      typedef unsigned u4_ __attribute__((ext_vector_type(4)));
      const u4_ ku = __builtin_bit_cast(u4_, __builtin_shufflevector(klo, khi, 0, 1, 2, 3, 4, 5, 6, 7));
      const float wb = __builtin_amdgcn_exp2f(lg * (float)(255 - 64 * t - m0));
      u4_ ks;
#pragma unroll
      for (int k = 0; k < 4; ++k) ks[k] = pack2(bflo(ku[k]) * (wb * wj[2 * k]), bfhi(ku[k]) * (wb * wj[2 * k + 1]));
      const bf16x8 af = __builtin_bit_cast(bf16x8, ks);
#pragma unroll
      for (int et = 0; et < 4; ++et) {
        const bfr* vp = Vt + (m0 + q4) * VPW + 128 * ehalf + 32 * et + 16 * blk + 4 * p4;
        const s16x4 vlo = tr_read(vp);
        const s16x4 vhi = tr_read(vp + 4 * VPW);
        const bf16x8 vf = __builtin_shufflevector(vlo, vhi, 0, 1, 2, 3, 4, 5, 6, 7);
        acc[et] = MFMA(af, vf, acc[et]);
      }
    }
  }
  float* kv = (float*)(ws + OFF_RKV) + (size_t)item * (128 * 256);
#pragma unroll
  for (int et = 0; et < 4; ++et)
#pragma unroll
    for (int i = 0; i < 16; ++i) kv[(32 * dtile + crow(i, h)) * 256 + 128 * ehalf + 32 * et + r] = acc[et][i];
  __syncthreads();
}

DI void ret_finish_row(const Params& p, int row, const int t) {
  char* ws = p.ws;
  const bfr* z = (const bfr*)(ws + OFF_Z);
  const int col = t * 8, head = t >> 5;
  const float4 st = *(const float4*)((const float*)(ws + OFF_RSTAT) + ((size_t)row * 8 + head) * 4);
  const float mu = (st.x + st.z) * (1.f / 256.f);
  const float var = fmaxf((st.y + st.w) * (1.f / 256.f) - mu * mu, 0.f);
  const float rstd = rsqrtf(var + 1e-6f);
  bfr* op = (bfr*)(ws + OFF_ORET) + (size_t)row * 2048 + col;
  const u32x4 ov = *(const u32x4*)op;
  const u32x4 gv = *(const u32x4*)(z + (size_t)row * ZS + ZC_GR + col);
  const float4 w0 = *(const float4*)(p.gn_w + col), w1 = *(const float4*)(p.gn_w + col + 4);
  u32x4 res;
  res[0] = pack2((bflo(ov[0]) - mu) * rstd * w0.x * bflo(gv[0]), (bfhi(ov[0]) - mu) * rstd * w0.y * bfhi(gv[0]));
  res[1] = pack2((bflo(ov[1]) - mu) * rstd * w0.z * bflo(gv[1]), (bfhi(ov[1]) - mu) * rstd * w0.w * bfhi(gv[1]));
  res[2] = pack2((bflo(ov[2]) - mu) * rstd * w1.x * bflo(gv[2]), (bfhi(ov[2]) - mu) * rstd * w1.y * bfhi(gv[2]));
  res[3] = pack2((bflo(ov[3]) - mu) * rstd * w1.z * bflo(gv[3]), (bfhi(ov[3]) - mu) * rstd * w1.w * bfhi(gv[3]));
  *(u32x4*)op = res;
}

DI void ret_finish_rows4(const Params& p, int row0, const int t) {
  char* ws = p.ws;
  const bfr* z = (const bfr*)(ws + OFF_Z);
  const int col = t * 8, head = t >> 5;
  float4 st[4];
  u32x4 ov[4], gv[4];
#pragma unroll
  for (int q = 0; q < 4; ++q) {
    const size_t row = (size_t)(row0 + 2 * q);
    st[q] = *(const float4*)((const float*)(ws + OFF_RSTAT) + (row * 8 + head) * 4);
    ov[q] = *(const u32x4*)((const bfr*)(ws + OFF_ORET) + row * 2048 + col);
    gv[q] = *(const u32x4*)(z + row * ZS + ZC_GR + col);
  }
  const float4 w0 = *(const float4*)(p.gn_w + col), w1 = *(const float4*)(p.gn_w + col + 4);
#pragma unroll
  for (int q = 0; q < 4; ++q) {
    const float mu = (st[q].x + st[q].z) * (1.f / 256.f);
    const float var = fmaxf((st[q].y + st[q].w) * (1.f / 256.f) - mu * mu, 0.f);
    const float rstd = rsqrtf(var + 1e-6f);
    u32x4 res;
    res[0] = pack2((bflo(ov[q][0]) - mu) * rstd * w0.x * bflo(gv[q][0]), (bfhi(ov[q][0]) - mu) * rstd * w0.y * bfhi(gv[q][0]));
    res[1] = pack2((bflo(ov[q][1]) - mu) * rstd * w0.z * bflo(gv[q][1]), (bfhi(ov[q][1]) - mu) * rstd * w0.w * bfhi(gv[q][1]));
    res[2] = pack2((bflo(ov[q][2]) - mu) * rstd * w1.x * bflo(gv[q][2]), (bfhi(ov[q][2]) - mu) * rstd * w1.y * bfhi(gv[q][2]));
    res[3] = pack2((bflo(ov[q][3]) - mu) * rstd * w1.z * bflo(gv[q][3]), (bfhi(ov[q][3]) - mu) * rstd * w1.w * bfhi(gv[q][3]));
    *(u32x4*)((bfr*)(ws + OFF_ORET) + (size_t)(row0 + 2 * q) * 2048 + col) = res;
  }
}

DI void cmp_item(const Params& p, int item, char* smem, const int tid) {
  bfr* Ks = (bfr*)smem;
  float* impw = (float*)(smem + 128 * KP * 2);
  const int w = tid >> 6, lane = tid & 63, r = lane & 31, h = lane >> 5;
  char* ws = p.ws;
  const bfr* z = (const bfr*)(ws + OFF_Z);
  const int tb = item >> 4, bg = item & 15, b = bg >> 2, grp = bg & 3;
  const int t0 = tb * 64, ti = 32 * (w >> 2) + r, tq = t0 + ti, hw = w & 3, head = grp * 4 + hw;
  const bfr* qrow = z + (size_t)(b * SEQ + tq) * ZS + ZC_Q + head * 128;
  const bfr* kc = (const bfr*)(ws + OFF_KCVC) + (size_t)((b * 4 + grp) * 128) * 128;
  const bfr* vc = kc + (size_t)2048 * 128;
  bf16x8 qf[8];
#pragma unroll
  for (int s = 0; s < 8; ++s) qf[s] = *(const bf16x8*)(qrow + 16 * s + 8 * h);
  u32x4 reg[4];
#pragma unroll
  for (int i = 0; i < 4; ++i) {
    const int c = tid + 512 * i, row = c >> 4, cc = c & 15;
    reg[i] = *(const u32x4*)(kc + row * 128 + cc * 8);
  }
  __syncthreads();
#pragma unroll
  for (int i = 0; i < 4; ++i) {
    const int c = tid + 512 * i, row = c >> 4, cc = c & 15;
    *(u32x4*)(Ks + row * KP + cc * 8) = reg[i];
  }
  __syncthreads();
  f32x16 s[4];
#pragma unroll
  for (int kt = 0; kt < 4; ++kt) {
#pragma unroll
    for (int i = 0; i < 16; ++i) s[kt][i] = 0.f;
#pragma unroll
    for (int ss = 0; ss < 8; ++ss) {
      const bf16x8 kf = *(const bf16x8*)(Ks + (32 * kt + r) * KP + 16 * ss + 8 * h);
      s[kt] = MFMA(kf, qf[ss], s[kt]);
    }
  }
  const float csc = 0.08838834764831845f * 1.4426950408889634f;
  float mx = -INFINITY;
#pragma unroll
  for (int kt = 0; kt < 4; ++kt)
#pragma unroll
    for (int i = 0; i < 16; ++i) {
      const int c = 32 * kt + crow(i, h);
      const bool ok = (c * 16 + 31 <= tq) && (c < 127);
      s[kt][i] = ok ? s[kt][i] * csc : -INFINITY;
      mx = fmaxf(mx, s[kt][i]);
    }
  mx = fmaxf(mx, __shfl_xor(mx, 32));
  const float muse = (mx == -INFINITY) ? 0.f : mx;
  float ls = 0.f;
#pragma unroll
  for (int kt = 0; kt < 4; ++kt)
#pragma unroll
    for (int i = 0; i < 16; ++i) {
      s[kt][i] = __builtin_amdgcn_exp2f(s[kt][i] - muse);
      ls += s[kt][i];
    }
  ls += __shfl_xor(ls, 32);
  const float inv = (ls > 0.f) ? 1.f / ls : 0.f;
#pragma unroll
  for (int kt = 0; kt < 4; ++kt)
#pragma unroll
    for (int i = 0; i < 16; ++i) s[kt][i] *= inv;
  float plast[16];
#pragma unroll
  for (int kt = 0; kt < 4; ++kt)
#pragma unroll
    for (int g = 0; g < 4; ++g) plast[kt * 4 + g] = __shfl_xor(s[kt][4 * g + 3], 32);
#pragma unroll
  for (int kt = 0; kt < 4; ++kt)
#pragma unroll
    for (int g = 0; g < 4; ++g) {
      const int slot = kt * 4 + g;
      const float sum4 = s[kt][4 * g] + s[kt][4 * g + 1] + s[kt][4 * g + 2] + s[kt][4 * g + 3];
      const float prevl = (slot > 0) ? plast[slot > 0 ? slot - 1 : 0] : 0.f;
      const float add = h ? plast[slot] : prevl;
      impw[(hw * 64 + ti) * 32 + 8 * kt + 2 * g + h] = sum4 + add;
    }
  bf16x8 pf[4][2];
#pragma unroll
  for (int kt = 0; kt < 4; ++kt) { pf[kt][0] = pack8(s[kt], 0); pf[kt][1] = pack8(s[kt], 1); }
#pragma unroll
  for (int i = 0; i < 4; ++i) {
    const int c = tid + 512 * i, row = c >> 4, cc = c & 15;
    reg[i] = *(const u32x4*)(vc + row * 128 + cc * 8);
  }
  __syncthreads();
#pragma unroll
  for (int i = 0; i < 4; ++i) {
    const int c = tid + 512 * i, row = c >> 4, cc = c & 15;
    *(u32x4*)(Ks + row * KP + cc * 8) = reg[i];
  }
  __syncthreads();
  f32x16 o[4];
#pragma unroll
  for (int dt = 0; dt < 4; ++dt)
#pragma unroll
    for (int i = 0; i < 16; ++i) o[dt][i] = 0.f;
  const int q4 = (lane & 15) >> 2, p4 = lane & 3, blk = (lane >> 4) & 1;
#pragma unroll
  for (int dt = 0; dt < 4; ++dt)
#pragma unroll
    for (int kt = 0; kt < 4; ++kt)
#pragma unroll
      for (int st = 0; st < 2; ++st) {
        const int key0 = 32 * kt + 16 * st + 4 * h;
        const bfr* vp = Ks + (key0 + q4) * KP + 32 * dt + 16 * blk + 4 * p4;
        const s16x4 lo = tr_read(vp);
        const s16x4 hi = tr_read(vp + 8 * KP);
        const bf16x8 vf = __builtin_shufflevector(lo, hi, 0, 1, 2, 3, 4, 5, 6, 7);
        o[dt] = MFMA(vf, pf[kt][st], o[dt]);
      }
  {
    const size_t mrow = (size_t)(b * SEQ + tq);
    const float gate = bflo(z[mrow * ZS + ZC_GN + head * 3 + 0]);
    bfr* orow = (bfr*)(ws + OFF_ONSA) + mrow * 2048 + head * 128;
#pragma unroll
    for (int dt = 0; dt < 4; ++dt)
#pragma unroll
      for (int g = 0; g < 4; ++g) {
        bfr* dst = orow + 32 * dt + 8 * g + 4 * h;
        const uint2 old = *(const uint2*)dst;
        st_bf4(dst, o[dt][4 * g] * gate + bflo(old.x), o[dt][4 * g + 1] * gate + bfhi(old.x),
               o[dt][4 * g + 2] * gate + bflo(old.y), o[dt][4 * g + 3] * gate + bfhi(old.y));
      }
  }
  {
    const int i = tid >> 3, jg = tid & 7;
    const int cur = (t0 + i) >> 6;
    float vm[4];
#pragma unroll
    for (int e = 0; e < 4; ++e) {
      const int jme = 4 * jg + e;
      const float a = impw[(0 * 64 + i) * 32 + jme] + impw[(1 * 64 + i) * 32 + jme] + impw[(2 * 64 + i) * 32 + jme] + impw[(3 * 64 + i) * 32 + jme];
      const bool forced = (jme == 0) || (jme == cur) || (jme == cur - 1);
      vm[e] = forced ? INFINITY : ((jme > cur) ? -INFINITY : a);
    }
#pragma unroll
    for (int e = 0; e < 4; ++e) impw[i * 32 + 4 * jg + e] = vm[e];
    __syncthreads();
    int rank[4] = {0, 0, 0, 0};
#pragma unroll 4
    for (int k = 0; k < 32; ++k) {
      const float vk = impw[i * 32 + k];
#pragma unroll
      for (int e = 0; e < 4; ++e) rank[e] += (vk > vm[e] || (vk == vm[e] && k < 4 * jg + e)) ? 1 : 0;
    }
    unsigned bits = 0;
#pragma unroll
    for (int e = 0; e < 4; ++e)
      if (rank[e] < 16 && 4 * jg + e <= cur) bits |= 1u << (4 * jg + e);
    bits |= (unsigned)__shfl_xor((int)bits, 1);
    bits |= (unsigned)__shfl_xor((int)bits, 2);
    bits |= (unsigned)__shfl_xor((int)bits, 4);
    if (jg == 0) ((unsigned*)(ws + OFF_SELM))[(b * 4 + grp) * SEQ + t0 + i] = bits;
  }
  __syncthreads();
}

typedef __attribute__((address_space(3))) volatile int lds_vi;
DI lds_vi* grab_word() { __shared__ int gw[4]; return (lds_vi*)gw; }
DI int grab(unsigned* ctr, int*  , const int tid) {
  lds_vi* sl = grab_word();
  __syncthreads();
  if (tid == 0) *sl = (int)atomicAdd(ctr, 1u);
  __syncthreads();
  return *sl;
}

DI void run_phase(const Params& p0, int ph, char* smem, int* slot, const int wave_s, const int rep) {
  char* ws = p0.ws;
  asm volatile("" : "+s"(ws));
  Params p = p0;
  p.ws = ws;
  p.dbg = rep;
  const int G = gridDim.x;
  int bid = blockIdx.x;
  int tid = wave_s * 64 + (int)__builtin_amdgcn_mbcnt_hi(~0u, __builtin_amdgcn_mbcnt_lo(~0u, 0u));
  asm volatile("" : "+s"(bid));
  asm volatile("" : "+v"(tid));
  bfr* z = (bfr*)(ws + OFF_Z);
  unsigned* ctr = (unsigned*)(ws + OFF_CTR) + rep * 8;
  switch (ph) {
    case 0: {
      if (bid == 0 && tid < 64) ((unsigned*)(ws + OFF_CTR))[tid] = 0u;
      if (bid < (2 * NTOK) / NTHR) ((float*)(ws + OFF_ROWSS))[bid * NTHR + tid] = 0.f;
      int tot = 0;
      for (int j = 0; j < 3; ++j) tot += tjob_tiles(j);
      const int n_norm = 1024 + 128, n_rope = 256;
      tr_run(p, 0, bid, G, tot, (float*)smem, tid);
      for (int it = tot + bid; it < tot + n_norm + n_rope; it += G) {
        if (it < tot + n_norm) {
          const int row = (it - tot) * 8 + (tid >> 6);
          if (row < NTOK) rmsnorm_row(p.x + (size_t)row * 2048, p.attn_norm_w, (bfr*)(ws + OFF_N) + (size_t)row * 2048, nullptr, tid);
          else rmsnorm_row(p.mem + (size_t)(row - NTOK) * 2048, p.mem_norm_w, (bfr*)(ws + OFF_MN) + (size_t)(row - NTOK) * 2048, nullptr, tid);
        } else {
          const int e = (it - tot - n_norm) * 512 + tid;
          const int t = e >> 6, i = e & 63;
          const float ang = (float)t * ROPE_INV[i];
          const float kk = rintf(ang * 0.15915494309189535f);
          float rr = fmaf(-kk, 6.2831854820251465f, ang);
          rr = fmaf(-kk, -1.7484555e-7f, rr);
          const float fr = rr * 0.15915494309189535f;
          ((float2*)(ws + OFF_ROPE))[e] = make_float2(__builtin_amdgcn_cosf(fr), __builtin_amdgcn_sinf(fr));
        }
      }
    } break;
    case 1: {
      {
        bfr* zcb = (bfr*)(ws + OFF_ZC);
        const float* rope = (const float*)(ws + OFF_ROPE);
        gemm8_phase(smem, (const bfr*)(ws + OFF_N), (const bfr*)(ws + OFF_WINT), 2048, 32 * 61, G, bid, tid,
          [&](const f32x4 (&acc)[2][2][4][2], int m0, int n0, int wr, int wc, int fr, int fq) {
            if (n0 < ZC_KC || (n0 >= ZC_KS && n0 < ZC_QR) || (n0 >= ZC_VR && n0 < ZC_GR)) {
              epi8_foreach(acc, m0, n0, wr, wc, fr, fq, [&](int m, int n, const f32x4& v0, const f32x4& v1) { st_bf8(z + (size_t)m * ZS + n, v0, v1); });
            } else if (n0 < ZC_KS) {
              const float* pe = (n0 < ZC_VC) ? p.pe_k : p.pe_v;
              epi8_foreach(acc, m0, n0, wr, wc, fr, fq, [&](int m, int n, const f32x4& v0, const f32x4& v1) {
                const int t = m & 2047, dd = n & 127;
                const float* pl = pe + (t & 15) * 128 + dd;
                const float* ph_ = pl + 16 * 128;
                const f32x4 l0 = *(const f32x4*)pl, l1 = *(const f32x4*)(pl + 4), h0 = *(const f32x4*)ph_, h1 = *(const f32x4*)(ph_ + 4);
                bfr* d = zcb + (size_t)m * 2048 + (n - ZC_KC);
                st_bf8(d, v0 + l0, v1 + l1);
                st_bf8(d + 1024, v0 + h0, v1 + h1);
              });
            } else if (n0 < ZC_VR) {
              const float sc = (n0 >= ZC_KR) ? 0.08838834764831845f : 1.f;
              epi8_foreach(acc, m0, n0, wr, wc, fr, fq, [&](int m, int n, const f32x4& v0, const f32x4& v1) {
                const int t = m & 2047, i0 = (n & 127) >> 1;
                const float* rp = rope + (size_t)(t * 64 + i0) * 2;
                const f32x4 c01 = *(const f32x4*)rp, c23 = *(const f32x4*)(rp + 4);
                f32x4 a0, a1;
                a0[0] = (v0[0] * c01[0] - v0[1] * c01[1]) * sc; a0[1] = (v0[0] * c01[1] + v0[1] * c01[0]) * sc;
                a0[2] = (v0[2] * c01[2] - v0[3] * c01[3]) * sc; a0[3] = (v0[2] * c01[3] + v0[3] * c01[2]) * sc;
                a1[0] = (v1[0] * c23[0] - v1[1] * c23[1]) * sc; a1[1] = (v1[0] * c23[1] + v1[1] * c23[0]) * sc;
                a1[2] = (v1[2] * c23[2] - v1[3] * c23[3]) * sc; a1[3] = (v1[2] * c23[3] + v1[3] * c23[2]) * sc;
                st_bf8(z + (size_t)m * ZS + n, a0, a1);
              });
            } else if (n0 < ZC_GA) {
              epi8_foreach(acc, m0, n0, wr, wc, fr, fq, [&](int m, int n, const f32x4& v0, const f32x4& v1) {
                f32x4 a0, a1;
#pragma unroll
                for (int j = 0; j < 4; ++j) { a0[j] = v0[j] * sigmoidf_(v0[j]); a1[j] = v1[j] * sigmoidf_(v1[j]); }
                st_bf8(z + (size_t)m * ZS + n, a0, a1);
              });
            } else {
              epi8_foreach(acc, m0, n0, wr, wc, fr, fq, [&](int m, int n, const f32x4& v0, const f32x4& v1) {
                if (n >= ZS) return;
                f32x4 a0, a1;
#pragma unroll
                for (int j = 0; j < 4; ++j) { a0[j] = sigmoidf_(v0[j]); a1[j] = sigmoidf_(v1[j]); }
                st_bf8(z + (size_t)m * ZS + n, a0, a1);
              });
            }
          });
      }
      {
        const int nunits = 32 * 61;
        const int nlong = (nunits % G == 0) ? 0 : nunits % G;
        const int nshort = G - nlong;
        const int sb_ = bid - nlong;
        if (sb_ >= 0) {
          for (int u = sb_; u < 32; u += nshort) {
            f32x16 acc[1][4];
            acc_zero<1>(acc);
            const int which = u >> 4, mt = (u & 15) >> 2, nt = u & 3;
            const int m0 = mt * 256, n0 = nt * 128;
            PlainPtr af{(const bfr*)(ws + OFF_MN) + (size_t)m0 * 2048, 2048};
            PlainPtr bf{(const bfr*)(ws + (which ? OFF_WVT : OFF_WKT)) + (size_t)n0 * 2048, 2048};
            gemm_main<1>(acc, af, bf, 32, smem, tid);
            bfr* dstb = (bfr*)(ws + (which ? OFF_VX : OFF_KX));
            gemm_epi<1>(acc, m0, n0, tid, [&](int m, int n, float a, float b, float c, float d) { st_bf4(dstb + (size_t)m * 512 + n, a, b, c, d); });
          }
          int tot2 = 0;
          for (int j = 3; j < 12; ++j) tot2 += tjob_tiles(j);
          tr_run(p, 3, sb_, nshort, tot2, (float*)smem, tid);
        }
      }
    } break;
    case 2: {
      for (int it = grab(ctr + 0, slot, tid); it < 128; it = grab(ctr + 0, slot, tid)) {
        const int which = it >> 6, mt = (it & 63) >> 3, nt = it & 7;
        const int m0 = mt * 256, n0 = nt * 128;
        f32x16 acc[1][4];
        acc_zero<1>(acc);
        struct GatherA {
          const bfr* base; int m0;
          DI int rowoff(int row) const {
            const int R = m0 + row;
            const int bb = R >> 9, g = (R >> 7) & 3;
            int c = R & 127; c = c > 126 ? 126 : c;
            return (bb * SEQ + c * 16) * 2048 + g * 128;
          }
          DI int koff(int kk) const { const int l = kk >> 7; return l * 2048 + ((l >> 4) << 10) + (kk & 127); }
        };
        GatherA af{(const bfr*)(ws + OFF_ZC) + which * 512, m0};
        PlainPtr bf{(const bfr*)(ws + OFF_W1T) + (size_t)which * 1024 * 4096 + (size_t)n0 * 4096, 4096};
        gemm_main<1>(acc, af, bf, 64, smem, tid);
        bfr* hid = (bfr*)(ws + OFF_HIDC) + (size_t)which * 2048 * 1024;
        gemm_epi<1>(acc, m0, n0, tid, [&](int m, int n, float a, float b, float c, float d) {
          st_bf4(hid + (size_t)m * 1024 + n, a * sigmoidf_(a), b * sigmoidf_(b), c * sigmoidf_(c), d * sigmoidf_(d));
        });
      }
      for (int it = grab(ctr + 6, slot, tid); it < 224; it = grab(ctr + 6, slot, tid)) retkv_item(p, it, smem, tid);
      for (int it = grab(ctr + 1, slot, tid); it < 512; it = grab(ctr + 1, slot, tid)) attn_item<MODE_WIN>(p, it, smem, tid);
    } break;
    case 3: {
      for (int it = bid; it < 16; it += G) {
        const int which = it >> 3, mt = it & 7;
        const int m0 = mt * 256;
        f32x16 acc[1][4];
        acc_zero<1>(acc);
        PlainPtr af{(const bfr*)(ws + OFF_HIDC) + (size_t)which * 2048 * 1024 + (size_t)m0 * 1024, 1024};
        PlainPtr bf{(const bfr*)(ws + OFF_W2T) + (size_t)which * 128 * 1024, 1024};
        gemm_main<1>(acc, af, bf, 16, smem, tid);
        bfr* dstb = (bfr*)(ws + OFF_KCVC) + (size_t)which * 2048 * 128;
        gemm_epi<1>(acc, m0, 0, tid, [&](int m, int n, float a, float b, float c, float d) { st_bf4(dstb + (size_t)m * 128 + n, a, b, c, d); });
      }
      for (int it = grab(ctr + 5, slot, tid); it < 512; it = grab(ctr + 5, slot, tid)) attn_item<MODE_RET>(p, it, smem, tid);
    } break;
    case 4: {
      for (int it = bid; it < 512; it += G) cmp_item(p, it, smem, tid);
      for (int it = bid; it < NTOK / 8; it += G) ret_finish_rows4(p, it * 8 + (tid >> 8), tid & 255);
    } break;
    case 5: {
      for (int it = grab(ctr + 2, slot, tid); it < 512; it = grab(ctr + 2, slot, tid)) attn_item<MODE_SEL>(p, it, smem, tid);
    } break;
    case 6: {
      bfr* mg = (bfr*)(ws + OFF_MERGED);
      gemm8_phase(smem, (const bfr*)(ws + OFF_ONSA), (const bfr*)(ws + OFF_WAT), 2048, 32 * 8, G, bid, tid,
        [&](const f32x4 (&acc)[2][2][4][2], int m0, int n0, int wr, int wc, int fr, int fq) {
          epi8_foreach(acc, m0, n0, wr, wc, fr, fq, [&](int m, int n, const f32x4& v0, const f32x4& v1) {
            const u32x4 ga = *(const u32x4*)(z + (size_t)m * ZS + ZC_GA + n);
            f32x4 a0 = {bflo(ga[0]) * v0[0], bfhi(ga[0]) * v0[1], bflo(ga[1]) * v0[2], bfhi(ga[1]) * v0[3]};
            f32x4 a1 = {bflo(ga[2]) * v1[0], bfhi(ga[2]) * v1[1], bflo(ga[3]) * v1[2], bfhi(ga[3]) * v1[3]};
            st_bf8(mg + (size_t)m * 2048 + n, a0, a1);
          });
        });
      gemm8_phase(smem, (const bfr*)(ws + OFF_ORET), (const bfr*)(ws + OFF_WBT), 2048, 32 * 8, G, bid, tid,
        [&](const f32x4 (&acc)[2][2][4][2], int m0, int n0, int wr, int wc, int fr, int fq) {
          epi8_foreach(acc, m0, n0, wr, wc, fr, fq, [&](int m, int n, const f32x4& v0, const f32x4& v1) {
            const u32x4 gb = *(const u32x4*)(z + (size_t)m * ZS + ZC_GB + n);
            bfr* dst = mg + (size_t)m * 2048 + n;
            const u32x4 old = *(const u32x4*)dst;
            f32x4 a0 = {bflo(old[0]) + bflo(gb[0]) * v0[0], bfhi(old[0]) + bfhi(gb[0]) * v0[1], bflo(old[1]) + bflo(gb[1]) * v0[2], bfhi(old[1]) + bfhi(gb[1]) * v0[3]};
            f32x4 a1 = {bflo(old[2]) + bflo(gb[2]) * v1[0], bfhi(old[2]) + bfhi(gb[2]) * v1[1], bflo(old[3]) + bflo(gb[3]) * v1[2], bfhi(old[3]) + bfhi(gb[3]) * v1[3]};
            st_bf8(dst, a0, a1);
          });
        });
    } break;
    case 7: {
      gemm8_phase(smem, (const bfr*)(ws + OFF_MERGED), (const bfr*)(ws + OFF_WOUTT), 2048, 32 * 8, G, bid, tid,
        [&](const f32x4 (&acc)[2][2][4][2], int m0, int n0, int wr, int wc, int fr, int fq) {
          epi8_resid(acc, m0, n0, wr, wc, fr, fq, p.x, (float*)(ws + OFF_H), (bfr*)(ws + OFF_NX), (float*)(ws + OFF_ROWSS));
        });
    } break;
    case 8: case 12: break;
    case 9: {
      const int ng = (G > 128) ? 128 : G;
      if (bid < ng)
      for (int v = bid; v < 32 * 4; v += ng) {
        int mt, nt;
        map_tile32(v, mt, nt);
        const int m0 = mt * 256, n0 = nt * 128;
        f32x16 acc[1][4];
        acc_zero<1>(acc);
        PlainPtr af{(const bfr*)(ws + OFF_NX) + (size_t)m0 * 2048, 2048};
        PlainPtr bf{(const bfr*)(ws + OFF_WQT) + (size_t)n0 * 2048, 2048};
        gemm_main<1>(acc, af, bf, 32, smem, tid);
        bfr* qx = (bfr*)(ws + OFF_QX);
        const float* rss = (const float*)(ws + OFF_ROWSS);
        gemm_epi<1>(acc, m0, n0, tid, [&](int m, int n, float a, float b, float c, float d) {
          const float rs = rsqrtf(rss[m] * (1.f / 2048.f) + 1e-6f);
          st_bf4(qx + (size_t)m * 512 + n, a * rs, b * rs, c * rs, d * rs);
        });
      }
      {
        const int nt12 = tjob_tiles(12);
        for (int c = grab(ctr + 3, slot, tid); c * 8 < nt12; c = grab(ctr + 3, slot, tid))
          tr_run(p, 12, c * 8, 1, (c * 8 + 8 < nt12) ? c * 8 + 8 : nt12, (float*)smem, tid);
      }
    } break;
    case 10: {
      const int ng = (G > 128) ? 128 : G;
      if (bid < ng)
        for (int it = bid; it < 128; it += ng) attn_item<MODE_X>(p, it, smem, tid);
      {
        const int nt13 = tjob_tiles(13);
        for (int c = grab(ctr + 4, slot, tid); c * 8 < nt13; c = grab(ctr + 4, slot, tid))
          tr_run(p, 13, c * 8, 1, (c * 8 + 8 < nt13) ? c * 8 + 8 : nt13, (float*)smem, tid);
      }
    } break;
    case 11: {
      gemm8_phase(smem, (const bfr*)(ws + OFF_OX), (const bfr*)(ws + OFF_WOT), 512, 32 * 8, G, bid, tid,
        [&](const f32x4 (&acc)[2][2][4][2], int m0, int n0, int wr, int wc, int fr, int fq) {
          epi8_resid(acc, m0, n0, wr, wc, fr, fq, (const float*)(ws + OFF_H), (float*)(ws + OFF_H), (bfr*)(ws + OFF_NX), (float*)(ws + OFF_ROWSS) + NTOK);
        });
    } break;
    case 13: {
      bfr* hid = (bfr*)(ws + OFF_HID);
      const float* rss = (const float*)(ws + OFF_ROWSS) + NTOK;
      gemm8_phase(smem, (const bfr*)(ws + OFF_NX), (const bfr*)(ws + OFF_WUPT), 2048, 32 * 32, G, bid, tid,
        [&](const f32x4 (&acc)[2][2][4][2], int m0, int n0, int wr, int wc, int fr, int fq) {
          epi8_foreach(acc, m0, n0, wr, wc, fr, fq, [&](int m, int n, const f32x4& v0, const f32x4& v1) {
            const float rs = rsqrtf(rss[m] * (1.f / 2048.f) + 1e-6f);
            f32x4 a0, a1;
#pragma unroll
            for (int j = 0; j < 4; ++j) { const float t0 = fmaxf(v0[j], 0.f) * rs, t1 = fmaxf(v1[j], 0.f) * rs; a0[j] = t0 * t0; a1[j] = t1 * t1; }
            st_bf8(hid + (size_t)m * 8192 + n, a0, a1);
          });
        });
    } break;
    case 14: {
      const float* hbuf = (const float*)(ws + OFF_H);
      gemm8_phase(smem, (const bfr*)(ws + OFF_HID), (const bfr*)(ws + OFF_WDOWNT), 8192, 32 * 8, G, bid, tid,
        [&](const f32x4 (&acc)[2][2][4][2], int m0, int n0, int wr, int wc, int fr, int fq) {
          epi8_foreach(acc, m0, n0, wr, wc, fr, fq, [&](int m, int n, const f32x4& v0, const f32x4& v1) {
            const float* sp = hbuf + (size_t)m * 2048 + n;
            const f32x4 x0 = *(const f32x4*)sp, x1 = *(const f32x4*)(sp + 4);
            float* dp = p.out + (size_t)m * 2048 + n;
            *(f32x4*)dp = x0 + v0; *(f32x4*)(dp + 4) = x1 + v1;
          });
        });
    } break;
    case 15: {
      for (int it = bid; it < 1024; it += G) {
        const int row = it * 8 + (tid >> 6);
        rmsnorm_row(p.out + (size_t)row * 2048, p.final_norm_w, nullptr, p.out + (size_t)row * 2048, tid);
      }
    } break;
    default: break;
  }
}

#define XB_TMO      128
#define XB_XCNT(j)  (256  + 64 * (j))
#define XB_XSUB(j)  (1280 + 64 * (j))
#define XB_XGEN(j)  (2304 + 64 * (j))
#define XB_TOP      3328
#define XB_TOPGEN   3392
#define XB_SPIN_CAP (1u << 18)
DI unsigned xb_ld(unsigned* p) { return __hip_atomic_load(p, __ATOMIC_RELAXED, __HIP_MEMORY_SCOPE_AGENT); }
DI unsigned xb_add(unsigned* p, unsigned v) { return __hip_atomic_fetch_add(p, v, __ATOMIC_RELAXED, __HIP_MEMORY_SCOPE_AGENT); }
DI unsigned xb_xcc_id() { return (unsigned)__builtin_amdgcn_s_getreg((3 << 11) | 20) & 0xFu; }
#define XB_SPIN(cond, bar) do { unsigned _sp = 0; while (cond) { __builtin_amdgcn_s_sleep(1); \
    if ((++_sp & 255u) == 0u) { if (xb_ld(&(bar)[XB_TMO])) break; if (_sp > XB_SPIN_CAP) { atomicAdd(&(bar)[XB_TMO], 1u); break; } } } } while (0)
typedef __attribute__((address_space(3))) volatile unsigned lds_vu;
struct XcdBarrier { unsigned* bar; unsigned x; lds_vu* st; };
DI lds_vu* xb_words() { __shared__ unsigned xbw[4]; return (lds_vu*)xbw; }
DI XcdBarrier xcd_barrier_post(unsigned* bar, lds_vu* st) {
  XcdBarrier b; b.bar = bar; b.x = xb_xcc_id(); b.st = st;
  if (threadIdx.x == 0) (void)xb_add(&bar[XB_XCNT(b.x)], 1u);
  return b;
}
DI void xcd_barrier_complete(unsigned* bar, unsigned x, unsigned& nloc, unsigned& nx) {
  const unsigned Gt = gridDim.x * gridDim.y * gridDim.z;
  unsigned sum, cnt, mine, sp = 0u;
  for (;;) {
    sum = 0u; cnt = 0u; mine = 0u;
#pragma unroll
    for (unsigned j = 0; j < 16; ++j) { const unsigned c = xb_ld(&bar[XB_XCNT(j)]); sum += c; cnt += (c > 0u) ? 1u : 0u; mine = (j == x) ? c : mine; }
    if (sum == Gt) break;
    __builtin_amdgcn_s_sleep(1);
    if ((++sp & 255u) == 0u) { if (xb_ld(&bar[XB_TMO])) break; if (sp > XB_SPIN_CAP) { atomicAdd(&bar[XB_TMO], 1u); break; } }
  }
  nloc = mine > 0u ? mine : 1u; nx = cnt > 0u ? cnt : 1u;
}
DI void xcd_barrier(unsigned* bar_in, const int wave_s) {
  lds_vu* st_in = xb_words();
  XcdBarrier b; b.bar = bar_in; b.st = st_in; b.x = xb_xcc_id();
  asm volatile("s_waitcnt vmcnt(0)" ::: "memory");
  __syncthreads();
  if (wave_s == 0 && __builtin_amdgcn_mbcnt_hi(~0u, __builtin_amdgcn_mbcnt_lo(~0u, 0u)) == 0u) {
    unsigned* bar = b.bar;
    __builtin_amdgcn_s_waitcnt(0);
    unsigned nloc = b.st[0], nx = b.st[1];
    if (nloc == 0u) { xcd_barrier_complete(bar, b.x, nloc, nx); b.st[0] = nloc; b.st[1] = nx; }
    const unsigned old = xb_add(&bar[XB_XSUB(b.x)], 1u);
    const unsigned gen = old / nloc;
    if (old + 1u == (gen + 1u) * nloc) {
      __builtin_amdgcn_fence(__ATOMIC_RELEASE, "agent");
      asm volatile("s_waitcnt vmcnt(0)" ::: "memory");
      const unsigned og = xb_add(&bar[XB_TOP], 1u);
      const unsigned tg = og / nx;
      if (og + 1u == (tg + 1u) * nx) xb_add(&bar[XB_TOPGEN], 1u);
      else XB_SPIN(xb_ld(&bar[XB_TOPGEN]) == tg, bar);
      __builtin_amdgcn_fence(__ATOMIC_ACQUIRE, "agent");
      xb_add(&bar[XB_XGEN(b.x)], 1u);
      asm volatile("s_waitcnt vmcnt(0)" ::: "memory");
    } else {
      XB_SPIN(xb_ld(&bar[XB_XGEN(b.x)]) == gen, bar);
      __builtin_amdgcn_fence(__ATOMIC_ACQUIRE, "agent");
      asm volatile("s_waitcnt vmcnt(0)" ::: "memory");
    }
  }
  __syncthreads();
}

__global__ void __launch_bounds__(512, 2) mega(Params p) {
  extern __shared__ __attribute__((aligned(1024))) char smem[];
  __shared__ int slot;
  cg::grid_group grid = cg::this_grid();
  const int wave_s = __builtin_amdgcn_readfirstlane((int)(threadIdx.x >> 6));
  if (p.dbg == 12345) grid.sync();
  if (threadIdx.x < 4) xb_words()[threadIdx.x] = 0u;
  __syncthreads();
  (void)xcd_barrier_post((unsigned*)(p.ws + OFF_BAR), xb_words());
  for (int ph = p.ph_lo; ph < p.ph_hi; ++ph) {
    if (ph == 8 || ph == 12) continue;
    int nrep = 1;
#ifdef PROBE_PH
    if (ph == PROBE_PH) nrep = 1 + PROBE_N;
#endif
#pragma unroll 1
    for (int rep = 0; rep < nrep; ++rep) {
      run_phase(p, ph, smem, &slot, wave_s, rep);
      if (rep + 1 < nrep || ph + 1 < p.ph_hi) xcd_barrier((unsigned*)(p.ws + OFF_BAR), wave_s);
    }
  }
}

extern "C" void kernel_launch(void* const* d_in, const int* in_sizes, int n_in, void* d_out, int out_size, void* d_ws,
                              size_t ws_size, hipStream_t stream) {
  static int grid_blocks = 0;
  if (!grid_blocks) {
    int dev = 0, cus = 0, per_cu = 0;
    (void)hipGetDevice(&dev);
    (void)hipDeviceGetAttribute(&cus, hipDeviceAttributeMultiprocessorCount, dev);
    (void)hipFuncSetAttribute((const void*)mega, hipFuncAttributeMaxDynamicSharedMemorySize, SMEM_BYTES);
    (void)hipOccupancyMaxActiveBlocksPerMultiprocessor(&per_cu, mega, NTHR, SMEM_BYTES);
    if (per_cu < 1) per_cu = 1;
    if (per_cu > 1) per_cu = 1;
    grid_blocks = cus * per_cu;
    grid_blocks &= ~7;
    if (ws_size < WS_END || n_in != 24) { fprintf(stderr, "kernel_launch: ws %zu < %zu or n_in %d\n", ws_size, (size_t)WS_END, n_in); grid_blocks = -1; }
  }
  if (grid_blocks < 0) return;
  Params p{};
  const float** pp = (const float**)&p;
  for (int i = 0; i < 24; ++i) pp[i] = (const float*)d_in[i];
  p.out = (float*)d_out;
  p.ws = (char*)d_ws;
#if ONE_LAUNCH
  p.ph_lo = 0; p.ph_hi = NPHASE;
  (void)hipMemsetAsync((char*)d_ws + OFF_BAR, 0, BAR_BYTES, stream);
  void* args[] = {&p};
  hipError_t e = hipLaunchCooperativeKernel((void*)mega, dim3(grid_blocks), dim3(NTHR), args, SMEM_BYTES, stream);
  if (e != hipSuccess) fprintf(stderr, "cooperative launch failed: %s (grid %d)\n", hipGetErrorString(e), grid_blocks);
#else
  for (int ph = 0; ph < NPHASE; ++ph) {
    p.ph_lo = ph; p.ph_hi = ph + 1;
    hipLaunchKernelGGL(mega, dim3(grid_blocks), dim3(NTHR), SMEM_BYTES, stream, p);
  }
#endif
}
```

```cpp
#include <hip/hip_runtime.h>
#include <hip/hip_cooperative_groups.h>
#include <cstdio>
namespace cg = cooperative_groups;

#ifndef ONE_LAUNCH
#define ONE_LAUNCH 1
#endif

#define DI __device__ __forceinline__
typedef unsigned short bfr;
using bf16x8 = __attribute__((ext_vector_type(8))) short;
using s16x4 = __attribute__((ext_vector_type(4))) short;
using f32x16 = __attribute__((ext_vector_type(16))) float;
using u32x4 = __attribute__((ext_vector_type(4))) unsigned;
#define MFMA(a, b, c) __builtin_amdgcn_mfma_f32_32x32x16_bf16((a), (b), (c), 0, 0, 0)

constexpr int DM = 2048, SEQ = 2048, NTOK = 8192;
constexpr int ZS = 15488;
constexpr int ZC_Q = 0, ZC_KC = 2048, ZC_VC = 2560, ZC_KS = 3072, ZC_VS = 3584, ZC_KW = 4096, ZC_VW = 4608,
              ZC_QR = 5120, ZC_KR = 6144, ZC_VR = 7168, ZC_GR = 9216, ZC_GA = 11264, ZC_GB = 13312, ZC_GN = 15360;
constexpr int NPHASE = 16;

constexpr int ZSP = 15616;
constexpr size_t SZ_WINT = (size_t)ZSP * 2048 * 2;
constexpr size_t SZ_ACT = (size_t)NTOK * 2048 * 2;
constexpr size_t OFF_WINT = 0;
constexpr size_t OFF_N = OFF_WINT + SZ_WINT;
constexpr size_t OFF_MERGED = OFF_WINT;
constexpr size_t OFF_RKV = OFF_WINT;
static_assert((size_t)224 * 128 * 256 * 4 <= SZ_WINT, "retention KV buffer must fit the dead w_in^T region");
constexpr size_t OFF_ORET = OFF_N;
constexpr size_t OFF_WUPT = 0;
constexpr size_t OFF_WDOWNT = SZ_ACT;
constexpr size_t OFF_Z = OFF_N + SZ_ACT;
constexpr size_t SZ_Z = (size_t)NTOK * ZS * 2;
constexpr size_t OFF_HID = OFF_Z;
constexpr size_t OFF_H = OFF_Z + (size_t)NTOK * 8192 * 2;
constexpr size_t OFF_NX = OFF_H + (size_t)NTOK * 2048 * 4;
constexpr size_t OFF_QX = OFF_NX + SZ_ACT;
constexpr size_t OFF_OX = OFF_QX + (size_t)NTOK * 512 * 2;
static_assert(OFF_OX + (size_t)NTOK * 512 * 2 <= OFF_Z + SZ_Z, "alias overflow");
constexpr size_t OFF_ZC = OFF_Z + SZ_Z;
constexpr size_t OFF_MN = OFF_ZC + (size_t)NTOK * 2048 * 2;
constexpr size_t OFF_W1T = OFF_MN + (size_t)1024 * 2048 * 2;
constexpr size_t OFF_W2T = OFF_W1T + (size_t)2 * 1024 * 4096 * 2;
constexpr size_t OFF_WAT = OFF_W2T + (size_t)2 * 128 * 1024 * 2;
constexpr size_t OFF_WBT = OFF_WAT + (size_t)2048 * 2048 * 2;
constexpr size_t OFF_WOUTT = OFF_WBT + (size_t)2048 * 2048 * 2;
constexpr size_t OFF_WQT = OFF_WOUTT + (size_t)2048 * 2048 * 2;
constexpr size_t OFF_WKT = OFF_WQT + (size_t)512 * 2048 * 2;
constexpr size_t OFF_WVT = OFF_WKT + (size_t)512 * 2048 * 2;
constexpr size_t OFF_WOT = OFF_WVT + (size_t)512 * 2048 * 2;
constexpr size_t OFF_ROPE = OFF_WOT + (size_t)512 * 2048 * 2;
constexpr size_t OFF_HIDC = OFF_ROPE + (size_t)2048 * 64 * 8;
constexpr size_t OFF_KCVC = OFF_HIDC + (size_t)2 * 2048 * 1024 * 2;
constexpr size_t OFF_SELM = OFF_KCVC + (size_t)2 * 2048 * 128 * 2;
constexpr size_t OFF_ONSA = OFF_SELM + (size_t)16 * 2048 * 4;
constexpr size_t OFF_KX = OFF_ONSA + SZ_ACT;
constexpr size_t OFF_VX = OFF_KX + (size_t)1024 * 512 * 2;
constexpr size_t OFF_RSTAT = OFF_VX + (size_t)1024 * 512 * 2;
constexpr size_t OFF_CTR = OFF_RSTAT + (size_t)NTOK * 8 * 2 * 2 * 4;
constexpr size_t OFF_BAR = OFF_CTR + 256;
constexpr size_t BAR_BYTES = 16384;
constexpr size_t OFF_ROWSS = OFF_BAR + BAR_BYTES;
constexpr size_t WS_END = OFF_ROWSS + (size_t)2 * NTOK * 4;

struct Params {
  const float *x, *mem, *attn_norm_w, *w_in, *pe_k, *w1k, *w2k, *pe_v, *w1v, *w2v, *w_a, *gn_w, *w_b, *w_out, *x_norm_w,
      *mem_norm_w, *wq, *wk, *wv, *wo, *mlp_norm_w, *w_up, *w_down, *final_norm_w;
  float* out;
  char* ws;
  int ph_lo, ph_hi;
  int dbg, pad;
};

constexpr int NTHR = 512;
constexpr int SMEM_BYTES = 139264;
__device__ const float ROPE_INV[64] = {1.0f, 0.865964353f, 0.749894261f, 0.649381638f, 0.562341332f, 0.486967534f, 0.421696514f, 0.365174115f, 0.316227764f, 0.273841977f, 0.237137377f, 0.2053525f, 0.177827939f, 0.153992653f, 0.133352131f, 0.115478203f, 0.100000001f, 0.0865964293f, 0.0749894157f, 0.0649381652f, 0.0562341325f, 0.0486967526f, 0.0421696529f, 0.0365174115f, 0.0316227749f, 0.0273841973f, 0.0237137377f, 0.0205352511f, 0.0177827943f, 0.0153992651f, 0.0133352149f, 0.0115478206f, 0.00999999978f, 0.00865964312f, 0.00749894185f, 0.00649381615f, 0.00562341325f, 0.00486967526f, 0.00421696482f, 0.00365174119f, 0.00316227763f, 0.00273841969f, 0.00237137359f, 0.00205352483f, 0.00177827943f, 0.00153992651f, 0.00133352145f, 0.0011547819f, 0.00100000005f, 0.000865964335f, 0.000749894243f, 0.000649381662f, 0.000562341302f, 0.000486967532f, 0.000421696517f, 0.000365174143f, 0.000316227757f, 0.000273841957f, 0.00023713737f, 0.00020535251f, 0.00017782794f, 0.000153992645f, 0.00013335215f, 0.0001154782f};

DI unsigned pack2(float a, float b) {
  typedef float f2 __attribute__((ext_vector_type(2)));
  typedef __bf16 b2 __attribute__((ext_vector_type(2)));
  f2 v = {a, b};
  b2 r = __builtin_convertvector(v, b2);
  return __builtin_bit_cast(unsigned, r);
}
DI float bflo(unsigned u) { return __uint_as_float(u << 16); }
DI float bfhi(unsigned u) { return __uint_as_float(u & 0xffff0000u); }
DI void st_bf4(bfr* p, float a, float b, float c, float d) {
  uint2 v; v.x = pack2(a, b); v.y = pack2(c, d);
  *(uint2*)p = v;
}
DI float wave_sum(float v) {
#pragma unroll
  for (int o = 32; o > 0; o >>= 1) v += __shfl_xor(v, o);
  return v;
}
DI float sigmoidf_(float x) { return __builtin_amdgcn_rcpf(1.f + __expf(-x)); }
DI int crow(int i, int h) { return (i & 3) + 8 * (i >> 2) + 4 * h; }
DI bf16x8 pack8(const f32x16& x, int s) {
  unsigned a = pack2(x[8 * s], x[8 * s + 1]), b = pack2(x[8 * s + 2], x[8 * s + 3]), c = pack2(x[8 * s + 4], x[8 * s + 5]),
           d = pack2(x[8 * s + 6], x[8 * s + 7]);
  typedef unsigned u4 __attribute__((ext_vector_type(4)));
  u4 v = {a, b, c, d};
  return __builtin_bit_cast(bf16x8, v);
}
DI s16x4 tr_read(const bfr* p) {
  return __builtin_amdgcn_ds_read_tr16_b64_v4i16((__attribute__((address_space(3))) s16x4*)(p));
}

struct TJob { const float* src; bfr* dst; int K, N, ntn, perm; const float* kscale; };
DI TJob get_tjob(const Params& p, int j) {
  TJob t;
  char* ws = p.ws;
  switch (j) {
    case 0: t = {p.w_in, (bfr*)(ws + OFF_WINT), 2048, 15408, 122, 1, nullptr}; break;
    case 1: t = {p.wk, (bfr*)(ws + OFF_WKT), 2048, 512, 4, 0, nullptr}; break;
    case 2: t = {p.wv, (bfr*)(ws + OFF_WVT), 2048, 512, 4, 0, nullptr}; break;
    case 3: t = {p.w_a, (bfr*)(ws + OFF_WAT), 2048, 2048, 16, 0, nullptr}; break;
    case 4: t = {p.w_b, (bfr*)(ws + OFF_WBT), 2048, 2048, 16, 0, nullptr}; break;
    case 5: t = {p.w_out, (bfr*)(ws + OFF_WOUTT), 2048, 2048, 16, 0, nullptr}; break;
    case 6: t = {p.w1k, (bfr*)(ws + OFF_W1T), 4096, 1024, 8, 0, nullptr}; break;
    case 7: t = {p.w1v, (bfr*)(ws + OFF_W1T) + (size_t)1024 * 4096, 4096, 1024, 8, 0, nullptr}; break;
    case 8: t = {p.w2k, (bfr*)(ws + OFF_W2T), 1024, 128, 1, 0, nullptr}; break;
    case 9: t = {p.w2v, (bfr*)(ws + OFF_W2T) + (size_t)128 * 1024, 1024, 128, 1, 0, nullptr}; break;
    case 10: t = {p.wq, (bfr*)(ws + OFF_WQT), 2048, 512, 4, 0, p.x_norm_w}; break;
    case 11: t = {p.wo, (bfr*)(ws + OFF_WOT), 512, 2048, 16, 0, nullptr}; break;
    case 12: t = {p.w_up, (bfr*)(ws + OFF_WUPT), 2048, 8192, 64, 0, p.mlp_norm_w}; break;
    default: t = {p.w_down, (bfr*)(ws + OFF_WDOWNT), 8192, 2048, 16, 0, nullptr}; break;
  }
  return t;
}
DI int tjob_tiles(int j) {
  switch (j) {
    case 0: return 122 * 16;
    case 1: case 2: return 4 * 16;
    case 3: case 4: case 5: return 16 * 16;
    case 6: case 7: return 8 * 32;
    case 8: case 9: return 1 * 8;
    case 10: return 4 * 16;
    case 11: return 16 * 4;
    case 12: return 64 * 16;
    default: return 16 * 64;
  }
}
struct TrRegs { float4 v[8]; };
DI void tr_load(const TJob& t, int tile, TrRegs& rg, const int tid) {
  const int nkt = t.K >> 7;
  const int kt = tile % nkt, nt = tile / nkt;
  const int k0 = kt * 128, d0 = nt * 128;
  int scol0 = d0, nvalid = 128;
  if (t.perm) {
    if (d0 < 5120) scol0 = d0;
    else if (d0 < 15360) scol0 = d0 + 48;
    else { scol0 = d0 - 15360 + 5120; nvalid = (d0 == 15360) ? 48 : 0; }
  }
#pragma unroll
  for (int i = 0; i < 8; ++i) {
    const int row = i * 16 + (tid >> 5), col = (tid & 31) * 4;
    rg.v[i] = make_float4(0.f, 0.f, 0.f, 0.f);
    if (col < nvalid) rg.v[i] = *(const float4*)(t.src + (size_t)(k0 + row) * t.N + scol0 + col);
    if (t.kscale) { const float sc = t.kscale[k0 + row]; rg.v[i].x *= sc; rg.v[i].y *= sc; rg.v[i].z *= sc; rg.v[i].w *= sc; }
  }
}
DI void tr_to_lds(const TrRegs& rg, float* sm, const int tid) {
#pragma unroll
  for (int i = 0; i < 8; ++i) {
    const int row = i * 16 + (tid >> 5), col = (tid & 31) * 4;
    float* d = sm + row * 129 + col;
    d[0] = rg.v[i].x; d[1] = rg.v[i].y; d[2] = rg.v[i].z; d[3] = rg.v[i].w;
  }
}
DI void tr_store(const TJob& t, int tile, const float* sm, const int tid) {
  const int nkt = t.K >> 7;
  const int kt = tile % nkt, nt = tile / nkt;
  const int k0 = kt * 128, d0 = nt * 128;
  const int n = tid >> 2, kq = (tid & 3) * 8;
  bfr* drow = t.dst + (size_t)(d0 + n) * t.K + k0 + kq;
#pragma unroll
  for (int q = 0; q < 4; ++q) {
    const int kb = kq + 32 * q;
    const unsigned o0 = pack2(sm[(kb + 0) * 129 + n], sm[(kb + 1) * 129 + n]);
    const unsigned o1 = pack2(sm[(kb + 2) * 129 + n], sm[(kb + 3) * 129 + n]);
    const unsigned o2 = pack2(sm[(kb + 4) * 129 + n], sm[(kb + 5) * 129 + n]);
    const unsigned o3 = pack2(sm[(kb + 6) * 129 + n], sm[(kb + 7) * 129 + n]);
    *(uint4*)(drow + 32 * q) = make_uint4(o0, o1, o2, o3);
  }
}
DI void tr_decode(int it, int j_lo, int& j, int& rem) {
  j = j_lo; rem = it;
  while (rem >= tjob_tiles(j)) { rem -= tjob_tiles(j); ++j; }
}
DI void tr_run(const Params& p, int j_lo, int it0, int stride, int n_tiles, float* sm, const int tid) {
  if (it0 >= n_tiles) return;
  TrRegs rg;
  int j, rem;
  tr_decode(it0, j_lo, j, rem);
  TJob t = get_tjob(p, j);
  tr_load(t, rem, rg, tid);
  for (int it = it0; it < n_tiles; it += stride) {
    __syncthreads();
    tr_to_lds(rg, sm, tid);
    __syncthreads();
    const TJob tc = t;
    const int remc = rem;
    const int nx = it + stride;
    if (nx < n_tiles) {
      tr_decode(nx, j_lo, j, rem);
      t = get_tjob(p, j);
      tr_load(t, rem, rg, tid);
    }
    tr_store(tc, remc, sm, tid);
  }
  __syncthreads();
}

DI void rmsnorm_row(const float* xrow, const float* w, bfr* obf, float* of32, const int tid) {
  const int lane = tid & 63;
  float4 v[8];
  float ss = 0.f;
#pragma unroll
  for (int i = 0; i < 8; ++i) {
    v[i] = ((const float4*)xrow)[lane + 64 * i];
    ss += v[i].x * v[i].x + v[i].y * v[i].y + v[i].z * v[i].z + v[i].w * v[i].w;
  }
  ss = wave_sum(ss);
  const float rs = rsqrtf(ss * (1.f / 2048.f) + 1e-6f);
#pragma unroll
  for (int i = 0; i < 8; ++i) {
    const float4 ww = ((const float4*)w)[lane + 64 * i];
    const float a = v[i].x * rs * ww.x, b = v[i].y * rs * ww.y, c = v[i].z * rs * ww.z, d = v[i].w * rs * ww.w;
    if (obf) st_bf4(obf + (lane + 64 * i) * 4, a, b, c, d);
    else ((float4*)of32)[lane + 64 * i] = make_float4(a, b, c, d);
  }
}

struct PlainPtr {
  const bfr* base; int ld;
  DI int rowoff(int row) const { return row * ld; }
  DI int koff(int k0) const { return k0; }
};
#define WAIT_V(n) asm volatile("s_waitcnt vmcnt(%0)" ::"n"(n) : "memory")
#define WAIT_L(n) asm volatile("s_waitcnt lgkmcnt(%0)" ::"n"(n) : "memory")
#define RAW_BARRIER() do { WAIT_L(0); __builtin_amdgcn_s_barrier(); } while (0)
typedef __attribute__((address_space(3))) unsigned lds_u32;
constexpr int STAGE_B = 65536;
template <int NI, class AF, class BF>
DI void gemm_main(f32x16 (&acc)[NI][4], const AF& af, const BF& bf, int nk, char* smem, const int tid) {
  const int lane = tid & 63, r = lane & 31, h = lane >> 5;
  const int w = __builtin_amdgcn_readfirstlane(tid >> 6);
  const int wm = w & 1, wn = w >> 1;
  int ao[4], bo[2 * NI];
  {
    const int rl = lane >> 3, kc = (lane & 7) ^ (((w & 1) * 4 + (lane >> 4)) & 7);
#pragma unroll
    for (int i = 0; i < 4; ++i) ao[i] = af.rowoff((w + 8 * i) * 8 + rl) + 8 * kc;
#pragma unroll
    for (int i = 0; i < 2 * NI; ++i) bo[i] = bf.rowoff((w + 8 * i) * 8 + rl) + 8 * kc;
  }
  auto stage = [&](int buf, int kt) {
    const int ka = af.koff(kt * 64), kb = bf.koff(kt * 64);
    char* sbase = smem + buf * STAGE_B + w * 1024;
#pragma unroll
    for (int i = 0; i < 4; ++i)
      __builtin_amdgcn_global_load_lds((const unsigned*)(af.base + (ao[i] + ka)), (lds_u32*)(sbase + i * 8192), 16, 0, 0);
#pragma unroll
    for (int i = 0; i < 2 * NI; ++i)
      __builtin_amdgcn_global_load_lds((const unsigned*)(bf.base + (bo[i] + kb)), (lds_u32*)(sbase + 32768 + i * 8192), 16, 0, 0);
  };
  const int xr = (r >> 1) & 7;
  const int arow = (wm * 128 + r) * 128, brow = 32768 + (wn * 32 * NI + r) * 128;
  WAIT_V(0);
  __syncthreads();
  stage(0, 0);
  WAIT_V(0);
  RAW_BARRIER();
#pragma unroll 1
  for (int kt = 0; kt < nk; ++kt) {
    if (kt + 1 < nk) stage((kt + 1) & 1, kt + 1);
    const char* sb = smem + (kt & 1) * STAGE_B;
#pragma unroll
    for (int ks = 0; ks < 4; ++ks) {
      const int off = ((2 * ks + h) ^ xr) * 16;
      bf16x8 wf[NI], xf[4];
#pragma unroll
      for (int i = 0; i < NI; ++i) wf[i] = *(const bf16x8*)(sb + brow + i * 4096 + off);
#pragma unroll
      for (int i = 0; i < 4; ++i) xf[i] = *(const bf16x8*)(sb + arow + i * 4096 + off);
#pragma unroll
      for (int mi = 0; mi < 4; ++mi)
#pragma unroll
        for (int ni = 0; ni < NI; ++ni) acc[ni][mi] = MFMA(wf[ni], xf[mi], acc[ni][mi]);
    }
    WAIT_V(0);
    RAW_BARRIER();
  }
}
template <int NI>
DI void acc_zero(f32x16 (&acc)[NI][4]) {
#pragma unroll
  for (int a = 0; a < NI; ++a)
#pragma unroll
    for (int b = 0; b < 4; ++b)
#pragma unroll
      for (int i = 0; i < 16; ++i) acc[a][b][i] = 0.f;
}
template <int NI, class EPI>
DI void gemm_epi(const f32x16 (&acc)[NI][4], int m0, int n0, const int tid_in, const EPI& epi) {
  int tid = tid_in;
  asm volatile("" : "+v"(tid));
  const int lane = tid & 63, w = tid >> 6, r = lane & 31, h = lane >> 5;
  const int wm = w & 1, wn = w >> 1;
#pragma unroll
  for (int mi = 0; mi < 4; ++mi)
#pragma unroll
    for (int ni = 0; ni < NI; ++ni)
#pragma unroll
      for (int g = 0; g < 4; ++g) {
        const int n = n0 + wn * 32 * NI + ni * 32 + 8 * g + 4 * h;
        const int m = m0 + wm * 128 + mi * 32 + r;
        epi(m, n, acc[ni][mi][4 * g], acc[ni][mi][4 * g + 1], acc[ni][mi][4 * g + 2], acc[ni][mi][4 * g + 3]);
      }
}
DI void gemm_epi_resid(const f32x16 (&acc)[2][4], int m0, int n0, const int tid_in, const float* hsrc, float* hdst, bfr* hb, float* rowss) {
  int tid = tid_in;
  asm volatile("" : "+v"(tid));
  const int lane = tid & 63, w = tid >> 6, r = lane & 31, h = lane >> 5;
  const int wm = w & 1, wn = w >> 1;
#pragma unroll
  for (int mi = 0; mi < 4; ++mi) {
    const int m = m0 + wm * 128 + mi * 32 + r;
    float ss = 0.f;
#pragma unroll
    for (int ni = 0; ni < 2; ++ni)
#pragma unroll
      for (int g = 0; g < 4; ++g) {
        const int n = n0 + wn * 64 + ni * 32 + 8 * g + 4 * h;
        const float4 xv = *(const float4*)(hsrc + (size_t)m * 2048 + n);
        const float a = xv.x + acc[ni][mi][4 * g], b = xv.y + acc[ni][mi][4 * g + 1], c = xv.z + acc[ni][mi][4 * g + 2], d = xv.w + acc[ni][mi][4 * g + 3];
        *(float4*)(hdst + (size_t)m * 2048 + n) = make_float4(a, b, c, d);
        st_bf4(hb + (size_t)m * 2048 + n, a, b, c, d);
        ss += a * a + b * b + c * c + d * d;
      }
    ss += __shfl_xor(ss, 32);
    if (h == 0) atomicAdd(rowss + m, ss);
  }
}
DI void map_tile32(int v, int& mt, int& nt) {
  const int xcd = v & 7, j = v >> 3;
  nt = j >> 2;
  mt = xcd * 4 + (j & 3);
}


using f32x4 = __attribute__((ext_vector_type(4))) float;
typedef __attribute__((address_space(3))) unsigned char lds_u8;
constexpr int HTB = 128 * 64 * 2;
DI int lds_byte8(int r, int c) { const int st = (r >> 4) * 2 + (c >> 5), rr = r & 15, cc = c & 31, ob = rr * 64 + cc * 2; return st * 1024 + (ob ^ (((ob >> 9) & 1) << 5)); }
DI void stage_rc8(int b, int& R, int& C) { const int st = b / 1024, sb = b % 1024, swz = sb ^ (((sb >> 9) & 1) << 5); R = (st >> 1) * 16 + swz / 64; C = (st & 1) * 32 + (swz % 64) / 2; }
DI int perm32(int rho) { const int n = rho >> 4, i = rho & 15; return 8 * (i >> 2) + 4 * n + (i & 3); }
DI bool unit_next(int i, int G, int bid, int nunits, int& pm, int& pn) {
  const int v = bid + i * G;
  if (v >= nunits) return false;
  const int xcd = v & 7, j = v >> 3;
  pn = j >> 2;
  pm = xcd * 4 + (j & 3);
  return true;
}
template <class Epi>
DI void gemm8_phase(char* smem, const bfr* A, const bfr* Bt, const int K, const int nunits, const int G, const int bid, const int tid, const Epi& E) {
  lds_u8* lds = (lds_u8*)smem;
  const int wid = __builtin_amdgcn_readfirstlane(tid >> 6), lane = tid & 63, wr = wid >> 2, wc = wid & 3, fr = lane & 15, fq = lane >> 4;
  const int nt = K / 64;
  unsigned voffA[2], voffB[2];
#pragma unroll
  for (int i = 0; i < 2; ++i) {
    int R, C;
    stage_rc8(tid * 16 + i * 8192, R, C);
    const int Rb = (R & ~31) + perm32(R & 31);
    voffA[i] = (unsigned)(R * K + C) * 2u;
    voffB[i] = (unsigned)(Rb * K + C) * 2u;
  }
  const size_t kstep = 128;
  const size_t hstep = (size_t)128 * K * 2;
  const size_t tstep = 2 * hstep;
  const unsigned ldsw = (unsigned)wid * 1024u;
  const int aoff = lds_byte8(wr * 64 + fr, fq * 8), boff = lds_byte8(wc * 32 + fr, fq * 8);
#define PG8_SA(b, h) (((b) * 2 + (h)) * HTB)
#define PG8_SB(b, h) ((4 + (b) * 2 + (h)) * HTB)
#define PG8_STAGE(bufoff, gbase, voff) do { _Pragma("unroll") for (int _i = 0; _i < 2; ++_i) \
    __builtin_amdgcn_global_load_lds((const unsigned*)((const char*)(gbase) + (voff)[_i]), (lds_u32*)(lds + (bufoff) + ldsw + _i * 8192), 16, 0, 0); } while (0)
#define PG8_LDA(dst, b, h) do { _Pragma("unroll") for (int m = 0; m < 4; ++m) _Pragma("unroll") for (int k = 0; k < 2; ++k) dst[m][k] = *(const __attribute__((address_space(3))) bf16x8*)(lds + PG8_SA(b, h) + aoff + m * 2048 + k * 1024); } while (0)
#define PG8_LDB(dst, b, h) do { _Pragma("unroll") for (int n = 0; n < 2; ++n) _Pragma("unroll") for (int k = 0; k < 2; ++k) dst[n][k] = *(const __attribute__((address_space(3))) bf16x8*)(lds + PG8_SB(b, h) + boff + n * 2048 + k * 1024); } while (0)
#define PG8_MMA(ai, bj, At, Bt_) do { __builtin_amdgcn_s_setprio(1); _Pragma("unroll") for (int m = 0; m < 4; ++m) _Pragma("unroll") for (int n = 0; n < 2; ++n) _Pragma("unroll") for (int k = 0; k < 2; ++k) \
    acc[ai][bj][m][n] = __builtin_amdgcn_mfma_f32_16x16x32_bf16(Bt_[n][k], At[m][k], acc[ai][bj][m][n], 0, 0, 0); __builtin_amdgcn_s_setprio(0); } while (0)
#define PG8_BAR __builtin_amdgcn_s_barrier()
#define PG8_SCHED __builtin_amdgcn_sched_barrier(0)
  int cpm, cpn, npm = 0, npn = 0, ui = 0;
  if (!unit_next(0, G, bid, nunits, cpm, cpn)) return;
  WAIT_V(0);
  __syncthreads();
  f32x4 acc[2][2][4][2];
#pragma unroll
  for (int a = 0; a < 2; ++a)
#pragma unroll
    for (int b = 0; b < 2; ++b)
#pragma unroll
      for (int m = 0; m < 4; ++m)
#pragma unroll
        for (int n = 0; n < 2; ++n) acc[a][b][m][n] = (f32x4){0.f, 0.f, 0.f, 0.f};
  bf16x8 At[4][2], B0[2][2], B1[2][2];
  const char* cA = (const char*)A + (size_t)cpm * tstep;
  const char* cB = (const char*)Bt + (size_t)cpn * tstep;
  PG8_STAGE(PG8_SB(0, 0), cB, voffB); PG8_STAGE(PG8_SA(0, 0), cA, voffA); PG8_STAGE(PG8_SB(0, 1), cB + hstep, voffB); PG8_STAGE(PG8_SA(0, 1), cA + hstep, voffA);
  if (wr == 1) PG8_BAR;
  WAIT_V(4); PG8_BAR;
  PG8_STAGE(PG8_SB(1, 0), cB + kstep, voffB); PG8_STAGE(PG8_SA(1, 0), cA + kstep, voffA); PG8_STAGE(PG8_SB(1, 1), cB + hstep + kstep, voffB);
  WAIT_V(6); PG8_BAR;
  for (;;) {
    const bool has_next = unit_next(ui + 1, G, bid, nunits, npm, npn);
    const char* nA = has_next ? (const char*)A + (size_t)npm * tstep : cA;
    const char* nB = has_next ? (const char*)Bt + (size_t)npn * tstep : cB;
#pragma unroll 1
    for (int t = 0; t < nt; t += 2) {
      const bool last = (t == nt - 2);
      const char* a1 = cA + (size_t)(t + 1) * kstep;
      const char* a2 = last ? nA : cA + (size_t)(t + 2) * kstep;
      const char* b2 = last ? nB : cB + (size_t)(t + 2) * kstep;
      const char* a3 = a2 + kstep;
      const char* b3 = b2 + kstep;
      PG8_LDB(B0, 0, 0); PG8_SCHED; PG8_LDA(At, 0, 0); PG8_STAGE(PG8_SA(1, 1), a1 + hstep, voffA);
      WAIT_L(8); PG8_BAR; WAIT_L(0); PG8_MMA(0, 0, At, B0); PG8_BAR; PG8_SCHED;
      PG8_LDB(B1, 0, 1); PG8_STAGE(PG8_SB(0, 0), b2, voffB);
      PG8_BAR; WAIT_L(0); PG8_MMA(0, 1, At, B1); PG8_BAR;
      PG8_LDA(At, 0, 1); PG8_STAGE(PG8_SA(0, 0), a2, voffA);
      PG8_BAR; WAIT_L(0); PG8_MMA(1, 0, At, B0); PG8_BAR; PG8_SCHED;
      PG8_STAGE(PG8_SB(0, 1), b2 + hstep, voffB);
      WAIT_V(6); PG8_BAR; PG8_MMA(1, 1, At, B1); PG8_BAR;
      PG8_LDB(B0, 1, 0); PG8_SCHED; PG8_LDA(At, 1, 0); PG8_STAGE(PG8_SA(0, 1), a2 + hstep, voffA);
      WAIT_L(8); PG8_BAR; WAIT_L(0); PG8_MMA(0, 0, At, B0); PG8_BAR; PG8_SCHED;
      PG8_LDB(B1, 1, 1); PG8_STAGE(PG8_SB(1, 0), b3, voffB);
      PG8_BAR; WAIT_L(0); PG8_MMA(0, 1, At, B1); PG8_BAR;
      PG8_LDA(At, 1, 1); PG8_STAGE(PG8_SA(1, 0), a3, voffA);
      PG8_BAR; WAIT_L(0); PG8_MMA(1, 0, At, B0); PG8_BAR; PG8_SCHED;
      PG8_STAGE(PG8_SB(1, 1), b3 + hstep, voffB);
      WAIT_V(6); PG8_BAR; PG8_MMA(1, 1, At, B1); PG8_BAR;
    }
    E(acc, cpm * 256, cpn * 256, wr, wc, fr, fq);
    if (!has_next) break;
#pragma unroll
    for (int a = 0; a < 2; ++a)
#pragma unroll
      for (int b = 0; b < 2; ++b)
#pragma unroll
        for (int m = 0; m < 4; ++m)
#pragma unroll
          for (int n = 0; n < 2; ++n) acc[a][b][m][n] = (f32x4){0.f, 0.f, 0.f, 0.f};
    cpm = npm; cpn = npn; cA = nA; cB = nB; ++ui;
  }
  WAIT_V(0);
  if (wr == 0) PG8_BAR;
  PG8_BAR;
#undef PG8_SA
#undef PG8_SB
#undef PG8_STAGE
#undef PG8_LDA
#undef PG8_LDB
#undef PG8_MMA
#undef PG8_BAR
#undef PG8_SCHED
}
template <class F>
DI void epi8_foreach(const f32x4 (&acc)[2][2][4][2], int m0, int n0, int wr, int wc, int fr, int fq, const F& f) {
#pragma unroll
  for (int ai = 0; ai < 2; ++ai)
#pragma unroll
    for (int m = 0; m < 4; ++m) {
      const int row = m0 + ai * 128 + wr * 64 + m * 16 + fr;
#pragma unroll
      for (int bj = 0; bj < 2; ++bj) f(row, n0 + bj * 128 + wc * 32 + 8 * fq, acc[ai][bj][m][0], acc[ai][bj][m][1]);
    }
}
DI void st_bf8(bfr* p, const f32x4& v0, const f32x4& v1) {
  u32x4 w;
  w[0] = pack2(v0[0], v0[1]); w[1] = pack2(v0[2], v0[3]); w[2] = pack2(v1[0], v1[1]); w[3] = pack2(v1[2], v1[3]);
  *(u32x4*)p = w;
}

DI void epi8_resid(const f32x4 (&acc)[2][2][4][2], int m0, int n0, int wr, int wc, int fr, int fq, const float* hsrc, float* hdst, bfr* hb, float* rowss) {
#pragma unroll
  for (int ai = 0; ai < 2; ++ai)
#pragma unroll
    for (int m = 0; m < 4; ++m) {
      const int row = m0 + ai * 128 + wr * 64 + m * 16 + fr;
      float ss = 0.f;
#pragma unroll
      for (int bj = 0; bj < 2; ++bj) {
        const int n = n0 + bj * 128 + wc * 32 + 8 * fq;
        const float* sp = hsrc + (size_t)row * 2048 + n;
        const f32x4 x0 = *(const f32x4*)sp, x1 = *(const f32x4*)(sp + 4);
        const f32x4 y0 = x0 + acc[ai][bj][m][0], y1 = x1 + acc[ai][bj][m][1];
        float* dp = hdst + (size_t)row * 2048 + n;
        *(f32x4*)dp = y0; *(f32x4*)(dp + 4) = y1;
        st_bf8(hb + (size_t)row * 2048 + n, y0, y1);
        ss += y0[0] * y0[0] + y0[1] * y0[1] + y0[2] * y0[2] + y0[3] * y0[3] + y1[0] * y1[0] + y1[1] * y1[1] + y1[2] * y1[2] + y1[3] * y1[3];
      }
      ss += __shfl_xor(ss, 16);
      ss += __shfl_xor(ss, 32);
      if (fq == 0) atomicAdd(rowss + row, ss);
    }
}
enum { MODE_WIN = 0, MODE_SEL = 1, MODE_X = 2, MODE_RET = 3 };
constexpr int KP = 136;

template <int MODE>
DI void attn_item(const Params& p, int item, char* smem, const int tid) {
  constexpr int VP = 136;
  bfr* Ks = (bfr*)smem;
  bfr* Vs = Ks + 64 * KP;
  const int w = tid >> 6, lane = tid & 63, r = lane & 31, h = lane >> 5;
  bfr* Qw = Vs + 64 * VP + w * 32 * KP;
  char* ws = p.ws;
  const bfr* z = (const bfr*)(ws + OFF_Z);

  int b, t0, tq0, jlo, jhi, head = 0, grp = 0, vh = 0;
  const bfr *qbase, *kbase, *vbase;
  int ldq, ldk;
  unsigned selm = 0, umask = 0xffffffffu;
  if (MODE == MODE_WIN) {
    const int tb = item >> 4, bg = item & 15;
    b = bg >> 2; grp = bg & 3; t0 = tb * 64; tq0 = t0 + 32 * (w >> 2); head = grp * 4 + (w & 3);
    qbase = z + (size_t)(b * SEQ + tq0) * ZS + ZC_Q + head * 128; ldq = ZS;
    kbase = z + (size_t)(b * SEQ) * ZS + ZC_KW + grp * 128;
    vbase = z + (size_t)(b * SEQ) * ZS + ZC_VW + grp * 128;
    ldk = ZS;
    jlo = (t0 - 511 > 0 ? t0 - 511 : 0) >> 6;
    jhi = tb;
  } else if (MODE == MODE_SEL) {
    const int tb = 31 - (item >> 4), bg = item & 15;
    b = bg >> 2; grp = bg & 3; t0 = tb * 64; tq0 = t0 + 32 * (w >> 2); head = grp * 4 + (w & 3);
    qbase = z + (size_t)(b * SEQ + tq0) * ZS + ZC_Q + head * 128; ldq = ZS;
    kbase = z + (size_t)(b * SEQ) * ZS + ZC_KS + grp * 128;
    vbase = z + (size_t)(b * SEQ) * ZS + ZC_VS + grp * 128;
    ldk = ZS;
    jlo = 0;
    jhi = tb;
    const unsigned* sm = (const unsigned*)(ws + OFF_SELM) + (b * 4 + grp) * SEQ;
    selm = sm[tq0 + r];
    unsigned u = sm[t0 + lane];
#pragma unroll
    for (int o = 32; o > 0; o >>= 1) u |= (unsigned)__shfl_xor((int)u, o);
    umask = (unsigned)__builtin_amdgcn_readfirstlane((int)u);
    umask &= (jhi >= 31) ? 0xffffffffu : ((1u << (jhi + 1)) - 1u);
  } else if (MODE == MODE_X) {
    const int tb = item >> 4, bh = item & 15;
    b = bh >> 2; head = bh & 3; t0 = tb * 256; tq0 = t0 + 32 * w;
    qbase = (const bfr*)(ws + OFF_QX) + (size_t)(b * SEQ + tq0) * 512 + head * 128; ldq = 512;
    kbase = (const bfr*)(ws + OFF_KX) + (size_t)(b * 256) * 512 + head * 128;
    vbase = (const bfr*)(ws + OFF_VX) + (size_t)(b * 256) * 512 + head * 128;
    ldk = 512;
    jlo = 0; jhi = 3;
  } else {
    const int tb = 7 - (item >> 6), rest = item & 63;
    b = rest >> 4; head = (rest >> 1) & 7; vh = rest & 1; t0 = tb * 256; tq0 = t0 + 32 * w;
    qbase = z + (size_t)(b * SEQ + tq0) * ZS + ZC_QR + head * 128; ldq = ZS;
    kbase = z + (size_t)(b * SEQ) * ZS + ZC_KR + head * 128;
    vbase = z + (size_t)(b * SEQ) * ZS + ZC_VR + head * 256 + vh * 128;
    ldk = ZS;
    jlo = 4 * tb; jhi = 4 * tb + 3;
  }
  const int tq = tq0 + r;

  f32x16 o[4];
#pragma unroll
  for (int dt = 0; dt < 4; ++dt)
#pragma unroll
    for (int i = 0; i < 16; ++i) o[dt][i] = 0.f;
  float m_run = -INFINITY, l_run = 0.f;
  float lg = 0.f;
  float rf[16];
  if (MODE == MODE_RET) {
    lg = log1pf(-exp2f(-5.f - (float)head)) * 1.4426950408889634f;
#pragma unroll
    for (int i = 0; i < 16; ++i) rf[i] = __builtin_amdgcn_exp2f(-lg * (float)crow(i, h));
  }

  u32x4 kreg[2], vreg[2];
  auto gload = [&](int j) {
    const int k0 = j * 64;
#pragma unroll
    for (int i = 0; i < 2; ++i) {
      const int c = tid + 512 * i, row = c >> 4, cc = c & 15;
      kreg[i] = *(const u32x4*)(kbase + (size_t)(k0 + row) * ldk + cc * 8);
      vreg[i] = *(const u32x4*)(vbase + (size_t)(k0 + row) * ldk + cc * 8);
    }
  };
  auto swrite = [&]() {
#pragma unroll
    for (int i = 0; i < 2; ++i) {
      const int c = tid + 512 * i, row = c >> 4, cc = c & 15;
      *(u32x4*)(Ks + row * KP + cc * 8) = kreg[i];
      *(u32x4*)(Vs + row * VP + cc * 8) = vreg[i];
    }
  };
  auto next_j = [&](int j) -> int {
    if (MODE == MODE_SEL) {
      const unsigned rem = (j >= 31) ? 0u : (umask & ~((2u << j) - 1u));
      return rem ? (__builtin_ctz(rem)) : 64;
    }
    return j + 1;
  };
  int j = jlo;
  if (MODE == MODE_SEL) j = __builtin_ctz(umask);
  gload(j);
  __syncthreads();
  {
    u32x4 qreg[8];
#pragma unroll
    for (int i = 0; i < 8; ++i) {
      const int c = lane + 64 * i, row = c >> 4, cc = c & 15;
      qreg[i] = *(const u32x4*)(qbase + (size_t)row * ldq + cc * 8);
    }
#pragma unroll
    for (int i = 0; i < 8; ++i) {
      const int c = lane + 64 * i, row = c >> 4, cc = c & 15;
      *(u32x4*)(Qw + row * KP + cc * 8) = qreg[i];
    }
  }
  const float csc = 0.08838834764831845f * 1.4426950408889634f;
  const int q4 = (lane & 15) >> 2, p4 = lane & 3, blk = (lane >> 4) & 1;
  if (MODE == MODE_RET) {
    const int c = t0 >> 8;
    if (c > 0) {
      bfr* Sb = Vs + 64 * VP + 8 * 32 * KP;
      const float* kvb = (const float*)(ws + OFF_RKV) + (size_t)((b * 8 + head) * 7) * (128 * 256) + vh * 128;
      const float g256 = __builtin_amdgcn_exp2f(lg * 256.f);
#pragma unroll 1
      for (int g = 0; g < 2; ++g) {
        f32x4 sum[4];
#pragma unroll
        for (int i = 0; i < 4; ++i) sum[i] = (f32x4){0.f, 0.f, 0.f, 0.f};
        float fac = 1.f;
#pragma unroll 1
        for (int jj = c - 1; jj >= 0; --jj) {
          const float* kj = kvb + (size_t)jj * (128 * 256);
          f32x4 kv[4];
#pragma unroll
          for (int i = 0; i < 4; ++i) { const int e4 = tid + 512 * (4 * g + i); kv[i] = *(const f32x4*)(kj + (e4 >> 5) * 256 + (e4 & 31) * 4); }
#pragma unroll
          for (int i = 0; i < 4; ++i) sum[i] += kv[i] * fac;
          fac *= g256;
        }
#pragma unroll
        for (int i = 0; i < 4; ++i) { const int e4 = tid + 512 * (4 * g + i); st_bf4(Sb + (e4 >> 5) * KP + (e4 & 31) * 4, sum[i][0], sum[i][1], sum[i][2], sum[i][3]); }
      }
      __syncthreads();
#pragma unroll
      for (int s = 0; s < 8; ++s) {
        const bf16x8 qf = *(const bf16x8*)(Qw + r * KP + 16 * s + 8 * h);
#pragma unroll
        for (int dt = 0; dt < 4; ++dt) {
          const bfr* sp = Sb + (16 * s + 8 * h + q4) * KP + 32 * dt + 16 * blk + 4 * p4;
          const s16x4 lo = tr_read(sp);
          const s16x4 hi = tr_read(sp + 4 * KP);
          const bf16x8 sf = __builtin_shufflevector(lo, hi, 0, 1, 2, 3, 4, 5, 6, 7);
          o[dt] = MFMA(sf, qf, o[dt]);
        }
      }
      const float fq_ = __builtin_amdgcn_exp2f(lg * (float)(tq - t0 + 1));
#pragma unroll
      for (int dt = 0; dt < 4; ++dt)
#pragma unroll
        for (int i = 0; i < 16; ++i) o[dt][i] *= fq_;
    }
  }
  bool first = true;
#pragma unroll 1
  while (j <= jhi) {
    if (!first) __syncthreads();
    first = false;
    swrite();
    __syncthreads();
    const int jn = next_j(j);
    if (jn <= jhi) gload(jn);
    const int k0 = j * 64;
    if (MODE == MODE_RET && k0 > tq0 + 31) { j = jn; continue; }
    bf16x8 pf[2][2];
    if (MODE == MODE_RET) {
#pragma unroll
      for (int sub = 0; sub < 2; ++sub) {
        f32x16 sx;
#pragma unroll
        for (int i = 0; i < 16; ++i) sx[i] = 0.f;
#pragma unroll
        for (int s = 0; s < 8; ++s) {
          const bf16x8 kf = *(const bf16x8*)(Ks + (32 * sub + r) * KP + 16 * s + 8 * h);
          const bf16x8 qf = *(const bf16x8*)(Qw + r * KP + 16 * s + 8 * h);
          sx = MFMA(kf, qf, sx);
        }
        {
          const int dq = tq - (k0 + 32 * sub);
          const float cf = __builtin_amdgcn_exp2f(lg * (float)dq);
#pragma unroll
          for (int i = 0; i < 16; ++i) sx[i] = (crow(i, h) <= dq) ? sx[i] * (cf * rf[i]) : 0.f;
        }
        pf[sub][0] = pack8(sx, 0);
        pf[sub][1] = pack8(sx, 1);
      }
    } else {
      f32x16 s0, s1;
#pragma unroll
      for (int i = 0; i < 16; ++i) { s0[i] = 0.f; s1[i] = 0.f; }
#pragma unroll
      for (int s = 0; s < 8; ++s) {
        const bf16x8 k0f = *(const bf16x8*)(Ks + r * KP + 16 * s + 8 * h);
        const bf16x8 k1f = *(const bf16x8*)(Ks + (32 + r) * KP + 16 * s + 8 * h);
        const bf16x8 qf = *(const bf16x8*)(Qw + r * KP + 16 * s + 8 * h);
        s0 = MFMA(k0f, qf, s0);
        s1 = MFMA(k1f, qf, s1);
      }
      bool need_mask = false;
      if (MODE == MODE_WIN) need_mask = (k0 + 63 > tq0) || (k0 < tq0 + 31 - 511);
      if (MODE == MODE_SEL) need_mask = (k0 + 63 > tq0);
      const bool lanesel = (MODE == MODE_SEL) ? ((selm >> j) & 1u) : true;
      float mx = -INFINITY;
      if (need_mask) {
#pragma unroll
        for (int i = 0; i < 16; ++i) {
          const int tk0 = k0 + crow(i, h), tk1 = tk0 + 32;
          bool ok0 = true, ok1 = true;
          if (MODE == MODE_WIN) { ok0 = (tk0 <= tq) && (tq - tk0 < 512); ok1 = (tk1 <= tq) && (tq - tk1 < 512); }
          if (MODE == MODE_SEL) { ok0 = lanesel && (tk0 <= tq); ok1 = lanesel && (tk1 <= tq); }
          s0[i] = ok0 ? s0[i] * csc : -INFINITY;
          s1[i] = ok1 ? s1[i] * csc : -INFINITY;
          mx = fmaxf(mx, fmaxf(s0[i], s1[i]));
        }
      } else {
#pragma unroll
        for (int i = 0; i < 16; ++i) {
          s0[i] = lanesel ? s0[i] * csc : -INFINITY;
          s1[i] = lanesel ? s1[i] * csc : -INFINITY;
          mx = fmaxf(mx, fmaxf(s0[i], s1[i]));
        }
      }
      mx = fmaxf(mx, __shfl_xor(mx, 32));
      const float mnew = fmaxf(m_run, mx);
      const float muse = (mnew == -INFINITY) ? 0.f : mnew;
      const float alpha = __builtin_amdgcn_exp2f(m_run - muse);
      float ls = 0.f;
#pragma unroll
      for (int i = 0; i < 16; ++i) {
        s0[i] = __builtin_amdgcn_exp2f(s0[i] - muse);
        s1[i] = __builtin_amdgcn_exp2f(s1[i] - muse);
        ls += s0[i] + s1[i];
      }
      ls += __shfl_xor(ls, 32);
      l_run = l_run * alpha + ls;
      m_run = mnew;
      if (__builtin_amdgcn_ballot_w64(alpha != 1.f) != 0) {
#pragma unroll
        for (int dt = 0; dt < 4; ++dt)
#pragma unroll
          for (int i = 0; i < 16; ++i) o[dt][i] *= alpha;
      }
      pf[0][0] = pack8(s0, 0); pf[0][1] = pack8(s0, 1);
      pf[1][0] = pack8(s1, 0); pf[1][1] = pack8(s1, 1);
    }
#pragma unroll
    for (int dt = 0; dt < 4; ++dt)
#pragma unroll
      for (int sub = 0; sub < 2; ++sub)
#pragma unroll
        for (int st = 0; st < 2; ++st) {
          const int key0 = 32 * sub + 16 * st + 4 * h;
          const bfr* vp = Vs + (key0 + q4) * VP + 32 * dt + 16 * blk + 4 * p4;
          const s16x4 lo = tr_read(vp);
          const s16x4 hi = tr_read(vp + 8 * VP);
          const bf16x8 vf = __builtin_shufflevector(lo, hi, 0, 1, 2, 3, 4, 5, 6, 7);
          o[dt] = MFMA(vf, pf[sub][st], o[dt]);
        }
    j = jn;
  }

  if (MODE == MODE_SEL && p.dbg) return;
  const size_t mrow = (size_t)(b * SEQ + tq);
  if (MODE == MODE_WIN || MODE == MODE_SEL) {
    const float inv = (l_run > 0.f) ? 1.f / l_run : 0.f;
    const float gate = bflo(z[mrow * ZS + ZC_GN + head * 3 + (MODE == MODE_WIN ? 2 : 1)]);
    bfr* orow = (bfr*)(ws + OFF_ONSA) + mrow * 2048 + head * 128;
    const float sc = inv * gate;
#pragma unroll
    for (int dt = 0; dt < 4; ++dt)
#pragma unroll
      for (int g = 0; g < 4; ++g) {
        bfr* dst = orow + 32 * dt + 8 * g + 4 * h;
        float a = o[dt][4 * g] * sc, bb = o[dt][4 * g + 1] * sc, c = o[dt][4 * g + 2] * sc, d = o[dt][4 * g + 3] * sc;
        if (MODE == MODE_SEL) {
          const uint2 old = *(const uint2*)dst;
          a += bflo(old.x); bb += bfhi(old.x); c += bflo(old.y); d += bfhi(old.y);
        }
        st_bf4(dst, a, bb, c, d);
      }
  } else if (MODE == MODE_X) {
    const float inv = 1.f / l_run;
    bfr* orow = (bfr*)(ws + OFF_OX) + mrow * 512 + head * 128;
#pragma unroll
    for (int dt = 0; dt < 4; ++dt)
#pragma unroll
      for (int g = 0; g < 4; ++g)
        st_bf4(orow + 32 * dt + 8 * g + 4 * h, o[dt][4 * g] * inv, o[dt][4 * g + 1] * inv, o[dt][4 * g + 2] * inv,
               o[dt][4 * g + 3] * inv);
  } else {
    float sm = 0.f, sq = 0.f;
#pragma unroll
    for (int dt = 0; dt < 4; ++dt)
#pragma unroll
      for (int i = 0; i < 16; ++i) { sm += o[dt][i]; sq += o[dt][i] * o[dt][i]; }
    sm += __shfl_xor(sm, 32);
    sq += __shfl_xor(sq, 32);
    if (h == 0) *(float2*)((float*)(ws + OFF_RSTAT) + ((mrow * 8 + head) * 2 + vh) * 2) = make_float2(sm, sq);
    bfr* orow = (bfr*)(ws + OFF_ORET) + mrow * 2048 + head * 256 + vh * 128;
#pragma unroll
    for (int dt = 0; dt < 4; ++dt)
#pragma unroll
      for (int g = 0; g < 4; ++g)
        st_bf4(orow + 32 * dt + 8 * g + 4 * h, o[dt][4 * g], o[dt][4 * g + 1], o[dt][4 * g + 2], o[dt][4 * g + 3]);
  }
}

DI void retkv_item(const Params& p, int item, char* smem, const int tid) {
  constexpr int VPW = 264;
  bfr* Kt = (bfr*)smem;
  bfr* Vt = Kt + 64 * KP;
  const int w = tid >> 6, lane = tid & 63, r = lane & 31, h = lane >> 5;
  const int c = item % 7, bh = item / 7, b = bh >> 3, head = bh & 7;
  char* ws = p.ws;
  const bfr* z = (const bfr*)(ws + OFF_Z);
  const bfr* kbase = z + (size_t)(b * SEQ + 256 * c) * ZS + ZC_KR + head * 128;
  const bfr* vbase = z + (size_t)(b * SEQ + 256 * c) * ZS + ZC_VR + head * 256;
  const float lg = log1pf(-exp2f(-5.f - (float)head)) * 1.4426950408889634f;
  const int dtile = w & 3, ehalf = w >> 2;
  const int q4 = (lane & 15) >> 2, p4 = lane & 3, blk = (lane >> 4) & 1;
  f32x16 acc[4];
#pragma unroll
  for (int et = 0; et < 4; ++et)
#pragma unroll
    for (int i = 0; i < 16; ++i) acc[et][i] = 0.f;
  float wj[8];
#pragma unroll
  for (int j = 0; j < 8; ++j) wj[j] = __builtin_amdgcn_exp2f(-lg * (float)j);
#pragma unroll 1
  for (int t = 0; t < 4; ++t) {
    u32x4 kr[2], vr[4];
#pragma unroll
    for (int i = 0; i < 2; ++i) {
      const int ch = tid + 512 * i, row = ch >> 4, cc = ch & 15;
      kr[i] = *(const u32x4*)(kbase + (size_t)(64 * t + row) * ZS + cc * 8);
    }
#pragma unroll
    for (int i = 0; i < 4; ++i) {
      const int ch = tid + 512 * i, row = ch >> 5, cc = ch & 31;
      vr[i] = *(const u32x4*)(vbase + (size_t)(64 * t + row) * ZS + cc * 8);
    }
    __syncthreads();
#pragma unroll
    for (int i = 0; i < 2; ++i) {
      const int ch = tid + 512 * i, row = ch >> 4, cc = ch & 15;
      *(u32x4*)(Kt + row * KP + cc * 8) = kr[i];
    }
#pragma unroll
    for (int i = 0; i < 4; ++i) {
      const int ch = tid + 512 * i, row = ch >> 5, cc = ch & 31;
      *(u32x4*)(Vt + row * VPW + cc * 8) = vr[i];
    }
    __syncthreads();
#pragma unroll
    for (int st = 0; st < 4; ++st) {
      const int m0 = 16 * st + 8 * h;
      const bfr* kp = Kt + (m0 + q4) * KP + 32 * dtile + 16 * blk + 4 * p4;
      const s16x4 klo = tr_read(kp);
      const s16x4 khi = tr_read(kp + 4 * KP);
      typedef unsigned u4_ __attribute__((ext_vector_type(4)));
      const u4_ ku = __builtin_bit_cast(u4_, __builtin_shufflevector(klo, khi, 0, 1, 2, 3, 4, 5, 6, 7));
      const float wb = __builtin_amdgcn_exp2f(lg * (float)(255 - 64 * t - m0));
      u4_ ks;
#pragma unroll
      for (int k = 0; k < 4; ++k) ks[k] = pack2(bflo(ku[k]) * (wb * wj[2 * k]), bfhi(ku[k]) * (wb * wj[2 * k + 1]));
      const bf16x8 af = __builtin_bit_cast(bf16x8, ks);
#pragma unroll
      for (int et = 0; et < 4; ++et) {
        const bfr* vp = Vt + (m0 + q4) * VPW + 128 * ehalf + 32 * et + 16 * blk + 4 * p4;
        const s16x4 vlo = tr_read(vp);
        const s16x4 vhi = tr_read(vp + 4 * VPW);
        const bf16x8 vf = __builtin_shufflevector(vlo, vhi, 0, 1, 2, 3, 4, 5, 6, 7);
        acc[et] = MFMA(af, vf, acc[et]);
      }
    }
  }
  float* kv = (float*)(ws + OFF_RKV) + (size_t)item * (128 * 256);
#pragma unroll
  for (int et = 0; et < 4; ++et)
#pragma unroll
    for (int i = 0; i < 16; ++i) kv[(32 * dtile + crow(i, h)) * 256 + 128 * ehalf + 32 * et + r] = acc[et][i];
  __syncthreads();
}

DI void ret_finish_row(const Params& p, int row, const int t) {
  char* ws = p.ws;
  const bfr* z = (const bfr*)(ws + OFF_Z);
  const int col = t * 8, head = t >> 5;
  const float4 st = *(const float4*)((const float*)(ws + OFF_RSTAT) + ((size_t)row * 8 + head) * 4);
  const float mu = (st.x + st.z) * (1.f / 256.f);
  const float var = fmaxf((st.y + st.w) * (1.f / 256.f) - mu * mu, 0.f);
  const float rstd = rsqrtf(var + 1e-6f);
  bfr* op = (bfr*)(ws + OFF_ORET) + (size_t)row * 2048 + col;
  const u32x4 ov = *(const u32x4*)op;
  const u32x4 gv = *(const u32x4*)(z + (size_t)row * ZS + ZC_GR + col);
  const float4 w0 = *(const float4*)(p.gn_w + col), w1 = *(const float4*)(p.gn_w + col + 4);
  u32x4 res;
  res[0] = pack2((bflo(ov[0]) - mu) * rstd * w0.x * bflo(gv[0]), (bfhi(ov[0]) - mu) * rstd * w0.y * bfhi(gv[0]));
  res[1] = pack2((bflo(ov[1]) - mu) * rstd * w0.z * bflo(gv[1]), (bfhi(ov[1]) - mu) * rstd * w0.w * bfhi(gv[1]));
  res[2] = pack2((bflo(ov[2]) - mu) * rstd * w1.x * bflo(gv[2]), (bfhi(ov[2]) - mu) * rstd * w1.y * bfhi(gv[2]));
  res[3] = pack2((bflo(ov[3]) - mu) * rstd * w1.z * bflo(gv[3]), (bfhi(ov[3]) - mu) * rstd * w1.w * bfhi(gv[3]));
  *(u32x4*)op = res;
}

DI void ret_finish_rows4(const Params& p, int row0, const int t) {
  char* ws = p.ws;
  const bfr* z = (const bfr*)(ws + OFF_Z);
  const int col = t * 8, head = t >> 5;
  float4 st[4];
  u32x4 ov[4], gv[4];
#pragma unroll
  for (int q = 0; q < 4; ++q) {
    const size_t row = (size_t)(row0 + 2 * q);
    st[q] = *(const float4*)((const float*)(ws + OFF_RSTAT) + (row * 8 + head) * 4);
    ov[q] = *(const u32x4*)((const bfr*)(ws + OFF_ORET) + row * 2048 + col);
    gv[q] = *(const u32x4*)(z + row * ZS + ZC_GR + col);
  }
  const float4 w0 = *(const float4*)(p.gn_w + col), w1 = *(const float4*)(p.gn_w + col + 4);
#pragma unroll
  for (int q = 0; q < 4; ++q) {
    const float mu = (st[q].x + st[q].z) * (1.f / 256.f);
    const float var = fmaxf((st[q].y + st[q].w) * (1.f / 256.f) - mu * mu, 0.f);
    const float rstd = rsqrtf(var + 1e-6f);
    u32x4 res;
    res[0] = pack2((bflo(ov[q][0]) - mu) * rstd * w0.x * bflo(gv[q][0]), (bfhi(ov[q][0]) - mu) * rstd * w0.y * bfhi(gv[q][0]));
    res[1] = pack2((bflo(ov[q][1]) - mu) * rstd * w0.z * bflo(gv[q][1]), (bfhi(ov[q][1]) - mu) * rstd * w0.w * bfhi(gv[q][1]));
    res[2] = pack2((bflo(ov[q][2]) - mu) * rstd * w1.x * bflo(gv[q][2]), (bfhi(ov[q][2]) - mu) * rstd * w1.y * bfhi(gv[q][2]));
    res[3] = pack2((bflo(ov[q][3]) - mu) * rstd * w1.z * bflo(gv[q][3]), (bfhi(ov[q][3]) - mu) * rstd * w1.w * bfhi(gv[q][3]));
    *(u32x4*)((bfr*)(ws + OFF_ORET) + (size_t)(row0 + 2 * q) * 2048 + col) = res;
  }
}

DI void cmp_item(const Params& p, int item, char* smem, const int tid) {
  bfr* Ks = (bfr*)smem;
  float* impw = (float*)(smem + 128 * KP * 2);
  const int w = tid >> 6, lane = tid & 63, r = lane & 31, h = lane >> 5;
  char* ws = p.ws;
  const bfr* z = (const bfr*)(ws + OFF_Z);
  const int tb = item >> 4, bg = item & 15, b = bg >> 2, grp = bg & 3;
  const int t0 = tb * 64, ti = 32 * (w >> 2) + r, tq = t0 + ti, hw = w & 3, head = grp * 4 + hw;
  const bfr* qrow = z + (size_t)(b * SEQ + tq) * ZS + ZC_Q + head * 128;
  const bfr* kc = (const bfr*)(ws + OFF_KCVC) + (size_t)((b * 4 + grp) * 128) * 128;
  const bfr* vc = kc + (size_t)2048 * 128;
  bf16x8 qf[8];
#pragma unroll
  for (int s = 0; s < 8; ++s) qf[s] = *(const bf16x8*)(qrow + 16 * s + 8 * h);
  u32x4 reg[4];
#pragma unroll
  for (int i = 0; i < 4; ++i) {
    const int c = tid + 512 * i, row = c >> 4, cc = c & 15;
    reg[i] = *(const u32x4*)(kc + row * 128 + cc * 8);
  }
  __syncthreads();
#pragma unroll
  for (int i = 0; i < 4; ++i) {
    const int c = tid + 512 * i, row = c >> 4, cc = c & 15;
    *(u32x4*)(Ks + row * KP + cc * 8) = reg[i];
  }
  __syncthreads();
  f32x16 s[4];
#pragma unroll
  for (int kt = 0; kt < 4; ++kt) {
#pragma unroll
    for (int i = 0; i < 16; ++i) s[kt][i] = 0.f;
#pragma unroll
    for (int ss = 0; ss < 8; ++ss) {
      const bf16x8 kf = *(const bf16x8*)(Ks + (32 * kt + r) * KP + 16 * ss + 8 * h);
      s[kt] = MFMA(kf, qf[ss], s[kt]);
    }
  }
  const float csc = 0.08838834764831845f * 1.4426950408889634f;
  float mx = -INFINITY;
#pragma unroll
  for (int kt = 0; kt < 4; ++kt)
#pragma unroll
    for (int i = 0; i < 16; ++i) {
      const int c = 32 * kt + crow(i, h);
      const bool ok = (c * 16 + 31 <= tq) && (c < 127);
      s[kt][i] = ok ? s[kt][i] * csc : -INFINITY;
      mx = fmaxf(mx, s[kt][i]);
    }
  mx = fmaxf(mx, __shfl_xor(mx, 32));
  const float muse = (mx == -INFINITY) ? 0.f : mx;
  float ls = 0.f;
#pragma unroll
  for (int kt = 0; kt < 4; ++kt)
#pragma unroll
    for (int i = 0; i < 16; ++i) {
      s[kt][i] = __builtin_amdgcn_exp2f(s[kt][i] - muse);
      ls += s[kt][i];
    }
  ls += __shfl_xor(ls, 32);
  const float inv = (ls > 0.f) ? 1.f / ls : 0.f;
#pragma unroll
  for (int kt = 0; kt < 4; ++kt)
#pragma unroll
    for (int i = 0; i < 16; ++i) s[kt][i] *= inv;
  float plast[16];
#pragma unroll
  for (int kt = 0; kt < 4; ++kt)
#pragma unroll
    for (int g = 0; g < 4; ++g) plast[kt * 4 + g] = __shfl_xor(s[kt][4 * g + 3], 32);
#pragma unroll
  for (int kt = 0; kt < 4; ++kt)
#pragma unroll
    for (int g = 0; g < 4; ++g) {
      const int slot = kt * 4 + g;
      const float sum4 = s[kt][4 * g] + s[kt][4 * g + 1] + s[kt][4 * g + 2] + s[kt][4 * g + 3];
      const float prevl = (slot > 0) ? plast[slot > 0 ? slot - 1 : 0] : 0.f;
      const float add = h ? plast[slot] : prevl;
      impw[(hw * 64 + ti) * 32 + 8 * kt + 2 * g + h] = sum4 + add;
    }
  bf16x8 pf[4][2];
#pragma unroll
  for (int kt = 0; kt < 4; ++kt) { pf[kt][0] = pack8(s[kt], 0); pf[kt][1] = pack8(s[kt], 1); }
#pragma unroll
  for (int i = 0; i < 4; ++i) {
    const int c = tid + 512 * i, row = c >> 4, cc = c & 15;
    reg[i] = *(const u32x4*)(vc + row * 128 + cc * 8);
  }
  __syncthreads();
#pragma unroll
  for (int i = 0; i < 4; ++i) {
    const int c = tid + 512 * i, row = c >> 4, cc = c & 15;
    *(u32x4*)(Ks + row * KP + cc * 8) = reg[i];
  }
  __syncthreads();
  f32x16 o[4];
#pragma unroll
  for (int dt = 0; dt < 4; ++dt)
#pragma unroll
    for (int i = 0; i < 16; ++i) o[dt][i] = 0.f;
  const int q4 = (lane & 15) >> 2, p4 = lane & 3, blk = (lane >> 4) & 1;
#pragma unroll
  for (int dt = 0; dt < 4; ++dt)
#pragma unroll
    for (int kt = 0; kt < 4; ++kt)
#pragma unroll
      for (int st = 0; st < 2; ++st) {
        const int key0 = 32 * kt + 16 * st + 4 * h;
        const bfr* vp = Ks + (key0 + q4) * KP + 32 * dt + 16 * blk + 4 * p4;
        const s16x4 lo = tr_read(vp);
        const s16x4 hi = tr_read(vp + 8 * KP);
        const bf16x8 vf = __builtin_shufflevector(lo, hi, 0, 1, 2, 3, 4, 5, 6, 7);
        o[dt] = MFMA(vf, pf[kt][st], o[dt]);
      }
  {
    const size_t mrow = (size_t)(b * SEQ + tq);
    const float gate = bflo(z[mrow * ZS + ZC_GN + head * 3 + 0]);
    bfr* orow = (bfr*)(ws + OFF_ONSA) + mrow * 2048 + head * 128;
#pragma unroll
    for (int dt = 0; dt < 4; ++dt)
#pragma unroll
      for (int g = 0; g < 4; ++g) {
        bfr* dst = orow + 32 * dt + 8 * g + 4 * h;
        const uint2 old = *(const uint2*)dst;
        st_bf4(dst, o[dt][4 * g] * gate + bflo(old.x), o[dt][4 * g + 1] * gate + bfhi(old.x),
               o[dt][4 * g + 2] * gate + bflo(old.y), o[dt][4 * g + 3] * gate + bfhi(old.y));
      }
  }
  {
    const int i = tid >> 3, jg = tid & 7;
    const int cur = (t0 + i) >> 6;
    float vm[4];
#pragma unroll
    for (int e = 0; e < 4; ++e) {
      const int jme = 4 * jg + e;
      const float a = impw[(0 * 64 + i) * 32 + jme] + impw[(1 * 64 + i) * 32 + jme] + impw[(2 * 64 + i) * 32 + jme] + impw[(3 * 64 + i) * 32 + jme];
      const bool forced = (jme == 0) || (jme == cur) || (jme == cur - 1);
      vm[e] = forced ? INFINITY : ((jme > cur) ? -INFINITY : a);
    }
#pragma unroll
    for (int e = 0; e < 4; ++e) impw[i * 32 + 4 * jg + e] = vm[e];
    __syncthreads();
    int rank[4] = {0, 0, 0, 0};
#pragma unroll 4
    for (int k = 0; k < 32; ++k) {
      const float vk = impw[i * 32 + k];
#pragma unroll
      for (int e = 0; e < 4; ++e) rank[e] += (vk > vm[e] || (vk == vm[e] && k < 4 * jg + e)) ? 1 : 0;
    }
    unsigned bits = 0;
#pragma unroll
    for (int e = 0; e < 4; ++e)
      if (rank[e] < 16 && 4 * jg + e <= cur) bits |= 1u << (4 * jg + e);
    bits |= (unsigned)__shfl_xor((int)bits, 1);
    bits |= (unsigned)__shfl_xor((int)bits, 2);
    bits |= (unsigned)__shfl_xor((int)bits, 4);
    if (jg == 0) ((unsigned*)(ws + OFF_SELM))[(b * 4 + grp) * SEQ + t0 + i] = bits;
  }
  __syncthreads();
}

typedef __attribute__((address_space(3))) volatile int lds_vi;
DI lds_vi* grab_word() { __shared__ int gw[4]; return (lds_vi*)gw; }
DI int grab(unsigned* ctr, int*  , const int tid) {
  lds_vi* sl = grab_word();
  __syncthreads();
  if (tid == 0) *sl = (int)atomicAdd(ctr, 1u);
  __syncthreads();
  return *sl;
}

DI void run_phase(const Params& p0, int ph, char* smem, int* slot, const int wave_s, const int rep) {
  char* ws = p0.ws;
  asm volatile("" : "+s"(ws));
  Params p = p0;
  p.ws = ws;
  p.dbg = rep;
  const int G = gridDim.x;
  int bid = blockIdx.x;
  int tid = wave_s * 64 + (int)__builtin_amdgcn_mbcnt_hi(~0u, __builtin_amdgcn_mbcnt_lo(~0u, 0u));
  asm volatile("" : "+s"(bid));
  asm volatile("" : "+v"(tid));
  bfr* z = (bfr*)(ws + OFF_Z);
  unsigned* ctr = (unsigned*)(ws + OFF_CTR) + rep * 8;
  switch (ph) {
    case 0: {
      if (bid == 0 && tid < 64) ((unsigned*)(ws + OFF_CTR))[tid] = 0u;
      if (bid < (2 * NTOK) / NTHR) ((float*)(ws + OFF_ROWSS))[bid * NTHR + tid] = 0.f;
      int tot = 0;
      for (int j = 0; j < 6; ++j) tot += tjob_tiles(j);
      const int n_norm = 1024 + 128, n_rope = 256;
      tr_run(p, 0, bid, G, tot, (float*)smem, tid);
      for (int it = tot + bid; it < tot + n_norm + n_rope; it += G) {
        if (it < tot + n_norm) {
          const int row = (it - tot) * 8 + (tid >> 6);
          if (row < NTOK) rmsnorm_row(p.x + (size_t)row * 2048, p.attn_norm_w, (bfr*)(ws + OFF_N) + (size_t)row * 2048, nullptr, tid);
          else rmsnorm_row(p.mem + (size_t)(row - NTOK) * 2048, p.mem_norm_w, (bfr*)(ws + OFF_MN) + (size_t)(row - NTOK) * 2048, nullptr, tid);
        } else {
          const int e = (it - tot - n_norm) * 512 + tid;
          const int t = e >> 6, i = e & 63;
          const float ang = (float)t * ROPE_INV[i];
          const float kk = rintf(ang * 0.15915494309189535f);
          float rr = fmaf(-kk, 6.2831854820251465f, ang);
          rr = fmaf(-kk, -1.7484555e-7f, rr);
          const float fr = rr * 0.15915494309189535f;
          ((float2*)(ws + OFF_ROPE))[e] = make_float2(__builtin_amdgcn_cosf(fr), __builtin_amdgcn_sinf(fr));
        }
      }
    } break;
    case 1: {
      {
        bfr* zcb = (bfr*)(ws + OFF_ZC);
        const float* rope = (const float*)(ws + OFF_ROPE);
        gemm8_phase(smem, (const bfr*)(ws + OFF_N), (const bfr*)(ws + OFF_WINT), 2048, 32 * 61, G, bid, tid,
          [&](const f32x4 (&acc)[2][2][4][2], int m0, int n0, int wr, int wc, int fr, int fq) {
            if (n0 < ZC_KC || (n0 >= ZC_KS && n0 < ZC_QR) || (n0 >= ZC_VR && n0 < ZC_GR)) {
              epi8_foreach(acc, m0, n0, wr, wc, fr, fq, [&](int m, int n, const f32x4& v0, const f32x4& v1) { st_bf8(z + (size_t)m * ZS + n, v0, v1); });
            } else if (n0 < ZC_KS) {
              const float* pe = (n0 < ZC_VC) ? p.pe_k : p.pe_v;
              epi8_foreach(acc, m0, n0, wr, wc, fr, fq, [&](int m, int n, const f32x4& v0, const f32x4& v1) {
                const int t = m & 2047, dd = n & 127;
                const float* pl = pe + (t & 15) * 128 + dd;
                const float* ph_ = pl + 16 * 128;
                const f32x4 l0 = *(const f32x4*)pl, l1 = *(const f32x4*)(pl + 4), h0 = *(const f32x4*)ph_, h1 = *(const f32x4*)(ph_ + 4);
                bfr* d = zcb + (size_t)m * 2048 + (n - ZC_KC);
                st_bf8(d, v0 + l0, v1 + l1);
                st_bf8(d + 1024, v0 + h0, v1 + h1);
              });
            } else if (n0 < ZC_VR) {
              const float sc = (n0 >= ZC_KR) ? 0.08838834764831845f : 1.f;
              epi8_foreach(acc, m0, n0, wr, wc, fr, fq, [&](int m, int n, const f32x4& v0, const f32x4& v1) {
                const int t = m & 2047, i0 = (n & 127) >> 1;
                const float* rp = rope + (size_t)(t * 64 + i0) * 2;
                const f32x4 c01 = *(const f32x4*)rp, c23 = *(const f32x4*)(rp + 4);
                f32x4 a0, a1;
                a0[0] = (v0[0] * c01[0] - v0[1] * c01[1]) * sc; a0[1] = (v0[0] * c01[1] + v0[1] * c01[0]) * sc;
                a0[2] = (v0[2] * c01[2] - v0[3] * c01[3]) * sc; a0[3] = (v0[2] * c01[3] + v0[3] * c01[2]) * sc;
                a1[0] = (v1[0] * c23[0] - v1[1] * c23[1]) * sc; a1[1] = (v1[0] * c23[1] + v1[1] * c23[0]) * sc;
                a1[2] = (v1[2] * c23[2] - v1[3] * c23[3]) * sc; a1[3] = (v1[2] * c23[3] + v1[3] * c23[2]) * sc;
                st_bf8(z + (size_t)m * ZS + n, a0, a1);
              });
            } else if (n0 < ZC_GA) {
              epi8_foreach(acc, m0, n0, wr, wc, fr, fq, [&](int m, int n, const f32x4& v0, const f32x4& v1) {
                f32x4 a0, a1;
#pragma unroll
                for (int j = 0; j < 4; ++j) { a0[j] = v0[j] * sigmoidf_(v0[j]); a1[j] = v1[j] * sigmoidf_(v1[j]); }
                st_bf8(z + (size_t)m * ZS + n, a0, a1);
              });
            } else {
              epi8_foreach(acc, m0, n0, wr, wc, fr, fq, [&](int m, int n, const f32x4& v0, const f32x4& v1) {
                if (n >= ZS) return;
                f32x4 a0, a1;
#pragma unroll
                for (int j = 0; j < 4; ++j) { a0[j] = sigmoidf_(v0[j]); a1[j] = sigmoidf_(v1[j]); }
                st_bf8(z + (size_t)m * ZS + n, a0, a1);
              });
            }
          });
      }
      {
        const int nunits = 32 * 61;
        const int nlong = (nunits % G == 0) ? 0 : nunits % G;
        const int nshort = G - nlong;
        const int sb_ = bid - nlong;
        if (sb_ >= 0) {
          for (int u = sb_; u < 32; u += nshort) {
            f32x16 acc[1][4];
            acc_zero<1>(acc);
            const int which = u >> 4, mt = (u & 15) >> 2, nt = u & 3;
            const int m0 = mt * 256, n0 = nt * 128;
            PlainPtr af{(const bfr*)(ws + OFF_MN) + (size_t)m0 * 2048, 2048};
            PlainPtr bf{(const bfr*)(ws + (which ? OFF_WVT : OFF_WKT)) + (size_t)n0 * 2048, 2048};
            gemm_main<1>(acc, af, bf, 32, smem, tid);
            bfr* dstb = (bfr*)(ws + (which ? OFF_VX : OFF_KX));
            gemm_epi<1>(acc, m0, n0, tid, [&](int m, int n, float a, float b, float c, float d) { st_bf4(dstb + (size_t)m * 512 + n, a, b, c, d); });
          }
          int tot2 = 0;
          for (int j = 6; j < 12; ++j) tot2 += tjob_tiles(j);
          tr_run(p, 6, sb_, nshort, tot2, (float*)smem, tid);
        }
      }
    } break;
    case 2: {
      for (int it = grab(ctr + 0, slot, tid); it < 128; it = grab(ctr + 0, slot, tid)) {
        const int which = it >> 6, mt = (it & 63) >> 3, nt = it & 7;
        const int m0 = mt * 256, n0 = nt * 128;
        f32x16 acc[1][4];
        acc_zero<1>(acc);
        struct GatherA {
          const bfr* base; int m0;
          DI int rowoff(int row) const {
            const int R = m0 + row;
            const int bb = R >> 9, g = (R >> 7) & 3;
            int c = R & 127; c = c > 126 ? 126 : c;
            return (bb * SEQ + c * 16) * 2048 + g * 128;
          }
          DI int koff(int kk) const { const int l = kk >> 7; return l * 2048 + ((l >> 4) << 10) + (kk & 127); }
        };
        GatherA af{(const bfr*)(ws + OFF_ZC) + which * 512, m0};
        PlainPtr bf{(const bfr*)(ws + OFF_W1T) + (size_t)which * 1024 * 4096 + (size_t)n0 * 4096, 4096};
        gemm_main<1>(acc, af, bf, 64, smem, tid);
        bfr* hid = (bfr*)(ws + OFF_HIDC) + (size_t)which * 2048 * 1024;
        gemm_epi<1>(acc, m0, n0, tid, [&](int m, int n, float a, float b, float c, float d) {
          st_bf4(hid + (size_t)m * 1024 + n, a * sigmoidf_(a), b * sigmoidf_(b), c * sigmoidf_(c), d * sigmoidf_(d));
        });
      }
      for (int it = grab(ctr + 6, slot, tid); it < 224; it = grab(ctr + 6, slot, tid)) retkv_item(p, it, smem, tid);
      for (int it = grab(ctr + 1, slot, tid); it < 512; it = grab(ctr + 1, slot, tid)) attn_item<MODE_WIN>(p, it, smem, tid);
    } break;
    case 3: {
      for (int it = bid; it < 16; it += G) {
        const int which = it >> 3, mt = it & 7;
        const int m0 = mt * 256;
        f32x16 acc[1][4];
        acc_zero<1>(acc);
        PlainPtr af{(const bfr*)(ws + OFF_HIDC) + (size_t)which * 2048 * 1024 + (size_t)m0 * 1024, 1024};
        PlainPtr bf{(const bfr*)(ws + OFF_W2T) + (size_t)which * 128 * 1024, 1024};
        gemm_main<1>(acc, af, bf, 16, smem, tid);
        bfr* dstb = (bfr*)(ws + OFF_KCVC) + (size_t)which * 2048 * 128;
        gemm_epi<1>(acc, m0, 0, tid, [&](int m, int n, float a, float b, float c, float d) { st_bf4(dstb + (size_t)m * 128 + n, a, b, c, d); });
      }
      for (int it = grab(ctr + 5, slot, tid); it < 512; it = grab(ctr + 5, slot, tid)) attn_item<MODE_RET>(p, it, smem, tid);
    } break;
    case 4: {
      for (int it = bid; it < 512; it += G) cmp_item(p, it, smem, tid);
      for (int it = bid; it < NTOK / 8; it += G) ret_finish_rows4(p, it * 8 + (tid >> 8), tid & 255);
    } break;
    case 5: {
      for (int it = grab(ctr + 2, slot, tid); it < 512; it = grab(ctr + 2, slot, tid)) attn_item<MODE_SEL>(p, it, smem, tid);
    } break;
    case 6: {
      bfr* mg = (bfr*)(ws + OFF_MERGED);
      gemm8_phase(smem, (const bfr*)(ws + OFF_ONSA), (const bfr*)(ws + OFF_WAT), 2048, 32 * 8, G, bid, tid,
        [&](const f32x4 (&acc)[2][2][4][2], int m0, int n0, int wr, int wc, int fr, int fq) {
          epi8_foreach(acc, m0, n0, wr, wc, fr, fq, [&](int m, int n, const f32x4& v0, const f32x4& v1) {
            const u32x4 ga = *(const u32x4*)(z + (size_t)m * ZS + ZC_GA + n);
            f32x4 a0 = {bflo(ga[0]) * v0[0], bfhi(ga[0]) * v0[1], bflo(ga[1]) * v0[2], bfhi(ga[1]) * v0[3]};
            f32x4 a1 = {bflo(ga[2]) * v1[0], bfhi(ga[2]) * v1[1], bflo(ga[3]) * v1[2], bfhi(ga[3]) * v1[3]};
            st_bf8(mg + (size_t)m * 2048 + n, a0, a1);
          });
        });
      gemm8_phase(smem, (const bfr*)(ws + OFF_ORET), (const bfr*)(ws + OFF_WBT), 2048, 32 * 8, G, bid, tid,
        [&](const f32x4 (&acc)[2][2][4][2], int m0, int n0, int wr, int wc, int fr, int fq) {
          epi8_foreach(acc, m0, n0, wr, wc, fr, fq, [&](int m, int n, const f32x4& v0, const f32x4& v1) {
            const u32x4 gb = *(const u32x4*)(z + (size_t)m * ZS + ZC_GB + n);
            bfr* dst = mg + (size_t)m * 2048 + n;
            const u32x4 old = *(const u32x4*)dst;
            f32x4 a0 = {bflo(old[0]) + bflo(gb[0]) * v0[0], bfhi(old[0]) + bfhi(gb[0]) * v0[1], bflo(old[1]) + bflo(gb[1]) * v0[2], bfhi(old[1]) + bfhi(gb[1]) * v0[3]};
            f32x4 a1 = {bflo(old[2]) + bflo(gb[2]) * v1[0], bfhi(old[2]) + bfhi(gb[2]) * v1[1], bflo(old[3]) + bflo(gb[3]) * v1[2], bfhi(old[3]) + bfhi(gb[3]) * v1[3]};
            st_bf8(dst, a0, a1);
          });
        });
    } break;
    case 7: {
      gemm8_phase(smem, (const bfr*)(ws + OFF_MERGED), (const bfr*)(ws + OFF_WOUTT), 2048, 32 * 8, G, bid, tid,
        [&](const f32x4 (&acc)[2][2][4][2], int m0, int n0, int wr, int wc, int fr, int fq) {
          epi8_resid(acc, m0, n0, wr, wc, fr, fq, p.x, (float*)(ws + OFF_H), (bfr*)(ws + OFF_NX), (float*)(ws + OFF_ROWSS));
        });
    } break;
    case 8: case 12: break;
    case 9: {
      const int ng = (G > 128) ? 128 : G;
      if (bid < ng)
      for (int v = bid; v < 32 * 4; v += ng) {
        int mt, nt;
        map_tile32(v, mt, nt);
        const int m0 = mt * 256, n0 = nt * 128;
        f32x16 acc[1][4];
        acc_zero<1>(acc);
        PlainPtr af{(const bfr*)(ws + OFF_NX) + (size_t)m0 * 2048, 2048};
        PlainPtr bf{(const bfr*)(ws + OFF_WQT) + (size_t)n0 * 2048, 2048};
        gemm_main<1>(acc, af, bf, 32, smem, tid);
        bfr* qx = (bfr*)(ws + OFF_QX);
        const float* rss = (const float*)(ws + OFF_ROWSS);
        gemm_epi<1>(acc, m0, n0, tid, [&](int m, int n, float a, float b, float c, float d) {
          const float rs = rsqrtf(rss[m] * (1.f / 2048.f) + 1e-6f);
          st_bf4(qx + (size_t)m * 512 + n, a * rs, b * rs, c * rs, d * rs);
        });
      }
      {
        const int nt12 = tjob_tiles(12);
        for (int c = grab(ctr + 3, slot, tid); c * 8 < nt12; c = grab(ctr + 3, slot, tid))
          tr_run(p, 12, c * 8, 1, (c * 8 + 8 < nt12) ? c * 8 + 8 : nt12, (float*)smem, tid);
      }
    } break;
    case 10: {
      const int ng = (G > 128) ? 128 : G;
      if (bid < ng)
        for (int it = bid; it < 128; it += ng) attn_item<MODE_X>(p, it, smem, tid);
      {
        const int nt13 = tjob_tiles(13);
        for (int c = grab(ctr + 4, slot, tid); c * 8 < nt13; c = grab(ctr + 4, slot, tid))
          tr_run(p, 13, c * 8, 1, (c * 8 + 8 < nt13) ? c * 8 + 8 : nt13, (float*)smem, tid);
      }
    } break;
    case 11: {
      gemm8_phase(smem, (const bfr*)(ws + OFF_OX), (const bfr*)(ws + OFF_WOT), 512, 32 * 8, G, bid, tid,
        [&](const f32x4 (&acc)[2][2][4][2], int m0, int n0, int wr, int wc, int fr, int fq) {
          epi8_resid(acc, m0, n0, wr, wc, fr, fq, (const float*)(ws + OFF_H), (float*)(ws + OFF_H), (bfr*)(ws + OFF_NX), (float*)(ws + OFF_ROWSS) + NTOK);
        });
    } break;
    case 13: {
      bfr* hid = (bfr*)(ws + OFF_HID);
      const float* rss = (const float*)(ws + OFF_ROWSS) + NTOK;
      gemm8_phase(smem, (const bfr*)(ws + OFF_NX), (const bfr*)(ws + OFF_WUPT), 2048, 32 * 32, G, bid, tid,
        [&](const f32x4 (&acc)[2][2][4][2], int m0, int n0, int wr, int wc, int fr, int fq) {
          epi8_foreach(acc, m0, n0, wr, wc, fr, fq, [&](int m, int n, const f32x4& v0, const f32x4& v1) {
            const float rs = rsqrtf(rss[m] * (1.f / 2048.f) + 1e-6f);
            f32x4 a0, a1;
#pragma unroll
            for (int j = 0; j < 4; ++j) { const float t0 = fmaxf(v0[j], 0.f) * rs, t1 = fmaxf(v1[j], 0.f) * rs; a0[j] = t0 * t0; a1[j] = t1 * t1; }
            st_bf8(hid + (size_t)m * 8192 + n, a0, a1);
          });
        });
    } break;
    case 14: {
      const float* hbuf = (const float*)(ws + OFF_H);
      gemm8_phase(smem, (const bfr*)(ws + OFF_HID), (const bfr*)(ws + OFF_WDOWNT), 8192, 32 * 8, G, bid, tid,
        [&](const f32x4 (&acc)[2][2][4][2], int m0, int n0, int wr, int wc, int fr, int fq) {
          epi8_foreach(acc, m0, n0, wr, wc, fr, fq, [&](int m, int n, const f32x4& v0, const f32x4& v1) {
            const float* sp = hbuf + (size_t)m * 2048 + n;
            const f32x4 x0 = *(const f32x4*)sp, x1 = *(const f32x4*)(sp + 4);
            float* dp = p.out + (size_t)m * 2048 + n;
            *(f32x4*)dp = x0 + v0; *(f32x4*)(dp + 4) = x1 + v1;
          });
        });
    } break;
    case 15: {
      for (int it = bid; it < 1024; it += G) {
        const int row = it * 8 + (tid >> 6);
        rmsnorm_row(p.out + (size_t)row * 2048, p.final_norm_w, nullptr, p.out + (size_t)row * 2048, tid);
      }
    } break;
    default: break;
  }
}

#define XB_TMO      128
#define XB_XCNT(j)  (256  + 64 * (j))
#define XB_XSUB(j)  (1280 + 64 * (j))
#define XB_XGEN(j)  (2304 + 64 * (j))
#define XB_TOP      3328
#define XB_TOPGEN   3392
#define XB_SPIN_CAP (1u << 18)
DI unsigned xb_ld(unsigned* p) { return __hip_atomic_load(p, __ATOMIC_RELAXED, __HIP_MEMORY_SCOPE_AGENT); }
DI unsigned xb_add(unsigned* p, unsigned v) { return __hip_atomic_fetch_add(p, v, __ATOMIC_RELAXED, __HIP_MEMORY_SCOPE_AGENT); }
DI unsigned xb_xcc_id() { return (unsigned)__builtin_amdgcn_s_getreg((3 << 11) | 20) & 0xFu; }
#define XB_SPIN(cond, bar) do { unsigned _sp = 0; while (cond) { __builtin_amdgcn_s_sleep(1); \
    if ((++_sp & 255u) == 0u) { if (xb_ld(&(bar)[XB_TMO])) break; if (_sp > XB_SPIN_CAP) { atomicAdd(&(bar)[XB_TMO], 1u); break; } } } } while (0)
typedef __attribute__((address_space(3))) volatile unsigned lds_vu;
struct XcdBarrier { unsigned* bar; unsigned x; lds_vu* st; };
DI lds_vu* xb_words() { __shared__ unsigned xbw[4]; return (lds_vu*)xbw; }
DI XcdBarrier xcd_barrier_post(unsigned* bar, lds_vu* st) {
  XcdBarrier b; b.bar = bar; b.x = xb_xcc_id(); b.st = st;
  if (threadIdx.x == 0) (void)xb_add(&bar[XB_XCNT(b.x)], 1u);
  return b;
}
DI void xcd_barrier_complete(unsigned* bar, unsigned x, unsigned& nloc, unsigned& nx) {
  const unsigned Gt = gridDim.x * gridDim.y * gridDim.z;
  unsigned sum, cnt, mine, sp = 0u;
  for (;;) {
    sum = 0u; cnt = 0u; mine = 0u;
#pragma unroll
    for (unsigned j = 0; j < 16; ++j) { const unsigned c = xb_ld(&bar[XB_XCNT(j)]); sum += c; cnt += (c > 0u) ? 1u : 0u; mine = (j == x) ? c : mine; }
    if (sum == Gt) break;
    __builtin_amdgcn_s_sleep(1);
    if ((++sp & 255u) == 0u) { if (xb_ld(&bar[XB_TMO])) break; if (sp > XB_SPIN_CAP) { atomicAdd(&bar[XB_TMO], 1u); break; } }
  }
  nloc = mine > 0u ? mine : 1u; nx = cnt > 0u ? cnt : 1u;
}
DI void xcd_barrier(unsigned* bar_in, const int wave_s) {
  lds_vu* st_in = xb_words();
  XcdBarrier b; b.bar = bar_in; b.st = st_in; b.x = xb_xcc_id();
  asm volatile("s_waitcnt vmcnt(0)" ::: "memory");
  __syncthreads();
  if (wave_s == 0 && __builtin_amdgcn_mbcnt_hi(~0u, __builtin_amdgcn_mbcnt_lo(~0u, 0u)) == 0u) {
    unsigned* bar = b.bar;
    __builtin_amdgcn_s_waitcnt(0);
    unsigned nloc = b.st[0], nx = b.st[1];
    if (nloc == 0u) { xcd_barrier_complete(bar, b.x, nloc, nx); b.st[0] = nloc; b.st[1] = nx; }
    const unsigned old = xb_add(&bar[XB_XSUB(b.x)], 1u);
    const unsigned gen = old / nloc;
    if (old + 1u == (gen + 1u) * nloc) {
      __builtin_amdgcn_fence(__ATOMIC_RELEASE, "agent");
      asm volatile("s_waitcnt vmcnt(0)" ::: "memory");
      const unsigned og = xb_add(&bar[XB_TOP], 1u);
      const unsigned tg = og / nx;
      if (og + 1u == (tg + 1u) * nx) xb_add(&bar[XB_TOPGEN], 1u);
      else XB_SPIN(xb_ld(&bar[XB_TOPGEN]) == tg, bar);
      __builtin_amdgcn_fence(__ATOMIC_ACQUIRE, "agent");
      xb_add(&bar[XB_XGEN(b.x)], 1u);
      asm volatile("s_waitcnt vmcnt(0)" ::: "memory");
    } else {
      XB_SPIN(xb_ld(&bar[XB_XGEN(b.x)]) == gen, bar);
      __builtin_amdgcn_fence(__ATOMIC_ACQUIRE, "agent");
      asm volatile("s_waitcnt vmcnt(0)" ::: "memory");
    }
  }
  __syncthreads();
}

__global__ void __launch_bounds__(512, 2) mega(Params p) {
  extern __shared__ __attribute__((aligned(1024))) char smem[];
  __shared__ int slot;
  cg::grid_group grid = cg::this_grid();
  const int wave_s = __builtin_amdgcn_readfirstlane((int)(threadIdx.x >> 6));
  if (p.dbg == 12345) grid.sync();
  if (threadIdx.x < 4) xb_words()[threadIdx.x] = 0u;
  __syncthreads();
  (void)xcd_barrier_post((unsigned*)(p.ws + OFF_BAR), xb_words());
  for (int ph = p.ph_lo; ph < p.ph_hi; ++ph) {
    if (ph == 8 || ph == 12) continue;
    int nrep = 1;
#ifdef PROBE_PH
    if (ph == PROBE_PH) nrep = 1 + PROBE_N;
#endif
#pragma unroll 1
    for (int rep = 0; rep < nrep; ++rep) {
      run_phase(p, ph, smem, &slot, wave_s, rep);
      if (rep + 1 < nrep || ph + 1 < p.ph_hi) xcd_barrier((unsigned*)(p.ws + OFF_BAR), wave_s);
    }
  }
}

extern "C" void kernel_launch(void* const* d_in, const int* in_sizes, int n_in, void* d_out, int out_size, void* d_ws,
                              size_t ws_size, hipStream_t stream) {
  static int grid_blocks = 0;
  if (!grid_blocks) {
    int dev = 0, cus = 0, per_cu = 0;
    (void)hipGetDevice(&dev);
    (void)hipDeviceGetAttribute(&cus, hipDeviceAttributeMultiprocessorCount, dev);
    (void)hipFuncSetAttribute((const void*)mega, hipFuncAttributeMaxDynamicSharedMemorySize, SMEM_BYTES);
    (void)hipOccupancyMaxActiveBlocksPerMultiprocessor(&per_cu, mega, NTHR, SMEM_BYTES);
    if (per_cu < 1) per_cu = 1;
    if (per_cu > 1) per_cu = 1;
    grid_blocks = cus * per_cu;
    grid_blocks &= ~7;
    if (ws_size < WS_END || n_in != 24) { fprintf(stderr, "kernel_launch: ws %zu < %zu or n_in %d\n", ws_size, (size_t)WS_END, n_in); grid_blocks = -1; }
  }
  if (grid_blocks < 0) return;
  Params p{};
  const float** pp = (const float**)&p;
  for (int i = 0; i < 24; ++i) pp[i] = (const float*)d_in[i];
  p.out = (float*)d_out;
  p.ws = (char*)d_ws;
#if ONE_LAUNCH
  p.ph_lo = 0; p.ph_hi = NPHASE;
  (void)hipMemsetAsync((char*)d_ws + OFF_BAR, 0, BAR_BYTES, stream);
  void* args[] = {&p};
  hipError_t e = hipLaunchCooperativeKernel((void*)mega, dim3(grid_blocks), dim3(NTHR), args, SMEM_BYTES, stream);
  if (e != hipSuccess) fprintf(stderr, "cooperative launch failed: %s (grid %d)\n", hipGetErrorString(e), grid_blocks);
#else
  for (int ph = 0; ph < NPHASE; ++ph) {
    p.ph_lo = ph; p.ph_hi = ph + 1;
    hipLaunchKernelGGL(mega, dim3(grid_blocks), dim3(NTHR), SMEM_BYTES, stream, p);
  }
#endif
}
```
